# Optimizing an MI355X kernel written in HIP

```python
import math
import jax
import jax.numpy as jnp
from jax import lax
import numpy as np

D_MODEL = 2048
BATCH = 16
SEQ = 256
DEPTH = 2
DEC_BATCH = 4
DEC_SEQ = 4096
PAST_LEN = 256

GRID_W = 64
ROPE_DIM = 64
ROPE_BASE = 10000.0
RMS_EPS = 1e-6
ATTN_BLOCK = 128
ML_HEADS = 4
ML_DH = 256
ML_W = ML_HEADS * ML_DH
ML_CHUNK = 64
MLA_HEADS = 8
MLA_NOPE = 128
MLA_ROPE = ROPE_DIM
MLA_V = 128
MLA_KV_RANK = 512
MLA_W = MLA_HEADS * MLA_V
S5_GROUP = 16
S5_GROUPS = 64
S5_W = S5_GROUPS * S5_GROUP
S5_P = 64
S5_CHUNK = 128
DF_HEADS = 8
DF_DQK = ROPE_DIM
DF_DV = 2 * DF_DQK
DF_W = DF_HEADS * DF_DV
N_BRANCH = 4
BRANCH_W = 1024
FFN_HIDDEN = (8 * D_MODEL + 3 * 256 - 1) // (3 * 256) * 256
IN_SIZES = (ML_W, ML_W, ML_W, ML_W, 4 * ML_HEADS,
            MLA_HEADS * (MLA_NOPE + MLA_ROPE), MLA_KV_RANK + MLA_ROPE,
            S5_W,
            DF_HEADS * 2 * DF_DQK, DF_HEADS * 2 * DF_DQK, DF_HEADS * DF_DV,
            N_BRANCH * D_MODEL)
IN_SPLITS = tuple(int(s) for s in np.cumsum(IN_SIZES)[:-1])
IN_COLS = int(sum(IN_SIZES))

kernel_name = 'hybrid_mlstm_mla_s5_diffattn_prefix_dit_step'


def _rmsnorm(x, g):
    xf = x.astype(jnp.float32)
    y = xf * lax.rsqrt(jnp.mean(xf * xf, axis=-1, keepdims=True) + RMS_EPS)
    return (y * g.astype(jnp.float32)).astype(x.dtype)


def _map_query_blocks(fn, q):
    bsz, n = q.shape[0], q.shape[1]
    nb = n // ATTN_BLOCK
    qb = jnp.moveaxis(q.reshape((bsz, nb, ATTN_BLOCK) + q.shape[2:]), 1, 0)
    out = jnp.moveaxis(lax.map(fn, qb), 0, 1)
    return out.reshape((bsz, n) + out.shape[3:])


def _softmax_attend(q, k, v, scale):
    def blk(qb):
        s = jnp.einsum('bqhd,bkhd->bhqk', qb, k).astype(jnp.float32) * scale
        p = jax.nn.softmax(s, axis=-1).astype(v.dtype)
        return jnp.einsum('bhqk,bkhd->bqhd', p, v)
    return _map_query_blocks(blk, q)


def _diff_attend(q, k, v, lam, scale):
    def blk(qb):
        s = jnp.einsum('bqhcd,bkhcd->bchqk', qb, k).astype(jnp.float32) * scale
        p = jax.nn.softmax(s, axis=-1)
        pd = (p[:, 0] - lam * p[:, 1]).astype(v.dtype)
        return jnp.einsum('bhqk,bkhd->bqhd', pd, v)
    return _map_query_blocks(blk, q)


def _axial_rope_tables(n_tok):
    grid_rows = n_tok // GRID_W
    rows, cols = jnp.meshgrid(jnp.arange(grid_rows, dtype=jnp.float32),
                              jnp.arange(GRID_W, dtype=jnp.float32), indexing='ij')
    quarter = ROPE_DIM // 4
    inv = ROPE_BASE ** (-jnp.arange(quarter, dtype=jnp.float32) / quarter)
    ang_r = rows.reshape(-1, 1) * inv
    ang_c = cols.reshape(-1, 1) * inv
    return (jnp.cos(ang_r), jnp.sin(ang_r), jnp.cos(ang_c), jnp.sin(ang_c))


def _rotate(z, cos, sin):
    z1, z2 = jnp.split(z, 2, axis=-1)
    return jnp.concatenate([z1 * cos - z2 * sin, z2 * cos + z1 * sin], axis=-1)


def _apply_axial_rope(x, tables):
    cos_r, sin_r, cos_c, sin_c = (t[:, None, :] for t in tables)
    x_row, x_col = jnp.split(x.astype(jnp.float32), 2, axis=-1)
    out = jnp.concatenate([_rotate(x_row, cos_r, sin_r), _rotate(x_col, cos_c, sin_c)], axis=-1)
    return out.astype(x.dtype)


def _mlstm_dir(q, k, v, log_i, log_f, c0, n0, m0):
    bsz, n = q.shape[0], q.shape[1]
    nc = n // ML_CHUNK
    tril = jnp.tril(jnp.ones((ML_CHUNK, ML_CHUNK), dtype=bool))

    def chunks(a):
        return jnp.moveaxis(a.reshape((bsz, nc, ML_CHUNK) + a.shape[2:]), 1, 0)

    def body(carry, xs):
        c_st, n_st, m_st = carry
        qc, kc, vc, li, lf = xs
        b = jnp.cumsum(lf, axis=1)
        log_d = b[:, :, None, :] - b[:, None, :, :] + li[:, None, :, :]
        log_d = jnp.where(tril[None, :, :, None], log_d, -jnp.inf)
        log_inter = b + m_st[:, None, :]
        m_t = jnp.maximum(log_inter, jnp.max(log_d, axis=2))
        w_d = jnp.exp(log_d - m_t[:, :, None, :])
        w_inter = jnp.exp(log_inter - m_t)
        s = jnp.einsum('bthd,bshd->btsh', qc, kc) * w_d
        num = (jnp.einsum('btsh,bshd->bthd', s, vc)
               + w_inter[..., None] * jnp.einsum('bhvk,bthk->bthv', c_st, qc))
        den = jnp.sum(s, axis=2) + w_inter * jnp.einsum('bhk,bthk->bth', n_st, qc)
        h = num / jnp.maximum(jnp.abs(den), jnp.exp(-m_t))[..., None]
        b_last = b[:, -1, :]
        log_w = b_last[:, None, :] - b + li
        m_new = jnp.maximum(b_last + m_st, jnp.max(log_w, axis=1))
        w_s = jnp.exp(log_w - m_new[:, None, :])
        w_c = jnp.exp(b_last + m_st - m_new)
        c_new = w_c[..., None, None] * c_st + jnp.einsum('bshv,bshk->bhvk', vc * w_s[..., None], kc)
        n_new = w_c[..., None] * n_st + jnp.einsum('bsh,bshk->bhk', w_s, kc)
        return (c_new, n_new, m_new), h

    (c_f, n_f, m_f), h = lax.scan(body, (c0, n0, m0),
                                  (chunks(q), chunks(k), chunks(v), chunks(log_i), chunks(log_f)))
    h = jnp.moveaxis(h, 0, 1).reshape(q.shape)
    return h, c_f, n_f, m_f


def _mlstm_bidir(q, k, v, log_i, log_f, c0, n0, m0):
    h_f, c_f, n_f, m_f = _mlstm_dir(q, k, v, log_i[:, :, 0], log_f[:, :, 0], c0[:, 0], n0[:, 0], m0[:, 0])
    h_b, c_b, n_b, m_b = _mlstm_dir(jnp.flip(q, 1), jnp.flip(k, 1), jnp.flip(v, 1),
                                    jnp.flip(log_i[:, :, 1], 1), jnp.flip(log_f[:, :, 1], 1),
                                    c0[:, 1], n0[:, 1], m0[:, 1])
    return (h_f + jnp.flip(h_b, 1), jnp.stack([c_f, c_b], axis=1),
            jnp.stack([n_f, n_b], axis=1), jnp.stack([m_f, m_b], axis=1))


def _complex_affine_combine(e1, e2):
    a1r, a1i, b1r, b1i = e1
    a2r, a2i, b2r, b2i = e2
    return (a2r * a1r - a2i * a1i, a2r * a1i + a2i * a1r,
            a2r * b1r - a2i * b1i + b2r, a2r * b1i + a2i * b1r + b2i)


def _s5_discretise(a_re, a_im, log_dt, b_re, b_im):
    lr = jnp.minimum(a_re.astype(jnp.float32), -1e-4)
    li = a_im.astype(jnp.float32)
    dt = jnp.exp(log_dt.astype(jnp.float32))[:, None]
    mag = jnp.exp(dt * lr)
    ab_re, ab_im = mag * jnp.cos(dt * li), mag * jnp.sin(dt * li)
    den = lr * lr + li * li
    nr, ni = ab_re - 1.0, ab_im
    qr = (nr * lr + ni * li) / den
    qi = (ni * lr - nr * li) / den
    b_re, b_im = b_re.astype(jnp.float32), b_im.astype(jnp.float32)
    bb_re = qr[..., None] * b_re - qi[..., None] * b_im
    bb_im = qr[..., None] * b_im + qi[..., None] * b_re
    return ab_re, ab_im, bb_re, bb_im


def _s5_dir(u, ab_re, ab_im, bb_re, bb_im, c_re, c_im, h_re, h_im):
    bsz, n = u.shape[0], u.shape[1]
    nc = n // S5_CHUNK
    uc = jnp.moveaxis(u.reshape((bsz, nc, S5_CHUNK) + u.shape[2:]), 1, 0)

    def body(carry, u_blk):
        hr, hi = carry
        bu_re = jnp.einsum('gpi,blgi->blgp', bb_re, u_blk)
        bu_im = jnp.einsum('gpi,blgi->blgp', bb_im, u_blk)
        bu_re = bu_re.at[:, 0].add(ab_re * hr - ab_im * hi)
        bu_im = bu_im.at[:, 0].add(ab_re * hi + ab_im * hr)
        a_re = jnp.broadcast_to(ab_re, bu_re.shape)
        a_im = jnp.broadcast_to(ab_im, bu_im.shape)
        _, _, sr, si = lax.associative_scan(_complex_affine_combine, (a_re, a_im, bu_re, bu_im), axis=1)
        y = jnp.einsum('gip,blgp->blgi', c_re, sr) - jnp.einsum('gip,blgp->blgi', c_im, si)
        return (sr[:, -1], si[:, -1]), y

    (hr_f, hi_f), y = lax.scan(body, (h_re, h_im), uc)
    return jnp.moveaxis(y, 0, 1).reshape(u.shape), hr_f, hi_f


def _s5_bidir(u, a_re, a_im, log_dt, b_re, b_im, c_re, c_im, h0_re, h0_im):
    ab_re, ab_im, bb_re, bb_im = _s5_discretise(a_re[0], a_im[0], log_dt[0], b_re[0], b_im[0])
    y_f, hr_f, hi_f = _s5_dir(u, ab_re, ab_im, bb_re, bb_im, c_re[0].astype(jnp.float32),
                              c_im[0].astype(jnp.float32), h0_re[:, 0], h0_im[:, 0])
    ab_re, ab_im, bb_re, bb_im = _s5_discretise(a_re[1], a_im[1], log_dt[1], b_re[1], b_im[1])
    y_b, hr_b, hi_b = _s5_dir(jnp.flip(u, 1), ab_re, ab_im, bb_re, bb_im, c_re[1].astype(jnp.float32),
                              c_im[1].astype(jnp.float32), h0_re[:, 1], h0_im[:, 1])
    return (y_f + jnp.flip(y_b, 1), jnp.stack([hr_f, hr_b], axis=1), jnp.stack([hi_f, hi_b], axis=1))


def _mixer(h, lp, rope, ctx):
    f32 = jnp.float32
    bsz, n, _ = h.shape
    (ml_q, ml_k, ml_v, ml_o, ml_if, mla_q, mla_kva, s5_u,
     df_q, df_k, df_v, gate_pre) = jnp.split(h @ lp['w_in'], IN_SPLITS, axis=-1)
    latent = ctx is not None
    if latent:
        (ckv_c, krope_c, dk_c, dv_c, ml_c0, ml_n0, ml_m0, s5_h0r, s5_h0i) = ctx
        ml_c0, ml_n0, ml_m0 = ml_c0.astype(f32), ml_n0.astype(f32), ml_m0.astype(f32)
        s5_h0r, s5_h0i = s5_h0r.astype(f32), s5_h0i.astype(f32)
    else:
        ml_c0 = jnp.zeros((bsz, 2, ML_HEADS, ML_DH, ML_DH), f32)
        ml_n0 = jnp.zeros((bsz, 2, ML_HEADS, ML_DH), f32)
        ml_m0 = jnp.zeros((bsz, 2, ML_HEADS), f32)
        s5_h0r = jnp.zeros((bsz, 2, S5_GROUPS, S5_P), f32)
        s5_h0i = jnp.zeros((bsz, 2, S5_GROUPS, S5_P), f32)

    q = ml_q.reshape(bsz, n, ML_HEADS, ML_DH).astype(f32)
    k = ml_k.reshape(bsz, n, ML_HEADS, ML_DH).astype(f32) * (ML_DH ** -0.5)
    v = ml_v.reshape(bsz, n, ML_HEADS, ML_DH).astype(f32)
    gpre = ml_if.reshape(bsz, n, 2, 2, ML_HEADS).astype(f32) + lp['ml_if_bias'].astype(f32)
    log_i = gpre[:, :, :, 0]
    log_f = jax.nn.log_sigmoid(gpre[:, :, :, 1])
    h_ml, ml_c, ml_n, ml_m = _mlstm_bidir(q, k, v, log_i, log_f, ml_c0, ml_n0, ml_m0)
    h_ml = _rmsnorm(h_ml, lp['ml_norm'].reshape(ML_HEADS, ML_DH)).astype(h.dtype)
    y_ml = (h_ml * jax.nn.sigmoid(ml_o.reshape(bsz, n, ML_HEADS, ML_DH))).reshape(bsz, n, ML_W)

    qm = mla_q.reshape(bsz, n, MLA_HEADS, MLA_NOPE + MLA_ROPE)
    q_nope, q_rope = qm[..., :MLA_NOPE], qm[..., MLA_NOPE:]
    ckv = _rmsnorm(mla_kva[..., :MLA_KV_RANK], lp['mla_kv_norm'])
    krope = mla_kva[..., MLA_KV_RANK:]
    if latent:
        q_rope = _apply_axial_rope(q_rope, rope)
        krope_lat = _apply_axial_rope(krope[:, :, None, :], rope)[:, :, 0, :]
        ckv_all = jnp.concatenate([ckv, ckv_c.astype(ckv.dtype)], axis=1)
        krope_all = jnp.concatenate([krope_lat, krope_c.astype(krope.dtype)], axis=1)
    else:
        ckv_all, krope_all = ckv, krope
    kv = (ckv_all @ lp['mla_w_kvb']).reshape(bsz, -1, MLA_HEADS, MLA_NOPE + MLA_V)
    k_nope, v_mla = kv[..., :MLA_NOPE], kv[..., MLA_NOPE:]
    k_mla = jnp.concatenate(
        [k_nope, jnp.broadcast_to(krope_all[:, :, None, :], k_nope.shape[:3] + (MLA_ROPE,))], axis=-1)
    q_mla = jnp.concatenate([q_nope, q_rope], axis=-1)
    y_mla = _softmax_attend(q_mla, k_mla, v_mla, (MLA_NOPE + MLA_ROPE) ** -0.5).reshape(bsz, n, MLA_W)

    u = s5_u.reshape(bsz, n, S5_GROUPS, S5_GROUP).astype(f32)
    y_ss, s5_hr, s5_hi = _s5_bidir(u, lp['s5_a_re'], lp['s5_a_im'], lp['s5_log_dt'], lp['s5_b_re'],
                                   lp['s5_b_im'], lp['s5_c_re'], lp['s5_c_im'], s5_h0r, s5_h0i)
    y_ss = y_ss.reshape(bsz, n, S5_W).astype(h.dtype) + lp['s5_d'] * s5_u
    g_ss = jax.nn.gelu(y_ss)
    y_s5 = g_ss * jax.nn.sigmoid(g_ss @ lp['s5_w_glu'])

    dq = df_q.reshape(bsz, n, 2 * DF_HEADS, DF_DQK)
    dk = df_k.reshape(bsz, n, 2 * DF_HEADS, DF_DQK)
    dv = df_v.reshape(bsz, n, DF_HEADS, DF_DV)
    dk_ctx_layout = dk.reshape(bsz, n, DF_HEADS, 2 * DF_DQK)
    if latent:
        dq = _apply_axial_rope(dq, rope)
        dk_lat = _apply_axial_rope(dk, rope).reshape(bsz, n, DF_HEADS, 2, DF_DQK)
        dk_all = jnp.concatenate(
            [dk_lat, dk_c.astype(dk.dtype).reshape(bsz, -1, DF_HEADS, 2, DF_DQK)], axis=1)
        dv_all = jnp.concatenate([dv, dv_c.astype(dv.dtype)], axis=1)
    else:
        dk_all = dk.reshape(bsz, n, DF_HEADS, 2, DF_DQK)
        dv_all = dv
    lam_p = lp['df_lambda'].astype(f32)
    lam = (jnp.exp(jnp.sum(lam_p[0] * lam_p[1])) - jnp.exp(jnp.sum(lam_p[2] * lam_p[3]))
           + lp['lam_init'])
    o = _diff_attend(dq.reshape(bsz, n, DF_HEADS, 2, DF_DQK), dk_all, dv_all, lam, DF_DQK ** -0.5)
    y_df = (_rmsnorm(o, lp['df_norm']) * (1.0 - lp['lam_init'])).reshape(bsz, n, DF_W)

    gates = jax.nn.sigmoid(gate_pre.reshape(bsz, n, N_BRANCH, D_MODEL))
    wb = lp['w_branch']
    merged = (gates[:, :, 0] * (y_ml @ wb[0]) + gates[:, :, 1] * (y_mla @ wb[1])
              + gates[:, :, 2] * (y_s5 @ wb[2]) + gates[:, :, 3] * (y_df @ wb[3]))
    out = merged @ lp['w_o']
    new_ctx = None if latent else (ckv, krope, dk_ctx_layout, dv, ml_c, ml_n, ml_m, s5_hr, s5_hi)
    return out, new_ctx


def _layer(x, cond, lp, rope, ctx):
    mod = jax.nn.silu(cond) @ lp['w_ada'] + lp['b_ada']
    sh1, sc1, g1, sh2, sc2, g2 = jnp.split(mod[:, None, :], 6, axis=-1)
    h = _rmsnorm(x, lp['norm_mix']) * (1.0 + sc1) + sh1
    mix, new_ctx = _mixer(h, lp, rope, ctx)
    x = x + g1 * mix
    h = _rmsnorm(x, lp['norm_ffn']) * (1.0 + sc2) + sh2
    a, b = jnp.split(h @ lp['w_ffn_in'], 2, axis=-1)
    x = x + g2 * ((jax.nn.silu(a) * b) @ lp['w_ffn_out'])
    return x, new_ctx


def setup_inputs(seed: int = 0) -> dict:
    key = jax.random.key(seed)
    ks = iter(jax.random.split(key, 48))
    f32 = jnp.float32

    def nrm(shape, scale):
        return scale * jax.random.normal(next(ks), shape, f32)

    def gain(shape):
        return 1.0 + nrm(shape, 0.01)

    inp = {}
    inp['x_prompt'] = nrm((BATCH, SEQ, D_MODEL), 1.0)
    inp['x_sample'] = nrm((DEC_BATCH, DEC_SEQ, D_MODEL), 1.0)
    inp['cache_mla_ckv'] = nrm((DEC_BATCH, DEPTH, PAST_LEN, MLA_KV_RANK), 1.0)
    inp['cache_mla_krope'] = nrm((DEC_BATCH, DEPTH, PAST_LEN, MLA_ROPE), 1.0)
    inp['cache_diff_k'] = nrm((DEC_BATCH, DEPTH, PAST_LEN, DF_HEADS, 2 * DF_DQK), 1.0)
    inp['cache_diff_v'] = nrm((DEC_BATCH, DEPTH, PAST_LEN, DF_HEADS, DF_DV), 1.0)
    inp['state_mlstm_c'] = nrm((DEC_BATCH, DEPTH, 2, ML_HEADS, ML_DH, ML_DH), 0.1)
    inp['state_mlstm_n'] = nrm((DEC_BATCH, DEPTH, 2, ML_HEADS, ML_DH), 0.1)
    inp['state_mlstm_m'] = nrm((DEC_BATCH, DEPTH, 2, ML_HEADS), 1.0)
    inp['state_s5_re'] = nrm((DEC_BATCH, DEPTH, 2, S5_GROUPS, S5_P), 0.1)
    inp['state_s5_im'] = nrm((DEC_BATCH, DEPTH, 2, S5_GROUPS, S5_P), 0.1)
    inp['c'] = nrm((DEC_BATCH, D_MODEL), 1.0)
    inp['c_ctx'] = nrm((D_MODEL,), 1.0)
    inp['w_ada'] = nrm((DEPTH, D_MODEL, 6 * D_MODEL), 0.5 * D_MODEL ** -0.5)
    inp['b_ada'] = nrm((DEPTH, 6 * D_MODEL), 0.01)
    inp['norm_mix'] = gain((DEPTH, D_MODEL))
    inp['norm_ffn'] = gain((DEPTH, D_MODEL))
    inp['w_in'] = nrm((DEPTH, D_MODEL, IN_COLS), D_MODEL ** -0.5)
    i_bias = nrm((DEPTH, 2, ML_HEADS), 0.1)
    f_bias = jnp.linspace(3.0, 6.0, ML_HEADS, dtype=f32) + nrm((DEPTH, 2, ML_HEADS), 0.1)
    inp['ml_if_bias'] = jnp.stack([i_bias, f_bias], axis=2)
    inp['ml_norm'] = gain((DEPTH, ML_W))
    inp['mla_kv_norm'] = gain((DEPTH, MLA_KV_RANK))
    inp['mla_w_kvb'] = nrm((DEPTH, MLA_KV_RANK, MLA_HEADS * (MLA_NOPE + MLA_V)), MLA_KV_RANK ** -0.5)
    n_idx = jnp.arange(S5_P, dtype=f32)
    inp['s5_a_re'] = -0.5 + nrm((DEPTH, 2, S5_GROUPS, S5_P), 0.01)
    inp['s5_a_im'] = math.pi * n_idx + nrm((DEPTH, 2, S5_GROUPS, S5_P), 0.01)
    inp['s5_log_dt'] = jax.random.uniform(next(ks), (DEPTH, 2, S5_GROUPS), f32,
                                          math.log(1e-3), math.log(1e-1))
    inp['s5_b_re'] = nrm((DEPTH, 2, S5_GROUPS, S5_P, S5_GROUP), (2 * S5_GROUP) ** -0.5)
    inp['s5_b_im'] = nrm((DEPTH, 2, S5_GROUPS, S5_P, S5_GROUP), (2 * S5_GROUP) ** -0.5)
    inp['s5_c_re'] = nrm((DEPTH, 2, S5_GROUPS, S5_GROUP, S5_P), S5_P ** -0.5)
    inp['s5_c_im'] = nrm((DEPTH, 2, S5_GROUPS, S5_GROUP, S5_P), S5_P ** -0.5)
    inp['s5_d'] = nrm((DEPTH, S5_W), 1.0)
    inp['s5_w_glu'] = nrm((DEPTH, S5_W, S5_W), S5_W ** -0.5)
    inp['df_lambda'] = nrm((DEPTH, 4, DF_DQK), 0.1)
    inp['df_norm'] = gain((DEPTH, DF_DV))
    inp['w_branch'] = nrm((DEPTH, N_BRANCH, BRANCH_W, D_MODEL), BRANCH_W ** -0.5)
    inp['w_o'] = nrm((DEPTH, D_MODEL, D_MODEL), D_MODEL ** -0.5)
    inp['w_ffn_in'] = nrm((DEPTH, D_MODEL, 2 * FFN_HIDDEN), D_MODEL ** -0.5)
    inp['w_ffn_out'] = nrm((DEPTH, FFN_HIDDEN, D_MODEL), FFN_HIDDEN ** -0.5)
    inp['final_norm'] = gain((D_MODEL,))
    return inp


def reference(x_prompt, x_sample, cache_mla_ckv, cache_mla_krope, cache_diff_k, cache_diff_v,
              state_mlstm_c, state_mlstm_n, state_mlstm_m, state_s5_re, state_s5_im, c,
              c_ctx, w_ada, b_ada, norm_mix, norm_ffn, w_in, ml_if_bias, ml_norm, mla_kv_norm,
              mla_w_kvb, s5_a_re, s5_a_im, s5_log_dt, s5_b_re, s5_b_im, s5_c_re, s5_c_im, s5_d,
              s5_w_glu, df_lambda, df_norm, w_branch, w_o, w_ffn_in, w_ffn_out, final_norm):
    rope = _axial_rope_tables(x_sample.shape[1])
    cond_ctx = jnp.broadcast_to(c_ctx, (x_prompt.shape[0], D_MODEL))
    xp, xs = x_prompt, x_sample
    ctx_out = []
    for l in range(DEPTH):
        lp = {'w_ada': w_ada[l], 'b_ada': b_ada[l], 'norm_mix': norm_mix[l], 'norm_ffn': norm_ffn[l],
              'w_in': w_in[l], 'ml_if_bias': ml_if_bias[l], 'ml_norm': ml_norm[l],
              'mla_kv_norm': mla_kv_norm[l], 'mla_w_kvb': mla_w_kvb[l],
              's5_a_re': s5_a_re[l], 's5_a_im': s5_a_im[l], 's5_log_dt': s5_log_dt[l],
              's5_b_re': s5_b_re[l], 's5_b_im': s5_b_im[l], 's5_c_re': s5_c_re[l], 's5_c_im': s5_c_im[l],
              's5_d': s5_d[l], 's5_w_glu': s5_w_glu[l], 'df_lambda': df_lambda[l], 'df_norm': df_norm[l],
              'lam_init': 0.8 - 0.6 * math.exp(-0.3 * l),
              'w_branch': w_branch[l], 'w_o': w_o[l], 'w_ffn_in': w_ffn_in[l], 'w_ffn_out': w_ffn_out[l]}
        xp, new_ctx = _layer(xp, cond_ctx, lp, None, None)
        ctx_out.append(new_ctx)
        cached = (cache_mla_ckv[:, l], cache_mla_krope[:, l], cache_diff_k[:, l], cache_diff_v[:, l],
                  state_mlstm_c[:, l], state_mlstm_n[:, l], state_mlstm_m[:, l],
                  state_s5_re[:, l], state_s5_im[:, l])
        xs, _ = _layer(xs, c, lp, rope, cached)
    y_prompt = _rmsnorm(xp, final_norm)
    y_sample = _rmsnorm(xs, final_norm)
    new_mla_ckv = jnp.stack([t[0] for t in ctx_out], axis=1)
    new_mla_krope = jnp.stack([t[1] for t in ctx_out], axis=1)
    new_diff_k = jnp.stack([t[2] for t in ctx_out], axis=1)
    new_diff_v = jnp.stack([t[3] for t in ctx_out], axis=1)
    new_mlstm_c = jnp.stack([t[4] for t in ctx_out], axis=1)
    new_mlstm_n = jnp.stack([t[5] for t in ctx_out], axis=1)
    new_mlstm_m = jnp.stack([t[6] for t in ctx_out], axis=1)
    new_s5_re = jnp.stack([t[7] for t in ctx_out], axis=1)
    new_s5_im = jnp.stack([t[8] for t in ctx_out], axis=1)
    return (y_prompt, y_sample, new_mla_ckv, new_mla_krope, new_diff_k, new_diff_v,
            new_mlstm_c, new_mlstm_n, new_mlstm_m, new_s5_re, new_s5_im)
```

```cpp
#include <hip/hip_runtime.h>
#include <cstdio>
#include <cstdint>

typedef unsigned short bf16_t;
typedef short bf16x8 __attribute__((ext_vector_type(8)));
typedef float f32x16 __attribute__((ext_vector_type(16)));
typedef float f32x4 __attribute__((ext_vector_type(4)));
typedef unsigned u32x4 __attribute__((ext_vector_type(4)));
typedef unsigned u32x2 __attribute__((ext_vector_type(2)));

constexpr int D = 2048, NCTX = 4096, NLAT = 16384, MTOK = 20480, MALL = 21504;
constexpr int CB = 16, CL = 256, LB = 4, LL = 4096, PAST = 256;
constexpr int IN_COLS = 18512, MIX_COLS = 10320, GATE_COLS = 8192;
constexpr int C_MLQ = 0, C_MLK = 1024, C_MLV = 2048, C_MLO = 3072, C_MLIF = 4096, C_MQ = 4112, C_KVA = 5648, C_S5U = 6224, C_DFQ = 7248, C_DFK = 8272, C_DFV = 9296;
constexpr int FFN = 5632;
constexpr int KVAW = 592;

constexpr size_t MiB = 1u << 20;
constexpr size_t WS_MOD = 1 * MiB;
constexpr size_t WS_ROPE = WS_MOD + 512 * 1024;
constexpr size_t WS_X = 2 * MiB;
constexpr size_t WS_H = 162 * MiB;
constexpr size_t WS_HF = 242 * MiB;
constexpr size_t WS_HB = 282 * MiB;
constexpr size_t WS_MLQ = 322 * MiB;
constexpr size_t WS_S5U = 362 * MiB;
constexpr size_t WS_DFQ = 402 * MiB;
constexpr size_t WS_MLK = 442 * MiB;
constexpr size_t WS_MLV = 482 * MiB;
constexpr size_t WS_MLO = 522 * MiB;
constexpr size_t WS_MQ = 562 * MiB;
constexpr size_t WS_KVA = 622 * MiB;
constexpr size_t WS_DFK = 669 * MiB;
constexpr size_t WS_DFV = 711 * MiB;
constexpr size_t WS_CKVN = 753 * MiB;
constexpr size_t WS_KFULL = 774 * MiB;
constexpr size_t WS_VFULL = 837 * MiB;
constexpr size_t WS_GATES = 879 * MiB;
constexpr size_t WS_CT = 881 * MiB;
constexpr size_t WS_GS = 442 * MiB;
constexpr size_t WS_FFNH = 442 * MiB;
constexpr size_t WS_DFO = 442 * MiB;
constexpr size_t WS_YS5F = 442 * MiB;
constexpr size_t WS_END = 921 * MiB;

constexpr size_t O_YP = 0, O_YS = 8388608, O_CKV = 41943040, O_KR = 46137344, O_DK = 46661632, O_DV = 55050240,
                 O_MC = 63438848, O_MN = 80216064, O_MM = 80281600, O_SR = 80281856, O_SI = 80544000, O_END = 80806144;

__device__ __forceinline__ unsigned f2bf(float f) { unsigned u = __builtin_bit_cast(unsigned, f); return (u + 0x7fffu + ((u >> 16) & 1u)) >> 16; }
__device__ __forceinline__ float bf2f(unsigned b) { return __builtin_bit_cast(float, (b & 0xffffu) << 16); }
__device__ __forceinline__ unsigned pk2(float lo, float hi) { return f2bf(lo) | (f2bf(hi) << 16); }
__device__ __forceinline__ float wave_sum(float v) {
#pragma unroll
    for (int o = 1; o < 64; o <<= 1) v += __shfl_xor(v, o);
    return v;
}
__device__ __forceinline__ float wave_max(float v) {
#pragma unroll
    for (int o = 1; o < 64; o <<= 1) v = fmaxf(v, __shfl_xor(v, o));
    return v;
}
__device__ __forceinline__ float sigmoidf_(float x) { return 1.0f / (1.0f + __expf(-x)); }
__device__ __forceinline__ float siluf_(float x) { return x / (1.0f + __expf(-x)); }
__device__ __forceinline__ float gelu_tanh(float x) { const float u = 0.7978845608028654f * (x + 0.044715f * x * x * x); const float t = 1.0f - 2.0f / (1.0f + __expf(2.0f * u)); return 0.5f * x * (1.0f + t); }
__device__ __forceinline__ void sincos_small(float x, float& s, float& c) {
    const float k = rintf(x * 0.6366197723675814f);
    float r = fmaf(-k, 1.5707962513e+0f, x); r = fmaf(-k, 7.5497894159e-8f, r); r = fmaf(-k, 5.3903029534e-15f, r);
    const float r2 = r * r;
    const float sp = r + r * r2 * (-1.6666654611e-1f + r2 * (8.3321608736e-3f + r2 * (-1.9515295891e-4f)));
    const float cp = 1.0f - 0.5f * r2 + r2 * r2 * (4.166664568298827e-2f + r2 * (-1.388731625493765e-3f + r2 * 2.443315711809948e-5f));
    const int q = ((int)k) & 3;
    s = (q == 0) ? sp : (q == 1) ? cp : (q == 2) ? -sp : -cp;
    c = (q == 0) ? cp : (q == 1) ? -sp : (q == 2) ? -cp : sp;
}
__device__ __forceinline__ int cond_of_row(int r) { return r < NCTX ? 0 : 1 + ((r - NCTX) >> 12); }

struct P {
    const float* in[38];
    float* out;
    unsigned char* ws;
};
__device__ __forceinline__ const float* x_src(const P& p, int l, int r) {
    if (l == 0) return r < NCTX ? p.in[0] + (size_t)r * D : p.in[1] + (size_t)(r - NCTX) * D;
    return (const float*)(p.ws + WS_X) + (size_t)r * D;
}

__global__ __launch_bounds__(256) void k_mod(P p) {
    __shared__ float sc[5 * 2048];
    const int tid = threadIdx.x;
    for (int i = tid; i < 5 * 2048; i += 256) { const int c = i >> 11, k = i & 2047; const float v = c == 0 ? p.in[12][k] : p.in[11][(c - 1) * 2048 + k]; sc[i] = siluf_(v); }
    __syncthreads();
    const int idx = blockIdx.x * 256 + tid;
    if (idx < 2 * 12288) {
        const int l = idx / 12288, n = idx % 12288;
        const float* w = p.in[13] + (size_t)l * 2048 * 12288 + n;
        float a0 = 0, a1 = 0, a2 = 0, a3 = 0, a4 = 0;
        for (int k = 0; k < 2048; ++k) { const float wv = w[(size_t)k * 12288]; a0 += sc[k] * wv; a1 += sc[2048 + k] * wv; a2 += sc[4096 + k] * wv; a3 += sc[6144 + k] * wv; a4 += sc[8192 + k] * wv; }
        const float b = p.in[14][l * 12288 + n];
        float* mod = (float*)(p.ws + WS_MOD) + (size_t)l * 5 * 12288 + n;
        mod[0] = a0 + b; mod[12288] = a1 + b; mod[2 * 12288] = a2 + b; mod[3 * 12288] = a3 + b; mod[4 * 12288] = a4 + b;
    }
    if (blockIdx.x == 0) {
        float* rt = (float*)(p.ws + WS_ROPE);
        for (int i = tid; i < 1024; i += 256) { const int pos = i >> 4, j = i & 15; const float inv = exp2f(-(float)j * (13.287712379549449f / 16.0f)); float s, c; sincos_small((float)pos * inv, s, c); rt[i] = c; rt[1024 + i] = s; }
    }
}

__global__ __launch_bounds__(256) void k_hnorm(P p, int l, int which) {
    const int lane = threadIdx.x & 63, r = blockIdx.x * 4 + (threadIdx.x >> 6);
    const float* x = which == 0 ? x_src(p, l, r) : (const float*)(p.ws + WS_X) + (size_t)r * D;
    const float* nw = p.in[which == 0 ? 15 : 16] + l * 2048;
    const float* mod = (const float*)(p.ws + WS_MOD) + ((size_t)l * 5 + cond_of_row(r)) * 12288 + (which == 0 ? 0 : 3 * 2048);
    f32x4 v[8]; float ss = 0.f;
#pragma unroll
    for (int j = 0; j < 8; ++j) { v[j] = *(const f32x4*)(x + j * 256 + lane * 4); ss += v[j][0] * v[j][0] + v[j][1] * v[j][1] + v[j][2] * v[j][2] + v[j][3] * v[j][3]; }
    const float rstd = rsqrtf(wave_sum(ss) * (1.0f / 2048.0f) + 1e-6f);
    bf16_t* o = (bf16_t*)(p.ws + WS_H) + (size_t)r * D;
#pragma unroll
    for (int j = 0; j < 8; ++j) { const int c = j * 256 + lane * 4; const f32x4 g = *(const f32x4*)(nw + c), sh = *(const f32x4*)(mod + c), s1 = *(const f32x4*)(mod + 2048 + c);
        float y[4];
#pragma unroll
        for (int e = 0; e < 4; ++e) y[e] = v[j][e] * rstd * g[e] * (1.0f + s1[e]) + sh[e];
        u32x2 w; w.x = pk2(y[0], y[1]); w.y = pk2(y[2], y[3]); *(u32x2*)(o + c) = w; }
}

template <class Epi, bool FFNMAP>
__global__ __launch_bounds__(256) void k_gemm(const bf16_t* A, int lda, const float* W, int ldw, int ncols, int K, int ntn, Epi E) {
    __shared__ __attribute__((aligned(16))) bf16_t As[128 * 40];
    __shared__ __attribute__((aligned(16))) bf16_t Bs[128 * 40];
    const int tid = threadIdx.x, lane = tid & 63, wid = tid >> 6, wm = wid >> 1, wn = wid & 1, r32 = lane & 31, hi = lane >> 5;
    const int tm = blockIdx.x / ntn, tn = blockIdx.x % ntn;
    f32x16 acc[2][2];
#pragma unroll
    for (int a = 0; a < 2; ++a)
#pragma unroll
        for (int b = 0; b < 2; ++b)
#pragma unroll
            for (int r = 0; r < 16; ++r) acc[a][b][r] = 0.f;
    const int arow = tid >> 1, acol = (tid & 1) * 16;
    const bf16_t* ap = A + (size_t)(tm * 128 + arow) * lda + acol;
    const int bk = tid >> 5, bn = (tid & 31) * 4;
    int wcol;
    { const int nv = tn * 128 + bn; wcol = FFNMAP ? (((nv >> 5) & 1) * FFN + (nv >> 6) * 32 + (nv & 31)) : nv; }
    const bool bvalid = wcol < ncols;
    for (int k0 = 0; k0 < K; k0 += 32) {
        const u32x4 a0 = *(const u32x4*)(ap + k0), a1 = *(const u32x4*)(ap + k0 + 8);
        f32x4 bv[4];
#pragma unroll
        for (int i = 0; i < 4; ++i) bv[i] = bvalid ? *(const f32x4*)(W + (size_t)(k0 + bk + 8 * i) * ldw + wcol) : (f32x4){0.f, 0.f, 0.f, 0.f};
        __syncthreads();
        *(u32x4*)(As + arow * 40 + acol) = a0; *(u32x4*)(As + arow * 40 + acol + 8) = a1;
#pragma unroll
        for (int i = 0; i < 4; ++i)
#pragma unroll
            for (int e = 0; e < 4; ++e) Bs[(bn + e) * 40 + bk + 8 * i] = (bf16_t)f2bf(bv[i][e]);
        __syncthreads();
#pragma unroll
        for (int ks = 0; ks < 2; ++ks) {
            bf16x8 af[2], bfr[2];
#pragma unroll
            for (int mi = 0; mi < 2; ++mi) af[mi] = *(const bf16x8*)(As + (wm * 64 + mi * 32 + r32) * 40 + ks * 16 + hi * 8);
#pragma unroll
            for (int ni = 0; ni < 2; ++ni) bfr[ni] = *(const bf16x8*)(Bs + (wn * 64 + ni * 32 + r32) * 40 + ks * 16 + hi * 8);
#pragma unroll
            for (int mi = 0; mi < 2; ++mi)
#pragma unroll
                for (int ni = 0; ni < 2; ++ni) acc[mi][ni] = __builtin_amdgcn_mfma_f32_32x32x16_bf16(af[mi], bfr[ni], acc[mi][ni], 0, 0, 0);
        }
    }
    E(acc, tm * 128 + wm * 64, tn * 128 + wn * 64, r32, hi);
}
#define FOR_ACC(...) _Pragma("unroll") for (int mi = 0; mi < 2; ++mi) _Pragma("unroll") for (int ni = 0; ni < 2; ++ni) _Pragma("unroll") for (int r = 0; r < 16; ++r) { \
    const int m = m0 + mi * 32 + (r & 3) + 8 * (r >> 2) + 4 * hi, n = n0 + ni * 32 + r32; const float v = acc[mi][ni][r]; __VA_ARGS__ }

struct EpiIn {
    unsigned char* ws;
    __device__ __forceinline__ void operator()(const f32x16 (&acc)[2][2], int m0, int n0, int r32, int hi) const {
        FOR_ACC({
            if (n < C_MLK) ((bf16_t*)(ws + WS_MLQ))[(size_t)m * 1024 + n] = (bf16_t)f2bf(v);
            else if (n < C_MLV) ((bf16_t*)(ws + WS_MLK))[(size_t)m * 1024 + n - C_MLK] = (bf16_t)f2bf(v * 0.0625f);
            else if (n < C_MLO) ((bf16_t*)(ws + WS_MLV))[(size_t)m * 1024 + n - C_MLV] = (bf16_t)f2bf(v);
            else if (n < C_MLIF) ((bf16_t*)(ws + WS_MLO))[(size_t)m * 1024 + n - C_MLO] = (bf16_t)f2bf(sigmoidf_(v));
            else if (n < C_MQ) ((float*)(ws + WS_KVA))[(size_t)m * KVAW + 576 + n - C_MLIF] = v;
            else if (n < C_KVA) ((bf16_t*)(ws + WS_MQ))[(size_t)m * 1536 + n - C_MQ] = (bf16_t)f2bf(v);
            else if (n < C_S5U) ((float*)(ws + WS_KVA))[(size_t)m * KVAW + n - C_KVA] = v;
            else if (n < C_DFQ) ((bf16_t*)(ws + WS_S5U))[(size_t)m * 1024 + n - C_S5U] = (bf16_t)f2bf(v);
            else if (n < C_DFK) ((bf16_t*)(ws + WS_DFQ))[(size_t)m * 1024 + n - C_DFQ] = (bf16_t)f2bf(v);
            else if (n < C_DFV) ((bf16_t*)(ws + WS_DFK))[(size_t)m * 1024 + n - C_DFK] = (bf16_t)f2bf(v);
            else if (n < MIX_COLS) ((bf16_t*)(ws + WS_DFV))[(size_t)m * 1024 + n - C_DFV] = (bf16_t)f2bf(v);
        })
    }
};
struct EpiGate {
    bf16_t* gs;
    __device__ __forceinline__ void operator()(const f32x16 (&acc)[2][2], int m0, int n0, int r32, int hi) const {
        FOR_ACC({ gs[(size_t)m * GATE_COLS + n] = (bf16_t)f2bf(sigmoidf_(v)); })
    }
};
struct EpiKvb {
    bf16_t* kf; bf16_t* vf;
    __device__ __forceinline__ void operator()(const f32x16 (&acc)[2][2], int m0, int n0, int r32, int hi) const {
        FOR_ACC({ const int h = n >> 8, j = n & 255;
            if (j < 128) kf[(size_t)m * 1536 + h * 192 + j] = (bf16_t)f2bf(v); else vf[(size_t)m * 1024 + h * 128 + j - 128] = (bf16_t)f2bf(v); })
    }
};
struct EpiGlu {
    const bf16_t* g; bf16_t* y;
    __device__ __forceinline__ void operator()(const f32x16 (&acc)[2][2], int m0, int n0, int r32, int hi) const {
        FOR_ACC({ const size_t i = (size_t)m * 1024 + n; y[i] = (bf16_t)f2bf(bf2f(g[i]) * sigmoidf_(v)); })
    }
};
struct EpiMerge {
    const bf16_t* gs; bf16_t* mg; int b; int pad;
    __device__ __forceinline__ void operator()(const f32x16 (&acc)[2][2], int m0, int n0, int r32, int hi) const {
        FOR_ACC({ const size_t i = (size_t)m * D + n; const float prev = b ? bf2f(mg[i]) : 0.f; mg[i] = (bf16_t)f2bf(prev + bf2f(gs[(size_t)m * GATE_COLS + b * D + n]) * v); })
    }
};
struct EpiRes {
    P p; int l; int goff;
    int from_x; int pad;
    __device__ __forceinline__ void operator()(const f32x16 (&acc)[2][2], int m0, int n0, int r32, int hi) const {
        float* X = (float*)(p.ws + WS_X);
        FOR_ACC({ const float* src = from_x ? X + (size_t)m * D : x_src(p, l, m);
            const float g = ((const float*)(p.ws + WS_MOD))[((size_t)l * 5 + cond_of_row(m)) * 12288 + goff + n];
            X[(size_t)m * D + n] = src[n] + g * v; })
    }
};
struct EpiFfnIn {
    bf16_t* hh;
    __device__ __forceinline__ void operator()(const f32x16 (&acc)[2][2], int m0, int n0, int r32, int hi) const {
#pragma unroll
        for (int mi = 0; mi < 2; ++mi)
#pragma unroll
            for (int r = 0; r < 16; ++r) { const int m = m0 + mi * 32 + (r & 3) + 8 * (r >> 2) + 4 * hi, i = (n0 >> 6) * 32 + r32;
                hh[(size_t)m * FFN + i] = (bf16_t)f2bf(siluf_(acc[mi][0][r]) * acc[mi][1][r]); }
    }
};

__device__ __forceinline__ float rope_lane(float x, int lane, int prow, int pcol, const float* rt) {
    const int part = lane >> 5, jj = lane & 31, idx = jj & 15, pos = part ? pcol : prow;
    const float c = rt[pos * 16 + idx], s = rt[1024 + pos * 16 + idx];
    const float o = __shfl_xor(x, 16);
    return (jj >= 16) ? (x * c + o * s) : (x * c - o * s);
}
__global__ __launch_bounds__(256) void k_prep(P p, int l) {
    const int lane = threadIdx.x & 63, r = blockIdx.x * 4 + (threadIdx.x >> 6);
    unsigned char* ws = p.ws;
    bf16_t* ckvn = (bf16_t*)(ws + WS_CKVN) + (size_t)r * 512;
    bf16_t* kf = (bf16_t*)(ws + WS_KFULL) + (size_t)r * 1536;
    bf16_t* dfk = (bf16_t*)(ws + WS_DFK) + (size_t)r * 1024;
    bf16_t* dfv = (bf16_t*)(ws + WS_DFV) + (size_t)r * 1024;
    if (r >= MTOK) {
        const int i = r - MTOK, b = i >> 8, t = i & 255;
        const float* cc = p.in[2] + ((size_t)(b * 2 + l) * PAST + t) * 512;
        for (int j = lane; j < 512; j += 64) ckvn[j] = (bf16_t)f2bf(cc[j]);
        const float kr = p.in[3][((size_t)(b * 2 + l) * PAST + t) * 64 + lane];
#pragma unroll
        for (int h = 0; h < 8; ++h) kf[h * 192 + 128 + lane] = (bf16_t)f2bf(kr);
        const float* ck = p.in[4] + ((size_t)(b * 2 + l) * PAST + t) * 1024; const float* cv = p.in[5] + ((size_t)(b * 2 + l) * PAST + t) * 1024;
        for (int j = lane; j < 1024; j += 64) { dfk[j] = (bf16_t)f2bf(ck[j]); dfv[j] = (bf16_t)f2bf(cv[j]); }
        return;
    }
    const float* kva = (const float*)(ws + WS_KVA) + (size_t)r * KVAW;
    const bool ctx = r < NCTX;
    const int cb = r >> 8, ct = r & 255;
    const int t = (r - NCTX) & 4095, prow = t >> 6, pcol = t & 63;
    const float* rt = (const float*)(ws + WS_ROPE);
    { float v[8]; float ss = 0.f;
#pragma unroll
      for (int j = 0; j < 8; ++j) { v[j] = kva[j * 64 + lane]; ss += v[j] * v[j]; }
      const float rstd = rsqrtf(wave_sum(ss) * (1.0f / 512.0f) + 1e-6f);
      const float* g = p.in[20] + l * 512;
#pragma unroll
      for (int j = 0; j < 8; ++j) { const float y = v[j] * rstd * g[j * 64 + lane]; ckvn[j * 64 + lane] = (bf16_t)f2bf(y);
          if (ctx) p.out[O_CKV + ((size_t)(cb * 2 + l) * CL + ct) * 512 + j * 64 + lane] = y; } }
    { float kr = kva[512 + lane];
      if (ctx) p.out[O_KR + ((size_t)(cb * 2 + l) * CL + ct) * 64 + lane] = kr; else kr = rope_lane(kr, lane, prow, pcol, rt);
#pragma unroll
      for (int h = 0; h < 8; ++h) kf[h * 192 + 128 + lane] = (bf16_t)f2bf(kr); }
    if (lane < 16) { const float g = kva[576 + lane] + p.in[18][l * 16 + lane];
        const float o = ((lane >> 2) & 1) ? (fminf(g, 0.f) - log1pf(__expf(-fabsf(g)))) : g;
        ((float*)(ws + WS_GATES))[(size_t)r * 16 + lane] = o; }
    if (ctx) {
        float* ok = p.out + O_DK + ((size_t)(cb * 2 + l) * CL + ct) * 1024; float* ov = p.out + O_DV + ((size_t)(cb * 2 + l) * CL + ct) * 1024;
        for (int j = lane; j < 1024; j += 64) { ok[j] = bf2f(dfk[j]); ov[j] = bf2f(dfv[j]); }
    } else {
        bf16_t* mq = (bf16_t*)(ws + WS_MQ) + (size_t)r * 1536; bf16_t* dfq = (bf16_t*)(ws + WS_DFQ) + (size_t)r * 1024;
#pragma unroll
        for (int h = 0; h < 8; ++h) { const float x = bf2f(mq[h * 192 + 128 + lane]); mq[h * 192 + 128 + lane] = (bf16_t)f2bf(rope_lane(x, lane, prow, pcol, rt)); }
#pragma unroll
        for (int h = 0; h < 16; ++h) { const float x = bf2f(dfq[h * 64 + lane]); dfq[h * 64 + lane] = (bf16_t)f2bf(rope_lane(x, lane, prow, pcol, rt));
            const float y = bf2f(dfk[h * 64 + lane]); dfk[h * 64 + lane] = (bf16_t)f2bf(rope_lane(y, lane, prow, pcol, rt)); }
    }
}

__global__ __launch_bounds__(256) void k_mlstm_naive(P p, int l) {
    __shared__ float sq[256], sk[256], red[4];
    const int tid = threadIdx.x, lane = tid & 63, wid = tid >> 6;
    const int chain = blockIdx.x;
    const bool lat = chain >= 128; const int cc = lat ? chain - 128 : chain, b = cc >> 3, h = (cc >> 1) & 3, dir = cc & 1;
    const int L = lat ? LL : CL, base = lat ? NCTX + b * LL : b * CL;
    float* CT = (float*)(p.ws + WS_CT) + (size_t)chain * 65536;
    float n_k, m;
    if (lat) {
        const float* c0 = p.in[6] + ((size_t)((b * 2 + l) * 2 + dir) * 4 + h) * 65536;
        for (int k = 0; k < 256; ++k) CT[k * 256 + tid] = c0[(size_t)tid * 256 + k];
        n_k = p.in[7][((size_t)((b * 2 + l) * 2 + dir) * 4 + h) * 256 + tid]; m = p.in[8][((b * 2 + l) * 2 + dir) * 4 + h];
    } else { for (int k = 0; k < 256; ++k) CT[k * 256 + tid] = 0.f; n_k = 0.f; m = 0.f; }
    const bf16_t* Q = (const bf16_t*)(p.ws + WS_MLQ); const bf16_t* Kp = (const bf16_t*)(p.ws + WS_MLK); const bf16_t* V = (const bf16_t*)(p.ws + WS_MLV);
    const float* G = (const float*)(p.ws + WS_GATES);
    bf16_t* Hout = (bf16_t*)(p.ws + (dir ? WS_HB : WS_HF));
    for (int s = 0; s < L; ++s) {
        const int r = base + (dir ? L - 1 - s : s);
        __syncthreads();
        sq[tid] = bf2f(Q[(size_t)r * 1024 + h * 256 + tid]); sk[tid] = bf2f(Kp[(size_t)r * 1024 + h * 256 + tid]);
        const float vv = bf2f(V[(size_t)r * 1024 + h * 256 + tid]);
        const float li = G[(size_t)r * 16 + dir * 8 + h], lf = G[(size_t)r * 16 + dir * 8 + 4 + h];
        const float mn = fmaxf(lf + m, li), ip = __expf(li - mn), fp = __expf(lf + m - mn); m = mn;
        __syncthreads();
        const float iv = ip * vv; float num = 0.f;
        for (int k = 0; k < 256; ++k) { float c = CT[k * 256 + tid]; c = fp * c + iv * sk[k]; CT[k * 256 + tid] = c; num += c * sq[k]; }
        n_k = fp * n_k + ip * sk[tid];
        const float dp = wave_sum(n_k * sq[tid]);
        if (lane == 0) red[wid] = dp;
        __syncthreads();
        const float den = red[0] + red[1] + red[2] + red[3];
        Hout[(size_t)r * 1024 + h * 256 + tid] = (bf16_t)f2bf(num / fmaxf(fabsf(den), __expf(-m)));
    }
    if (!lat) {
        float* oc = p.out + O_MC + ((size_t)((b * 2 + l) * 2 + dir) * 4 + h) * 65536;
        for (int k = 0; k < 256; ++k) oc[(size_t)tid * 256 + k] = CT[k * 256 + tid];
        p.out[O_MN + ((size_t)((b * 2 + l) * 2 + dir) * 4 + h) * 256 + tid] = n_k;
        if (tid == 0) p.out[O_MM + ((b * 2 + l) * 2 + dir) * 4 + h] = m;
    }
}
__global__ __launch_bounds__(256) void k_ml_combine(P p, int l) {
    const int lane = threadIdx.x & 63, w = blockIdx.x * 4 + (threadIdx.x >> 6), r = w >> 2, h = w & 3;
    bf16_t* hf = (bf16_t*)(p.ws + WS_HF) + (size_t)r * 1024 + h * 256; const bf16_t* hb = (const bf16_t*)(p.ws + WS_HB) + (size_t)r * 1024 + h * 256;
    const bf16_t* so = (const bf16_t*)(p.ws + WS_MLO) + (size_t)r * 1024 + h * 256; const float* g = p.in[19] + l * 1024 + h * 256;
    float v[4]; float ss = 0.f;
#pragma unroll
    for (int j = 0; j < 4; ++j) { v[j] = bf2f(hf[j * 64 + lane]) + bf2f(hb[j * 64 + lane]); ss += v[j] * v[j]; }
    const float rstd = rsqrtf(wave_sum(ss) * (1.0f / 256.0f) + 1e-6f);
#pragma unroll
    for (int j = 0; j < 4; ++j) hf[j * 64 + lane] = (bf16_t)f2bf(v[j] * rstd * g[j * 64 + lane] * bf2f(so[j * 64 + lane]));
}

__device__ __forceinline__ void reduce16(float (&v)[16], int lane) {
    const bool b5 = lane & 32, b4 = lane & 16, b3 = lane & 8, b2 = lane & 4;
#pragma unroll
    for (int j = 0; j < 8; ++j) { const float keep = b5 ? v[8 + j] : v[j], send = b5 ? v[j] : v[8 + j]; v[j] = keep + __shfl_xor(send, 32); }
#pragma unroll
    for (int j = 0; j < 4; ++j) { const float keep = b4 ? v[4 + j] : v[j], send = b4 ? v[j] : v[4 + j]; v[j] = keep + __shfl_xor(send, 16); }
#pragma unroll
    for (int j = 0; j < 2; ++j) { const float keep = b3 ? v[2 + j] : v[j], send = b3 ? v[j] : v[2 + j]; v[j] = keep + __shfl_xor(send, 8); }
    { const float keep = b2 ? v[1] : v[0], send = b2 ? v[0] : v[1]; v[0] = keep + __shfl_xor(send, 4); }
    v[0] += __shfl_xor(v[0], 2); v[0] += __shfl_xor(v[0], 1);
}
__global__ __launch_bounds__(256) void k_s5_naive(P p, int l, int dir) {
    const int lane = threadIdx.x & 63, w = blockIdx.x * 4 + (threadIdx.x >> 6);
    const int seq = w >> 6, g = w & 63; const bool lat = seq >= 16; const int b = lat ? seq - 16 : seq;
    const int L = lat ? LL : CL, base = lat ? NCTX + b * LL : b * CL;
    const size_t pg = ((size_t)(l * 2 + dir) * 64 + g);
    const float lr = fminf(p.in[22][pg * 64 + lane], -1e-4f), li = p.in[23][pg * 64 + lane], dt = __expf(p.in[24][pg]);
    const float mag = __expf(dt * lr); float sn, cs; sincos_small(dt * li, sn, cs);
    const float ar = mag * cs, ai = mag * sn, den = lr * lr + li * li, nr = ar - 1.0f, ni = ai, qr = (nr * lr + ni * li) / den, qi = (ni * lr - nr * li) / den;
    float bbr[16], bbi[16], cr[16], ci[16];
#pragma unroll
    for (int i = 0; i < 16; ++i) { const float br = p.in[25][(pg * 64 + lane) * 16 + i], bi = p.in[26][(pg * 64 + lane) * 16 + i]; bbr[i] = qr * br - qi * bi; bbi[i] = qr * bi + qi * br;
        cr[i] = p.in[27][(pg * 16 + i) * 64 + lane]; ci[i] = p.in[28][(pg * 16 + i) * 64 + lane]; }
    float sr = 0.f, si = 0.f;
    if (lat) { sr = p.in[9][((size_t)((b * 2 + l) * 2 + dir) * 64 + g) * 64 + lane]; si = p.in[10][((size_t)((b * 2 + l) * 2 + dir) * 64 + g) * 64 + lane]; }
    const bf16_t* U = (const bf16_t*)(p.ws + WS_S5U); float* YF = (float*)(p.ws + WS_YS5F); bf16_t* YG = (bf16_t*)(p.ws + WS_HB);
    const float dval = p.in[29][l * 1024 + g * 16 + ((lane >> 2) & 15)];
    for (int s = 0; s < L; ++s) {
        const int r = base + (dir ? L - 1 - s : s);
        const u32x4 u0 = *(const u32x4*)(U + (size_t)r * 1024 + g * 16), u1 = *(const u32x4*)(U + (size_t)r * 1024 + g * 16 + 8);
        float u[16];
#pragma unroll
        for (int i = 0; i < 4; ++i) { u[2 * i] = bf2f(u0[i]); u[2 * i + 1] = bf2f(u0[i] >> 16); u[8 + 2 * i] = bf2f(u1[i]); u[9 + 2 * i] = bf2f(u1[i] >> 16); }
        float bur = 0.f, bui = 0.f;
#pragma unroll
        for (int i = 0; i < 16; ++i) { bur += bbr[i] * u[i]; bui += bbi[i] * u[i]; }
        const float nsr = ar * sr - ai * si + bur, nsi = ar * si + ai * sr + bui; sr = nsr; si = nsi;
        float y[16];
#pragma unroll
        for (int i = 0; i < 16; ++i) y[i] = cr[i] * sr - ci[i] * si;
        reduce16(y, lane);
        if ((lane & 3) == 0) { const int i = lane >> 2; const size_t o = (size_t)r * 1024 + g * 16 + i;
            if (dir == 0) YF[o] = y[0];
            else { float ui = 0.f;
#pragma unroll
                for (int e = 0; e < 16; ++e) ui = (e == i) ? u[e] : ui;
                YG[o] = (bf16_t)f2bf(gelu_tanh(YF[o] + y[0] + dval * ui)); } }
    }
    if (!lat) { p.out[O_SR + ((size_t)((b * 2 + l) * 2 + dir) * 64 + g) * 64 + lane] = sr; p.out[O_SI + ((size_t)((b * 2 + l) * 2 + dir) * 64 + g) * 64 + lane] = si; }
}

template <int DQK>
__global__ __launch_bounds__(256) void k_attn_naive(const bf16_t* Qp, int qpitch, const bf16_t* Kp, int kpitch, const bf16_t* Vp, int vpitch, int vdiv, bf16_t* Op, int opitch, int nheads, float scale) {
    const int lane = threadIdx.x & 63, w = blockIdx.x * 4 + (threadIdx.x >> 6), r = w / nheads, h = w % nheads;
    const bool lat = r >= NCTX; const int b = lat ? (r - NCTX) >> 12 : r >> 8;
    const int nk = lat ? LL + PAST : CL, kbase = lat ? NCTX + b * LL : b * CL, cbase = MTOK + b * PAST;
    const bf16_t* q = Qp + (size_t)r * qpitch + h * DQK;
    float qreg[DQK / 64];
#pragma unroll
    for (int j = 0; j < DQK / 64; ++j) qreg[j] = bf2f(q[j * 64 + lane]) * scale;
    float mrun = -1e30f, lrun = 0.f, o0 = 0.f, o1 = 0.f;
    const int vh = h / vdiv;
    for (int k0 = 0; k0 < nk; k0 += 64) {
        const int kk = k0 + lane, krow = kk < (lat ? LL : CL) ? kbase + kk : cbase + (kk - LL);
        const bf16_t* kp = Kp + (size_t)krow * kpitch + h * DQK;
        float s = 0.f;
#pragma unroll
        for (int j = 0; j < DQK / 64; ++j) {
#pragma unroll
            for (int c8 = 0; c8 < 8; ++c8) { const u32x4 kv = *(const u32x4*)(kp + j * 64 + c8 * 8);
#pragma unroll
                for (int e = 0; e < 4; ++e) { const float q0 = __shfl(qreg[j], c8 * 8 + 2 * e), q1 = __shfl(qreg[j], c8 * 8 + 2 * e + 1); s += q0 * bf2f(kv[e]) + q1 * bf2f(kv[e] >> 16); } }
        }
        const float mx = wave_max(s), mn = fmaxf(mrun, mx), alpha = __expf(mrun - mn), pj = __expf(s - mn);
        lrun = lrun * alpha + wave_sum(pj); o0 *= alpha; o1 *= alpha; mrun = mn;
        for (int j = 0; j < 64; ++j) { const float pb = __shfl(pj, j); const int kj = k0 + j, vrow = kj < (lat ? LL : CL) ? kbase + kj : cbase + (kj - LL);
            const bf16_t* vp = Vp + (size_t)vrow * vpitch + vh * 128; o0 += pb * bf2f(vp[lane]); o1 += pb * bf2f(vp[64 + lane]); }
    }
    const float inv = 1.0f / lrun;
    bf16_t* o = Op + (size_t)r * opitch + h * 128; o[lane] = (bf16_t)f2bf(o0 * inv); o[64 + lane] = (bf16_t)f2bf(o1 * inv);
}
__global__ __launch_bounds__(256) void k_df_combine(P p, int l, float lam_init) {
    const int lane = threadIdx.x & 63, w = blockIdx.x * 4 + (threadIdx.x >> 6), r = w >> 3, h = w & 7;
    const float* lp = p.in[31] + l * 256;
    const float lam = __expf(wave_sum(lp[lane] * lp[64 + lane])) - __expf(wave_sum(lp[128 + lane] * lp[192 + lane])) + lam_init;
    const bf16_t* o = (const bf16_t*)(p.ws + WS_DFO) + (size_t)r * 2048 + h * 256;
    const float v0 = bf2f(o[lane]) - lam * bf2f(o[128 + lane]), v1 = bf2f(o[64 + lane]) - lam * bf2f(o[192 + lane]);
    const float rstd = rsqrtf(wave_sum(v0 * v0 + v1 * v1) * (1.0f / 128.0f) + 1e-6f);
    const float* g = p.in[32] + l * 128;
    bf16_t* y = (bf16_t*)(p.ws + WS_DFQ) + (size_t)r * 1024 + h * 128;
    y[lane] = (bf16_t)f2bf(v0 * rstd * g[lane] * (1.0f - lam_init)); y[64 + lane] = (bf16_t)f2bf(v1 * rstd * g[64 + lane] * (1.0f - lam_init));
}
__global__ __launch_bounds__(256) void k_final(P p) {
    const int lane = threadIdx.x & 63, r = blockIdx.x * 4 + (threadIdx.x >> 6);
    const float* x = (const float*)(p.ws + WS_X) + (size_t)r * D; const float* g = p.in[37];
    f32x4 v[8]; float ss = 0.f;
#pragma unroll
    for (int j = 0; j < 8; ++j) { v[j] = *(const f32x4*)(x + j * 256 + lane * 4); ss += v[j][0] * v[j][0] + v[j][1] * v[j][1] + v[j][2] * v[j][2] + v[j][3] * v[j][3]; }
    const float rstd = rsqrtf(wave_sum(ss) * (1.0f / 2048.0f) + 1e-6f);
    float* o = p.out + (r < NCTX ? O_YP + (size_t)r * D : O_YS + (size_t)(r - NCTX) * D);
#pragma unroll
    for (int j = 0; j < 8; ++j) { const int c = j * 256 + lane * 4; const f32x4 gg = *(const f32x4*)(g + c); *(f32x4*)(o + c) = v[j] * rstd * gg; }
}
#ifdef DBG_SCALE
__global__ void k_dbg(float* out, unsigned mask_keep, float scale) {
    const size_t offs[12] = {O_YP, O_YS, O_CKV, O_KR, O_DK, O_DV, O_MC, O_MN, O_MM, O_SR, O_SI, O_END};
    for (size_t i = (size_t)blockIdx.x * 256 + threadIdx.x; i < O_END; i += (size_t)gridDim.x * 256) {
        int k = 0;
#pragma unroll
        for (int j = 1; j < 11; ++j) k += (i >= offs[j]) ? 1 : 0;
        out[i] = ((mask_keep >> k) & 1u) ? out[i] * scale : 0.f;
    }
}
#endif

template <class Epi, bool FM>
static void gemm(hipStream_t st, const bf16_t* A, int lda, int M, const float* W, int ldw, int ncols, int nvirt, int K, const Epi& E) {
    const int ntm = M / 128, ntn = (nvirt + 127) / 128;
    hipLaunchKernelGGL((k_gemm<Epi, FM>), dim3(ntm * ntn), dim3(256), 0, st, A, lda, W, ldw, ncols, K, ntn, E);
}

extern "C" void kernel_launch(void* const* d_in, const int* in_sizes, int n_in, void* d_out, int out_size, void* d_ws, size_t ws_size, hipStream_t stream) {
    if (n_in != 38 || out_size != (int)O_END || ws_size < WS_END) { fprintf(stderr, "kernel_launch: unexpected shapes (n_in %d out %d ws %zu)\n", n_in, out_size, ws_size); return; }
    P p{};
    for (int i = 0; i < 38; ++i) p.in[i] = (const float*)d_in[i];
    p.out = (float*)d_out; p.ws = (unsigned char*)d_ws;
    unsigned char* ws = p.ws;
    hipLaunchKernelGGL(k_mod, dim3(96), dim3(256), 0, stream, p);
    for (int l = 0; l < 2; ++l) {
        const float* w_in = p.in[17] + (size_t)l * D * IN_COLS;
        hipLaunchKernelGGL(k_hnorm, dim3(MTOK / 4), dim3(256), 0, stream, p, l, 0);
        gemm<EpiIn, false>(stream, (const bf16_t*)(ws + WS_H), D, MTOK, w_in, IN_COLS, MIX_COLS, MIX_COLS, D, EpiIn{ws});
        hipLaunchKernelGGL(k_prep, dim3(MALL / 4), dim3(256), 0, stream, p, l);
        gemm<EpiKvb, false>(stream, (const bf16_t*)(ws + WS_CKVN), 512, MALL, p.in[21] + (size_t)l * 512 * 2048, 2048, 2048, 2048, 512, EpiKvb{(bf16_t*)(ws + WS_KFULL), (bf16_t*)(ws + WS_VFULL)});
        hipLaunchKernelGGL(k_mlstm_naive, dim3(160), dim3(256), 0, stream, p, l);
        hipLaunchKernelGGL(k_ml_combine, dim3(MTOK), dim3(256), 0, stream, p, l);
        hipLaunchKernelGGL(k_s5_naive, dim3(20 * 64 / 4), dim3(256), 0, stream, p, l, 0);
        hipLaunchKernelGGL(k_s5_naive, dim3(20 * 64 / 4), dim3(256), 0, stream, p, l, 1);
        gemm<EpiGlu, false>(stream, (const bf16_t*)(ws + WS_HB), 1024, MTOK, p.in[30] + (size_t)l * 1024 * 1024, 1024, 1024, 1024, 1024, EpiGlu{(const bf16_t*)(ws + WS_HB), (bf16_t*)(ws + WS_S5U)});
        hipLaunchKernelGGL((k_attn_naive<192>), dim3(MTOK * 8 / 4), dim3(256), 0, stream, (const bf16_t*)(ws + WS_MQ), 1536, (const bf16_t*)(ws + WS_KFULL), 1536, (const bf16_t*)(ws + WS_VFULL), 1024, 1,
                           (bf16_t*)(ws + WS_MLQ), 1024, 8, 0.07216878364870322f);
        hipLaunchKernelGGL((k_attn_naive<64>), dim3(MTOK * 16 / 4), dim3(256), 0, stream, (const bf16_t*)(ws + WS_DFQ), 1024, (const bf16_t*)(ws + WS_DFK), 1024, (const bf16_t*)(ws + WS_DFV), 1024, 2,
                           (bf16_t*)(ws + WS_DFO), 2048, 16, 0.125f);
        const float lam_init = (l == 0) ? 0.2f : (float)(0.8 - 0.6 * 0.7408182206817179);
        hipLaunchKernelGGL(k_df_combine, dim3(MTOK * 8 / 4), dim3(256), 0, stream, p, l, lam_init);
        gemm<EpiGate, false>(stream, (const bf16_t*)(ws + WS_H), D, MTOK, w_in + MIX_COLS, IN_COLS, GATE_COLS, GATE_COLS, D, EpiGate{(bf16_t*)(ws + WS_GS)});
        const size_t ybuf[4] = {WS_HF, WS_MLQ, WS_S5U, WS_DFQ};
        for (int b = 0; b < 4; ++b)
            gemm<EpiMerge, false>(stream, (const bf16_t*)(ws + ybuf[b]), 1024, MTOK, p.in[33] + ((size_t)l * 4 + b) * 1024 * 2048, 2048, 2048, 2048, 1024, EpiMerge{(const bf16_t*)(ws + WS_GS), (bf16_t*)(ws + WS_H), b, 0});
        gemm<EpiRes, false>(stream, (const bf16_t*)(ws + WS_H), D, MTOK, p.in[34] + (size_t)l * D * D, D, D, D, D, EpiRes{p, l, 4096, 0, 0});
        hipLaunchKernelGGL(k_hnorm, dim3(MTOK / 4), dim3(256), 0, stream, p, l, 1);
        gemm<EpiFfnIn, true>(stream, (const bf16_t*)(ws + WS_H), D, MTOK, p.in[35] + (size_t)l * D * 2 * FFN, 2 * FFN, 2 * FFN, 2 * FFN, D, EpiFfnIn{(bf16_t*)(ws + WS_FFNH)});
        gemm<EpiRes, false>(stream, (const bf16_t*)(ws + WS_FFNH), FFN, MTOK, p.in[36] + (size_t)l * FFN * D, D, D, D, FFN, EpiRes{p, l, 10240, 1, 0});
    }
    hipLaunchKernelGGL(k_final, dim3(MTOK / 4), dim3(256), 0, stream, p);
#ifdef DBG_SCALE
    hipLaunchKernelGGL(k_dbg, dim3(4096), dim3(256), 0, stream, (float*)d_out, (unsigned)DBG_MASK, (float)DBG_SCALE);
#endif
}
```

```cpp
#include <hip/hip_runtime.h>
#include <cstdio>
#include <cstdint>

typedef unsigned short bf16_t;
typedef short bf16x8 __attribute__((ext_vector_type(8)));
typedef float f32x16 __attribute__((ext_vector_type(16)));
typedef float f32x4 __attribute__((ext_vector_type(4)));
typedef unsigned u32x4 __attribute__((ext_vector_type(4)));
typedef unsigned u32x2 __attribute__((ext_vector_type(2)));

constexpr int D = 2048, NCTX = 4096, NLAT = 16384, MTOK = 20480, MALL = 21504;
constexpr int CB = 16, CL = 256, LB = 4, LL = 4096, PAST = 256;
constexpr int IN_COLS = 18512, MIX_COLS = 10320, GATE_COLS = 8192;
constexpr int C_MLQ = 0, C_MLK = 1024, C_MLV = 2048, C_MLO = 3072, C_MLIF = 4096, C_MQ = 4112, C_KVA = 5648, C_S5U = 6224, C_DFQ = 7248, C_DFK = 8272, C_DFV = 9296;
constexpr int FFN = 5632;
constexpr int KVAW = 768;

constexpr size_t MiB = 1u << 20;
constexpr size_t WS_CTL = 0, CTL_BYTES = 64 * 1024;
constexpr size_t WS_MOD = 1 * MiB;
constexpr size_t WS_ROPE = WS_MOD + 512 * 1024;
constexpr size_t WS_X = 2 * MiB;
constexpr size_t WS_H = 162 * MiB;
constexpr size_t WS_HF = 242 * MiB;
constexpr size_t WS_HB = 282 * MiB;
constexpr size_t WS_MLQ = 322 * MiB;
constexpr size_t WS_S5U = 362 * MiB;
constexpr size_t WS_DFQ = 402 * MiB;
constexpr size_t WS_MLK = 442 * MiB;
constexpr size_t WS_MLV = 482 * MiB;
constexpr size_t WS_MLO = 522 * MiB;
constexpr size_t WS_MQ = 562 * MiB;
constexpr size_t WS_KVA = 622 * MiB;
constexpr size_t WS_DFK = 682 * MiB;
constexpr size_t WS_DFV = 724 * MiB;
constexpr size_t WS_CKVN = 766 * MiB;
constexpr size_t WS_KFULL = 787 * MiB;
constexpr size_t WS_VFULL = 850 * MiB;
constexpr size_t WS_GATES = 892 * MiB;
constexpr size_t WS_CT = 894 * MiB;
constexpr size_t WS_WBF = 934 * MiB;
constexpr size_t WS_GS = 442 * MiB;
constexpr size_t WS_FFNH = 442 * MiB;
constexpr size_t WS_DFO = 442 * MiB;
constexpr size_t WS_YS5F = 442 * MiB;
constexpr size_t WS_END = 1101 * MiB;

constexpr size_t O_YP = 0, O_YS = 8388608, O_CKV = 41943040, O_KR = 46137344, O_DK = 46661632, O_DV = 55050240,
                 O_MC = 63438848, O_MN = 80216064, O_MM = 80281600, O_SR = 80281856, O_SI = 80544000, O_END = 80806144;

__device__ __forceinline__ unsigned f2bf(float f) { unsigned u = __builtin_bit_cast(unsigned, f); return (u + 0x7fffu + ((u >> 16) & 1u)) >> 16; }
__device__ __forceinline__ float bf2f(unsigned b) { return __builtin_bit_cast(float, (b & 0xffffu) << 16); }
__device__ __forceinline__ unsigned pk2(float lo, float hi) { return f2bf(lo) | (f2bf(hi) << 16); }
__device__ __forceinline__ float wave_sum(float v) {
#pragma unroll
    for (int o = 1; o < 64; o <<= 1) v += __shfl_xor(v, o);
    return v;
}
__device__ __forceinline__ float wave_max(float v) {
#pragma unroll
    for (int o = 1; o < 64; o <<= 1) v = fmaxf(v, __shfl_xor(v, o));
    return v;
}
__device__ __forceinline__ float sigmoidf_(float x) { return 1.0f / (1.0f + __expf(-x)); }
__device__ __forceinline__ float siluf_(float x) { return x / (1.0f + __expf(-x)); }
__device__ __forceinline__ float gelu_tanh(float x) { const float u = 0.7978845608028654f * (x + 0.044715f * x * x * x); const float t = 1.0f - 2.0f / (1.0f + __expf(2.0f * u)); return 0.5f * x * (1.0f + t); }
__device__ __forceinline__ void sincos_small(float x, float& s, float& c) {
    const float k = rintf(x * 0.6366197723675814f);
    float r = fmaf(-k, 1.5707962513e+0f, x); r = fmaf(-k, 7.5497894159e-8f, r); r = fmaf(-k, 5.3903029534e-15f, r);
    const float r2 = r * r;
    const float sp = r + r * r2 * (-1.6666654611e-1f + r2 * (8.3321608736e-3f + r2 * (-1.9515295891e-4f)));
    const float cp = 1.0f - 0.5f * r2 + r2 * r2 * (4.166664568298827e-2f + r2 * (-1.388731625493765e-3f + r2 * 2.443315711809948e-5f));
    const int q = ((int)k) & 3;
    s = (q == 0) ? sp : (q == 1) ? cp : (q == 2) ? -sp : -cp;
    c = (q == 0) ? cp : (q == 1) ? -sp : (q == 2) ? -cp : sp;
}
__device__ __forceinline__ int cond_of_row(int r) { return r < NCTX ? 0 : 1 + ((r - NCTX) >> 12); }

struct P {
    const float* in[38];
    float* out;
    unsigned char* ws;
};
__device__ __forceinline__ const float* x_src(const P& p, int l, int r) {
    if (l == 0) return r < NCTX ? p.in[0] + (size_t)r * D : p.in[1] + (size_t)(r - NCTX) * D;
    return (const float*)(p.ws + WS_X) + (size_t)r * D;
}


#define XB_TMO      128
#define XB_XCNT(j)  (256  + 64 * (j))
#define XB_XSUB(j)  (1280 + 64 * (j))
#define XB_XGEN(j)  (2304 + 64 * (j))
#define XB_TOP      3328
#define XB_TOPGEN   3392
#define XCD_BAR_WORDS 3456
#define XB_SPIN_CAP (1u << 22)
#define LAS __attribute__((address_space(3)))

__device__ __forceinline__ unsigned xb_ld(unsigned* p)              { return __hip_atomic_load(p, __ATOMIC_RELAXED, __HIP_MEMORY_SCOPE_AGENT); }
__device__ __forceinline__ unsigned xb_add(unsigned* p, unsigned v) { return __hip_atomic_fetch_add(p, v, __ATOMIC_RELAXED, __HIP_MEMORY_SCOPE_AGENT); }
__device__ __forceinline__ unsigned xb_xcc_id() { return (unsigned)__builtin_amdgcn_s_getreg((3 << 11) | 20) & 0xFu; }
#define XB_SPIN(cond, bar) do { unsigned _sp = 0; while (cond) { __builtin_amdgcn_s_sleep(1); \
    if ((++_sp & 255u) == 0u) { if (xb_ld(&(bar)[XB_TMO])) break; if (_sp > XB_SPIN_CAP) { atomicAdd(&(bar)[XB_TMO], 1u); break; } } } } while (0)

struct XcdBarrier {
    unsigned* bar; unsigned x;
    volatile LAS unsigned* st;
};
__device__ __forceinline__ XcdBarrier xcd_barrier_post(unsigned* bar, volatile LAS unsigned* st) {
    XcdBarrier b; b.bar = bar; b.x = xb_xcc_id(); b.st = st;
    if (threadIdx.x == 0) (void)xb_add(&bar[XB_XCNT(b.x)], 1u);
    return b;
}
__device__ __forceinline__ void xcd_barrier_complete(unsigned* bar, unsigned x, unsigned& nloc, unsigned& nx) {
    const unsigned G = gridDim.x * gridDim.y * gridDim.z;
    unsigned sum, cnt, mine, sp = 0u;
    for (;;) {
        sum = 0u; cnt = 0u; mine = 0u;
#pragma unroll
        for (unsigned j = 0; j < 16; ++j) { const unsigned c = xb_ld(&bar[XB_XCNT(j)]); sum += c; cnt += (c > 0u) ? 1u : 0u; mine = (j == x) ? c : mine; }
        if (sum == G) break;
        __builtin_amdgcn_s_sleep(1);
        if ((++sp & 255u) == 0u) { if (xb_ld(&bar[XB_TMO])) break; if (sp > XB_SPIN_CAP) { atomicAdd(&bar[XB_TMO], 1u); break; } }
    }
    nloc = mine > 0u ? mine : 1u; nx = cnt > 0u ? cnt : 1u;
}
__device__ __forceinline__ void xcd_barrier(const XcdBarrier& b) {
    asm volatile("s_waitcnt vmcnt(0)" ::: "memory");
    __syncthreads();
    if (threadIdx.x == 0) {
        unsigned* bar = b.bar;
        __builtin_amdgcn_s_waitcnt(0);
        unsigned nloc = b.st[0], nx = b.st[1];
        if (nloc == 0u) { xcd_barrier_complete(bar, b.x, nloc, nx); b.st[0] = nloc; b.st[1] = nx; }
        const unsigned old = xb_add(&bar[XB_XSUB(b.x)], 1u);
        const unsigned gen = old / nloc;
        if (old + 1u == (gen + 1u) * nloc) {
            __builtin_amdgcn_fence(__ATOMIC_RELEASE, "agent");
            asm volatile("s_waitcnt vmcnt(0)" ::: "memory");
            const unsigned og = xb_add(&bar[XB_TOP], 1u);
            const unsigned tg = og / nx;
            if (og + 1u == (tg + 1u) * nx) xb_add(&bar[XB_TOPGEN], 1u);
            else XB_SPIN(xb_ld(&bar[XB_TOPGEN]) == tg, bar);
            __builtin_amdgcn_fence(__ATOMIC_ACQUIRE, "agent");
            xb_add(&bar[XB_XGEN(b.x)], 1u);
            asm volatile("s_waitcnt vmcnt(0)" ::: "memory");
        } else {
            XB_SPIN(xb_ld(&bar[XB_XGEN(b.x)]) == gen, bar);
            __builtin_amdgcn_fence(__ATOMIC_ACQUIRE, "agent");
            asm volatile("s_waitcnt vmcnt(0)" ::: "memory");
        }
    }
    __syncthreads();
}


__device__ __forceinline__ void ph_mod(const P& p, int vblk, bool active, int tid, float* sc) {
    for (int i = tid; i < 5 * 2048; i += 256) { const int c = i >> 11, k = i & 2047; const float v = c == 0 ? p.in[12][k] : p.in[11][(c - 1) * 2048 + k]; sc[i] = siluf_(v); }
    __syncthreads();
    const int idx = vblk * 256 + tid;
    if (active && idx < 2 * 12288) {
        const int l = idx / 12288, n = idx % 12288;
        const float* w = p.in[13] + (size_t)l * 2048 * 12288 + n;
        float a0 = 0, a1 = 0, a2 = 0, a3 = 0, a4 = 0;
        for (int k = 0; k < 2048; ++k) { const float wv = w[(size_t)k * 12288]; a0 += sc[k] * wv; a1 += sc[2048 + k] * wv; a2 += sc[4096 + k] * wv; a3 += sc[6144 + k] * wv; a4 += sc[8192 + k] * wv; }
        const float b = p.in[14][l * 12288 + n];
        float* mod = (float*)(p.ws + WS_MOD) + (size_t)l * 5 * 12288 + n;
        mod[0] = a0 + b; mod[12288] = a1 + b; mod[2 * 12288] = a2 + b; mod[3 * 12288] = a3 + b; mod[4 * 12288] = a4 + b;
    }
    if (active && vblk == 0) {
        float* rt = (float*)(p.ws + WS_ROPE);
        for (int i = tid; i < 1024; i += 256) { const int pos = i >> 4, j = i & 15; const float inv = exp2f(-(float)j * (13.287712379549449f / 16.0f)); float s, c; sincos_small((float)pos * inv, s, c); rt[i] = c; rt[1024 + i] = s; }
    }
}

__device__ __forceinline__ void ph_hnorm_row(const P& p, int l, int which, int r, int lane) {
    const float* x = which == 0 ? x_src(p, l, r) : (const float*)(p.ws + WS_X) + (size_t)r * D;
    const float* nw = p.in[which == 0 ? 15 : 16] + l * 2048;
    const float* mod = (const float*)(p.ws + WS_MOD) + ((size_t)l * 5 + cond_of_row(r)) * 12288 + (which == 0 ? 0 : 3 * 2048);
    f32x4 v[8]; float ss = 0.f;
#pragma unroll
    for (int j = 0; j < 8; ++j) { v[j] = *(const f32x4*)(x + j * 256 + lane * 4); ss += v[j][0] * v[j][0] + v[j][1] * v[j][1] + v[j][2] * v[j][2] + v[j][3] * v[j][3]; }
    const float rstd = rsqrtf(wave_sum(ss) * (1.0f / 2048.0f) + 1e-6f);
    bf16_t* o = (bf16_t*)(p.ws + WS_H) + (size_t)r * D;
#pragma unroll
    for (int j = 0; j < 8; ++j) { const int c = j * 256 + lane * 4; const f32x4 g = *(const f32x4*)(nw + c), sh = *(const f32x4*)(mod + c), s1 = *(const f32x4*)(mod + 2048 + c);
        float y[4];
#pragma unroll
        for (int e = 0; e < 4; ++e) y[e] = v[j][e] * rstd * g[e] * (1.0f + s1[e]) + sh[e];
        u32x2 w; w.x = pk2(y[0], y[1]); w.y = pk2(y[2], y[3]); *(u32x2*)(o + c) = w; }
}

template <class Epi, bool FFNMAP>
__device__ __forceinline__ void gemm_tile(const bf16_t* A, int lda, const float* W, int ldw, int ncols, int K, int tm, int tn, bool active, const Epi& E, int tid, bf16_t* As, bf16_t* Bs) {
    const int lane = tid & 63, wid = tid >> 6, wm = wid >> 1, wn = wid & 1, r32 = lane & 31, hi = lane >> 5;
    f32x16 acc[2][2];
#pragma unroll
    for (int a = 0; a < 2; ++a)
#pragma unroll
        for (int b = 0; b < 2; ++b)
#pragma unroll
            for (int r = 0; r < 16; ++r) acc[a][b][r] = 0.f;
    const int arow = tid >> 1, acol = (tid & 1) * 16;
    const bf16_t* ap = A + (size_t)(tm * 128 + arow) * lda + acol;
    const int bk = tid >> 5, bn = (tid & 31) * 4;
    int wcol;
    { const int nv = tn * 128 + bn; wcol = FFNMAP ? (((nv >> 5) & 1) * FFN + (nv >> 6) * 32 + (nv & 31)) : nv; }
    const bool bvalid = wcol < ncols;
    for (int k0 = 0; k0 < K; k0 += 32) {
        const u32x4 a0 = *(const u32x4*)(ap + k0), a1 = *(const u32x4*)(ap + k0 + 8);
        f32x4 bv[4];
#pragma unroll
        for (int i = 0; i < 4; ++i) bv[i] = bvalid ? *(const f32x4*)(W + (size_t)(k0 + bk + 8 * i) * ldw + wcol) : (f32x4){0.f, 0.f, 0.f, 0.f};
        __syncthreads();
        *(u32x4*)(As + arow * 40 + acol) = a0; *(u32x4*)(As + arow * 40 + acol + 8) = a1;
#pragma unroll
        for (int i = 0; i < 4; ++i)
#pragma unroll
            for (int e = 0; e < 4; ++e) Bs[(bn + e) * 40 + bk + 8 * i] = (bf16_t)f2bf(bv[i][e]);
        __syncthreads();
#pragma unroll
        for (int ks = 0; ks < 2; ++ks) {
            bf16x8 af[2], bfr[2];
#pragma unroll
            for (int mi = 0; mi < 2; ++mi) af[mi] = *(const bf16x8*)(As + (wm * 64 + mi * 32 + r32) * 40 + ks * 16 + hi * 8);
#pragma unroll
            for (int ni = 0; ni < 2; ++ni) bfr[ni] = *(const bf16x8*)(Bs + (wn * 64 + ni * 32 + r32) * 40 + ks * 16 + hi * 8);
#pragma unroll
            for (int mi = 0; mi < 2; ++mi)
#pragma unroll
                for (int ni = 0; ni < 2; ++ni) acc[mi][ni] = __builtin_amdgcn_mfma_f32_32x32x16_bf16(af[mi], bfr[ni], acc[mi][ni], 0, 0, 0);
        }
    }
    if (active) E(acc, tm * 128 + wm * 64, tn * 128 + wn * 64, r32, hi);
}
template <class Epi, bool FFNMAP>
__device__ __forceinline__ void gemm_phase_simple(int tid_, unsigned char* lds, const bf16_t* A, int lda, int M, const float* W, int ldw, int ncols, int nvirt, int K, const Epi& E) {
    const int half = tid_ >> 8, vt = tid_ & 255, ntm = M / 128, ntn = (nvirt + 127) / 128, nt = ntm * ntn, nvb = 2 * gridDim.x;
    bf16_t* As = (bf16_t*)(lds + half * 32768); bf16_t* Bs = As + 128 * 40;
    for (int base = 0; base < nt; base += nvb) {
        const int tile = base + blockIdx.x * 2 + half; const bool active = tile < nt; const int t = active ? tile : nt - 1;
        gemm_tile<Epi, FFNMAP>(A, lda, W, ldw, ncols, K, t / ntn, t % ntn, active, E, vt, As, Bs);
        __syncthreads();
    }
}
#define FOR_ACC(...) _Pragma("unroll") for (int mi = 0; mi < 2; ++mi) _Pragma("unroll") for (int ni = 0; ni < 2; ++ni) _Pragma("unroll") for (int r = 0; r < 16; ++r) { \
    const int m = m0 + mi * 32 + (r & 3) + 8 * (r >> 2) + 4 * hi, n = n0 + ni * 32 + r32; const float v = acc[mi][ni][r]; __VA_ARGS__ }
struct EpiIn {
    unsigned char* ws;
    __device__ __forceinline__ void operator()(const f32x16 (&acc)[2][2], int m0, int n0, int r32, int hi) const {
        FOR_ACC({
            if (n < C_MLK) ((bf16_t*)(ws + WS_MLQ))[(size_t)m * 1024 + n] = (bf16_t)f2bf(v);
            else if (n < C_MLV) ((bf16_t*)(ws + WS_MLK))[(size_t)m * 1024 + n - C_MLK] = (bf16_t)f2bf(v * 0.0625f);
            else if (n < C_MLO) ((bf16_t*)(ws + WS_MLV))[(size_t)m * 1024 + n - C_MLV] = (bf16_t)f2bf(v);
            else if (n < C_MLIF) ((bf16_t*)(ws + WS_MLO))[(size_t)m * 1024 + n - C_MLO] = (bf16_t)f2bf(sigmoidf_(v));
            else if (n < C_MQ) ((float*)(ws + WS_KVA))[(size_t)m * KVAW + 576 + n - C_MLIF] = v;
            else if (n < C_KVA) ((bf16_t*)(ws + WS_MQ))[(size_t)m * 1536 + n - C_MQ] = (bf16_t)f2bf(v);
            else if (n < C_S5U) ((float*)(ws + WS_KVA))[(size_t)m * KVAW + n - C_KVA] = v;
            else if (n < C_DFQ) ((bf16_t*)(ws + WS_S5U))[(size_t)m * 1024 + n - C_S5U] = (bf16_t)f2bf(v);
            else if (n < C_DFK) ((bf16_t*)(ws + WS_DFQ))[(size_t)m * 1024 + n - C_DFQ] = (bf16_t)f2bf(v);
            else if (n < C_DFV) ((bf16_t*)(ws + WS_DFK))[(size_t)m * 1024 + n - C_DFK] = (bf16_t)f2bf(v);
            else if (n < MIX_COLS) ((bf16_t*)(ws + WS_DFV))[(size_t)m * 1024 + n - C_DFV] = (bf16_t)f2bf(v);
        })
    }
};
struct EpiGate {
    bf16_t* gs;
    __device__ __forceinline__ void operator()(const f32x16 (&acc)[2][2], int m0, int n0, int r32, int hi) const {
        FOR_ACC({ gs[(size_t)m * GATE_COLS + n] = (bf16_t)f2bf(sigmoidf_(v)); })
    }
};
struct EpiKvb {
    bf16_t* kf; bf16_t* vf;
    __device__ __forceinline__ void operator()(const f32x16 (&acc)[2][2], int m0, int n0, int r32, int hi) const {
        FOR_ACC({ const int h = n >> 8, j = n & 255;
            if (j < 128) kf[(size_t)m * 1536 + h * 192 + j] = (bf16_t)f2bf(v); else vf[(size_t)m * 1024 + h * 128 + j - 128] = (bf16_t)f2bf(v); })
    }
};
struct EpiGlu {
    const bf16_t* g; bf16_t* y;
    __device__ __forceinline__ void operator()(const f32x16 (&acc)[2][2], int m0, int n0, int r32, int hi) const {
        FOR_ACC({ const size_t i = (size_t)m * 1024 + n; y[i] = (bf16_t)f2bf(bf2f(g[i]) * sigmoidf_(v)); })
    }
};
struct EpiMerge {
    const bf16_t* gs; bf16_t* mg; int b; int pad;
    __device__ __forceinline__ void operator()(const f32x16 (&acc)[2][2], int m0, int n0, int r32, int hi) const {
        FOR_ACC({ const size_t i = (size_t)m * D + n; const float prev = b ? bf2f(mg[i]) : 0.f; mg[i] = (bf16_t)f2bf(prev + bf2f(gs[(size_t)m * GATE_COLS + b * D + n]) * v); })
    }
};
struct EpiRes {
    P p; int l; int goff;
    int from_x; int pad;
    __device__ __forceinline__ void operator()(const f32x16 (&acc)[2][2], int m0, int n0, int r32, int hi) const {
        float* X = (float*)(p.ws + WS_X);
        FOR_ACC({ const float* src = from_x ? X + (size_t)m * D : x_src(p, l, m);
            const float g = ((const float*)(p.ws + WS_MOD))[((size_t)l * 5 + cond_of_row(m)) * 12288 + goff + n];
            X[(size_t)m * D + n] = src[n] + g * v; })
    }
};
struct EpiFfnIn {
    bf16_t* hh;
    __device__ __forceinline__ void operator()(const f32x16 (&acc)[2][2], int m0, int n0, int r32, int hi) const {
#pragma unroll
        for (int mi = 0; mi < 2; ++mi)
#pragma unroll
            for (int r = 0; r < 16; ++r) { const int m = m0 + mi * 32 + (r & 3) + 8 * (r >> 2) + 4 * hi, i = (n0 >> 6) * 32 + r32;
                hh[(size_t)m * FFN + i] = (bf16_t)f2bf(siluf_(acc[mi][0][r]) * acc[mi][1][r]); }
    }
};

namespace pg8 {
#define PG8_LAS __attribute__((address_space(3)))
typedef unsigned short bf16_t;
typedef short bf16x8 __attribute__((ext_vector_type(8)));
typedef float f32x4 __attribute__((ext_vector_type(4)));
typedef unsigned u32x4 __attribute__((ext_vector_type(4)));
constexpr int BM = 256, BK = 64, HALF = 128, HTB = HALF * BK * 2  , STAGE_BYTES = 8 * HTB, NXCD = 8, WGM = 8;

__host__ __device__ __forceinline__ int lds_byte(int r, int c) { const int st = (r >> 4) * 2 + (c >> 5), rr = r & 15, cc = c & 31, ob = rr * 64 + cc * 2; return st * 1024 + (ob ^ (((ob >> 9) & 1) << 5)); }
__host__ __device__ __forceinline__ void stage_rc(int b, int& R, int& C) { const int st = b / 1024, sb = b % 1024, swz = sb ^ (((sb >> 9) & 1) << 5); R = (st >> 1) * 16 + swz / 64; C = (st & 1) * 32 + (swz % 64) / 2; }
__host__ __device__ __forceinline__ int perm32(int rho) { const int n = rho >> 4, i = rho & 15; return 8 * (i >> 2) + 4 * n + (i & 3); }

struct Unit { int pm, pn; };
struct Gemm { const bf16_t* A; const bf16_t* Bt; int M, N, K; };

struct StaticOrder {
    int nM, nN, nwg, G, c;
    __host__ __device__ void init(int M, int N, int G_, int c_) { nM = M / BM; nN = N / BM; nwg = nM * nN; G = G_; c = c_; }
    __host__ __device__ bool next(int i, Unit& u) const {
        const long L = (long)i * G + c; if (L >= nwg) return false;
        int wgid = (int)L; { const int q = nwg / NXCD, r = nwg % NXCD, xcd = wgid % NXCD, off = wgid / NXCD; wgid = (xcd < r ? xcd * (q + 1) : r * (q + 1) + (xcd - r) * q) + off; }
        const int nig = WGM * nN, gid = wgid / nig, fm = gid * WGM, gsz = (nM - fm) < WGM ? (nM - fm) : WGM;
        u.pm = fm + ((wgid % nig) % gsz); u.pn = (wgid % nig) / gsz; return true;
    }
    __device__ __forceinline__ void a_ready(const Unit&) const {}
    __device__ __forceinline__ void done(const Unit&) const {}
};

__device__ __forceinline__ unsigned cvt_pk_bf16(float lo, float hi) { unsigned r; asm volatile("v_cvt_pk_bf16_f32 %0, %1, %2" : "=v"(r) : "v"(lo), "v"(hi)); return r; }

template <class Epi, class Sched, bool ALIGN_EPI = false, bool SP2 = false>
__device__ __forceinline__ void gemm_phase(PG8_LAS unsigned char* lds, const Gemm g, const Sched& S, const Epi& E) {
    int tid_l = threadIdx.x; asm volatile("" : "+v"(tid_l));
    const int tid = tid_l, wid = __builtin_amdgcn_readfirstlane(tid >> 6), lane = tid & 63, wr = wid >> 2, wc = wid & 3, fr = lane & 15, fq = lane >> 4;
    const int K = g.K, nt = K / BK;
    unsigned voffA[2], voffB[2];
#pragma unroll
    for (int i = 0; i < 2; ++i) { int R, C; stage_rc(tid * 16 + i * 8192, R, C); const int Rb = Epi::PERM ? ((R & ~31) + perm32(R & 31)) : R;
        voffA[i] = (unsigned)(R * K + C) * 2u; voffB[i] = (unsigned)(Rb * K + C) * 2u; }
    const size_t kstep = (size_t)(BK * 2);
    const size_t hstep = (size_t)HALF * K * 2;
    const size_t tstep = 2 * hstep;
    const unsigned ldsw = (unsigned)wid * 1024u;
    const int aoff = lds_byte(wr * 64 + fr, fq * 8), boff = lds_byte(wc * 32 + fr, fq * 8);
#define PG8_SA(b, h) (((b) * 2 + (h)) * HTB)
#define PG8_SB(b, h) ((4 + (b) * 2 + (h)) * HTB)
#define PG8_STAGE(bufoff, gbase, voff) do { _Pragma("unroll") for (int _i = 0; _i < 2; ++_i) \
        __builtin_amdgcn_global_load_lds((const unsigned*)((const char*)(gbase) + (voff)[_i]), (PG8_LAS unsigned*)(lds + (bufoff) + ldsw + _i * 8192), 16, 0, 0); } while (0)
#define PG8_LDA(dst, b, h) do { _Pragma("unroll") for (int m = 0; m < 4; ++m) _Pragma("unroll") for (int k = 0; k < 2; ++k) dst[m][k] = *(const PG8_LAS bf16x8*)(lds + PG8_SA(b, h) + aoff + m * 2048 + k * 1024); } while (0)
#define PG8_LDB(dst, b, h) do { _Pragma("unroll") for (int n = 0; n < 2; ++n) _Pragma("unroll") for (int k = 0; k < 2; ++k) dst[n][k] = *(const PG8_LAS bf16x8*)(lds + PG8_SB(b, h) + boff + n * 2048 + k * 1024); } while (0)
#define PG8_MMA(ai, bj, At, Bt) do { __builtin_amdgcn_s_setprio(1); _Pragma("unroll") for (int m = 0; m < 4; ++m) _Pragma("unroll") for (int n = 0; n < 2; ++n) _Pragma("unroll") for (int k = 0; k < 2; ++k) \
        acc[ai][bj][m][n] = __builtin_amdgcn_mfma_f32_16x16x32_bf16(Bt[n][k], At[m][k], acc[ai][bj][m][n], 0, 0, 0); __builtin_amdgcn_s_setprio(0); } while (0)
#define PG8_WAIT_V(n) asm volatile("s_waitcnt vmcnt(" #n ")" ::: "memory")
#define PG8_WAIT_L(n) asm volatile("s_waitcnt lgkmcnt(" #n ")" ::: "memory")
#define PG8_BAR __builtin_amdgcn_s_barrier()
#define PG8_SCHED __builtin_amdgcn_sched_barrier(0)
    Unit cur, nxt; int ui = 0;
    if (!S.next(0, cur)) return;
    f32x4 acc[2][2][4][2];
#pragma unroll
    for (int a = 0; a < 2; ++a)
#pragma unroll
        for (int b = 0; b < 2; ++b)
#pragma unroll
            for (int m = 0; m < 4; ++m)
#pragma unroll
                for (int n = 0; n < 2; ++n) acc[a][b][m][n] = (f32x4){0.f, 0.f, 0.f, 0.f};
    bf16x8 At[4][2], B0[2][2], B1[2][2];
    const char* cA = (const char*)g.A + (size_t)cur.pm * tstep; const char* cB = (const char*)g.Bt + (size_t)cur.pn * tstep;
    S.a_ready(cur);
    if constexpr (SP2) {
        PG8_STAGE(PG8_SB(0, 0), cB, voffB); PG8_STAGE(PG8_SB(0, 1), cB + hstep, voffB); PG8_STAGE(PG8_SA(0, 0), cA, voffA); PG8_STAGE(PG8_SA(0, 1), cA + hstep, voffA);
        if (wr == 1) PG8_BAR;
        PG8_WAIT_V(2); PG8_BAR;
        PG8_STAGE(PG8_SB(1, 0), cB + kstep, voffB); PG8_STAGE(PG8_SA(1, 0), cA + kstep, voffA); PG8_STAGE(PG8_SB(1, 1), cB + hstep + kstep, voffB);
        PG8_WAIT_V(6); PG8_BAR;
    } else {
        PG8_STAGE(PG8_SB(0, 0), cB, voffB); PG8_STAGE(PG8_SA(0, 0), cA, voffA); PG8_STAGE(PG8_SB(0, 1), cB + hstep, voffB); PG8_STAGE(PG8_SA(0, 1), cA + hstep, voffA);
        if (wr == 1) PG8_BAR;
        PG8_WAIT_V(4); PG8_BAR;
        PG8_STAGE(PG8_SB(1, 0), cB + kstep, voffB); PG8_STAGE(PG8_SA(1, 0), cA + kstep, voffA); PG8_STAGE(PG8_SB(1, 1), cB + hstep + kstep, voffB);
        PG8_WAIT_V(6); PG8_BAR;
    }
    for (;;) {
        const bool has_next = S.next(ui + 1, nxt);
        const char* nA = has_next ? (const char*)g.A + (size_t)nxt.pm * tstep : cA; const char* nB = has_next ? (const char*)g.Bt + (size_t)nxt.pn * tstep : cB;
        for (int t = 0; t < nt; t += 2) {
            const bool last = (t == nt - 2);
            const char* a1 = cA + (size_t)(t + 1) * kstep;
            const char* a2 = last ? nA : cA + (size_t)(t + 2) * kstep; const char* b2 = last ? nB : cB + (size_t)(t + 2) * kstep;
            const char* a3 = a2 + kstep; const char* b3 = b2 + kstep;
            if (last && has_next) S.a_ready(nxt);
            if constexpr (SP2) {
            PG8_LDB(B0, 0, 0); PG8_LDB(B1, 0, 1); PG8_SCHED; PG8_LDA(At, 0, 0); PG8_STAGE(PG8_SA(1, 1), a1 + hstep, voffA);
            PG8_WAIT_V(8); PG8_WAIT_L(0); PG8_BAR; PG8_MMA(0, 0, At, B0); PG8_MMA(0, 1, At, B1); PG8_BAR; PG8_SCHED;
            PG8_LDA(At, 0, 1); PG8_STAGE(PG8_SB(0, 0), b2, voffB); PG8_STAGE(PG8_SB(0, 1), b2 + hstep, voffB); PG8_STAGE(PG8_SA(0, 0), a2, voffA);
            PG8_WAIT_V(8); PG8_WAIT_L(0); PG8_BAR; PG8_MMA(1, 0, At, B0); PG8_MMA(1, 1, At, B1); PG8_BAR; PG8_SCHED;
            PG8_LDB(B0, 1, 0); PG8_LDB(B1, 1, 1); PG8_SCHED; PG8_LDA(At, 1, 0); PG8_STAGE(PG8_SA(0, 1), a2 + hstep, voffA);
            PG8_WAIT_V(8); PG8_WAIT_L(0); PG8_BAR; PG8_MMA(0, 0, At, B0); PG8_MMA(0, 1, At, B1); PG8_BAR; PG8_SCHED;
            PG8_LDA(At, 1, 1); PG8_STAGE(PG8_SB(1, 0), b3, voffB); PG8_STAGE(PG8_SB(1, 1), b3 + hstep, voffB); PG8_STAGE(PG8_SA(1, 0), a3, voffA);
            PG8_WAIT_V(8); PG8_WAIT_L(0); PG8_BAR; PG8_MMA(1, 0, At, B0); PG8_MMA(1, 1, At, B1); PG8_BAR; PG8_SCHED;
            } else {
            PG8_LDB(B0, 0, 0); PG8_SCHED; PG8_LDA(At, 0, 0); PG8_STAGE(PG8_SA(1, 1), a1 + hstep, voffA);
            PG8_WAIT_L(8); PG8_BAR; PG8_WAIT_L(0); PG8_MMA(0, 0, At, B0); PG8_BAR; PG8_SCHED;
            PG8_LDB(B1, 0, 1); PG8_STAGE(PG8_SB(0, 0), b2, voffB);
            PG8_BAR; PG8_WAIT_L(0); PG8_MMA(0, 1, At, B1); PG8_BAR;
            PG8_LDA(At, 0, 1); PG8_STAGE(PG8_SA(0, 0), a2, voffA);
            PG8_BAR; PG8_WAIT_L(0); PG8_MMA(1, 0, At, B0); PG8_BAR; PG8_SCHED;
            PG8_STAGE(PG8_SB(0, 1), b2 + hstep, voffB);
            PG8_WAIT_V(6); PG8_BAR; PG8_MMA(1, 1, At, B1); PG8_BAR;
            PG8_LDB(B0, 1, 0); PG8_SCHED; PG8_LDA(At, 1, 0); PG8_STAGE(PG8_SA(0, 1), a2 + hstep, voffA);
            PG8_WAIT_L(8); PG8_BAR; PG8_WAIT_L(0); PG8_MMA(0, 0, At, B0); PG8_BAR; PG8_SCHED;
            PG8_LDB(B1, 1, 1); PG8_STAGE(PG8_SB(1, 0), b3, voffB);
            PG8_BAR; PG8_WAIT_L(0); PG8_MMA(0, 1, At, B1); PG8_BAR;
            PG8_LDA(At, 1, 1); PG8_STAGE(PG8_SA(1, 0), a3, voffA);
            PG8_BAR; PG8_WAIT_L(0); PG8_MMA(1, 0, At, B0); PG8_BAR; PG8_SCHED;
            PG8_STAGE(PG8_SB(1, 1), b3 + hstep, voffB);
            PG8_WAIT_V(6); PG8_BAR; PG8_MMA(1, 1, At, B1); PG8_BAR;
            }
        }
        if constexpr (ALIGN_EPI) { if (wr == 0) PG8_BAR; }
        if constexpr (!Epi::AFTER_DRAIN) { E(acc, cur, wr, wc, fr, fq); S.done(cur); }
        if (!has_next) break;
#pragma unroll
        for (int a = 0; a < 2; ++a)
#pragma unroll
            for (int b = 0; b < 2; ++b)
#pragma unroll
                for (int m = 0; m < 4; ++m)
#pragma unroll
                    for (int n = 0; n < 2; ++n) acc[a][b][m][n] = (f32x4){0.f, 0.f, 0.f, 0.f};
        cur = nxt; cA = nA; cB = nB; ++ui;
        if constexpr (ALIGN_EPI) { if (wr == 1) PG8_BAR; }
    }
    PG8_WAIT_V(0);
    if constexpr (!ALIGN_EPI) { if (wr == 0) PG8_BAR; }
    PG8_BAR;
    if constexpr (Epi::AFTER_DRAIN) { E.fused(acc, cur, wr, wc, fr, fq, lds, wid, lane); S.done(cur); }
#undef PG8_SA
#undef PG8_SB
#undef PG8_STAGE
#undef PG8_LDA
#undef PG8_LDB
#undef PG8_MMA
#undef PG8_WAIT_V
#undef PG8_WAIT_L
#undef PG8_BAR
#undef PG8_SCHED
}
}

#define PG8_ROW(ai, m) (u.pm * 256 + (ai) * 128 + wr * 64 + (m) * 16 + fr)
#define PG8_FOR(...) _Pragma("unroll") for (int ai = 0; ai < 2; ++ai) _Pragma("unroll") for (int m = 0; m < 4; ++m) { const int row = PG8_ROW(ai, m); _Pragma("unroll") for (int bj = 0; bj < 2; ++bj) { \
    const int ct = bj * 128 + wc * 32 + 8 * fq; const pg8::f32x4 v0 = acc[ai][bj][m][0], v1 = acc[ai][bj][m][1]; __VA_ARGS__ } }
__device__ __forceinline__ u32x4 pack8(const pg8::f32x4& a, const pg8::f32x4& b) { u32x4 w; w.x = pg8::cvt_pk_bf16(a[0], a[1]); w.y = pg8::cvt_pk_bf16(a[2], a[3]); w.z = pg8::cvt_pk_bf16(b[0], b[1]); w.w = pg8::cvt_pk_bf16(b[2], b[3]); return w; }
__device__ __forceinline__ void unpack8(const u32x4& w, float (&f)[8]) {
#pragma unroll
    for (int i = 0; i < 4; ++i) { f[2 * i] = bf2f(w[i]); f[2 * i + 1] = bf2f(w[i] >> 16); } }

struct Epi8In {
    static constexpr bool PERM = true, AFTER_DRAIN = false;
    unsigned char* ws;
    __device__ __forceinline__ void operator()(const pg8::f32x4 (&acc)[2][2][4][2], const pg8::Unit& u, int wr, int wc, int fr, int fq) const {
        const int pn = u.pn;
        if (pn >= 22 && pn < 25) {
            float* kva = (float*)(ws + WS_KVA);
            PG8_FOR({ float* o = kva + (size_t)row * KVAW + (pn - 22) * 256 + ct; *(pg8::f32x4*)o = v0; *(pg8::f32x4*)(o + 4) = v1; })
            return;
        }
        size_t base; int ldc, c0, mode = 0;
        if (pn < 4) { base = WS_MLQ; ldc = 1024; c0 = pn * 256; }
        else if (pn < 8) { base = WS_MLK; ldc = 1024; c0 = (pn - 4) * 256; mode = 1; }
        else if (pn < 12) { base = WS_MLV; ldc = 1024; c0 = (pn - 8) * 256; }
        else if (pn < 16) { base = WS_MLO; ldc = 1024; c0 = (pn - 12) * 256; mode = 2; }
        else if (pn < 22) { base = WS_MQ; ldc = 1536; c0 = (pn - 16) * 256; }
        else if (pn < 29) { base = WS_S5U; ldc = 1024; c0 = (pn - 25) * 256; }
        else if (pn < 33) { base = WS_DFQ; ldc = 1024; c0 = (pn - 29) * 256; }
        else if (pn < 37) { base = WS_DFK; ldc = 1024; c0 = (pn - 33) * 256; }
        else { base = WS_DFV; ldc = 1024; c0 = (pn - 37) * 256; }
        bf16_t* O = (bf16_t*)(ws + base);
        PG8_FOR({ pg8::f32x4 a = v0, b = v1;
            if (mode == 1) { a = a * 0.0625f; b = b * 0.0625f; }
            if (mode == 2) {
_Pragma("unroll")
                for (int e = 0; e < 4; ++e) { a[e] = sigmoidf_(a[e]); b[e] = sigmoidf_(b[e]); } }
            *(u32x4*)(O + (size_t)row * ldc + c0 + ct) = pack8(a, b); })
    }
};
struct Epi8Gate {
    static constexpr bool PERM = true, AFTER_DRAIN = false;
    bf16_t* gs;
    __device__ __forceinline__ void operator()(const pg8::f32x4 (&acc)[2][2][4][2], const pg8::Unit& u, int wr, int wc, int fr, int fq) const {
        PG8_FOR({ pg8::f32x4 a, b;
_Pragma("unroll")
            for (int e = 0; e < 4; ++e) { a[e] = sigmoidf_(v0[e]); b[e] = sigmoidf_(v1[e]); }
            *(u32x4*)(gs + (size_t)row * GATE_COLS + u.pn * 256 + ct) = pack8(a, b); })
    }
};
struct Epi8Kvb {
    static constexpr bool PERM = true, AFTER_DRAIN = false;
    bf16_t* kf; bf16_t* vf;
    __device__ __forceinline__ void operator()(const pg8::f32x4 (&acc)[2][2][4][2], const pg8::Unit& u, int wr, int wc, int fr, int fq) const {
        PG8_FOR({ bf16_t* o = bj == 0 ? kf + (size_t)row * 1536 + u.pn * 192 + wc * 32 + 8 * fq : vf + (size_t)row * 1024 + u.pn * 128 + wc * 32 + 8 * fq; (void)ct;
            *(u32x4*)o = pack8(v0, v1); })
    }
};
struct Epi8Glu {
    static constexpr bool PERM = true, AFTER_DRAIN = false;
    const bf16_t* g; bf16_t* y;
    __device__ __forceinline__ void operator()(const pg8::f32x4 (&acc)[2][2][4][2], const pg8::Unit& u, int wr, int wc, int fr, int fq) const {
        PG8_FOR({ const size_t i = (size_t)row * 1024 + u.pn * 256 + ct; float gf[8]; unpack8(*(const u32x4*)(g + i), gf); pg8::f32x4 a, b;
_Pragma("unroll")
            for (int e = 0; e < 4; ++e) { a[e] = gf[e] * sigmoidf_(v0[e]); b[e] = gf[4 + e] * sigmoidf_(v1[e]); }
            *(u32x4*)(y + i) = pack8(a, b); })
    }
};
struct Epi8Merge {
    static constexpr bool PERM = true, AFTER_DRAIN = false;
    const bf16_t* gs; bf16_t* mg; int b; int pad;
    __device__ __forceinline__ void operator()(const pg8::f32x4 (&acc)[2][2][4][2], const pg8::Unit& u, int wr, int wc, int fr, int fq) const {
        PG8_FOR({ const size_t i = (size_t)row * D + u.pn * 256 + ct; float gf[8], pf[8]; unpack8(*(const u32x4*)(gs + (size_t)row * GATE_COLS + b * D + u.pn * 256 + ct), gf);
            if (b) unpack8(*(const u32x4*)(mg + i), pf); else {
_Pragma("unroll")
                for (int e = 0; e < 8; ++e) pf[e] = 0.f; }
            pg8::f32x4 a, c;
_Pragma("unroll")
            for (int e = 0; e < 4; ++e) { a[e] = pf[e] + gf[e] * v0[e]; c[e] = pf[4 + e] + gf[4 + e] * v1[e]; }
            *(u32x4*)(mg + i) = pack8(a, c); })
    }
};
struct Epi8Res {
    static constexpr bool PERM = true, AFTER_DRAIN = false;
    P p; int l; int goff; int from_x; int pad;
    __device__ __forceinline__ void operator()(const pg8::f32x4 (&acc)[2][2][4][2], const pg8::Unit& u, int wr, int wc, int fr, int fq) const {
        float* X = (float*)(p.ws + WS_X);
        const float* gv = (const float*)(p.ws + WS_MOD) + ((size_t)l * 5 + cond_of_row(u.pm * 256)) * 12288 + goff + u.pn * 256;
        PG8_FOR({ const float* src = (from_x ? X + (size_t)row * D : x_src(p, l, row)) + u.pn * 256 + ct; float* dst = X + (size_t)row * D + u.pn * 256 + ct;
            const pg8::f32x4 g0 = *(const pg8::f32x4*)(gv + ct), g1 = *(const pg8::f32x4*)(gv + ct + 4), s0 = *(const pg8::f32x4*)src, s1 = *(const pg8::f32x4*)(src + 4);
            *(pg8::f32x4*)dst = s0 + g0 * v0; *(pg8::f32x4*)(dst + 4) = s1 + g1 * v1; })
    }
};
struct Epi8FfnIn {
    static constexpr bool PERM = true, AFTER_DRAIN = false;
    bf16_t* hh;
    __device__ __forceinline__ void operator()(const pg8::f32x4 (&acc)[2][2][4][2], const pg8::Unit& u, int wr, int wc, int fr, int fq) const {
_Pragma("unroll")
        for (int ai = 0; ai < 2; ++ai)
_Pragma("unroll")
            for (int m = 0; m < 4; ++m) { const int row = PG8_ROW(ai, m); pg8::f32x4 a, b;
_Pragma("unroll")
                for (int e = 0; e < 4; ++e) { a[e] = siluf_(acc[ai][0][m][0][e]) * acc[ai][1][m][0][e]; b[e] = siluf_(acc[ai][0][m][1][e]) * acc[ai][1][m][1][e]; }
                *(u32x4*)(hh + (size_t)row * FFN + u.pn * 128 + wc * 32 + 8 * fq) = pack8(a, b); }
    }
};

__device__ __forceinline__ int win_row(int n) {
    if (n < 4096) return n;
    if (n < 4112) return 6208 + (n - 4096);
    if (n < 5648) return 4096 + (n - 4112);
    if (n < 6224) return 5632 + (n - 5648);
    if (n < MIX_COLS) return 6400 + (n - 6224);
    return 10496 + (n - MIX_COLS);
}
template <int MAP>
__device__ __forceinline__ void cvt_item(const float* W, int K, int N, bf16_t* WT, int row_off, LAS float* scr, int item, int lane) {
    const int nblk = (N + 31) / 32, kb = item / nblk, nb = item % nblk, k0 = 64 * kb, n0 = 32 * nb;
    const bool nok = n0 + (lane & 31) < N;
#pragma unroll 8
    for (int i = 0; i < 32; ++i) { const int kk = 2 * i + (lane >> 5); scr[kk * 33 + (lane & 31)] = nok ? W[(size_t)(k0 + kk) * N + n0 + (lane & 31)] : 0.f; }
    asm volatile("s_waitcnt lgkmcnt(0)" ::: "memory");
    const int c = lane & 7;
#pragma unroll
    for (int j = 0; j < 4; ++j) { const int n = (lane >> 3) + 8 * j; const LAS float* s = scr + (8 * c) * 33 + n;
        u32x4 o; o.x = pk2(s[0 * 33], s[1 * 33]); o.y = pk2(s[2 * 33], s[3 * 33]); o.z = pk2(s[4 * 33], s[5 * 33]); o.w = pk2(s[6 * 33], s[7 * 33]);
        const int ng = n0 + n; int row;
        if (MAP == 0) row = row_off + ng; else if (MAP == 1) row = win_row(ng); else row = (ng < FFN) ? ((ng >> 7) * 256 + (ng & 127)) : (((ng - FFN) >> 7) * 256 + 128 + ((ng - FFN) & 127));
        if (ng < N) *(u32x4*)(WT + (size_t)row * K + k0 + 8 * c) = o; }
    asm volatile("s_waitcnt lgkmcnt(0)" ::: "memory");
}
constexpr size_t WB_IN = 0, WB_KVB = 73 * MiB, WB_GLU = 75 * MiB, WB_BR = 77 * MiB, WB_O = 93 * MiB, WB_FIN = 101 * MiB, WB_FOUT = 145 * MiB, WB_END = 167 * MiB;
constexpr int NIN_T = 18688;
__device__ __forceinline__ void ph_convert(const P& p, int l, int gw, int NGW, int lane, LAS float* scr) {
    unsigned char* wb = p.ws + WS_WBF;
    constexpr int I_IN = (D / 64) * ((IN_COLS + 31) / 32), I_KVB = (512 / 64) * (2048 / 32), I_GLU = (1024 / 64) * (1024 / 32), I_BR = (1024 / 64) * (2048 / 32), I_O = (D / 64) * (D / 32),
                  I_FIN = (D / 64) * (2 * FFN / 32), I_FOUT = (FFN / 64) * (D / 32);
    constexpr int NIT = I_IN + I_KVB + I_GLU + 4 * I_BR + I_O + I_FIN + I_FOUT;
    for (int it = gw; it < NIT; it += NGW) {
        int r = it;
        if (r < I_IN) { cvt_item<1>(p.in[17] + (size_t)l * D * IN_COLS, D, IN_COLS, (bf16_t*)(wb + WB_IN), 0, scr, r, lane); continue; } r -= I_IN;
        if (r < I_KVB) { cvt_item<0>(p.in[21] + (size_t)l * 512 * 2048, 512, 2048, (bf16_t*)(wb + WB_KVB), 0, scr, r, lane); continue; } r -= I_KVB;
        if (r < I_GLU) { cvt_item<0>(p.in[30] + (size_t)l * 1024 * 1024, 1024, 1024, (bf16_t*)(wb + WB_GLU), 0, scr, r, lane); continue; } r -= I_GLU;
        if (r < 4 * I_BR) { const int b = r / I_BR; cvt_item<0>(p.in[33] + ((size_t)l * 4 + b) * 1024 * 2048, 1024, 2048, (bf16_t*)(wb + WB_BR) + (size_t)b * 2048 * 1024, 0, scr, r % I_BR, lane); continue; } r -= 4 * I_BR;
        if (r < I_O) { cvt_item<0>(p.in[34] + (size_t)l * D * D, D, D, (bf16_t*)(wb + WB_O), 0, scr, r, lane); continue; } r -= I_O;
        if (r < I_FIN) { cvt_item<2>(p.in[35] + (size_t)l * D * 2 * FFN, D, 2 * FFN, (bf16_t*)(wb + WB_FIN), 0, scr, r, lane); continue; } r -= I_FIN;
        cvt_item<0>(p.in[36] + (size_t)l * FFN * D, FFN, D, (bf16_t*)(wb + WB_FOUT), 0, scr, r, lane);
    }
    for (int row = 6224 + gw; row < 6400; row += NGW) { u32x4* o = (u32x4*)((bf16_t*)(wb + WB_IN) + (size_t)row * D); for (int j = lane; j < D / 8; j += 64) o[j] = (u32x4){0u, 0u, 0u, 0u}; }
}

__device__ __forceinline__ float rope_lane(float x, int lane, int prow, int pcol, const float* rt) {
    const int part = lane >> 5, jj = lane & 31, idx = jj & 15, pos = part ? pcol : prow;
    const float c = rt[pos * 16 + idx], s = rt[1024 + pos * 16 + idx];
    const float o = __shfl_xor(x, 16);
    return (jj >= 16) ? (x * c + o * s) : (x * c - o * s);
}
__device__ __forceinline__ void ph_prep_row(const P& p, int l, int r, int lane) {
    unsigned char* ws = p.ws;
    bf16_t* ckvn = (bf16_t*)(ws + WS_CKVN) + (size_t)r * 512;
    bf16_t* kf = (bf16_t*)(ws + WS_KFULL) + (size_t)r * 1536;
    bf16_t* dfk = (bf16_t*)(ws + WS_DFK) + (size_t)r * 1024;
    bf16_t* dfv = (bf16_t*)(ws + WS_DFV) + (size_t)r * 1024;
    if (r >= MTOK) {
        const int i = r - MTOK, b = i >> 8, t = i & 255;
        const float* cc = p.in[2] + ((size_t)(b * 2 + l) * PAST + t) * 512;
        for (int j = lane; j < 512; j += 64) ckvn[j] = (bf16_t)f2bf(cc[j]);
        const float kr = p.in[3][((size_t)(b * 2 + l) * PAST + t) * 64 + lane];
#pragma unroll
        for (int h = 0; h < 8; ++h) kf[h * 192 + 128 + lane] = (bf16_t)f2bf(kr);
        const float* ck = p.in[4] + ((size_t)(b * 2 + l) * PAST + t) * 1024; const float* cv = p.in[5] + ((size_t)(b * 2 + l) * PAST + t) * 1024;
        for (int j = lane; j < 1024; j += 64) { dfk[j] = (bf16_t)f2bf(ck[j]); dfv[j] = (bf16_t)f2bf(cv[j]); }
        return;
    }
    const float* kva = (const float*)(ws + WS_KVA) + (size_t)r * KVAW;
    const bool ctx = r < NCTX;
    const int cb = r >> 8, ct = r & 255;
    const int t = (r - NCTX) & 4095, prow = t >> 6, pcol = t & 63;
    const float* rt = (const float*)(ws + WS_ROPE);
    { float v[8]; float ss = 0.f;
#pragma unroll
      for (int j = 0; j < 8; ++j) { v[j] = kva[j * 64 + lane]; ss += v[j] * v[j]; }
      const float rstd = rsqrtf(wave_sum(ss) * (1.0f / 512.0f) + 1e-6f);
      const float* g = p.in[20] + l * 512;
#pragma unroll
      for (int j = 0; j < 8; ++j) { const float y = v[j] * rstd * g[j * 64 + lane]; ckvn[j * 64 + lane] = (bf16_t)f2bf(y);
          if (ctx) p.out[O_CKV + ((size_t)(cb * 2 + l) * CL + ct) * 512 + j * 64 + lane] = y; } }
    { float kr = kva[512 + lane];
      if (ctx) p.out[O_KR + ((size_t)(cb * 2 + l) * CL + ct) * 64 + lane] = kr; else kr = rope_lane(kr, lane, prow, pcol, rt);
#pragma unroll
      for (int h = 0; h < 8; ++h) kf[h * 192 + 128 + lane] = (bf16_t)f2bf(kr); }
    if (lane < 16) { const float g = kva[576 + lane] + p.in[18][l * 16 + lane];
        const float o = ((lane >> 2) & 1) ? (fminf(g, 0.f) - log1pf(__expf(-fabsf(g)))) : g;
        ((float*)(ws + WS_GATES))[(size_t)r * 16 + lane] = o; }
    if (ctx) {
        float* ok = p.out + O_DK + ((size_t)(cb * 2 + l) * CL + ct) * 1024; float* ov = p.out + O_DV + ((size_t)(cb * 2 + l) * CL + ct) * 1024;
        for (int j = lane; j < 1024; j += 64) { ok[j] = bf2f(dfk[j]); ov[j] = bf2f(dfv[j]); }
    } else {
        bf16_t* mq = (bf16_t*)(ws + WS_MQ) + (size_t)r * 1536; bf16_t* dfq = (bf16_t*)(ws + WS_DFQ) + (size_t)r * 1024;
#pragma unroll
        for (int h = 0; h < 8; ++h) { const float x = bf2f(mq[h * 192 + 128 + lane]); mq[h * 192 + 128 + lane] = (bf16_t)f2bf(rope_lane(x, lane, prow, pcol, rt)); }
#pragma unroll
        for (int h = 0; h < 16; ++h) { const float x = bf2f(dfq[h * 64 + lane]); dfq[h * 64 + lane] = (bf16_t)f2bf(rope_lane(x, lane, prow, pcol, rt));
            const float y = bf2f(dfk[h * 64 + lane]); dfk[h * 64 + lane] = (bf16_t)f2bf(rope_lane(y, lane, prow, pcol, rt)); }
    }
}

__device__ __forceinline__ void ph_mlstm_chain(const P& p, int l, int chain, int tid, float* sm) {
    float* sq = sm; float* sk = sm + 256; float* red = sm + 512;
    const int lane = tid & 63, wid = tid >> 6;
    const bool lat = chain >= 128; const int cc = lat ? chain - 128 : chain, b = cc >> 3, h = (cc >> 1) & 3, dir = cc & 1;
    const int L = lat ? LL : CL, base = lat ? NCTX + b * LL : b * CL;
    float* CT = (float*)(p.ws + WS_CT) + (size_t)chain * 65536;
    float n_k, m;
    if (lat) {
        const float* c0 = p.in[6] + ((size_t)((b * 2 + l) * 2 + dir) * 4 + h) * 65536;
        for (int k = 0; k < 256; ++k) CT[k * 256 + tid] = c0[(size_t)tid * 256 + k];
        n_k = p.in[7][((size_t)((b * 2 + l) * 2 + dir) * 4 + h) * 256 + tid]; m = p.in[8][((b * 2 + l) * 2 + dir) * 4 + h];
    } else { for (int k = 0; k < 256; ++k) CT[k * 256 + tid] = 0.f; n_k = 0.f; m = 0.f; }
    const bf16_t* Q = (const bf16_t*)(p.ws + WS_MLQ); const bf16_t* Kp = (const bf16_t*)(p.ws + WS_MLK); const bf16_t* V = (const bf16_t*)(p.ws + WS_MLV);
    const float* G = (const float*)(p.ws + WS_GATES);
    bf16_t* Hout = (bf16_t*)(p.ws + (dir ? WS_HB : WS_HF));
    for (int s = 0; s < L; ++s) {
        const int r = base + (dir ? L - 1 - s : s);
        __syncthreads();
        sq[tid] = bf2f(Q[(size_t)r * 1024 + h * 256 + tid]); sk[tid] = bf2f(Kp[(size_t)r * 1024 + h * 256 + tid]);
        const float vv = bf2f(V[(size_t)r * 1024 + h * 256 + tid]);
        const float li = G[(size_t)r * 16 + dir * 8 + h], lf = G[(size_t)r * 16 + dir * 8 + 4 + h];
        const float mn = fmaxf(lf + m, li), ip = __expf(li - mn), fp = __expf(lf + m - mn); m = mn;
        __syncthreads();
        const float iv = ip * vv; float num = 0.f;
        for (int k = 0; k < 256; ++k) { float c = CT[k * 256 + tid]; c = fp * c + iv * sk[k]; CT[k * 256 + tid] = c; num += c * sq[k]; }
        n_k = fp * n_k + ip * sk[tid];
        const float dp = wave_sum(n_k * sq[tid]);
        if (lane == 0) red[wid] = dp;
        __syncthreads();
        const float den = red[0] + red[1] + red[2] + red[3];
        Hout[(size_t)r * 1024 + h * 256 + tid] = (bf16_t)f2bf(num / fmaxf(fabsf(den), __expf(-m)));
    }
    if (!lat) {
        float* oc = p.out + O_MC + ((size_t)((b * 2 + l) * 2 + dir) * 4 + h) * 65536;
        for (int k = 0; k < 256; ++k) oc[(size_t)tid * 256 + k] = CT[k * 256 + tid];
        p.out[O_MN + ((size_t)((b * 2 + l) * 2 + dir) * 4 + h) * 256 + tid] = n_k;
        if (tid == 0) p.out[O_MM + ((b * 2 + l) * 2 + dir) * 4 + h] = m;
    }
}
__device__ __forceinline__ void ph_ml_combine(const P& p, int l, int w, int lane) {
    const int r = w >> 2, h = w & 3;
    bf16_t* hf = (bf16_t*)(p.ws + WS_HF) + (size_t)r * 1024 + h * 256; const bf16_t* hb = (const bf16_t*)(p.ws + WS_HB) + (size_t)r * 1024 + h * 256;
    const bf16_t* so = (const bf16_t*)(p.ws + WS_MLO) + (size_t)r * 1024 + h * 256; const float* g = p.in[19] + l * 1024 + h * 256;
    float v[4]; float ss = 0.f;
#pragma unroll
    for (int j = 0; j < 4; ++j) { v[j] = bf2f(hf[j * 64 + lane]) + bf2f(hb[j * 64 + lane]); ss += v[j] * v[j]; }
    const float rstd = rsqrtf(wave_sum(ss) * (1.0f / 256.0f) + 1e-6f);
#pragma unroll
    for (int j = 0; j < 4; ++j) hf[j * 64 + lane] = (bf16_t)f2bf(v[j] * rstd * g[j * 64 + lane] * bf2f(so[j * 64 + lane]));
}

__device__ __forceinline__ void reduce16(float (&v)[16], int lane) {
    const bool b5 = lane & 32, b4 = lane & 16, b3 = lane & 8, b2 = lane & 4;
#pragma unroll
    for (int j = 0; j < 8; ++j) { const float keep = b5 ? v[8 + j] : v[j], send = b5 ? v[j] : v[8 + j]; v[j] = keep + __shfl_xor(send, 32); }
#pragma unroll
    for (int j = 0; j < 4; ++j) { const float keep = b4 ? v[4 + j] : v[j], send = b4 ? v[j] : v[4 + j]; v[j] = keep + __shfl_xor(send, 16); }
#pragma unroll
    for (int j = 0; j < 2; ++j) { const float keep = b3 ? v[2 + j] : v[j], send = b3 ? v[j] : v[2 + j]; v[j] = keep + __shfl_xor(send, 8); }
    { const float keep = b2 ? v[1] : v[0], send = b2 ? v[0] : v[1]; v[0] = keep + __shfl_xor(send, 4); }
    v[0] += __shfl_xor(v[0], 2); v[0] += __shfl_xor(v[0], 1);
}
__device__ __forceinline__ void ph_s5_unit(const P& p, int l, int dir, int w, int lane) {
    const int seq = w >> 6, g = w & 63; const bool lat = seq >= 16; const int b = lat ? seq - 16 : seq;
    const int L = lat ? LL : CL, base = lat ? NCTX + b * LL : b * CL;
    const size_t pg = ((size_t)(l * 2 + dir) * 64 + g);
    const float lr = fminf(p.in[22][pg * 64 + lane], -1e-4f), li = p.in[23][pg * 64 + lane], dt = __expf(p.in[24][pg]);
    const float mag = __expf(dt * lr); float sn, cs; sincos_small(dt * li, sn, cs);
    const float ar = mag * cs, ai = mag * sn, den = lr * lr + li * li, nr = ar - 1.0f, ni = ai, qr = (nr * lr + ni * li) / den, qi = (ni * lr - nr * li) / den;
    float bbr[16], bbi[16], cr[16], ci[16];
#pragma unroll
    for (int i = 0; i < 16; ++i) { const float br = p.in[25][(pg * 64 + lane) * 16 + i], bi = p.in[26][(pg * 64 + lane) * 16 + i]; bbr[i] = qr * br - qi * bi; bbi[i] = qr * bi + qi * br;
        cr[i] = p.in[27][(pg * 16 + i) * 64 + lane]; ci[i] = p.in[28][(pg * 16 + i) * 64 + lane]; }
    float sr = 0.f, si = 0.f;
    if (lat) { sr = p.in[9][((size_t)((b * 2 + l) * 2 + dir) * 64 + g) * 64 + lane]; si = p.in[10][((size_t)((b * 2 + l) * 2 + dir) * 64 + g) * 64 + lane]; }
    const bf16_t* U = (const bf16_t*)(p.ws + WS_S5U); float* YF = (float*)(p.ws + WS_YS5F); bf16_t* YG = (bf16_t*)(p.ws + WS_HB);
    const float dval = p.in[29][l * 1024 + g * 16 + ((lane >> 2) & 15)];
    for (int s = 0; s < L; ++s) {
        const int r = base + (dir ? L - 1 - s : s);
        const u32x4 u0 = *(const u32x4*)(U + (size_t)r * 1024 + g * 16), u1 = *(const u32x4*)(U + (size_t)r * 1024 + g * 16 + 8);
        float u[16];
#pragma unroll
        for (int i = 0; i < 4; ++i) { u[2 * i] = bf2f(u0[i]); u[2 * i + 1] = bf2f(u0[i] >> 16); u[8 + 2 * i] = bf2f(u1[i]); u[9 + 2 * i] = bf2f(u1[i] >> 16); }
        float bur = 0.f, bui = 0.f;
#pragma unroll
        for (int i = 0; i < 16; ++i) { bur += bbr[i] * u[i]; bui += bbi[i] * u[i]; }
        const float nsr = ar * sr - ai * si + bur, nsi = ar * si + ai * sr + bui; sr = nsr; si = nsi;
        float y[16];
#pragma unroll
        for (int i = 0; i < 16; ++i) y[i] = cr[i] * sr - ci[i] * si;
        reduce16(y, lane);
        if ((lane & 3) == 0) { const int i = lane >> 2; const size_t o = (size_t)r * 1024 + g * 16 + i;
            if (dir == 0) YF[o] = y[0];
            else { float ui = 0.f;
#pragma unroll
                for (int e = 0; e < 16; ++e) ui = (e == i) ? u[e] : ui;
                YG[o] = (bf16_t)f2bf(gelu_tanh(YF[o] + y[0] + dval * ui)); } }
    }
    if (!lat) { p.out[O_SR + ((size_t)((b * 2 + l) * 2 + dir) * 64 + g) * 64 + lane] = sr; p.out[O_SI + ((size_t)((b * 2 + l) * 2 + dir) * 64 + g) * 64 + lane] = si; }
}

template <int DQK>
__device__ __forceinline__ void ph_attn_unit(const bf16_t* Qp, int qpitch, const bf16_t* Kp, int kpitch, const bf16_t* Vp, int vpitch, int vdiv, bf16_t* Op, int opitch, int nheads, float scale, int w, int lane) {
    const int r = w / nheads, h = w % nheads;
    const bool lat = r >= NCTX; const int b = lat ? (r - NCTX) >> 12 : r >> 8;
    const int nk = lat ? LL + PAST : CL, kbase = lat ? NCTX + b * LL : b * CL, cbase = MTOK + b * PAST;
    const bf16_t* q = Qp + (size_t)r * qpitch + h * DQK;
    float qreg[DQK / 64];
#pragma unroll
    for (int j = 0; j < DQK / 64; ++j) qreg[j] = bf2f(q[j * 64 + lane]) * scale;
    float mrun = -1e30f, lrun = 0.f, o0 = 0.f, o1 = 0.f;
    const int vh = h / vdiv;
    for (int k0 = 0; k0 < nk; k0 += 64) {
        const int kk = k0 + lane, krow = kk < (lat ? LL : CL) ? kbase + kk : cbase + (kk - LL);
        const bf16_t* kp = Kp + (size_t)krow * kpitch + h * DQK;
        float s = 0.f;
#pragma unroll
        for (int j = 0; j < DQK / 64; ++j) {
#pragma unroll
            for (int c8 = 0; c8 < 8; ++c8) { const u32x4 kv = *(const u32x4*)(kp + j * 64 + c8 * 8);
#pragma unroll
                for (int e = 0; e < 4; ++e) { const float q0 = __shfl(qreg[j], c8 * 8 + 2 * e), q1 = __shfl(qreg[j], c8 * 8 + 2 * e + 1); s += q0 * bf2f(kv[e]) + q1 * bf2f(kv[e] >> 16); } }
        }
        const float mx = wave_max(s), mn = fmaxf(mrun, mx), alpha = __expf(mrun - mn), pj = __expf(s - mn);
        lrun = lrun * alpha + wave_sum(pj); o0 *= alpha; o1 *= alpha; mrun = mn;
        for (int j = 0; j < 64; ++j) { const float pb = __shfl(pj, j); const int kj = k0 + j, vrow = kj < (lat ? LL : CL) ? kbase + kj : cbase + (kj - LL);
            const bf16_t* vp = Vp + (size_t)vrow * vpitch + vh * 128; o0 += pb * bf2f(vp[lane]); o1 += pb * bf2f(vp[64 + lane]); }
    }
    const float inv = 1.0f / lrun;
    bf16_t* o = Op + (size_t)r * opitch + h * 128; o[lane] = (bf16_t)f2bf(o0 * inv); o[64 + lane] = (bf16_t)f2bf(o1 * inv);
}
__device__ __forceinline__ void ph_df_combine(const P& p, int l, float lam_init, int w, int lane) {
    const int r = w >> 3, h = w & 7;
    const float* lp = p.in[31] + l * 256;
    const float lam = __expf(wave_sum(lp[lane] * lp[64 + lane])) - __expf(wave_sum(lp[128 + lane] * lp[192 + lane])) + lam_init;
    const bf16_t* o = (const bf16_t*)(p.ws + WS_DFO) + (size_t)r * 2048 + h * 256;
    const float v0 = bf2f(o[lane]) - lam * bf2f(o[128 + lane]), v1 = bf2f(o[64 + lane]) - lam * bf2f(o[192 + lane]);
    const float rstd = rsqrtf(wave_sum(v0 * v0 + v1 * v1) * (1.0f / 128.0f) + 1e-6f);
    const float* g = p.in[32] + l * 128;
    bf16_t* y = (bf16_t*)(p.ws + WS_DFQ) + (size_t)r * 1024 + h * 128;
    y[lane] = (bf16_t)f2bf(v0 * rstd * g[lane] * (1.0f - lam_init)); y[64 + lane] = (bf16_t)f2bf(v1 * rstd * g[64 + lane] * (1.0f - lam_init));
}
__device__ __forceinline__ void ph_final_row(const P& p, int r, int lane) {
    const float* x = (const float*)(p.ws + WS_X) + (size_t)r * D; const float* g = p.in[37];
    f32x4 v[8]; float ss = 0.f;
#pragma unroll
    for (int j = 0; j < 8; ++j) { v[j] = *(const f32x4*)(x + j * 256 + lane * 4); ss += v[j][0] * v[j][0] + v[j][1] * v[j][1] + v[j][2] * v[j][2] + v[j][3] * v[j][3]; }
    const float rstd = rsqrtf(wave_sum(ss) * (1.0f / 2048.0f) + 1e-6f);
    float* o = p.out + (r < NCTX ? O_YP + (size_t)r * D : O_YS + (size_t)(r - NCTX) * D);
#pragma unroll
    for (int j = 0; j < 8; ++j) { const int c = j * 256 + lane * 4; const f32x4 gg = *(const f32x4*)(g + c); *(f32x4*)(o + c) = v[j] * rstd * gg; }
}

constexpr int NTHR = 512, LDS_BYTES = 147456, MISC_OFF = 131072;
__global__ void __launch_bounds__(NTHR, 2) mega(P p) {
    extern __shared__ __attribute__((aligned(16))) unsigned char lds[];
    const int tid = threadIdx.x;
    const int G = gridDim.x, NGW = G * 8;
    unsigned char* ws = p.ws;
    for (int u = tid; u < (LDS_BYTES - MISC_OFF) / 4; u += NTHR) ((LAS unsigned*)((LAS unsigned char*)lds + MISC_OFF))[u] = 0u;
    __syncthreads();
    XcdBarrier bar = xcd_barrier_post((unsigned*)(ws + WS_CTL), (volatile LAS unsigned*)((LAS unsigned char*)lds + MISC_OFF + 32));
#define GRID_BAR() do { XcdBarrier b_ = bar; asm volatile("" : "+s"(b_.x)); xcd_barrier(b_); } while (0)

#define PH_VARS int tid_ = threadIdx.x; asm volatile("" : "+v"(tid_)); const int lane = tid_ & 63, wave = __builtin_amdgcn_readfirstlane(tid_ >> 6), half = tid_ >> 8, vt = tid_ & 255; \
    const int gw = blockIdx.x * 8 + wave, vb = blockIdx.x * 2 + half; (void)lane; (void)half; (void)vt; (void)gw; (void)vb;
    { PH_VARS ph_mod(p, vb, vb < 96, vt, (float*)(lds + half * 40960)); }
    GRID_BAR();
    for (int l = 0; l < 2; ++l) {
        unsigned char* wb = ws + WS_WBF;
        { PH_VARS ph_convert(p, l, gw, NGW, lane, (LAS float*)((LAS unsigned char*)lds + wave * 16384)); }
        { PH_VARS for (int r = gw; r < MTOK; r += NGW) ph_hnorm_row(p, l, 0, r, lane); }
        GRID_BAR();
        { pg8::Gemm g{(const bf16_t*)(ws + WS_H), (const bf16_t*)(wb + WB_IN), MTOK, 10496, D}; pg8::StaticOrder S; S.init(MTOK, 10496, G, (int)blockIdx.x);
          pg8::gemm_phase<Epi8In, pg8::StaticOrder, true, true>((LAS unsigned char*)lds, g, S, Epi8In{ws}); }
        GRID_BAR();
        { PH_VARS for (int r = gw; r < MALL; r += NGW) ph_prep_row(p, l, r, lane); }
        GRID_BAR();
        { pg8::Gemm g{(const bf16_t*)(ws + WS_CKVN), (const bf16_t*)(wb + WB_KVB), MALL, 2048, 512}; pg8::StaticOrder S; S.init(MALL, 2048, G, (int)blockIdx.x);
          pg8::gemm_phase<Epi8Kvb, pg8::StaticOrder, true, true>((LAS unsigned char*)lds, g, S, Epi8Kvb{(bf16_t*)(ws + WS_KFULL), (bf16_t*)(ws + WS_VFULL)}); }
        { PH_VARS if (vb < 160) ph_mlstm_chain(p, l, vb, vt, (float*)(lds + half * 4096)); }
        GRID_BAR();
        { PH_VARS for (int w = gw; w < MTOK * 4; w += NGW) ph_ml_combine(p, l, w, lane); }
        { PH_VARS for (int w = gw; w < 20 * 64; w += NGW) ph_s5_unit(p, l, 0, w, lane); }
        GRID_BAR();
        { PH_VARS for (int w = gw; w < 20 * 64; w += NGW) ph_s5_unit(p, l, 1, w, lane); }
        GRID_BAR();
        { pg8::Gemm g{(const bf16_t*)(ws + WS_HB), (const bf16_t*)(wb + WB_GLU), MTOK, 1024, 1024}; pg8::StaticOrder S; S.init(MTOK, 1024, G, (int)blockIdx.x);
          pg8::gemm_phase<Epi8Glu, pg8::StaticOrder, true, true>((LAS unsigned char*)lds, g, S, Epi8Glu{(const bf16_t*)(ws + WS_HB), (bf16_t*)(ws + WS_S5U)}); }
        { PH_VARS for (int w = gw; w < MTOK * 8; w += NGW)
            ph_attn_unit<192>((const bf16_t*)(ws + WS_MQ), 1536, (const bf16_t*)(ws + WS_KFULL), 1536, (const bf16_t*)(ws + WS_VFULL), 1024, 1, (bf16_t*)(ws + WS_MLQ), 1024, 8, 0.07216878364870322f, w, lane); }
        { PH_VARS for (int w = gw; w < MTOK * 16; w += NGW)
            ph_attn_unit<64>((const bf16_t*)(ws + WS_DFQ), 1024, (const bf16_t*)(ws + WS_DFK), 1024, (const bf16_t*)(ws + WS_DFV), 1024, 2, (bf16_t*)(ws + WS_DFO), 2048, 16, 0.125f, w, lane); }
        GRID_BAR();
        { PH_VARS const float lam_init = (l == 0) ? 0.2f : 0.35550906759096927f;
          for (int w = gw; w < MTOK * 8; w += NGW) ph_df_combine(p, l, lam_init, w, lane); }
        GRID_BAR();
        { pg8::Gemm g{(const bf16_t*)(ws + WS_H), (const bf16_t*)(wb + WB_IN) + (size_t)10496 * D, MTOK, GATE_COLS, D}; pg8::StaticOrder S; S.init(MTOK, GATE_COLS, G, (int)blockIdx.x);
          pg8::gemm_phase<Epi8Gate, pg8::StaticOrder, true, true>((LAS unsigned char*)lds, g, S, Epi8Gate{(bf16_t*)(ws + WS_GS)}); }
        GRID_BAR();
        { pg8::Gemm g{(const bf16_t*)(ws + WS_HF), (const bf16_t*)(wb + WB_BR) + (size_t)0 * 2048 * 1024, MTOK, D, 1024}; pg8::StaticOrder S; S.init(MTOK, D, G, (int)blockIdx.x);
          pg8::gemm_phase<Epi8Merge, pg8::StaticOrder, true, true>((LAS unsigned char*)lds, g, S, Epi8Merge{(const bf16_t*)(ws + WS_GS), (bf16_t*)(ws + WS_H), 0, 0}); }
        { pg8::Gemm g{(const bf16_t*)(ws + WS_MLQ), (const bf16_t*)(wb + WB_BR) + (size_t)1 * 2048 * 1024, MTOK, D, 1024}; pg8::StaticOrder S; S.init(MTOK, D, G, (int)blockIdx.x);
          pg8::gemm_phase<Epi8Merge, pg8::StaticOrder, true, true>((LAS unsigned char*)lds, g, S, Epi8Merge{(const bf16_t*)(ws + WS_GS), (bf16_t*)(ws + WS_H), 1, 0}); }
        { pg8::Gemm g{(const bf16_t*)(ws + WS_S5U), (const bf16_t*)(wb + WB_BR) + (size_t)2 * 2048 * 1024, MTOK, D, 1024}; pg8::StaticOrder S; S.init(MTOK, D, G, (int)blockIdx.x);
          pg8::gemm_phase<Epi8Merge, pg8::StaticOrder, true, true>((LAS unsigned char*)lds, g, S, Epi8Merge{(const bf16_t*)(ws + WS_GS), (bf16_t*)(ws + WS_H), 2, 0}); }
        { pg8::Gemm g{(const bf16_t*)(ws + WS_DFQ), (const bf16_t*)(wb + WB_BR) + (size_t)3 * 2048 * 1024, MTOK, D, 1024}; pg8::StaticOrder S; S.init(MTOK, D, G, (int)blockIdx.x);
          pg8::gemm_phase<Epi8Merge, pg8::StaticOrder, true, true>((LAS unsigned char*)lds, g, S, Epi8Merge{(const bf16_t*)(ws + WS_GS), (bf16_t*)(ws + WS_H), 3, 0}); }
        GRID_BAR();
        { pg8::Gemm g{(const bf16_t*)(ws + WS_H), (const bf16_t*)(wb + WB_O), MTOK, D, D}; pg8::StaticOrder S; S.init(MTOK, D, G, (int)blockIdx.x);
          pg8::gemm_phase<Epi8Res, pg8::StaticOrder, true, true>((LAS unsigned char*)lds, g, S, Epi8Res{p, l, 4096, 0, 0}); }
        GRID_BAR();
        { PH_VARS for (int r = gw; r < MTOK; r += NGW) ph_hnorm_row(p, l, 1, r, lane); }
        GRID_BAR();
        { pg8::Gemm g{(const bf16_t*)(ws + WS_H), (const bf16_t*)(wb + WB_FIN), MTOK, 2 * FFN, D}; pg8::StaticOrder S; S.init(MTOK, 2 * FFN, G, (int)blockIdx.x);
          pg8::gemm_phase<Epi8FfnIn, pg8::StaticOrder, true, true>((LAS unsigned char*)lds, g, S, Epi8FfnIn{(bf16_t*)(ws + WS_FFNH)}); }
        GRID_BAR();
        { pg8::Gemm g{(const bf16_t*)(ws + WS_FFNH), (const bf16_t*)(wb + WB_FOUT), MTOK, D, FFN}; pg8::StaticOrder S; S.init(MTOK, D, G, (int)blockIdx.x);
          pg8::gemm_phase<Epi8Res, pg8::StaticOrder, true, true>((LAS unsigned char*)lds, g, S, Epi8Res{p, l, 10240, 1, 0}); }
        GRID_BAR();
    }
    { PH_VARS for (int r = gw; r < MTOK; r += NGW) ph_final_row(p, r, lane); }
}

extern "C" void kernel_launch(void* const* d_in, const int* in_sizes, int n_in, void* d_out, int out_size, void* d_ws, size_t ws_size, hipStream_t stream) {
    static int grid = 0;
    if (grid == 0) {
        if (n_in != 38 || out_size != (int)O_END || ws_size < WS_END) { fprintf(stderr, "kernel_launch: unexpected shapes (n_in %d out %d ws %zu)\n", n_in, out_size, ws_size); grid = -1; return; }
        int dev = 0, cus = 0, per_cu = 0;
        if (hipGetDevice(&dev) != hipSuccess || hipDeviceGetAttribute(&cus, hipDeviceAttributeMultiprocessorCount, dev) != hipSuccess) { grid = -1; return; }
        if (hipFuncSetAttribute((const void*)mega, hipFuncAttributeMaxDynamicSharedMemorySize, LDS_BYTES) != hipSuccess) { fprintf(stderr, "kernel_launch: hipFuncSetAttribute failed\n"); grid = -1; return; }
        if (hipOccupancyMaxActiveBlocksPerMultiprocessor(&per_cu, (const void*)mega, NTHR, LDS_BYTES) != hipSuccess || per_cu < 1) { fprintf(stderr, "kernel_launch: occupancy query says %d workgroups per CU\n", per_cu); grid = -1; return; }
        (void)hipGetLastError();
        grid = cus;
    }
    if (grid < 0) return;
    if (hipMemsetAsync((char*)d_ws + WS_CTL, 0, CTL_BYTES, stream) != hipSuccess) return;
    P p{};
    for (int i = 0; i < 38; ++i) p.in[i] = (const float*)d_in[i];
    p.out = (float*)d_out; p.ws = (unsigned char*)d_ws;
    hipLaunchKernelGGL(mega, dim3(grid), dim3(NTHR), LDS_BYTES, stream, p);
}
```

```cpp
#include <hip/hip_runtime.h>
#include <cstdio>
#include <cstdint>

typedef unsigned short bf16_t;
typedef short bf16x8 __attribute__((ext_vector_type(8)));
typedef float f32x16 __attribute__((ext_vector_type(16)));
typedef float f32x4 __attribute__((ext_vector_type(4)));
typedef unsigned u32x4 __attribute__((ext_vector_type(4)));
typedef unsigned u32x2 __attribute__((ext_vector_type(2)));

constexpr int D = 2048, NCTX = 4096, NLAT = 16384, MTOK = 20480, MALL = 21504;
constexpr int CB = 16, CL = 256, LB = 4, LL = 4096, PAST = 256;
constexpr int IN_COLS = 18512, MIX_COLS = 10320, GATE_COLS = 8192;
constexpr int C_MLQ = 0, C_MLK = 1024, C_MLV = 2048, C_MLO = 3072, C_MLIF = 4096, C_MQ = 4112, C_KVA = 5648, C_S5U = 6224, C_DFQ = 7248, C_DFK = 8272, C_DFV = 9296;
constexpr int FFN = 5632;
constexpr int KVAW = 768;

constexpr size_t MiB = 1u << 20;
constexpr size_t WS_CTL = 0, CTL_BYTES = 64 * 1024;
constexpr size_t WS_MOD = 1 * MiB;
constexpr size_t WS_ROPE = WS_MOD + 512 * 1024;
constexpr size_t WS_X = 2 * MiB;
constexpr size_t WS_H = 162 * MiB;
constexpr size_t WS_HF = 242 * MiB;
constexpr size_t WS_HB = 282 * MiB;
constexpr size_t WS_MLQ = 322 * MiB;
constexpr size_t WS_S5U = 362 * MiB;
constexpr size_t WS_DFQ = 402 * MiB;
constexpr size_t WS_MLK = 442 * MiB;
constexpr size_t WS_MLV = 482 * MiB;
constexpr size_t WS_MLO = 522 * MiB;
constexpr size_t WS_MQ = 562 * MiB;
constexpr size_t WS_KVA = 622 * MiB;
constexpr size_t WS_DFK = 682 * MiB;
constexpr size_t WS_DFV = 724 * MiB;
constexpr size_t WS_CKVN = 766 * MiB;
constexpr size_t WS_KFULL = 787 * MiB;
constexpr size_t WS_VFULL = 850 * MiB;
constexpr size_t WS_GATES = 892 * MiB;
constexpr size_t WS_CT = 894 * MiB;
constexpr size_t WS_WBF = 934 * MiB;
constexpr size_t WS_GS = 442 * MiB;
constexpr size_t WS_FFNH = 442 * MiB;
constexpr size_t WS_DFO = 442 * MiB;
constexpr size_t WS_YS5F = 442 * MiB;
constexpr size_t WS_END = 1101 * MiB;

constexpr size_t O_YP = 0, O_YS = 8388608, O_CKV = 41943040, O_KR = 46137344, O_DK = 46661632, O_DV = 55050240,
                 O_MC = 63438848, O_MN = 80216064, O_MM = 80281600, O_SR = 80281856, O_SI = 80544000, O_END = 80806144;

__device__ __forceinline__ unsigned f2bf(float f) { unsigned u = __builtin_bit_cast(unsigned, f); return (u + 0x7fffu + ((u >> 16) & 1u)) >> 16; }
__device__ __forceinline__ float bf2f(unsigned b) { return __builtin_bit_cast(float, (b & 0xffffu) << 16); }
__device__ __forceinline__ unsigned pk2(float lo, float hi) { return f2bf(lo) | (f2bf(hi) << 16); }
__device__ __forceinline__ float wave_sum(float v) {
#pragma unroll
    for (int o = 1; o < 64; o <<= 1) v += __shfl_xor(v, o);
    return v;
}
__device__ __forceinline__ float wave_max(float v) {
#pragma unroll
    for (int o = 1; o < 64; o <<= 1) v = fmaxf(v, __shfl_xor(v, o));
    return v;
}
__device__ __forceinline__ float sigmoidf_(float x) { return 1.0f / (1.0f + __expf(-x)); }
__device__ __forceinline__ float siluf_(float x) { return x / (1.0f + __expf(-x)); }
__device__ __forceinline__ float gelu_tanh(float x) { const float u = 0.7978845608028654f * (x + 0.044715f * x * x * x); const float t = 1.0f - 2.0f / (1.0f + __expf(2.0f * u)); return 0.5f * x * (1.0f + t); }
__device__ __forceinline__ void sincos_small(float x, float& s, float& c) {
    const float k = rintf(x * 0.6366197723675814f);
    float r = fmaf(-k, 1.5707962513e+0f, x); r = fmaf(-k, 7.5497894159e-8f, r); r = fmaf(-k, 5.3903029534e-15f, r);
    const float r2 = r * r;
    const float sp = r + r * r2 * (-1.6666654611e-1f + r2 * (8.3321608736e-3f + r2 * (-1.9515295891e-4f)));
    const float cp = 1.0f - 0.5f * r2 + r2 * r2 * (4.166664568298827e-2f + r2 * (-1.388731625493765e-3f + r2 * 2.443315711809948e-5f));
    const int q = ((int)k) & 3;
    s = (q == 0) ? sp : (q == 1) ? cp : (q == 2) ? -sp : -cp;
    c = (q == 0) ? cp : (q == 1) ? -sp : (q == 2) ? -cp : sp;
}
__device__ __forceinline__ int cond_of_row(int r) { return r < NCTX ? 0 : 1 + ((r - NCTX) >> 12); }

struct P {
    const float* in[38];
    float* out;
    unsigned char* ws;
};
__device__ __forceinline__ const float* x_src(const P& p, int l, int r) {
    if (l == 0) return r < NCTX ? p.in[0] + (size_t)r * D : p.in[1] + (size_t)(r - NCTX) * D;
    return (const float*)(p.ws + WS_X) + (size_t)r * D;
}


#define XB_TMO      128
#define XB_XCNT(j)  (256  + 64 * (j))
#define XB_XSUB(j)  (1280 + 64 * (j))
#define XB_XGEN(j)  (2304 + 64 * (j))
#define XB_TOP      3328
#define XB_TOPGEN   3392
#define XCD_BAR_WORDS 3456
#define XB_SPIN_CAP (1u << 22)
#define LAS __attribute__((address_space(3)))

__device__ __forceinline__ unsigned xb_ld(unsigned* p)              { return __hip_atomic_load(p, __ATOMIC_RELAXED, __HIP_MEMORY_SCOPE_AGENT); }
__device__ __forceinline__ unsigned xb_add(unsigned* p, unsigned v) { return __hip_atomic_fetch_add(p, v, __ATOMIC_RELAXED, __HIP_MEMORY_SCOPE_AGENT); }
__device__ __forceinline__ unsigned xb_xcc_id() { return (unsigned)__builtin_amdgcn_s_getreg((3 << 11) | 20) & 0xFu; }
#define XB_SPIN(cond, bar) do { unsigned _sp = 0; while (cond) { __builtin_amdgcn_s_sleep(1); \
    if ((++_sp & 255u) == 0u) { if (xb_ld(&(bar)[XB_TMO])) break; if (_sp > XB_SPIN_CAP) { atomicAdd(&(bar)[XB_TMO], 1u); break; } } } } while (0)

__device__ __forceinline__ unsigned lane_id_() { return __builtin_amdgcn_mbcnt_hi(~0u, __builtin_amdgcn_mbcnt_lo(~0u, 0u)); }
struct XcdBarrier {
    unsigned* bar; unsigned x; unsigned w;
    volatile LAS unsigned* st;
};
__device__ __forceinline__ XcdBarrier xcd_barrier_post(unsigned* bar, volatile LAS unsigned* st) {
    XcdBarrier b; b.bar = bar; b.x = xb_xcc_id(); b.st = st; b.w = (unsigned)__builtin_amdgcn_readfirstlane(threadIdx.x >> 6);
    if (threadIdx.x == 0) (void)xb_add(&bar[XB_XCNT(b.x)], 1u);
    return b;
}
__device__ __forceinline__ void xcd_barrier_complete(unsigned* bar, unsigned x, unsigned& nloc, unsigned& nx) {
    const unsigned G = gridDim.x * gridDim.y * gridDim.z;
    unsigned sum, cnt, mine, sp = 0u;
    for (;;) {
        sum = 0u; cnt = 0u; mine = 0u;
#pragma unroll
        for (unsigned j = 0; j < 16; ++j) { const unsigned c = xb_ld(&bar[XB_XCNT(j)]); sum += c; cnt += (c > 0u) ? 1u : 0u; mine = (j == x) ? c : mine; }
        if (sum == G) break;
        __builtin_amdgcn_s_sleep(1);
        if ((++sp & 255u) == 0u) { if (xb_ld(&bar[XB_TMO])) break; if (sp > XB_SPIN_CAP) { atomicAdd(&bar[XB_TMO], 1u); break; } }
    }
    nloc = mine > 0u ? mine : 1u; nx = cnt > 0u ? cnt : 1u;
}
__device__ __forceinline__ void xcd_barrier(const XcdBarrier& b) {
    asm volatile("s_waitcnt vmcnt(0)" ::: "memory");
    __syncthreads();
    if (b.w == 0u && lane_id_() == 0u) {
        unsigned* bar = b.bar;
        __builtin_amdgcn_s_waitcnt(0);
        unsigned nloc = b.st[0], nx = b.st[1];
        if (nloc == 0u) { xcd_barrier_complete(bar, b.x, nloc, nx); b.st[0] = nloc; b.st[1] = nx; }
        const unsigned old = xb_add(&bar[XB_XSUB(b.x)], 1u);
        const unsigned gen = old / nloc;
        if (old + 1u == (gen + 1u) * nloc) {
            __builtin_amdgcn_fence(__ATOMIC_RELEASE, "agent");
            asm volatile("s_waitcnt vmcnt(0)" ::: "memory");
            const unsigned og = xb_add(&bar[XB_TOP], 1u);
            const unsigned tg = og / nx;
            if (og + 1u == (tg + 1u) * nx) xb_add(&bar[XB_TOPGEN], 1u);
            else XB_SPIN(xb_ld(&bar[XB_TOPGEN]) == tg, bar);
            __builtin_amdgcn_fence(__ATOMIC_ACQUIRE, "agent");
            xb_add(&bar[XB_XGEN(b.x)], 1u);
            asm volatile("s_waitcnt vmcnt(0)" ::: "memory");
        } else {
            XB_SPIN(xb_ld(&bar[XB_XGEN(b.x)]) == gen, bar);
            __builtin_amdgcn_fence(__ATOMIC_ACQUIRE, "agent");
            asm volatile("s_waitcnt vmcnt(0)" ::: "memory");
        }
    }
    __syncthreads();
}


__device__ __forceinline__ void ph_mod(const P& p, int vblk, bool active, int tid, float* sc) {
    for (int i = tid; i < 5 * 2048; i += 256) { const int c = i >> 11, k = i & 2047; const float v = c == 0 ? p.in[12][k] : p.in[11][(c - 1) * 2048 + k]; sc[i] = siluf_(v); }
    __syncthreads();
    const int idx = vblk * 256 + tid;
    if (active && idx < 2 * 12288) {
        const int l = idx / 12288, n = idx % 12288;
        const float* w = p.in[13] + (size_t)l * 2048 * 12288 + n;
        float a0 = 0, a1 = 0, a2 = 0, a3 = 0, a4 = 0;
        for (int k = 0; k < 2048; ++k) { const float wv = w[(size_t)k * 12288]; a0 += sc[k] * wv; a1 += sc[2048 + k] * wv; a2 += sc[4096 + k] * wv; a3 += sc[6144 + k] * wv; a4 += sc[8192 + k] * wv; }
        const float b = p.in[14][l * 12288 + n];
        float* mod = (float*)(p.ws + WS_MOD) + (size_t)l * 5 * 12288 + n;
        mod[0] = a0 + b; mod[12288] = a1 + b; mod[2 * 12288] = a2 + b; mod[3 * 12288] = a3 + b; mod[4 * 12288] = a4 + b;
    }
    if (active && vblk == 0) {
        float* rt = (float*)(p.ws + WS_ROPE);
        for (int i = tid; i < 1024; i += 256) { const int pos = i >> 4, j = i & 15; const float inv = exp2f(-(float)j * (13.287712379549449f / 16.0f)); float s, c; sincos_small((float)pos * inv, s, c); rt[i] = c; rt[1024 + i] = s; }
    }
}

__device__ __forceinline__ void ph_hnorm_row(const P& p, int l, int which, int r, int lane) {
    const float* x = which == 0 ? x_src(p, l, r) : (const float*)(p.ws + WS_X) + (size_t)r * D;
    const float* nw = p.in[which == 0 ? 15 : 16] + l * 2048;
    const float* mod = (const float*)(p.ws + WS_MOD) + ((size_t)l * 5 + cond_of_row(r)) * 12288 + (which == 0 ? 0 : 3 * 2048);
    f32x4 v[8]; float ss = 0.f;
#pragma unroll
    for (int j = 0; j < 8; ++j) { v[j] = *(const f32x4*)(x + j * 256 + lane * 4); ss += v[j][0] * v[j][0] + v[j][1] * v[j][1] + v[j][2] * v[j][2] + v[j][3] * v[j][3]; }
    const float rstd = rsqrtf(wave_sum(ss) * (1.0f / 2048.0f) + 1e-6f);
    bf16_t* o = (bf16_t*)(p.ws + WS_H) + (size_t)r * D;
#pragma unroll
    for (int j = 0; j < 8; ++j) { const int c = j * 256 + lane * 4; const f32x4 g = *(const f32x4*)(nw + c), sh = *(const f32x4*)(mod + c), s1 = *(const f32x4*)(mod + 2048 + c);
        float y[4];
#pragma unroll
        for (int e = 0; e < 4; ++e) y[e] = v[j][e] * rstd * g[e] * (1.0f + s1[e]) + sh[e];
        u32x2 w; w.x = pk2(y[0], y[1]); w.y = pk2(y[2], y[3]); *(u32x2*)(o + c) = w; }
}

template <class Epi, bool FFNMAP>
__device__ __forceinline__ void gemm_tile(const bf16_t* A, int lda, const float* W, int ldw, int ncols, int K, int tm, int tn, bool active, const Epi& E, int tid, bf16_t* As, bf16_t* Bs) {
    const int lane = tid & 63, wid = tid >> 6, wm = wid >> 1, wn = wid & 1, r32 = lane & 31, hi = lane >> 5;
    f32x16 acc[2][2];
#pragma unroll
    for (int a = 0; a < 2; ++a)
#pragma unroll
        for (int b = 0; b < 2; ++b)
#pragma unroll
            for (int r = 0; r < 16; ++r) acc[a][b][r] = 0.f;
    const int arow = tid >> 1, acol = (tid & 1) * 16;
    const bf16_t* ap = A + (size_t)(tm * 128 + arow) * lda + acol;
    const int bk = tid >> 5, bn = (tid & 31) * 4;
    int wcol;
    { const int nv = tn * 128 + bn; wcol = FFNMAP ? (((nv >> 5) & 1) * FFN + (nv >> 6) * 32 + (nv & 31)) : nv; }
    const bool bvalid = wcol < ncols;
    for (int k0 = 0; k0 < K; k0 += 32) {
        const u32x4 a0 = *(const u32x4*)(ap + k0), a1 = *(const u32x4*)(ap + k0 + 8);
        f32x4 bv[4];
#pragma unroll
        for (int i = 0; i < 4; ++i) bv[i] = bvalid ? *(const f32x4*)(W + (size_t)(k0 + bk + 8 * i) * ldw + wcol) : (f32x4){0.f, 0.f, 0.f, 0.f};
        __syncthreads();
        *(u32x4*)(As + arow * 40 + acol) = a0; *(u32x4*)(As + arow * 40 + acol + 8) = a1;
#pragma unroll
        for (int i = 0; i < 4; ++i)
#pragma unroll
            for (int e = 0; e < 4; ++e) Bs[(bn + e) * 40 + bk + 8 * i] = (bf16_t)f2bf(bv[i][e]);
        __syncthreads();
#pragma unroll
        for (int ks = 0; ks < 2; ++ks) {
            bf16x8 af[2], bfr[2];
#pragma unroll
            for (int mi = 0; mi < 2; ++mi) af[mi] = *(const bf16x8*)(As + (wm * 64 + mi * 32 + r32) * 40 + ks * 16 + hi * 8);
#pragma unroll
            for (int ni = 0; ni < 2; ++ni) bfr[ni] = *(const bf16x8*)(Bs + (wn * 64 + ni * 32 + r32) * 40 + ks * 16 + hi * 8);
#pragma unroll
            for (int mi = 0; mi < 2; ++mi)
#pragma unroll
                for (int ni = 0; ni < 2; ++ni) acc[mi][ni] = __builtin_amdgcn_mfma_f32_32x32x16_bf16(af[mi], bfr[ni], acc[mi][ni], 0, 0, 0);
        }
    }
    if (active) E(acc, tm * 128 + wm * 64, tn * 128 + wn * 64, r32, hi);
}
template <class Epi, bool FFNMAP>
__device__ __forceinline__ void gemm_phase_simple(int tid_, unsigned char* lds, const bf16_t* A, int lda, int M, const float* W, int ldw, int ncols, int nvirt, int K, const Epi& E) {
    const int half = tid_ >> 8, vt = tid_ & 255, ntm = M / 128, ntn = (nvirt + 127) / 128, nt = ntm * ntn, nvb = 2 * gridDim.x;
    bf16_t* As = (bf16_t*)(lds + half * 32768); bf16_t* Bs = As + 128 * 40;
    for (int base = 0; base < nt; base += nvb) {
        const int tile = base + blockIdx.x * 2 + half; const bool active = tile < nt; const int t = active ? tile : nt - 1;
        gemm_tile<Epi, FFNMAP>(A, lda, W, ldw, ncols, K, t / ntn, t % ntn, active, E, vt, As, Bs);
        __syncthreads();
    }
}
#define FOR_ACC(...) _Pragma("unroll") for (int mi = 0; mi < 2; ++mi) _Pragma("unroll") for (int ni = 0; ni < 2; ++ni) _Pragma("unroll") for (int r = 0; r < 16; ++r) { \
    const int m = m0 + mi * 32 + (r & 3) + 8 * (r >> 2) + 4 * hi, n = n0 + ni * 32 + r32; const float v = acc[mi][ni][r]; __VA_ARGS__ }
struct EpiIn {
    unsigned char* ws;
    __device__ __forceinline__ void operator()(const f32x16 (&acc)[2][2], int m0, int n0, int r32, int hi) const {
        FOR_ACC({
            if (n < C_MLK) ((bf16_t*)(ws + WS_MLQ))[(size_t)m * 1024 + n] = (bf16_t)f2bf(v);
            else if (n < C_MLV) ((bf16_t*)(ws + WS_MLK))[(size_t)m * 1024 + n - C_MLK] = (bf16_t)f2bf(v * 0.0625f);
            else if (n < C_MLO) ((bf16_t*)(ws + WS_MLV))[(size_t)m * 1024 + n - C_MLV] = (bf16_t)f2bf(v);
            else if (n < C_MLIF) ((bf16_t*)(ws + WS_MLO))[(size_t)m * 1024 + n - C_MLO] = (bf16_t)f2bf(sigmoidf_(v));
            else if (n < C_MQ) ((float*)(ws + WS_KVA))[(size_t)m * KVAW + 576 + n - C_MLIF] = v;
            else if (n < C_KVA) ((bf16_t*)(ws + WS_MQ))[(size_t)m * 1536 + n - C_MQ] = (bf16_t)f2bf(v);
            else if (n < C_S5U) ((float*)(ws + WS_KVA))[(size_t)m * KVAW + n - C_KVA] = v;
            else if (n < C_DFQ) ((bf16_t*)(ws + WS_S5U))[(size_t)m * 1024 + n - C_S5U] = (bf16_t)f2bf(v);
            else if (n < C_DFK) ((bf16_t*)(ws + WS_DFQ))[(size_t)m * 1024 + n - C_DFQ] = (bf16_t)f2bf(v);
            else if (n < C_DFV) ((bf16_t*)(ws + WS_DFK))[(size_t)m * 1024 + n - C_DFK] = (bf16_t)f2bf(v);
            else if (n < MIX_COLS) ((bf16_t*)(ws + WS_DFV))[(size_t)m * 1024 + n - C_DFV] = (bf16_t)f2bf(v);
        })
    }
};
struct EpiGate {
    bf16_t* gs;
    __device__ __forceinline__ void operator()(const f32x16 (&acc)[2][2], int m0, int n0, int r32, int hi) const {
        FOR_ACC({ gs[(size_t)m * GATE_COLS + n] = (bf16_t)f2bf(sigmoidf_(v)); })
    }
};
struct EpiKvb {
    bf16_t* kf; bf16_t* vf;
    __device__ __forceinline__ void operator()(const f32x16 (&acc)[2][2], int m0, int n0, int r32, int hi) const {
        FOR_ACC({ const int h = n >> 8, j = n & 255;
            if (j < 128) kf[(size_t)m * 1536 + h * 192 + j] = (bf16_t)f2bf(v); else vf[(size_t)m * 1024 + h * 128 + j - 128] = (bf16_t)f2bf(v); })
    }
};
struct EpiGlu {
    const bf16_t* g; bf16_t* y;
    __device__ __forceinline__ void operator()(const f32x16 (&acc)[2][2], int m0, int n0, int r32, int hi) const {
        FOR_ACC({ const size_t i = (size_t)m * 1024 + n; y[i] = (bf16_t)f2bf(bf2f(g[i]) * sigmoidf_(v)); })
    }
};
struct EpiMerge {
    const bf16_t* gs; bf16_t* mg; int b; int pad;
    __device__ __forceinline__ void operator()(const f32x16 (&acc)[2][2], int m0, int n0, int r32, int hi) const {
        FOR_ACC({ const size_t i = (size_t)m * D + n; const float prev = b ? bf2f(mg[i]) : 0.f; mg[i] = (bf16_t)f2bf(prev + bf2f(gs[(size_t)m * GATE_COLS + b * D + n]) * v); })
    }
};
struct EpiRes {
    P p; int l; int goff;
    int from_x; int pad;
    __device__ __forceinline__ void operator()(const f32x16 (&acc)[2][2], int m0, int n0, int r32, int hi) const {
        float* X = (float*)(p.ws + WS_X);
        FOR_ACC({ const float* src = from_x ? X + (size_t)m * D : x_src(p, l, m);
            const float g = ((const float*)(p.ws + WS_MOD))[((size_t)l * 5 + cond_of_row(m)) * 12288 + goff + n];
            X[(size_t)m * D + n] = src[n] + g * v; })
    }
};
struct EpiFfnIn {
    bf16_t* hh;
    __device__ __forceinline__ void operator()(const f32x16 (&acc)[2][2], int m0, int n0, int r32, int hi) const {
#pragma unroll
        for (int mi = 0; mi < 2; ++mi)
#pragma unroll
            for (int r = 0; r < 16; ++r) { const int m = m0 + mi * 32 + (r & 3) + 8 * (r >> 2) + 4 * hi, i = (n0 >> 6) * 32 + r32;
                hh[(size_t)m * FFN + i] = (bf16_t)f2bf(siluf_(acc[mi][0][r]) * acc[mi][1][r]); }
    }
};

namespace pg8 {
#define PG8_LAS __attribute__((address_space(3)))
typedef unsigned short bf16_t;
typedef short bf16x8 __attribute__((ext_vector_type(8)));
typedef float f32x4 __attribute__((ext_vector_type(4)));
typedef unsigned u32x4 __attribute__((ext_vector_type(4)));
constexpr int BM = 256, BK = 64, HALF = 128, HTB = HALF * BK * 2  , STAGE_BYTES = 8 * HTB, NXCD = 8, WGM = 8;

__host__ __device__ __forceinline__ int lds_byte(int r, int c) { const int st = (r >> 4) * 2 + (c >> 5), rr = r & 15, cc = c & 31, ob = rr * 64 + cc * 2; return st * 1024 + (ob ^ (((ob >> 9) & 1) << 5)); }
__host__ __device__ __forceinline__ void stage_rc(int b, int& R, int& C) { const int st = b / 1024, sb = b % 1024, swz = sb ^ (((sb >> 9) & 1) << 5); R = (st >> 1) * 16 + swz / 64; C = (st & 1) * 32 + (swz % 64) / 2; }
__host__ __device__ __forceinline__ int perm32(int rho) { const int n = rho >> 4, i = rho & 15; return 8 * (i >> 2) + 4 * n + (i & 3); }

struct Unit { int pm, pn; };
struct Gemm { const bf16_t* A; const bf16_t* Bt; int M, N, K; };

struct StaticOrder {
    int nM, nN, nwg, G, c;
    __host__ __device__ void init(int M, int N, int G_, int c_) { nM = M / BM; nN = N / BM; nwg = nM * nN; G = G_; c = c_; }
    __host__ __device__ bool next(int i, Unit& u) const {
        const long L = (long)i * G + c; if (L >= nwg) return false;
        int wgid = (int)L; { const int q = nwg / NXCD, r = nwg % NXCD, xcd = wgid % NXCD, off = wgid / NXCD; wgid = (xcd < r ? xcd * (q + 1) : r * (q + 1) + (xcd - r) * q) + off; }
        const int nig = WGM * nN, gid = wgid / nig, fm = gid * WGM, gsz = (nM - fm) < WGM ? (nM - fm) : WGM;
        u.pm = fm + ((wgid % nig) % gsz); u.pn = (wgid % nig) / gsz; return true;
    }
    __device__ __forceinline__ void a_ready(const Unit&) const {}
    __device__ __forceinline__ void done(const Unit&) const {}
};

__device__ __forceinline__ unsigned cvt_pk_bf16(float lo, float hi) { unsigned r; asm volatile("v_cvt_pk_bf16_f32 %0, %1, %2" : "=v"(r) : "v"(lo), "v"(hi)); return r; }

template <class Epi, class Sched, bool ALIGN_EPI = false, bool SP2 = false>
__device__ __forceinline__ void gemm_phase(PG8_LAS unsigned char* lds, const Gemm g, const Sched& S, const Epi& E, int tid_in) {
    int tid_l = tid_in; asm volatile("" : "+v"(tid_l));
    const int tid = tid_l, wid = __builtin_amdgcn_readfirstlane(tid >> 6), lane = tid & 63, wr = wid >> 2, wc = wid & 3, fr = lane & 15, fq = lane >> 4;
    const int K = g.K, nt = K / BK;
    unsigned voffA[2], voffB[2];
#pragma unroll
    for (int i = 0; i < 2; ++i) { int R, C; stage_rc(tid * 16 + i * 8192, R, C); const int Rb = Epi::PERM ? ((R & ~31) + perm32(R & 31)) : R;
        voffA[i] = (unsigned)(R * K + C) * 2u; voffB[i] = (unsigned)(Rb * K + C) * 2u; }
    const size_t kstep = (size_t)(BK * 2);
    const size_t hstep = (size_t)HALF * K * 2;
    const size_t tstep = 2 * hstep;
    const unsigned ldsw = (unsigned)wid * 1024u;
    const int aoff = lds_byte(wr * 64 + fr, fq * 8), boff = lds_byte(wc * 32 + fr, fq * 8);
#define PG8_SA(b, h) (((b) * 2 + (h)) * HTB)
#define PG8_SB(b, h) ((4 + (b) * 2 + (h)) * HTB)
#define PG8_STAGE(bufoff, gbase, voff) do { _Pragma("unroll") for (int _i = 0; _i < 2; ++_i) \
        __builtin_amdgcn_global_load_lds((const unsigned*)((const char*)(gbase) + (voff)[_i]), (PG8_LAS unsigned*)(lds + (bufoff) + ldsw + _i * 8192), 16, 0, 0); } while (0)
#define PG8_LDA(dst, b, h) do { _Pragma("unroll") for (int m = 0; m < 4; ++m) _Pragma("unroll") for (int k = 0; k < 2; ++k) dst[m][k] = *(const PG8_LAS bf16x8*)(lds + PG8_SA(b, h) + aoff + m * 2048 + k * 1024); } while (0)
#define PG8_LDB(dst, b, h) do { _Pragma("unroll") for (int n = 0; n < 2; ++n) _Pragma("unroll") for (int k = 0; k < 2; ++k) dst[n][k] = *(const PG8_LAS bf16x8*)(lds + PG8_SB(b, h) + boff + n * 2048 + k * 1024); } while (0)
#define PG8_MMA(ai, bj, At, Bt) do { __builtin_amdgcn_s_setprio(1); _Pragma("unroll") for (int m = 0; m < 4; ++m) _Pragma("unroll") for (int n = 0; n < 2; ++n) _Pragma("unroll") for (int k = 0; k < 2; ++k) \
        acc[ai][bj][m][n] = __builtin_amdgcn_mfma_f32_16x16x32_bf16(Bt[n][k], At[m][k], acc[ai][bj][m][n], 0, 0, 0); __builtin_amdgcn_s_setprio(0); } while (0)
#define PG8_WAIT_V(n) asm volatile("s_waitcnt vmcnt(" #n ")" ::: "memory")
#define PG8_WAIT_L(n) asm volatile("s_waitcnt lgkmcnt(" #n ")" ::: "memory")
#define PG8_BAR __builtin_amdgcn_s_barrier()
#define PG8_SCHED __builtin_amdgcn_sched_barrier(0)
    Unit cur, nxt; int ui = 0;
    if (!S.next(0, cur)) return;
    f32x4 acc[2][2][4][2];
    { float z0 = 0.f; asm volatile("" : "+v"(z0));
#pragma unroll
    for (int a = 0; a < 2; ++a)
#pragma unroll
        for (int b = 0; b < 2; ++b)
#pragma unroll
            for (int m = 0; m < 4; ++m)
#pragma unroll
                for (int n = 0; n < 2; ++n) acc[a][b][m][n] = (f32x4){z0, z0, z0, z0}; }
    bf16x8 At[4][2], B0[2][2], B1[2][2];
    const char* cA = (const char*)g.A + (size_t)cur.pm * tstep; const char* cB = (const char*)g.Bt + (size_t)cur.pn * tstep;
    S.a_ready(cur);
    if constexpr (SP2) {
        PG8_STAGE(PG8_SB(0, 0), cB, voffB); PG8_STAGE(PG8_SB(0, 1), cB + hstep, voffB); PG8_STAGE(PG8_SA(0, 0), cA, voffA); PG8_STAGE(PG8_SA(0, 1), cA + hstep, voffA);
        if (wr == 1) PG8_BAR;
        PG8_WAIT_V(2); PG8_BAR;
        PG8_STAGE(PG8_SB(1, 0), cB + kstep, voffB); PG8_STAGE(PG8_SA(1, 0), cA + kstep, voffA); PG8_STAGE(PG8_SB(1, 1), cB + hstep + kstep, voffB);
        PG8_WAIT_V(6); PG8_BAR;
    } else {
        PG8_STAGE(PG8_SB(0, 0), cB, voffB); PG8_STAGE(PG8_SA(0, 0), cA, voffA); PG8_STAGE(PG8_SB(0, 1), cB + hstep, voffB); PG8_STAGE(PG8_SA(0, 1), cA + hstep, voffA);
        if (wr == 1) PG8_BAR;
        PG8_WAIT_V(4); PG8_BAR;
        PG8_STAGE(PG8_SB(1, 0), cB + kstep, voffB); PG8_STAGE(PG8_SA(1, 0), cA + kstep, voffA); PG8_STAGE(PG8_SB(1, 1), cB + hstep + kstep, voffB);
        PG8_WAIT_V(6); PG8_BAR;
    }
    for (;;) {
        const bool has_next = S.next(ui + 1, nxt);
        const char* nA = has_next ? (const char*)g.A + (size_t)nxt.pm * tstep : cA; const char* nB = has_next ? (const char*)g.Bt + (size_t)nxt.pn * tstep : cB;
        for (int t = 0; t < nt; t += 2) {
            const bool last = (t == nt - 2);
            const char* a1 = cA + (size_t)(t + 1) * kstep;
            const char* a2 = last ? nA : cA + (size_t)(t + 2) * kstep; const char* b2 = last ? nB : cB + (size_t)(t + 2) * kstep;
            const char* a3 = a2 + kstep; const char* b3 = b2 + kstep;
            if (last && has_next) S.a_ready(nxt);
            if constexpr (SP2) {
            PG8_LDB(B0, 0, 0); PG8_LDB(B1, 0, 1); PG8_SCHED; PG8_LDA(At, 0, 0); PG8_STAGE(PG8_SA(1, 1), a1 + hstep, voffA);
            PG8_WAIT_V(8); PG8_WAIT_L(0); PG8_BAR; PG8_MMA(0, 0, At, B0); PG8_MMA(0, 1, At, B1); PG8_BAR; PG8_SCHED;
            PG8_LDA(At, 0, 1); PG8_STAGE(PG8_SB(0, 0), b2, voffB); PG8_STAGE(PG8_SB(0, 1), b2 + hstep, voffB); PG8_STAGE(PG8_SA(0, 0), a2, voffA);
            PG8_WAIT_V(8); PG8_WAIT_L(0); PG8_BAR; PG8_MMA(1, 0, At, B0); PG8_MMA(1, 1, At, B1); PG8_BAR; PG8_SCHED;
            PG8_LDB(B0, 1, 0); PG8_LDB(B1, 1, 1); PG8_SCHED; PG8_LDA(At, 1, 0); PG8_STAGE(PG8_SA(0, 1), a2 + hstep, voffA);
            PG8_WAIT_V(8); PG8_WAIT_L(0); PG8_BAR; PG8_MMA(0, 0, At, B0); PG8_MMA(0, 1, At, B1); PG8_BAR; PG8_SCHED;
            PG8_LDA(At, 1, 1); PG8_STAGE(PG8_SB(1, 0), b3, voffB); PG8_STAGE(PG8_SB(1, 1), b3 + hstep, voffB); PG8_STAGE(PG8_SA(1, 0), a3, voffA);
            PG8_WAIT_V(8); PG8_WAIT_L(0); PG8_BAR; PG8_MMA(1, 0, At, B0); PG8_MMA(1, 1, At, B1); PG8_BAR; PG8_SCHED;
            } else {
            PG8_LDB(B0, 0, 0); PG8_SCHED; PG8_LDA(At, 0, 0); PG8_STAGE(PG8_SA(1, 1), a1 + hstep, voffA);
            PG8_WAIT_L(8); PG8_BAR; PG8_WAIT_L(0); PG8_MMA(0, 0, At, B0); PG8_BAR; PG8_SCHED;
            PG8_LDB(B1, 0, 1); PG8_STAGE(PG8_SB(0, 0), b2, voffB);
            PG8_BAR; PG8_WAIT_L(0); PG8_MMA(0, 1, At, B1); PG8_BAR;
            PG8_LDA(At, 0, 1); PG8_STAGE(PG8_SA(0, 0), a2, voffA);
            PG8_BAR; PG8_WAIT_L(0); PG8_MMA(1, 0, At, B0); PG8_BAR; PG8_SCHED;
            PG8_STAGE(PG8_SB(0, 1), b2 + hstep, voffB);
            PG8_WAIT_V(6); PG8_BAR; PG8_MMA(1, 1, At, B1); PG8_BAR;
            PG8_LDB(B0, 1, 0); PG8_SCHED; PG8_LDA(At, 1, 0); PG8_STAGE(PG8_SA(0, 1), a2 + hstep, voffA);
            PG8_WAIT_L(8); PG8_BAR; PG8_WAIT_L(0); PG8_MMA(0, 0, At, B0); PG8_BAR; PG8_SCHED;
            PG8_LDB(B1, 1, 1); PG8_STAGE(PG8_SB(1, 0), b3, voffB);
            PG8_BAR; PG8_WAIT_L(0); PG8_MMA(0, 1, At, B1); PG8_BAR;
            PG8_LDA(At, 1, 1); PG8_STAGE(PG8_SA(1, 0), a3, voffA);
            PG8_BAR; PG8_WAIT_L(0); PG8_MMA(1, 0, At, B0); PG8_BAR; PG8_SCHED;
            PG8_STAGE(PG8_SB(1, 1), b3 + hstep, voffB);
            PG8_WAIT_V(6); PG8_BAR; PG8_MMA(1, 1, At, B1); PG8_BAR;
            }
        }
        if constexpr (ALIGN_EPI) { if (wr == 0) PG8_BAR; }
        if constexpr (!Epi::AFTER_DRAIN) { E(acc, cur, wr, wc, fr, fq); S.done(cur); }
        if (!has_next) break;
        { float z0 = 0.f; asm volatile("" : "+v"(z0));
#pragma unroll
        for (int a = 0; a < 2; ++a)
#pragma unroll
            for (int b = 0; b < 2; ++b)
#pragma unroll
                for (int m = 0; m < 4; ++m)
#pragma unroll
                    for (int n = 0; n < 2; ++n) acc[a][b][m][n] = (f32x4){z0, z0, z0, z0}; }
        cur = nxt; cA = nA; cB = nB; ++ui;
        if constexpr (ALIGN_EPI) { if (wr == 1) PG8_BAR; }
    }
    PG8_WAIT_V(0);
    if constexpr (!ALIGN_EPI) { if (wr == 0) PG8_BAR; }
    PG8_BAR;
    if constexpr (Epi::AFTER_DRAIN) { E.fused(acc, cur, wr, wc, fr, fq, lds, wid, lane); S.done(cur); }
#undef PG8_SA
#undef PG8_SB
#undef PG8_STAGE
#undef PG8_LDA
#undef PG8_LDB
#undef PG8_MMA
#undef PG8_WAIT_V
#undef PG8_WAIT_L
#undef PG8_BAR
#undef PG8_SCHED
}
}

#define PG8_ROW(ai, m) (u.pm * 256 + (ai) * 128 + wr * 64 + (m) * 16 + fr)
#define PG8_FOR(...) _Pragma("unroll") for (int ai = 0; ai < 2; ++ai) _Pragma("unroll") for (int m = 0; m < 4; ++m) { const int row = PG8_ROW(ai, m); _Pragma("unroll") for (int bj = 0; bj < 2; ++bj) { \
    const int ct = bj * 128 + wc * 32 + 8 * fq; const pg8::f32x4 v0 = acc[ai][bj][m][0], v1 = acc[ai][bj][m][1]; __VA_ARGS__ } }
__device__ __forceinline__ u32x4 pack8(const pg8::f32x4& a, const pg8::f32x4& b) { u32x4 w; w.x = pg8::cvt_pk_bf16(a[0], a[1]); w.y = pg8::cvt_pk_bf16(a[2], a[3]); w.z = pg8::cvt_pk_bf16(b[0], b[1]); w.w = pg8::cvt_pk_bf16(b[2], b[3]); return w; }
__device__ __forceinline__ void unpack8(const u32x4& w, float (&f)[8]) {
#pragma unroll
    for (int i = 0; i < 4; ++i) { f[2 * i] = bf2f(w[i]); f[2 * i + 1] = bf2f(w[i] >> 16); } }

struct Epi8In {
    static constexpr bool PERM = true, AFTER_DRAIN = false;
    unsigned char* ws;
    __device__ __forceinline__ void operator()(const pg8::f32x4 (&acc)[2][2][4][2], const pg8::Unit& u, int wr, int wc, int fr, int fq) const {
        const int pn = u.pn;
        if (pn >= 22 && pn < 25) {
            float* kva = (float*)(ws + WS_KVA);
            PG8_FOR({ float* o = kva + (size_t)row * KVAW + (pn - 22) * 256 + ct; *(pg8::f32x4*)o = v0; *(pg8::f32x4*)(o + 4) = v1; })
            return;
        }
        size_t base; int ldc, c0, mode = 0;
        if (pn < 4) { base = WS_MLQ; ldc = 1024; c0 = pn * 256; }
        else if (pn < 8) { base = WS_MLK; ldc = 1024; c0 = (pn - 4) * 256; mode = 1; }
        else if (pn < 12) { base = WS_MLV; ldc = 1024; c0 = (pn - 8) * 256; }
        else if (pn < 16) { base = WS_MLO; ldc = 1024; c0 = (pn - 12) * 256; mode = 2; }
        else if (pn < 22) { base = WS_MQ; ldc = 1536; c0 = (pn - 16) * 256; }
        else if (pn < 29) { base = WS_S5U; ldc = 1024; c0 = (pn - 25) * 256; }
        else if (pn < 33) { base = WS_DFQ; ldc = 1024; c0 = (pn - 29) * 256; }
        else if (pn < 37) { base = WS_DFK; ldc = 1024; c0 = (pn - 33) * 256; }
        else { base = WS_DFV; ldc = 1024; c0 = (pn - 37) * 256; }
        bf16_t* O = (bf16_t*)(ws + base);
        PG8_FOR({ pg8::f32x4 a = v0, b = v1;
            if (mode == 1) { a = a * 0.0625f; b = b * 0.0625f; }
            if (mode == 2) {
_Pragma("unroll")
                for (int e = 0; e < 4; ++e) { a[e] = sigmoidf_(a[e]); b[e] = sigmoidf_(b[e]); } }
            *(u32x4*)(O + (size_t)row * ldc + c0 + ct) = pack8(a, b); })
    }
};
struct Epi8Gate {
    static constexpr bool PERM = true, AFTER_DRAIN = false;
    bf16_t* gs;
    __device__ __forceinline__ void operator()(const pg8::f32x4 (&acc)[2][2][4][2], const pg8::Unit& u, int wr, int wc, int fr, int fq) const {
        PG8_FOR({ pg8::f32x4 a, b;
_Pragma("unroll")
            for (int e = 0; e < 4; ++e) { a[e] = sigmoidf_(v0[e]); b[e] = sigmoidf_(v1[e]); }
            *(u32x4*)(gs + (size_t)row * GATE_COLS + u.pn * 256 + ct) = pack8(a, b); })
    }
};
struct Epi8Kvb {
    static constexpr bool PERM = true, AFTER_DRAIN = false;
    bf16_t* kf; bf16_t* vf;
    __device__ __forceinline__ void operator()(const pg8::f32x4 (&acc)[2][2][4][2], const pg8::Unit& u, int wr, int wc, int fr, int fq) const {
        PG8_FOR({ bf16_t* o = bj == 0 ? kf + (size_t)row * 1536 + u.pn * 192 + wc * 32 + 8 * fq : vf + (size_t)row * 1024 + u.pn * 128 + wc * 32 + 8 * fq; (void)ct;
            *(u32x4*)o = pack8(v0, v1); })
    }
};
struct Epi8Glu {
    static constexpr bool PERM = true, AFTER_DRAIN = false;
    const bf16_t* g; bf16_t* y;
    __device__ __forceinline__ void operator()(const pg8::f32x4 (&acc)[2][2][4][2], const pg8::Unit& u, int wr, int wc, int fr, int fq) const {
        PG8_FOR({ const size_t i = (size_t)row * 1024 + u.pn * 256 + ct; float gf[8]; unpack8(*(const u32x4*)(g + i), gf); pg8::f32x4 a, b;
_Pragma("unroll")
            for (int e = 0; e < 4; ++e) { a[e] = gf[e] * sigmoidf_(v0[e]); b[e] = gf[4 + e] * sigmoidf_(v1[e]); }
            *(u32x4*)(y + i) = pack8(a, b); })
    }
};
struct Epi8Merge {
    static constexpr bool PERM = true, AFTER_DRAIN = false;
    const bf16_t* gs; bf16_t* mg; int b; int pad;
    __device__ __forceinline__ void operator()(const pg8::f32x4 (&acc)[2][2][4][2], const pg8::Unit& u, int wr, int wc, int fr, int fq) const {
        PG8_FOR({ const size_t i = (size_t)row * D + u.pn * 256 + ct; float gf[8], pf[8]; unpack8(*(const u32x4*)(gs + (size_t)row * GATE_COLS + b * D + u.pn * 256 + ct), gf);
            if (b) unpack8(*(const u32x4*)(mg + i), pf); else {
_Pragma("unroll")
                for (int e = 0; e < 8; ++e) pf[e] = 0.f; }
            pg8::f32x4 a, c;
_Pragma("unroll")
            for (int e = 0; e < 4; ++e) { a[e] = pf[e] + gf[e] * v0[e]; c[e] = pf[4 + e] + gf[4 + e] * v1[e]; }
            *(u32x4*)(mg + i) = pack8(a, c); })
    }
};
struct Epi8Res {
    static constexpr bool PERM = true, AFTER_DRAIN = false;
    P p; int l; int goff; int from_x; int pad;
    __device__ __forceinline__ void operator()(const pg8::f32x4 (&acc)[2][2][4][2], const pg8::Unit& u, int wr, int wc, int fr, int fq) const {
        float* X = (float*)(p.ws + WS_X);
        const float* gv = (const float*)(p.ws + WS_MOD) + ((size_t)l * 5 + cond_of_row(u.pm * 256)) * 12288 + goff + u.pn * 256;
        PG8_FOR({ const float* src = (from_x ? X + (size_t)row * D : x_src(p, l, row)) + u.pn * 256 + ct; float* dst = X + (size_t)row * D + u.pn * 256 + ct;
            const pg8::f32x4 g0 = *(const pg8::f32x4*)(gv + ct), g1 = *(const pg8::f32x4*)(gv + ct + 4), s0 = *(const pg8::f32x4*)src, s1 = *(const pg8::f32x4*)(src + 4);
            *(pg8::f32x4*)dst = s0 + g0 * v0; *(pg8::f32x4*)(dst + 4) = s1 + g1 * v1; })
    }
};
struct Epi8FfnIn {
    static constexpr bool PERM = true, AFTER_DRAIN = false;
    bf16_t* hh;
    __device__ __forceinline__ void operator()(const pg8::f32x4 (&acc)[2][2][4][2], const pg8::Unit& u, int wr, int wc, int fr, int fq) const {
_Pragma("unroll")
        for (int ai = 0; ai < 2; ++ai)
_Pragma("unroll")
            for (int m = 0; m < 4; ++m) { const int row = PG8_ROW(ai, m); pg8::f32x4 a, b;
_Pragma("unroll")
                for (int e = 0; e < 4; ++e) { a[e] = siluf_(acc[ai][0][m][0][e]) * acc[ai][1][m][0][e]; b[e] = siluf_(acc[ai][0][m][1][e]) * acc[ai][1][m][1][e]; }
                *(u32x4*)(hh + (size_t)row * FFN + u.pn * 128 + wc * 32 + 8 * fq) = pack8(a, b); }
    }
};

__device__ __forceinline__ int win_row(int n) {
    if (n < 4096) return n;
    if (n < 4112) return 6208 + (n - 4096);
    if (n < 5648) return 4096 + (n - 4112);
    if (n < 6224) return 5632 + (n - 5648);
    if (n < MIX_COLS) return 6400 + (n - 6224);
    return 10496 + (n - MIX_COLS);
}
template <int MAP>
__device__ __forceinline__ void cvt_item(const float* W, int K, int N, bf16_t* WT, int row_off, LAS float* scr, int item, int lane) {
    const int nblk = (N + 31) / 32, kb = item / nblk, nb = item % nblk, k0 = 64 * kb, n0 = 32 * nb;
    const int nl = (lane & 7) * 4, kr = lane >> 3;
    const bool nok = n0 + nl < N;
    const float* wp = W + (size_t)(k0 + kr) * N + n0 + nl;
    f32x4 v[8];
#pragma unroll
    for (int i = 0; i < 8; ++i) v[i] = nok ? *(const f32x4*)(wp + (size_t)(8 * i) * N) : (f32x4){0.f, 0.f, 0.f, 0.f};
#pragma unroll
    for (int i = 0; i < 8; ++i) { LAS float* d = scr + (kr + 8 * i) * 33 + nl; d[0] = v[i][0]; d[1] = v[i][1]; d[2] = v[i][2]; d[3] = v[i][3]; }
    asm volatile("s_waitcnt lgkmcnt(0)" ::: "memory");
    const int c = lane & 7;
#pragma unroll
    for (int j = 0; j < 4; ++j) { const int n = (lane >> 3) + 8 * j; const LAS float* s = scr + (8 * c) * 33 + n;
        u32x4 o; o.x = pk2(s[0 * 33], s[1 * 33]); o.y = pk2(s[2 * 33], s[3 * 33]); o.z = pk2(s[4 * 33], s[5 * 33]); o.w = pk2(s[6 * 33], s[7 * 33]);
        const int ng = n0 + n; int row;
        if (MAP == 0) row = row_off + ng; else if (MAP == 1) row = win_row(ng); else row = (ng < FFN) ? ((ng >> 7) * 256 + (ng & 127)) : (((ng - FFN) >> 7) * 256 + 128 + ((ng - FFN) & 127));
        if (ng < N) *(u32x4*)(WT + (size_t)row * K + k0 + 8 * c) = o; }
    asm volatile("s_waitcnt lgkmcnt(0)" ::: "memory");
}
constexpr size_t WB_IN = 0, WB_KVB = 73 * MiB, WB_GLU = 75 * MiB, WB_BR = 77 * MiB, WB_O = 93 * MiB, WB_FIN = 101 * MiB, WB_FOUT = 145 * MiB, WB_END = 167 * MiB;
constexpr int NIN_T = 18688;
__device__ __forceinline__ void ph_convert(const P& p, int l, int gw, int NGW, int lane, LAS float* scr) {
    unsigned char* wb = p.ws + WS_WBF;
    constexpr int I_IN = (D / 64) * ((IN_COLS + 31) / 32), I_KVB = (512 / 64) * (2048 / 32), I_GLU = (1024 / 64) * (1024 / 32), I_BR = (1024 / 64) * (2048 / 32), I_O = (D / 64) * (D / 32),
                  I_FIN = (D / 64) * (2 * FFN / 32), I_FOUT = (FFN / 64) * (D / 32);
    constexpr int NIT = I_IN + I_KVB + I_GLU + 4 * I_BR + I_O + I_FIN + I_FOUT;
    for (int it = gw; it < NIT; it += NGW) {
        int r = it;
        if (r < I_IN) { cvt_item<1>(p.in[17] + (size_t)l * D * IN_COLS, D, IN_COLS, (bf16_t*)(wb + WB_IN), 0, scr, r, lane); continue; } r -= I_IN;
        if (r < I_KVB) { cvt_item<0>(p.in[21] + (size_t)l * 512 * 2048, 512, 2048, (bf16_t*)(wb + WB_KVB), 0, scr, r, lane); continue; } r -= I_KVB;
        if (r < I_GLU) { cvt_item<0>(p.in[30] + (size_t)l * 1024 * 1024, 1024, 1024, (bf16_t*)(wb + WB_GLU), 0, scr, r, lane); continue; } r -= I_GLU;
        if (r < 4 * I_BR) { const int b = r / I_BR; cvt_item<0>(p.in[33] + ((size_t)l * 4 + b) * 1024 * 2048, 1024, 2048, (bf16_t*)(wb + WB_BR) + (size_t)b * 2048 * 1024, 0, scr, r % I_BR, lane); continue; } r -= 4 * I_BR;
        if (r < I_O) { cvt_item<0>(p.in[34] + (size_t)l * D * D, D, D, (bf16_t*)(wb + WB_O), 0, scr, r, lane); continue; } r -= I_O;
        if (r < I_FIN) { cvt_item<2>(p.in[35] + (size_t)l * D * 2 * FFN, D, 2 * FFN, (bf16_t*)(wb + WB_FIN), 0, scr, r, lane); continue; } r -= I_FIN;
        cvt_item<0>(p.in[36] + (size_t)l * FFN * D, FFN, D, (bf16_t*)(wb + WB_FOUT), 0, scr, r, lane);
    }
    for (int row = 6224 + gw; row < 6400; row += NGW) { u32x4* o = (u32x4*)((bf16_t*)(wb + WB_IN) + (size_t)row * D); for (int j = lane; j < D / 8; j += 64) o[j] = (u32x4){0u, 0u, 0u, 0u}; }
}


namespace fa {
typedef short s16x4 __attribute__((ext_vector_type(4)));
__device__ __forceinline__ int crow(int r, int hi) { return (r & 3) + 8 * (r >> 2) + 4 * hi; }
__device__ __forceinline__ unsigned cvtpk(float lo, float hi) { unsigned r; asm volatile("v_cvt_pk_bf16_f32 %0, %1, %2" : "=v"(r) : "v"(lo), "v"(hi)); return r; }
#define FA_SBAR() __builtin_amdgcn_sched_barrier(0)
constexpr float THR = 8.f;
__device__ __forceinline__ void partialSM(f32x16& p0, f32x16& p1, float& m_reg, float& mn, float& alpha, float SCALE) {
    const float C = SCALE * 1.4426950408889634f;
    float pmax = p0[0];
#pragma unroll
    for (int r = 1; r < 16; ++r) pmax = fmaxf(pmax, p0[r]);
#pragma unroll
    for (int r = 0; r < 16; ++r) pmax = fmaxf(pmax, p1[r]);
    { auto rr = __builtin_amdgcn_permlane32_swap(__float_as_uint(pmax), __float_as_uint(pmax), false, false);
      pmax = fmaxf(__uint_as_float(rr[0]), __uint_as_float(rr[1])); }
    if (__builtin_expect(__all(pmax - m_reg <= THR / SCALE), 1)) { mn = m_reg; alpha = 1.f; }
    else { mn = fmaxf(m_reg, pmax); alpha = __builtin_amdgcn_exp2f((m_reg - mn) * C); m_reg = mn; }
    const float mnC = -mn * C;
#pragma unroll
    for (int r = 0; r < 16; ++r) p0[r] = fmaf(p0[r], C, mnC);
#pragma unroll
    for (int r = 0; r < 16; ++r) p1[r] = fmaf(p1[r], C, mnC);
#pragma unroll
    for (int r = 0; r < 16; ++r) p0[r] = __builtin_amdgcn_exp2f(p0[r]);
}
__device__ __forceinline__ void finishSM(f32x16& p0, f32x16& p1, float alpha, float& l_reg, bf16x8& pa0, bf16x8& pa1, bf16x8& pa2, bf16x8& pa3) {
#pragma unroll
    for (int r = 0; r < 16; ++r) p1[r] = __builtin_amdgcn_exp2f(p1[r]);
    float ps = 0;
#pragma unroll
    for (int r = 0; r < 16; ++r) ps += p0[r];
#pragma unroll
    for (int r = 0; r < 16; ++r) ps += p1[r];
    { auto rr = __builtin_amdgcn_permlane32_swap(__float_as_uint(ps), __float_as_uint(ps), false, false);
      ps = __uint_as_float(rr[0]) + __uint_as_float(rr[1]); }
    l_reg = l_reg * alpha + ps;
#define FA_PK4(P, BASE, OUT) do { unsigned a0 = cvtpk(P[BASE + 0], P[BASE + 1]), a1 = cvtpk(P[BASE + 2], P[BASE + 3]);   \
    unsigned b0 = cvtpk(P[BASE + 4], P[BASE + 5]), b1 = cvtpk(P[BASE + 6], P[BASE + 7]);                              \
    auto r0 = __builtin_amdgcn_permlane32_swap(a0, b0, false, false); auto r1 = __builtin_amdgcn_permlane32_swap(a1, b1, false, false); \
    u32x4 w = {r0[0], r1[0], r0[1], r1[1]}; OUT = *reinterpret_cast<bf16x8*>(&w); } while (0)
    FA_PK4(p0, 0, pa0); FA_PK4(p0, 8, pa1); FA_PK4(p1, 0, pa2); FA_PK4(p1, 8, pa3);
#undef FA_PK4
}
__device__ __forceinline__ int v_rd_base(int lane) { return ((lane & 3) << 3) | (((lane >> 2) & 3) << 6) | (((lane >> 4) & 1) << 5) | (((lane >> 5) & 1) << 8); }
constexpr int v_rd_off(int d0, int ks, int half) { return d0 * 512 + ks * 4096 + half * 2048; }
template <int OFF> __device__ __forceinline__ s16x4 tr_read(unsigned vb) {
    s16x4 r; asm volatile("ds_read_b64_tr_b16 %0, %1 offset:%2" : "=&v"(r) : "v"(vb), "i"(OFF) : "memory"); return r;
}
template <int D0> __device__ __forceinline__ void pv_one(f32x16& od, unsigned vb, bf16x8 pa0, bf16x8 pa1, bf16x8 pa2, bf16x8 pa3) {
    const s16x4 l0 = tr_read<v_rd_off(D0, 0, 0)>(vb), h0 = tr_read<v_rd_off(D0, 0, 1)>(vb), l1 = tr_read<v_rd_off(D0, 1, 0)>(vb), h1 = tr_read<v_rd_off(D0, 1, 1)>(vb);
    const s16x4 l2 = tr_read<v_rd_off(D0, 2, 0)>(vb), h2 = tr_read<v_rd_off(D0, 2, 1)>(vb), l3 = tr_read<v_rd_off(D0, 3, 0)>(vb), h3 = tr_read<v_rd_off(D0, 3, 1)>(vb);
    asm volatile("s_waitcnt lgkmcnt(0)" ::: "memory"); FA_SBAR();
#define FA_PK(L, H) (bf16x8){L[0], L[1], L[2], L[3], H[0], H[1], H[2], H[3]}
    od = __builtin_amdgcn_mfma_f32_32x32x16_bf16(pa0, FA_PK(l0, h0), od, 0, 0, 0);
    od = __builtin_amdgcn_mfma_f32_32x32x16_bf16(pa1, FA_PK(l1, h1), od, 0, 0, 0);
    od = __builtin_amdgcn_mfma_f32_32x32x16_bf16(pa2, FA_PK(l2, h2), od, 0, 0, 0);
    od = __builtin_amdgcn_mfma_f32_32x32x16_bf16(pa3, FA_PK(l3, h3), od, 0, 0, 0);
#undef FA_PK
}
struct Args { const bf16_t* Q; const bf16_t* K; const bf16_t* V; bf16_t* O; int qpitch, kpitch, vpitch, opitch, nheads, vdiv; float scale; int pad; };

template <int DQK>
__device__ __forceinline__ void attn_phase(LAS unsigned char* lds, const Args& a, int tid) {
    constexpr int KROWB = DQK * 2, KCH = KROWB / 16, KTILE = 64 * KROWB, VTILE = 16384, STAGE = KTILE + VTILE, NKI = KTILE / 8192, NVI = 2, NDMA = NKI + NVI, ND = DQK / 16;
    static_assert(3 * STAGE + 2048 <= 131072, "attention LDS");
    const int wid = __builtin_amdgcn_readfirstlane(tid >> 6), lane = tid & 63, r32 = lane & 31, hi = lane >> 5;
    LAS float* wsc = (LAS float*)(lds + 3 * STAGE) + wid * 64;
    unsigned koff_[NKI], voff_[NVI];
#pragma unroll
    for (int i = 0; i < NKI; ++i) { const int s = i * 512 + wid * 64 + lane, row = s / KCH, ch = s % KCH; koff_[i] = (unsigned)(row * a.kpitch + (ch ^ (row & 7)) * 8) * 2u; }
#pragma unroll
    for (int i = 0; i < NVI; ++i) { const int o = (i * 512 + wid * 64 + lane) * 16, sub = o >> 9, within = o & 511, kk = (sub >> 2) * 8 + (within >> 6), c = (sub & 3) * 32 + ((within & 63) >> 1);
        const int k = (kk & ~0xC) | ((kk & 4) << 1) | ((kk & 8) >> 1); voff_[i] = (unsigned)(k * a.vpitch + c) * 2u; }
    const unsigned vb0 = (unsigned)(uintptr_t)(lds + KTILE) + (unsigned)v_rd_base(lane);
    const int n_lat = a.nheads * 64, n_units = n_lat + a.nheads * 16;
    for (int u = blockIdx.x; u < n_units; u += gridDim.x) {
        int b, h, q0, nk, kbase, cbase;
        if (u < n_lat) { const int bh = u >> 4, qb = u & 15; b = bh / a.nheads; h = bh % a.nheads; q0 = NCTX + b * LL + qb * 256; nk = LL + PAST; kbase = NCTX + b * LL; cbase = MTOK + b * PAST; }
        else { const int v = u - n_lat; b = v / a.nheads; h = v % a.nheads; q0 = b * CL; nk = CL; kbase = b * CL; cbase = 0; }
        const int NT = nk >> 6, vh = h / a.vdiv;
        const bf16_t* Kh = a.K + h * DQK; const bf16_t* Vh = a.V + vh * 128;
#define FA_ISSUE(j) do { const int t0_ = (j) * 64; const int rb_ = (t0_ < LL || nk == CL) ? kbase + t0_ : cbase + (t0_ - LL); LAS unsigned char* st_ = lds + ((j) % 3) * STAGE; \
        const char* kb_ = (const char*)(Kh + (size_t)rb_ * a.kpitch); const char* vb_ = (const char*)(Vh + (size_t)rb_ * a.vpitch); \
        _Pragma("unroll") for (int i_ = 0; i_ < NKI; ++i_) __builtin_amdgcn_global_load_lds((const unsigned*)(kb_ + koff_[i_]), (LAS unsigned*)(st_ + i_ * 8192 + wid * 1024), 16, 0, 0); \
        _Pragma("unroll") for (int i_ = 0; i_ < NVI; ++i_) __builtin_amdgcn_global_load_lds((const unsigned*)(vb_ + voff_[i_]), (LAS unsigned*)(st_ + KTILE + i_ * 8192 + wid * 1024), 16, 0, 0); } while (0)
        bf16x8 qr[ND];
        { const bf16_t* Qw = a.Q + (size_t)(q0 + wid * 32 + r32) * a.qpitch + h * DQK + hi * 8;
#pragma unroll
          for (int d0 = 0; d0 < ND; ++d0) qr[d0] = *(const bf16x8*)(Qw + d0 * 16); }
        float m_reg = -1e30f, l_reg = 0.f; f32x16 o[4];
        float z0 = 0.f; asm volatile("" : "+v"(z0));
#pragma unroll
        for (int d = 0; d < 4; ++d)
#pragma unroll
            for (int r = 0; r < 16; ++r) o[d][r] = z0;
        FA_ISSUE(0); FA_ISSUE(1);
        if (NDMA == 5) asm volatile("s_waitcnt vmcnt(5)" ::: "memory"); else asm volatile("s_waitcnt vmcnt(3)" ::: "memory");
        __builtin_amdgcn_s_barrier(); asm volatile("" ::: "memory");
        for (int j = 0; j < NT; ++j) {
            if (j + 2 < NT) FA_ISSUE(j + 2);
            LAS unsigned char* Ks = lds + (j % 3) * STAGE;
            f32x16 p0, p1;
#pragma unroll
            for (int r = 0; r < 16; ++r) { p0[r] = z0; p1[r] = z0; }
#pragma unroll
            for (int d0 = 0; d0 < ND; ++d0) { const int cb = (d0 * 16 + hi * 8) * 2;
                const bf16x8 b0 = *(const LAS bf16x8*)(Ks + r32 * KROWB + (cb ^ ((r32 & 7) << 4)));
                const bf16x8 b1 = *(const LAS bf16x8*)(Ks + (32 + r32) * KROWB + (cb ^ ((r32 & 7) << 4)));
                p0 = __builtin_amdgcn_mfma_f32_32x32x16_bf16(b0, qr[d0], p0, 0, 0, 0);
                p1 = __builtin_amdgcn_mfma_f32_32x32x16_bf16(b1, qr[d0], p1, 0, 0, 0);
                if ((d0 & 3) == 3) asm volatile("" ::: "memory"); }
            float mn, alpha; partialSM(p0, p1, m_reg, mn, alpha, a.scale);
            if (__any(alpha < 1.f)) { if (hi == 0) wsc[32 + r32] = alpha; asm volatile("s_waitcnt lgkmcnt(0)" ::: "memory");
#pragma unroll
                for (int d = 0; d < 4; ++d)
#pragma unroll
                    for (int r = 0; r < 16; ++r) o[d][r] *= wsc[32 + crow(r, hi)]; }
            bf16x8 pa0, pa1, pa2, pa3; finishSM(p0, p1, alpha, l_reg, pa0, pa1, pa2, pa3); FA_SBAR();
            const unsigned vb = vb0 + (unsigned)((j % 3) * STAGE);
            pv_one<0>(o[0], vb, pa0, pa1, pa2, pa3); pv_one<1>(o[1], vb, pa0, pa1, pa2, pa3); pv_one<2>(o[2], vb, pa0, pa1, pa2, pa3); pv_one<3>(o[3], vb, pa0, pa1, pa2, pa3);
            if (j + 2 < NT) { if (NDMA == 5) asm volatile("s_waitcnt vmcnt(5)" ::: "memory"); else asm volatile("s_waitcnt vmcnt(3)" ::: "memory"); }
            else asm volatile("s_waitcnt vmcnt(0)" ::: "memory");
            asm volatile("s_waitcnt lgkmcnt(0)" ::: "memory");
            __builtin_amdgcn_s_barrier(); asm volatile("" ::: "memory");
        }
#undef FA_ISSUE
        if (hi == 0) wsc[r32] = l_reg; asm volatile("s_waitcnt lgkmcnt(0)" ::: "memory");
        bf16_t* Ow = a.O + (size_t)(q0 + wid * 32) * a.opitch + h * 128 + r32;
#pragma unroll
        for (int r = 0; r < 16; ++r) { const int orow = crow(r, hi); const float rl = __builtin_amdgcn_rcpf(wsc[orow]);
#pragma unroll
            for (int d0 = 0; d0 < 4; ++d0) Ow[(size_t)orow * a.opitch + d0 * 32] = (bf16_t)f2bf(o[d0][r] * rl); }
        asm volatile("s_waitcnt lgkmcnt(0)" ::: "memory");
    }
}
}

__device__ __forceinline__ float rope_lane(float x, int lane, int prow, int pcol, const float* rt) {
    const int part = lane >> 5, jj = lane & 31, idx = jj & 15, pos = part ? pcol : prow;
    const float c = rt[pos * 16 + idx], s = rt[1024 + pos * 16 + idx];
    const float o = __shfl_xor(x, 16);
    return (jj >= 16) ? (x * c + o * s) : (x * c - o * s);
}
__device__ __forceinline__ void ph_prep_row(const P& p, int l, int r, int lane) {
    unsigned char* ws = p.ws;
    bf16_t* ckvn = (bf16_t*)(ws + WS_CKVN) + (size_t)r * 512;
    bf16_t* kf = (bf16_t*)(ws + WS_KFULL) + (size_t)r * 1536;
    bf16_t* dfk = (bf16_t*)(ws + WS_DFK) + (size_t)r * 1024;
    bf16_t* dfv = (bf16_t*)(ws + WS_DFV) + (size_t)r * 1024;
    if (r >= MTOK) {
        const int i = r - MTOK, b = i >> 8, t = i & 255;
        const float* cc = p.in[2] + ((size_t)(b * 2 + l) * PAST + t) * 512;
        for (int j = lane; j < 512; j += 64) ckvn[j] = (bf16_t)f2bf(cc[j]);
        const float kr = p.in[3][((size_t)(b * 2 + l) * PAST + t) * 64 + lane];
#pragma unroll
        for (int h = 0; h < 8; ++h) kf[h * 192 + 128 + lane] = (bf16_t)f2bf(kr);
        const float* ck = p.in[4] + ((size_t)(b * 2 + l) * PAST + t) * 1024; const float* cv = p.in[5] + ((size_t)(b * 2 + l) * PAST + t) * 1024;
        for (int j = lane; j < 1024; j += 64) { dfk[j] = (bf16_t)f2bf(ck[j]); dfv[j] = (bf16_t)f2bf(cv[j]); }
        return;
    }
    const float* kva = (const float*)(ws + WS_KVA) + (size_t)r * KVAW;
    const bool ctx = r < NCTX;
    const int cb = r >> 8, ct = r & 255;
    const int t = (r - NCTX) & 4095, prow = t >> 6, pcol = t & 63;
    const float* rt = (const float*)(ws + WS_ROPE);
    { float v[8]; float ss = 0.f;
#pragma unroll
      for (int j = 0; j < 8; ++j) { v[j] = kva[j * 64 + lane]; ss += v[j] * v[j]; }
      const float rstd = rsqrtf(wave_sum(ss) * (1.0f / 512.0f) + 1e-6f);
      const float* g = p.in[20] + l * 512;
#pragma unroll
      for (int j = 0; j < 8; ++j) { const float y = v[j] * rstd * g[j * 64 + lane]; ckvn[j * 64 + lane] = (bf16_t)f2bf(y);
          if (ctx) p.out[O_CKV + ((size_t)(cb * 2 + l) * CL + ct) * 512 + j * 64 + lane] = y; } }
    { float kr = kva[512 + lane];
      if (ctx) p.out[O_KR + ((size_t)(cb * 2 + l) * CL + ct) * 64 + lane] = kr; else kr = rope_lane(kr, lane, prow, pcol, rt);
#pragma unroll
      for (int h = 0; h < 8; ++h) kf[h * 192 + 128 + lane] = (bf16_t)f2bf(kr); }
    if (lane < 16) { const float g = kva[576 + lane] + p.in[18][l * 16 + lane];
        const float o = ((lane >> 2) & 1) ? (fminf(g, 0.f) - __logf(1.0f + __expf(-fabsf(g)))) : g;
        ((float*)(ws + WS_GATES))[(size_t)r * 16 + lane] = o; }
    if (ctx) {
        float* ok = p.out + O_DK + ((size_t)(cb * 2 + l) * CL + ct) * 1024; float* ov = p.out + O_DV + ((size_t)(cb * 2 + l) * CL + ct) * 1024;
        for (int j = lane; j < 1024; j += 64) { ok[j] = bf2f(dfk[j]); ov[j] = bf2f(dfv[j]); }
    } else {
        bf16_t* mq = (bf16_t*)(ws + WS_MQ) + (size_t)r * 1536; bf16_t* dfq = (bf16_t*)(ws + WS_DFQ) + (size_t)r * 1024;
#pragma unroll
        for (int h = 0; h < 8; ++h) { const float x = bf2f(mq[h * 192 + 128 + lane]); mq[h * 192 + 128 + lane] = (bf16_t)f2bf(rope_lane(x, lane, prow, pcol, rt)); }
#pragma unroll
        for (int h = 0; h < 16; ++h) { const float x = bf2f(dfq[h * 64 + lane]); dfq[h * 64 + lane] = (bf16_t)f2bf(rope_lane(x, lane, prow, pcol, rt));
            const float y = bf2f(dfk[h * 64 + lane]); dfk[h * 64 + lane] = (bf16_t)f2bf(rope_lane(y, lane, prow, pcol, rt)); }
    }
}

__device__ __forceinline__ void ph_mlstm_chain(const P& p, int l, int chain, int tid, float* sm) {
    float* sq = sm; float* sk = sm + 256; float* red = sm + 512;
    const int lane = tid & 63, wid = tid >> 6;
    const bool lat = chain >= 128; const int cc = lat ? chain - 128 : chain, b = cc >> 3, h = (cc >> 1) & 3, dir = cc & 1;
    const int L = lat ? LL : CL, base = lat ? NCTX + b * LL : b * CL;
    float* CT = (float*)(p.ws + WS_CT) + (size_t)chain * 65536;
    float n_k, m;
    if (lat) {
        const float* c0 = p.in[6] + ((size_t)((b * 2 + l) * 2 + dir) * 4 + h) * 65536;
        for (int k = 0; k < 256; ++k) CT[k * 256 + tid] = c0[(size_t)tid * 256 + k];
        n_k = p.in[7][((size_t)((b * 2 + l) * 2 + dir) * 4 + h) * 256 + tid]; m = p.in[8][((b * 2 + l) * 2 + dir) * 4 + h];
    } else { for (int k = 0; k < 256; ++k) CT[k * 256 + tid] = 0.f; n_k = 0.f; m = 0.f; }
    const bf16_t* Q = (const bf16_t*)(p.ws + WS_MLQ); const bf16_t* Kp = (const bf16_t*)(p.ws + WS_MLK); const bf16_t* V = (const bf16_t*)(p.ws + WS_MLV);
    const float* G = (const float*)(p.ws + WS_GATES);
    bf16_t* Hout = (bf16_t*)(p.ws + (dir ? WS_HB : WS_HF));
    for (int s = 0; s < L; ++s) {
        const int r = base + (dir ? L - 1 - s : s);
        __syncthreads();
        sq[tid] = bf2f(Q[(size_t)r * 1024 + h * 256 + tid]); sk[tid] = bf2f(Kp[(size_t)r * 1024 + h * 256 + tid]);
        const float vv = bf2f(V[(size_t)r * 1024 + h * 256 + tid]);
        const float li = G[(size_t)r * 16 + dir * 8 + h], lf = G[(size_t)r * 16 + dir * 8 + 4 + h];
        const float mn = fmaxf(lf + m, li), ip = __expf(li - mn), fp = __expf(lf + m - mn); m = mn;
        __syncthreads();
        const float iv = ip * vv; float num = 0.f;
        for (int k0 = 0; k0 < 256; k0 += 16) { float c[16];
#pragma unroll
            for (int j = 0; j < 16; ++j) c[j] = CT[(k0 + j) * 256 + tid];
#pragma unroll
            for (int j = 0; j < 16; ++j) { c[j] = fp * c[j] + iv * sk[k0 + j]; CT[(k0 + j) * 256 + tid] = c[j]; num += c[j] * sq[k0 + j]; } }
        n_k = fp * n_k + ip * sk[tid];
        const float dp = wave_sum(n_k * sq[tid]);
        if (lane == 0) red[wid] = dp;
        __syncthreads();
        const float den = red[0] + red[1] + red[2] + red[3];
        Hout[(size_t)r * 1024 + h * 256 + tid] = (bf16_t)f2bf(num / fmaxf(fabsf(den), __expf(-m)));
    }
    if (!lat) {
        float* oc = p.out + O_MC + ((size_t)((b * 2 + l) * 2 + dir) * 4 + h) * 65536;
        for (int k = 0; k < 256; ++k) oc[(size_t)tid * 256 + k] = CT[k * 256 + tid];
        p.out[O_MN + ((size_t)((b * 2 + l) * 2 + dir) * 4 + h) * 256 + tid] = n_k;
        if (tid == 0) p.out[O_MM + ((b * 2 + l) * 2 + dir) * 4 + h] = m;
    }
}
__device__ __forceinline__ void ph_ml_combine(const P& p, int l, int w, int lane) {
    const int r = w >> 2, h = w & 3;
    bf16_t* hf = (bf16_t*)(p.ws + WS_HF) + (size_t)r * 1024 + h * 256; const bf16_t* hb = (const bf16_t*)(p.ws + WS_HB) + (size_t)r * 1024 + h * 256;
    const bf16_t* so = (const bf16_t*)(p.ws + WS_MLO) + (size_t)r * 1024 + h * 256; const float* g = p.in[19] + l * 1024 + h * 256;
    float v[4]; float ss = 0.f;
#pragma unroll
    for (int j = 0; j < 4; ++j) { v[j] = bf2f(hf[j * 64 + lane]) + bf2f(hb[j * 64 + lane]); ss += v[j] * v[j]; }
    const float rstd = rsqrtf(wave_sum(ss) * (1.0f / 256.0f) + 1e-6f);
#pragma unroll
    for (int j = 0; j < 4; ++j) hf[j * 64 + lane] = (bf16_t)f2bf(v[j] * rstd * g[j * 64 + lane] * bf2f(so[j * 64 + lane]));
}

__device__ __forceinline__ void reduce16(float (&v)[16], int lane) {
    const bool b5 = lane & 32, b4 = lane & 16, b3 = lane & 8, b2 = lane & 4;
#pragma unroll
    for (int j = 0; j < 8; ++j) { const float keep = b5 ? v[8 + j] : v[j], send = b5 ? v[j] : v[8 + j]; v[j] = keep + __shfl_xor(send, 32); }
#pragma unroll
    for (int j = 0; j < 4; ++j) { const float keep = b4 ? v[4 + j] : v[j], send = b4 ? v[j] : v[4 + j]; v[j] = keep + __shfl_xor(send, 16); }
#pragma unroll
    for (int j = 0; j < 2; ++j) { const float keep = b3 ? v[2 + j] : v[j], send = b3 ? v[j] : v[2 + j]; v[j] = keep + __shfl_xor(send, 8); }
    { const float keep = b2 ? v[1] : v[0], send = b2 ? v[0] : v[1]; v[0] = keep + __shfl_xor(send, 4); }
    v[0] += __shfl_xor(v[0], 2); v[0] += __shfl_xor(v[0], 1);
}
__device__ __forceinline__ void ph_s5_unit(const P& p, int l, int dir, int w, int lane) {
    const int seq = w >> 6, g = w & 63; const bool lat = seq >= 16; const int b = lat ? seq - 16 : seq;
    const int L = lat ? LL : CL, base = lat ? NCTX + b * LL : b * CL;
    const size_t pg = ((size_t)(l * 2 + dir) * 64 + g);
    const float lr = fminf(p.in[22][pg * 64 + lane], -1e-4f), li = p.in[23][pg * 64 + lane], dt = __expf(p.in[24][pg]);
    const float mag = __expf(dt * lr); float sn, cs; sincos_small(dt * li, sn, cs);
    const float ar = mag * cs, ai = mag * sn, den = lr * lr + li * li, nr = ar - 1.0f, ni = ai, qr = (nr * lr + ni * li) / den, qi = (ni * lr - nr * li) / den;
    float bbr[16], bbi[16], cr[16], ci[16];
#pragma unroll
    for (int i = 0; i < 16; ++i) { const float br = p.in[25][(pg * 64 + lane) * 16 + i], bi = p.in[26][(pg * 64 + lane) * 16 + i]; bbr[i] = qr * br - qi * bi; bbi[i] = qr * bi + qi * br;
        cr[i] = p.in[27][(pg * 16 + i) * 64 + lane]; ci[i] = p.in[28][(pg * 16 + i) * 64 + lane]; }
    float sr = 0.f, si = 0.f;
    if (lat) { sr = p.in[9][((size_t)((b * 2 + l) * 2 + dir) * 64 + g) * 64 + lane]; si = p.in[10][((size_t)((b * 2 + l) * 2 + dir) * 64 + g) * 64 + lane]; }
    const bf16_t* U = (const bf16_t*)(p.ws + WS_S5U); float* YF = (float*)(p.ws + WS_YS5F); bf16_t* YG = (bf16_t*)(p.ws + WS_HB);
    const float dval = p.in[29][l * 1024 + g * 16 + ((lane >> 2) & 15)];
    for (int s = 0; s < L; ++s) {
        const int r = base + (dir ? L - 1 - s : s);
        const u32x4 u0 = *(const u32x4*)(U + (size_t)r * 1024 + g * 16), u1 = *(const u32x4*)(U + (size_t)r * 1024 + g * 16 + 8);
        float u[16];
#pragma unroll
        for (int i = 0; i < 4; ++i) { u[2 * i] = bf2f(u0[i]); u[2 * i + 1] = bf2f(u0[i] >> 16); u[8 + 2 * i] = bf2f(u1[i]); u[9 + 2 * i] = bf2f(u1[i] >> 16); }
        float bur = 0.f, bui = 0.f;
#pragma unroll
        for (int i = 0; i < 16; ++i) { bur += bbr[i] * u[i]; bui += bbi[i] * u[i]; }
        const float nsr = ar * sr - ai * si + bur, nsi = ar * si + ai * sr + bui; sr = nsr; si = nsi;
        float y[16];
#pragma unroll
        for (int i = 0; i < 16; ++i) y[i] = cr[i] * sr - ci[i] * si;
        reduce16(y, lane);
        if ((lane & 3) == 0) { const int i = lane >> 2; const size_t o = (size_t)r * 1024 + g * 16 + i;
            if (dir == 0) YF[o] = y[0];
            else { float ui = 0.f;
#pragma unroll
                for (int e = 0; e < 16; ++e) ui = (e == i) ? u[e] : ui;
                YG[o] = (bf16_t)f2bf(gelu_tanh(YF[o] + y[0] + dval * ui)); } }
    }
    if (!lat) { p.out[O_SR + ((size_t)((b * 2 + l) * 2 + dir) * 64 + g) * 64 + lane] = sr; p.out[O_SI + ((size_t)((b * 2 + l) * 2 + dir) * 64 + g) * 64 + lane] = si; }
}

template <int DQK>
__device__ __forceinline__ void ph_attn_unit(const bf16_t* Qp, int qpitch, const bf16_t* Kp, int kpitch, const bf16_t* Vp, int vpitch, int vdiv, bf16_t* Op, int opitch, int nheads, float scale, int w, int lane) {
    const int r = w / nheads, h = w % nheads;
    const bool lat = r >= NCTX; const int b = lat ? (r - NCTX) >> 12 : r >> 8;
    const int nk = lat ? LL + PAST : CL, kbase = lat ? NCTX + b * LL : b * CL, cbase = MTOK + b * PAST;
    const bf16_t* q = Qp + (size_t)r * qpitch + h * DQK;
    float qreg[DQK / 64];
#pragma unroll
    for (int j = 0; j < DQK / 64; ++j) qreg[j] = bf2f(q[j * 64 + lane]) * scale;
    float mrun = -1e30f, lrun = 0.f, o0 = 0.f, o1 = 0.f;
    const int vh = h / vdiv;
    for (int k0 = 0; k0 < nk; k0 += 64) {
        const int kk = k0 + lane, krow = kk < (lat ? LL : CL) ? kbase + kk : cbase + (kk - LL);
        const bf16_t* kp = Kp + (size_t)krow * kpitch + h * DQK;
        float s = 0.f;
#pragma unroll
        for (int j = 0; j < DQK / 64; ++j) {
#pragma unroll
            for (int c8 = 0; c8 < 8; ++c8) { const u32x4 kv = *(const u32x4*)(kp + j * 64 + c8 * 8);
#pragma unroll
                for (int e = 0; e < 4; ++e) { const float q0 = __shfl(qreg[j], c8 * 8 + 2 * e), q1 = __shfl(qreg[j], c8 * 8 + 2 * e + 1); s += q0 * bf2f(kv[e]) + q1 * bf2f(kv[e] >> 16); } }
        }
        const float mx = wave_max(s), mn = fmaxf(mrun, mx), alpha = __expf(mrun - mn), pj = __expf(s - mn);
        lrun = lrun * alpha + wave_sum(pj); o0 *= alpha; o1 *= alpha; mrun = mn;
        for (int j = 0; j < 64; ++j) { const float pb = __shfl(pj, j); const int kj = k0 + j, vrow = kj < (lat ? LL : CL) ? kbase + kj : cbase + (kj - LL);
            const bf16_t* vp = Vp + (size_t)vrow * vpitch + vh * 128; o0 += pb * bf2f(vp[lane]); o1 += pb * bf2f(vp[64 + lane]); }
    }
    const float inv = 1.0f / lrun;
    bf16_t* o = Op + (size_t)r * opitch + h * 128; o[lane] = (bf16_t)f2bf(o0 * inv); o[64 + lane] = (bf16_t)f2bf(o1 * inv);
}
__device__ __forceinline__ void ph_df_combine(const P& p, int l, float lam_init, int w, int lane) {
    const int r = w >> 3, h = w & 7;
    const float* lp = p.in[31] + l * 256;
    const float lam = __expf(wave_sum(lp[lane] * lp[64 + lane])) - __expf(wave_sum(lp[128 + lane] * lp[192 + lane])) + lam_init;
    const bf16_t* o = (const bf16_t*)(p.ws + WS_DFO) + (size_t)r * 2048 + h * 256;
    const float v0 = bf2f(o[lane]) - lam * bf2f(o[128 + lane]), v1 = bf2f(o[64 + lane]) - lam * bf2f(o[192 + lane]);
    const float rstd = rsqrtf(wave_sum(v0 * v0 + v1 * v1) * (1.0f / 128.0f) + 1e-6f);
    const float* g = p.in[32] + l * 128;
    bf16_t* y = (bf16_t*)(p.ws + WS_DFQ) + (size_t)r * 1024 + h * 128;
    y[lane] = (bf16_t)f2bf(v0 * rstd * g[lane] * (1.0f - lam_init)); y[64 + lane] = (bf16_t)f2bf(v1 * rstd * g[64 + lane] * (1.0f - lam_init));
}
__device__ __forceinline__ void ph_final_row(const P& p, int r, int lane) {
    const float* x = (const float*)(p.ws + WS_X) + (size_t)r * D; const float* g = p.in[37];
    f32x4 v[8]; float ss = 0.f;
#pragma unroll
    for (int j = 0; j < 8; ++j) { v[j] = *(const f32x4*)(x + j * 256 + lane * 4); ss += v[j][0] * v[j][0] + v[j][1] * v[j][1] + v[j][2] * v[j][2] + v[j][3] * v[j][3]; }
    const float rstd = rsqrtf(wave_sum(ss) * (1.0f / 2048.0f) + 1e-6f);
    float* o = p.out + (r < NCTX ? O_YP + (size_t)r * D : O_YS + (size_t)(r - NCTX) * D);
#pragma unroll
    for (int j = 0; j < 8; ++j) { const int c = j * 256 + lane * 4; const f32x4 gg = *(const f32x4*)(g + c); *(f32x4*)(o + c) = v[j] * rstd * gg; }
}

__device__ __forceinline__ void load_args(P& p) {
#if defined(__HIP_DEVICE_COMPILE__)
    const __attribute__((address_space(4))) unsigned long long* q = (const __attribute__((address_space(4))) unsigned long long*)__builtin_amdgcn_kernarg_segment_ptr();
    asm volatile("" : "+s"(q));
#pragma unroll
    for (int i = 0; i < 38; ++i) p.in[i] = (const float*)q[i];
    p.out = (float*)q[38]; p.ws = (unsigned char*)q[39];
#endif
}
constexpr int NTHR = 512, LDS_BYTES = 147456, MISC_OFF = 131072;
#define GRID_BAR() do { XcdBarrier b_ = bar; asm volatile("" : "+s"(b_.x)); xcd_barrier(b_); } while (0)

#define PH_VARS P p; load_args(p); unsigned char* ws = p.ws; (void)ws; int tid_ = (int)(bar.w * 64u + lane_id_()); asm volatile("" : "+v"(tid_)); const int lane = tid_ & 63, wave = __builtin_amdgcn_readfirstlane(tid_ >> 6), half = tid_ >> 8, vt = tid_ & 255; \
    const int gw = blockIdx.x * 8 + wave, vb = blockIdx.x * 2 + half; (void)lane; (void)half; (void)vt; (void)gw; (void)vb;

template <int l>
__device__ __forceinline__ void run_layer(unsigned char* lds, const XcdBarrier& bar, const int G, const int NGW) {
        { PH_VARS ph_convert(p, l, gw, NGW, lane, (LAS float*)((LAS unsigned char*)lds + wave * 16384)); }
        { PH_VARS for (int r = gw; r < MTOK; r += NGW) ph_hnorm_row(p, l, 0, r, lane); }
        GRID_BAR();
        { PH_VARS pg8::Gemm g{(const bf16_t*)(ws + WS_H), (const bf16_t*)(ws + WS_WBF + WB_IN), MTOK, 10496, D}; pg8::StaticOrder S; S.init(MTOK, 10496, G, (int)blockIdx.x);
          pg8::gemm_phase<Epi8In, pg8::StaticOrder, true, true>((LAS unsigned char*)lds, g, S, Epi8In{ws}, tid_); }
        GRID_BAR();
        { PH_VARS for (int r = gw; r < MALL; r += NGW) ph_prep_row(p, l, r, lane); }
        GRID_BAR();
        { PH_VARS pg8::Gemm g{(const bf16_t*)(ws + WS_CKVN), (const bf16_t*)(ws + WS_WBF + WB_KVB), MALL, 2048, 512}; pg8::StaticOrder S; S.init(MALL, 2048, G, (int)blockIdx.x);
          pg8::gemm_phase<Epi8Kvb, pg8::StaticOrder, true, true>((LAS unsigned char*)lds, g, S, Epi8Kvb{(bf16_t*)(ws + WS_KFULL), (bf16_t*)(ws + WS_VFULL)}, tid_); }
        { PH_VARS if (vb < 160) ph_mlstm_chain(p, l, vb, vt, (float*)(lds + half * 4096)); }
        GRID_BAR();
        { PH_VARS for (int w = gw; w < MTOK * 4; w += NGW) ph_ml_combine(p, l, w, lane); }
        { PH_VARS for (int w = gw; w < 20 * 64; w += NGW) ph_s5_unit(p, l, 0, w, lane); }
        GRID_BAR();
        { PH_VARS for (int w = gw; w < 20 * 64; w += NGW) ph_s5_unit(p, l, 1, w, lane); }
        GRID_BAR();
        { PH_VARS pg8::Gemm g{(const bf16_t*)(ws + WS_HB), (const bf16_t*)(ws + WS_WBF + WB_GLU), MTOK, 1024, 1024}; pg8::StaticOrder S; S.init(MTOK, 1024, G, (int)blockIdx.x);
          pg8::gemm_phase<Epi8Glu, pg8::StaticOrder, true, true>((LAS unsigned char*)lds, g, S, Epi8Glu{(const bf16_t*)(ws + WS_HB), (bf16_t*)(ws + WS_S5U)}, tid_); }
        { PH_VARS fa::Args aa{(const bf16_t*)(ws + WS_MQ), (const bf16_t*)(ws + WS_KFULL), (const bf16_t*)(ws + WS_VFULL), (bf16_t*)(ws + WS_MLQ), 1536, 1536, 1024, 1024, 8, 1, 0.07216878364870322f, 0};
          fa::attn_phase<192>((LAS unsigned char*)lds, aa, tid_); }
        { PH_VARS fa::Args aa{(const bf16_t*)(ws + WS_DFQ), (const bf16_t*)(ws + WS_DFK), (const bf16_t*)(ws + WS_DFV), (bf16_t*)(ws + WS_DFO), 1024, 1024, 1024, 2048, 16, 2, 0.125f, 0};
          fa::attn_phase<64>((LAS unsigned char*)lds, aa, tid_); }
        GRID_BAR();
        { PH_VARS const float lam_init = (l == 0) ? 0.2f : 0.35550906759096927f;
          for (int w = gw; w < MTOK * 8; w += NGW) ph_df_combine(p, l, lam_init, w, lane); }
        GRID_BAR();
        { PH_VARS pg8::Gemm g{(const bf16_t*)(ws + WS_H), (const bf16_t*)(ws + WS_WBF + WB_IN) + (size_t)10496 * D, MTOK, GATE_COLS, D}; pg8::StaticOrder S; S.init(MTOK, GATE_COLS, G, (int)blockIdx.x);
          pg8::gemm_phase<Epi8Gate, pg8::StaticOrder, true, true>((LAS unsigned char*)lds, g, S, Epi8Gate{(bf16_t*)(ws + WS_GS)}, tid_); }
        GRID_BAR();
        { PH_VARS pg8::Gemm g{(const bf16_t*)(ws + WS_HF), (const bf16_t*)(ws + WS_WBF + WB_BR) + (size_t)0 * 2048 * 1024, MTOK, D, 1024}; pg8::StaticOrder S; S.init(MTOK, D, G, (int)blockIdx.x);
          pg8::gemm_phase<Epi8Merge, pg8::StaticOrder, true, true>((LAS unsigned char*)lds, g, S, Epi8Merge{(const bf16_t*)(ws + WS_GS), (bf16_t*)(ws + WS_H), 0, 0}, tid_); }
        { PH_VARS pg8::Gemm g{(const bf16_t*)(ws + WS_MLQ), (const bf16_t*)(ws + WS_WBF + WB_BR) + (size_t)1 * 2048 * 1024, MTOK, D, 1024}; pg8::StaticOrder S; S.init(MTOK, D, G, (int)blockIdx.x);
          pg8::gemm_phase<Epi8Merge, pg8::StaticOrder, true, true>((LAS unsigned char*)lds, g, S, Epi8Merge{(const bf16_t*)(ws + WS_GS), (bf16_t*)(ws + WS_H), 1, 0}, tid_); }
        { PH_VARS pg8::Gemm g{(const bf16_t*)(ws + WS_S5U), (const bf16_t*)(ws + WS_WBF + WB_BR) + (size_t)2 * 2048 * 1024, MTOK, D, 1024}; pg8::StaticOrder S; S.init(MTOK, D, G, (int)blockIdx.x);
          pg8::gemm_phase<Epi8Merge, pg8::StaticOrder, true, true>((LAS unsigned char*)lds, g, S, Epi8Merge{(const bf16_t*)(ws + WS_GS), (bf16_t*)(ws + WS_H), 2, 0}, tid_); }
        { PH_VARS pg8::Gemm g{(const bf16_t*)(ws + WS_DFQ), (const bf16_t*)(ws + WS_WBF + WB_BR) + (size_t)3 * 2048 * 1024, MTOK, D, 1024}; pg8::StaticOrder S; S.init(MTOK, D, G, (int)blockIdx.x);
          pg8::gemm_phase<Epi8Merge, pg8::StaticOrder, true, true>((LAS unsigned char*)lds, g, S, Epi8Merge{(const bf16_t*)(ws + WS_GS), (bf16_t*)(ws + WS_H), 3, 0}, tid_); }
        GRID_BAR();
        { PH_VARS pg8::Gemm g{(const bf16_t*)(ws + WS_H), (const bf16_t*)(ws + WS_WBF + WB_O), MTOK, D, D}; pg8::StaticOrder S; S.init(MTOK, D, G, (int)blockIdx.x);
          pg8::gemm_phase<Epi8Res, pg8::StaticOrder, true, true>((LAS unsigned char*)lds, g, S, Epi8Res{p, l, 4096, 0, 0}, tid_); }
        GRID_BAR();
        { PH_VARS for (int r = gw; r < MTOK; r += NGW) ph_hnorm_row(p, l, 1, r, lane); }
        GRID_BAR();
        { PH_VARS pg8::Gemm g{(const bf16_t*)(ws + WS_H), (const bf16_t*)(ws + WS_WBF + WB_FIN), MTOK, 2 * FFN, D}; pg8::StaticOrder S; S.init(MTOK, 2 * FFN, G, (int)blockIdx.x);
          pg8::gemm_phase<Epi8FfnIn, pg8::StaticOrder, true, true>((LAS unsigned char*)lds, g, S, Epi8FfnIn{(bf16_t*)(ws + WS_FFNH)}, tid_); }
        GRID_BAR();
        { PH_VARS pg8::Gemm g{(const bf16_t*)(ws + WS_FFNH), (const bf16_t*)(ws + WS_WBF + WB_FOUT), MTOK, D, FFN}; pg8::StaticOrder S; S.init(MTOK, D, G, (int)blockIdx.x);
          pg8::gemm_phase<Epi8Res, pg8::StaticOrder, true, true>((LAS unsigned char*)lds, g, S, Epi8Res{p, l, 10240, 1, 0}, tid_); }
        GRID_BAR();
}

__global__ void __launch_bounds__(NTHR, 2) mega(P p_arg) {
    extern __shared__ __attribute__((aligned(16))) unsigned char lds[];
    const int tid = threadIdx.x;
    const int G = gridDim.x, NGW = G * 8;
    for (int u = tid; u < (LDS_BYTES - MISC_OFF) / 4; u += NTHR) ((LAS unsigned*)((LAS unsigned char*)lds + MISC_OFF))[u] = 0u;
    __syncthreads();
    XcdBarrier bar = xcd_barrier_post((unsigned*)(p_arg.ws + WS_CTL), (volatile LAS unsigned*)((LAS unsigned char*)lds + MISC_OFF + 32));
    { PH_VARS ph_mod(p, vb, vb < 96, vt, (float*)(lds + half * 40960)); }
    GRID_BAR();
    run_layer<0>(lds, bar, G, NGW);
    run_layer<1>(lds, bar, G, NGW);
    { PH_VARS for (int r = gw; r < MTOK; r += NGW) ph_final_row(p, r, lane); }
}

extern "C" void kernel_launch(void* const* d_in, const int* in_sizes, int n_in, void* d_out, int out_size, void* d_ws, size_t ws_size, hipStream_t stream) {
    static int grid = 0;
    if (grid == 0) {
        if (n_in != 38 || out_size != (int)O_END || ws_size < WS_END) { fprintf(stderr, "kernel_launch: unexpected shapes (n_in %d out %d ws %zu)\n", n_in, out_size, ws_size); grid = -1; return; }
        int dev = 0, cus = 0, per_cu = 0;
        if (hipGetDevice(&dev) != hipSuccess || hipDeviceGetAttribute(&cus, hipDeviceAttributeMultiprocessorCount, dev) != hipSuccess) { grid = -1; return; }
        if (hipFuncSetAttribute((const void*)mega, hipFuncAttributeMaxDynamicSharedMemorySize, LDS_BYTES) != hipSuccess) { fprintf(stderr, "kernel_launch: hipFuncSetAttribute failed\n"); grid = -1; return; }
        if (hipOccupancyMaxActiveBlocksPerMultiprocessor(&per_cu, (const void*)mega, NTHR, LDS_BYTES) != hipSuccess || per_cu < 1) { fprintf(stderr, "kernel_launch: occupancy query says %d workgroups per CU\n", per_cu); grid = -1; return; }
        (void)hipGetLastError();
        grid = cus;
    }
    if (grid < 0) return;
    if (hipMemsetAsync((char*)d_ws + WS_CTL, 0, CTL_BYTES, stream) != hipSuccess) return;
    P p{};
    for (int i = 0; i < 38; ++i) p.in[i] = (const float*)d_in[i];
    p.out = (float*)d_out; p.ws = (unsigned char*)d_ws;
    hipLaunchKernelGGL(mega, dim3(grid), dim3(NTHR), LDS_BYTES, stream, p);
}
```

```cpp
#include <hip/hip_runtime.h>
#include <cstdio>
#include <cstdint>

typedef unsigned short bf16_t;
typedef short bf16x8 __attribute__((ext_vector_type(8)));
typedef float f32x16 __attribute__((ext_vector_type(16)));
typedef float f32x4 __attribute__((ext_vector_type(4)));
typedef unsigned u32x4 __attribute__((ext_vector_type(4)));
typedef unsigned u32x2 __attribute__((ext_vector_type(2)));

constexpr int D = 2048, NCTX = 4096, NLAT = 16384, MTOK = 20480, MALL = 21504;
constexpr int CB = 16, CL = 256, LB = 4, LL = 4096, PAST = 256;
constexpr int IN_COLS = 18512, MIX_COLS = 10320, GATE_COLS = 8192;
constexpr int C_MLQ = 0, C_MLK = 1024, C_MLV = 2048, C_MLO = 3072, C_MLIF = 4096, C_MQ = 4112, C_KVA = 5648, C_S5U = 6224, C_DFQ = 7248, C_DFK = 8272, C_DFV = 9296;
constexpr int FFN = 5632;
constexpr int KVAW = 768;

constexpr size_t MiB = 1u << 20;
constexpr size_t WS_CTL = 0, CTL_BYTES = 64 * 1024;
constexpr size_t WS_MOD = 1 * MiB;
constexpr size_t WS_ROPE = WS_MOD + 512 * 1024;
constexpr size_t WS_X = 2 * MiB;
constexpr size_t WS_H = 162 * MiB;
constexpr size_t WS_HF = 242 * MiB;
constexpr size_t WS_HB = 282 * MiB;
constexpr size_t WS_MLQ = 322 * MiB;
constexpr size_t WS_S5U = 362 * MiB;
constexpr size_t WS_DFQ = 402 * MiB;
constexpr size_t WS_MLK = 442 * MiB;
constexpr size_t WS_MLV = 482 * MiB;
constexpr size_t WS_MLO = 522 * MiB;
constexpr size_t WS_MQ = 562 * MiB;
constexpr size_t WS_KVA = 622 * MiB;
constexpr size_t WS_DFK = 682 * MiB;
constexpr size_t WS_DFV = 724 * MiB;
constexpr size_t WS_CKVN = 766 * MiB;
constexpr size_t WS_KFULL = 787 * MiB;
constexpr size_t WS_VFULL = 850 * MiB;
constexpr size_t WS_GATES = 892 * MiB;
constexpr size_t WS_CT = 894 * MiB;
constexpr size_t WS_WBF = 934 * MiB;
constexpr size_t WS_GS = 442 * MiB;
constexpr size_t WS_FFNH = 442 * MiB;
constexpr size_t WS_DFO = 442 * MiB;
constexpr size_t WS_YS5F = 442 * MiB;
constexpr size_t WS_END = 1101 * MiB;

constexpr size_t O_YP = 0, O_YS = 8388608, O_CKV = 41943040, O_KR = 46137344, O_DK = 46661632, O_DV = 55050240,
                 O_MC = 63438848, O_MN = 80216064, O_MM = 80281600, O_SR = 80281856, O_SI = 80544000, O_END = 80806144;

__device__ __forceinline__ unsigned f2bf(float f) { unsigned u = __builtin_bit_cast(unsigned, f); return (u + 0x7fffu + ((u >> 16) & 1u)) >> 16; }
__device__ __forceinline__ float bf2f(unsigned b) { return __builtin_bit_cast(float, (b & 0xffffu) << 16); }
__device__ __forceinline__ unsigned pk2(float lo, float hi) { return f2bf(lo) | (f2bf(hi) << 16); }
__device__ __forceinline__ float wave_sum(float v) {
#pragma unroll
    for (int o = 1; o < 64; o <<= 1) v += __shfl_xor(v, o);
    return v;
}
__device__ __forceinline__ float wave_max(float v) {
#pragma unroll
    for (int o = 1; o < 64; o <<= 1) v = fmaxf(v, __shfl_xor(v, o));
    return v;
}
__device__ __forceinline__ float sigmoidf_(float x) { return 1.0f / (1.0f + __expf(-x)); }
__device__ __forceinline__ float siluf_(float x) { return x / (1.0f + __expf(-x)); }
__device__ __forceinline__ float gelu_tanh(float x) { const float u = 0.7978845608028654f * (x + 0.044715f * x * x * x); const float t = 1.0f - 2.0f / (1.0f + __expf(2.0f * u)); return 0.5f * x * (1.0f + t); }
__device__ __forceinline__ void sincos_small(float x, float& s, float& c) {
    const float k = rintf(x * 0.6366197723675814f);
    float r = fmaf(-k, 1.5707962513e+0f, x); r = fmaf(-k, 7.5497894159e-8f, r); r = fmaf(-k, 5.3903029534e-15f, r);
    const float r2 = r * r;
    const float sp = r + r * r2 * (-1.6666654611e-1f + r2 * (8.3321608736e-3f + r2 * (-1.9515295891e-4f)));
    const float cp = 1.0f - 0.5f * r2 + r2 * r2 * (4.166664568298827e-2f + r2 * (-1.388731625493765e-3f + r2 * 2.443315711809948e-5f));
    const int q = ((int)k) & 3;
    s = (q == 0) ? sp : (q == 1) ? cp : (q == 2) ? -sp : -cp;
    c = (q == 0) ? cp : (q == 1) ? -sp : (q == 2) ? -cp : sp;
}
__device__ __forceinline__ int cond_of_row(int r) { return r < NCTX ? 0 : 1 + ((r - NCTX) >> 12); }

struct P {
    const float* in[38];
    float* out;
    unsigned char* ws;
};
__device__ __forceinline__ const float* x_src(const P& p, int l, int r) {
    if (l == 0) return r < NCTX ? p.in[0] + (size_t)r * D : p.in[1] + (size_t)(r - NCTX) * D;
    return (const float*)(p.ws + WS_X) + (size_t)r * D;
}


#define XB_TMO      128
#define XB_XCNT(j)  (256  + 64 * (j))
#define XB_XSUB(j)  (1280 + 64 * (j))
#define XB_XGEN(j)  (2304 + 64 * (j))
#define XB_TOP      3328
#define XB_TOPGEN   3392
#define XCD_BAR_WORDS 3456
#define XB_SPIN_CAP (1u << 22)
#define LAS __attribute__((address_space(3)))

__device__ __forceinline__ unsigned xb_ld(unsigned* p)              { return __hip_atomic_load(p, __ATOMIC_RELAXED, __HIP_MEMORY_SCOPE_AGENT); }
__device__ __forceinline__ unsigned xb_add(unsigned* p, unsigned v) { return __hip_atomic_fetch_add(p, v, __ATOMIC_RELAXED, __HIP_MEMORY_SCOPE_AGENT); }
__device__ __forceinline__ unsigned xb_xcc_id() { return (unsigned)__builtin_amdgcn_s_getreg((3 << 11) | 20) & 0xFu; }
#define XB_SPIN(cond, bar) do { unsigned _sp = 0; while (cond) { __builtin_amdgcn_s_sleep(1); \
    if ((++_sp & 255u) == 0u) { if (xb_ld(&(bar)[XB_TMO])) break; if (_sp > XB_SPIN_CAP) { atomicAdd(&(bar)[XB_TMO], 1u); break; } } } } while (0)

__device__ __forceinline__ unsigned lane_id_() { return __builtin_amdgcn_mbcnt_hi(~0u, __builtin_amdgcn_mbcnt_lo(~0u, 0u)); }
struct XcdBarrier {
    unsigned* bar; unsigned x; unsigned w;
    volatile LAS unsigned* st;
};
__device__ __forceinline__ XcdBarrier xcd_barrier_post(unsigned* bar, volatile LAS unsigned* st) {
    XcdBarrier b; b.bar = bar; b.x = xb_xcc_id(); b.st = st; b.w = (unsigned)__builtin_amdgcn_readfirstlane(threadIdx.x >> 6);
    if (threadIdx.x == 0) (void)xb_add(&bar[XB_XCNT(b.x)], 1u);
    return b;
}
__device__ __forceinline__ void xcd_barrier_complete(unsigned* bar, unsigned x, unsigned& nloc, unsigned& nx) {
    const unsigned G = gridDim.x * gridDim.y * gridDim.z;
    unsigned sum, cnt, mine, sp = 0u;
    for (;;) {
        sum = 0u; cnt = 0u; mine = 0u;
#pragma unroll
        for (unsigned j = 0; j < 16; ++j) { const unsigned c = xb_ld(&bar[XB_XCNT(j)]); sum += c; cnt += (c > 0u) ? 1u : 0u; mine = (j == x) ? c : mine; }
        if (sum == G) break;
        __builtin_amdgcn_s_sleep(1);
        if ((++sp & 255u) == 0u) { if (xb_ld(&bar[XB_TMO])) break; if (sp > XB_SPIN_CAP) { atomicAdd(&bar[XB_TMO], 1u); break; } }
    }
    nloc = mine > 0u ? mine : 1u; nx = cnt > 0u ? cnt : 1u;
}
__device__ __forceinline__ void xcd_barrier(const XcdBarrier& b) {
    asm volatile("s_waitcnt vmcnt(0)" ::: "memory");
    __syncthreads();
    if (b.w == 0u && lane_id_() == 0u) {
        unsigned* bar = b.bar;
        __builtin_amdgcn_s_waitcnt(0);
        unsigned nloc = b.st[0], nx = b.st[1];
        if (nloc == 0u) { xcd_barrier_complete(bar, b.x, nloc, nx); b.st[0] = nloc; b.st[1] = nx; }
        const unsigned old = xb_add(&bar[XB_XSUB(b.x)], 1u);
        const unsigned gen = old / nloc;
        if (old + 1u == (gen + 1u) * nloc) {
            __builtin_amdgcn_fence(__ATOMIC_RELEASE, "agent");
            asm volatile("s_waitcnt vmcnt(0)" ::: "memory");
            const unsigned og = xb_add(&bar[XB_TOP], 1u);
            const unsigned tg = og / nx;
            if (og + 1u == (tg + 1u) * nx) xb_add(&bar[XB_TOPGEN], 1u);
            else XB_SPIN(xb_ld(&bar[XB_TOPGEN]) == tg, bar);
            __builtin_amdgcn_fence(__ATOMIC_ACQUIRE, "agent");
            xb_add(&bar[XB_XGEN(b.x)], 1u);
            asm volatile("s_waitcnt vmcnt(0)" ::: "memory");
        } else {
            XB_SPIN(xb_ld(&bar[XB_XGEN(b.x)]) == gen, bar);
            __builtin_amdgcn_fence(__ATOMIC_ACQUIRE, "agent");
            asm volatile("s_waitcnt vmcnt(0)" ::: "memory");
        }
    }
    __syncthreads();
}


__device__ __forceinline__ void ph_mod(const P& p, int vblk, bool active, int tid, float* sc) {
    for (int i = tid; i < 5 * 2048; i += 256) { const int c = i >> 11, k = i & 2047; const float v = c == 0 ? p.in[12][k] : p.in[11][(c - 1) * 2048 + k]; sc[i] = siluf_(v); }
    __syncthreads();
    const int idx = vblk * 256 + tid;
    if (active && idx < 2 * 12288) {
        const int l = idx / 12288, n = idx % 12288;
        const float* w = p.in[13] + (size_t)l * 2048 * 12288 + n;
        float a0 = 0, a1 = 0, a2 = 0, a3 = 0, a4 = 0;
        for (int k = 0; k < 2048; ++k) { const float wv = w[(size_t)k * 12288]; a0 += sc[k] * wv; a1 += sc[2048 + k] * wv; a2 += sc[4096 + k] * wv; a3 += sc[6144 + k] * wv; a4 += sc[8192 + k] * wv; }
        const float b = p.in[14][l * 12288 + n];
        float* mod = (float*)(p.ws + WS_MOD) + (size_t)l * 5 * 12288 + n;
        mod[0] = a0 + b; mod[12288] = a1 + b; mod[2 * 12288] = a2 + b; mod[3 * 12288] = a3 + b; mod[4 * 12288] = a4 + b;
    }
    if (active && vblk == 0) {
        float* rt = (float*)(p.ws + WS_ROPE);
        for (int i = tid; i < 1024; i += 256) { const int pos = i >> 4, j = i & 15; const float inv = exp2f(-(float)j * (13.287712379549449f / 16.0f)); float s, c; sincos_small((float)pos * inv, s, c); rt[i] = c; rt[1024 + i] = s; }
    }
}

__device__ __forceinline__ void ph_hnorm_row(const P& p, int l, int which, int r, int lane) {
    const float* x = which == 0 ? x_src(p, l, r) : (const float*)(p.ws + WS_X) + (size_t)r * D;
    const float* nw = p.in[which == 0 ? 15 : 16] + l * 2048;
    const float* mod = (const float*)(p.ws + WS_MOD) + ((size_t)l * 5 + cond_of_row(r)) * 12288 + (which == 0 ? 0 : 3 * 2048);
    f32x4 v[8]; float ss = 0.f;
#pragma unroll
    for (int j = 0; j < 8; ++j) { v[j] = *(const f32x4*)(x + j * 256 + lane * 4); ss += v[j][0] * v[j][0] + v[j][1] * v[j][1] + v[j][2] * v[j][2] + v[j][3] * v[j][3]; }
    const float rstd = rsqrtf(wave_sum(ss) * (1.0f / 2048.0f) + 1e-6f);
    bf16_t* o = (bf16_t*)(p.ws + WS_H) + (size_t)r * D;
#pragma unroll
    for (int j = 0; j < 8; ++j) { const int c = j * 256 + lane * 4; const f32x4 g = *(const f32x4*)(nw + c), sh = *(const f32x4*)(mod + c), s1 = *(const f32x4*)(mod + 2048 + c);
        float y[4];
#pragma unroll
        for (int e = 0; e < 4; ++e) y[e] = v[j][e] * rstd * g[e] * (1.0f + s1[e]) + sh[e];
        u32x2 w; w.x = pk2(y[0], y[1]); w.y = pk2(y[2], y[3]); *(u32x2*)(o + c) = w; }
}

template <class Epi, bool FFNMAP>
__device__ __forceinline__ void gemm_tile(const bf16_t* A, int lda, const float* W, int ldw, int ncols, int K, int tm, int tn, bool active, const Epi& E, int tid, bf16_t* As, bf16_t* Bs) {
    const int lane = tid & 63, wid = tid >> 6, wm = wid >> 1, wn = wid & 1, r32 = lane & 31, hi = lane >> 5;
    f32x16 acc[2][2];
#pragma unroll
    for (int a = 0; a < 2; ++a)
#pragma unroll
        for (int b = 0; b < 2; ++b)
#pragma unroll
            for (int r = 0; r < 16; ++r) acc[a][b][r] = 0.f;
    const int arow = tid >> 1, acol = (tid & 1) * 16;
    const bf16_t* ap = A + (size_t)(tm * 128 + arow) * lda + acol;
    const int bk = tid >> 5, bn = (tid & 31) * 4;
    int wcol;
    { const int nv = tn * 128 + bn; wcol = FFNMAP ? (((nv >> 5) & 1) * FFN + (nv >> 6) * 32 + (nv & 31)) : nv; }
    const bool bvalid = wcol < ncols;
    for (int k0 = 0; k0 < K; k0 += 32) {
        const u32x4 a0 = *(const u32x4*)(ap + k0), a1 = *(const u32x4*)(ap + k0 + 8);
        f32x4 bv[4];
#pragma unroll
        for (int i = 0; i < 4; ++i) bv[i] = bvalid ? *(const f32x4*)(W + (size_t)(k0 + bk + 8 * i) * ldw + wcol) : (f32x4){0.f, 0.f, 0.f, 0.f};
        __syncthreads();
        *(u32x4*)(As + arow * 40 + acol) = a0; *(u32x4*)(As + arow * 40 + acol + 8) = a1;
#pragma unroll
        for (int i = 0; i < 4; ++i)
#pragma unroll
            for (int e = 0; e < 4; ++e) Bs[(bn + e) * 40 + bk + 8 * i] = (bf16_t)f2bf(bv[i][e]);
        __syncthreads();
#pragma unroll
        for (int ks = 0; ks < 2; ++ks) {
            bf16x8 af[2], bfr[2];
#pragma unroll
            for (int mi = 0; mi < 2; ++mi) af[mi] = *(const bf16x8*)(As + (wm * 64 + mi * 32 + r32) * 40 + ks * 16 + hi * 8);
#pragma unroll
            for (int ni = 0; ni < 2; ++ni) bfr[ni] = *(const bf16x8*)(Bs + (wn * 64 + ni * 32 + r32) * 40 + ks * 16 + hi * 8);
#pragma unroll
            for (int mi = 0; mi < 2; ++mi)
#pragma unroll
                for (int ni = 0; ni < 2; ++ni) acc[mi][ni] = __builtin_amdgcn_mfma_f32_32x32x16_bf16(af[mi], bfr[ni], acc[mi][ni], 0, 0, 0);
        }
    }
    if (active) E(acc, tm * 128 + wm * 64, tn * 128 + wn * 64, r32, hi);
}
template <class Epi, bool FFNMAP>
__device__ __forceinline__ void gemm_phase_simple(int tid_, unsigned char* lds, const bf16_t* A, int lda, int M, const float* W, int ldw, int ncols, int nvirt, int K, const Epi& E) {
    const int half = tid_ >> 8, vt = tid_ & 255, ntm = M / 128, ntn = (nvirt + 127) / 128, nt = ntm * ntn, nvb = 2 * gridDim.x;
    bf16_t* As = (bf16_t*)(lds + half * 32768); bf16_t* Bs = As + 128 * 40;
    for (int base = 0; base < nt; base += nvb) {
        const int tile = base + blockIdx.x * 2 + half; const bool active = tile < nt; const int t = active ? tile : nt - 1;
        gemm_tile<Epi, FFNMAP>(A, lda, W, ldw, ncols, K, t / ntn, t % ntn, active, E, vt, As, Bs);
        __syncthreads();
    }
}
#define FOR_ACC(...) _Pragma("unroll") for (int mi = 0; mi < 2; ++mi) _Pragma("unroll") for (int ni = 0; ni < 2; ++ni) _Pragma("unroll") for (int r = 0; r < 16; ++r) { \
    const int m = m0 + mi * 32 + (r & 3) + 8 * (r >> 2) + 4 * hi, n = n0 + ni * 32 + r32; const float v = acc[mi][ni][r]; __VA_ARGS__ }
struct EpiIn {
    unsigned char* ws;
    __device__ __forceinline__ void operator()(const f32x16 (&acc)[2][2], int m0, int n0, int r32, int hi) const {
        FOR_ACC({
            if (n < C_MLK) ((bf16_t*)(ws + WS_MLQ))[(size_t)m * 1024 + n] = (bf16_t)f2bf(v);
            else if (n < C_MLV) ((bf16_t*)(ws + WS_MLK))[(size_t)m * 1024 + n - C_MLK] = (bf16_t)f2bf(v * 0.0625f);
            else if (n < C_MLO) ((bf16_t*)(ws + WS_MLV))[(size_t)m * 1024 + n - C_MLV] = (bf16_t)f2bf(v);
            else if (n < C_MLIF) ((bf16_t*)(ws + WS_MLO))[(size_t)m * 1024 + n - C_MLO] = (bf16_t)f2bf(sigmoidf_(v));
            else if (n < C_MQ) ((float*)(ws + WS_KVA))[(size_t)m * KVAW + 576 + n - C_MLIF] = v;
            else if (n < C_KVA) ((bf16_t*)(ws + WS_MQ))[(size_t)m * 1536 + n - C_MQ] = (bf16_t)f2bf(v);
            else if (n < C_S5U) ((float*)(ws + WS_KVA))[(size_t)m * KVAW + n - C_KVA] = v;
            else if (n < C_DFQ) ((bf16_t*)(ws + WS_S5U))[(size_t)m * 1024 + n - C_S5U] = (bf16_t)f2bf(v);
            else if (n < C_DFK) ((bf16_t*)(ws + WS_DFQ))[(size_t)m * 1024 + n - C_DFQ] = (bf16_t)f2bf(v);
            else if (n < C_DFV) ((bf16_t*)(ws + WS_DFK))[(size_t)m * 1024 + n - C_DFK] = (bf16_t)f2bf(v);
            else if (n < MIX_COLS) ((bf16_t*)(ws + WS_DFV))[(size_t)m * 1024 + n - C_DFV] = (bf16_t)f2bf(v);
        })
    }
};
struct EpiGate {
    bf16_t* gs;
    __device__ __forceinline__ void operator()(const f32x16 (&acc)[2][2], int m0, int n0, int r32, int hi) const {
        FOR_ACC({ gs[(size_t)m * GATE_COLS + n] = (bf16_t)f2bf(sigmoidf_(v)); })
    }
};
struct EpiKvb {
    bf16_t* kf; bf16_t* vf;
    __device__ __forceinline__ void operator()(const f32x16 (&acc)[2][2], int m0, int n0, int r32, int hi) const {
        FOR_ACC({ const int h = n >> 8, j = n & 255;
            if (j < 128) kf[(size_t)m * 1536 + h * 192 + j] = (bf16_t)f2bf(v); else vf[(size_t)m * 1024 + h * 128 + j - 128] = (bf16_t)f2bf(v); })
    }
};
struct EpiGlu {
    const bf16_t* g; bf16_t* y;
    __device__ __forceinline__ void operator()(const f32x16 (&acc)[2][2], int m0, int n0, int r32, int hi) const {
        FOR_ACC({ const size_t i = (size_t)m * 1024 + n; y[i] = (bf16_t)f2bf(bf2f(g[i]) * sigmoidf_(v)); })
    }
};
struct EpiMerge {
    const bf16_t* gs; bf16_t* mg; int b; int pad;
    __device__ __forceinline__ void operator()(const f32x16 (&acc)[2][2], int m0, int n0, int r32, int hi) const {
        FOR_ACC({ const size_t i = (size_t)m * D + n; const float prev = b ? bf2f(mg[i]) : 0.f; mg[i] = (bf16_t)f2bf(prev + bf2f(gs[(size_t)m * GATE_COLS + b * D + n]) * v); })
    }
};
struct EpiRes {
    P p; int l; int goff;
    int from_x; int pad;
    __device__ __forceinline__ void operator()(const f32x16 (&acc)[2][2], int m0, int n0, int r32, int hi) const {
        float* X = (float*)(p.ws + WS_X);
        FOR_ACC({ const float* src = from_x ? X + (size_t)m * D : x_src(p, l, m);
            const float g = ((const float*)(p.ws + WS_MOD))[((size_t)l * 5 + cond_of_row(m)) * 12288 + goff + n];
            X[(size_t)m * D + n] = src[n] + g * v; })
    }
};
struct EpiFfnIn {
    bf16_t* hh;
    __device__ __forceinline__ void operator()(const f32x16 (&acc)[2][2], int m0, int n0, int r32, int hi) const {
#pragma unroll
        for (int mi = 0; mi < 2; ++mi)
#pragma unroll
            for (int r = 0; r < 16; ++r) { const int m = m0 + mi * 32 + (r & 3) + 8 * (r >> 2) + 4 * hi, i = (n0 >> 6) * 32 + r32;
                hh[(size_t)m * FFN + i] = (bf16_t)f2bf(siluf_(acc[mi][0][r]) * acc[mi][1][r]); }
    }
};

namespace pg8 {
#define PG8_LAS __attribute__((address_space(3)))
typedef unsigned short bf16_t;
typedef short bf16x8 __attribute__((ext_vector_type(8)));
typedef float f32x4 __attribute__((ext_vector_type(4)));
typedef unsigned u32x4 __attribute__((ext_vector_type(4)));
constexpr int BM = 256, BK = 64, HALF = 128, HTB = HALF * BK * 2  , STAGE_BYTES = 8 * HTB, NXCD = 8, WGM = 8;

__host__ __device__ __forceinline__ int lds_byte(int r, int c) { const int st = (r >> 4) * 2 + (c >> 5), rr = r & 15, cc = c & 31, ob = rr * 64 + cc * 2; return st * 1024 + (ob ^ (((ob >> 9) & 1) << 5)); }
__host__ __device__ __forceinline__ void stage_rc(int b, int& R, int& C) { const int st = b / 1024, sb = b % 1024, swz = sb ^ (((sb >> 9) & 1) << 5); R = (st >> 1) * 16 + swz / 64; C = (st & 1) * 32 + (swz % 64) / 2; }
__host__ __device__ __forceinline__ int perm32(int rho) { const int n = rho >> 4, i = rho & 15; return 8 * (i >> 2) + 4 * n + (i & 3); }

struct Unit { int pm, pn; };
struct Gemm { const bf16_t* A; const bf16_t* Bt; int M, N, K; };

struct StaticOrder {
    int nM, nN, nwg, G, c;
    __host__ __device__ void init(int M, int N, int G_, int c_) { nM = M / BM; nN = N / BM; nwg = nM * nN; G = G_; c = c_; }
    __host__ __device__ bool next(int i, Unit& u) const {
        const long L = (long)i * G + c; if (L >= nwg) return false;
        int wgid = (int)L; { const int q = nwg / NXCD, r = nwg % NXCD, xcd = wgid % NXCD, off = wgid / NXCD; wgid = (xcd < r ? xcd * (q + 1) : r * (q + 1) + (xcd - r) * q) + off; }
        const int nig = WGM * nN, gid = wgid / nig, fm = gid * WGM, gsz = (nM - fm) < WGM ? (nM - fm) : WGM;
        u.pm = fm + ((wgid % nig) % gsz); u.pn = (wgid % nig) / gsz; return true;
    }
    __device__ __forceinline__ void a_ready(const Unit&) const {}
    __device__ __forceinline__ void done(const Unit&) const {}
};

__device__ __forceinline__ unsigned cvt_pk_bf16(float lo, float hi) { unsigned r; asm volatile("v_cvt_pk_bf16_f32 %0, %1, %2" : "=v"(r) : "v"(lo), "v"(hi)); return r; }

template <class Epi, class Sched, bool ALIGN_EPI = false, bool SP2 = false>
__device__ __forceinline__ void gemm_phase(PG8_LAS unsigned char* lds, const Gemm g, const Sched& S, const Epi& E, int tid_in) {
    int tid_l = tid_in; asm volatile("" : "+v"(tid_l));
    const int tid = tid_l, wid = __builtin_amdgcn_readfirstlane(tid >> 6), lane = tid & 63, wr = wid >> 2, wc = wid & 3, fr = lane & 15, fq = lane >> 4;
    const int K = g.K, nt = K / BK;
    unsigned voffA[2], voffB[2];
#pragma unroll
    for (int i = 0; i < 2; ++i) { int R, C; stage_rc(tid * 16 + i * 8192, R, C); const int Rb = Epi::PERM ? ((R & ~31) + perm32(R & 31)) : R;
        voffA[i] = (unsigned)(R * K + C) * 2u; voffB[i] = (unsigned)(Rb * K + C) * 2u; }
    const size_t kstep = (size_t)(BK * 2);
    const size_t hstep = (size_t)HALF * K * 2;
    const size_t tstep = 2 * hstep;
    const unsigned ldsw = (unsigned)wid * 1024u;
    const int aoff = lds_byte(wr * 64 + fr, fq * 8), boff = lds_byte(wc * 32 + fr, fq * 8);
#define PG8_SA(b, h) (((b) * 2 + (h)) * HTB)
#define PG8_SB(b, h) ((4 + (b) * 2 + (h)) * HTB)
#define PG8_STAGE(bufoff, gbase, voff) do { _Pragma("unroll") for (int _i = 0; _i < 2; ++_i) \
        __builtin_amdgcn_global_load_lds((const unsigned*)((const char*)(gbase) + (voff)[_i]), (PG8_LAS unsigned*)(lds + (bufoff) + ldsw + _i * 8192), 16, 0, 0); } while (0)
#define PG8_LDA(dst, b, h) do { _Pragma("unroll") for (int m = 0; m < 4; ++m) _Pragma("unroll") for (int k = 0; k < 2; ++k) dst[m][k] = *(const PG8_LAS bf16x8*)(lds + PG8_SA(b, h) + aoff + m * 2048 + k * 1024); } while (0)
#define PG8_LDB(dst, b, h) do { _Pragma("unroll") for (int n = 0; n < 2; ++n) _Pragma("unroll") for (int k = 0; k < 2; ++k) dst[n][k] = *(const PG8_LAS bf16x8*)(lds + PG8_SB(b, h) + boff + n * 2048 + k * 1024); } while (0)
#define PG8_MMA(ai, bj, At, Bt) do { __builtin_amdgcn_s_setprio(1); _Pragma("unroll") for (int m = 0; m < 4; ++m) _Pragma("unroll") for (int n = 0; n < 2; ++n) _Pragma("unroll") for (int k = 0; k < 2; ++k) \
        acc[ai][bj][m][n] = __builtin_amdgcn_mfma_f32_16x16x32_bf16(Bt[n][k], At[m][k], acc[ai][bj][m][n], 0, 0, 0); __builtin_amdgcn_s_setprio(0); } while (0)
#define PG8_WAIT_V(n) asm volatile("s_waitcnt vmcnt(" #n ")" ::: "memory")
#define PG8_WAIT_L(n) asm volatile("s_waitcnt lgkmcnt(" #n ")" ::: "memory")
#define PG8_BAR __builtin_amdgcn_s_barrier()
#define PG8_SCHED __builtin_amdgcn_sched_barrier(0)
    Unit cur, nxt; int ui = 0;
    if (!S.next(0, cur)) return;
    f32x4 acc[2][2][4][2];
    { float z0 = 0.f; asm volatile("" : "+v"(z0));
#pragma unroll
    for (int a = 0; a < 2; ++a)
#pragma unroll
        for (int b = 0; b < 2; ++b)
#pragma unroll
            for (int m = 0; m < 4; ++m)
#pragma unroll
                for (int n = 0; n < 2; ++n) acc[a][b][m][n] = (f32x4){z0, z0, z0, z0}; }
    bf16x8 At[4][2], B0[2][2], B1[2][2];
    const char* cA = (const char*)g.A + (size_t)cur.pm * tstep; const char* cB = (const char*)g.Bt + (size_t)cur.pn * tstep;
    S.a_ready(cur);
    if constexpr (SP2) {
        PG8_STAGE(PG8_SB(0, 0), cB, voffB); PG8_STAGE(PG8_SB(0, 1), cB + hstep, voffB); PG8_STAGE(PG8_SA(0, 0), cA, voffA); PG8_STAGE(PG8_SA(0, 1), cA + hstep, voffA);
        if (wr == 1) PG8_BAR;
        PG8_WAIT_V(2); PG8_BAR;
        PG8_STAGE(PG8_SB(1, 0), cB + kstep, voffB); PG8_STAGE(PG8_SA(1, 0), cA + kstep, voffA); PG8_STAGE(PG8_SB(1, 1), cB + hstep + kstep, voffB);
        PG8_WAIT_V(6); PG8_BAR;
    } else {
        PG8_STAGE(PG8_SB(0, 0), cB, voffB); PG8_STAGE(PG8_SA(0, 0), cA, voffA); PG8_STAGE(PG8_SB(0, 1), cB + hstep, voffB); PG8_STAGE(PG8_SA(0, 1), cA + hstep, voffA);
        if (wr == 1) PG8_BAR;
        PG8_WAIT_V(4); PG8_BAR;
        PG8_STAGE(PG8_SB(1, 0), cB + kstep, voffB); PG8_STAGE(PG8_SA(1, 0), cA + kstep, voffA); PG8_STAGE(PG8_SB(1, 1), cB + hstep + kstep, voffB);
        PG8_WAIT_V(6); PG8_BAR;
    }
    for (;;) {
        const bool has_next = S.next(ui + 1, nxt);
        const char* nA = has_next ? (const char*)g.A + (size_t)nxt.pm * tstep : cA; const char* nB = has_next ? (const char*)g.Bt + (size_t)nxt.pn * tstep : cB;
        for (int t = 0; t < nt; t += 2) {
            const bool last = (t == nt - 2);
            const char* a1 = cA + (size_t)(t + 1) * kstep;
            const char* a2 = last ? nA : cA + (size_t)(t + 2) * kstep; const char* b2 = last ? nB : cB + (size_t)(t + 2) * kstep;
            const char* a3 = a2 + kstep; const char* b3 = b2 + kstep;
            if (last && has_next) S.a_ready(nxt);
            if constexpr (SP2) {
            PG8_LDB(B0, 0, 0); PG8_LDB(B1, 0, 1); PG8_SCHED; PG8_LDA(At, 0, 0); PG8_STAGE(PG8_SA(1, 1), a1 + hstep, voffA);
            PG8_WAIT_V(8); PG8_WAIT_L(0); PG8_BAR; PG8_MMA(0, 0, At, B0); PG8_MMA(0, 1, At, B1); PG8_BAR; PG8_SCHED;
            PG8_LDA(At, 0, 1); PG8_STAGE(PG8_SB(0, 0), b2, voffB); PG8_STAGE(PG8_SB(0, 1), b2 + hstep, voffB); PG8_STAGE(PG8_SA(0, 0), a2, voffA);
            PG8_WAIT_V(8); PG8_WAIT_L(0); PG8_BAR; PG8_MMA(1, 0, At, B0); PG8_MMA(1, 1, At, B1); PG8_BAR; PG8_SCHED;
            PG8_LDB(B0, 1, 0); PG8_LDB(B1, 1, 1); PG8_SCHED; PG8_LDA(At, 1, 0); PG8_STAGE(PG8_SA(0, 1), a2 + hstep, voffA);
            PG8_WAIT_V(8); PG8_WAIT_L(0); PG8_BAR; PG8_MMA(0, 0, At, B0); PG8_MMA(0, 1, At, B1); PG8_BAR; PG8_SCHED;
            PG8_LDA(At, 1, 1); PG8_STAGE(PG8_SB(1, 0), b3, voffB); PG8_STAGE(PG8_SB(1, 1), b3 + hstep, voffB); PG8_STAGE(PG8_SA(1, 0), a3, voffA);
            PG8_WAIT_V(8); PG8_WAIT_L(0); PG8_BAR; PG8_MMA(1, 0, At, B0); PG8_MMA(1, 1, At, B1); PG8_BAR; PG8_SCHED;
            } else {
            PG8_LDB(B0, 0, 0); PG8_SCHED; PG8_LDA(At, 0, 0); PG8_STAGE(PG8_SA(1, 1), a1 + hstep, voffA);
            PG8_WAIT_L(8); PG8_BAR; PG8_WAIT_L(0); PG8_MMA(0, 0, At, B0); PG8_BAR; PG8_SCHED;
            PG8_LDB(B1, 0, 1); PG8_STAGE(PG8_SB(0, 0), b2, voffB);
            PG8_BAR; PG8_WAIT_L(0); PG8_MMA(0, 1, At, B1); PG8_BAR;
            PG8_LDA(At, 0, 1); PG8_STAGE(PG8_SA(0, 0), a2, voffA);
            PG8_BAR; PG8_WAIT_L(0); PG8_MMA(1, 0, At, B0); PG8_BAR; PG8_SCHED;
            PG8_STAGE(PG8_SB(0, 1), b2 + hstep, voffB);
            PG8_WAIT_V(6); PG8_BAR; PG8_MMA(1, 1, At, B1); PG8_BAR;
            PG8_LDB(B0, 1, 0); PG8_SCHED; PG8_LDA(At, 1, 0); PG8_STAGE(PG8_SA(0, 1), a2 + hstep, voffA);
            PG8_WAIT_L(8); PG8_BAR; PG8_WAIT_L(0); PG8_MMA(0, 0, At, B0); PG8_BAR; PG8_SCHED;
            PG8_LDB(B1, 1, 1); PG8_STAGE(PG8_SB(1, 0), b3, voffB);
            PG8_BAR; PG8_WAIT_L(0); PG8_MMA(0, 1, At, B1); PG8_BAR;
            PG8_LDA(At, 1, 1); PG8_STAGE(PG8_SA(1, 0), a3, voffA);
            PG8_BAR; PG8_WAIT_L(0); PG8_MMA(1, 0, At, B0); PG8_BAR; PG8_SCHED;
            PG8_STAGE(PG8_SB(1, 1), b3 + hstep, voffB);
            PG8_WAIT_V(6); PG8_BAR; PG8_MMA(1, 1, At, B1); PG8_BAR;
            }
        }
        if constexpr (ALIGN_EPI) { if (wr == 0) PG8_BAR; }
        if constexpr (!Epi::AFTER_DRAIN) { E(acc, cur, wr, wc, fr, fq); S.done(cur); }
        if (!has_next) break;
        { float z0 = 0.f; asm volatile("" : "+v"(z0));
#pragma unroll
        for (int a = 0; a < 2; ++a)
#pragma unroll
            for (int b = 0; b < 2; ++b)
#pragma unroll
                for (int m = 0; m < 4; ++m)
#pragma unroll
                    for (int n = 0; n < 2; ++n) acc[a][b][m][n] = (f32x4){z0, z0, z0, z0}; }
        cur = nxt; cA = nA; cB = nB; ++ui;
        if constexpr (ALIGN_EPI) { if (wr == 1) PG8_BAR; }
    }
    PG8_WAIT_V(0);
    if constexpr (!ALIGN_EPI) { if (wr == 0) PG8_BAR; }
    PG8_BAR;
    if constexpr (Epi::AFTER_DRAIN) { E.fused(acc, cur, wr, wc, fr, fq, lds, wid, lane); S.done(cur); }
#undef PG8_SA
#undef PG8_SB
#undef PG8_STAGE
#undef PG8_LDA
#undef PG8_LDB
#undef PG8_MMA
#undef PG8_WAIT_V
#undef PG8_WAIT_L
#undef PG8_BAR
#undef PG8_SCHED
}
}

#define PG8_ROW(ai, m) (u.pm * 256 + (ai) * 128 + wr * 64 + (m) * 16 + fr)
#define PG8_FOR(...) _Pragma("unroll") for (int ai = 0; ai < 2; ++ai) _Pragma("unroll") for (int m = 0; m < 4; ++m) { const int row = PG8_ROW(ai, m); _Pragma("unroll") for (int bj = 0; bj < 2; ++bj) { \
    const int ct = bj * 128 + wc * 32 + 8 * fq; const pg8::f32x4 v0 = acc[ai][bj][m][0], v1 = acc[ai][bj][m][1]; __VA_ARGS__ } }
__device__ __forceinline__ u32x4 pack8(const pg8::f32x4& a, const pg8::f32x4& b) { u32x4 w; w.x = pg8::cvt_pk_bf16(a[0], a[1]); w.y = pg8::cvt_pk_bf16(a[2], a[3]); w.z = pg8::cvt_pk_bf16(b[0], b[1]); w.w = pg8::cvt_pk_bf16(b[2], b[3]); return w; }
__device__ __forceinline__ void unpack8(const u32x4& w, float (&f)[8]) {
#pragma unroll
    for (int i = 0; i < 4; ++i) { f[2 * i] = bf2f(w[i]); f[2 * i + 1] = bf2f(w[i] >> 16); } }

struct Epi8In {
    static constexpr bool PERM = true, AFTER_DRAIN = false;
    unsigned char* ws;
    __device__ __forceinline__ void operator()(const pg8::f32x4 (&acc)[2][2][4][2], const pg8::Unit& u, int wr, int wc, int fr, int fq) const {
        const int pn = u.pn;
        if (pn >= 22 && pn < 25) {
            float* kva = (float*)(ws + WS_KVA);
            PG8_FOR({ float* o = kva + (size_t)row * KVAW + (pn - 22) * 256 + ct; *(pg8::f32x4*)o = v0; *(pg8::f32x4*)(o + 4) = v1; })
            return;
        }
        size_t base; int ldc, c0, mode = 0;
        if (pn < 4) { base = WS_MLQ; ldc = 1024; c0 = pn * 256; }
        else if (pn < 8) { base = WS_MLK; ldc = 1024; c0 = (pn - 4) * 256; mode = 1; }
        else if (pn < 12) { base = WS_MLV; ldc = 1024; c0 = (pn - 8) * 256; }
        else if (pn < 16) { base = WS_MLO; ldc = 1024; c0 = (pn - 12) * 256; mode = 2; }
        else if (pn < 22) { base = WS_MQ; ldc = 1536; c0 = (pn - 16) * 256; }
        else if (pn < 29) { base = WS_S5U; ldc = 1024; c0 = (pn - 25) * 256; }
        else if (pn < 33) { base = WS_DFQ; ldc = 1024; c0 = (pn - 29) * 256; }
        else if (pn < 37) { base = WS_DFK; ldc = 1024; c0 = (pn - 33) * 256; }
        else { base = WS_DFV; ldc = 1024; c0 = (pn - 37) * 256; }
        bf16_t* O = (bf16_t*)(ws + base);
        PG8_FOR({ pg8::f32x4 a = v0, b = v1;
            if (mode == 1) { a = a * 0.0625f; b = b * 0.0625f; }
            if (mode == 2) {
_Pragma("unroll")
                for (int e = 0; e < 4; ++e) { a[e] = sigmoidf_(a[e]); b[e] = sigmoidf_(b[e]); } }
            *(u32x4*)(O + (size_t)row * ldc + c0 + ct) = pack8(a, b); })
    }
};
struct Epi8Gate {
    static constexpr bool PERM = true, AFTER_DRAIN = false;
    bf16_t* gs;
    __device__ __forceinline__ void operator()(const pg8::f32x4 (&acc)[2][2][4][2], const pg8::Unit& u, int wr, int wc, int fr, int fq) const {
        PG8_FOR({ pg8::f32x4 a, b;
_Pragma("unroll")
            for (int e = 0; e < 4; ++e) { a[e] = sigmoidf_(v0[e]); b[e] = sigmoidf_(v1[e]); }
            *(u32x4*)(gs + (size_t)row * GATE_COLS + u.pn * 256 + ct) = pack8(a, b); })
    }
};
struct Epi8Kvb {
    static constexpr bool PERM = true, AFTER_DRAIN = false;
    bf16_t* kf; bf16_t* vf;
    __device__ __forceinline__ void operator()(const pg8::f32x4 (&acc)[2][2][4][2], const pg8::Unit& u, int wr, int wc, int fr, int fq) const {
        PG8_FOR({ bf16_t* o = bj == 0 ? kf + (size_t)row * 1536 + u.pn * 192 + wc * 32 + 8 * fq : vf + (size_t)row * 1024 + u.pn * 128 + wc * 32 + 8 * fq; (void)ct;
            *(u32x4*)o = pack8(v0, v1); })
    }
};
struct Epi8Glu {
    static constexpr bool PERM = true, AFTER_DRAIN = false;
    const bf16_t* g; bf16_t* y;
    __device__ __forceinline__ void operator()(const pg8::f32x4 (&acc)[2][2][4][2], const pg8::Unit& u, int wr, int wc, int fr, int fq) const {
        PG8_FOR({ const size_t i = (size_t)row * 1024 + u.pn * 256 + ct; float gf[8]; unpack8(*(const u32x4*)(g + i), gf); pg8::f32x4 a, b;
_Pragma("unroll")
            for (int e = 0; e < 4; ++e) { a[e] = gf[e] * sigmoidf_(v0[e]); b[e] = gf[4 + e] * sigmoidf_(v1[e]); }
            *(u32x4*)(y + i) = pack8(a, b); })
    }
};
struct Epi8Merge {
    static constexpr bool PERM = true, AFTER_DRAIN = false;
    const bf16_t* gs; bf16_t* mg; int b; int pad;
    __device__ __forceinline__ void operator()(const pg8::f32x4 (&acc)[2][2][4][2], const pg8::Unit& u, int wr, int wc, int fr, int fq) const {
        PG8_FOR({ const size_t i = (size_t)row * D + u.pn * 256 + ct; float gf[8], pf[8]; unpack8(*(const u32x4*)(gs + (size_t)row * GATE_COLS + b * D + u.pn * 256 + ct), gf);
            if (b) unpack8(*(const u32x4*)(mg + i), pf); else {
_Pragma("unroll")
                for (int e = 0; e < 8; ++e) pf[e] = 0.f; }
            pg8::f32x4 a, c;
_Pragma("unroll")
            for (int e = 0; e < 4; ++e) { a[e] = pf[e] + gf[e] * v0[e]; c[e] = pf[4 + e] + gf[4 + e] * v1[e]; }
            *(u32x4*)(mg + i) = pack8(a, c); })
    }
};
struct Epi8Res {
    static constexpr bool PERM = true, AFTER_DRAIN = false;
    P p; int l; int goff; int from_x; int pad;
    __device__ __forceinline__ void operator()(const pg8::f32x4 (&acc)[2][2][4][2], const pg8::Unit& u, int wr, int wc, int fr, int fq) const {
        float* X = (float*)(p.ws + WS_X);
        const float* gv = (const float*)(p.ws + WS_MOD) + ((size_t)l * 5 + cond_of_row(u.pm * 256)) * 12288 + goff + u.pn * 256;
        PG8_FOR({ const float* src = (from_x ? X + (size_t)row * D : x_src(p, l, row)) + u.pn * 256 + ct; float* dst = X + (size_t)row * D + u.pn * 256 + ct;
            const pg8::f32x4 g0 = *(const pg8::f32x4*)(gv + ct), g1 = *(const pg8::f32x4*)(gv + ct + 4), s0 = *(const pg8::f32x4*)src, s1 = *(const pg8::f32x4*)(src + 4);
            *(pg8::f32x4*)dst = s0 + g0 * v0; *(pg8::f32x4*)(dst + 4) = s1 + g1 * v1; })
    }
};
struct Epi8FfnIn {
    static constexpr bool PERM = true, AFTER_DRAIN = false;
    bf16_t* hh;
    __device__ __forceinline__ void operator()(const pg8::f32x4 (&acc)[2][2][4][2], const pg8::Unit& u, int wr, int wc, int fr, int fq) const {
_Pragma("unroll")
        for (int ai = 0; ai < 2; ++ai)
_Pragma("unroll")
            for (int m = 0; m < 4; ++m) { const int row = PG8_ROW(ai, m); pg8::f32x4 a, b;
_Pragma("unroll")
                for (int e = 0; e < 4; ++e) { a[e] = siluf_(acc[ai][0][m][0][e]) * acc[ai][1][m][0][e]; b[e] = siluf_(acc[ai][0][m][1][e]) * acc[ai][1][m][1][e]; }
                *(u32x4*)(hh + (size_t)row * FFN + u.pn * 128 + wc * 32 + 8 * fq) = pack8(a, b); }
    }
};

__device__ __forceinline__ int win_row(int n) {
    if (n < 4096) return n;
    if (n < 4112) return 6208 + (n - 4096);
    if (n < 5648) return 4096 + (n - 4112);
    if (n < 6224) return 5632 + (n - 5648);
    if (n < MIX_COLS) return 6400 + (n - 6224);
    return 10496 + (n - MIX_COLS);
}
template <int MAP>
__device__ __forceinline__ void cvt_item(const float* W, int K, int N, bf16_t* WT, int row_off, LAS float* scr, int item, int lane) {
    const int nblk = (N + 31) / 32, kb = item / nblk, nb = item % nblk, k0 = 64 * kb, n0 = 32 * nb;
    const int nl = (lane & 7) * 4, kr = lane >> 3;
    const bool nok = n0 + nl < N;
    const float* wp = W + (size_t)(k0 + kr) * N + n0 + nl;
    f32x4 v[8];
#pragma unroll
    for (int i = 0; i < 8; ++i) v[i] = nok ? *(const f32x4*)(wp + (size_t)(8 * i) * N) : (f32x4){0.f, 0.f, 0.f, 0.f};
#pragma unroll
    for (int i = 0; i < 8; ++i) { LAS float* d = scr + (kr + 8 * i) * 33 + nl; d[0] = v[i][0]; d[1] = v[i][1]; d[2] = v[i][2]; d[3] = v[i][3]; }
    asm volatile("s_waitcnt lgkmcnt(0)" ::: "memory");
    const int c = lane & 7;
#pragma unroll
    for (int j = 0; j < 4; ++j) { const int n = (lane >> 3) + 8 * j; const LAS float* s = scr + (8 * c) * 33 + n;
        u32x4 o; o.x = pk2(s[0 * 33], s[1 * 33]); o.y = pk2(s[2 * 33], s[3 * 33]); o.z = pk2(s[4 * 33], s[5 * 33]); o.w = pk2(s[6 * 33], s[7 * 33]);
        const int ng = n0 + n; int row;
        if (MAP == 0) row = row_off + ng; else if (MAP == 1) row = win_row(ng); else row = (ng < FFN) ? ((ng >> 7) * 256 + (ng & 127)) : (((ng - FFN) >> 7) * 256 + 128 + ((ng - FFN) & 127));
        if (ng < N) *(u32x4*)(WT + (size_t)row * K + k0 + 8 * c) = o; }
    asm volatile("s_waitcnt lgkmcnt(0)" ::: "memory");
}
constexpr size_t WB_IN = 0, WB_KVB = 73 * MiB, WB_GLU = 75 * MiB, WB_BR = 77 * MiB, WB_O = 93 * MiB, WB_FIN = 101 * MiB, WB_FOUT = 145 * MiB, WB_END = 167 * MiB;
constexpr int NIN_T = 18688;
__device__ __forceinline__ void ph_convert(const P& p, int l, int gw, int NGW, int lane, LAS float* scr) {
    unsigned char* wb = p.ws + WS_WBF;
    constexpr int I_IN = (D / 64) * ((IN_COLS + 31) / 32), I_KVB = (512 / 64) * (2048 / 32), I_GLU = (1024 / 64) * (1024 / 32), I_BR = (1024 / 64) * (2048 / 32), I_O = (D / 64) * (D / 32),
                  I_FIN = (D / 64) * (2 * FFN / 32), I_FOUT = (FFN / 64) * (D / 32);
    constexpr int NIT = I_IN + I_KVB + I_GLU + 4 * I_BR + I_O + I_FIN + I_FOUT;
    for (int it = gw; it < NIT; it += NGW) {
        int r = it;
        if (r < I_IN) { cvt_item<1>(p.in[17] + (size_t)l * D * IN_COLS, D, IN_COLS, (bf16_t*)(wb + WB_IN), 0, scr, r, lane); continue; } r -= I_IN;
        if (r < I_KVB) { cvt_item<0>(p.in[21] + (size_t)l * 512 * 2048, 512, 2048, (bf16_t*)(wb + WB_KVB), 0, scr, r, lane); continue; } r -= I_KVB;
        if (r < I_GLU) { cvt_item<0>(p.in[30] + (size_t)l * 1024 * 1024, 1024, 1024, (bf16_t*)(wb + WB_GLU), 0, scr, r, lane); continue; } r -= I_GLU;
        if (r < 4 * I_BR) { const int b = r / I_BR; cvt_item<0>(p.in[33] + ((size_t)l * 4 + b) * 1024 * 2048, 1024, 2048, (bf16_t*)(wb + WB_BR) + (size_t)b * 2048 * 1024, 0, scr, r % I_BR, lane); continue; } r -= 4 * I_BR;
        if (r < I_O) { cvt_item<0>(p.in[34] + (size_t)l * D * D, D, D, (bf16_t*)(wb + WB_O), 0, scr, r, lane); continue; } r -= I_O;
        if (r < I_FIN) { cvt_item<2>(p.in[35] + (size_t)l * D * 2 * FFN, D, 2 * FFN, (bf16_t*)(wb + WB_FIN), 0, scr, r, lane); continue; } r -= I_FIN;
        cvt_item<0>(p.in[36] + (size_t)l * FFN * D, FFN, D, (bf16_t*)(wb + WB_FOUT), 0, scr, r, lane);
    }
    for (int row = 6224 + gw; row < 6400; row += NGW) { u32x4* o = (u32x4*)((bf16_t*)(wb + WB_IN) + (size_t)row * D); for (int j = lane; j < D / 8; j += 64) o[j] = (u32x4){0u, 0u, 0u, 0u}; }
}


namespace fa {
typedef short s16x4 __attribute__((ext_vector_type(4)));
__device__ __forceinline__ int crow(int r, int hi) { return (r & 3) + 8 * (r >> 2) + 4 * hi; }
__device__ __forceinline__ unsigned cvtpk(float lo, float hi) { unsigned r; asm volatile("v_cvt_pk_bf16_f32 %0, %1, %2" : "=v"(r) : "v"(lo), "v"(hi)); return r; }
#define FA_SBAR() __builtin_amdgcn_sched_barrier(0)
constexpr float THR = 8.f;
__device__ __forceinline__ void partialSM(f32x16& p0, f32x16& p1, float& m_reg, float& mn, float& alpha, float SCALE) {
    const float C = SCALE * 1.4426950408889634f;
    float pmax = p0[0];
#pragma unroll
    for (int r = 1; r < 16; ++r) pmax = fmaxf(pmax, p0[r]);
#pragma unroll
    for (int r = 0; r < 16; ++r) pmax = fmaxf(pmax, p1[r]);
    { auto rr = __builtin_amdgcn_permlane32_swap(__float_as_uint(pmax), __float_as_uint(pmax), false, false);
      pmax = fmaxf(__uint_as_float(rr[0]), __uint_as_float(rr[1])); }
    if (__builtin_expect(__all(pmax - m_reg <= THR / SCALE), 1)) { mn = m_reg; alpha = 1.f; }
    else { mn = fmaxf(m_reg, pmax); alpha = __builtin_amdgcn_exp2f((m_reg - mn) * C); m_reg = mn; }
    const float mnC = -mn * C;
#pragma unroll
    for (int r = 0; r < 16; ++r) p0[r] = fmaf(p0[r], C, mnC);
#pragma unroll
    for (int r = 0; r < 16; ++r) p1[r] = fmaf(p1[r], C, mnC);
#pragma unroll
    for (int r = 0; r < 16; ++r) p0[r] = __builtin_amdgcn_exp2f(p0[r]);
}
__device__ __forceinline__ void finishSM(f32x16& p0, f32x16& p1, float alpha, float& l_reg, bf16x8& pa0, bf16x8& pa1, bf16x8& pa2, bf16x8& pa3) {
#pragma unroll
    for (int r = 0; r < 16; ++r) p1[r] = __builtin_amdgcn_exp2f(p1[r]);
    float ps = 0;
#pragma unroll
    for (int r = 0; r < 16; ++r) ps += p0[r];
#pragma unroll
    for (int r = 0; r < 16; ++r) ps += p1[r];
    { auto rr = __builtin_amdgcn_permlane32_swap(__float_as_uint(ps), __float_as_uint(ps), false, false);
      ps = __uint_as_float(rr[0]) + __uint_as_float(rr[1]); }
    l_reg = l_reg * alpha + ps;
#define FA_PK4(P, BASE, OUT) do { unsigned a0 = cvtpk(P[BASE + 0], P[BASE + 1]), a1 = cvtpk(P[BASE + 2], P[BASE + 3]);   \
    unsigned b0 = cvtpk(P[BASE + 4], P[BASE + 5]), b1 = cvtpk(P[BASE + 6], P[BASE + 7]);                              \
    auto r0 = __builtin_amdgcn_permlane32_swap(a0, b0, false, false); auto r1 = __builtin_amdgcn_permlane32_swap(a1, b1, false, false); \
    u32x4 w = {r0[0], r1[0], r0[1], r1[1]}; OUT = *reinterpret_cast<bf16x8*>(&w); } while (0)
    FA_PK4(p0, 0, pa0); FA_PK4(p0, 8, pa1); FA_PK4(p1, 0, pa2); FA_PK4(p1, 8, pa3);
#undef FA_PK4
}
__device__ __forceinline__ int v_rd_base(int lane) { return ((lane & 3) << 3) | (((lane >> 2) & 3) << 6) | (((lane >> 4) & 1) << 5) | (((lane >> 5) & 1) << 8); }
constexpr int v_rd_off(int d0, int ks, int half) { return d0 * 512 + ks * 4096 + half * 2048; }
template <int OFF> __device__ __forceinline__ s16x4 tr_read(unsigned vb) {
    s16x4 r; asm volatile("ds_read_b64_tr_b16 %0, %1 offset:%2" : "=&v"(r) : "v"(vb), "i"(OFF) : "memory"); return r;
}
template <int D0> __device__ __forceinline__ void pv_one(f32x16& od, unsigned vb, bf16x8 pa0, bf16x8 pa1, bf16x8 pa2, bf16x8 pa3) {
    const s16x4 l0 = tr_read<v_rd_off(D0, 0, 0)>(vb), h0 = tr_read<v_rd_off(D0, 0, 1)>(vb), l1 = tr_read<v_rd_off(D0, 1, 0)>(vb), h1 = tr_read<v_rd_off(D0, 1, 1)>(vb);
    const s16x4 l2 = tr_read<v_rd_off(D0, 2, 0)>(vb), h2 = tr_read<v_rd_off(D0, 2, 1)>(vb), l3 = tr_read<v_rd_off(D0, 3, 0)>(vb), h3 = tr_read<v_rd_off(D0, 3, 1)>(vb);
    asm volatile("s_waitcnt lgkmcnt(0)" ::: "memory"); FA_SBAR();
#define FA_PK(L, H) (bf16x8){L[0], L[1], L[2], L[3], H[0], H[1], H[2], H[3]}
    od = __builtin_amdgcn_mfma_f32_32x32x16_bf16(pa0, FA_PK(l0, h0), od, 0, 0, 0);
    od = __builtin_amdgcn_mfma_f32_32x32x16_bf16(pa1, FA_PK(l1, h1), od, 0, 0, 0);
    od = __builtin_amdgcn_mfma_f32_32x32x16_bf16(pa2, FA_PK(l2, h2), od, 0, 0, 0);
    od = __builtin_amdgcn_mfma_f32_32x32x16_bf16(pa3, FA_PK(l3, h3), od, 0, 0, 0);
#undef FA_PK
}
struct Args { const bf16_t* Q; const bf16_t* K; const bf16_t* V; bf16_t* O; int qpitch, kpitch, vpitch, opitch, nheads, vdiv; float scale; int pad; };

template <int DQK>
__device__ __forceinline__ void attn_phase(LAS unsigned char* lds, const Args& a, int tid) {
    constexpr int KROWB = DQK * 2, KCH = KROWB / 16, KTILE = 64 * KROWB, VTILE = 16384, STAGE = KTILE + VTILE, NKI = KTILE / 8192, NVI = 2, NDMA = NKI + NVI, ND = DQK / 16;
    static_assert(3 * STAGE + 2048 <= 131072, "attention LDS");
    const int wid = __builtin_amdgcn_readfirstlane(tid >> 6), lane = tid & 63, r32 = lane & 31, hi = lane >> 5;
    LAS float* wsc = (LAS float*)(lds + 3 * STAGE) + wid * 64;
    unsigned koff_[NKI], voff_[NVI];
#pragma unroll
    for (int i = 0; i < NKI; ++i) { const int s = i * 512 + wid * 64 + lane, row = s / KCH, ch = s % KCH; koff_[i] = (unsigned)(row * a.kpitch + (ch ^ (row & 7)) * 8) * 2u; }
#pragma unroll
    for (int i = 0; i < NVI; ++i) { const int o = (i * 512 + wid * 64 + lane) * 16, sub = o >> 9, within = o & 511, kk = (sub >> 2) * 8 + (within >> 6), c = (sub & 3) * 32 + ((within & 63) >> 1);
        const int k = (kk & ~0xC) | ((kk & 4) << 1) | ((kk & 8) >> 1); voff_[i] = (unsigned)(k * a.vpitch + c) * 2u; }
    const unsigned vb0 = (unsigned)(uintptr_t)(lds + KTILE) + (unsigned)v_rd_base(lane);
    const int n_lat = a.nheads * 64, n_units = n_lat + a.nheads * 16;
    for (int u = blockIdx.x; u < n_units; u += gridDim.x) {
        int b, h, q0, nk, kbase, cbase;
        if (u < n_lat) { const int bh = u >> 4, qb = u & 15; b = bh / a.nheads; h = bh % a.nheads; q0 = NCTX + b * LL + qb * 256; nk = LL + PAST; kbase = NCTX + b * LL; cbase = MTOK + b * PAST; }
        else { const int v = u - n_lat; b = v / a.nheads; h = v % a.nheads; q0 = b * CL; nk = CL; kbase = b * CL; cbase = 0; }
        const int NT = nk >> 6, vh = h / a.vdiv;
        const bf16_t* Kh = a.K + h * DQK; const bf16_t* Vh = a.V + vh * 128;
#define FA_ISSUE(j) do { const int t0_ = (j) * 64; const int rb_ = (t0_ < LL || nk == CL) ? kbase + t0_ : cbase + (t0_ - LL); LAS unsigned char* st_ = lds + ((j) % 3) * STAGE; \
        const char* kb_ = (const char*)(Kh + (size_t)rb_ * a.kpitch); const char* vb_ = (const char*)(Vh + (size_t)rb_ * a.vpitch); \
        _Pragma("unroll") for (int i_ = 0; i_ < NKI; ++i_) __builtin_amdgcn_global_load_lds((const unsigned*)(kb_ + koff_[i_]), (LAS unsigned*)(st_ + i_ * 8192 + wid * 1024), 16, 0, 0); \
        _Pragma("unroll") for (int i_ = 0; i_ < NVI; ++i_) __builtin_amdgcn_global_load_lds((const unsigned*)(vb_ + voff_[i_]), (LAS unsigned*)(st_ + KTILE + i_ * 8192 + wid * 1024), 16, 0, 0); } while (0)
        bf16x8 qr[ND];
        { const bf16_t* Qw = a.Q + (size_t)(q0 + wid * 32 + r32) * a.qpitch + h * DQK + hi * 8;
#pragma unroll
          for (int d0 = 0; d0 < ND; ++d0) qr[d0] = *(const bf16x8*)(Qw + d0 * 16); }
        float m_reg = -1e30f, l_reg = 0.f; f32x16 o[4];
        float z0 = 0.f; asm volatile("" : "+v"(z0));
#pragma unroll
        for (int d = 0; d < 4; ++d)
#pragma unroll
            for (int r = 0; r < 16; ++r) o[d][r] = z0;
        FA_ISSUE(0); FA_ISSUE(1);
        if (NDMA == 5) asm volatile("s_waitcnt vmcnt(5)" ::: "memory"); else asm volatile("s_waitcnt vmcnt(3)" ::: "memory");
        __builtin_amdgcn_s_barrier(); asm volatile("" ::: "memory");
        for (int j = 0; j < NT; ++j) {
            if (j + 2 < NT) FA_ISSUE(j + 2);
            LAS unsigned char* Ks = lds + (j % 3) * STAGE;
            f32x16 p0, p1;
#pragma unroll
            for (int r = 0; r < 16; ++r) { p0[r] = z0; p1[r] = z0; }
#pragma unroll
            for (int d0 = 0; d0 < ND; ++d0) { const int cb = (d0 * 16 + hi * 8) * 2;
                const bf16x8 b0 = *(const LAS bf16x8*)(Ks + r32 * KROWB + (cb ^ ((r32 & 7) << 4)));
                const bf16x8 b1 = *(const LAS bf16x8*)(Ks + (32 + r32) * KROWB + (cb ^ ((r32 & 7) << 4)));
                p0 = __builtin_amdgcn_mfma_f32_32x32x16_bf16(b0, qr[d0], p0, 0, 0, 0);
                p1 = __builtin_amdgcn_mfma_f32_32x32x16_bf16(b1, qr[d0], p1, 0, 0, 0);
                if ((d0 & 3) == 3) asm volatile("" ::: "memory"); }
            float mn, alpha; partialSM(p0, p1, m_reg, mn, alpha, a.scale);
            if (__any(alpha < 1.f)) { if (hi == 0) wsc[32 + r32] = alpha; asm volatile("s_waitcnt lgkmcnt(0)" ::: "memory");
#pragma unroll
                for (int d = 0; d < 4; ++d)
#pragma unroll
                    for (int r = 0; r < 16; ++r) o[d][r] *= wsc[32 + crow(r, hi)]; }
            bf16x8 pa0, pa1, pa2, pa3; finishSM(p0, p1, alpha, l_reg, pa0, pa1, pa2, pa3); FA_SBAR();
            const unsigned vb = vb0 + (unsigned)((j % 3) * STAGE);
            pv_one<0>(o[0], vb, pa0, pa1, pa2, pa3); pv_one<1>(o[1], vb, pa0, pa1, pa2, pa3); pv_one<2>(o[2], vb, pa0, pa1, pa2, pa3); pv_one<3>(o[3], vb, pa0, pa1, pa2, pa3);
            if (j + 2 < NT) { if (NDMA == 5) asm volatile("s_waitcnt vmcnt(5)" ::: "memory"); else asm volatile("s_waitcnt vmcnt(3)" ::: "memory"); }
            else asm volatile("s_waitcnt vmcnt(0)" ::: "memory");
            asm volatile("s_waitcnt lgkmcnt(0)" ::: "memory");
            __builtin_amdgcn_s_barrier(); asm volatile("" ::: "memory");
        }
#undef FA_ISSUE
        if (hi == 0) wsc[r32] = l_reg; asm volatile("s_waitcnt lgkmcnt(0)" ::: "memory");
        bf16_t* Ow = a.O + (size_t)(q0 + wid * 32) * a.opitch + h * 128 + r32;
#pragma unroll
        for (int r = 0; r < 16; ++r) { const int orow = crow(r, hi); const float rl = __builtin_amdgcn_rcpf(wsc[orow]);
#pragma unroll
            for (int d0 = 0; d0 < 4; ++d0) Ow[(size_t)orow * a.opitch + d0 * 32] = (bf16_t)f2bf(o[d0][r] * rl); }
        asm volatile("s_waitcnt lgkmcnt(0)" ::: "memory");
    }
}
}


namespace ml {
typedef short s16x4 __attribute__((ext_vector_type(4)));
constexpr int QP = 528, VP = 80, CP = 528;
constexpr int L_Q = 0, L_K = 33792, L_V = 67584, L_CT = 72704, L_INT = 89600, L_SC = 97792, L_N = 99840, L_END = 101888;
__device__ __forceinline__ s16x4 trr(unsigned addr) { s16x4 r; asm volatile("ds_read_b64_tr_b16 %0, %1" : "=&v"(r) : "v"(addr) : "memory"); return r; }
__device__ __forceinline__ unsigned cvtpk(float lo, float hi) { unsigned r; asm volatile("v_cvt_pk_bf16_f32 %0, %1, %2" : "=v"(r) : "v"(lo), "v"(hi)); return r; }
__device__ __forceinline__ int crow(int r, int hi) { return (r & 3) + 8 * (r >> 2) + 4 * hi; }

__device__ __forceinline__ void mlstm_phase(LAS unsigned char* lds, const P& p, const int l, const int tid) {
    const int wid = __builtin_amdgcn_readfirstlane(tid >> 6), lane = tid & 63, r32 = lane & 31, hi = lane >> 5;
    const bf16_t* MQ_ = (const bf16_t*)(p.ws + WS_MLQ); const bf16_t* MK_ = (const bf16_t*)(p.ws + WS_MLK); const bf16_t* MV_ = (const bf16_t*)(p.ws + WS_MLV);
    const float* GT = (const float*)(p.ws + WS_GATES);
    LAS float* SC = (LAS float*)(lds + L_SC);
    LAS float* sg = SC; LAS float* sAt = SC + 64; LAS float* swI = SC + 128; LAS float* semt = SC + 192; LAS float* sws = SC + 256; LAS float* sdenI = SC + 320; LAS float* snq = SC + 384; LAS float* smisc = SC + 448;
    const unsigned ldsb = (unsigned)(uintptr_t)lds;
    const int tq = (lane & 15) >> 2, tp = lane & 3, tc0 = 16 * ((lane >> 4) & 1) + 4 * tp;
    for (int u = blockIdx.x; u < 1280; u += gridDim.x) {
        const bool lat = u < 256; const int uu = lat ? u : u - 256, chain = uu >> 3, sl = uu & 7;
        const int b = chain >> 3, h = (chain >> 1) & 3, dir = chain & 1;
        const int L = lat ? LL : CL, base = lat ? NCTX + b * LL : b * CL, NC = L >> 6;
        const int colq = h * 256, colv = h * 256 + sl * 32;
        bf16_t* Hout = (bf16_t*)(p.ws + (dir ? WS_HB : WS_HF));
        f32x16 ct; float m_st = 0.f;
        { float z0 = 0.f; asm volatile("" : "+v"(z0));
#pragma unroll
          for (int r = 0; r < 16; ++r) ct[r] = z0; }
        LAS float* nb0 = (LAS float*)(lds + L_N); LAS float* nb1 = nb0 + 256;
        if (lat) {
            const size_t so = (size_t)((b * 2 + l) * 2 + dir) * 4 + h;
            const float* c0 = p.in[6] + so * 65536 + (size_t)(sl * 32 + r32) * 256 + wid * 32 + 4 * hi;
#pragma unroll
            for (int i = 0; i < 4; ++i) { const f32x4 v4 = *(const f32x4*)(c0 + 8 * i); ct[4 * i] = v4[0]; ct[4 * i + 1] = v4[1]; ct[4 * i + 2] = v4[2]; ct[4 * i + 3] = v4[3]; }
            if (tid < 256) nb0[tid] = p.in[7][so * 256 + tid];
            m_st = p.in[8][so];
        } else if (tid < 256) nb0[tid] = 0.f;
        u32x4 pq[4], pk[4], pv; pv = (u32x4){0u, 0u, 0u, 0u};
#define ML_TOK(c, i) (base + (dir ? (L - 1 - ((c) * 64 + (i))) : ((c) * 64 + (i))))
#define ML_LOAD(c) do { _Pragma("unroll") for (int i_ = 0; i_ < 4; ++i_) { const int ch_ = tid + 512 * i_, row_ = ch_ >> 5, c16_ = ch_ & 31; const size_t g_ = (size_t)ML_TOK(c, row_) * 1024 + colq + c16_ * 8; \
            pq[i_] = *(const u32x4*)(MQ_ + g_); pk[i_] = *(const u32x4*)(MK_ + g_); } \
        if (tid < 256) { const int row_ = tid >> 2, c16_ = tid & 3; pv = *(const u32x4*)(MV_ + (size_t)ML_TOK(c, row_) * 1024 + colv + c16_ * 8); } } while (0)
#define ML_WRITE() do { _Pragma("unroll") for (int i_ = 0; i_ < 4; ++i_) { const int ch_ = tid + 512 * i_, row_ = ch_ >> 5, c16_ = ch_ & 31; \
            *(LAS u32x4*)(lds + L_Q + row_ * QP + c16_ * 16) = pq[i_]; *(LAS u32x4*)(lds + L_K + row_ * QP + c16_ * 16) = pk[i_]; } \
        if (tid < 256) { const int row_ = tid >> 2, c16_ = tid & 3; *(LAS u32x4*)(lds + L_V + row_ * VP + c16_ * 16) = pv; } } while (0)
#define ML_CTB() do { _Pragma("unroll") for (int i_ = 0; i_ < 4; ++i_) { u32x2 w_; w_.x = cvtpk(ct[4 * i_], ct[4 * i_ + 1]); w_.y = cvtpk(ct[4 * i_ + 2], ct[4 * i_ + 3]); \
            *(LAS u32x2*)(lds + L_CT + r32 * CP + (wid * 32 + 8 * i_ + 4 * hi) * 2) = w_; } } while (0)
        ML_LOAD(0); ML_WRITE(); ML_CTB();
        int nsel = 0;
        for (int c = 0; c < NC; ++c) {
            __syncthreads();
            LAS float* ncur = nsel ? nb1 : nb0; LAS float* nnxt = nsel ? nb0 : nb1;
            if (c + 1 < NC) ML_LOAD(c + 1);
            if (wid == 7) {
                const int row = ML_TOK(c, lane);
                const float li = GT[(size_t)row * 16 + dir * 8 + h], lf = GT[(size_t)row * 16 + dir * 8 + 4 + h];
                float bc = lf;
#pragma unroll
                for (int o = 1; o < 64; o <<= 1) { const float t_ = __shfl_up(bc, o); if (lane >= o) bc += t_; }
                const float g = li - bc; float pm = g;
#pragma unroll
                for (int o = 1; o < 64; o <<= 1) { const float t_ = __shfl_up(pm, o); if (lane >= o) pm = fmaxf(pm, t_); }
                const float mx = fmaxf(m_st, pm);
                const float blast = __shfl(bc, 63), mxl = __shfl(mx, 63);
                sg[lane] = g; sAt[lane] = -mx; swI[lane] = __expf(m_st - mx); semt[lane] = __expf(-(bc + mx)); sws[lane] = __expf(g - mxl);
                if (lane == 0) smisc[0] = __expf(m_st - mxl);
                m_st = blast + mxl;
            }
            __syncthreads();
            const float w_c = smisc[0];
            if (wid < 2) {
                const int tb = wid, t = tb * 32 + r32;
                f32x16 p0, p1; { float z0 = 0.f; asm volatile("" : "+v"(z0));
#pragma unroll
                  for (int r = 0; r < 16; ++r) { p0[r] = z0; p1[r] = z0; } }
#pragma unroll 4
                for (int ks = 0; ks < 16; ++ks) { const int cb = (ks * 16 + hi * 8) * 2;
                    const bf16x8 qf = *(const LAS bf16x8*)(lds + L_Q + t * QP + cb);
                    const bf16x8 k0 = *(const LAS bf16x8*)(lds + L_K + r32 * QP + cb);
                    p0 = __builtin_amdgcn_mfma_f32_32x32x16_bf16(k0, qf, p0, 0, 0, 0);
                    if (tb == 1) { const bf16x8 k1 = *(const LAS bf16x8*)(lds + L_K + (32 + r32) * QP + cb); p1 = __builtin_amdgcn_mfma_f32_32x32x16_bf16(k1, qf, p1, 0, 0, 0); } }
                const float At = sAt[t]; float dsum = 0.f;
#pragma unroll
                for (int r = 0; r < 16; ++r) { const int s0 = crow(r, hi);
                    const float w0 = (tb == 1 || s0 <= r32) ? __expf(At + sg[s0]) : 0.f; p0[r] *= w0; dsum += p0[r];
                    const float w1 = (tb == 1 && s0 <= r32) ? __expf(At + sg[32 + s0]) : 0.f; p1[r] *= w1; dsum += p1[r]; }
                { auto rr = __builtin_amdgcn_permlane32_swap(__float_as_uint(dsum), __float_as_uint(dsum), false, false); dsum = __uint_as_float(rr[0]) + __uint_as_float(rr[1]); }
                if (hi == 0) sdenI[t] = dsum;
                bf16x8 pa0, pa1, pa2, pa3;
#define ML_PK4(P_, BASE, OUT) do { unsigned a0 = cvtpk(P_[BASE + 0], P_[BASE + 1]), a1 = cvtpk(P_[BASE + 2], P_[BASE + 3]);   \
    unsigned b0 = cvtpk(P_[BASE + 4], P_[BASE + 5]), b1 = cvtpk(P_[BASE + 6], P_[BASE + 7]);                              \
    auto r0 = __builtin_amdgcn_permlane32_swap(a0, b0, false, false); auto r1 = __builtin_amdgcn_permlane32_swap(a1, b1, false, false); \
    u32x4 w = {r0[0], r1[0], r0[1], r1[1]}; OUT = *reinterpret_cast<bf16x8*>(&w); } while (0)
                ML_PK4(p0, 0, pa0); ML_PK4(p0, 8, pa1); ML_PK4(p1, 0, pa2); ML_PK4(p1, 8, pa3);
                f32x16 num; { float z0 = 0.f; asm volatile("" : "+v"(z0));
#pragma unroll
                  for (int r = 0; r < 16; ++r) num[r] = z0; }
#pragma unroll
                for (int ks = 0; ks < 4; ++ks) { if (ks < 2 || tb == 1) {
                    const unsigned va = ldsb + L_V + (16 * ks + 8 * hi + tq) * VP + tc0 * 2;
                    const s16x4 lo = trr(va), hh = trr(va + 4 * VP);
                    asm volatile("s_waitcnt lgkmcnt(0)" ::: "memory"); __builtin_amdgcn_sched_barrier(0);
                    const bf16x8 vf = (bf16x8){lo[0], lo[1], lo[2], lo[3], hh[0], hh[1], hh[2], hh[3]};
                    const bf16x8 pa = ks == 0 ? pa0 : ks == 1 ? pa1 : ks == 2 ? pa2 : pa3;
                    num = __builtin_amdgcn_mfma_f32_32x32x16_bf16(pa, vf, num, 0, 0, 0); } }
                { f32x16 cc = ct;
#pragma unroll
                  for (int r = 0; r < 16; ++r) cc[r] *= w_c;
#pragma unroll
                  for (int ks = 0; ks < 4; ++ks) {
                    const unsigned ka = ldsb + L_K + (16 * ks + 8 * hi + tq) * QP + (wid * 32 + tc0) * 2, va = ldsb + L_V + (16 * ks + 8 * hi + tq) * VP + tc0 * 2;
                    const s16x4 kl = trr(ka), kh = trr(ka + 4 * QP), vl = trr(va), vh = trr(va + 4 * VP);
                    const f32x4 wa = *(const LAS f32x4*)(sws + 16 * ks + 8 * hi), wb = *(const LAS f32x4*)(sws + 16 * ks + 8 * hi + 4);
                    asm volatile("s_waitcnt lgkmcnt(0)" ::: "memory"); __builtin_amdgcn_sched_barrier(0);
                    u32x4 vw; vw.x = cvtpk(bf2f((unsigned short)vl[0]) * wa[0], bf2f((unsigned short)vl[1]) * wa[1]); vw.y = cvtpk(bf2f((unsigned short)vl[2]) * wa[2], bf2f((unsigned short)vl[3]) * wa[3]);
                    vw.z = cvtpk(bf2f((unsigned short)vh[0]) * wb[0], bf2f((unsigned short)vh[1]) * wb[1]); vw.w = cvtpk(bf2f((unsigned short)vh[2]) * wb[2], bf2f((unsigned short)vh[3]) * wb[3]);
                    const bf16x8 kf = (bf16x8){kl[0], kl[1], kl[2], kl[3], kh[0], kh[1], kh[2], kh[3]};
                    cc = __builtin_amdgcn_mfma_f32_32x32x16_bf16(kf, *reinterpret_cast<bf16x8*>(&vw), cc, 0, 0, 0); }
                  ct = cc; }
                __syncthreads();
#pragma unroll
                for (int r = 0; r < 16; ++r) { const int tt = tb * 32 + crow(r, hi);
                    const float wi = swI[tt], den = sdenI[tt] + wi * snq[tt], inter = *(const LAS float*)(lds + L_INT + ((tb * 16 + r) * 64 + lane) * 4);
                    const float hv = (num[r] + wi * inter) / fmaxf(fabsf(den), semt[tt]);
                    Hout[(size_t)ML_TOK(c, tt) * 1024 + colv + r32] = (bf16_t)f2bf(hv); }
            } else {
                if (wid < 4) {
                    const int tb = wid - 2;
                    f32x16 ia; { float z0 = 0.f; asm volatile("" : "+v"(z0));
#pragma unroll
                      for (int r = 0; r < 16; ++r) ia[r] = z0; }
#pragma unroll 4
                    for (int ks = 0; ks < 16; ++ks) { const int cb = (ks * 16 + hi * 8) * 2;
                        const bf16x8 qf = *(const LAS bf16x8*)(lds + L_Q + (tb * 32 + r32) * QP + cb);
                        const bf16x8 cf = *(const LAS bf16x8*)(lds + L_CT + r32 * CP + cb);
                        ia = __builtin_amdgcn_mfma_f32_32x32x16_bf16(qf, cf, ia, 0, 0, 0); }
#pragma unroll
                    for (int r = 0; r < 16; ++r) *(LAS float*)(lds + L_INT + ((tb * 16 + r) * 64 + lane) * 4) = ia[r];
                } else {
                    const int j = tid - 256, t = j >> 2, part = j & 3;
                    float acc = 0.f;
#pragma unroll
                    for (int i = 0; i < 8; ++i) { const u32x4 qv = *(const LAS u32x4*)(lds + L_Q + t * QP + (part * 64 + i * 8) * 2);
                        const f32x4 n0 = *(const LAS f32x4*)(ncur + part * 64 + i * 8), n1 = *(const LAS f32x4*)(ncur + part * 64 + i * 8 + 4);
                        acc += bf2f(qv[0]) * n0[0] + bf2f(qv[0] >> 16) * n0[1] + bf2f(qv[1]) * n0[2] + bf2f(qv[1] >> 16) * n0[3] + bf2f(qv[2]) * n1[0] + bf2f(qv[2] >> 16) * n1[1] + bf2f(qv[3]) * n1[2] + bf2f(qv[3] >> 16) * n1[3]; }
                    acc += __shfl_xor(acc, 1); acc += __shfl_xor(acc, 2);
                    if (part == 0) snq[t] = acc;
                    float nn = w_c * ncur[j];
#pragma unroll 8
                    for (int s = 0; s < 64; ++s) nn += sws[s] * bf2f(*(const LAS unsigned short*)(lds + L_K + s * QP + j * 2));
                    nnxt[j] = nn;
                }
                { f32x16 cc = ct;
#pragma unroll
                  for (int r = 0; r < 16; ++r) cc[r] *= w_c;
#pragma unroll
                  for (int ks = 0; ks < 4; ++ks) {
                    const unsigned ka = ldsb + L_K + (16 * ks + 8 * hi + tq) * QP + (wid * 32 + tc0) * 2, va = ldsb + L_V + (16 * ks + 8 * hi + tq) * VP + tc0 * 2;
                    const s16x4 kl = trr(ka), kh = trr(ka + 4 * QP), vl = trr(va), vh = trr(va + 4 * VP);
                    const f32x4 wa = *(const LAS f32x4*)(sws + 16 * ks + 8 * hi), wb = *(const LAS f32x4*)(sws + 16 * ks + 8 * hi + 4);
                    asm volatile("s_waitcnt lgkmcnt(0)" ::: "memory"); __builtin_amdgcn_sched_barrier(0);
                    u32x4 vw; vw.x = cvtpk(bf2f((unsigned short)vl[0]) * wa[0], bf2f((unsigned short)vl[1]) * wa[1]); vw.y = cvtpk(bf2f((unsigned short)vl[2]) * wa[2], bf2f((unsigned short)vl[3]) * wa[3]);
                    vw.z = cvtpk(bf2f((unsigned short)vh[0]) * wb[0], bf2f((unsigned short)vh[1]) * wb[1]); vw.w = cvtpk(bf2f((unsigned short)vh[2]) * wb[2], bf2f((unsigned short)vh[3]) * wb[3]);
                    const bf16x8 kf = (bf16x8){kl[0], kl[1], kl[2], kl[3], kh[0], kh[1], kh[2], kh[3]};
                    cc = __builtin_amdgcn_mfma_f32_32x32x16_bf16(kf, *reinterpret_cast<bf16x8*>(&vw), cc, 0, 0, 0); }
                  ct = cc; }
                __syncthreads();
            }
            if (c + 1 < NC) { ML_WRITE(); }
            ML_CTB();
            nsel ^= 1;
        }
        __syncthreads();
        if (!lat) {
            const size_t so = (size_t)((b * 2 + l) * 2 + dir) * 4 + h;
            float* oc = p.out + O_MC + so * 65536 + (size_t)(sl * 32 + r32) * 256 + wid * 32 + 4 * hi;
#pragma unroll
            for (int i = 0; i < 4; ++i) *(f32x4*)(oc + 8 * i) = (f32x4){ct[4 * i], ct[4 * i + 1], ct[4 * i + 2], ct[4 * i + 3]};
            if (sl == 0) { LAS float* nfin = nsel ? nb1 : nb0; if (tid < 256) p.out[O_MN + so * 256 + tid] = nfin[tid]; if (wid == 7 && lane == 0) p.out[O_MM + so] = m_st; }
        }
        __syncthreads();
#undef ML_TOK
#undef ML_LOAD
#undef ML_WRITE
#undef ML_CTB
#undef ML_PK4
    }
}
}

__device__ __forceinline__ float rope_lane(float x, int lane, int prow, int pcol, const float* rt) {
    const int part = lane >> 5, jj = lane & 31, idx = jj & 15, pos = part ? pcol : prow;
    const float c = rt[pos * 16 + idx], s = rt[1024 + pos * 16 + idx];
    const float o = __shfl_xor(x, 16);
    return (jj >= 16) ? (x * c + o * s) : (x * c - o * s);
}
__device__ __forceinline__ void ph_prep_row(const P& p, int l, int r, int lane) {
    unsigned char* ws = p.ws;
    bf16_t* ckvn = (bf16_t*)(ws + WS_CKVN) + (size_t)r * 512;
    bf16_t* kf = (bf16_t*)(ws + WS_KFULL) + (size_t)r * 1536;
    bf16_t* dfk = (bf16_t*)(ws + WS_DFK) + (size_t)r * 1024;
    bf16_t* dfv = (bf16_t*)(ws + WS_DFV) + (size_t)r * 1024;
    if (r >= MTOK) {
        const int i = r - MTOK, b = i >> 8, t = i & 255;
        const float* cc = p.in[2] + ((size_t)(b * 2 + l) * PAST + t) * 512;
        for (int j = lane; j < 512; j += 64) ckvn[j] = (bf16_t)f2bf(cc[j]);
        const float kr = p.in[3][((size_t)(b * 2 + l) * PAST + t) * 64 + lane];
#pragma unroll
        for (int h = 0; h < 8; ++h) kf[h * 192 + 128 + lane] = (bf16_t)f2bf(kr);
        const float* ck = p.in[4] + ((size_t)(b * 2 + l) * PAST + t) * 1024; const float* cv = p.in[5] + ((size_t)(b * 2 + l) * PAST + t) * 1024;
        for (int j = lane; j < 1024; j += 64) { dfk[j] = (bf16_t)f2bf(ck[j]); dfv[j] = (bf16_t)f2bf(cv[j]); }
        return;
    }
    const float* kva = (const float*)(ws + WS_KVA) + (size_t)r * KVAW;
    const bool ctx = r < NCTX;
    const int cb = r >> 8, ct = r & 255;
    const int t = (r - NCTX) & 4095, prow = t >> 6, pcol = t & 63;
    const float* rt = (const float*)(ws + WS_ROPE);
    { float v[8]; float ss = 0.f;
#pragma unroll
      for (int j = 0; j < 8; ++j) { v[j] = kva[j * 64 + lane]; ss += v[j] * v[j]; }
      const float rstd = rsqrtf(wave_sum(ss) * (1.0f / 512.0f) + 1e-6f);
      const float* g = p.in[20] + l * 512;
#pragma unroll
      for (int j = 0; j < 8; ++j) { const float y = v[j] * rstd * g[j * 64 + lane]; ckvn[j * 64 + lane] = (bf16_t)f2bf(y);
          if (ctx) p.out[O_CKV + ((size_t)(cb * 2 + l) * CL + ct) * 512 + j * 64 + lane] = y; } }
    { float kr = kva[512 + lane];
      if (ctx) p.out[O_KR + ((size_t)(cb * 2 + l) * CL + ct) * 64 + lane] = kr; else kr = rope_lane(kr, lane, prow, pcol, rt);
#pragma unroll
      for (int h = 0; h < 8; ++h) kf[h * 192 + 128 + lane] = (bf16_t)f2bf(kr); }
    if (lane < 16) { const float g = kva[576 + lane] + p.in[18][l * 16 + lane];
        const float o = ((lane >> 2) & 1) ? (fminf(g, 0.f) - __logf(1.0f + __expf(-fabsf(g)))) : g;
        ((float*)(ws + WS_GATES))[(size_t)r * 16 + lane] = o; }
    if (ctx) {
        float* ok = p.out + O_DK + ((size_t)(cb * 2 + l) * CL + ct) * 1024; float* ov = p.out + O_DV + ((size_t)(cb * 2 + l) * CL + ct) * 1024;
        for (int j = lane; j < 1024; j += 64) { ok[j] = bf2f(dfk[j]); ov[j] = bf2f(dfv[j]); }
    } else {
        bf16_t* mq = (bf16_t*)(ws + WS_MQ) + (size_t)r * 1536; bf16_t* dfq = (bf16_t*)(ws + WS_DFQ) + (size_t)r * 1024;
#pragma unroll
        for (int h = 0; h < 8; ++h) { const float x = bf2f(mq[h * 192 + 128 + lane]); mq[h * 192 + 128 + lane] = (bf16_t)f2bf(rope_lane(x, lane, prow, pcol, rt)); }
#pragma unroll
        for (int h = 0; h < 16; ++h) { const float x = bf2f(dfq[h * 64 + lane]); dfq[h * 64 + lane] = (bf16_t)f2bf(rope_lane(x, lane, prow, pcol, rt));
            const float y = bf2f(dfk[h * 64 + lane]); dfk[h * 64 + lane] = (bf16_t)f2bf(rope_lane(y, lane, prow, pcol, rt)); }
    }
}

__device__ __forceinline__ void ph_mlstm_chain(const P& p, int l, int chain, int tid, float* sm) {
    float* sq = sm; float* sk = sm + 256; float* red = sm + 512;
    const int lane = tid & 63, wid = tid >> 6;
    const bool lat = chain >= 128; const int cc = lat ? chain - 128 : chain, b = cc >> 3, h = (cc >> 1) & 3, dir = cc & 1;
    const int L = lat ? LL : CL, base = lat ? NCTX + b * LL : b * CL;
    float* CT = (float*)(p.ws + WS_CT) + (size_t)chain * 65536;
    float n_k, m;
    if (lat) {
        const float* c0 = p.in[6] + ((size_t)((b * 2 + l) * 2 + dir) * 4 + h) * 65536;
        for (int k = 0; k < 256; ++k) CT[k * 256 + tid] = c0[(size_t)tid * 256 + k];
        n_k = p.in[7][((size_t)((b * 2 + l) * 2 + dir) * 4 + h) * 256 + tid]; m = p.in[8][((b * 2 + l) * 2 + dir) * 4 + h];
    } else { for (int k = 0; k < 256; ++k) CT[k * 256 + tid] = 0.f; n_k = 0.f; m = 0.f; }
    const bf16_t* Q = (const bf16_t*)(p.ws + WS_MLQ); const bf16_t* Kp = (const bf16_t*)(p.ws + WS_MLK); const bf16_t* V = (const bf16_t*)(p.ws + WS_MLV);
    const float* G = (const float*)(p.ws + WS_GATES);
    bf16_t* Hout = (bf16_t*)(p.ws + (dir ? WS_HB : WS_HF));
    for (int s = 0; s < L; ++s) {
        const int r = base + (dir ? L - 1 - s : s);
        __syncthreads();
        sq[tid] = bf2f(Q[(size_t)r * 1024 + h * 256 + tid]); sk[tid] = bf2f(Kp[(size_t)r * 1024 + h * 256 + tid]);
        const float vv = bf2f(V[(size_t)r * 1024 + h * 256 + tid]);
        const float li = G[(size_t)r * 16 + dir * 8 + h], lf = G[(size_t)r * 16 + dir * 8 + 4 + h];
        const float mn = fmaxf(lf + m, li), ip = __expf(li - mn), fp = __expf(lf + m - mn); m = mn;
        __syncthreads();
        const float iv = ip * vv; float num = 0.f;
        for (int k0 = 0; k0 < 256; k0 += 16) { float c[16];
#pragma unroll
            for (int j = 0; j < 16; ++j) c[j] = CT[(k0 + j) * 256 + tid];
#pragma unroll
            for (int j = 0; j < 16; ++j) { c[j] = fp * c[j] + iv * sk[k0 + j]; CT[(k0 + j) * 256 + tid] = c[j]; num += c[j] * sq[k0 + j]; } }
        n_k = fp * n_k + ip * sk[tid];
        const float dp = wave_sum(n_k * sq[tid]);
        if (lane == 0) red[wid] = dp;
        __syncthreads();
        const float den = red[0] + red[1] + red[2] + red[3];
        Hout[(size_t)r * 1024 + h * 256 + tid] = (bf16_t)f2bf(num / fmaxf(fabsf(den), __expf(-m)));
    }
    if (!lat) {
        float* oc = p.out + O_MC + ((size_t)((b * 2 + l) * 2 + dir) * 4 + h) * 65536;
        for (int k = 0; k < 256; ++k) oc[(size_t)tid * 256 + k] = CT[k * 256 + tid];
        p.out[O_MN + ((size_t)((b * 2 + l) * 2 + dir) * 4 + h) * 256 + tid] = n_k;
        if (tid == 0) p.out[O_MM + ((b * 2 + l) * 2 + dir) * 4 + h] = m;
    }
}
__device__ __forceinline__ void ph_ml_combine(const P& p, int l, int w, int lane) {
    const int r = w >> 2, h = w & 3;
    bf16_t* hf = (bf16_t*)(p.ws + WS_HF) + (size_t)r * 1024 + h * 256; const bf16_t* hb = (const bf16_t*)(p.ws + WS_HB) + (size_t)r * 1024 + h * 256;
    const bf16_t* so = (const bf16_t*)(p.ws + WS_MLO) + (size_t)r * 1024 + h * 256; const float* g = p.in[19] + l * 1024 + h * 256;
    float v[4]; float ss = 0.f;
#pragma unroll
    for (int j = 0; j < 4; ++j) { v[j] = bf2f(hf[j * 64 + lane]) + bf2f(hb[j * 64 + lane]); ss += v[j] * v[j]; }
    const float rstd = rsqrtf(wave_sum(ss) * (1.0f / 256.0f) + 1e-6f);
#pragma unroll
    for (int j = 0; j < 4; ++j) hf[j * 64 + lane] = (bf16_t)f2bf(v[j] * rstd * g[j * 64 + lane] * bf2f(so[j * 64 + lane]));
}

__device__ __forceinline__ void reduce16(float (&v)[16], int lane) {
    const bool b5 = lane & 32, b4 = lane & 16, b3 = lane & 8, b2 = lane & 4;
#pragma unroll
    for (int j = 0; j < 8; ++j) { const float keep = b5 ? v[8 + j] : v[j], send = b5 ? v[j] : v[8 + j]; v[j] = keep + __shfl_xor(send, 32); }
#pragma unroll
    for (int j = 0; j < 4; ++j) { const float keep = b4 ? v[4 + j] : v[j], send = b4 ? v[j] : v[4 + j]; v[j] = keep + __shfl_xor(send, 16); }
#pragma unroll
    for (int j = 0; j < 2; ++j) { const float keep = b3 ? v[2 + j] : v[j], send = b3 ? v[j] : v[2 + j]; v[j] = keep + __shfl_xor(send, 8); }
    { const float keep = b2 ? v[1] : v[0], send = b2 ? v[0] : v[1]; v[0] = keep + __shfl_xor(send, 4); }
    v[0] += __shfl_xor(v[0], 2); v[0] += __shfl_xor(v[0], 1);
}
__device__ __forceinline__ void ph_s5_unit(const P& p, int l, int dir, int w, int lane) {
    const int seq = w >> 6, g = w & 63; const bool lat = seq >= 16; const int b = lat ? seq - 16 : seq;
    const int L = lat ? LL : CL, base = lat ? NCTX + b * LL : b * CL;
    const size_t pg = ((size_t)(l * 2 + dir) * 64 + g);
    const float lr = fminf(p.in[22][pg * 64 + lane], -1e-4f), li = p.in[23][pg * 64 + lane], dt = __expf(p.in[24][pg]);
    const float mag = __expf(dt * lr); float sn, cs; sincos_small(dt * li, sn, cs);
    const float ar = mag * cs, ai = mag * sn, den = lr * lr + li * li, nr = ar - 1.0f, ni = ai, qr = (nr * lr + ni * li) / den, qi = (ni * lr - nr * li) / den;
    float bbr[16], bbi[16], cr[16], ci[16];
#pragma unroll
    for (int i = 0; i < 16; ++i) { const float br = p.in[25][(pg * 64 + lane) * 16 + i], bi = p.in[26][(pg * 64 + lane) * 16 + i]; bbr[i] = qr * br - qi * bi; bbi[i] = qr * bi + qi * br;
        cr[i] = p.in[27][(pg * 16 + i) * 64 + lane]; ci[i] = p.in[28][(pg * 16 + i) * 64 + lane]; }
    float sr = 0.f, si = 0.f;
    if (lat) { sr = p.in[9][((size_t)((b * 2 + l) * 2 + dir) * 64 + g) * 64 + lane]; si = p.in[10][((size_t)((b * 2 + l) * 2 + dir) * 64 + g) * 64 + lane]; }
    const bf16_t* U = (const bf16_t*)(p.ws + WS_S5U); float* YF = (float*)(p.ws + WS_YS5F); bf16_t* YG = (bf16_t*)(p.ws + WS_HB);
    const float dval = p.in[29][l * 1024 + g * 16 + ((lane >> 2) & 15)];
    for (int s = 0; s < L; ++s) {
        const int r = base + (dir ? L - 1 - s : s);
        const u32x4 u0 = *(const u32x4*)(U + (size_t)r * 1024 + g * 16), u1 = *(const u32x4*)(U + (size_t)r * 1024 + g * 16 + 8);
        float u[16];
#pragma unroll
        for (int i = 0; i < 4; ++i) { u[2 * i] = bf2f(u0[i]); u[2 * i + 1] = bf2f(u0[i] >> 16); u[8 + 2 * i] = bf2f(u1[i]); u[9 + 2 * i] = bf2f(u1[i] >> 16); }
        float bur = 0.f, bui = 0.f;
#pragma unroll
        for (int i = 0; i < 16; ++i) { bur += bbr[i] * u[i]; bui += bbi[i] * u[i]; }
        const float nsr = ar * sr - ai * si + bur, nsi = ar * si + ai * sr + bui; sr = nsr; si = nsi;
        float y[16];
#pragma unroll
        for (int i = 0; i < 16; ++i) y[i] = cr[i] * sr - ci[i] * si;
        reduce16(y, lane);
        if ((lane & 3) == 0) { const int i = lane >> 2; const size_t o = (size_t)r * 1024 + g * 16 + i;
            if (dir == 0) YF[o] = y[0];
            else { float ui = 0.f;
#pragma unroll
                for (int e = 0; e < 16; ++e) ui = (e == i) ? u[e] : ui;
                YG[o] = (bf16_t)f2bf(gelu_tanh(YF[o] + y[0] + dval * ui)); } }
    }
    if (!lat) { p.out[O_SR + ((size_t)((b * 2 + l) * 2 + dir) * 64 + g) * 64 + lane] = sr; p.out[O_SI + ((size_t)((b * 2 + l) * 2 + dir) * 64 + g) * 64 + lane] = si; }
}

template <int DQK>
__device__ __forceinline__ void ph_attn_unit(const bf16_t* Qp, int qpitch, const bf16_t* Kp, int kpitch, const bf16_t* Vp, int vpitch, int vdiv, bf16_t* Op, int opitch, int nheads, float scale, int w, int lane) {
    const int r = w / nheads, h = w % nheads;
    const bool lat = r >= NCTX; const int b = lat ? (r - NCTX) >> 12 : r >> 8;
    const int nk = lat ? LL + PAST : CL, kbase = lat ? NCTX + b * LL : b * CL, cbase = MTOK + b * PAST;
    const bf16_t* q = Qp + (size_t)r * qpitch + h * DQK;
    float qreg[DQK / 64];
#pragma unroll
    for (int j = 0; j < DQK / 64; ++j) qreg[j] = bf2f(q[j * 64 + lane]) * scale;
    float mrun = -1e30f, lrun = 0.f, o0 = 0.f, o1 = 0.f;
    const int vh = h / vdiv;
    for (int k0 = 0; k0 < nk; k0 += 64) {
        const int kk = k0 + lane, krow = kk < (lat ? LL : CL) ? kbase + kk : cbase + (kk - LL);
        const bf16_t* kp = Kp + (size_t)krow * kpitch + h * DQK;
        float s = 0.f;
#pragma unroll
        for (int j = 0; j < DQK / 64; ++j) {
#pragma unroll
            for (int c8 = 0; c8 < 8; ++c8) { const u32x4 kv = *(const u32x4*)(kp + j * 64 + c8 * 8);
#pragma unroll
                for (int e = 0; e < 4; ++e) { const float q0 = __shfl(qreg[j], c8 * 8 + 2 * e), q1 = __shfl(qreg[j], c8 * 8 + 2 * e + 1); s += q0 * bf2f(kv[e]) + q1 * bf2f(kv[e] >> 16); } }
        }
        const float mx = wave_max(s), mn = fmaxf(mrun, mx), alpha = __expf(mrun - mn), pj = __expf(s - mn);
        lrun = lrun * alpha + wave_sum(pj); o0 *= alpha; o1 *= alpha; mrun = mn;
        for (int j = 0; j < 64; ++j) { const float pb = __shfl(pj, j); const int kj = k0 + j, vrow = kj < (lat ? LL : CL) ? kbase + kj : cbase + (kj - LL);
            const bf16_t* vp = Vp + (size_t)vrow * vpitch + vh * 128; o0 += pb * bf2f(vp[lane]); o1 += pb * bf2f(vp[64 + lane]); }
    }
    const float inv = 1.0f / lrun;
    bf16_t* o = Op + (size_t)r * opitch + h * 128; o[lane] = (bf16_t)f2bf(o0 * inv); o[64 + lane] = (bf16_t)f2bf(o1 * inv);
}
__device__ __forceinline__ void ph_df_combine(const P& p, int l, float lam_init, int w, int lane) {
    const int r = w >> 3, h = w & 7;
    const float* lp = p.in[31] + l * 256;
    const float lam = __expf(wave_sum(lp[lane] * lp[64 + lane])) - __expf(wave_sum(lp[128 + lane] * lp[192 + lane])) + lam_init;
    const bf16_t* o = (const bf16_t*)(p.ws + WS_DFO) + (size_t)r * 2048 + h * 256;
    const float v0 = bf2f(o[lane]) - lam * bf2f(o[128 + lane]), v1 = bf2f(o[64 + lane]) - lam * bf2f(o[192 + lane]);
    const float rstd = rsqrtf(wave_sum(v0 * v0 + v1 * v1) * (1.0f / 128.0f) + 1e-6f);
    const float* g = p.in[32] + l * 128;
    bf16_t* y = (bf16_t*)(p.ws + WS_DFQ) + (size_t)r * 1024 + h * 128;
    y[lane] = (bf16_t)f2bf(v0 * rstd * g[lane] * (1.0f - lam_init)); y[64 + lane] = (bf16_t)f2bf(v1 * rstd * g[64 + lane] * (1.0f - lam_init));
}
__device__ __forceinline__ void ph_final_row(const P& p, int r, int lane) {
    const float* x = (const float*)(p.ws + WS_X) + (size_t)r * D; const float* g = p.in[37];
    f32x4 v[8]; float ss = 0.f;
#pragma unroll
    for (int j = 0; j < 8; ++j) { v[j] = *(const f32x4*)(x + j * 256 + lane * 4); ss += v[j][0] * v[j][0] + v[j][1] * v[j][1] + v[j][2] * v[j][2] + v[j][3] * v[j][3]; }
    const float rstd = rsqrtf(wave_sum(ss) * (1.0f / 2048.0f) + 1e-6f);
    float* o = p.out + (r < NCTX ? O_YP + (size_t)r * D : O_YS + (size_t)(r - NCTX) * D);
#pragma unroll
    for (int j = 0; j < 8; ++j) { const int c = j * 256 + lane * 4; const f32x4 gg = *(const f32x4*)(g + c); *(f32x4*)(o + c) = v[j] * rstd * gg; }
}

__device__ __forceinline__ void load_args(P& p) {
#if defined(__HIP_DEVICE_COMPILE__)
    const __attribute__((address_space(4))) unsigned long long* q = (const __attribute__((address_space(4))) unsigned long long*)__builtin_amdgcn_kernarg_segment_ptr();
    asm volatile("" : "+s"(q));
#pragma unroll
    for (int i = 0; i < 38; ++i) p.in[i] = (const float*)q[i];
    p.out = (float*)q[38]; p.ws = (unsigned char*)q[39];
#endif
}
constexpr int NTHR = 512, LDS_BYTES = 147456, MISC_OFF = 131072;
#define GRID_BAR() do { XcdBarrier b_ = bar; asm volatile("" : "+s"(b_.x)); xcd_barrier(b_); } while (0)

#define PH_VARS P p; load_args(p); unsigned char* ws = p.ws; (void)ws; int tid_ = (int)(bar.w * 64u + lane_id_()); asm volatile("" : "+v"(tid_)); const int lane = tid_ & 63, wave = __builtin_amdgcn_readfirstlane(tid_ >> 6), half = tid_ >> 8, vt = tid_ & 255; \
    const int gw = blockIdx.x * 8 + wave, vb = blockIdx.x * 2 + half; (void)lane; (void)half; (void)vt; (void)gw; (void)vb;

template <int l>
__device__ __forceinline__ void run_layer(unsigned char* lds, const XcdBarrier& bar, const int G, const int NGW) {
        { PH_VARS ph_convert(p, l, gw, NGW, lane, (LAS float*)((LAS unsigned char*)lds + wave * 16384)); }
        { PH_VARS for (int r = gw; r < MTOK; r += NGW) ph_hnorm_row(p, l, 0, r, lane); }
        GRID_BAR();
        { PH_VARS pg8::Gemm g{(const bf16_t*)(ws + WS_H), (const bf16_t*)(ws + WS_WBF + WB_IN), MTOK, 10496, D}; pg8::StaticOrder S; S.init(MTOK, 10496, G, (int)blockIdx.x);
          pg8::gemm_phase<Epi8In, pg8::StaticOrder, true, true>((LAS unsigned char*)lds, g, S, Epi8In{ws}, tid_); }
        GRID_BAR();
        { PH_VARS for (int r = gw; r < MALL; r += NGW) ph_prep_row(p, l, r, lane); }
        GRID_BAR();
        { PH_VARS pg8::Gemm g{(const bf16_t*)(ws + WS_CKVN), (const bf16_t*)(ws + WS_WBF + WB_KVB), MALL, 2048, 512}; pg8::StaticOrder S; S.init(MALL, 2048, G, (int)blockIdx.x);
          pg8::gemm_phase<Epi8Kvb, pg8::StaticOrder, true, true>((LAS unsigned char*)lds, g, S, Epi8Kvb{(bf16_t*)(ws + WS_KFULL), (bf16_t*)(ws + WS_VFULL)}, tid_); }
        { PH_VARS ml::mlstm_phase((LAS unsigned char*)lds, p, l, tid_); }
        GRID_BAR();
        { PH_VARS for (int w = gw; w < MTOK * 4; w += NGW) ph_ml_combine(p, l, w, lane); }
        { PH_VARS for (int w = gw; w < 20 * 64; w += NGW) ph_s5_unit(p, l, 0, w, lane); }
        GRID_BAR();
        { PH_VARS for (int w = gw; w < 20 * 64; w += NGW) ph_s5_unit(p, l, 1, w, lane); }
        GRID_BAR();
        { PH_VARS pg8::Gemm g{(const bf16_t*)(ws + WS_HB), (const bf16_t*)(ws + WS_WBF + WB_GLU), MTOK, 1024, 1024}; pg8::StaticOrder S; S.init(MTOK, 1024, G, (int)blockIdx.x);
          pg8::gemm_phase<Epi8Glu, pg8::StaticOrder, true, true>((LAS unsigned char*)lds, g, S, Epi8Glu{(const bf16_t*)(ws + WS_HB), (bf16_t*)(ws + WS_S5U)}, tid_); }
        { PH_VARS fa::Args aa{(const bf16_t*)(ws + WS_MQ), (const bf16_t*)(ws + WS_KFULL), (const bf16_t*)(ws + WS_VFULL), (bf16_t*)(ws + WS_MLQ), 1536, 1536, 1024, 1024, 8, 1, 0.07216878364870322f, 0};
          fa::attn_phase<192>((LAS unsigned char*)lds, aa, tid_); }
        { PH_VARS fa::Args aa{(const bf16_t*)(ws + WS_DFQ), (const bf16_t*)(ws + WS_DFK), (const bf16_t*)(ws + WS_DFV), (bf16_t*)(ws + WS_DFO), 1024, 1024, 1024, 2048, 16, 2, 0.125f, 0};
          fa::attn_phase<64>((LAS unsigned char*)lds, aa, tid_); }
        GRID_BAR();
        { PH_VARS const float lam_init = (l == 0) ? 0.2f : 0.35550906759096927f;
          for (int w = gw; w < MTOK * 8; w += NGW) ph_df_combine(p, l, lam_init, w, lane); }
        GRID_BAR();
        { PH_VARS pg8::Gemm g{(const bf16_t*)(ws + WS_H), (const bf16_t*)(ws + WS_WBF + WB_IN) + (size_t)10496 * D, MTOK, GATE_COLS, D}; pg8::StaticOrder S; S.init(MTOK, GATE_COLS, G, (int)blockIdx.x);
          pg8::gemm_phase<Epi8Gate, pg8::StaticOrder, true, true>((LAS unsigned char*)lds, g, S, Epi8Gate{(bf16_t*)(ws + WS_GS)}, tid_); }
        GRID_BAR();
        { PH_VARS pg8::Gemm g{(const bf16_t*)(ws + WS_HF), (const bf16_t*)(ws + WS_WBF + WB_BR) + (size_t)0 * 2048 * 1024, MTOK, D, 1024}; pg8::StaticOrder S; S.init(MTOK, D, G, (int)blockIdx.x);
          pg8::gemm_phase<Epi8Merge, pg8::StaticOrder, true, true>((LAS unsigned char*)lds, g, S, Epi8Merge{(const bf16_t*)(ws + WS_GS), (bf16_t*)(ws + WS_H), 0, 0}, tid_); }
        { PH_VARS pg8::Gemm g{(const bf16_t*)(ws + WS_MLQ), (const bf16_t*)(ws + WS_WBF + WB_BR) + (size_t)1 * 2048 * 1024, MTOK, D, 1024}; pg8::StaticOrder S; S.init(MTOK, D, G, (int)blockIdx.x);
          pg8::gemm_phase<Epi8Merge, pg8::StaticOrder, true, true>((LAS unsigned char*)lds, g, S, Epi8Merge{(const bf16_t*)(ws + WS_GS), (bf16_t*)(ws + WS_H), 1, 0}, tid_); }
        { PH_VARS pg8::Gemm g{(const bf16_t*)(ws + WS_S5U), (const bf16_t*)(ws + WS_WBF + WB_BR) + (size_t)2 * 2048 * 1024, MTOK, D, 1024}; pg8::StaticOrder S; S.init(MTOK, D, G, (int)blockIdx.x);
          pg8::gemm_phase<Epi8Merge, pg8::StaticOrder, true, true>((LAS unsigned char*)lds, g, S, Epi8Merge{(const bf16_t*)(ws + WS_GS), (bf16_t*)(ws + WS_H), 2, 0}, tid_); }
        { PH_VARS pg8::Gemm g{(const bf16_t*)(ws + WS_DFQ), (const bf16_t*)(ws + WS_WBF + WB_BR) + (size_t)3 * 2048 * 1024, MTOK, D, 1024}; pg8::StaticOrder S; S.init(MTOK, D, G, (int)blockIdx.x);
          pg8::gemm_phase<Epi8Merge, pg8::StaticOrder, true, true>((LAS unsigned char*)lds, g, S, Epi8Merge{(const bf16_t*)(ws + WS_GS), (bf16_t*)(ws + WS_H), 3, 0}, tid_); }
        GRID_BAR();
        { PH_VARS pg8::Gemm g{(const bf16_t*)(ws + WS_H), (const bf16_t*)(ws + WS_WBF + WB_O), MTOK, D, D}; pg8::StaticOrder S; S.init(MTOK, D, G, (int)blockIdx.x);
          pg8::gemm_phase<Epi8Res, pg8::StaticOrder, true, true>((LAS unsigned char*)lds, g, S, Epi8Res{p, l, 4096, 0, 0}, tid_); }
        GRID_BAR();
        { PH_VARS for (int r = gw; r < MTOK; r += NGW) ph_hnorm_row(p, l, 1, r, lane); }
        GRID_BAR();
        { PH_VARS pg8::Gemm g{(const bf16_t*)(ws + WS_H), (const bf16_t*)(ws + WS_WBF + WB_FIN), MTOK, 2 * FFN, D}; pg8::StaticOrder S; S.init(MTOK, 2 * FFN, G, (int)blockIdx.x);
          pg8::gemm_phase<Epi8FfnIn, pg8::StaticOrder, true, true>((LAS unsigned char*)lds, g, S, Epi8FfnIn{(bf16_t*)(ws + WS_FFNH)}, tid_); }
        GRID_BAR();
        { PH_VARS pg8::Gemm g{(const bf16_t*)(ws + WS_FFNH), (const bf16_t*)(ws + WS_WBF + WB_FOUT), MTOK, D, FFN}; pg8::StaticOrder S; S.init(MTOK, D, G, (int)blockIdx.x);
          pg8::gemm_phase<Epi8Res, pg8::StaticOrder, true, true>((LAS unsigned char*)lds, g, S, Epi8Res{p, l, 10240, 1, 0}, tid_); }
        GRID_BAR();
}

__global__ void __launch_bounds__(NTHR, 2) mega(P p_arg) {
    extern __shared__ __attribute__((aligned(16))) unsigned char lds[];
    const int tid = threadIdx.x;
    const int G = gridDim.x, NGW = G * 8;
    for (int u = tid; u < (LDS_BYTES - MISC_OFF) / 4; u += NTHR) ((LAS unsigned*)((LAS unsigned char*)lds + MISC_OFF))[u] = 0u;
    __syncthreads();
    XcdBarrier bar = xcd_barrier_post((unsigned*)(p_arg.ws + WS_CTL), (volatile LAS unsigned*)((LAS unsigned char*)lds + MISC_OFF + 32));
    { PH_VARS ph_mod(p, vb, vb < 96, vt, (float*)(lds + half * 40960)); }
    GRID_BAR();
    run_layer<0>(lds, bar, G, NGW);
    run_layer<1>(lds, bar, G, NGW);
    { PH_VARS for (int r = gw; r < MTOK; r += NGW) ph_final_row(p, r, lane); }
}

extern "C" void kernel_launch(void* const* d_in, const int* in_sizes, int n_in, void* d_out, int out_size, void* d_ws, size_t ws_size, hipStream_t stream) {
    static int grid = 0;
    if (grid == 0) {
        if (n_in != 38 || out_size != (int)O_END || ws_size < WS_END) { fprintf(stderr, "kernel_launch: unexpected shapes (n_in %d out %d ws %zu)\n", n_in, out_size, ws_size); grid = -1; return; }
        int dev = 0, cus = 0, per_cu = 0;
        if (hipGetDevice(&dev) != hipSuccess || hipDeviceGetAttribute(&cus, hipDeviceAttributeMultiprocessorCount, dev) != hipSuccess) { grid = -1; return; }
        if (hipFuncSetAttribute((const void*)mega, hipFuncAttributeMaxDynamicSharedMemorySize, LDS_BYTES) != hipSuccess) { fprintf(stderr, "kernel_launch: hipFuncSetAttribute failed\n"); grid = -1; return; }
        if (hipOccupancyMaxActiveBlocksPerMultiprocessor(&per_cu, (const void*)mega, NTHR, LDS_BYTES) != hipSuccess || per_cu < 1) { fprintf(stderr, "kernel_launch: occupancy query says %d workgroups per CU\n", per_cu); grid = -1; return; }
        (void)hipGetLastError();
        grid = cus;
    }
    if (grid < 0) return;
    if (hipMemsetAsync((char*)d_ws + WS_CTL, 0, CTL_BYTES, stream) != hipSuccess) return;
    P p{};
    for (int i = 0; i < 38; ++i) p.in[i] = (const float*)d_in[i];
    p.out = (float*)d_out; p.ws = (unsigned char*)d_ws;
    hipLaunchKernelGGL(mega, dim3(grid), dim3(NTHR), LDS_BYTES, stream, p);
}
```

```cpp
#include <hip/hip_runtime.h>
#include <cstdio>
#include <cstdint>

typedef unsigned short bf16_t;
typedef short bf16x8 __attribute__((ext_vector_type(8)));
typedef float f32x16 __attribute__((ext_vector_type(16)));
typedef float f32x4 __attribute__((ext_vector_type(4)));
typedef unsigned u32x4 __attribute__((ext_vector_type(4)));
typedef unsigned u32x2 __attribute__((ext_vector_type(2)));

constexpr int D = 2048, NCTX = 4096, NLAT = 16384, MTOK = 20480, MALL = 21504;
constexpr int CB = 16, CL = 256, LB = 4, LL = 4096, PAST = 256;
constexpr int IN_COLS = 18512, MIX_COLS = 10320, GATE_COLS = 8192;
constexpr int C_MLQ = 0, C_MLK = 1024, C_MLV = 2048, C_MLO = 3072, C_MLIF = 4096, C_MQ = 4112, C_KVA = 5648, C_S5U = 6224, C_DFQ = 7248, C_DFK = 8272, C_DFV = 9296;
constexpr int FFN = 5632;
constexpr int KVAW = 768;

constexpr size_t MiB = 1u << 20;
constexpr size_t WS_CTL = 0, CTL_BYTES = 64 * 1024;
constexpr size_t WS_MOD = 1 * MiB;
constexpr size_t WS_ROPE = WS_MOD + 512 * 1024;
constexpr size_t WS_X = 2 * MiB;
constexpr size_t WS_H = 162 * MiB;
constexpr size_t WS_HF = 242 * MiB;
constexpr size_t WS_HB = 282 * MiB;
constexpr size_t WS_MLQ = 322 * MiB;
constexpr size_t WS_S5U = 362 * MiB;
constexpr size_t WS_DFQ = 402 * MiB;
constexpr size_t WS_MLK = 442 * MiB;
constexpr size_t WS_MLV = 482 * MiB;
constexpr size_t WS_MLO = 522 * MiB;
constexpr size_t WS_MQ = 562 * MiB;
constexpr size_t WS_KVA = 622 * MiB;
constexpr size_t WS_DFK = 682 * MiB;
constexpr size_t WS_DFV = 724 * MiB;
constexpr size_t WS_CKVN = 766 * MiB;
constexpr size_t WS_KFULL = 787 * MiB;
constexpr size_t WS_VFULL = 850 * MiB;
constexpr size_t WS_GATES = 892 * MiB;
constexpr size_t WS_CT = 894 * MiB;
constexpr size_t WS_WBF = 934 * MiB;
constexpr size_t WS_GS = 442 * MiB;
constexpr size_t WS_FFNH = 442 * MiB;
constexpr size_t WS_DFO = 442 * MiB;
constexpr size_t WS_YS5F = 442 * MiB;
constexpr size_t WS_YS5B = 482 * MiB;
constexpr size_t WS_END = 1101 * MiB;

constexpr size_t O_YP = 0, O_YS = 8388608, O_CKV = 41943040, O_KR = 46137344, O_DK = 46661632, O_DV = 55050240,
                 O_MC = 63438848, O_MN = 80216064, O_MM = 80281600, O_SR = 80281856, O_SI = 80544000, O_END = 80806144;

__device__ __forceinline__ unsigned f2bf(float f) { unsigned u = __builtin_bit_cast(unsigned, f); return (u + 0x7fffu + ((u >> 16) & 1u)) >> 16; }
__device__ __forceinline__ float bf2f(unsigned b) { return __builtin_bit_cast(float, (b & 0xffffu) << 16); }
__device__ __forceinline__ unsigned pk2(float lo, float hi) { return f2bf(lo) | (f2bf(hi) << 16); }
__device__ __forceinline__ float wave_sum(float v) {
#pragma unroll
    for (int o = 1; o < 64; o <<= 1) v += __shfl_xor(v, o);
    return v;
}
__device__ __forceinline__ float wave_max(float v) {
#pragma unroll
    for (int o = 1; o < 64; o <<= 1) v = fmaxf(v, __shfl_xor(v, o));
    return v;
}
__device__ __forceinline__ float sigmoidf_(float x) { return 1.0f / (1.0f + __expf(-x)); }
__device__ __forceinline__ float siluf_(float x) { return x / (1.0f + __expf(-x)); }
__device__ __forceinline__ float gelu_tanh(float x) { const float u = 0.7978845608028654f * (x + 0.044715f * x * x * x); const float t = 1.0f - 2.0f / (1.0f + __expf(2.0f * u)); return 0.5f * x * (1.0f + t); }
__device__ __forceinline__ void sincos_small(float x, float& s, float& c) {
    const float k = rintf(x * 0.6366197723675814f);
    float r = fmaf(-k, 1.5707962513e+0f, x); r = fmaf(-k, 7.5497894159e-8f, r); r = fmaf(-k, 5.3903029534e-15f, r);
    const float r2 = r * r;
    const float sp = r + r * r2 * (-1.6666654611e-1f + r2 * (8.3321608736e-3f + r2 * (-1.9515295891e-4f)));
    const float cp = 1.0f - 0.5f * r2 + r2 * r2 * (4.166664568298827e-2f + r2 * (-1.388731625493765e-3f + r2 * 2.443315711809948e-5f));
    const int q = ((int)k) & 3;
    s = (q == 0) ? sp : (q == 1) ? cp : (q == 2) ? -sp : -cp;
    c = (q == 0) ? cp : (q == 1) ? -sp : (q == 2) ? -cp : sp;
}
__device__ __forceinline__ int cond_of_row(int r) { return r < NCTX ? 0 : 1 + ((r - NCTX) >> 12); }

struct P {
    const float* in[38];
    float* out;
    unsigned char* ws;
};
__device__ __forceinline__ const float* x_src(const P& p, int l, int r) {
    if (l == 0) return r < NCTX ? p.in[0] + (size_t)r * D : p.in[1] + (size_t)(r - NCTX) * D;
    return (const float*)(p.ws + WS_X) + (size_t)r * D;
}


#define XB_TMO      128
#define XB_XCNT(j)  (256  + 64 * (j))
#define XB_XSUB(j)  (1280 + 64 * (j))
#define XB_XGEN(j)  (2304 + 64 * (j))
#define XB_TOP      3328
#define XB_TOPGEN   3392
#define XCD_BAR_WORDS 3456
#define XB_SPIN_CAP (1u << 22)
#define LAS __attribute__((address_space(3)))

__device__ __forceinline__ unsigned xb_ld(unsigned* p)              { return __hip_atomic_load(p, __ATOMIC_RELAXED, __HIP_MEMORY_SCOPE_AGENT); }
__device__ __forceinline__ unsigned xb_add(unsigned* p, unsigned v) { return __hip_atomic_fetch_add(p, v, __ATOMIC_RELAXED, __HIP_MEMORY_SCOPE_AGENT); }
__device__ __forceinline__ unsigned xb_xcc_id() { return (unsigned)__builtin_amdgcn_s_getreg((3 << 11) | 20) & 0xFu; }
#define XB_SPIN(cond, bar) do { unsigned _sp = 0; while (cond) { __builtin_amdgcn_s_sleep(1); \
    if ((++_sp & 255u) == 0u) { if (xb_ld(&(bar)[XB_TMO])) break; if (_sp > XB_SPIN_CAP) { atomicAdd(&(bar)[XB_TMO], 1u); break; } } } } while (0)

__device__ __forceinline__ unsigned lane_id_() { return __builtin_amdgcn_mbcnt_hi(~0u, __builtin_amdgcn_mbcnt_lo(~0u, 0u)); }
struct XcdBarrier {
    unsigned* bar; unsigned x; unsigned w;
    volatile LAS unsigned* st;
};
__device__ __forceinline__ XcdBarrier xcd_barrier_post(unsigned* bar, volatile LAS unsigned* st) {
    XcdBarrier b; b.bar = bar; b.x = xb_xcc_id(); b.st = st; b.w = (unsigned)__builtin_amdgcn_readfirstlane(threadIdx.x >> 6);
    if (threadIdx.x == 0) (void)xb_add(&bar[XB_XCNT(b.x)], 1u);
    return b;
}
__device__ __forceinline__ void xcd_barrier_complete(unsigned* bar, unsigned x, unsigned& nloc, unsigned& nx) {
    const unsigned G = gridDim.x * gridDim.y * gridDim.z;
    unsigned sum, cnt, mine, sp = 0u;
    for (;;) {
        sum = 0u; cnt = 0u; mine = 0u;
#pragma unroll
        for (unsigned j = 0; j < 16; ++j) { const unsigned c = xb_ld(&bar[XB_XCNT(j)]); sum += c; cnt += (c > 0u) ? 1u : 0u; mine = (j == x) ? c : mine; }
        if (sum == G) break;
        __builtin_amdgcn_s_sleep(1);
        if ((++sp & 255u) == 0u) { if (xb_ld(&bar[XB_TMO])) break; if (sp > XB_SPIN_CAP) { atomicAdd(&bar[XB_TMO], 1u); break; } }
    }
    nloc = mine > 0u ? mine : 1u; nx = cnt > 0u ? cnt : 1u;
}
__device__ __forceinline__ void xcd_barrier(const XcdBarrier& b) {
    asm volatile("s_waitcnt vmcnt(0)" ::: "memory");
    __syncthreads();
    if (b.w == 0u && lane_id_() == 0u) {
        unsigned* bar = b.bar;
        __builtin_amdgcn_s_waitcnt(0);
        unsigned nloc = b.st[0], nx = b.st[1];
        if (nloc == 0u) { xcd_barrier_complete(bar, b.x, nloc, nx); b.st[0] = nloc; b.st[1] = nx; }
        const unsigned old = xb_add(&bar[XB_XSUB(b.x)], 1u);
        const unsigned gen = old / nloc;
        if (old + 1u == (gen + 1u) * nloc) {
            __builtin_amdgcn_fence(__ATOMIC_RELEASE, "agent");
            asm volatile("s_waitcnt vmcnt(0)" ::: "memory");
            const unsigned og = xb_add(&bar[XB_TOP], 1u);
            const unsigned tg = og / nx;
            if (og + 1u == (tg + 1u) * nx) xb_add(&bar[XB_TOPGEN], 1u);
            else XB_SPIN(xb_ld(&bar[XB_TOPGEN]) == tg, bar);
            __builtin_amdgcn_fence(__ATOMIC_ACQUIRE, "agent");
            xb_add(&bar[XB_XGEN(b.x)], 1u);
            asm volatile("s_waitcnt vmcnt(0)" ::: "memory");
        } else {
            XB_SPIN(xb_ld(&bar[XB_XGEN(b.x)]) == gen, bar);
            __builtin_amdgcn_fence(__ATOMIC_ACQUIRE, "agent");
            asm volatile("s_waitcnt vmcnt(0)" ::: "memory");
        }
    }
    __syncthreads();
}


__device__ __forceinline__ void ph_mod(const P& p, int vblk, bool active, int tid, float* sc) {
    for (int i = tid; i < 5 * 2048; i += 256) { const int c = i >> 11, k = i & 2047; const float v = c == 0 ? p.in[12][k] : p.in[11][(c - 1) * 2048 + k]; sc[i] = siluf_(v); }
    __syncthreads();
    const int idx = vblk * 256 + tid;
    if (active && idx < 2 * 12288) {
        const int l = idx / 12288, n = idx % 12288;
        const float* w = p.in[13] + (size_t)l * 2048 * 12288 + n;
        float a0 = 0, a1 = 0, a2 = 0, a3 = 0, a4 = 0;
        for (int k = 0; k < 2048; ++k) { const float wv = w[(size_t)k * 12288]; a0 += sc[k] * wv; a1 += sc[2048 + k] * wv; a2 += sc[4096 + k] * wv; a3 += sc[6144 + k] * wv; a4 += sc[8192 + k] * wv; }
        const float b = p.in[14][l * 12288 + n];
        float* mod = (float*)(p.ws + WS_MOD) + (size_t)l * 5 * 12288 + n;
        mod[0] = a0 + b; mod[12288] = a1 + b; mod[2 * 12288] = a2 + b; mod[3 * 12288] = a3 + b; mod[4 * 12288] = a4 + b;
    }
    if (active && vblk == 0) {
        float* rt = (float*)(p.ws + WS_ROPE);
        for (int i = tid; i < 1024; i += 256) { const int pos = i >> 4, j = i & 15; const float inv = exp2f(-(float)j * (13.287712379549449f / 16.0f)); float s, c; sincos_small((float)pos * inv, s, c); rt[i] = c; rt[1024 + i] = s; }
    }
}

__device__ __forceinline__ void ph_hnorm_row(const P& p, int l, int which, int r, int lane) {
    const float* x = which == 0 ? x_src(p, l, r) : (const float*)(p.ws + WS_X) + (size_t)r * D;
    const float* nw = p.in[which == 0 ? 15 : 16] + l * 2048;
    const float* mod = (const float*)(p.ws + WS_MOD) + ((size_t)l * 5 + cond_of_row(r)) * 12288 + (which == 0 ? 0 : 3 * 2048);
    f32x4 v[8]; float ss = 0.f;
#pragma unroll
    for (int j = 0; j < 8; ++j) { v[j] = *(const f32x4*)(x + j * 256 + lane * 4); ss += v[j][0] * v[j][0] + v[j][1] * v[j][1] + v[j][2] * v[j][2] + v[j][3] * v[j][3]; }
    const float rstd = rsqrtf(wave_sum(ss) * (1.0f / 2048.0f) + 1e-6f);
    bf16_t* o = (bf16_t*)(p.ws + WS_H) + (size_t)r * D;
#pragma unroll
    for (int j = 0; j < 8; ++j) { const int c = j * 256 + lane * 4; const f32x4 g = *(const f32x4*)(nw + c), sh = *(const f32x4*)(mod + c), s1 = *(const f32x4*)(mod + 2048 + c);
        float y[4];
#pragma unroll
        for (int e = 0; e < 4; ++e) y[e] = v[j][e] * rstd * g[e] * (1.0f + s1[e]) + sh[e];
        u32x2 w; w.x = pk2(y[0], y[1]); w.y = pk2(y[2], y[3]); *(u32x2*)(o + c) = w; }
}

template <class Epi, bool FFNMAP>
__device__ __forceinline__ void gemm_tile(const bf16_t* A, int lda, const float* W, int ldw, int ncols, int K, int tm, int tn, bool active, const Epi& E, int tid, bf16_t* As, bf16_t* Bs) {
    const int lane = tid & 63, wid = tid >> 6, wm = wid >> 1, wn = wid & 1, r32 = lane & 31, hi = lane >> 5;
    f32x16 acc[2][2];
#pragma unroll
    for (int a = 0; a < 2; ++a)
#pragma unroll
        for (int b = 0; b < 2; ++b)
#pragma unroll
            for (int r = 0; r < 16; ++r) acc[a][b][r] = 0.f;
    const int arow = tid >> 1, acol = (tid & 1) * 16;
    const bf16_t* ap = A + (size_t)(tm * 128 + arow) * lda + acol;
    const int bk = tid >> 5, bn = (tid & 31) * 4;
    int wcol;
    { const int nv = tn * 128 + bn; wcol = FFNMAP ? (((nv >> 5) & 1) * FFN + (nv >> 6) * 32 + (nv & 31)) : nv; }
    const bool bvalid = wcol < ncols;
    for (int k0 = 0; k0 < K; k0 += 32) {
        const u32x4 a0 = *(const u32x4*)(ap + k0), a1 = *(const u32x4*)(ap + k0 + 8);
        f32x4 bv[4];
#pragma unroll
        for (int i = 0; i < 4; ++i) bv[i] = bvalid ? *(const f32x4*)(W + (size_t)(k0 + bk + 8 * i) * ldw + wcol) : (f32x4){0.f, 0.f, 0.f, 0.f};
        __syncthreads();
        *(u32x4*)(As + arow * 40 + acol) = a0; *(u32x4*)(As + arow * 40 + acol + 8) = a1;
#pragma unroll
        for (int i = 0; i < 4; ++i)
#pragma unroll
            for (int e = 0; e < 4; ++e) Bs[(bn + e) * 40 + bk + 8 * i] = (bf16_t)f2bf(bv[i][e]);
        __syncthreads();
#pragma unroll
        for (int ks = 0; ks < 2; ++ks) {
            bf16x8 af[2], bfr[2];
#pragma unroll
            for (int mi = 0; mi < 2; ++mi) af[mi] = *(const bf16x8*)(As + (wm * 64 + mi * 32 + r32) * 40 + ks * 16 + hi * 8);
#pragma unroll
            for (int ni = 0; ni < 2; ++ni) bfr[ni] = *(const bf16x8*)(Bs + (wn * 64 + ni * 32 + r32) * 40 + ks * 16 + hi * 8);
#pragma unroll
            for (int mi = 0; mi < 2; ++mi)
#pragma unroll
                for (int ni = 0; ni < 2; ++ni) acc[mi][ni] = __builtin_amdgcn_mfma_f32_32x32x16_bf16(af[mi], bfr[ni], acc[mi][ni], 0, 0, 0);
        }
    }
    if (active) E(acc, tm * 128 + wm * 64, tn * 128 + wn * 64, r32, hi);
}
template <class Epi, bool FFNMAP>
__device__ __forceinline__ void gemm_phase_simple(int tid_, unsigned char* lds, const bf16_t* A, int lda, int M, const float* W, int ldw, int ncols, int nvirt, int K, const Epi& E) {
    const int half = tid_ >> 8, vt = tid_ & 255, ntm = M / 128, ntn = (nvirt + 127) / 128, nt = ntm * ntn, nvb = 2 * gridDim.x;
    bf16_t* As = (bf16_t*)(lds + half * 32768); bf16_t* Bs = As + 128 * 40;
    for (int base = 0; base < nt; base += nvb) {
        const int tile = base + blockIdx.x * 2 + half; const bool active = tile < nt; const int t = active ? tile : nt - 1;
        gemm_tile<Epi, FFNMAP>(A, lda, W, ldw, ncols, K, t / ntn, t % ntn, active, E, vt, As, Bs);
        __syncthreads();
    }
}
#define FOR_ACC(...) _Pragma("unroll") for (int mi = 0; mi < 2; ++mi) _Pragma("unroll") for (int ni = 0; ni < 2; ++ni) _Pragma("unroll") for (int r = 0; r < 16; ++r) { \
    const int m = m0 + mi * 32 + (r & 3) + 8 * (r >> 2) + 4 * hi, n = n0 + ni * 32 + r32; const float v = acc[mi][ni][r]; __VA_ARGS__ }
struct EpiIn {
    unsigned char* ws;
    __device__ __forceinline__ void operator()(const f32x16 (&acc)[2][2], int m0, int n0, int r32, int hi) const {
        FOR_ACC({
            if (n < C_MLK) ((bf16_t*)(ws + WS_MLQ))[(size_t)m * 1024 + n] = (bf16_t)f2bf(v);
            else if (n < C_MLV) ((bf16_t*)(ws + WS_MLK))[(size_t)m * 1024 + n - C_MLK] = (bf16_t)f2bf(v * 0.0625f);
            else if (n < C_MLO) ((bf16_t*)(ws + WS_MLV))[(size_t)m * 1024 + n - C_MLV] = (bf16_t)f2bf(v);
            else if (n < C_MLIF) ((bf16_t*)(ws + WS_MLO))[(size_t)m * 1024 + n - C_MLO] = (bf16_t)f2bf(sigmoidf_(v));
            else if (n < C_MQ) ((float*)(ws + WS_KVA))[(size_t)m * KVAW + 576 + n - C_MLIF] = v;
            else if (n < C_KVA) ((bf16_t*)(ws + WS_MQ))[(size_t)m * 1536 + n - C_MQ] = (bf16_t)f2bf(v);
            else if (n < C_S5U) ((float*)(ws + WS_KVA))[(size_t)m * KVAW + n - C_KVA] = v;
            else if (n < C_DFQ) ((bf16_t*)(ws + WS_S5U))[(size_t)m * 1024 + n - C_S5U] = (bf16_t)f2bf(v);
            else if (n < C_DFK) ((bf16_t*)(ws + WS_DFQ))[(size_t)m * 1024 + n - C_DFQ] = (bf16_t)f2bf(v);
            else if (n < C_DFV) ((bf16_t*)(ws + WS_DFK))[(size_t)m * 1024 + n - C_DFK] = (bf16_t)f2bf(v);
            else if (n < MIX_COLS) ((bf16_t*)(ws + WS_DFV))[(size_t)m * 1024 + n - C_DFV] = (bf16_t)f2bf(v);
        })
    }
};
struct EpiGate {
    bf16_t* gs;
    __device__ __forceinline__ void operator()(const f32x16 (&acc)[2][2], int m0, int n0, int r32, int hi) const {
        FOR_ACC({ gs[(size_t)m * GATE_COLS + n] = (bf16_t)f2bf(sigmoidf_(v)); })
    }
};
struct EpiKvb {
    bf16_t* kf; bf16_t* vf;
    __device__ __forceinline__ void operator()(const f32x16 (&acc)[2][2], int m0, int n0, int r32, int hi) const {
        FOR_ACC({ const int h = n >> 8, j = n & 255;
            if (j < 128) kf[(size_t)m * 1536 + h * 192 + j] = (bf16_t)f2bf(v); else vf[(size_t)m * 1024 + h * 128 + j - 128] = (bf16_t)f2bf(v); })
    }
};
struct EpiGlu {
    const bf16_t* g; bf16_t* y;
    __device__ __forceinline__ void operator()(const f32x16 (&acc)[2][2], int m0, int n0, int r32, int hi) const {
        FOR_ACC({ const size_t i = (size_t)m * 1024 + n; y[i] = (bf16_t)f2bf(bf2f(g[i]) * sigmoidf_(v)); })
    }
};
struct EpiMerge {
    const bf16_t* gs; bf16_t* mg; int b; int pad;
    __device__ __forceinline__ void operator()(const f32x16 (&acc)[2][2], int m0, int n0, int r32, int hi) const {
        FOR_ACC({ const size_t i = (size_t)m * D + n; const float prev = b ? bf2f(mg[i]) : 0.f; mg[i] = (bf16_t)f2bf(prev + bf2f(gs[(size_t)m * GATE_COLS + b * D + n]) * v); })
    }
};
struct EpiRes {
    P p; int l; int goff;
    int from_x; int pad;
    __device__ __forceinline__ void operator()(const f32x16 (&acc)[2][2], int m0, int n0, int r32, int hi) const {
        float* X = (float*)(p.ws + WS_X);
        FOR_ACC({ const float* src = from_x ? X + (size_t)m * D : x_src(p, l, m);
            const float g = ((const float*)(p.ws + WS_MOD))[((size_t)l * 5 + cond_of_row(m)) * 12288 + goff + n];
            X[(size_t)m * D + n] = src[n] + g * v; })
    }
};
struct EpiFfnIn {
    bf16_t* hh;
    __device__ __forceinline__ void operator()(const f32x16 (&acc)[2][2], int m0, int n0, int r32, int hi) const {
#pragma unroll
        for (int mi = 0; mi < 2; ++mi)
#pragma unroll
            for (int r = 0; r < 16; ++r) { const int m = m0 + mi * 32 + (r & 3) + 8 * (r >> 2) + 4 * hi, i = (n0 >> 6) * 32 + r32;
                hh[(size_t)m * FFN + i] = (bf16_t)f2bf(siluf_(acc[mi][0][r]) * acc[mi][1][r]); }
    }
};

namespace pg8 {
#define PG8_LAS __attribute__((address_space(3)))
typedef unsigned short bf16_t;
typedef short bf16x8 __attribute__((ext_vector_type(8)));
typedef float f32x4 __attribute__((ext_vector_type(4)));
typedef unsigned u32x4 __attribute__((ext_vector_type(4)));
constexpr int BM = 256, BK = 64, HALF = 128, HTB = HALF * BK * 2  , STAGE_BYTES = 8 * HTB, NXCD = 8, WGM = 8;

__host__ __device__ __forceinline__ int lds_byte(int r, int c) { const int st = (r >> 4) * 2 + (c >> 5), rr = r & 15, cc = c & 31, ob = rr * 64 + cc * 2; return st * 1024 + (ob ^ (((ob >> 9) & 1) << 5)); }
__host__ __device__ __forceinline__ void stage_rc(int b, int& R, int& C) { const int st = b / 1024, sb = b % 1024, swz = sb ^ (((sb >> 9) & 1) << 5); R = (st >> 1) * 16 + swz / 64; C = (st & 1) * 32 + (swz % 64) / 2; }
__host__ __device__ __forceinline__ int perm32(int rho) { const int n = rho >> 4, i = rho & 15; return 8 * (i >> 2) + 4 * n + (i & 3); }

struct Unit { int pm, pn; };
struct Gemm { const bf16_t* A; const bf16_t* Bt; int M, N, K; };

struct StaticOrder {
    int nM, nN, nwg, G, c;
    __host__ __device__ void init(int M, int N, int G_, int c_) { nM = M / BM; nN = N / BM; nwg = nM * nN; G = G_; c = c_; }
    __host__ __device__ bool next(int i, Unit& u) const {
        const long L = (long)i * G + c; if (L >= nwg) return false;
        int wgid = (int)L; { const int q = nwg / NXCD, r = nwg % NXCD, xcd = wgid % NXCD, off = wgid / NXCD; wgid = (xcd < r ? xcd * (q + 1) : r * (q + 1) + (xcd - r) * q) + off; }
        const int nig = WGM * nN, gid = wgid / nig, fm = gid * WGM, gsz = (nM - fm) < WGM ? (nM - fm) : WGM;
        u.pm = fm + ((wgid % nig) % gsz); u.pn = (wgid % nig) / gsz; return true;
    }
    __device__ __forceinline__ void a_ready(const Unit&) const {}
    __device__ __forceinline__ void done(const Unit&) const {}
};

__device__ __forceinline__ unsigned cvt_pk_bf16(float lo, float hi) { unsigned r; asm volatile("v_cvt_pk_bf16_f32 %0, %1, %2" : "=v"(r) : "v"(lo), "v"(hi)); return r; }

template <class Epi, class Sched, bool ALIGN_EPI = false, bool SP2 = false>
__device__ __forceinline__ void gemm_phase(PG8_LAS unsigned char* lds, const Gemm g, const Sched& S, const Epi& E, int tid_in) {
    int tid_l = tid_in; asm volatile("" : "+v"(tid_l));
    const int tid = tid_l, wid = __builtin_amdgcn_readfirstlane(tid >> 6), lane = tid & 63, wr = wid >> 2, wc = wid & 3, fr = lane & 15, fq = lane >> 4;
    const int K = g.K, nt = K / BK;
    unsigned voffA[2], voffB[2];
#pragma unroll
    for (int i = 0; i < 2; ++i) { int R, C; stage_rc(tid * 16 + i * 8192, R, C); const int Rb = Epi::PERM ? ((R & ~31) + perm32(R & 31)) : R;
        voffA[i] = (unsigned)(R * K + C) * 2u; voffB[i] = (unsigned)(Rb * K + C) * 2u; }
    const size_t kstep = (size_t)(BK * 2);
    const size_t hstep = (size_t)HALF * K * 2;
    const size_t tstep = 2 * hstep;
    const unsigned ldsw = (unsigned)wid * 1024u;
    const int aoff = lds_byte(wr * 64 + fr, fq * 8), boff = lds_byte(wc * 32 + fr, fq * 8);
#define PG8_SA(b, h) (((b) * 2 + (h)) * HTB)
#define PG8_SB(b, h) ((4 + (b) * 2 + (h)) * HTB)
#define PG8_STAGE(bufoff, gbase, voff) do { _Pragma("unroll") for (int _i = 0; _i < 2; ++_i) \
        __builtin_amdgcn_global_load_lds((const unsigned*)((const char*)(gbase) + (voff)[_i]), (PG8_LAS unsigned*)(lds + (bufoff) + ldsw + _i * 8192), 16, 0, 0); } while (0)
#define PG8_LDA(dst, b, h) do { _Pragma("unroll") for (int m = 0; m < 4; ++m) _Pragma("unroll") for (int k = 0; k < 2; ++k) dst[m][k] = *(const PG8_LAS bf16x8*)(lds + PG8_SA(b, h) + aoff + m * 2048 + k * 1024); } while (0)
#define PG8_LDB(dst, b, h) do { _Pragma("unroll") for (int n = 0; n < 2; ++n) _Pragma("unroll") for (int k = 0; k < 2; ++k) dst[n][k] = *(const PG8_LAS bf16x8*)(lds + PG8_SB(b, h) + boff + n * 2048 + k * 1024); } while (0)
#define PG8_MMA(ai, bj, At, Bt) do { __builtin_amdgcn_s_setprio(1); _Pragma("unroll") for (int m = 0; m < 4; ++m) _Pragma("unroll") for (int n = 0; n < 2; ++n) _Pragma("unroll") for (int k = 0; k < 2; ++k) \
        acc[ai][bj][m][n] = __builtin_amdgcn_mfma_f32_16x16x32_bf16(Bt[n][k], At[m][k], acc[ai][bj][m][n], 0, 0, 0); __builtin_amdgcn_s_setprio(0); } while (0)
#define PG8_WAIT_V(n) asm volatile("s_waitcnt vmcnt(" #n ")" ::: "memory")
#define PG8_WAIT_L(n) asm volatile("s_waitcnt lgkmcnt(" #n ")" ::: "memory")
#define PG8_BAR __builtin_amdgcn_s_barrier()
#define PG8_SCHED __builtin_amdgcn_sched_barrier(0)
    Unit cur, nxt; int ui = 0;
    if (!S.next(0, cur)) return;
    f32x4 acc[2][2][4][2];
    { float z0 = 0.f; asm volatile("" : "+v"(z0));
#pragma unroll
    for (int a = 0; a < 2; ++a)
#pragma unroll
        for (int b = 0; b < 2; ++b)
#pragma unroll
            for (int m = 0; m < 4; ++m)
#pragma unroll
                for (int n = 0; n < 2; ++n) acc[a][b][m][n] = (f32x4){z0, z0, z0, z0}; }
    bf16x8 At[4][2], B0[2][2], B1[2][2];
    const char* cA = (const char*)g.A + (size_t)cur.pm * tstep; const char* cB = (const char*)g.Bt + (size_t)cur.pn * tstep;
    S.a_ready(cur);
    if constexpr (SP2) {
        PG8_STAGE(PG8_SB(0, 0), cB, voffB); PG8_STAGE(PG8_SB(0, 1), cB + hstep, voffB); PG8_STAGE(PG8_SA(0, 0), cA, voffA); PG8_STAGE(PG8_SA(0, 1), cA + hstep, voffA);
        if (wr == 1) PG8_BAR;
        PG8_WAIT_V(2); PG8_BAR;
        PG8_STAGE(PG8_SB(1, 0), cB + kstep, voffB); PG8_STAGE(PG8_SA(1, 0), cA + kstep, voffA); PG8_STAGE(PG8_SB(1, 1), cB + hstep + kstep, voffB);
        PG8_WAIT_V(6); PG8_BAR;
    } else {
        PG8_STAGE(PG8_SB(0, 0), cB, voffB); PG8_STAGE(PG8_SA(0, 0), cA, voffA); PG8_STAGE(PG8_SB(0, 1), cB + hstep, voffB); PG8_STAGE(PG8_SA(0, 1), cA + hstep, voffA);
        if (wr == 1) PG8_BAR;
        PG8_WAIT_V(4); PG8_BAR;
        PG8_STAGE(PG8_SB(1, 0), cB + kstep, voffB); PG8_STAGE(PG8_SA(1, 0), cA + kstep, voffA); PG8_STAGE(PG8_SB(1, 1), cB + hstep + kstep, voffB);
        PG8_WAIT_V(6); PG8_BAR;
    }
    for (;;) {
        const bool has_next = S.next(ui + 1, nxt);
        const char* nA = has_next ? (const char*)g.A + (size_t)nxt.pm * tstep : cA; const char* nB = has_next ? (const char*)g.Bt + (size_t)nxt.pn * tstep : cB;
        for (int t = 0; t < nt; t += 2) {
            const bool last = (t == nt - 2);
            const char* a1 = cA + (size_t)(t + 1) * kstep;
            const char* a2 = last ? nA : cA + (size_t)(t + 2) * kstep; const char* b2 = last ? nB : cB + (size_t)(t + 2) * kstep;
            const char* a3 = a2 + kstep; const char* b3 = b2 + kstep;
            if (last && has_next) S.a_ready(nxt);
            if constexpr (SP2) {
            PG8_LDB(B0, 0, 0); PG8_LDB(B1, 0, 1); PG8_SCHED; PG8_LDA(At, 0, 0); PG8_STAGE(PG8_SA(1, 1), a1 + hstep, voffA);
            PG8_WAIT_V(8); PG8_WAIT_L(0); PG8_BAR; PG8_MMA(0, 0, At, B0); PG8_MMA(0, 1, At, B1); PG8_BAR; PG8_SCHED;
            PG8_LDA(At, 0, 1); PG8_STAGE(PG8_SB(0, 0), b2, voffB); PG8_STAGE(PG8_SB(0, 1), b2 + hstep, voffB); PG8_STAGE(PG8_SA(0, 0), a2, voffA);
            PG8_WAIT_V(8); PG8_WAIT_L(0); PG8_BAR; PG8_MMA(1, 0, At, B0); PG8_MMA(1, 1, At, B1); PG8_BAR; PG8_SCHED;
            PG8_LDB(B0, 1, 0); PG8_LDB(B1, 1, 1); PG8_SCHED; PG8_LDA(At, 1, 0); PG8_STAGE(PG8_SA(0, 1), a2 + hstep, voffA);
            PG8_WAIT_V(8); PG8_WAIT_L(0); PG8_BAR; PG8_MMA(0, 0, At, B0); PG8_MMA(0, 1, At, B1); PG8_BAR; PG8_SCHED;
            PG8_LDA(At, 1, 1); PG8_STAGE(PG8_SB(1, 0), b3, voffB); PG8_STAGE(PG8_SB(1, 1), b3 + hstep, voffB); PG8_STAGE(PG8_SA(1, 0), a3, voffA);
            PG8_WAIT_V(8); PG8_WAIT_L(0); PG8_BAR; PG8_MMA(1, 0, At, B0); PG8_MMA(1, 1, At, B1); PG8_BAR; PG8_SCHED;
            } else {
            PG8_LDB(B0, 0, 0); PG8_SCHED; PG8_LDA(At, 0, 0); PG8_STAGE(PG8_SA(1, 1), a1 + hstep, voffA);
            PG8_WAIT_L(8); PG8_BAR; PG8_WAIT_L(0); PG8_MMA(0, 0, At, B0); PG8_BAR; PG8_SCHED;
            PG8_LDB(B1, 0, 1); PG8_STAGE(PG8_SB(0, 0), b2, voffB);
            PG8_BAR; PG8_WAIT_L(0); PG8_MMA(0, 1, At, B1); PG8_BAR;
            PG8_LDA(At, 0, 1); PG8_STAGE(PG8_SA(0, 0), a2, voffA);
            PG8_BAR; PG8_WAIT_L(0); PG8_MMA(1, 0, At, B0); PG8_BAR; PG8_SCHED;
            PG8_STAGE(PG8_SB(0, 1), b2 + hstep, voffB);
            PG8_WAIT_V(6); PG8_BAR; PG8_MMA(1, 1, At, B1); PG8_BAR;
            PG8_LDB(B0, 1, 0); PG8_SCHED; PG8_LDA(At, 1, 0); PG8_STAGE(PG8_SA(0, 1), a2 + hstep, voffA);
            PG8_WAIT_L(8); PG8_BAR; PG8_WAIT_L(0); PG8_MMA(0, 0, At, B0); PG8_BAR; PG8_SCHED;
            PG8_LDB(B1, 1, 1); PG8_STAGE(PG8_SB(1, 0), b3, voffB);
            PG8_BAR; PG8_WAIT_L(0); PG8_MMA(0, 1, At, B1); PG8_BAR;
            PG8_LDA(At, 1, 1); PG8_STAGE(PG8_SA(1, 0), a3, voffA);
            PG8_BAR; PG8_WAIT_L(0); PG8_MMA(1, 0, At, B0); PG8_BAR; PG8_SCHED;
            PG8_STAGE(PG8_SB(1, 1), b3 + hstep, voffB);
            PG8_WAIT_V(6); PG8_BAR; PG8_MMA(1, 1, At, B1); PG8_BAR;
            }
        }
        if constexpr (ALIGN_EPI) { if (wr == 0) PG8_BAR; }
        if constexpr (!Epi::AFTER_DRAIN) { E(acc, cur, wr, wc, fr, fq); S.done(cur); }
        if (!has_next) break;
        { float z0 = 0.f; asm volatile("" : "+v"(z0));
#pragma unroll
        for (int a = 0; a < 2; ++a)
#pragma unroll
            for (int b = 0; b < 2; ++b)
#pragma unroll
                for (int m = 0; m < 4; ++m)
#pragma unroll
                    for (int n = 0; n < 2; ++n) acc[a][b][m][n] = (f32x4){z0, z0, z0, z0}; }
        cur = nxt; cA = nA; cB = nB; ++ui;
        if constexpr (ALIGN_EPI) { if (wr == 1) PG8_BAR; }
    }
    PG8_WAIT_V(0);
    if constexpr (!ALIGN_EPI) { if (wr == 0) PG8_BAR; }
    PG8_BAR;
    if constexpr (Epi::AFTER_DRAIN) { E.fused(acc, cur, wr, wc, fr, fq, lds, wid, lane); S.done(cur); }
#undef PG8_SA
#undef PG8_SB
#undef PG8_STAGE
#undef PG8_LDA
#undef PG8_LDB
#undef PG8_MMA
#undef PG8_WAIT_V
#undef PG8_WAIT_L
#undef PG8_BAR
#undef PG8_SCHED
}
}

#define PG8_ROW(ai, m) (u.pm * 256 + (ai) * 128 + wr * 64 + (m) * 16 + fr)
#define PG8_FOR(...) _Pragma("unroll") for (int ai = 0; ai < 2; ++ai) _Pragma("unroll") for (int m = 0; m < 4; ++m) { const int row = PG8_ROW(ai, m); _Pragma("unroll") for (int bj = 0; bj < 2; ++bj) { \
    const int ct = bj * 128 + wc * 32 + 8 * fq; const pg8::f32x4 v0 = acc[ai][bj][m][0], v1 = acc[ai][bj][m][1]; __VA_ARGS__ } }
__device__ __forceinline__ u32x4 pack8(const pg8::f32x4& a, const pg8::f32x4& b) { u32x4 w; w.x = pg8::cvt_pk_bf16(a[0], a[1]); w.y = pg8::cvt_pk_bf16(a[2], a[3]); w.z = pg8::cvt_pk_bf16(b[0], b[1]); w.w = pg8::cvt_pk_bf16(b[2], b[3]); return w; }
__device__ __forceinline__ void unpack8(const u32x4& w, float (&f)[8]) {
#pragma unroll
    for (int i = 0; i < 4; ++i) { f[2 * i] = bf2f(w[i]); f[2 * i + 1] = bf2f(w[i] >> 16); } }

struct Epi8In {
    static constexpr bool PERM = true, AFTER_DRAIN = false;
    unsigned char* ws;
    __device__ __forceinline__ void operator()(const pg8::f32x4 (&acc)[2][2][4][2], const pg8::Unit& u, int wr, int wc, int fr, int fq) const {
        const int pn = u.pn;
        if (pn >= 22 && pn < 25) {
            float* kva = (float*)(ws + WS_KVA);
            PG8_FOR({ float* o = kva + (size_t)row * KVAW + (pn - 22) * 256 + ct; *(pg8::f32x4*)o = v0; *(pg8::f32x4*)(o + 4) = v1; })
            return;
        }
        size_t base; int ldc, c0, mode = 0;
        if (pn < 4) { base = WS_MLQ; ldc = 1024; c0 = pn * 256; }
        else if (pn < 8) { base = WS_MLK; ldc = 1024; c0 = (pn - 4) * 256; mode = 1; }
        else if (pn < 12) { base = WS_MLV; ldc = 1024; c0 = (pn - 8) * 256; }
        else if (pn < 16) { base = WS_MLO; ldc = 1024; c0 = (pn - 12) * 256; mode = 2; }
        else if (pn < 22) { base = WS_MQ; ldc = 1536; c0 = (pn - 16) * 256; }
        else if (pn < 29) { base = WS_S5U; ldc = 1024; c0 = (pn - 25) * 256; }
        else if (pn < 33) { base = WS_DFQ; ldc = 1024; c0 = (pn - 29) * 256; }
        else if (pn < 37) { base = WS_DFK; ldc = 1024; c0 = (pn - 33) * 256; }
        else { base = WS_DFV; ldc = 1024; c0 = (pn - 37) * 256; }
        bf16_t* O = (bf16_t*)(ws + base);
        PG8_FOR({ pg8::f32x4 a = v0, b = v1;
            if (mode == 1) { a = a * 0.0625f; b = b * 0.0625f; }
            if (mode == 2) {
_Pragma("unroll")
                for (int e = 0; e < 4; ++e) { a[e] = sigmoidf_(a[e]); b[e] = sigmoidf_(b[e]); } }
            *(u32x4*)(O + (size_t)row * ldc + c0 + ct) = pack8(a, b); })
    }
};
struct Epi8Gate {
    static constexpr bool PERM = true, AFTER_DRAIN = false;
    bf16_t* gs;
    __device__ __forceinline__ void operator()(const pg8::f32x4 (&acc)[2][2][4][2], const pg8::Unit& u, int wr, int wc, int fr, int fq) const {
        PG8_FOR({ pg8::f32x4 a, b;
_Pragma("unroll")
            for (int e = 0; e < 4; ++e) { a[e] = sigmoidf_(v0[e]); b[e] = sigmoidf_(v1[e]); }
            *(u32x4*)(gs + (size_t)row * GATE_COLS + u.pn * 256 + ct) = pack8(a, b); })
    }
};
struct Epi8Kvb {
    static constexpr bool PERM = true, AFTER_DRAIN = false;
    bf16_t* kf; bf16_t* vf;
    __device__ __forceinline__ void operator()(const pg8::f32x4 (&acc)[2][2][4][2], const pg8::Unit& u, int wr, int wc, int fr, int fq) const {
        PG8_FOR({ bf16_t* o = bj == 0 ? kf + (size_t)row * 1536 + u.pn * 192 + wc * 32 + 8 * fq : vf + (size_t)row * 1024 + u.pn * 128 + wc * 32 + 8 * fq; (void)ct;
            *(u32x4*)o = pack8(v0, v1); })
    }
};
struct Epi8Glu {
    static constexpr bool PERM = true, AFTER_DRAIN = false;
    const bf16_t* g; bf16_t* y;
    __device__ __forceinline__ void operator()(const pg8::f32x4 (&acc)[2][2][4][2], const pg8::Unit& u, int wr, int wc, int fr, int fq) const {
        PG8_FOR({ const size_t i = (size_t)row * 1024 + u.pn * 256 + ct; float gf[8]; unpack8(*(const u32x4*)(g + i), gf); pg8::f32x4 a, b;
_Pragma("unroll")
            for (int e = 0; e < 4; ++e) { a[e] = gf[e] * sigmoidf_(v0[e]); b[e] = gf[4 + e] * sigmoidf_(v1[e]); }
            *(u32x4*)(y + i) = pack8(a, b); })
    }
};
struct Epi8Merge {
    static constexpr bool PERM = true, AFTER_DRAIN = false;
    const bf16_t* gs; bf16_t* mg; int b; int pad;
    __device__ __forceinline__ void operator()(const pg8::f32x4 (&acc)[2][2][4][2], const pg8::Unit& u, int wr, int wc, int fr, int fq) const {
        PG8_FOR({ const size_t i = (size_t)row * D + u.pn * 256 + ct; float gf[8], pf[8]; unpack8(*(const u32x4*)(gs + (size_t)row * GATE_COLS + b * D + u.pn * 256 + ct), gf);
            if (b) unpack8(*(const u32x4*)(mg + i), pf); else {
_Pragma("unroll")
                for (int e = 0; e < 8; ++e) pf[e] = 0.f; }
            pg8::f32x4 a, c;
_Pragma("unroll")
            for (int e = 0; e < 4; ++e) { a[e] = pf[e] + gf[e] * v0[e]; c[e] = pf[4 + e] + gf[4 + e] * v1[e]; }
            *(u32x4*)(mg + i) = pack8(a, c); })
    }
};
struct Epi8Res {
    static constexpr bool PERM = true, AFTER_DRAIN = false;
    P p; int l; int goff; int from_x; int pad;
    __device__ __forceinline__ void operator()(const pg8::f32x4 (&acc)[2][2][4][2], const pg8::Unit& u, int wr, int wc, int fr, int fq) const {
        float* X = (float*)(p.ws + WS_X);
        const float* gv = (const float*)(p.ws + WS_MOD) + ((size_t)l * 5 + cond_of_row(u.pm * 256)) * 12288 + goff + u.pn * 256;
        PG8_FOR({ const float* src = (from_x ? X + (size_t)row * D : x_src(p, l, row)) + u.pn * 256 + ct; float* dst = X + (size_t)row * D + u.pn * 256 + ct;
            const pg8::f32x4 g0 = *(const pg8::f32x4*)(gv + ct), g1 = *(const pg8::f32x4*)(gv + ct + 4), s0 = *(const pg8::f32x4*)src, s1 = *(const pg8::f32x4*)(src + 4);
            *(pg8::f32x4*)dst = s0 + g0 * v0; *(pg8::f32x4*)(dst + 4) = s1 + g1 * v1; })
    }
};
struct Epi8FfnIn {
    static constexpr bool PERM = true, AFTER_DRAIN = false;
    bf16_t* hh;
    __device__ __forceinline__ void operator()(const pg8::f32x4 (&acc)[2][2][4][2], const pg8::Unit& u, int wr, int wc, int fr, int fq) const {
_Pragma("unroll")
        for (int ai = 0; ai < 2; ++ai)
_Pragma("unroll")
            for (int m = 0; m < 4; ++m) { const int row = PG8_ROW(ai, m); pg8::f32x4 a, b;
_Pragma("unroll")
                for (int e = 0; e < 4; ++e) { a[e] = siluf_(acc[ai][0][m][0][e]) * acc[ai][1][m][0][e]; b[e] = siluf_(acc[ai][0][m][1][e]) * acc[ai][1][m][1][e]; }
                *(u32x4*)(hh + (size_t)row * FFN + u.pn * 128 + wc * 32 + 8 * fq) = pack8(a, b); }
    }
};

__device__ __forceinline__ int win_row(int n) {
    if (n < 4096) return n;
    if (n < 4112) return 6208 + (n - 4096);
    if (n < 5648) return 4096 + (n - 4112);
    if (n < 6224) return 5632 + (n - 5648);
    if (n < MIX_COLS) return 6400 + (n - 6224);
    return 10496 + (n - MIX_COLS);
}
template <int MAP>
__device__ __forceinline__ void cvt_item(const float* W, int K, int N, bf16_t* WT, int row_off, LAS float* scr, int item, int lane) {
    const int nblk = (N + 31) / 32, kb = item / nblk, nb = item % nblk, k0 = 64 * kb, n0 = 32 * nb;
    const int nl = (lane & 7) * 4, kr = lane >> 3;
    const bool nok = n0 + nl < N;
    const float* wp = W + (size_t)(k0 + kr) * N + n0 + nl;
    f32x4 v[8];
#pragma unroll
    for (int i = 0; i < 8; ++i) v[i] = nok ? *(const f32x4*)(wp + (size_t)(8 * i) * N) : (f32x4){0.f, 0.f, 0.f, 0.f};
#pragma unroll
    for (int i = 0; i < 8; ++i) { LAS float* d = scr + (kr + 8 * i) * 33 + nl; d[0] = v[i][0]; d[1] = v[i][1]; d[2] = v[i][2]; d[3] = v[i][3]; }
    asm volatile("s_waitcnt lgkmcnt(0)" ::: "memory");
    const int c = lane & 7;
#pragma unroll
    for (int j = 0; j < 4; ++j) { const int n = (lane >> 3) + 8 * j; const LAS float* s = scr + (8 * c) * 33 + n;
        u32x4 o; o.x = pk2(s[0 * 33], s[1 * 33]); o.y = pk2(s[2 * 33], s[3 * 33]); o.z = pk2(s[4 * 33], s[5 * 33]); o.w = pk2(s[6 * 33], s[7 * 33]);
        const int ng = n0 + n; int row;
        if (MAP == 0) row = row_off + ng; else if (MAP == 1) row = win_row(ng); else row = (ng < FFN) ? ((ng >> 7) * 256 + (ng & 127)) : (((ng - FFN) >> 7) * 256 + 128 + ((ng - FFN) & 127));
        if (ng < N) *(u32x4*)(WT + (size_t)row * K + k0 + 8 * c) = o; }
    asm volatile("s_waitcnt lgkmcnt(0)" ::: "memory");
}
constexpr size_t WB_IN = 0, WB_KVB = 73 * MiB, WB_GLU = 75 * MiB, WB_BR = 77 * MiB, WB_O = 93 * MiB, WB_FIN = 101 * MiB, WB_FOUT = 145 * MiB, WB_END = 167 * MiB;
constexpr int NIN_T = 18688;
__device__ __forceinline__ void ph_convert(const P& p, int l, int gw, int NGW, int lane, LAS float* scr) {
    unsigned char* wb = p.ws + WS_WBF;
    constexpr int I_IN = (D / 64) * ((IN_COLS + 31) / 32), I_KVB = (512 / 64) * (2048 / 32), I_GLU = (1024 / 64) * (1024 / 32), I_BR = (1024 / 64) * (2048 / 32), I_O = (D / 64) * (D / 32),
                  I_FIN = (D / 64) * (2 * FFN / 32), I_FOUT = (FFN / 64) * (D / 32);
    constexpr int NIT = I_IN + I_KVB + I_GLU + 4 * I_BR + I_O + I_FIN + I_FOUT;
    for (int it = gw; it < NIT; it += NGW) {
        int r = it;
        if (r < I_IN) { cvt_item<1>(p.in[17] + (size_t)l * D * IN_COLS, D, IN_COLS, (bf16_t*)(wb + WB_IN), 0, scr, r, lane); continue; } r -= I_IN;
        if (r < I_KVB) { cvt_item<0>(p.in[21] + (size_t)l * 512 * 2048, 512, 2048, (bf16_t*)(wb + WB_KVB), 0, scr, r, lane); continue; } r -= I_KVB;
        if (r < I_GLU) { cvt_item<0>(p.in[30] + (size_t)l * 1024 * 1024, 1024, 1024, (bf16_t*)(wb + WB_GLU), 0, scr, r, lane); continue; } r -= I_GLU;
        if (r < 4 * I_BR) { const int b = r / I_BR; cvt_item<0>(p.in[33] + ((size_t)l * 4 + b) * 1024 * 2048, 1024, 2048, (bf16_t*)(wb + WB_BR) + (size_t)b * 2048 * 1024, 0, scr, r % I_BR, lane); continue; } r -= 4 * I_BR;
        if (r < I_O) { cvt_item<0>(p.in[34] + (size_t)l * D * D, D, D, (bf16_t*)(wb + WB_O), 0, scr, r, lane); continue; } r -= I_O;
        if (r < I_FIN) { cvt_item<2>(p.in[35] + (size_t)l * D * 2 * FFN, D, 2 * FFN, (bf16_t*)(wb + WB_FIN), 0, scr, r, lane); continue; } r -= I_FIN;
        cvt_item<0>(p.in[36] + (size_t)l * FFN * D, FFN, D, (bf16_t*)(wb + WB_FOUT), 0, scr, r, lane);
    }
    for (int row = 6224 + gw; row < 6400; row += NGW) { u32x4* o = (u32x4*)((bf16_t*)(wb + WB_IN) + (size_t)row * D); for (int j = lane; j < D / 8; j += 64) o[j] = (u32x4){0u, 0u, 0u, 0u}; }
}


namespace fa {
typedef short s16x4 __attribute__((ext_vector_type(4)));
__device__ __forceinline__ int crow(int r, int hi) { return (r & 3) + 8 * (r >> 2) + 4 * hi; }
__device__ __forceinline__ unsigned cvtpk(float lo, float hi) { unsigned r; asm volatile("v_cvt_pk_bf16_f32 %0, %1, %2" : "=v"(r) : "v"(lo), "v"(hi)); return r; }
#define FA_SBAR() __builtin_amdgcn_sched_barrier(0)
constexpr float THR = 8.f;
__device__ __forceinline__ void partialSM(f32x16& p0, f32x16& p1, float& m_reg, float& mn, float& alpha, float SCALE) {
    const float C = SCALE * 1.4426950408889634f;
    float pmax = p0[0];
#pragma unroll
    for (int r = 1; r < 16; ++r) pmax = fmaxf(pmax, p0[r]);
#pragma unroll
    for (int r = 0; r < 16; ++r) pmax = fmaxf(pmax, p1[r]);
    { auto rr = __builtin_amdgcn_permlane32_swap(__float_as_uint(pmax), __float_as_uint(pmax), false, false);
      pmax = fmaxf(__uint_as_float(rr[0]), __uint_as_float(rr[1])); }
    if (__builtin_expect(__all(pmax - m_reg <= THR / SCALE), 1)) { mn = m_reg; alpha = 1.f; }
    else { mn = fmaxf(m_reg, pmax); alpha = __builtin_amdgcn_exp2f((m_reg - mn) * C); m_reg = mn; }
    const float mnC = -mn * C;
#pragma unroll
    for (int r = 0; r < 16; ++r) p0[r] = fmaf(p0[r], C, mnC);
#pragma unroll
    for (int r = 0; r < 16; ++r) p1[r] = fmaf(p1[r], C, mnC);
#pragma unroll
    for (int r = 0; r < 16; ++r) p0[r] = __builtin_amdgcn_exp2f(p0[r]);
}
__device__ __forceinline__ void finishSM(f32x16& p0, f32x16& p1, float alpha, float& l_reg, bf16x8& pa0, bf16x8& pa1, bf16x8& pa2, bf16x8& pa3) {
#pragma unroll
    for (int r = 0; r < 16; ++r) p1[r] = __builtin_amdgcn_exp2f(p1[r]);
    float ps = 0;
#pragma unroll
    for (int r = 0; r < 16; ++r) ps += p0[r];
#pragma unroll
    for (int r = 0; r < 16; ++r) ps += p1[r];
    { auto rr = __builtin_amdgcn_permlane32_swap(__float_as_uint(ps), __float_as_uint(ps), false, false);
      ps = __uint_as_float(rr[0]) + __uint_as_float(rr[1]); }
    l_reg = l_reg * alpha + ps;
#define FA_PK4(P, BASE, OUT) do { unsigned a0 = cvtpk(P[BASE + 0], P[BASE + 1]), a1 = cvtpk(P[BASE + 2], P[BASE + 3]);   \
    unsigned b0 = cvtpk(P[BASE + 4], P[BASE + 5]), b1 = cvtpk(P[BASE + 6], P[BASE + 7]);                              \
    auto r0 = __builtin_amdgcn_permlane32_swap(a0, b0, false, false); auto r1 = __builtin_amdgcn_permlane32_swap(a1, b1, false, false); \
    u32x4 w = {r0[0], r1[0], r0[1], r1[1]}; OUT = *reinterpret_cast<bf16x8*>(&w); } while (0)
    FA_PK4(p0, 0, pa0); FA_PK4(p0, 8, pa1); FA_PK4(p1, 0, pa2); FA_PK4(p1, 8, pa3);
#undef FA_PK4
}
__device__ __forceinline__ int v_rd_base(int lane) { return ((lane & 3) << 3) | (((lane >> 2) & 3) << 6) | (((lane >> 4) & 1) << 5) | (((lane >> 5) & 1) << 8); }
constexpr int v_rd_off(int d0, int ks, int half) { return d0 * 512 + ks * 4096 + half * 2048; }
template <int OFF> __device__ __forceinline__ s16x4 tr_read(unsigned vb) {
    s16x4 r; asm volatile("ds_read_b64_tr_b16 %0, %1 offset:%2" : "=&v"(r) : "v"(vb), "i"(OFF) : "memory"); return r;
}
template <int D0> __device__ __forceinline__ void pv_one(f32x16& od, unsigned vb, bf16x8 pa0, bf16x8 pa1, bf16x8 pa2, bf16x8 pa3) {
    const s16x4 l0 = tr_read<v_rd_off(D0, 0, 0)>(vb), h0 = tr_read<v_rd_off(D0, 0, 1)>(vb), l1 = tr_read<v_rd_off(D0, 1, 0)>(vb), h1 = tr_read<v_rd_off(D0, 1, 1)>(vb);
    const s16x4 l2 = tr_read<v_rd_off(D0, 2, 0)>(vb), h2 = tr_read<v_rd_off(D0, 2, 1)>(vb), l3 = tr_read<v_rd_off(D0, 3, 0)>(vb), h3 = tr_read<v_rd_off(D0, 3, 1)>(vb);
    asm volatile("s_waitcnt lgkmcnt(0)" ::: "memory"); FA_SBAR();
#define FA_PK(L, H) (bf16x8){L[0], L[1], L[2], L[3], H[0], H[1], H[2], H[3]}
    od = __builtin_amdgcn_mfma_f32_32x32x16_bf16(pa0, FA_PK(l0, h0), od, 0, 0, 0);
    od = __builtin_amdgcn_mfma_f32_32x32x16_bf16(pa1, FA_PK(l1, h1), od, 0, 0, 0);
    od = __builtin_amdgcn_mfma_f32_32x32x16_bf16(pa2, FA_PK(l2, h2), od, 0, 0, 0);
    od = __builtin_amdgcn_mfma_f32_32x32x16_bf16(pa3, FA_PK(l3, h3), od, 0, 0, 0);
#undef FA_PK
}
struct Args { const bf16_t* Q; const bf16_t* K; const bf16_t* V; bf16_t* O; int qpitch, kpitch, vpitch, opitch, nheads, vdiv; float scale; int pad; };

template <int DQK>
__device__ __forceinline__ void attn_phase(LAS unsigned char* lds, const Args& a, int tid) {
    constexpr int KROWB = DQK * 2, KCH = KROWB / 16, KTILE = 64 * KROWB, VTILE = 16384, STAGE = KTILE + VTILE, NKI = KTILE / 8192, NVI = 2, NDMA = NKI + NVI, ND = DQK / 16;
    static_assert(3 * STAGE + 2048 <= 131072, "attention LDS");
    const int wid = __builtin_amdgcn_readfirstlane(tid >> 6), lane = tid & 63, r32 = lane & 31, hi = lane >> 5;
    LAS float* wsc = (LAS float*)(lds + 3 * STAGE) + wid * 64;
    unsigned koff_[NKI], voff_[NVI];
#pragma unroll
    for (int i = 0; i < NKI; ++i) { const int s = i * 512 + wid * 64 + lane, row = s / KCH, ch = s % KCH; koff_[i] = (unsigned)(row * a.kpitch + (ch ^ (row & 7)) * 8) * 2u; }
#pragma unroll
    for (int i = 0; i < NVI; ++i) { const int o = (i * 512 + wid * 64 + lane) * 16, sub = o >> 9, within = o & 511, kk = (sub >> 2) * 8 + (within >> 6), c = (sub & 3) * 32 + ((within & 63) >> 1);
        const int k = (kk & ~0xC) | ((kk & 4) << 1) | ((kk & 8) >> 1); voff_[i] = (unsigned)(k * a.vpitch + c) * 2u; }
    const unsigned vb0 = (unsigned)(uintptr_t)(lds + KTILE) + (unsigned)v_rd_base(lane);
    const int n_lat = a.nheads * 64, n_units = n_lat + a.nheads * 16;
    for (int u = blockIdx.x; u < n_units; u += gridDim.x) {
        int b, h, q0, nk, kbase, cbase;
        if (u < n_lat) { const int bh = u >> 4, qb = u & 15; b = bh / a.nheads; h = bh % a.nheads; q0 = NCTX + b * LL + qb * 256; nk = LL + PAST; kbase = NCTX + b * LL; cbase = MTOK + b * PAST; }
        else { const int v = u - n_lat; b = v / a.nheads; h = v % a.nheads; q0 = b * CL; nk = CL; kbase = b * CL; cbase = 0; }
        const int NT = nk >> 6, vh = h / a.vdiv;
        const bf16_t* Kh = a.K + h * DQK; const bf16_t* Vh = a.V + vh * 128;
#define FA_ISSUE(j) do { const int t0_ = (j) * 64; const int rb_ = (t0_ < LL || nk == CL) ? kbase + t0_ : cbase + (t0_ - LL); LAS unsigned char* st_ = lds + ((j) % 3) * STAGE; \
        const char* kb_ = (const char*)(Kh + (size_t)rb_ * a.kpitch); const char* vb_ = (const char*)(Vh + (size_t)rb_ * a.vpitch); \
        _Pragma("unroll") for (int i_ = 0; i_ < NKI; ++i_) __builtin_amdgcn_global_load_lds((const unsigned*)(kb_ + koff_[i_]), (LAS unsigned*)(st_ + i_ * 8192 + wid * 1024), 16, 0, 0); \
        _Pragma("unroll") for (int i_ = 0; i_ < NVI; ++i_) __builtin_amdgcn_global_load_lds((const unsigned*)(vb_ + voff_[i_]), (LAS unsigned*)(st_ + KTILE + i_ * 8192 + wid * 1024), 16, 0, 0); } while (0)
        bf16x8 qr[ND];
        { const bf16_t* Qw = a.Q + (size_t)(q0 + wid * 32 + r32) * a.qpitch + h * DQK + hi * 8;
#pragma unroll
          for (int d0 = 0; d0 < ND; ++d0) qr[d0] = *(const bf16x8*)(Qw + d0 * 16); }
        float m_reg = -1e30f, l_reg = 0.f; f32x16 o[4];
        float z0 = 0.f; asm volatile("" : "+v"(z0));
#pragma unroll
        for (int d = 0; d < 4; ++d)
#pragma unroll
            for (int r = 0; r < 16; ++r) o[d][r] = z0;
        FA_ISSUE(0); FA_ISSUE(1);
        if (NDMA == 5) asm volatile("s_waitcnt vmcnt(5)" ::: "memory"); else asm volatile("s_waitcnt vmcnt(3)" ::: "memory");
        __builtin_amdgcn_s_barrier(); asm volatile("" ::: "memory");
        for (int j = 0; j < NT; ++j) {
            if (j + 2 < NT) FA_ISSUE(j + 2);
            LAS unsigned char* Ks = lds + (j % 3) * STAGE;
            f32x16 p0, p1;
#pragma unroll
            for (int r = 0; r < 16; ++r) { p0[r] = z0; p1[r] = z0; }
#pragma unroll
            for (int d0 = 0; d0 < ND; ++d0) { const int cb = (d0 * 16 + hi * 8) * 2;
                const bf16x8 b0 = *(const LAS bf16x8*)(Ks + r32 * KROWB + (cb ^ ((r32 & 7) << 4)));
                const bf16x8 b1 = *(const LAS bf16x8*)(Ks + (32 + r32) * KROWB + (cb ^ ((r32 & 7) << 4)));
                p0 = __builtin_amdgcn_mfma_f32_32x32x16_bf16(b0, qr[d0], p0, 0, 0, 0);
                p1 = __builtin_amdgcn_mfma_f32_32x32x16_bf16(b1, qr[d0], p1, 0, 0, 0);
                if ((d0 & 3) == 3) asm volatile("" ::: "memory"); }
            float mn, alpha; partialSM(p0, p1, m_reg, mn, alpha, a.scale);
            if (__any(alpha < 1.f)) { if (hi == 0) wsc[32 + r32] = alpha; asm volatile("s_waitcnt lgkmcnt(0)" ::: "memory");
#pragma unroll
                for (int d = 0; d < 4; ++d)
#pragma unroll
                    for (int r = 0; r < 16; ++r) o[d][r] *= wsc[32 + crow(r, hi)]; }
            bf16x8 pa0, pa1, pa2, pa3; finishSM(p0, p1, alpha, l_reg, pa0, pa1, pa2, pa3); FA_SBAR();
            const unsigned vb = vb0 + (unsigned)((j % 3) * STAGE);
            pv_one<0>(o[0], vb, pa0, pa1, pa2, pa3); pv_one<1>(o[1], vb, pa0, pa1, pa2, pa3); pv_one<2>(o[2], vb, pa0, pa1, pa2, pa3); pv_one<3>(o[3], vb, pa0, pa1, pa2, pa3);
            if (j + 2 < NT) { if (NDMA == 5) asm volatile("s_waitcnt vmcnt(5)" ::: "memory"); else asm volatile("s_waitcnt vmcnt(3)" ::: "memory"); }
            else asm volatile("s_waitcnt vmcnt(0)" ::: "memory");
            asm volatile("s_waitcnt lgkmcnt(0)" ::: "memory");
            __builtin_amdgcn_s_barrier(); asm volatile("" ::: "memory");
        }
#undef FA_ISSUE
        if (hi == 0) wsc[r32] = l_reg; asm volatile("s_waitcnt lgkmcnt(0)" ::: "memory");
        bf16_t* Ow = a.O + (size_t)(q0 + wid * 32) * a.opitch + h * 128 + r32;
#pragma unroll
        for (int r = 0; r < 16; ++r) { const int orow = crow(r, hi); const float rl = __builtin_amdgcn_rcpf(wsc[orow]);
#pragma unroll
            for (int d0 = 0; d0 < 4; ++d0) Ow[(size_t)orow * a.opitch + d0 * 32] = (bf16_t)f2bf(o[d0][r] * rl); }
        asm volatile("s_waitcnt lgkmcnt(0)" ::: "memory");
    }
}
}


namespace ml {
typedef short s16x4 __attribute__((ext_vector_type(4)));
constexpr int QP = 528, VP = 80, CP = 528;
constexpr int L_Q = 0, L_K = 33792, L_V = 67584, L_CT = 72704, L_INT = 89600, L_SC = 97792, L_N = 99840, L_END = 101888;
__device__ __forceinline__ s16x4 trr(unsigned addr) { s16x4 r; asm volatile("ds_read_b64_tr_b16 %0, %1" : "=&v"(r) : "v"(addr) : "memory"); return r; }
__device__ __forceinline__ unsigned cvtpk(float lo, float hi) { unsigned r; asm volatile("v_cvt_pk_bf16_f32 %0, %1, %2" : "=v"(r) : "v"(lo), "v"(hi)); return r; }
__device__ __forceinline__ int crow(int r, int hi) { return (r & 3) + 8 * (r >> 2) + 4 * hi; }

__device__ __forceinline__ void mlstm_phase(LAS unsigned char* lds, const P& p, const int l, const int tid) {
    const int wid = __builtin_amdgcn_readfirstlane(tid >> 6), lane = tid & 63, r32 = lane & 31, hi = lane >> 5;
    const bf16_t* MQ_ = (const bf16_t*)(p.ws + WS_MLQ); const bf16_t* MK_ = (const bf16_t*)(p.ws + WS_MLK); const bf16_t* MV_ = (const bf16_t*)(p.ws + WS_MLV);
    const float* GT = (const float*)(p.ws + WS_GATES);
    LAS float* SC = (LAS float*)(lds + L_SC);
    LAS float* sg = SC; LAS float* sAt = SC + 64; LAS float* swI = SC + 128; LAS float* semt = SC + 192; LAS float* sws = SC + 256; LAS float* sdenI = SC + 320; LAS float* snq = SC + 384; LAS float* smisc = SC + 448;
    const unsigned ldsb = (unsigned)(uintptr_t)lds;
    const int tq = (lane & 15) >> 2, tp = lane & 3, tc0 = 16 * ((lane >> 4) & 1) + 4 * tp;
    for (int u = blockIdx.x; u < 1280; u += gridDim.x) {
        const bool lat = u < 256; const int uu = lat ? u : u - 256, chain = uu >> 3, sl = uu & 7;
        const int b = chain >> 3, h = (chain >> 1) & 3, dir = chain & 1;
        const int L = lat ? LL : CL, base = lat ? NCTX + b * LL : b * CL, NC = L >> 6;
        const int colq = h * 256, colv = h * 256 + sl * 32;
        bf16_t* Hout = (bf16_t*)(p.ws + (dir ? WS_HB : WS_HF));
        f32x16 ct; float m_st = 0.f;
        { float z0 = 0.f; asm volatile("" : "+v"(z0));
#pragma unroll
          for (int r = 0; r < 16; ++r) ct[r] = z0; }
        LAS float* nb0 = (LAS float*)(lds + L_N); LAS float* nb1 = nb0 + 256;
        if (lat) {
            const size_t so = (size_t)((b * 2 + l) * 2 + dir) * 4 + h;
            const float* c0 = p.in[6] + so * 65536 + (size_t)(sl * 32 + r32) * 256 + wid * 32 + 4 * hi;
#pragma unroll
            for (int i = 0; i < 4; ++i) { const f32x4 v4 = *(const f32x4*)(c0 + 8 * i); ct[4 * i] = v4[0]; ct[4 * i + 1] = v4[1]; ct[4 * i + 2] = v4[2]; ct[4 * i + 3] = v4[3]; }
            if (tid < 256) nb0[tid] = p.in[7][so * 256 + tid];
            m_st = p.in[8][so];
        } else if (tid < 256) nb0[tid] = 0.f;
        u32x4 pq[4], pk[4], pv; pv = (u32x4){0u, 0u, 0u, 0u};
#define ML_TOK(c, i) (base + (dir ? (L - 1 - ((c) * 64 + (i))) : ((c) * 64 + (i))))
#define ML_LOAD(c) do { _Pragma("unroll") for (int i_ = 0; i_ < 4; ++i_) { const int ch_ = tid + 512 * i_, row_ = ch_ >> 5, c16_ = ch_ & 31; const size_t g_ = (size_t)ML_TOK(c, row_) * 1024 + colq + c16_ * 8; \
            pq[i_] = *(const u32x4*)(MQ_ + g_); pk[i_] = *(const u32x4*)(MK_ + g_); } \
        if (tid < 256) { const int row_ = tid >> 2, c16_ = tid & 3; pv = *(const u32x4*)(MV_ + (size_t)ML_TOK(c, row_) * 1024 + colv + c16_ * 8); } } while (0)
#define ML_WRITE() do { _Pragma("unroll") for (int i_ = 0; i_ < 4; ++i_) { const int ch_ = tid + 512 * i_, row_ = ch_ >> 5, c16_ = ch_ & 31; \
            *(LAS u32x4*)(lds + L_Q + row_ * QP + c16_ * 16) = pq[i_]; *(LAS u32x4*)(lds + L_K + row_ * QP + c16_ * 16) = pk[i_]; } \
        if (tid < 256) { const int row_ = tid >> 2, c16_ = tid & 3; *(LAS u32x4*)(lds + L_V + row_ * VP + c16_ * 16) = pv; } } while (0)
#define ML_CTB() do { _Pragma("unroll") for (int i_ = 0; i_ < 4; ++i_) { u32x2 w_; w_.x = cvtpk(ct[4 * i_], ct[4 * i_ + 1]); w_.y = cvtpk(ct[4 * i_ + 2], ct[4 * i_ + 3]); \
            *(LAS u32x2*)(lds + L_CT + r32 * CP + (wid * 32 + 8 * i_ + 4 * hi) * 2) = w_; } } while (0)
        ML_LOAD(0); ML_WRITE(); ML_CTB();
        int nsel = 0;
        for (int c = 0; c < NC; ++c) {
            __syncthreads();
            LAS float* ncur = nsel ? nb1 : nb0; LAS float* nnxt = nsel ? nb0 : nb1;
            if (c + 1 < NC) ML_LOAD(c + 1);
            if (wid == 7) {
                const int row = ML_TOK(c, lane);
                const float li = GT[(size_t)row * 16 + dir * 8 + h], lf = GT[(size_t)row * 16 + dir * 8 + 4 + h];
                float bc = lf;
#pragma unroll
                for (int o = 1; o < 64; o <<= 1) { const float t_ = __shfl_up(bc, o); if (lane >= o) bc += t_; }
                const float g = li - bc; float pm = g;
#pragma unroll
                for (int o = 1; o < 64; o <<= 1) { const float t_ = __shfl_up(pm, o); if (lane >= o) pm = fmaxf(pm, t_); }
                const float mx = fmaxf(m_st, pm);
                const float blast = __shfl(bc, 63), mxl = __shfl(mx, 63);
                sg[lane] = g; sAt[lane] = -mx; swI[lane] = __expf(m_st - mx); semt[lane] = __expf(-(bc + mx)); sws[lane] = __expf(g - mxl);
                if (lane == 0) smisc[0] = __expf(m_st - mxl);
                m_st = blast + mxl;
            }
            __syncthreads();
            const float w_c = smisc[0];
            if (wid < 2) {
                const int tb = wid, t = tb * 32 + r32;
                f32x16 p0, p1; { float z0 = 0.f; asm volatile("" : "+v"(z0));
#pragma unroll
                  for (int r = 0; r < 16; ++r) { p0[r] = z0; p1[r] = z0; } }
#pragma unroll 4
                for (int ks = 0; ks < 16; ++ks) { const int cb = (ks * 16 + hi * 8) * 2;
                    const bf16x8 qf = *(const LAS bf16x8*)(lds + L_Q + t * QP + cb);
                    const bf16x8 k0 = *(const LAS bf16x8*)(lds + L_K + r32 * QP + cb);
                    p0 = __builtin_amdgcn_mfma_f32_32x32x16_bf16(k0, qf, p0, 0, 0, 0);
                    if (tb == 1) { const bf16x8 k1 = *(const LAS bf16x8*)(lds + L_K + (32 + r32) * QP + cb); p1 = __builtin_amdgcn_mfma_f32_32x32x16_bf16(k1, qf, p1, 0, 0, 0); } }
                const float At = sAt[t]; float dsum = 0.f;
#pragma unroll
                for (int r = 0; r < 16; ++r) { const int s0 = crow(r, hi);
                    const float w0 = (tb == 1 || s0 <= r32) ? __expf(At + sg[s0]) : 0.f; p0[r] *= w0; dsum += p0[r];
                    const float w1 = (tb == 1 && s0 <= r32) ? __expf(At + sg[32 + s0]) : 0.f; p1[r] *= w1; dsum += p1[r]; }
                { auto rr = __builtin_amdgcn_permlane32_swap(__float_as_uint(dsum), __float_as_uint(dsum), false, false); dsum = __uint_as_float(rr[0]) + __uint_as_float(rr[1]); }
                if (hi == 0) sdenI[t] = dsum;
                bf16x8 pa0, pa1, pa2, pa3;
#define ML_PK4(P_, BASE, OUT) do { unsigned a0 = cvtpk(P_[BASE + 0], P_[BASE + 1]), a1 = cvtpk(P_[BASE + 2], P_[BASE + 3]);   \
    unsigned b0 = cvtpk(P_[BASE + 4], P_[BASE + 5]), b1 = cvtpk(P_[BASE + 6], P_[BASE + 7]);                              \
    auto r0 = __builtin_amdgcn_permlane32_swap(a0, b0, false, false); auto r1 = __builtin_amdgcn_permlane32_swap(a1, b1, false, false); \
    u32x4 w = {r0[0], r1[0], r0[1], r1[1]}; OUT = *reinterpret_cast<bf16x8*>(&w); } while (0)
                ML_PK4(p0, 0, pa0); ML_PK4(p0, 8, pa1); ML_PK4(p1, 0, pa2); ML_PK4(p1, 8, pa3);
                f32x16 num; { float z0 = 0.f; asm volatile("" : "+v"(z0));
#pragma unroll
                  for (int r = 0; r < 16; ++r) num[r] = z0; }
#pragma unroll
                for (int ks = 0; ks < 4; ++ks) { if (ks < 2 || tb == 1) {
                    const unsigned va = ldsb + L_V + (16 * ks + 8 * hi + tq) * VP + tc0 * 2;
                    const s16x4 lo = trr(va), hh = trr(va + 4 * VP);
                    asm volatile("s_waitcnt lgkmcnt(0)" ::: "memory"); __builtin_amdgcn_sched_barrier(0);
                    const bf16x8 vf = (bf16x8){lo[0], lo[1], lo[2], lo[3], hh[0], hh[1], hh[2], hh[3]};
                    const bf16x8 pa = ks == 0 ? pa0 : ks == 1 ? pa1 : ks == 2 ? pa2 : pa3;
                    num = __builtin_amdgcn_mfma_f32_32x32x16_bf16(pa, vf, num, 0, 0, 0); } }
                { f32x16 cc = ct;
#pragma unroll
                  for (int r = 0; r < 16; ++r) cc[r] *= w_c;
#pragma unroll
                  for (int ks = 0; ks < 4; ++ks) {
                    const unsigned ka = ldsb + L_K + (16 * ks + 8 * hi + tq) * QP + (wid * 32 + tc0) * 2, va = ldsb + L_V + (16 * ks + 8 * hi + tq) * VP + tc0 * 2;
                    const s16x4 kl = trr(ka), kh = trr(ka + 4 * QP), vl = trr(va), vh = trr(va + 4 * VP);
                    const f32x4 wa = *(const LAS f32x4*)(sws + 16 * ks + 8 * hi), wb = *(const LAS f32x4*)(sws + 16 * ks + 8 * hi + 4);
                    asm volatile("s_waitcnt lgkmcnt(0)" ::: "memory"); __builtin_amdgcn_sched_barrier(0);
                    u32x4 vw; vw.x = cvtpk(bf2f((unsigned short)vl[0]) * wa[0], bf2f((unsigned short)vl[1]) * wa[1]); vw.y = cvtpk(bf2f((unsigned short)vl[2]) * wa[2], bf2f((unsigned short)vl[3]) * wa[3]);
                    vw.z = cvtpk(bf2f((unsigned short)vh[0]) * wb[0], bf2f((unsigned short)vh[1]) * wb[1]); vw.w = cvtpk(bf2f((unsigned short)vh[2]) * wb[2], bf2f((unsigned short)vh[3]) * wb[3]);
                    const bf16x8 kf = (bf16x8){kl[0], kl[1], kl[2], kl[3], kh[0], kh[1], kh[2], kh[3]};
                    cc = __builtin_amdgcn_mfma_f32_32x32x16_bf16(kf, *reinterpret_cast<bf16x8*>(&vw), cc, 0, 0, 0); }
                  ct = cc; }
                __syncthreads();
#pragma unroll
                for (int r = 0; r < 16; ++r) { const int tt = tb * 32 + crow(r, hi);
                    const float wi = swI[tt], den = sdenI[tt] + wi * snq[tt], inter = *(const LAS float*)(lds + L_INT + ((tb * 16 + r) * 64 + lane) * 4);
                    const float hv = (num[r] + wi * inter) / fmaxf(fabsf(den), semt[tt]);
                    Hout[(size_t)ML_TOK(c, tt) * 1024 + colv + r32] = (bf16_t)f2bf(hv); }
            } else {
                if (wid < 4) {
                    const int tb = wid - 2;
                    f32x16 ia; { float z0 = 0.f; asm volatile("" : "+v"(z0));
#pragma unroll
                      for (int r = 0; r < 16; ++r) ia[r] = z0; }
#pragma unroll 4
                    for (int ks = 0; ks < 16; ++ks) { const int cb = (ks * 16 + hi * 8) * 2;
                        const bf16x8 qf = *(const LAS bf16x8*)(lds + L_Q + (tb * 32 + r32) * QP + cb);
                        const bf16x8 cf = *(const LAS bf16x8*)(lds + L_CT + r32 * CP + cb);
                        ia = __builtin_amdgcn_mfma_f32_32x32x16_bf16(qf, cf, ia, 0, 0, 0); }
#pragma unroll
                    for (int r = 0; r < 16; ++r) *(LAS float*)(lds + L_INT + ((tb * 16 + r) * 64 + lane) * 4) = ia[r];
                } else {
                    const int j = tid - 256, t = j >> 2, part = j & 3;
                    float acc = 0.f;
#pragma unroll
                    for (int i = 0; i < 8; ++i) { const u32x4 qv = *(const LAS u32x4*)(lds + L_Q + t * QP + (part * 64 + i * 8) * 2);
                        const f32x4 n0 = *(const LAS f32x4*)(ncur + part * 64 + i * 8), n1 = *(const LAS f32x4*)(ncur + part * 64 + i * 8 + 4);
                        acc += bf2f(qv[0]) * n0[0] + bf2f(qv[0] >> 16) * n0[1] + bf2f(qv[1]) * n0[2] + bf2f(qv[1] >> 16) * n0[3] + bf2f(qv[2]) * n1[0] + bf2f(qv[2] >> 16) * n1[1] + bf2f(qv[3]) * n1[2] + bf2f(qv[3] >> 16) * n1[3]; }
                    acc += __shfl_xor(acc, 1); acc += __shfl_xor(acc, 2);
                    if (part == 0) snq[t] = acc;
                    float nn = w_c * ncur[j];
#pragma unroll 8
                    for (int s = 0; s < 64; ++s) nn += sws[s] * bf2f(*(const LAS unsigned short*)(lds + L_K + s * QP + j * 2));
                    nnxt[j] = nn;
                }
                { f32x16 cc = ct;
#pragma unroll
                  for (int r = 0; r < 16; ++r) cc[r] *= w_c;
#pragma unroll
                  for (int ks = 0; ks < 4; ++ks) {
                    const unsigned ka = ldsb + L_K + (16 * ks + 8 * hi + tq) * QP + (wid * 32 + tc0) * 2, va = ldsb + L_V + (16 * ks + 8 * hi + tq) * VP + tc0 * 2;
                    const s16x4 kl = trr(ka), kh = trr(ka + 4 * QP), vl = trr(va), vh = trr(va + 4 * VP);
                    const f32x4 wa = *(const LAS f32x4*)(sws + 16 * ks + 8 * hi), wb = *(const LAS f32x4*)(sws + 16 * ks + 8 * hi + 4);
                    asm volatile("s_waitcnt lgkmcnt(0)" ::: "memory"); __builtin_amdgcn_sched_barrier(0);
                    u32x4 vw; vw.x = cvtpk(bf2f((unsigned short)vl[0]) * wa[0], bf2f((unsigned short)vl[1]) * wa[1]); vw.y = cvtpk(bf2f((unsigned short)vl[2]) * wa[2], bf2f((unsigned short)vl[3]) * wa[3]);
                    vw.z = cvtpk(bf2f((unsigned short)vh[0]) * wb[0], bf2f((unsigned short)vh[1]) * wb[1]); vw.w = cvtpk(bf2f((unsigned short)vh[2]) * wb[2], bf2f((unsigned short)vh[3]) * wb[3]);
                    const bf16x8 kf = (bf16x8){kl[0], kl[1], kl[2], kl[3], kh[0], kh[1], kh[2], kh[3]};
                    cc = __builtin_amdgcn_mfma_f32_32x32x16_bf16(kf, *reinterpret_cast<bf16x8*>(&vw), cc, 0, 0, 0); }
                  ct = cc; }
                __syncthreads();
            }
            if (c + 1 < NC) { ML_WRITE(); }
            ML_CTB();
            nsel ^= 1;
        }
        __syncthreads();
        if (!lat) {
            const size_t so = (size_t)((b * 2 + l) * 2 + dir) * 4 + h;
            float* oc = p.out + O_MC + so * 65536 + (size_t)(sl * 32 + r32) * 256 + wid * 32 + 4 * hi;
#pragma unroll
            for (int i = 0; i < 4; ++i) *(f32x4*)(oc + 8 * i) = (f32x4){ct[4 * i], ct[4 * i + 1], ct[4 * i + 2], ct[4 * i + 3]};
            if (sl == 0) { LAS float* nfin = nsel ? nb1 : nb0; if (tid < 256) p.out[O_MN + so * 256 + tid] = nfin[tid]; if (wid == 7 && lane == 0) p.out[O_MM + so] = m_st; }
        }
        __syncthreads();
#undef ML_TOK
#undef ML_LOAD
#undef ML_WRITE
#undef ML_CTB
#undef ML_PK4
    }
}
}


namespace s5 {
typedef short s16x4 __attribute__((ext_vector_type(4)));
__device__ __forceinline__ s16x4 trr(unsigned addr) { s16x4 r; asm volatile("ds_read_b64_tr_b16 %0, %1" : "=&v"(r) : "v"(addr) : "memory"); return r; }
__device__ __forceinline__ unsigned cvtpk(float lo, float hi) { unsigned r; asm volatile("v_cvt_pk_bf16_f32 %0, %1, %2" : "=v"(r) : "v"(lo), "v"(hi)); return r; }
__device__ __forceinline__ void scan_unit(const P& p, const int l, LAS unsigned char* T, const int g, const int dir, const bool lat, const int b0, const int lane) {
    const int r32 = lane & 31, hh = lane >> 5;
    const int L = lat ? LL : CL, NB = L >> 4;
    const int baseA = lat ? NCTX + b0 * LL : b0 * CL, baseB = baseA + L;
    const size_t pg = (size_t)(l * 2 + dir) * 64 + g;
    float ar[2], ai[2]; bf16x8 bb[4];
    const float dt = __expf(p.in[24][pg]);
#pragma unroll
    for (int pb = 0; pb < 2; ++pb) { const int pp = pb * 32 + r32;
        const float lr = fminf(p.in[22][pg * 64 + pp], -1e-4f), li = p.in[23][pg * 64 + pp];
        const float mag = __expf(dt * lr); float sn, cs; sincos_small(dt * li, sn, cs);
        const float a_r = mag * cs, a_i = mag * sn, den = lr * lr + li * li, nr = a_r - 1.0f, ni = a_i, qr = (nr * lr + ni * li) / den, qi = (ni * lr - nr * li) / den;
        ar[pb] = a_r; ai[pb] = a_i;
        const float* br = p.in[25] + (pg * 64 + pp) * 16 + 8 * hh; const float* bi = p.in[26] + (pg * 64 + pp) * 16 + 8 * hh;
        u32x4 wr, wi;
#pragma unroll
        for (int j = 0; j < 4; ++j) { const float r0 = qr * br[2 * j] - qi * bi[2 * j], r1 = qr * br[2 * j + 1] - qi * bi[2 * j + 1], i0 = qr * bi[2 * j] + qi * br[2 * j], i1 = qr * bi[2 * j + 1] + qi * br[2 * j + 1];
            wr[j] = cvtpk(r0, r1); wi[j] = cvtpk(i0, i1); }
        bb[pb] = *reinterpret_cast<bf16x8*>(&wr); bb[2 + pb] = *reinterpret_cast<bf16x8*>(&wi); }
    bf16x8 cm[8];
#pragma unroll
    for (int ks = 0; ks < 8; ++ks) { u32x4 w = {0u, 0u, 0u, 0u};
        if (r32 < 16) { const int k0 = 16 * ks + 8 * hh; const float* src = (k0 < 64 ? p.in[27] : p.in[28]) + (pg * 16 + r32) * 64 + (k0 & 63); const float sg = k0 < 64 ? 1.f : -1.f;
#pragma unroll
            for (int j = 0; j < 4; ++j) w[j] = cvtpk(sg * src[2 * j], sg * src[2 * j + 1]); }
        cm[ks] = *reinterpret_cast<bf16x8*>(&w); }
    const int bme = b0 + hh; float sr[2], si[2];
#pragma unroll
    for (int pb = 0; pb < 2; ++pb) { if (lat) { const size_t so = ((size_t)((bme * 2 + l) * 2 + dir) * 64 + g) * 64 + pb * 32 + r32; sr[pb] = p.in[9][so]; si[pb] = p.in[10][so]; } else { sr[pb] = 0.f; si[pb] = 0.f; } }
    const int urow_tok = 4 * (r32 >> 3) + (r32 & 3), urow_base = ((r32 >> 2) & 1) ? baseB : baseA;
    const bf16_t* U = (const bf16_t*)(p.ws + WS_S5U) + g * 16 + 8 * hh;
    bf16_t* Yo = (bf16_t*)(p.ws + (dir ? WS_YS5B : WS_YS5F)) + g * 16 + r32;
    const int mybase = hh ? baseB : baseA;
#define S5_POS(n, j) (dir ? (L - 1 - ((n) * 16 + (j))) : ((n) * 16 + (j)))
    bf16x8 ucur = *(const bf16x8*)(U + (size_t)(urow_base + S5_POS(0, urow_tok)) * 1024), unxt = ucur;
    const unsigned tb = (unsigned)(uintptr_t)T;
    const int tq = (lane & 15) >> 2, tp = lane & 3, tc0 = 16 * ((lane >> 4) & 1) + 4 * tp;
    for (int n = 0; n < NB; ++n) {
        if (n + 1 < NB) unxt = *(const bf16x8*)(U + (size_t)(urow_base + S5_POS(n + 1, urow_tok)) * 1024);
        f32x16 acc[4]; { float z0 = 0.f; asm volatile("" : "+v"(z0));
#pragma unroll
          for (int q = 0; q < 4; ++q)
#pragma unroll
              for (int r = 0; r < 16; ++r) acc[q][r] = z0; }
#pragma unroll
        for (int q = 0; q < 4; ++q) acc[q] = __builtin_amdgcn_mfma_f32_32x32x16_bf16(ucur, bb[q], acc[q], 0, 0, 0);
#pragma unroll
        for (int pb = 0; pb < 2; ++pb) { float xr = sr[pb], xi = si[pb]; const float a_r = ar[pb], a_i = ai[pb];
#pragma unroll
            for (int r = 0; r < 16; ++r) { const float nr_ = a_r * xr - a_i * xi + acc[pb][r], ni_ = a_r * xi + a_i * xr + acc[2 + pb][r]; xr = nr_; xi = ni_; acc[pb][r] = nr_; acc[2 + pb][r] = ni_; }
            sr[pb] = xr; si[pb] = xi; }
#pragma unroll
        for (int q = 0; q < 4; ++q)
#pragma unroll
            for (int a4 = 0; a4 < 4; ++a4) { u32x2 w; w.x = cvtpk(acc[q][4 * a4], acc[q][4 * a4 + 1]); w.y = cvtpk(acc[q][4 * a4 + 2], acc[q][4 * a4 + 3]);
                *(LAS u32x2*)(T + (q * 32 + r32) * 64 + 16 * a4 + 8 * hh) = w; }
        f32x16 y; { float z0 = 0.f; asm volatile("" : "+v"(z0));
#pragma unroll
          for (int r = 0; r < 16; ++r) y[r] = z0; }
#pragma unroll
        for (int ks = 0; ks < 8; ++ks) { const unsigned ta = tb + (16 * ks + 8 * hh + tq) * 64 + tc0 * 2;
            const s16x4 lo = trr(ta), hi4 = trr(ta + 4 * 64);
            asm volatile("s_waitcnt lgkmcnt(0)" ::: "memory"); __builtin_amdgcn_sched_barrier(0);
            const bf16x8 af = (bf16x8){lo[0], lo[1], lo[2], lo[3], hi4[0], hi4[1], hi4[2], hi4[3]};
            y = __builtin_amdgcn_mfma_f32_32x32x16_bf16(af, cm[ks], y, 0, 0, 0); }
        if (r32 < 16) {
#pragma unroll
            for (int r = 0; r < 16; ++r) Yo[(size_t)(mybase + S5_POS(n, r)) * 1024] = (bf16_t)f2bf(y[r]); }
        ucur = unxt;
    }
#undef S5_POS
    if (!lat) {
#pragma unroll
        for (int pb = 0; pb < 2; ++pb) { const size_t so = ((size_t)((bme * 2 + l) * 2 + dir) * 64 + g) * 64 + pb * 32 + r32; p.out[O_SR + so] = sr[pb]; p.out[O_SI + so] = si[pb]; } }
}
__device__ __forceinline__ void combine_row(const P& p, const int l, const int r, const int lane) {
    const bf16_t* yf = (const bf16_t*)(p.ws + WS_YS5F) + (size_t)r * 1024; const bf16_t* yb = (const bf16_t*)(p.ws + WS_YS5B) + (size_t)r * 1024; const bf16_t* uu = (const bf16_t*)(p.ws + WS_S5U) + (size_t)r * 1024;
    bf16_t* o = (bf16_t*)(p.ws + WS_HB) + (size_t)r * 1024; const float* dv = p.in[29] + l * 1024;
#pragma unroll
    for (int j = 0; j < 2; ++j) { const int c = j * 512 + lane * 8; float a[8], b[8], u[8];
        { const u32x4 w = *(const u32x4*)(yf + c);
#pragma unroll
          for (int i = 0; i < 4; ++i) { a[2 * i] = bf2f(w[i]); a[2 * i + 1] = bf2f(w[i] >> 16); } }
        { const u32x4 w = *(const u32x4*)(yb + c);
#pragma unroll
          for (int i = 0; i < 4; ++i) { b[2 * i] = bf2f(w[i]); b[2 * i + 1] = bf2f(w[i] >> 16); } }
        { const u32x4 w = *(const u32x4*)(uu + c);
#pragma unroll
          for (int i = 0; i < 4; ++i) { u[2 * i] = bf2f(w[i]); u[2 * i + 1] = bf2f(w[i] >> 16); } }
        const f32x4 d0 = *(const f32x4*)(dv + c), d1 = *(const f32x4*)(dv + c + 4);
        float gq[8];
#pragma unroll
        for (int i = 0; i < 8; ++i) gq[i] = gelu_tanh(a[i] + b[i] + (i < 4 ? d0[i] : d1[i - 4]) * u[i]);
        u32x4 w; w.x = pk2(gq[0], gq[1]); w.y = pk2(gq[2], gq[3]); w.z = pk2(gq[4], gq[5]); w.w = pk2(gq[6], gq[7]);
        *(u32x4*)(o + c) = w; }
}
}

__device__ __forceinline__ float rope_lane(float x, int lane, int prow, int pcol, const float* rt) {
    const int part = lane >> 5, jj = lane & 31, idx = jj & 15, pos = part ? pcol : prow;
    const float c = rt[pos * 16 + idx], s = rt[1024 + pos * 16 + idx];
    const float o = __shfl_xor(x, 16);
    return (jj >= 16) ? (x * c + o * s) : (x * c - o * s);
}
__device__ __forceinline__ void ph_prep_row(const P& p, int l, int r, int lane) {
    unsigned char* ws = p.ws;
    bf16_t* ckvn = (bf16_t*)(ws + WS_CKVN) + (size_t)r * 512;
    bf16_t* kf = (bf16_t*)(ws + WS_KFULL) + (size_t)r * 1536;
    bf16_t* dfk = (bf16_t*)(ws + WS_DFK) + (size_t)r * 1024;
    bf16_t* dfv = (bf16_t*)(ws + WS_DFV) + (size_t)r * 1024;
    if (r >= MTOK) {
        const int i = r - MTOK, b = i >> 8, t = i & 255;
        const float* cc = p.in[2] + ((size_t)(b * 2 + l) * PAST + t) * 512;
        for (int j = lane; j < 512; j += 64) ckvn[j] = (bf16_t)f2bf(cc[j]);
        const float kr = p.in[3][((size_t)(b * 2 + l) * PAST + t) * 64 + lane];
#pragma unroll
        for (int h = 0; h < 8; ++h) kf[h * 192 + 128 + lane] = (bf16_t)f2bf(kr);
        const float* ck = p.in[4] + ((size_t)(b * 2 + l) * PAST + t) * 1024; const float* cv = p.in[5] + ((size_t)(b * 2 + l) * PAST + t) * 1024;
        for (int j = lane; j < 1024; j += 64) { dfk[j] = (bf16_t)f2bf(ck[j]); dfv[j] = (bf16_t)f2bf(cv[j]); }
        return;
    }
    const float* kva = (const float*)(ws + WS_KVA) + (size_t)r * KVAW;
    const bool ctx = r < NCTX;
    const int cb = r >> 8, ct = r & 255;
    const int t = (r - NCTX) & 4095, prow = t >> 6, pcol = t & 63;
    const float* rt = (const float*)(ws + WS_ROPE);
    { float v[8]; float ss = 0.f;
#pragma unroll
      for (int j = 0; j < 8; ++j) { v[j] = kva[j * 64 + lane]; ss += v[j] * v[j]; }
      const float rstd = rsqrtf(wave_sum(ss) * (1.0f / 512.0f) + 1e-6f);
      const float* g = p.in[20] + l * 512;
#pragma unroll
      for (int j = 0; j < 8; ++j) { const float y = v[j] * rstd * g[j * 64 + lane]; ckvn[j * 64 + lane] = (bf16_t)f2bf(y);
          if (ctx) p.out[O_CKV + ((size_t)(cb * 2 + l) * CL + ct) * 512 + j * 64 + lane] = y; } }
    { float kr = kva[512 + lane];
      if (ctx) p.out[O_KR + ((size_t)(cb * 2 + l) * CL + ct) * 64 + lane] = kr; else kr = rope_lane(kr, lane, prow, pcol, rt);
#pragma unroll
      for (int h = 0; h < 8; ++h) kf[h * 192 + 128 + lane] = (bf16_t)f2bf(kr); }
    if (lane < 16) { const float g = kva[576 + lane] + p.in[18][l * 16 + lane];
        const float o = ((lane >> 2) & 1) ? (fminf(g, 0.f) - __logf(1.0f + __expf(-fabsf(g)))) : g;
        ((float*)(ws + WS_GATES))[(size_t)r * 16 + lane] = o; }
    if (ctx) {
        float* ok = p.out + O_DK + ((size_t)(cb * 2 + l) * CL + ct) * 1024; float* ov = p.out + O_DV + ((size_t)(cb * 2 + l) * CL + ct) * 1024;
        for (int j = lane; j < 1024; j += 64) { ok[j] = bf2f(dfk[j]); ov[j] = bf2f(dfv[j]); }
    } else {
        bf16_t* mq = (bf16_t*)(ws + WS_MQ) + (size_t)r * 1536; bf16_t* dfq = (bf16_t*)(ws + WS_DFQ) + (size_t)r * 1024;
#pragma unroll
        for (int h = 0; h < 8; ++h) { const float x = bf2f(mq[h * 192 + 128 + lane]); mq[h * 192 + 128 + lane] = (bf16_t)f2bf(rope_lane(x, lane, prow, pcol, rt)); }
#pragma unroll
        for (int h = 0; h < 16; ++h) { const float x = bf2f(dfq[h * 64 + lane]); dfq[h * 64 + lane] = (bf16_t)f2bf(rope_lane(x, lane, prow, pcol, rt));
            const float y = bf2f(dfk[h * 64 + lane]); dfk[h * 64 + lane] = (bf16_t)f2bf(rope_lane(y, lane, prow, pcol, rt)); }
    }
}

__device__ __forceinline__ void ph_mlstm_chain(const P& p, int l, int chain, int tid, float* sm) {
    float* sq = sm; float* sk = sm + 256; float* red = sm + 512;
    const int lane = tid & 63, wid = tid >> 6;
    const bool lat = chain >= 128; const int cc = lat ? chain - 128 : chain, b = cc >> 3, h = (cc >> 1) & 3, dir = cc & 1;
    const int L = lat ? LL : CL, base = lat ? NCTX + b * LL : b * CL;
    float* CT = (float*)(p.ws + WS_CT) + (size_t)chain * 65536;
    float n_k, m;
    if (lat) {
        const float* c0 = p.in[6] + ((size_t)((b * 2 + l) * 2 + dir) * 4 + h) * 65536;
        for (int k = 0; k < 256; ++k) CT[k * 256 + tid] = c0[(size_t)tid * 256 + k];
        n_k = p.in[7][((size_t)((b * 2 + l) * 2 + dir) * 4 + h) * 256 + tid]; m = p.in[8][((b * 2 + l) * 2 + dir) * 4 + h];
    } else { for (int k = 0; k < 256; ++k) CT[k * 256 + tid] = 0.f; n_k = 0.f; m = 0.f; }
    const bf16_t* Q = (const bf16_t*)(p.ws + WS_MLQ); const bf16_t* Kp = (const bf16_t*)(p.ws + WS_MLK); const bf16_t* V = (const bf16_t*)(p.ws + WS_MLV);
    const float* G = (const float*)(p.ws + WS_GATES);
    bf16_t* Hout = (bf16_t*)(p.ws + (dir ? WS_HB : WS_HF));
    for (int s = 0; s < L; ++s) {
        const int r = base + (dir ? L - 1 - s : s);
        __syncthreads();
        sq[tid] = bf2f(Q[(size_t)r * 1024 + h * 256 + tid]); sk[tid] = bf2f(Kp[(size_t)r * 1024 + h * 256 + tid]);
        const float vv = bf2f(V[(size_t)r * 1024 + h * 256 + tid]);
        const float li = G[(size_t)r * 16 + dir * 8 + h], lf = G[(size_t)r * 16 + dir * 8 + 4 + h];
        const float mn = fmaxf(lf + m, li), ip = __expf(li - mn), fp = __expf(lf + m - mn); m = mn;
        __syncthreads();
        const float iv = ip * vv; float num = 0.f;
        for (int k0 = 0; k0 < 256; k0 += 16) { float c[16];
#pragma unroll
            for (int j = 0; j < 16; ++j) c[j] = CT[(k0 + j) * 256 + tid];
#pragma unroll
            for (int j = 0; j < 16; ++j) { c[j] = fp * c[j] + iv * sk[k0 + j]; CT[(k0 + j) * 256 + tid] = c[j]; num += c[j] * sq[k0 + j]; } }
        n_k = fp * n_k + ip * sk[tid];
        const float dp = wave_sum(n_k * sq[tid]);
        if (lane == 0) red[wid] = dp;
        __syncthreads();
        const float den = red[0] + red[1] + red[2] + red[3];
        Hout[(size_t)r * 1024 + h * 256 + tid] = (bf16_t)f2bf(num / fmaxf(fabsf(den), __expf(-m)));
    }
    if (!lat) {
        float* oc = p.out + O_MC + ((size_t)((b * 2 + l) * 2 + dir) * 4 + h) * 65536;
        for (int k = 0; k < 256; ++k) oc[(size_t)tid * 256 + k] = CT[k * 256 + tid];
        p.out[O_MN + ((size_t)((b * 2 + l) * 2 + dir) * 4 + h) * 256 + tid] = n_k;
        if (tid == 0) p.out[O_MM + ((b * 2 + l) * 2 + dir) * 4 + h] = m;
    }
}
__device__ __forceinline__ void ph_ml_combine(const P& p, int l, int w, int lane) {
    const int r = w >> 2, h = w & 3;
    bf16_t* hf = (bf16_t*)(p.ws + WS_HF) + (size_t)r * 1024 + h * 256; const bf16_t* hb = (const bf16_t*)(p.ws + WS_HB) + (size_t)r * 1024 + h * 256;
    const bf16_t* so = (const bf16_t*)(p.ws + WS_MLO) + (size_t)r * 1024 + h * 256; const float* g = p.in[19] + l * 1024 + h * 256;
    float v[4]; float ss = 0.f;
#pragma unroll
    for (int j = 0; j < 4; ++j) { v[j] = bf2f(hf[j * 64 + lane]) + bf2f(hb[j * 64 + lane]); ss += v[j] * v[j]; }
    const float rstd = rsqrtf(wave_sum(ss) * (1.0f / 256.0f) + 1e-6f);
#pragma unroll
    for (int j = 0; j < 4; ++j) hf[j * 64 + lane] = (bf16_t)f2bf(v[j] * rstd * g[j * 64 + lane] * bf2f(so[j * 64 + lane]));
}

__device__ __forceinline__ void reduce16(float (&v)[16], int lane) {
    const bool b5 = lane & 32, b4 = lane & 16, b3 = lane & 8, b2 = lane & 4;
#pragma unroll
    for (int j = 0; j < 8; ++j) { const float keep = b5 ? v[8 + j] : v[j], send = b5 ? v[j] : v[8 + j]; v[j] = keep + __shfl_xor(send, 32); }
#pragma unroll
    for (int j = 0; j < 4; ++j) { const float keep = b4 ? v[4 + j] : v[j], send = b4 ? v[j] : v[4 + j]; v[j] = keep + __shfl_xor(send, 16); }
#pragma unroll
    for (int j = 0; j < 2; ++j) { const float keep = b3 ? v[2 + j] : v[j], send = b3 ? v[j] : v[2 + j]; v[j] = keep + __shfl_xor(send, 8); }
    { const float keep = b2 ? v[1] : v[0], send = b2 ? v[0] : v[1]; v[0] = keep + __shfl_xor(send, 4); }
    v[0] += __shfl_xor(v[0], 2); v[0] += __shfl_xor(v[0], 1);
}
__device__ __forceinline__ void ph_s5_unit(const P& p, int l, int dir, int w, int lane) {
    const int seq = w >> 6, g = w & 63; const bool lat = seq >= 16; const int b = lat ? seq - 16 : seq;
    const int L = lat ? LL : CL, base = lat ? NCTX + b * LL : b * CL;
    const size_t pg = ((size_t)(l * 2 + dir) * 64 + g);
    const float lr = fminf(p.in[22][pg * 64 + lane], -1e-4f), li = p.in[23][pg * 64 + lane], dt = __expf(p.in[24][pg]);
    const float mag = __expf(dt * lr); float sn, cs; sincos_small(dt * li, sn, cs);
    const float ar = mag * cs, ai = mag * sn, den = lr * lr + li * li, nr = ar - 1.0f, ni = ai, qr = (nr * lr + ni * li) / den, qi = (ni * lr - nr * li) / den;
    float bbr[16], bbi[16], cr[16], ci[16];
#pragma unroll
    for (int i = 0; i < 16; ++i) { const float br = p.in[25][(pg * 64 + lane) * 16 + i], bi = p.in[26][(pg * 64 + lane) * 16 + i]; bbr[i] = qr * br - qi * bi; bbi[i] = qr * bi + qi * br;
        cr[i] = p.in[27][(pg * 16 + i) * 64 + lane]; ci[i] = p.in[28][(pg * 16 + i) * 64 + lane]; }
    float sr = 0.f, si = 0.f;
    if (lat) { sr = p.in[9][((size_t)((b * 2 + l) * 2 + dir) * 64 + g) * 64 + lane]; si = p.in[10][((size_t)((b * 2 + l) * 2 + dir) * 64 + g) * 64 + lane]; }
    const bf16_t* U = (const bf16_t*)(p.ws + WS_S5U); float* YF = (float*)(p.ws + WS_YS5F); bf16_t* YG = (bf16_t*)(p.ws + WS_HB);
    const float dval = p.in[29][l * 1024 + g * 16 + ((lane >> 2) & 15)];
    for (int s = 0; s < L; ++s) {
        const int r = base + (dir ? L - 1 - s : s);
        const u32x4 u0 = *(const u32x4*)(U + (size_t)r * 1024 + g * 16), u1 = *(const u32x4*)(U + (size_t)r * 1024 + g * 16 + 8);
        float u[16];
#pragma unroll
        for (int i = 0; i < 4; ++i) { u[2 * i] = bf2f(u0[i]); u[2 * i + 1] = bf2f(u0[i] >> 16); u[8 + 2 * i] = bf2f(u1[i]); u[9 + 2 * i] = bf2f(u1[i] >> 16); }
        float bur = 0.f, bui = 0.f;
#pragma unroll
        for (int i = 0; i < 16; ++i) { bur += bbr[i] * u[i]; bui += bbi[i] * u[i]; }
        const float nsr = ar * sr - ai * si + bur, nsi = ar * si + ai * sr + bui; sr = nsr; si = nsi;
        float y[16];
#pragma unroll
        for (int i = 0; i < 16; ++i) y[i] = cr[i] * sr - ci[i] * si;
        reduce16(y, lane);
        if ((lane & 3) == 0) { const int i = lane >> 2; const size_t o = (size_t)r * 1024 + g * 16 + i;
            if (dir == 0) YF[o] = y[0];
            else { float ui = 0.f;
#pragma unroll
                for (int e = 0; e < 16; ++e) ui = (e == i) ? u[e] : ui;
                YG[o] = (bf16_t)f2bf(gelu_tanh(YF[o] + y[0] + dval * ui)); } }
    }
    if (!lat) { p.out[O_SR + ((size_t)((b * 2 + l) * 2 + dir) * 64 + g) * 64 + lane] = sr; p.out[O_SI + ((size_t)((b * 2 + l) * 2 + dir) * 64 + g) * 64 + lane] = si; }
}

template <int DQK>
__device__ __forceinline__ void ph_attn_unit(const bf16_t* Qp, int qpitch, const bf16_t* Kp, int kpitch, const bf16_t* Vp, int vpitch, int vdiv, bf16_t* Op, int opitch, int nheads, float scale, int w, int lane) {
    const int r = w / nheads, h = w % nheads;
    const bool lat = r >= NCTX; const int b = lat ? (r - NCTX) >> 12 : r >> 8;
    const int nk = lat ? LL + PAST : CL, kbase = lat ? NCTX + b * LL : b * CL, cbase = MTOK + b * PAST;
    const bf16_t* q = Qp + (size_t)r * qpitch + h * DQK;
    float qreg[DQK / 64];
#pragma unroll
    for (int j = 0; j < DQK / 64; ++j) qreg[j] = bf2f(q[j * 64 + lane]) * scale;
    float mrun = -1e30f, lrun = 0.f, o0 = 0.f, o1 = 0.f;
    const int vh = h / vdiv;
    for (int k0 = 0; k0 < nk; k0 += 64) {
        const int kk = k0 + lane, krow = kk < (lat ? LL : CL) ? kbase + kk : cbase + (kk - LL);
        const bf16_t* kp = Kp + (size_t)krow * kpitch + h * DQK;
        float s = 0.f;
#pragma unroll
        for (int j = 0; j < DQK / 64; ++j) {
#pragma unroll
            for (int c8 = 0; c8 < 8; ++c8) { const u32x4 kv = *(const u32x4*)(kp + j * 64 + c8 * 8);
#pragma unroll
                for (int e = 0; e < 4; ++e) { const float q0 = __shfl(qreg[j], c8 * 8 + 2 * e), q1 = __shfl(qreg[j], c8 * 8 + 2 * e + 1); s += q0 * bf2f(kv[e]) + q1 * bf2f(kv[e] >> 16); } }
        }
        const float mx = wave_max(s), mn = fmaxf(mrun, mx), alpha = __expf(mrun - mn), pj = __expf(s - mn);
        lrun = lrun * alpha + wave_sum(pj); o0 *= alpha; o1 *= alpha; mrun = mn;
        for (int j = 0; j < 64; ++j) { const float pb = __shfl(pj, j); const int kj = k0 + j, vrow = kj < (lat ? LL : CL) ? kbase + kj : cbase + (kj - LL);
            const bf16_t* vp = Vp + (size_t)vrow * vpitch + vh * 128; o0 += pb * bf2f(vp[lane]); o1 += pb * bf2f(vp[64 + lane]); }
    }
    const float inv = 1.0f / lrun;
    bf16_t* o = Op + (size_t)r * opitch + h * 128; o[lane] = (bf16_t)f2bf(o0 * inv); o[64 + lane] = (bf16_t)f2bf(o1 * inv);
}
__device__ __forceinline__ void ph_df_combine(const P& p, int l, float lam_init, int w, int lane) {
    const int r = w >> 3, h = w & 7;
    const float* lp = p.in[31] + l * 256;
    const float lam = __expf(wave_sum(lp[lane] * lp[64 + lane])) - __expf(wave_sum(lp[128 + lane] * lp[192 + lane])) + lam_init;
    const bf16_t* o = (const bf16_t*)(p.ws + WS_DFO) + (size_t)r * 2048 + h * 256;
    const float v0 = bf2f(o[lane]) - lam * bf2f(o[128 + lane]), v1 = bf2f(o[64 + lane]) - lam * bf2f(o[192 + lane]);
    const float rstd = rsqrtf(wave_sum(v0 * v0 + v1 * v1) * (1.0f / 128.0f) + 1e-6f);
    const float* g = p.in[32] + l * 128;
    bf16_t* y = (bf16_t*)(p.ws + WS_DFQ) + (size_t)r * 1024 + h * 128;
    y[lane] = (bf16_t)f2bf(v0 * rstd * g[lane] * (1.0f - lam_init)); y[64 + lane] = (bf16_t)f2bf(v1 * rstd * g[64 + lane] * (1.0f - lam_init));
}
__device__ __forceinline__ void ph_final_row(const P& p, int r, int lane) {
    const float* x = (const float*)(p.ws + WS_X) + (size_t)r * D; const float* g = p.in[37];
    f32x4 v[8]; float ss = 0.f;
#pragma unroll
    for (int j = 0; j < 8; ++j) { v[j] = *(const f32x4*)(x + j * 256 + lane * 4); ss += v[j][0] * v[j][0] + v[j][1] * v[j][1] + v[j][2] * v[j][2] + v[j][3] * v[j][3]; }
    const float rstd = rsqrtf(wave_sum(ss) * (1.0f / 2048.0f) + 1e-6f);
    float* o = p.out + (r < NCTX ? O_YP + (size_t)r * D : O_YS + (size_t)(r - NCTX) * D);
#pragma unroll
    for (int j = 0; j < 8; ++j) { const int c = j * 256 + lane * 4; const f32x4 gg = *(const f32x4*)(g + c); *(f32x4*)(o + c) = v[j] * rstd * gg; }
}

__device__ __forceinline__ void load_args(P& p) {
#if defined(__HIP_DEVICE_COMPILE__)
    const __attribute__((address_space(4))) unsigned long long* q = (const __attribute__((address_space(4))) unsigned long long*)__builtin_amdgcn_kernarg_segment_ptr();
    asm volatile("" : "+s"(q));
#pragma unroll
    for (int i = 0; i < 38; ++i) p.in[i] = (const float*)q[i];
    p.out = (float*)q[38]; p.ws = (unsigned char*)q[39];
#endif
}
constexpr int NTHR = 512, LDS_BYTES = 147456, MISC_OFF = 131072;
#define GRID_BAR() do { XcdBarrier b_ = bar; asm volatile("" : "+s"(b_.x)); xcd_barrier(b_); } while (0)

#define PH_VARS P p; load_args(p); unsigned char* ws = p.ws; (void)ws; int tid_ = (int)(bar.w * 64u + lane_id_()); asm volatile("" : "+v"(tid_)); const int lane = tid_ & 63, wave = __builtin_amdgcn_readfirstlane(tid_ >> 6), half = tid_ >> 8, vt = tid_ & 255; \
    const int gw = blockIdx.x * 8 + wave, vb = blockIdx.x * 2 + half; (void)lane; (void)half; (void)vt; (void)gw; (void)vb;

template <int l>
__device__ __forceinline__ void run_layer(unsigned char* lds, const XcdBarrier& bar, const int G, const int NGW) {
        { PH_VARS ph_convert(p, l, gw, NGW, lane, (LAS float*)((LAS unsigned char*)lds + wave * 16384)); }
        { PH_VARS for (int r = gw; r < MTOK; r += NGW) ph_hnorm_row(p, l, 0, r, lane); }
        GRID_BAR();
        { PH_VARS pg8::Gemm g{(const bf16_t*)(ws + WS_H), (const bf16_t*)(ws + WS_WBF + WB_IN), MTOK, 10496, D}; pg8::StaticOrder S; S.init(MTOK, 10496, G, (int)blockIdx.x);
          pg8::gemm_phase<Epi8In, pg8::StaticOrder, true, true>((LAS unsigned char*)lds, g, S, Epi8In{ws}, tid_); }
        GRID_BAR();
        { PH_VARS for (int r = gw; r < MALL; r += NGW) ph_prep_row(p, l, r, lane); }
        GRID_BAR();
        { PH_VARS pg8::Gemm g{(const bf16_t*)(ws + WS_CKVN), (const bf16_t*)(ws + WS_WBF + WB_KVB), MALL, 2048, 512}; pg8::StaticOrder S; S.init(MALL, 2048, G, (int)blockIdx.x);
          pg8::gemm_phase<Epi8Kvb, pg8::StaticOrder, true, true>((LAS unsigned char*)lds, g, S, Epi8Kvb{(bf16_t*)(ws + WS_KFULL), (bf16_t*)(ws + WS_VFULL)}, tid_); }
        { PH_VARS ml::mlstm_phase((LAS unsigned char*)lds, p, l, tid_); }
        GRID_BAR();
        { PH_VARS
          LAS unsigned char* T = (LAS unsigned char*)lds + wave * 8192;
          if (wave == 0) { for (int u = blockIdx.x; u < 256; u += G) { const int dir = u & 1, g = (u >> 1) & 63, pair = u >> 7; s5::scan_unit(p, l, T, g, dir, true, 2 * pair, lane); } }
          else { if (wave <= 4) for (int u = (wave - 1) * G + blockIdx.x; u < 1024; u += 4 * G) { const int dir = u & 1, g = (u >> 1) & 63, pair = u >> 7; s5::scan_unit(p, l, T, g, dir, false, 2 * pair, lane); }
                 for (int w = blockIdx.x * 7 + (wave - 1); w < MTOK * 4; w += G * 7) ph_ml_combine(p, l, w, lane); } }
        GRID_BAR();
        { PH_VARS for (int r = gw; r < MTOK; r += NGW) s5::combine_row(p, l, r, lane); }
        GRID_BAR();
        { PH_VARS pg8::Gemm g{(const bf16_t*)(ws + WS_HB), (const bf16_t*)(ws + WS_WBF + WB_GLU), MTOK, 1024, 1024}; pg8::StaticOrder S; S.init(MTOK, 1024, G, (int)blockIdx.x);
          pg8::gemm_phase<Epi8Glu, pg8::StaticOrder, true, true>((LAS unsigned char*)lds, g, S, Epi8Glu{(const bf16_t*)(ws + WS_HB), (bf16_t*)(ws + WS_S5U)}, tid_); }
        { PH_VARS fa::Args aa{(const bf16_t*)(ws + WS_MQ), (const bf16_t*)(ws + WS_KFULL), (const bf16_t*)(ws + WS_VFULL), (bf16_t*)(ws + WS_MLQ), 1536, 1536, 1024, 1024, 8, 1, 0.07216878364870322f, 0};
          fa::attn_phase<192>((LAS unsigned char*)lds, aa, tid_); }
        { PH_VARS fa::Args aa{(const bf16_t*)(ws + WS_DFQ), (const bf16_t*)(ws + WS_DFK), (const bf16_t*)(ws + WS_DFV), (bf16_t*)(ws + WS_DFO), 1024, 1024, 1024, 2048, 16, 2, 0.125f, 0};
          fa::attn_phase<64>((LAS unsigned char*)lds, aa, tid_); }
        GRID_BAR();
        { PH_VARS const float lam_init = (l == 0) ? 0.2f : 0.35550906759096927f;
          for (int w = gw; w < MTOK * 8; w += NGW) ph_df_combine(p, l, lam_init, w, lane); }
        GRID_BAR();
        { PH_VARS pg8::Gemm g{(const bf16_t*)(ws + WS_H), (const bf16_t*)(ws + WS_WBF + WB_IN) + (size_t)10496 * D, MTOK, GATE_COLS, D}; pg8::StaticOrder S; S.init(MTOK, GATE_COLS, G, (int)blockIdx.x);
          pg8::gemm_phase<Epi8Gate, pg8::StaticOrder, true, true>((LAS unsigned char*)lds, g, S, Epi8Gate{(bf16_t*)(ws + WS_GS)}, tid_); }
        GRID_BAR();
        { PH_VARS pg8::Gemm g{(const bf16_t*)(ws + WS_HF), (const bf16_t*)(ws + WS_WBF + WB_BR) + (size_t)0 * 2048 * 1024, MTOK, D, 1024}; pg8::StaticOrder S; S.init(MTOK, D, G, (int)blockIdx.x);
          pg8::gemm_phase<Epi8Merge, pg8::StaticOrder, true, true>((LAS unsigned char*)lds, g, S, Epi8Merge{(const bf16_t*)(ws + WS_GS), (bf16_t*)(ws + WS_H), 0, 0}, tid_); }
        { PH_VARS pg8::Gemm g{(const bf16_t*)(ws + WS_MLQ), (const bf16_t*)(ws + WS_WBF + WB_BR) + (size_t)1 * 2048 * 1024, MTOK, D, 1024}; pg8::StaticOrder S; S.init(MTOK, D, G, (int)blockIdx.x);
          pg8::gemm_phase<Epi8Merge, pg8::StaticOrder, true, true>((LAS unsigned char*)lds, g, S, Epi8Merge{(const bf16_t*)(ws + WS_GS), (bf16_t*)(ws + WS_H), 1, 0}, tid_); }
        { PH_VARS pg8::Gemm g{(const bf16_t*)(ws + WS_S5U), (const bf16_t*)(ws + WS_WBF + WB_BR) + (size_t)2 * 2048 * 1024, MTOK, D, 1024}; pg8::StaticOrder S; S.init(MTOK, D, G, (int)blockIdx.x);
          pg8::gemm_phase<Epi8Merge, pg8::StaticOrder, true, true>((LAS unsigned char*)lds, g, S, Epi8Merge{(const bf16_t*)(ws + WS_GS), (bf16_t*)(ws + WS_H), 2, 0}, tid_); }
        { PH_VARS pg8::Gemm g{(const bf16_t*)(ws + WS_DFQ), (const bf16_t*)(ws + WS_WBF + WB_BR) + (size_t)3 * 2048 * 1024, MTOK, D, 1024}; pg8::StaticOrder S; S.init(MTOK, D, G, (int)blockIdx.x);
          pg8::gemm_phase<Epi8Merge, pg8::StaticOrder, true, true>((LAS unsigned char*)lds, g, S, Epi8Merge{(const bf16_t*)(ws + WS_GS), (bf16_t*)(ws + WS_H), 3, 0}, tid_); }
        GRID_BAR();
        { PH_VARS pg8::Gemm g{(const bf16_t*)(ws + WS_H), (const bf16_t*)(ws + WS_WBF + WB_O), MTOK, D, D}; pg8::StaticOrder S; S.init(MTOK, D, G, (int)blockIdx.x);
          pg8::gemm_phase<Epi8Res, pg8::StaticOrder, true, true>((LAS unsigned char*)lds, g, S, Epi8Res{p, l, 4096, 0, 0}, tid_); }
        GRID_BAR();
        { PH_VARS for (int r = gw; r < MTOK; r += NGW) ph_hnorm_row(p, l, 1, r, lane); }
        GRID_BAR();
        { PH_VARS pg8::Gemm g{(const bf16_t*)(ws + WS_H), (const bf16_t*)(ws + WS_WBF + WB_FIN), MTOK, 2 * FFN, D}; pg8::StaticOrder S; S.init(MTOK, 2 * FFN, G, (int)blockIdx.x);
          pg8::gemm_phase<Epi8FfnIn, pg8::StaticOrder, true, true>((LAS unsigned char*)lds, g, S, Epi8FfnIn{(bf16_t*)(ws + WS_FFNH)}, tid_); }
        GRID_BAR();
        { PH_VARS pg8::Gemm g{(const bf16_t*)(ws + WS_FFNH), (const bf16_t*)(ws + WS_WBF + WB_FOUT), MTOK, D, FFN}; pg8::StaticOrder S; S.init(MTOK, D, G, (int)blockIdx.x);
          pg8::gemm_phase<Epi8Res, pg8::StaticOrder, true, true>((LAS unsigned char*)lds, g, S, Epi8Res{p, l, 10240, 1, 0}, tid_); }
        GRID_BAR();
}

__global__ void __launch_bounds__(NTHR, 2) mega(P p_arg) {
    extern __shared__ __attribute__((aligned(16))) unsigned char lds[];
    const int tid = threadIdx.x;
    const int G = gridDim.x, NGW = G * 8;
    for (int u = tid; u < (LDS_BYTES - MISC_OFF) / 4; u += NTHR) ((LAS unsigned*)((LAS unsigned char*)lds + MISC_OFF))[u] = 0u;
    __syncthreads();
    XcdBarrier bar = xcd_barrier_post((unsigned*)(p_arg.ws + WS_CTL), (volatile LAS unsigned*)((LAS unsigned char*)lds + MISC_OFF + 32));
    { PH_VARS ph_mod(p, vb, vb < 96, vt, (float*)(lds + half * 40960)); }
    GRID_BAR();
    run_layer<0>(lds, bar, G, NGW);
    run_layer<1>(lds, bar, G, NGW);
    { PH_VARS for (int r = gw; r < MTOK; r += NGW) ph_final_row(p, r, lane); }
}

extern "C" void kernel_launch(void* const* d_in, const int* in_sizes, int n_in, void* d_out, int out_size, void* d_ws, size_t ws_size, hipStream_t stream) {
    static int grid = 0;
    if (grid == 0) {
        if (n_in != 38 || out_size != (int)O_END || ws_size < WS_END) { fprintf(stderr, "kernel_launch: unexpected shapes (n_in %d out %d ws %zu)\n", n_in, out_size, ws_size); grid = -1; return; }
        int dev = 0, cus = 0, per_cu = 0;
        if (hipGetDevice(&dev) != hipSuccess || hipDeviceGetAttribute(&cus, hipDeviceAttributeMultiprocessorCount, dev) != hipSuccess) { grid = -1; return; }
        if (hipFuncSetAttribute((const void*)mega, hipFuncAttributeMaxDynamicSharedMemorySize, LDS_BYTES) != hipSuccess) { fprintf(stderr, "kernel_launch: hipFuncSetAttribute failed\n"); grid = -1; return; }
        if (hipOccupancyMaxActiveBlocksPerMultiprocessor(&per_cu, (const void*)mega, NTHR, LDS_BYTES) != hipSuccess || per_cu < 1) { fprintf(stderr, "kernel_launch: occupancy query says %d workgroups per CU\n", per_cu); grid = -1; return; }
        (void)hipGetLastError();
        grid = cus;
    }
    if (grid < 0) return;
    if (hipMemsetAsync((char*)d_ws + WS_CTL, 0, CTL_BYTES, stream) != hipSuccess) return;
    P p{};
    for (int i = 0; i < 38; ++i) p.in[i] = (const float*)d_in[i];
    p.out = (float*)d_out; p.ws = (unsigned char*)d_ws;
    hipLaunchKernelGGL(mega, dim3(grid), dim3(NTHR), LDS_BYTES, stream, p);
}
```

```cpp
#include <hip/hip_runtime.h>
#include <cstdio>
#include <cstdint>

typedef unsigned short bf16_t;
typedef short bf16x8 __attribute__((ext_vector_type(8)));
typedef float f32x16 __attribute__((ext_vector_type(16)));
typedef float f32x4 __attribute__((ext_vector_type(4)));
typedef unsigned u32x4 __attribute__((ext_vector_type(4)));
typedef unsigned u32x2 __attribute__((ext_vector_type(2)));
typedef float f32x2_ __attribute__((ext_vector_type(2)));

constexpr int D = 2048, NCTX = 4096, NLAT = 16384, MTOK = 20480, MALL = 21504;
constexpr int CB = 16, CL = 256, LB = 4, LL = 4096, PAST = 256;
constexpr int IN_COLS = 18512, MIX_COLS = 10320, GATE_COLS = 8192;
constexpr int C_MLQ = 0, C_MLK = 1024, C_MLV = 2048, C_MLO = 3072, C_MLIF = 4096, C_MQ = 4112, C_KVA = 5648, C_S5U = 6224, C_DFQ = 7248, C_DFK = 8272, C_DFV = 9296;
constexpr int FFN = 5632;
constexpr int NTHR_ = 512;
constexpr int KVAW = 768;

constexpr size_t MiB = 1u << 20;
constexpr size_t WS_CTL = 0, CTL_BYTES = 64 * 1024;
constexpr size_t WS_MOD = 1 * MiB;
constexpr size_t WS_ROPE = WS_MOD + 512 * 1024;
constexpr size_t WS_X = 2 * MiB;
constexpr size_t WS_H = 162 * MiB;
constexpr size_t WS_HF = 242 * MiB;
constexpr size_t WS_HB = 282 * MiB;
constexpr size_t WS_MLQ = 322 * MiB;
constexpr size_t WS_S5U = 362 * MiB;
constexpr size_t WS_DFQ = 402 * MiB;
constexpr size_t WS_MLK = 442 * MiB;
constexpr size_t WS_MLV = 482 * MiB;
constexpr size_t WS_MLO = 522 * MiB;
constexpr size_t WS_MQ = 562 * MiB;
constexpr size_t WS_KVA = 622 * MiB;
constexpr size_t WS_DFK = 682 * MiB;
constexpr size_t WS_DFV = 724 * MiB;
constexpr size_t WS_CKVN = 766 * MiB;
constexpr size_t WS_KFULL = 787 * MiB;
constexpr size_t WS_VFULL = 850 * MiB;
constexpr size_t WS_GATES = 892 * MiB;
constexpr size_t WS_CT = 894 * MiB;
constexpr size_t WS_WBF = 934 * MiB;
constexpr size_t WS_GS = 442 * MiB;
constexpr size_t WS_FFNH = 442 * MiB;
constexpr size_t WS_DFO = 442 * MiB;
constexpr size_t WS_YS5F = 442 * MiB;
constexpr size_t WS_YS5B = 482 * MiB;
constexpr size_t WS_END = 1101 * MiB;

constexpr size_t O_YP = 0, O_YS = 8388608, O_CKV = 41943040, O_KR = 46137344, O_DK = 46661632, O_DV = 55050240,
                 O_MC = 63438848, O_MN = 80216064, O_MM = 80281600, O_SR = 80281856, O_SI = 80544000, O_END = 80806144;

__device__ __forceinline__ unsigned f2bf(float f) { unsigned u = __builtin_bit_cast(unsigned, f); return (u + 0x7fffu + ((u >> 16) & 1u)) >> 16; }
__device__ __forceinline__ float bf2f(unsigned b) { return __builtin_bit_cast(float, (b & 0xffffu) << 16); }
__device__ __forceinline__ unsigned pk2(float lo, float hi) { return f2bf(lo) | (f2bf(hi) << 16); }
__device__ __forceinline__ float wave_sum(float v) {
#pragma unroll
    for (int o = 1; o < 64; o <<= 1) v += __shfl_xor(v, o);
    return v;
}
__device__ __forceinline__ float wave_max(float v) {
#pragma unroll
    for (int o = 1; o < 64; o <<= 1) v = fmaxf(v, __shfl_xor(v, o));
    return v;
}
__device__ __forceinline__ float sigmoidf_(float x) { return 1.0f / (1.0f + __expf(-x)); }
__device__ __forceinline__ float siluf_(float x) { return x / (1.0f + __expf(-x)); }
__device__ __forceinline__ float gelu_tanh(float x) { const float u = 0.7978845608028654f * (x + 0.044715f * x * x * x); const float t = 1.0f - 2.0f / (1.0f + __expf(2.0f * u)); return 0.5f * x * (1.0f + t); }
__device__ __forceinline__ void sincos_small(float x, float& s, float& c) {
    const float k = rintf(x * 0.6366197723675814f);
    float r = fmaf(-k, 1.5707962513e+0f, x); r = fmaf(-k, 7.5497894159e-8f, r); r = fmaf(-k, 5.3903029534e-15f, r);
    const float r2 = r * r;
    const float sp = r + r * r2 * (-1.6666654611e-1f + r2 * (8.3321608736e-3f + r2 * (-1.9515295891e-4f)));
    const float cp = 1.0f - 0.5f * r2 + r2 * r2 * (4.166664568298827e-2f + r2 * (-1.388731625493765e-3f + r2 * 2.443315711809948e-5f));
    const int q = ((int)k) & 3;
    s = (q == 0) ? sp : (q == 1) ? cp : (q == 2) ? -sp : -cp;
    c = (q == 0) ? cp : (q == 1) ? -sp : (q == 2) ? -cp : sp;
}
__device__ __forceinline__ int cond_of_row(int r) { return r < NCTX ? 0 : 1 + ((r - NCTX) >> 12); }

struct P {
    const float* in[38];
    float* out;
    unsigned char* ws;
};
__device__ __forceinline__ const float* x_src(const P& p, int l, int r) {
    if (l == 0) return r < NCTX ? p.in[0] + (size_t)r * D : p.in[1] + (size_t)(r - NCTX) * D;
    return (const float*)(p.ws + WS_X) + (size_t)r * D;
}


#define XB_TMO      128
#define XB_XCNT(j)  (256  + 64 * (j))
#define XB_XSUB(j)  (1280 + 64 * (j))
#define XB_XGEN(j)  (2304 + 64 * (j))
#define XB_TOP      3328
#define XB_TOPGEN   3392
#define XCD_BAR_WORDS 3456
#define XB_SPIN_CAP (1u << 22)
#define LAS __attribute__((address_space(3)))

__device__ __forceinline__ unsigned xb_ld(unsigned* p)              { return __hip_atomic_load(p, __ATOMIC_RELAXED, __HIP_MEMORY_SCOPE_AGENT); }
__device__ __forceinline__ unsigned xb_add(unsigned* p, unsigned v) { return __hip_atomic_fetch_add(p, v, __ATOMIC_RELAXED, __HIP_MEMORY_SCOPE_AGENT); }
__device__ __forceinline__ unsigned xb_xcc_id() { return (unsigned)__builtin_amdgcn_s_getreg((3 << 11) | 20) & 0xFu; }
#define XB_SPIN(cond, bar) do { unsigned _sp = 0; while (cond) { __builtin_amdgcn_s_sleep(1); \
    if ((++_sp & 255u) == 0u) { if (xb_ld(&(bar)[XB_TMO])) break; if (_sp > XB_SPIN_CAP) { atomicAdd(&(bar)[XB_TMO], 1u); break; } } } } while (0)

__device__ __forceinline__ unsigned lane_id_() { unsigned l_; asm volatile("v_mbcnt_lo_u32_b32 %0, -1, 0\n\tv_mbcnt_hi_u32_b32 %0, -1, %0" : "=v"(l_)); return l_; }
struct XcdBarrier {
    unsigned* bar; unsigned x; unsigned w;
    volatile LAS unsigned* st;
};
__device__ __forceinline__ XcdBarrier xcd_barrier_post(unsigned* bar, volatile LAS unsigned* st) {
    XcdBarrier b; b.bar = bar; b.x = xb_xcc_id(); b.st = st; b.w = (unsigned)__builtin_amdgcn_readfirstlane(threadIdx.x >> 6);
    if (threadIdx.x == 0) (void)xb_add(&bar[XB_XCNT(b.x)], 1u);
    return b;
}
__device__ __forceinline__ void xcd_barrier_complete(unsigned* bar, unsigned x, unsigned& nloc, unsigned& nx) {
    const unsigned G = gridDim.x * gridDim.y * gridDim.z;
    unsigned sum, cnt, mine, sp = 0u;
    for (;;) {
        sum = 0u; cnt = 0u; mine = 0u;
#pragma unroll
        for (unsigned j = 0; j < 16; ++j) { const unsigned c = xb_ld(&bar[XB_XCNT(j)]); sum += c; cnt += (c > 0u) ? 1u : 0u; mine = (j == x) ? c : mine; }
        if (sum == G) break;
        __builtin_amdgcn_s_sleep(1);
        if ((++sp & 255u) == 0u) { if (xb_ld(&bar[XB_TMO])) break; if (sp > XB_SPIN_CAP) { atomicAdd(&bar[XB_TMO], 1u); break; } }
    }
    nloc = mine > 0u ? mine : 1u; nx = cnt > 0u ? cnt : 1u;
}
__device__ __forceinline__ void xcd_barrier(const XcdBarrier& b) {
    asm volatile("s_waitcnt vmcnt(0)" ::: "memory");
    __syncthreads();
    if (b.w == 0u && lane_id_() == 0u) {
        unsigned* bar = b.bar;
        __builtin_amdgcn_s_waitcnt(0);
        unsigned nloc = b.st[0], nx = b.st[1];
        if (nloc == 0u) { xcd_barrier_complete(bar, b.x, nloc, nx); b.st[0] = nloc; b.st[1] = nx; }
        const unsigned old = xb_add(&bar[XB_XSUB(b.x)], 1u);
        const unsigned gen = old / nloc;
        if (old + 1u == (gen + 1u) * nloc) {
            __builtin_amdgcn_fence(__ATOMIC_RELEASE, "agent");
            asm volatile("s_waitcnt vmcnt(0)" ::: "memory");
            const unsigned og = xb_add(&bar[XB_TOP], 1u);
            const unsigned tg = og / nx;
            if (og + 1u == (tg + 1u) * nx) xb_add(&bar[XB_TOPGEN], 1u);
            else XB_SPIN(xb_ld(&bar[XB_TOPGEN]) == tg, bar);
            __builtin_amdgcn_fence(__ATOMIC_ACQUIRE, "agent");
            xb_add(&bar[XB_XGEN(b.x)], 1u);
            asm volatile("s_waitcnt vmcnt(0)" ::: "memory");
        } else {
            XB_SPIN(xb_ld(&bar[XB_XGEN(b.x)]) == gen, bar);
            __builtin_amdgcn_fence(__ATOMIC_ACQUIRE, "agent");
            asm volatile("s_waitcnt vmcnt(0)" ::: "memory");
        }
    }
    __syncthreads();
}


constexpr int MOD_KS = 16, MOD_KC = 2048 / MOD_KS;
constexpr size_t WS_MODP = WS_X;
__device__ __forceinline__ void ph_mod_partial(const P& p, int tid, float* sc) {
    for (int i = tid; i < 5 * 2048; i += NTHR_) { const int c = i >> 11, k = i & 2047; const float v = c == 0 ? p.in[12][k] : p.in[11][(c - 1) * 2048 + k]; sc[i] = siluf_(v); }
    __syncthreads();
    const int NU = 2 * 3072 * MOD_KS;
    for (int u = blockIdx.x * NTHR_ + tid; u < NU; u += gridDim.x * NTHR_) {
        const int cg = u % 3072, kc = (u / 3072) % MOD_KS, l = u / (3072 * MOD_KS);
        const float* w = p.in[13] + ((size_t)l * 2048 + kc * MOD_KC) * 12288 + cg * 4;
        f32x4 a0 = {0.f, 0.f, 0.f, 0.f}, a1 = a0, a2 = a0, a3 = a0, a4 = a0;
#pragma unroll 8
        for (int k = 0; k < MOD_KC; ++k) { const f32x4 wv = *(const f32x4*)(w + (size_t)k * 12288); const int kk = kc * MOD_KC + k;
            a0 += wv * sc[kk]; a1 += wv * sc[2048 + kk]; a2 += wv * sc[4096 + kk]; a3 += wv * sc[6144 + kk]; a4 += wv * sc[8192 + kk]; }
        float* o = (float*)(p.ws + WS_MODP) + ((size_t)(kc * 2 + l) * 5) * 12288 + cg * 4;
        *(f32x4*)o = a0; *(f32x4*)(o + 12288) = a1; *(f32x4*)(o + 2 * 12288) = a2; *(f32x4*)(o + 3 * 12288) = a3; *(f32x4*)(o + 4 * 12288) = a4;
    }
    if (blockIdx.x == 0) {
        float* rt = (float*)(p.ws + WS_ROPE);
        for (int i = tid; i < 1024; i += NTHR_) { const int pos = i >> 4, j = i & 15; const float inv = exp2f(-(float)j * (13.287712379549449f / 16.0f)); float s_, c_; sincos_small((float)pos * inv, s_, c_); rt[i] = c_; rt[1024 + i] = s_; }
    }
}
__device__ __forceinline__ void ph_mod_reduce(const P& p, int tid) {
    for (int i = blockIdx.x * NTHR_ + tid; i < 2 * 5 * 12288; i += gridDim.x * NTHR_) {
        const int n = i % 12288, l = (i / 12288) / 5; float acc = p.in[14][l * 12288 + n];
#pragma unroll
        for (int kc = 0; kc < MOD_KS; ++kc) acc += ((const float*)(p.ws + WS_MODP))[(size_t)kc * 2 * 5 * 12288 + i];
        ((float*)(p.ws + WS_MOD))[i] = acc;
    }
}

__device__ __forceinline__ void ph_hnorm_row(const P& p, int l, int which, int r, int lane) {
    const float* x = which == 0 ? x_src(p, l, r) : (const float*)(p.ws + WS_X) + (size_t)r * D;
    const float* nw = p.in[which == 0 ? 15 : 16] + l * 2048;
    const float* mod = (const float*)(p.ws + WS_MOD) + ((size_t)l * 5 + cond_of_row(r)) * 12288 + (which == 0 ? 0 : 3 * 2048);
    f32x4 v[8]; float ss = 0.f;
#pragma unroll
    for (int j = 0; j < 8; ++j) { v[j] = *(const f32x4*)(x + j * 256 + lane * 4); ss += v[j][0] * v[j][0] + v[j][1] * v[j][1] + v[j][2] * v[j][2] + v[j][3] * v[j][3]; }
    const float rstd = rsqrtf(wave_sum(ss) * (1.0f / 2048.0f) + 1e-6f);
    bf16_t* o = (bf16_t*)(p.ws + WS_H) + (size_t)r * D;
#pragma unroll
    for (int j = 0; j < 8; ++j) { const int c = j * 256 + lane * 4; const f32x4 g = *(const f32x4*)(nw + c), sh = *(const f32x4*)(mod + c), s1 = *(const f32x4*)(mod + 2048 + c);
        float y[4];
#pragma unroll
        for (int e = 0; e < 4; ++e) y[e] = v[j][e] * rstd * g[e] * (1.0f + s1[e]) + sh[e];
        u32x2 w; w.x = pk2(y[0], y[1]); w.y = pk2(y[2], y[3]); *(u32x2*)(o + c) = w; }
}

namespace pg8 {
#define PG8_LAS __attribute__((address_space(3)))
typedef unsigned short bf16_t;
typedef short bf16x8 __attribute__((ext_vector_type(8)));
typedef float f32x4 __attribute__((ext_vector_type(4)));
typedef unsigned u32x4 __attribute__((ext_vector_type(4)));
constexpr int BM = 256, BK = 64, HALF = 128, HTB = HALF * BK * 2  , STAGE_BYTES = 8 * HTB, NXCD = 8, WGM = 8;

__host__ __device__ __forceinline__ int lds_byte(int r, int c) { const int st = (r >> 4) * 2 + (c >> 5), rr = r & 15, cc = c & 31, ob = rr * 64 + cc * 2; return st * 1024 + (ob ^ (((ob >> 9) & 1) << 5)); }
__host__ __device__ __forceinline__ void stage_rc(int b, int& R, int& C) { const int st = b / 1024, sb = b % 1024, swz = sb ^ (((sb >> 9) & 1) << 5); R = (st >> 1) * 16 + swz / 64; C = (st & 1) * 32 + (swz % 64) / 2; }
__host__ __device__ __forceinline__ int perm32(int rho) { const int n = rho >> 4, i = rho & 15; return 8 * (i >> 2) + 4 * n + (i & 3); }

struct Unit { int pm, pn; };
struct Gemm { const bf16_t* A; const bf16_t* Bt; int M, N, K; };

struct StaticOrder {
    int nM, nN, nwg, G, c;
    __host__ __device__ void init(int M, int N, int G_, int c_) { nM = M / BM; nN = N / BM; nwg = nM * nN; G = G_; c = c_; }
    __host__ __device__ bool next(int i, Unit& u) const {
        const long L = (long)i * G + c; if (L >= nwg) return false;
        int wgid = (int)L; { const int q = nwg / NXCD, r = nwg % NXCD, xcd = wgid % NXCD, off = wgid / NXCD; wgid = (xcd < r ? xcd * (q + 1) : r * (q + 1) + (xcd - r) * q) + off; }
        const int nig = WGM * nN, gid = wgid / nig, fm = gid * WGM, gsz = (nM - fm) < WGM ? (nM - fm) : WGM;
        u.pm = fm + ((wgid % nig) % gsz); u.pn = (wgid % nig) / gsz; return true;
    }
    __device__ __forceinline__ void a_ready(const Unit&) const {}
    __device__ __forceinline__ void done(const Unit&) const {}
};

__device__ __forceinline__ unsigned cvt_pk_bf16(float lo, float hi) { unsigned r; asm volatile("s_nop 0\n\tv_cvt_pk_bf16_f32 %0, %1, %2" : "=v"(r) : "v"(lo), "v"(hi)); return r; }

template <class Epi, class Sched, bool ALIGN_EPI = false, bool SP2 = false>
__device__ __forceinline__ void gemm_phase(PG8_LAS unsigned char* lds, const Gemm g, const Sched& S, const Epi& E, int tid_in) {
    int tid_l = tid_in; asm volatile("" : "+v"(tid_l));
    const int tid = tid_l, wid = __builtin_amdgcn_readfirstlane(tid >> 6), lane = tid & 63, wr = wid >> 2, wc = wid & 3, fr = lane & 15, fq = lane >> 4;
    const int K = g.K, nt = K / BK;
    unsigned voffA[2], voffB[2];
#pragma unroll
    for (int i = 0; i < 2; ++i) { int R, C; stage_rc(tid * 16 + i * 8192, R, C); const int Rb = Epi::PERM ? ((R & ~31) + perm32(R & 31)) : R;
        voffA[i] = (unsigned)(R * K + C) * 2u; voffB[i] = (unsigned)(Rb * K + C) * 2u; }
    const size_t kstep = (size_t)(BK * 2);
    const size_t hstep = (size_t)HALF * K * 2;
    const size_t tstep = 2 * hstep;
    const unsigned ldsw = (unsigned)wid * 1024u;
    const int aoff = lds_byte(wr * 64 + fr, fq * 8), boff = lds_byte(wc * 32 + fr, fq * 8);
#define PG8_SA(b, h) (((b) * 2 + (h)) * HTB)
#define PG8_SB(b, h) ((4 + (b) * 2 + (h)) * HTB)
#define PG8_STAGE(bufoff, gbase, voff) do { _Pragma("unroll") for (int _i = 0; _i < 2; ++_i) \
        __builtin_amdgcn_global_load_lds((const unsigned*)((const char*)(gbase) + (voff)[_i]), (PG8_LAS unsigned*)(lds + (bufoff) + ldsw + _i * 8192), 16, 0, 0); } while (0)
#define PG8_LDA(dst, b, h) do { _Pragma("unroll") for (int m = 0; m < 4; ++m) _Pragma("unroll") for (int k = 0; k < 2; ++k) dst[m][k] = *(const PG8_LAS bf16x8*)(lds + PG8_SA(b, h) + aoff + m * 2048 + k * 1024); } while (0)
#define PG8_LDB(dst, b, h) do { _Pragma("unroll") for (int n = 0; n < 2; ++n) _Pragma("unroll") for (int k = 0; k < 2; ++k) dst[n][k] = *(const PG8_LAS bf16x8*)(lds + PG8_SB(b, h) + boff + n * 2048 + k * 1024); } while (0)
#define PG8_MMA(ai, bj, At, Bt) do { __builtin_amdgcn_s_setprio(1); _Pragma("unroll") for (int m = 0; m < 4; ++m) _Pragma("unroll") for (int n = 0; n < 2; ++n) _Pragma("unroll") for (int k = 0; k < 2; ++k) \
        acc[ai][bj][m][n] = __builtin_amdgcn_mfma_f32_16x16x32_bf16(Bt[n][k], At[m][k], acc[ai][bj][m][n], 0, 0, 0); __builtin_amdgcn_s_setprio(0); } while (0)
#define PG8_WAIT_V(n) asm volatile("s_waitcnt vmcnt(" #n ")" ::: "memory")
#define PG8_WAIT_L(n) asm volatile("s_waitcnt lgkmcnt(" #n ")" ::: "memory")
#define PG8_BAR __builtin_amdgcn_s_barrier()
#define PG8_SCHED __builtin_amdgcn_sched_barrier(0)
    Unit cur, nxt; int ui = 0;
    if (!S.next(0, cur)) return;
    f32x4 acc[2][2][4][2];
    { float z0 = 0.f; asm volatile("" : "+v"(z0));
#pragma unroll
    for (int a = 0; a < 2; ++a)
#pragma unroll
        for (int b = 0; b < 2; ++b)
#pragma unroll
            for (int m = 0; m < 4; ++m)
#pragma unroll
                for (int n = 0; n < 2; ++n) acc[a][b][m][n] = (f32x4){z0, z0, z0, z0}; }
    bf16x8 At[4][2], B0[2][2], B1[2][2];
    const char* cA = (const char*)g.A + (size_t)cur.pm * tstep; const char* cB = (const char*)g.Bt + (size_t)cur.pn * tstep;
    S.a_ready(cur);
    if constexpr (SP2) {
        PG8_STAGE(PG8_SB(0, 0), cB, voffB); PG8_STAGE(PG8_SB(0, 1), cB + hstep, voffB); PG8_STAGE(PG8_SA(0, 0), cA, voffA); PG8_STAGE(PG8_SA(0, 1), cA + hstep, voffA);
        if (wr == 1) PG8_BAR;
        PG8_WAIT_V(2); PG8_BAR;
        PG8_STAGE(PG8_SB(1, 0), cB + kstep, voffB); PG8_STAGE(PG8_SA(1, 0), cA + kstep, voffA); PG8_STAGE(PG8_SB(1, 1), cB + hstep + kstep, voffB);
        PG8_WAIT_V(6); PG8_BAR;
    } else {
        PG8_STAGE(PG8_SB(0, 0), cB, voffB); PG8_STAGE(PG8_SA(0, 0), cA, voffA); PG8_STAGE(PG8_SB(0, 1), cB + hstep, voffB); PG8_STAGE(PG8_SA(0, 1), cA + hstep, voffA);
        if (wr == 1) PG8_BAR;
        PG8_WAIT_V(4); PG8_BAR;
        PG8_STAGE(PG8_SB(1, 0), cB + kstep, voffB); PG8_STAGE(PG8_SA(1, 0), cA + kstep, voffA); PG8_STAGE(PG8_SB(1, 1), cB + hstep + kstep, voffB);
        PG8_WAIT_V(6); PG8_BAR;
    }
    for (;;) {
        const bool has_next = S.next(ui + 1, nxt);
        const char* nA = has_next ? (const char*)g.A + (size_t)nxt.pm * tstep : cA; const char* nB = has_next ? (const char*)g.Bt + (size_t)nxt.pn * tstep : cB;
        for (int t = 0; t < nt; t += 2) {
            const bool last = (t == nt - 2);
            const char* a1 = cA + (size_t)(t + 1) * kstep;
            const char* a2 = last ? nA : cA + (size_t)(t + 2) * kstep; const char* b2 = last ? nB : cB + (size_t)(t + 2) * kstep;
            const char* a3 = a2 + kstep; const char* b3 = b2 + kstep;
            if (last && has_next) S.a_ready(nxt);
            if constexpr (SP2) {
            PG8_LDB(B0, 0, 0); PG8_LDB(B1, 0, 1); PG8_SCHED; PG8_LDA(At, 0, 0); PG8_STAGE(PG8_SA(1, 1), a1 + hstep, voffA);
            PG8_WAIT_V(8); PG8_WAIT_L(0); PG8_BAR; PG8_MMA(0, 0, At, B0); PG8_MMA(0, 1, At, B1); PG8_BAR; PG8_SCHED;
            PG8_LDA(At, 0, 1); PG8_STAGE(PG8_SB(0, 0), b2, voffB); PG8_STAGE(PG8_SB(0, 1), b2 + hstep, voffB); PG8_STAGE(PG8_SA(0, 0), a2, voffA);
            PG8_WAIT_V(8); PG8_WAIT_L(0); PG8_BAR; PG8_MMA(1, 0, At, B0); PG8_MMA(1, 1, At, B1); PG8_BAR; PG8_SCHED;
            PG8_LDB(B0, 1, 0); PG8_LDB(B1, 1, 1); PG8_SCHED; PG8_LDA(At, 1, 0); PG8_STAGE(PG8_SA(0, 1), a2 + hstep, voffA);
            PG8_WAIT_V(8); PG8_WAIT_L(0); PG8_BAR; PG8_MMA(0, 0, At, B0); PG8_MMA(0, 1, At, B1); PG8_BAR; PG8_SCHED;
            PG8_LDA(At, 1, 1); PG8_STAGE(PG8_SB(1, 0), b3, voffB); PG8_STAGE(PG8_SB(1, 1), b3 + hstep, voffB); PG8_STAGE(PG8_SA(1, 0), a3, voffA);
            PG8_WAIT_V(8); PG8_WAIT_L(0); PG8_BAR; PG8_MMA(1, 0, At, B0); PG8_MMA(1, 1, At, B1); PG8_BAR; PG8_SCHED;
            } else {
            PG8_LDB(B0, 0, 0); PG8_SCHED; PG8_LDA(At, 0, 0); PG8_STAGE(PG8_SA(1, 1), a1 + hstep, voffA);
            PG8_WAIT_L(8); PG8_BAR; PG8_WAIT_L(0); PG8_MMA(0, 0, At, B0); PG8_BAR; PG8_SCHED;
            PG8_LDB(B1, 0, 1); PG8_STAGE(PG8_SB(0, 0), b2, voffB);
            PG8_BAR; PG8_WAIT_L(0); PG8_MMA(0, 1, At, B1); PG8_BAR;
            PG8_LDA(At, 0, 1); PG8_STAGE(PG8_SA(0, 0), a2, voffA);
            PG8_BAR; PG8_WAIT_L(0); PG8_MMA(1, 0, At, B0); PG8_BAR; PG8_SCHED;
            PG8_STAGE(PG8_SB(0, 1), b2 + hstep, voffB);
            PG8_WAIT_V(6); PG8_BAR; PG8_MMA(1, 1, At, B1); PG8_BAR;
            PG8_LDB(B0, 1, 0); PG8_SCHED; PG8_LDA(At, 1, 0); PG8_STAGE(PG8_SA(0, 1), a2 + hstep, voffA);
            PG8_WAIT_L(8); PG8_BAR; PG8_WAIT_L(0); PG8_MMA(0, 0, At, B0); PG8_BAR; PG8_SCHED;
            PG8_LDB(B1, 1, 1); PG8_STAGE(PG8_SB(1, 0), b3, voffB);
            PG8_BAR; PG8_WAIT_L(0); PG8_MMA(0, 1, At, B1); PG8_BAR;
            PG8_LDA(At, 1, 1); PG8_STAGE(PG8_SA(1, 0), a3, voffA);
            PG8_BAR; PG8_WAIT_L(0); PG8_MMA(1, 0, At, B0); PG8_BAR; PG8_SCHED;
            PG8_STAGE(PG8_SB(1, 1), b3 + hstep, voffB);
            PG8_WAIT_V(6); PG8_BAR; PG8_MMA(1, 1, At, B1); PG8_BAR;
            }
        }
        if constexpr (ALIGN_EPI) { if (wr == 0) PG8_BAR; }
        if constexpr (!Epi::AFTER_DRAIN) { E(acc, cur, wr, wc, fr, fq); S.done(cur); }
        if (!has_next) break;
        { float z0 = 0.f; asm volatile("" : "+v"(z0));
#pragma unroll
        for (int a = 0; a < 2; ++a)
#pragma unroll
            for (int b = 0; b < 2; ++b)
#pragma unroll
                for (int m = 0; m < 4; ++m)
#pragma unroll
                    for (int n = 0; n < 2; ++n) acc[a][b][m][n] = (f32x4){z0, z0, z0, z0}; }
        cur = nxt; cA = nA; cB = nB; ++ui;
        if constexpr (ALIGN_EPI) { if (wr == 1) PG8_BAR; }
    }
    PG8_WAIT_V(0);
    if constexpr (!ALIGN_EPI) { if (wr == 0) PG8_BAR; }
    PG8_BAR;
    if constexpr (Epi::AFTER_DRAIN) { E.fused(acc, cur, wr, wc, fr, fq, lds, wid, lane); S.done(cur); }
#undef PG8_SA
#undef PG8_SB
#undef PG8_STAGE
#undef PG8_LDA
#undef PG8_LDB
#undef PG8_MMA
#undef PG8_WAIT_V
#undef PG8_WAIT_L
#undef PG8_BAR
#undef PG8_SCHED
}
}

#define PG8_ROW(ai, m) (u.pm * 256 + (ai) * 128 + wr * 64 + (m) * 16 + fr)
#define PG8_FOR(...) _Pragma("unroll") for (int ai = 0; ai < 2; ++ai) _Pragma("unroll") for (int m = 0; m < 4; ++m) { const int row = PG8_ROW(ai, m); _Pragma("unroll") for (int bj = 0; bj < 2; ++bj) { \
    const int ct = bj * 128 + wc * 32 + 8 * fq; const pg8::f32x4 v0 = acc[ai][bj][m][0], v1 = acc[ai][bj][m][1]; __VA_ARGS__ } }
__device__ __forceinline__ u32x4 pack8(const pg8::f32x4& a, const pg8::f32x4& b) { u32x4 w; w.x = pg8::cvt_pk_bf16(a[0], a[1]); w.y = pg8::cvt_pk_bf16(a[2], a[3]); w.z = pg8::cvt_pk_bf16(b[0], b[1]); w.w = pg8::cvt_pk_bf16(b[2], b[3]); return w; }
__device__ __forceinline__ void unpack8(const u32x4& w, float (&f)[8]) {
#pragma unroll
    for (int i = 0; i < 4; ++i) { f[2 * i] = bf2f(w[i]); f[2 * i + 1] = bf2f(w[i] >> 16); } }

struct Epi8In {
    static constexpr bool PERM = true, AFTER_DRAIN = false;
    unsigned char* ws;
    __device__ __forceinline__ void operator()(const pg8::f32x4 (&acc)[2][2][4][2], const pg8::Unit& u, int wr, int wc, int fr, int fq) const {
        const int pn = u.pn;
        if (pn >= 22 && pn < 25) {
            float* kva = (float*)(ws + WS_KVA);
            PG8_FOR({ float* o = kva + (size_t)row * KVAW + (pn - 22) * 256 + ct; *(pg8::f32x4*)o = v0; *(pg8::f32x4*)(o + 4) = v1; })
            return;
        }
        size_t base; int ldc, c0, mode = 0;
        if (pn < 4) { base = WS_MLQ; ldc = 1024; c0 = pn * 256; }
        else if (pn < 8) { base = WS_MLK; ldc = 1024; c0 = (pn - 4) * 256; mode = 1; }
        else if (pn < 12) { base = WS_MLV; ldc = 1024; c0 = (pn - 8) * 256; }
        else if (pn < 16) { base = WS_MLO; ldc = 1024; c0 = (pn - 12) * 256; mode = 2; }
        else if (pn < 22) { base = WS_MQ; ldc = 1536; c0 = (pn - 16) * 256; mode = 3; }
        else if (pn < 29) { base = WS_S5U; ldc = 1024; c0 = (pn - 25) * 256; }
        else if (pn < 33) { base = WS_DFQ; ldc = 1024; c0 = (pn - 29) * 256; mode = 4; }
        else if (pn < 37) { base = WS_DFK; ldc = 1024; c0 = (pn - 33) * 256; }
        else { base = WS_DFV; ldc = 1024; c0 = (pn - 37) * 256; }
        bf16_t* O = (bf16_t*)(ws + base);
        PG8_FOR({ pg8::f32x4 a = v0, b = v1;
            if (mode == 1) { a = a * 0.0625f; b = b * 0.0625f; }
            if (mode == 3) { a = a * (0.07216878364870322f * 1.4426950408889634f); b = b * (0.07216878364870322f * 1.4426950408889634f); }
            if (mode == 4) { a = a * (0.125f * 1.4426950408889634f); b = b * (0.125f * 1.4426950408889634f); }
            if (mode == 2) {
_Pragma("unroll")
                for (int e = 0; e < 4; ++e) { a[e] = sigmoidf_(a[e]); b[e] = sigmoidf_(b[e]); } }
            *(u32x4*)(O + (size_t)row * ldc + c0 + ct) = pack8(a, b); })
    }
};
struct Epi8Gate {
    static constexpr bool PERM = true, AFTER_DRAIN = false;
    bf16_t* gs;
    __device__ __forceinline__ void operator()(const pg8::f32x4 (&acc)[2][2][4][2], const pg8::Unit& u, int wr, int wc, int fr, int fq) const {
        PG8_FOR({ pg8::f32x4 a, b;
_Pragma("unroll")
            for (int e = 0; e < 4; ++e) { a[e] = sigmoidf_(v0[e]); b[e] = sigmoidf_(v1[e]); }
            *(u32x4*)(gs + (size_t)row * GATE_COLS + u.pn * 256 + ct) = pack8(a, b); })
    }
};
struct Epi8Kvb {
    static constexpr bool PERM = true, AFTER_DRAIN = false;
    bf16_t* kf; bf16_t* vf;
    __device__ __forceinline__ void operator()(const pg8::f32x4 (&acc)[2][2][4][2], const pg8::Unit& u, int wr, int wc, int fr, int fq) const {
        PG8_FOR({ bf16_t* o = bj == 0 ? kf + (size_t)row * 1536 + u.pn * 192 + wc * 32 + 8 * fq : vf + (size_t)row * 1024 + u.pn * 128 + wc * 32 + 8 * fq; (void)ct;
            *(u32x4*)o = pack8(v0, v1); })
    }
};
struct Epi8Glu {
    static constexpr bool PERM = true, AFTER_DRAIN = false;
    const bf16_t* g; bf16_t* y;
    __device__ __forceinline__ void operator()(const pg8::f32x4 (&acc)[2][2][4][2], const pg8::Unit& u, int wr, int wc, int fr, int fq) const {
        PG8_FOR({ const size_t i = (size_t)row * 1024 + u.pn * 256 + ct; float gf[8]; unpack8(*(const u32x4*)(g + i), gf); pg8::f32x4 a, b;
_Pragma("unroll")
            for (int e = 0; e < 4; ++e) { a[e] = gf[e] * sigmoidf_(v0[e]); b[e] = gf[4 + e] * sigmoidf_(v1[e]); }
            *(u32x4*)(y + i) = pack8(a, b); })
    }
};
struct Epi8Merge {
    static constexpr bool PERM = true, AFTER_DRAIN = false;
    const bf16_t* gs; bf16_t* mg; int b; int pad;
    __device__ __forceinline__ void operator()(const pg8::f32x4 (&acc)[2][2][4][2], const pg8::Unit& u, int wr, int wc, int fr, int fq) const {
        PG8_FOR({ const size_t i = (size_t)row * D + u.pn * 256 + ct; float gf[8], pf[8]; unpack8(*(const u32x4*)(gs + (size_t)row * GATE_COLS + b * D + u.pn * 256 + ct), gf);
            if (b) unpack8(*(const u32x4*)(mg + i), pf); else {
_Pragma("unroll")
                for (int e = 0; e < 8; ++e) pf[e] = 0.f; }
            pg8::f32x4 a, c;
_Pragma("unroll")
            for (int e = 0; e < 4; ++e) { a[e] = pf[e] + gf[e] * v0[e]; c[e] = pf[4 + e] + gf[4 + e] * v1[e]; }
            *(u32x4*)(mg + i) = pack8(a, c); })
    }
};
struct Epi8Res {
    static constexpr bool PERM = true, AFTER_DRAIN = false;
    P p; int l; int goff; int from_x; int pad;
    __device__ __forceinline__ void operator()(const pg8::f32x4 (&acc)[2][2][4][2], const pg8::Unit& u, int wr, int wc, int fr, int fq) const {
        float* X = (float*)(p.ws + WS_X);
        const float* gv = (const float*)(p.ws + WS_MOD) + ((size_t)l * 5 + cond_of_row(u.pm * 256)) * 12288 + goff + u.pn * 256;
        PG8_FOR({ const float* src = (from_x ? X + (size_t)row * D : x_src(p, l, row)) + u.pn * 256 + ct; float* dst = X + (size_t)row * D + u.pn * 256 + ct;
            const pg8::f32x4 g0 = *(const pg8::f32x4*)(gv + ct), g1 = *(const pg8::f32x4*)(gv + ct + 4), s0 = *(const pg8::f32x4*)src, s1 = *(const pg8::f32x4*)(src + 4);
            *(pg8::f32x4*)dst = s0 + g0 * v0; *(pg8::f32x4*)(dst + 4) = s1 + g1 * v1; })
    }
};
struct Epi8FfnIn {
    static constexpr bool PERM = true, AFTER_DRAIN = false;
    bf16_t* hh;
    __device__ __forceinline__ void operator()(const pg8::f32x4 (&acc)[2][2][4][2], const pg8::Unit& u, int wr, int wc, int fr, int fq) const {
_Pragma("unroll")
        for (int ai = 0; ai < 2; ++ai)
_Pragma("unroll")
            for (int m = 0; m < 4; ++m) { const int row = PG8_ROW(ai, m); pg8::f32x4 a, b;
_Pragma("unroll")
                for (int e = 0; e < 4; ++e) { a[e] = siluf_(acc[ai][0][m][0][e]) * acc[ai][1][m][0][e]; b[e] = siluf_(acc[ai][0][m][1][e]) * acc[ai][1][m][1][e]; }
                *(u32x4*)(hh + (size_t)row * FFN + u.pn * 128 + wc * 32 + 8 * fq) = pack8(a, b); }
    }
};

__device__ __forceinline__ int win_row(int n) {
    if (n < 4096) return n;
    if (n < 4112) return 6208 + (n - 4096);
    if (n < 5648) return 4096 + (n - 4112);
    if (n < 6224) return 5632 + (n - 5648);
    if (n < MIX_COLS) return 6400 + (n - 6224);
    return 10496 + (n - MIX_COLS);
}
template <int MAP>
__device__ __forceinline__ void cvt_item(const float* W, int K, int N, bf16_t* WT, int row_off, LAS float* scr, int item, int lane) {
    const int nblk = (N + 31) / 32, kb = item / nblk, nb = item % nblk, k0 = 64 * kb, n0 = 32 * nb;
    const int nl = (lane & 7) * 4, kr = lane >> 3;
    const bool nok = n0 + nl < N;
    const float* wp = W + (size_t)(k0 + kr) * N + n0 + nl;
    f32x4 v[8];
#pragma unroll
    for (int i = 0; i < 8; ++i) v[i] = nok ? *(const f32x4*)(wp + (size_t)(8 * i) * N) : (f32x4){0.f, 0.f, 0.f, 0.f};
#pragma unroll
    for (int i = 0; i < 8; ++i) { LAS float* d = scr + (kr + 8 * i) * 33 + nl; d[0] = v[i][0]; d[1] = v[i][1]; d[2] = v[i][2]; d[3] = v[i][3]; }
    asm volatile("s_waitcnt lgkmcnt(0)" ::: "memory");
    const int c = lane & 7;
#pragma unroll
    for (int j = 0; j < 4; ++j) { const int n = (lane >> 3) + 8 * j; const LAS float* s = scr + (8 * c) * 33 + n;
        u32x4 o; o.x = pk2(s[0 * 33], s[1 * 33]); o.y = pk2(s[2 * 33], s[3 * 33]); o.z = pk2(s[4 * 33], s[5 * 33]); o.w = pk2(s[6 * 33], s[7 * 33]);
        const int ng = n0 + n; int row;
        if (MAP == 0) row = row_off + ng; else if (MAP == 1) row = win_row(ng); else row = (ng < FFN) ? ((ng >> 7) * 256 + (ng & 127)) : (((ng - FFN) >> 7) * 256 + 128 + ((ng - FFN) & 127));
        if (ng < N) *(u32x4*)(WT + (size_t)row * K + k0 + 8 * c) = o; }
    asm volatile("s_waitcnt lgkmcnt(0)" ::: "memory");
}
constexpr size_t WB_IN = 0, WB_KVB = 73 * MiB, WB_GLU = 75 * MiB, WB_BR = 77 * MiB, WB_O = 93 * MiB, WB_FIN = 101 * MiB, WB_FOUT = 145 * MiB, WB_END = 167 * MiB;
constexpr int NIN_T = 18688;
__device__ __forceinline__ void ph_convert(const P& p, int l, int gw, int NGW, int lane, LAS float* scr, const bool early, const bool late) {
    unsigned char* wb = p.ws + WS_WBF;
    constexpr int I_IN = (D / 64) * ((IN_COLS + 31) / 32), I_KVB = (512 / 64) * (2048 / 32), I_GLU = (1024 / 64) * (1024 / 32), I_BR = (1024 / 64) * (2048 / 32), I_O = (D / 64) * (D / 32),
                  I_FIN = (D / 64) * (2 * FFN / 32), I_FOUT = (FFN / 64) * (D / 32);
    constexpr int NIT = I_IN + I_KVB + I_GLU + 4 * I_BR + I_O + I_FIN + I_FOUT;
    const int it_lo = early ? 0 : NIT - I_FOUT, it_hi = late ? NIT : NIT - I_FOUT;
    for (int it = it_lo + gw; it < it_hi; it += NGW) {
        int r = it;
        if (r < I_IN) { cvt_item<1>(p.in[17] + (size_t)l * D * IN_COLS, D, IN_COLS, (bf16_t*)(wb + WB_IN), 0, scr, r, lane); continue; } r -= I_IN;
        if (r < I_KVB) { cvt_item<0>(p.in[21] + (size_t)l * 512 * 2048, 512, 2048, (bf16_t*)(wb + WB_KVB), 0, scr, r, lane); continue; } r -= I_KVB;
        if (r < I_GLU) { cvt_item<0>(p.in[30] + (size_t)l * 1024 * 1024, 1024, 1024, (bf16_t*)(wb + WB_GLU), 0, scr, r, lane); continue; } r -= I_GLU;
        if (r < 4 * I_BR) { const int b = r / I_BR; cvt_item<0>(p.in[33] + ((size_t)l * 4 + b) * 1024 * 2048, 1024, 2048, (bf16_t*)(wb + WB_BR) + (size_t)b * 2048 * 1024, 0, scr, r % I_BR, lane); continue; } r -= 4 * I_BR;
        if (r < I_O) { cvt_item<0>(p.in[34] + (size_t)l * D * D, D, D, (bf16_t*)(wb + WB_O), 0, scr, r, lane); continue; } r -= I_O;
        if (r < I_FIN) { cvt_item<2>(p.in[35] + (size_t)l * D * 2 * FFN, D, 2 * FFN, (bf16_t*)(wb + WB_FIN), 0, scr, r, lane); continue; } r -= I_FIN;
        cvt_item<0>(p.in[36] + (size_t)l * FFN * D, FFN, D, (bf16_t*)(wb + WB_FOUT), 0, scr, r, lane);
    }
    if (early) for (int row = 6224 + gw; row < 6400; row += NGW) { u32x4* o = (u32x4*)((bf16_t*)(wb + WB_IN) + (size_t)row * D); for (int j = lane; j < D / 8; j += 64) o[j] = (u32x4){0u, 0u, 0u, 0u}; }
}


__device__ __forceinline__ int xcd_slot() { const int G_ = (int)gridDim.x, c_ = (int)blockIdx.x; return (G_ % 8 == 0) ? (c_ % 8) * (G_ / 8) + c_ / 8 : c_; }
namespace fa {
typedef short s16x4 __attribute__((ext_vector_type(4)));
__device__ __forceinline__ int crow(int r, int hi) { return (r & 3) + 8 * (r >> 2) + 4 * hi; }
__device__ __forceinline__ unsigned cvtpk(float lo, float hi) { unsigned r; asm volatile("v_cvt_pk_bf16_f32 %0, %1, %2" : "=v"(r) : "v"(lo), "v"(hi)); return r; }
#define FA_SBAR() __builtin_amdgcn_sched_barrier(0)
constexpr float THR = 8.f;
__device__ __forceinline__ void partialSM_fma(f32x16& p0, f32x16& p1, float& m_reg, float& mn, float& alpha, float SCALE) {
    const float C = SCALE * 1.4426950408889634f;
    float pmax = p0[0];
#pragma unroll
    for (int r = 1; r < 16; ++r) pmax = fmaxf(pmax, p0[r]);
#pragma unroll
    for (int r = 0; r < 16; ++r) pmax = fmaxf(pmax, p1[r]);
    { auto rr = __builtin_amdgcn_permlane32_swap(__float_as_uint(pmax), __float_as_uint(pmax), false, false);
      pmax = fmaxf(__uint_as_float(rr[0]), __uint_as_float(rr[1])); }
    if (__builtin_expect(__all(pmax - m_reg <= THR / SCALE), 1)) { mn = m_reg; alpha = 1.f; }
    else { mn = fmaxf(m_reg, pmax); alpha = __builtin_amdgcn_exp2f((m_reg - mn) * C); m_reg = mn; }
    const float mnC = -mn * C;
#pragma unroll
    for (int r = 0; r < 16; ++r) p0[r] = fmaf(p0[r], C, mnC);
#pragma unroll
    for (int r = 0; r < 16; ++r) p1[r] = fmaf(p1[r], C, mnC);
#pragma unroll
    for (int r = 0; r < 16; ++r) p0[r] = __builtin_amdgcn_exp2f(p0[r]);
}
constexpr float THR2 = THR * 1.4426950408889634f;
__device__ __forceinline__ void partialSM(f32x16& p0, f32x16& p1, float& m_reg, f32x16& nm, float& alpha, const bool first) {
    float pmax = p0[0];
#pragma unroll
    for (int r = 1; r < 16; ++r) pmax = fmaxf(pmax, p0[r]);
#pragma unroll
    for (int r = 0; r < 16; ++r) pmax = fmaxf(pmax, p1[r]);
    { auto rr = __builtin_amdgcn_permlane32_swap(__float_as_uint(pmax), __float_as_uint(pmax), false, false);
      pmax = fmaxf(__uint_as_float(rr[0]), __uint_as_float(rr[1])); }
    alpha = 1.f;
    if (first || !__all(pmax <= THR2)) {
        const float d = first ? pmax : fmaxf(pmax, 0.f);
        if (!first) alpha = __builtin_amdgcn_exp2f(-d);
        m_reg += d;
#pragma unroll
        for (int r = 0; r < 16; ++r) { p0[r] -= d; p1[r] -= d; nm[r] = -m_reg; }
    }
#pragma unroll
    for (int r = 0; r < 16; ++r) p0[r] = __builtin_amdgcn_exp2f(p0[r]);
}
__device__ __forceinline__ void finishSM(f32x16& p0, f32x16& p1, float alpha, float& l_reg, bf16x8& pa0, bf16x8& pa1, bf16x8& pa2, bf16x8& pa3) {
#pragma unroll
    for (int r = 0; r < 16; ++r) p1[r] = __builtin_amdgcn_exp2f(p1[r]);
    FA_SBAR(); asm volatile("s_nop 1");
    float ps = 0;
#pragma unroll
    for (int r = 0; r < 16; ++r) ps += p0[r];
#pragma unroll
    for (int r = 0; r < 16; ++r) ps += p1[r];
    { auto rr = __builtin_amdgcn_permlane32_swap(__float_as_uint(ps), __float_as_uint(ps), false, false);
      ps = __uint_as_float(rr[0]) + __uint_as_float(rr[1]); }
    l_reg = l_reg * alpha + ps;
#define FA_PK4(P, BASE, OUT) do { u32x4 w = {cvtpk(P[BASE + 0], P[BASE + 1]), cvtpk(P[BASE + 2], P[BASE + 3]), cvtpk(P[BASE + 4], P[BASE + 5]), cvtpk(P[BASE + 6], P[BASE + 7])}; \
    OUT = *reinterpret_cast<bf16x8*>(&w); } while (0)
    FA_PK4(p0, 0, pa0); FA_PK4(p0, 8, pa1); FA_PK4(p1, 0, pa2); FA_PK4(p1, 8, pa3);
#undef FA_PK4
}
__device__ __forceinline__ int v_rd_base(int lane) { return ((lane & 3) << 3) | (((lane >> 2) & 3) << 6) | (((lane >> 4) & 1) << 5) | (((lane >> 5) & 1) << 8); }
constexpr int v_rd_off(int d0, int ks, int half) { return d0 * 512 + ks * 4096 + half * 2048; }
__device__ __forceinline__ bf16x8 lds_rd128i(unsigned addr, const int off) { bf16x8 r; asm volatile("ds_read_b128 %0, %1 offset:%2" : "=&v"(r) : "v"(addr), "i"(off) : "memory"); return r; }
template <int OFF> __device__ __forceinline__ bf16x8 lds_rd128(unsigned addr) { bf16x8 r; asm volatile("ds_read_b128 %0, %1 offset:%2" : "=&v"(r) : "v"(addr), "i"(OFF) : "memory"); return r; }
template <int OFF> __device__ __forceinline__ s16x4 tr_read(unsigned vb) {
    s16x4 r; asm volatile("ds_read_b64_tr_b16 %0, %1 offset:%2" : "=&v"(r) : "v"(vb), "i"(OFF) : "memory"); return r;
}
template <int D0> __device__ __forceinline__ void pv_one(f32x16& od, unsigned vb, bf16x8 pa0, bf16x8 pa1, bf16x8 pa2, bf16x8 pa3) {
    const s16x4 l0 = tr_read<v_rd_off(D0, 0, 0)>(vb), h0 = tr_read<v_rd_off(D0, 0, 1)>(vb), l1 = tr_read<v_rd_off(D0, 1, 0)>(vb), h1 = tr_read<v_rd_off(D0, 1, 1)>(vb);
    const s16x4 l2 = tr_read<v_rd_off(D0, 2, 0)>(vb), h2 = tr_read<v_rd_off(D0, 2, 1)>(vb), l3 = tr_read<v_rd_off(D0, 3, 0)>(vb), h3 = tr_read<v_rd_off(D0, 3, 1)>(vb);
    asm volatile("s_waitcnt lgkmcnt(0)" ::: "memory"); FA_SBAR();
#define FA_PK(L, H) (bf16x8){L[0], L[1], L[2], L[3], H[0], H[1], H[2], H[3]}
    od = __builtin_amdgcn_mfma_f32_32x32x16_bf16(pa0, FA_PK(l0, h0), od, 0, 0, 0);
    od = __builtin_amdgcn_mfma_f32_32x32x16_bf16(pa1, FA_PK(l1, h1), od, 0, 0, 0);
    od = __builtin_amdgcn_mfma_f32_32x32x16_bf16(pa2, FA_PK(l2, h2), od, 0, 0, 0);
    od = __builtin_amdgcn_mfma_f32_32x32x16_bf16(pa3, FA_PK(l3, h3), od, 0, 0, 0);
#undef FA_PK
}
struct Args { const bf16_t* Q; const bf16_t* K; const bf16_t* V; bf16_t* O; int qpitch, kpitch, vpitch, opitch, nheads, vdiv; float scale; int pad; };

template <int DQK>
__device__ __forceinline__ void attn_phase(LAS unsigned char* lds, const Args& a, int tid) {
    constexpr int KROWB = DQK * 2, KCH = KROWB / 16, KTILE = 64 * KROWB, VTILE = 16384, STAGE = KTILE + VTILE, NKI = KTILE / 8192, NVI = 2, NDMA = NKI + NVI, ND = DQK / 16;
    constexpr int RING = (DQK == 64) ? 4 : 3;
    static_assert(RING * STAGE + 2048 <= 131072, "attention LDS");
    const int wid = __builtin_amdgcn_readfirstlane(tid >> 6), lane = tid & 63, r32 = lane & 31, hi = lane >> 5;
    const int krow = (r32 & ~0xC) | ((r32 & 4) << 1) | ((r32 & 8) >> 1);
    LAS float* wsc = (LAS float*)(lds + RING * STAGE) + wid * 64;
    unsigned koff_[NKI], voff_[NVI];
#pragma unroll
    for (int i = 0; i < NKI; ++i) { const int s = i * 512 + wid * 64 + lane, row = s / KCH, ch = s % KCH; koff_[i] = (unsigned)(row * a.kpitch + (ch ^ ((row & 3) | (((row >> 3) & 1) << 2))) * 8) * 2u; }
#pragma unroll
    for (int i = 0; i < NVI; ++i) { const int o = (i * 512 + wid * 64 + lane) * 16, sub = o >> 9, within = o & 511, kk = (sub >> 2) * 8 + (within >> 6), c = (sub & 3) * 32 + ((within & 63) >> 1);
        const int k = (kk & ~0xC) | ((kk & 4) << 1) | ((kk & 8) >> 1); voff_[i] = (unsigned)(k * a.vpitch + c) * 2u; }
    const unsigned vb0 = (unsigned)(uintptr_t)(lds + KTILE) + (unsigned)v_rd_base(lane);
    const int n_lat = a.nheads * 64, n_units = n_lat + a.nheads * 16;
    for (int u = xcd_slot(); u < n_units; u += gridDim.x) {
        int b, h, q0, nk, kbase, cbase;
        if (u < n_lat) { const int bh = u >> 4, qb = u & 15; b = bh / a.nheads; h = bh % a.nheads; q0 = NCTX + b * LL + qb * 256; nk = LL + PAST; kbase = NCTX + b * LL; cbase = MTOK + b * PAST; }
        else { const int v = u - n_lat; b = v / a.nheads; h = v % a.nheads; q0 = b * CL; nk = CL; kbase = b * CL; cbase = 0; }
        const int NT = nk >> 6, vh = h / a.vdiv;
        const bf16_t* Kh = a.K + h * DQK; const bf16_t* Vh = a.V + vh * 128;
#define FA_ISSUE(j) do { const int t0_ = (j) * 64; const int rb_ = (t0_ < LL || nk == CL) ? kbase + t0_ : cbase + (t0_ - LL); LAS unsigned char* st_ = lds + ((j) % RING) * STAGE; \
        const char* kb_ = (const char*)(Kh + (size_t)rb_ * a.kpitch); const char* vb_ = (const char*)(Vh + (size_t)rb_ * a.vpitch); \
        _Pragma("unroll") for (int i_ = 0; i_ < NKI; ++i_) __builtin_amdgcn_global_load_lds((const unsigned*)(kb_ + koff_[i_]), (LAS unsigned*)(st_ + i_ * 8192 + wid * 1024), 16, 0, 0); \
        _Pragma("unroll") for (int i_ = 0; i_ < NVI; ++i_) __builtin_amdgcn_global_load_lds((const unsigned*)(vb_ + voff_[i_]), (LAS unsigned*)(st_ + KTILE + i_ * 8192 + wid * 1024), 16, 0, 0); } while (0)
        bf16x8 qr[ND];
        { const bf16_t* Qw = a.Q + (size_t)(q0 + wid * 32 + r32) * a.qpitch + h * DQK + hi * 8;
#pragma unroll
          for (int d0 = 0; d0 < ND; ++d0) qr[d0] = *(const bf16x8*)(Qw + d0 * 16); }
        float m_reg = 0.f, l_reg = 0.f; f32x16 o[4], nm;
        float z0 = 0.f; asm volatile("" : "+v"(z0));
#pragma unroll
        for (int d = 0; d < 4; ++d)
#pragma unroll
            for (int r = 0; r < 16; ++r) o[d][r] = z0;
#pragma unroll
        for (int r = 0; r < 16; ++r) nm[r] = z0;
        FA_ISSUE(0); FA_ISSUE(1);
        if constexpr (DQK != 64) { if (NDMA == 5) asm volatile("s_waitcnt vmcnt(5)" ::: "memory"); else asm volatile("s_waitcnt vmcnt(3)" ::: "memory");
            __builtin_amdgcn_s_barrier(); asm volatile("" ::: "memory"); }
        auto tile = [&](const int j) __attribute__((always_inline)) {
            LAS unsigned char* Ks = lds + (j % RING) * STAGE;
            f32x16 p0 = nm, p1 = nm;
            constexpr int KD = (DQK == 64) ? 3 : 2;
            bf16x8 kb[KD][2];
            unsigned kae[4];
#pragma unroll
            for (int e = 0; e < 4; ++e) kae[e] = (unsigned)(uintptr_t)Ks + (unsigned)(krow * KROWB + (((2 * e + hi) ^ ((krow & 3) | (((krow >> 3) & 1) << 2))) << 4));
#define FA_LDK(d0_, s_) do { kb[s_][0] = lds_rd128i(kae[(d0_) & 3], ((d0_) >> 2) * 128); kb[s_][1] = lds_rd128i(kae[(d0_) & 3], 32 * KROWB + ((d0_) >> 2) * 128); } while (0)
#pragma unroll
            for (int d0 = 0; d0 < KD - 1; ++d0) FA_LDK(d0, d0);
#pragma unroll
            for (int d0 = 0; d0 < ND; ++d0) {
                if (d0 + KD - 1 < ND) FA_LDK(d0 + KD - 1, (d0 + KD - 1) % KD);
                const int ahead = (ND - 1 - d0) < (KD - 1) ? (ND - 1 - d0) : (KD - 1);
                if (ahead == 2) asm volatile("s_waitcnt lgkmcnt(4)" ::: "memory"); else if (ahead == 1) asm volatile("s_waitcnt lgkmcnt(2)" ::: "memory"); else asm volatile("s_waitcnt lgkmcnt(0)" ::: "memory");
                FA_SBAR();
                p0 = __builtin_amdgcn_mfma_f32_32x32x16_bf16(kb[d0 % KD][0], qr[d0], p0, 0, 0, 0);
                p1 = __builtin_amdgcn_mfma_f32_32x32x16_bf16(kb[d0 % KD][1], qr[d0], p1, 0, 0, 0);
                FA_SBAR(); }
#undef FA_LDK
            float alpha; partialSM(p0, p1, m_reg, nm, alpha, j == 0);
            if (__any(alpha < 1.f)) { if (hi == 0) wsc[32 + r32] = alpha; asm volatile("s_waitcnt lgkmcnt(0)" ::: "memory");
#pragma unroll
                for (int d = 0; d < 4; ++d)
#pragma unroll
                    for (int r = 0; r < 16; ++r) o[d][r] *= wsc[32 + crow(r, hi)]; }
            bf16x8 pa0, pa1, pa2, pa3; finishSM(p0, p1, alpha, l_reg, pa0, pa1, pa2, pa3); FA_SBAR();
            const unsigned vb = vb0 + (unsigned)((j % RING) * STAGE);
            pv_one<0>(o[0], vb, pa0, pa1, pa2, pa3); pv_one<1>(o[1], vb, pa0, pa1, pa2, pa3); pv_one<2>(o[2], vb, pa0, pa1, pa2, pa3); pv_one<3>(o[3], vb, pa0, pa1, pa2, pa3);
        };
        if constexpr (DQK == 64) {
            asm volatile("s_waitcnt vmcnt(0)" ::: "memory");
            __builtin_amdgcn_s_barrier(); asm volatile("" ::: "memory");
            for (int j = 0; j < NT; j += 2) {
                if (j + 2 < NT) { FA_ISSUE(j + 2); FA_ISSUE(j + 3); }
                tile(j); tile(j + 1);
                asm volatile("s_waitcnt vmcnt(0)" ::: "memory");
                asm volatile("s_waitcnt lgkmcnt(0)" ::: "memory");
                __builtin_amdgcn_s_barrier(); asm volatile("" ::: "memory");
            }
        } else
        for (int j = 0; j < NT; ++j) {
            if (j + 2 < NT) FA_ISSUE(j + 2);
            tile(j);
            if (j + 2 < NT) { if (NDMA == 5) asm volatile("s_waitcnt vmcnt(5)" ::: "memory"); else asm volatile("s_waitcnt vmcnt(3)" ::: "memory"); }
            else asm volatile("s_waitcnt vmcnt(0)" ::: "memory");
            asm volatile("s_waitcnt lgkmcnt(0)" ::: "memory");
            __builtin_amdgcn_s_barrier(); asm volatile("" ::: "memory");
        }
#undef FA_ISSUE
        if (hi == 0) wsc[r32] = l_reg; asm volatile("s_waitcnt lgkmcnt(0)" ::: "memory");
        bf16_t* Ow = a.O + (size_t)(q0 + wid * 32) * a.opitch + h * 128 + r32;
#pragma unroll
        for (int r = 0; r < 16; ++r) { const int orow = crow(r, hi); const float rl = __builtin_amdgcn_rcpf(wsc[orow]);
#pragma unroll
            for (int d0 = 0; d0 < 4; ++d0) Ow[(size_t)orow * a.opitch + d0 * 32] = (bf16_t)f2bf(o[d0][r] * rl); }
        asm volatile("s_waitcnt lgkmcnt(0)" ::: "memory");
    }
}
}


namespace ml {
typedef short s16x4 __attribute__((ext_vector_type(4)));
constexpr int QP = 528, VP = 80, CP = 528, PP = 144;
constexpr size_t WS_SCT = WS_CT, WS_WC = WS_CT + 4 * MiB, WS_DENI = WS_CT + 5 * MiB, WS_KW = WS_CT + 6 * MiB;
__device__ __forceinline__ s16x4 trr(unsigned addr) { s16x4 r; asm volatile("ds_read_b64_tr_b16 %0, %1" : "=&v"(r) : "v"(addr) : "memory"); return r; }
__device__ __forceinline__ unsigned cvtpk(float lo, float hi) { unsigned r; asm volatile("s_nop 0\n\tv_cvt_pk_bf16_f32 %0, %1, %2\n\ts_nop 1" : "=v"(r) : "v"(lo), "v"(hi)); return r; }
__device__ __forceinline__ unsigned cvtpk_n(float lo, float hi) { unsigned r; asm volatile("v_cvt_pk_bf16_f32 %0, %1, %2" : "=v"(r) : "v"(lo), "v"(hi)); return r; }
__device__ __forceinline__ int crow(int r, int hi) { return (r & 3) + 8 * (r >> 2) + 4 * hi; }
#define ML_BAR() do { asm volatile("s_waitcnt lgkmcnt(0)" ::: "memory"); __builtin_amdgcn_s_barrier(); asm volatile("" ::: "memory"); } while (0)
#define ML_TOK(c, i) (base + (dir ? (L - 1 - ((c) * 64 + (i))) : ((c) * 64 + (i))))
__device__ __forceinline__ float logsig(float g) { return fminf(g, 0.f) - __logf(1.0f + __expf(-fabsf(g))); }

__device__ __forceinline__ void scalars_wg(const P& p, const int l, const int chain, const int wave, const int lane, LAS float* sx) {
    const bool lat = chain >= 128; const int cc = lat ? chain - 128 : chain, b = cc >> 3, h = (cc >> 1) & 3, dir = cc & 1;
    const int L = lat ? LL : CL, base = lat ? NCTX + b * LL : b * CL, NC = L >> 6;
    const float* kva = (const float*)(p.ws + WS_KVA) + 576 + dir * 8 + h;
    const float bi = p.in[18][l * 16 + dir * 8 + h], bf = p.in[18][l * 16 + dir * 8 + 4 + h];
    float li_[8], lf_[8];
#pragma unroll
    for (int j = 0; j < 8; ++j) { const int c = wave + 8 * j; li_[j] = 0.f; lf_[j] = 0.f; if (c < NC) { const float* r_ = kva + (size_t)ML_TOK(c, lane) * KVAW; li_[j] = r_[0] + bi; lf_[j] = r_[4] + bf; } }
    float bb_[8], gg_[8], pm_[8];
#pragma unroll
    for (int j = 0; j < 8; ++j) { const int c = wave + 8 * j;
        float bc = logsig(lf_[j]);
#pragma unroll
        for (int o = 1; o < 64; o <<= 1) { const float t_ = __shfl_up(bc, o); if (lane >= o) bc += t_; }
        const float g = li_[j] - bc; float pm = g;
#pragma unroll
        for (int o = 1; o < 64; o <<= 1) { const float t_ = __shfl_up(pm, o); if (lane >= o) pm = fmaxf(pm, t_); }
        bb_[j] = bc; gg_[j] = g; pm_[j] = pm;
        if (lane == 63) { sx[c] = (c < NC) ? bc : 0.f; sx[64 + c] = (c < NC) ? bc + pm : -1e30f; } }
    __syncthreads();
    float al = sx[lane], be = sx[64 + lane];
#pragma unroll
    for (int o = 1; o < 64; o <<= 1) { const float ea = __shfl_up(al, o), eb = __shfl_up(be, o); if (lane >= o) { be = fmaxf(eb + al, be); al = ea + al; } }
    float m0 = 0.f; if (lat) m0 = p.in[8][(size_t)((b * 2 + l) * 2 + dir) * 4 + h];
    const float pa = __shfl_up(al, 1), pb = __shfl_up(be, 1);
    const float mst_all = lane == 0 ? m0 : fmaxf(m0 + pa, pb);
    if (!lat && wave == 0 && lane == NC - 1) p.out[O_MM + ((b * 2 + l) * 2 + dir) * 4 + h] = fmaxf(m0 + al, be);
    f32x4* sct = (f32x4*)(p.ws + WS_SCT);
#pragma unroll
    for (int j = 0; j < 8; ++j) { const int c = wave + 8 * j;
        const float m_st = __shfl(mst_all, c & 63);
        if (c < NC) { const float mxl = fmaxf(m_st, __shfl(pm_[j], 63)), mx = fmaxf(m_st, pm_[j]);
            sct[((size_t)ML_TOK(c, lane) * 2 + dir) * 4 + h] = (f32x4){__expf(pm_[j] - mx), __expf(m_st - mx), __expf(-(bb_[j] + mx)), __expf(gg_[j] - mxl)};
            if (lane == 0) ((float*)(p.ws + WS_WC))[chain * 64 + c] = __expf(m_st - mxl); } }
    __syncthreads();
}

constexpr int B_Q = 0, B_K = 33792, B_V = 67584, B_P = 101376, B_S = 110592, B_END = 112640;
__device__ __forceinline__ void intra_phase(LAS unsigned char* lds, const P& p, const int l, const int tid) {
    const int wid = __builtin_amdgcn_readfirstlane(tid >> 6), lane = tid & 63, r32 = lane & 31, hi = lane >> 5;
    const bf16_t* MQ_ = (const bf16_t*)(p.ws + WS_MLQ); const bf16_t* MK_ = (const bf16_t*)(p.ws + WS_MLK); const bf16_t* MV_ = (const bf16_t*)(p.ws + WS_MLV);
    LAS float* sg = (LAS float*)(lds + B_S); LAS float* spm = sg + 64; LAS float* sws = sg + 128; LAS float* sd0 = sg + 192; LAS float* sd1 = sg + 256;
    const unsigned ldsb = (unsigned)(uintptr_t)lds;
    const int tq = (lane & 15) >> 2, tp = lane & 3, tc0 = 16 * ((lane >> 4) & 1) + 4 * tp;
    u32x4 q4[4], k4[4], v4[4]; float gli = 0.f, glf = 0.f, gws = 0.f;
#define B_DECODE(uu) const bool lat = (uu) < 2048; const int chain = lat ? 128 + ((uu) >> 6) : ((uu) - 2048) >> 2, c = lat ? ((uu) & 63) : (((uu) - 2048) & 3); \
        const int cc = lat ? chain - 128 : chain, b = cc >> 3, h = (cc >> 1) & 3, dir = cc & 1; const int L = lat ? LL : CL, base = lat ? NCTX + b * LL : b * CL;
#define B_LOAD(uu) do { B_DECODE(uu) (void)chain; \
        _Pragma("unroll") for (int i = 0; i < 4; ++i) { const int ch = tid + 512 * i, row = ch >> 5, c16 = ch & 31; const size_t g_ = (size_t)ML_TOK(c, row) * 1024 + h * 256 + c16 * 8; \
            q4[i] = *(const u32x4*)(MQ_ + g_); k4[i] = *(const u32x4*)(MK_ + g_); v4[i] = *(const u32x4*)(MV_ + g_); } \
        if (wid == 7) { const int row = ML_TOK(c, lane); const float* r_ = (const float*)(p.ws + WS_KVA) + (size_t)row * KVAW + 576 + dir * 8 + h; \
            gli = r_[0] + p.in[18][l * 16 + dir * 8 + h]; glf = r_[4] + p.in[18][l * 16 + dir * 8 + 4 + h]; gws = ((const f32x4*)(p.ws + WS_SCT))[((size_t)row * 2 + dir) * 4 + h][3]; } } while (0)
    if ((int)blockIdx.x < 2560) B_LOAD((int)blockIdx.x);
    for (int u = blockIdx.x; u < 2560; u += gridDim.x) {
        B_DECODE(u)
        bf16_t* Hout = (bf16_t*)(p.ws + (dir ? WS_HB : WS_HF));
#pragma unroll
        for (int i = 0; i < 4; ++i) { const int ch = tid + 512 * i, row = ch >> 5, c16 = ch & 31;
            *(LAS u32x4*)(lds + B_Q + row * QP + c16 * 16) = q4[i]; *(LAS u32x4*)(lds + B_K + row * QP + c16 * 16) = k4[i]; *(LAS u32x4*)(lds + B_V + row * QP + c16 * 16) = v4[i]; }
        if (wid == 7) {
            float bc = logsig(glf);
#pragma unroll
            for (int o = 1; o < 64; o <<= 1) { const float t_ = __shfl_up(bc, o); if (lane >= o) bc += t_; }
            const float g = gli - bc; float pm = g;
#pragma unroll
            for (int o = 1; o < 64; o <<= 1) { const float t_ = __shfl_up(pm, o); if (lane >= o) pm = fmaxf(pm, t_); }
            sg[lane] = g; spm[lane] = pm; sws[lane] = gws;
        }
        if (u + (int)gridDim.x < 2560) B_LOAD(u + (int)gridDim.x);
        ML_BAR();
        if (wid < 3) {
            const int tb = wid == 0 ? 0 : 1, sb = wid == 2 ? 1 : 0, t = tb * 32 + r32;
            f32x16 p0; { float z0 = 0.f; asm volatile("" : "+v"(z0));
#pragma unroll
              for (int r = 0; r < 16; ++r) p0[r] = z0; }
#pragma unroll 4
            for (int ks = 0; ks < 16; ++ks) { const int cb = (ks * 16 + hi * 8) * 2;
                const bf16x8 qf = *(const LAS bf16x8*)(lds + B_Q + t * QP + cb), kf = *(const LAS bf16x8*)(lds + B_K + (sb * 32 + r32) * QP + cb);
                p0 = __builtin_amdgcn_mfma_f32_32x32x16_bf16(kf, qf, p0, 0, 0, 0); }
            const float mpm = -spm[t]; float dsum = 0.f;
#pragma unroll
            for (int r = 0; r < 16; ++r) { const int s = sb * 32 + crow(r, hi); const float w = (s <= t) ? __expf(sg[s] + mpm) : 0.f; p0[r] *= w; dsum += p0[r]; }
            { auto rr = __builtin_amdgcn_permlane32_swap(__float_as_uint(dsum), __float_as_uint(dsum), false, false); dsum = __uint_as_float(rr[0]) + __uint_as_float(rr[1]); }
            if (hi == 0) { if (sb == 0) sd0[t] = dsum; else sd1[r32] = dsum; }
            __builtin_amdgcn_sched_barrier(0); asm volatile("s_nop 1");
#pragma unroll
            for (int i = 0; i < 4; ++i) { u32x2 w; w.x = cvtpk_n(p0[4 * i], p0[4 * i + 1]); w.y = cvtpk_n(p0[4 * i + 2], p0[4 * i + 3]);
                *(LAS u32x2*)(lds + B_P + t * PP + (sb * 32 + 8 * i + 4 * hi) * 2) = w; }
        } else if (wid >= 4) {
            const int k = tid - 256; float acc = 0.f;
#pragma unroll 8
            for (int s = 0; s < 64; ++s) acc += sws[s] * bf2f(*(const LAS unsigned short*)(lds + B_K + s * QP + k * 2));
            ((float*)(p.ws + WS_KW))[((size_t)chain * 64 + c) * 256 + k] = acc;
        }
        ML_BAR();
        {
            f32x16 h0, h1; { float z0 = 0.f; asm volatile("" : "+v"(z0));
#pragma unroll
              for (int r = 0; r < 16; ++r) { h0[r] = z0; h1[r] = z0; } }
#pragma unroll
            for (int ks = 0; ks < 4; ++ks) {
                const unsigned va = ldsb + B_V + (16 * ks + 8 * hi + tq) * QP + (wid * 32 + tc0) * 2;
                const s16x4 lo = trr(va), hh = trr(va + 4 * QP);
                const bf16x8 a1 = *(const LAS bf16x8*)(lds + B_P + (32 + r32) * PP + (ks * 16 + hi * 8) * 2);
                bf16x8 a0 = a1; if (ks < 2) a0 = *(const LAS bf16x8*)(lds + B_P + r32 * PP + (ks * 16 + hi * 8) * 2);
                asm volatile("s_waitcnt lgkmcnt(0)" ::: "memory"); __builtin_amdgcn_sched_barrier(0);
                const bf16x8 vf = (bf16x8){lo[0], lo[1], lo[2], lo[3], hh[0], hh[1], hh[2], hh[3]};
                if (ks < 2) h0 = __builtin_amdgcn_mfma_f32_32x32x16_bf16(a0, vf, h0, 0, 0, 0);
                h1 = __builtin_amdgcn_mfma_f32_32x32x16_bf16(a1, vf, h1, 0, 0, 0); }
#pragma unroll
            for (int r = 0; r < 16; ++r) { const int t0 = crow(r, hi);
                Hout[(size_t)ML_TOK(c, t0) * 1024 + h * 256 + wid * 32 + r32] = (bf16_t)f2bf(h0[r]); Hout[(size_t)ML_TOK(c, 32 + t0) * 1024 + h * 256 + wid * 32 + r32] = (bf16_t)f2bf(h1[r]); }
            if (tid < 64) ((float*)(p.ws + WS_DENI))[((size_t)ML_TOK(c, tid) * 2 + dir) * 4 + h] = sd0[tid] + (tid >= 32 ? sd1[tid - 32] : 0.f);
        }
        ML_BAR();
    }
}

constexpr int L_Q = 0, L_K = 33792, L_V = 67584, L_CT = 72704, L_SC = 89600, L_NQ = 95744, L_N = 96256, L_PART = 98304, L_END = 114688;
__device__ __forceinline__ void seq_phase(LAS unsigned char* lds, const P& p, const int l, const int tid) {
    const int wid = __builtin_amdgcn_readfirstlane(tid >> 6), lane = tid & 63, r32 = lane & 31, hi = lane >> 5;
    const bf16_t* MQ_ = (const bf16_t*)(p.ws + WS_MLQ); const bf16_t* MK_ = (const bf16_t*)(p.ws + WS_MLK); const bf16_t* MV_ = (const bf16_t*)(p.ws + WS_MLV);
    const unsigned ldsb = (unsigned)(uintptr_t)lds;
    const int tq = (lane & 15) >> 2, tp = lane & 3, tc0 = 16 * ((lane >> 4) & 1) + 4 * tp;
    for (int u = xcd_slot(); u < 1280; u += gridDim.x) {
        const bool lat = u < 256; const int uu = lat ? u : u - 256, cc = uu >> 3, sl = uu & 7, chain = lat ? 128 + cc : cc;
        const int b = cc >> 3, h = (cc >> 1) & 3, dir = cc & 1;
        const int L = lat ? LL : CL, base = lat ? NCTX + b * LL : b * CL, NC = L >> 6;
        const int colq = h * 256, colv = h * 256 + sl * 32;
        bf16_t* Hout = (bf16_t*)(p.ws + (dir ? WS_HB : WS_HF));
        f32x16 ct, ia;
        { float z0 = 0.f; asm volatile("" : "+v"(z0));
#pragma unroll
          for (int r = 0; r < 16; ++r) { ct[r] = z0; ia[r] = z0; } }
        LAS float* nb0 = (LAS float*)(lds + L_N); LAS float* nb1 = nb0 + 256;
        if (lat) {
            const size_t so = (size_t)((b * 2 + l) * 2 + dir) * 4 + h;
            const float* c0 = p.in[6] + so * 65536 + (size_t)(sl * 32 + r32) * 256 + wid * 32 + 4 * hi;
#pragma unroll
            for (int i = 0; i < 4; ++i) { const f32x4 v4 = *(const f32x4*)(c0 + 8 * i); ct[4 * i] = v4[0]; ct[4 * i + 1] = v4[1]; ct[4 * i + 2] = v4[2]; ct[4 * i + 3] = v4[3]; }
            if (tid < 256) nb0[tid] = p.in[7][so * 256 + tid];
        } else if (tid < 256) nb0[tid] = 0.f;
        u32x4 pq[4], pk[4], pv; pv = (u32x4){0u, 0u, 0u, 0u}; f32x4 psc = {0.f, 0.f, 0.f, 0.f}; float pdi = 0.f, pwc = 0.f, pkw = 0.f; unsigned hpre[16];
#pragma unroll
        for (int r = 0; r < 16; ++r) hpre[r] = 0u;
#define ML_HPRE(cc_) do { _Pragma("unroll") for (int rr = 0; rr < 8; ++rr) hpre[rr] = Hout[(size_t)ML_TOK(cc_, (wid & 1) * 32 + crow(8 * (wid >> 1) + rr, hi)) * 1024 + colv + r32]; } while (0)
#define ML_LOAD(c) do { _Pragma("unroll") for (int i_ = 0; i_ < 4; ++i_) { const int ch_ = tid + 512 * i_, row_ = ch_ >> 5, c16_ = ch_ & 31; const size_t g_ = (size_t)ML_TOK(c, row_) * 1024 + colq + c16_ * 8; \
            pq[i_] = *(const u32x4*)(MQ_ + g_); pk[i_] = *(const u32x4*)(MK_ + g_); } \
        if (tid < 256) { const int row_ = tid >> 2, c16_ = tid & 3; pv = *(const u32x4*)(MV_ + (size_t)ML_TOK(c, row_) * 1024 + colv + c16_ * 8); } \
        else pkw = ((const float*)(p.ws + WS_KW))[((size_t)chain * 64 + (c)) * 256 + tid - 256]; \
        if (wid == 0) { const size_t ix_ = ((size_t)ML_TOK(c, lane) * 2 + dir) * 4 + h; psc = ((const f32x4*)(p.ws + WS_SCT))[ix_]; pdi = ((const float*)(p.ws + WS_DENI))[ix_]; pwc = ((const float*)(p.ws + WS_WC))[chain * 64 + (c)]; } } while (0)
#define ML_WRITE(cc_) do { _Pragma("unroll") for (int i_ = 0; i_ < 4; ++i_) { const int ch_ = tid + 512 * i_, row_ = ch_ >> 5, c16_ = ch_ & 31; \
            *(LAS u32x4*)(lds + L_Q + row_ * QP + c16_ * 16) = pq[i_]; *(LAS u32x4*)(lds + L_K + row_ * QP + c16_ * 16) = pk[i_]; } \
        if (tid < 256) { const int row_ = tid >> 2, c16_ = tid & 3; *(LAS u32x4*)(lds + L_V + row_ * VP + c16_ * 16) = pv; } \
        if (wid == 0) { LAS float* S_ = (LAS float*)(lds + L_SC + ((cc_) % 3) * 2048); S_[lane] = psc[0]; S_[64 + lane] = psc[1]; S_[128 + lane] = psc[2]; S_[192 + lane] = psc[3]; S_[256 + lane] = pdi; if (lane == 0) S_[320] = pwc; } } while (0)
#define ML_CTB() do { __builtin_amdgcn_sched_barrier(0); asm volatile("s_nop 7\n\ts_nop 7"); _Pragma("unroll") for (int i_ = 0; i_ < 4; ++i_) { u32x2 w_; w_.x = cvtpk_n(ct[4 * i_], ct[4 * i_ + 1]); w_.y = cvtpk_n(ct[4 * i_ + 2], ct[4 * i_ + 3]); \
            *(LAS u32x2*)(lds + L_CT + r32 * CP + (wid * 32 + 8 * i_ + 4 * hi) * 2) = w_; } } while (0)
#define ML_COMB(cc_) do { const int tb_ = wid & 1, kh_ = wid >> 1; const LAS float* S_ = (const LAS float*)(lds + L_SC + ((cc_) % 3) * 2048); const LAS float* NQ_ = (const LAS float*)(lds + L_NQ + ((cc_) & 1) * 256); \
            const LAS float* PT_ = (const LAS float*)(lds + L_PART + (((cc_) & 1) * 4 + (wid ^ 2)) * 2048); \
            _Pragma("unroll") for (int rr = 0; rr < 8; ++rr) { const int r = 8 * kh_ + rr, tt = tb_ * 32 + crow(r, hi); bf16_t* hp_ = Hout + (size_t)ML_TOK(cc_, tt) * 1024 + colv + r32; \
                const float rr_ = S_[tt], wi = S_[64 + tt], den = rr_ * S_[256 + tt] + wi * NQ_[tt], it_ = (kh_ ? ia[8 + rr] : ia[rr]) + PT_[rr * 64 + lane]; \
                *hp_ = (bf16_t)f2bf((rr_ * bf2f(hpre[rr]) + wi * it_) / fmaxf(fabsf(den), S_[128 + tt])); } } while (0)
        float kwc = 0.f;
        ML_LOAD(0); ML_WRITE(0); ML_CTB(); kwc = pkw;
        int nsel = 0;
        for (int c = 0; c < NC; ++c) {
            ML_BAR();
            LAS float* ncur = nsel ? nb1 : nb0; LAS float* nnxt = nsel ? nb0 : nb1;
            const LAS float* SC = (const LAS float*)(lds + L_SC + (c % 3) * 2048);
            if (c + 1 < NC) ML_LOAD(c + 1);
            const float w_c = SC[320];
            if (wid < 4) {
                if (c > 0) ML_COMB(c - 1);
                ML_HPRE(c);
                const int tb = wid & 1, kh = wid >> 1;
                { float z0 = 0.f; asm volatile("" : "+v"(z0));
#pragma unroll
                  for (int r = 0; r < 16; ++r) ia[r] = z0; }
#pragma unroll
                for (int k1 = 0; k1 < 8; ++k1) { const int cb0 = ((kh * 8 + k1) * 16 + hi * 8) * 2;
                    const bf16x8 qf0 = *(const LAS bf16x8*)(lds + L_Q + (tb * 32 + r32) * QP + cb0), cf0 = *(const LAS bf16x8*)(lds + L_CT + r32 * CP + cb0);
                    ia = __builtin_amdgcn_mfma_f32_32x32x16_bf16(qf0, cf0, ia, 0, 0, 0); }
                { LAS float* PW = (LAS float*)(lds + L_PART + ((c & 1) * 4 + wid) * 2048);
#pragma unroll
                  for (int rr = 0; rr < 8; ++rr) PW[rr * 64 + lane] = kh ? ia[rr] : ia[8 + rr]; }
            } else if (wid >= 4) {
                const int j = tid - 256, t = j >> 2, part = j & 3;
                float acc = 0.f;
#pragma unroll
                for (int i = 0; i < 8; ++i) { const u32x4 qv = *(const LAS u32x4*)(lds + L_Q + t * QP + (part * 64 + i * 8) * 2);
                    const f32x4 n0 = *(const LAS f32x4*)(ncur + part * 64 + i * 8), n1 = *(const LAS f32x4*)(ncur + part * 64 + i * 8 + 4);
                    acc += bf2f(qv[0]) * n0[0] + bf2f(qv[0] >> 16) * n0[1] + bf2f(qv[1]) * n0[2] + bf2f(qv[1] >> 16) * n0[3] + bf2f(qv[2]) * n1[0] + bf2f(qv[2] >> 16) * n1[1] + bf2f(qv[3]) * n1[2] + bf2f(qv[3] >> 16) * n1[3]; }
                acc += __shfl_xor(acc, 1); acc += __shfl_xor(acc, 2);
                if (part == 0) ((LAS float*)(lds + L_NQ + (c & 1) * 256))[t] = acc;
                nnxt[j] = w_c * ncur[j] + kwc;
            }
            { f32x16 cc = ct;
#pragma unroll
              for (int r = 0; r < 16; ++r) cc[r] *= w_c;
#pragma unroll
              for (int ks = 0; ks < 4; ++ks) {
                const unsigned ka = ldsb + L_K + (16 * ks + 8 * hi + tq) * QP + (wid * 32 + tc0) * 2, va = ldsb + L_V + (16 * ks + 8 * hi + tq) * VP + tc0 * 2;
                const s16x4 kl = trr(ka), kh = trr(ka + 4 * QP), vl = trr(va), vh = trr(va + 4 * VP);
                const f32x4 wa = *(const LAS f32x4*)(SC + 192 + 16 * ks + 8 * hi), wb = *(const LAS f32x4*)(SC + 192 + 16 * ks + 8 * hi + 4);
                asm volatile("s_waitcnt lgkmcnt(0)" ::: "memory"); __builtin_amdgcn_sched_barrier(0);
                u32x4 vw; vw.x = cvtpk_n(bf2f((unsigned short)vl[0]) * wa[0], bf2f((unsigned short)vl[1]) * wa[1]); vw.y = cvtpk_n(bf2f((unsigned short)vl[2]) * wa[2], bf2f((unsigned short)vl[3]) * wa[3]);
                vw.z = cvtpk_n(bf2f((unsigned short)vh[0]) * wb[0], bf2f((unsigned short)vh[1]) * wb[1]); vw.w = cvtpk_n(bf2f((unsigned short)vh[2]) * wb[2], bf2f((unsigned short)vh[3]) * wb[3]);
                asm volatile("s_nop 1" : "+v"(vw));
                const bf16x8 kf = (bf16x8){kl[0], kl[1], kl[2], kl[3], kh[0], kh[1], kh[2], kh[3]};
                cc = __builtin_amdgcn_mfma_f32_32x32x16_bf16(kf, *reinterpret_cast<bf16x8*>(&vw), cc, 0, 0, 0); }
              ct = cc; }
            ML_BAR();
            if (c + 1 < NC) { ML_WRITE(c + 1); kwc = pkw; }
            ML_CTB();
            nsel ^= 1;
        }
        if (wid < 4) ML_COMB(NC - 1);
        if (!lat) {
            const size_t so = (size_t)((b * 2 + l) * 2 + dir) * 4 + h;
            float* oc = p.out + O_MC + so * 65536 + (size_t)(sl * 32 + r32) * 256 + wid * 32 + 4 * hi;
#pragma unroll
            for (int i = 0; i < 4; ++i) *(f32x4*)(oc + 8 * i) = (f32x4){ct[4 * i], ct[4 * i + 1], ct[4 * i + 2], ct[4 * i + 3]};
            if (sl == 0) { LAS float* nfin = nsel ? nb1 : nb0; if (tid < 256) p.out[O_MN + so * 256 + tid] = nfin[tid]; }
        }
        ML_BAR();
#undef ML_LOAD
#undef ML_WRITE
#undef ML_CTB
#undef ML_COMB
#undef ML_HPRE
    }
}
#undef ML_BAR
#undef ML_TOK
#undef B_LOAD
#undef B_DECODE
}


namespace s5 {
typedef short s16x4 __attribute__((ext_vector_type(4)));
__device__ __forceinline__ s16x4 trr(unsigned addr) { s16x4 r; asm volatile("ds_read_b64_tr_b16 %0, %1" : "=&v"(r) : "v"(addr) : "memory"); return r; }
__device__ __forceinline__ unsigned cvtpk(float lo, float hi) { unsigned r; asm volatile("s_nop 0\n\tv_cvt_pk_bf16_f32 %0, %1, %2\n\ts_nop 1" : "=v"(r) : "v"(lo), "v"(hi)); return r; }
__device__ __forceinline__ unsigned cvtpk_n(float lo, float hi) { unsigned r; asm volatile("v_cvt_pk_bf16_f32 %0, %1, %2" : "=v"(r) : "v"(lo), "v"(hi)); return r; }
template <bool FULL>
__device__ __forceinline__ void scan_seg(const P& p, const int l, LAS unsigned char* T, const int g, const int dir, const bool lat, const int b0, const int lane, const int blk0, const int nblk,
                                         const float (&ar)[2], const float (&ai)[2], const bf16x8 (&bb)[4], float (&sr)[2], float (&si)[2]) {
    const int r32 = lane & 31, hh = lane >> 5;
    const int L = lat ? LL : CL;
    const int baseA = lat ? NCTX + b0 * LL : b0 * CL, baseB = baseA + L;
    const size_t pg = (size_t)(l * 2 + dir) * 64 + g;
    bf16x8 cm[8];
    if (FULL) {
#pragma unroll
        for (int ks = 0; ks < 8; ++ks) { u32x4 w = {0u, 0u, 0u, 0u};
            if (r32 < 16) { const int k0 = 16 * ks + 8 * hh; const float* src = (k0 < 64 ? p.in[27] : p.in[28]) + (pg * 16 + r32) * 64 + (k0 & 63); const float sg = k0 < 64 ? 1.f : -1.f;
#pragma unroll
                for (int j = 0; j < 4; ++j) w[j] = cvtpk(sg * src[2 * j], sg * src[2 * j + 1]); }
            cm[ks] = *reinterpret_cast<bf16x8*>(&w); } }
    const int urow_tok = 4 * (r32 >> 3) + (r32 & 3), urow_base = ((r32 >> 2) & 1) ? baseB : baseA;
    const bf16_t* U = (const bf16_t*)(p.ws + WS_S5U) + g * 16 + 8 * hh;
    bf16_t* Yo2 = (bf16_t*)(p.ws + (dir ? WS_YS5B : WS_YS5F)) + g * 16;
#define S5_POS(n, j) (dir ? (L - 1 - ((n) * 16 + (j))) : ((n) * 16 + (j)))
    bf16x8 ucur[4], unxt[4];
#pragma unroll
    for (int i = 0; i < 4; ++i) { ucur[i] = *(const bf16x8*)(U + (size_t)(urow_base + S5_POS(blk0 + i, urow_tok)) * 1024); unxt[i] = ucur[i]; }
    const unsigned tb = (unsigned)(uintptr_t)T;
    const int tq = (lane & 15) >> 2, tp = lane & 3, tc0 = 16 * ((lane >> 4) & 1) + 4 * tp;
    for (int n4 = blk0; n4 < blk0 + nblk; n4 += 4) {
        if (n4 + 4 < blk0 + nblk) {
#pragma unroll
            for (int i = 0; i < 4; ++i) unxt[i] = *(const bf16x8*)(U + (size_t)(urow_base + S5_POS(n4 + 4 + i, urow_tok)) * 1024); }
#pragma unroll
      for (int i4 = 0; i4 < 4; ++i4) { const int n = n4 + i4; const bf16x8 ucur1 = ucur[i4];
        f32x16 acc[4]; { float z0 = 0.f; asm volatile("" : "+v"(z0));
#pragma unroll
          for (int q = 0; q < 4; ++q)
#pragma unroll
              for (int r = 0; r < 16; ++r) acc[q][r] = z0; }
#pragma unroll
        for (int q = 0; q < 4; ++q) acc[q] = __builtin_amdgcn_mfma_f32_32x32x16_bf16(ucur1, bb[q], acc[q], 0, 0, 0);
#pragma unroll
        for (int pb = 0; pb < 2; ++pb) { float xr = sr[pb], xi = si[pb]; const float a_r = ar[pb], a_i = ai[pb];
#pragma unroll
            for (int r = 0; r < 16; ++r) { const float nr_ = a_r * xr - a_i * xi + acc[pb][r], ni_ = a_r * xi + a_i * xr + acc[2 + pb][r]; xr = nr_; xi = ni_; acc[pb][r] = nr_; acc[2 + pb][r] = ni_; }
            sr[pb] = xr; si[pb] = xi; }
        if (FULL) {
        __builtin_amdgcn_sched_barrier(0); asm volatile("s_nop 7\n\ts_nop 7");
#pragma unroll
        for (int q = 0; q < 4; ++q)
#pragma unroll
            for (int a4 = 0; a4 < 4; ++a4) { u32x2 w; w.x = cvtpk_n(acc[q][4 * a4], acc[q][4 * a4 + 1]); w.y = cvtpk_n(acc[q][4 * a4 + 2], acc[q][4 * a4 + 3]);
                *(LAS u32x2*)(T + (q * 32 + r32) * 64 + 16 * a4 + 8 * hh) = w; }
        f32x16 y, y2; { float z0 = 0.f; asm volatile("" : "+v"(z0));
#pragma unroll
          for (int r = 0; r < 16; ++r) { y[r] = z0; y2[r] = z0; } }
        { s16x4 lo_[8], hi_[8];
#pragma unroll
          for (int ks = 0; ks < 8; ++ks) { const unsigned ta = tb + (16 * ks + 8 * hh + tq) * 64 + tc0 * 2; lo_[ks] = trr(ta); hi_[ks] = trr(ta + 4 * 64); }
          asm volatile("s_waitcnt lgkmcnt(0)" ::: "memory"); __builtin_amdgcn_sched_barrier(0);
#pragma unroll
          for (int ks = 0; ks < 8; ks += 2) {
            const bf16x8 af0 = (bf16x8){lo_[ks][0], lo_[ks][1], lo_[ks][2], lo_[ks][3], hi_[ks][0], hi_[ks][1], hi_[ks][2], hi_[ks][3]};
            const bf16x8 af1 = (bf16x8){lo_[ks + 1][0], lo_[ks + 1][1], lo_[ks + 1][2], lo_[ks + 1][3], hi_[ks + 1][0], hi_[ks + 1][1], hi_[ks + 1][2], hi_[ks + 1][3]};
            y = __builtin_amdgcn_mfma_f32_32x32x16_bf16(cm[ks], af0, y, 0, 0, 0);
            y2 = __builtin_amdgcn_mfma_f32_32x32x16_bf16(cm[ks + 1], af1, y2, 0, 0, 0); }
#pragma unroll
          for (int r = 0; r < 16; ++r) y[r] += y2[r]; }
        {
          bf16_t* yo = Yo2 + (size_t)(urow_base + S5_POS(n, urow_tok)) * 1024 + 4 * hh;
          u32x2 w0, w1; w0.x = cvtpk(y[0], y[1]); w0.y = cvtpk(y[2], y[3]); w1.x = cvtpk(y[4], y[5]); w1.y = cvtpk(y[6], y[7]);
          *(u32x2*)yo = w0; *(u32x2*)(yo + 8) = w1; }
        }
      }
#pragma unroll
        for (int i = 0; i < 4; ++i) ucur[i] = unxt[i];
    }
#undef S5_POS
}
__device__ __forceinline__ void params(const P& p, const int l, const int g, const int dir, const int lane, float (&ar)[2], float (&ai)[2], bf16x8 (&bb)[4]) {
    const int r32 = lane & 31, hh = lane >> 5; const size_t pg = (size_t)(l * 2 + dir) * 64 + g;
    const float dt = __expf(p.in[24][pg]);
#pragma unroll
    for (int pb = 0; pb < 2; ++pb) { const int pp = pb * 32 + r32;
        const float lr = fminf(p.in[22][pg * 64 + pp], -1e-4f), li = p.in[23][pg * 64 + pp];
        const float mag = __expf(dt * lr); float sn, cs; sincos_small(dt * li, sn, cs);
        const float a_r = mag * cs, a_i = mag * sn, den = lr * lr + li * li, nr = a_r - 1.0f, ni = a_i, qr = (nr * lr + ni * li) / den, qi = (ni * lr - nr * li) / den;
        ar[pb] = a_r; ai[pb] = a_i;
        const float* br = p.in[25] + (pg * 64 + pp) * 16 + 8 * hh; const float* bi = p.in[26] + (pg * 64 + pp) * 16 + 8 * hh;
        u32x4 wr, wi;
#pragma unroll
        for (int j = 0; j < 4; ++j) { const float r0 = qr * br[2 * j] - qi * bi[2 * j], r1 = qr * br[2 * j + 1] - qi * bi[2 * j + 1], i0 = qr * bi[2 * j] + qi * br[2 * j], i1 = qr * bi[2 * j + 1] + qi * br[2 * j + 1];
            wr[j] = cvtpk(r0, r1); wi[j] = cvtpk(i0, i1); }
        bb[pb] = *reinterpret_cast<bf16x8*>(&wr); bb[2 + pb] = *reinterpret_cast<bf16x8*>(&wi); }
}
__device__ __forceinline__ void ctx_unit(const P& p, const int l, LAS unsigned char* T, const int u, const int lane) {
    const int dir = u & 1, g = (u >> 1) & 63, b0 = 2 * (u >> 7), r32 = lane & 31, hh = lane >> 5;
    float ar[2], ai[2]; bf16x8 bb[4]; params(p, l, g, dir, lane, ar, ai, bb);
    float sr[2] = {0.f, 0.f}, si[2] = {0.f, 0.f};
    scan_seg<true>(p, l, T, g, dir, false, b0, lane, 0, CL / 16, ar, ai, bb, sr, si);
#pragma unroll
    for (int pb = 0; pb < 2; ++pb) { const size_t so = ((size_t)(((b0 + hh) * 2 + l) * 2 + dir) * 64 + g) * 64 + pb * 32 + r32; p.out[O_SR + so] = sr[pb]; p.out[O_SI + so] = si[pb]; }
}
__device__ __forceinline__ void lat_unit(const P& p, const int l, LAS unsigned char* lds, const int u, const int wave, const int lane) {
    const int dir = u & 1, g = (u >> 1) & 63, b0 = 2 * (u >> 7), r32 = lane & 31, hh = lane >> 5;
    LAS unsigned char* T = lds + wave * 8192; LAS float* X = (LAS float*)(lds + 65536);
    float ar[2], ai[2]; bf16x8 bb[4]; params(p, l, g, dir, lane, ar, ai, bb);
    float sr[2] = {0.f, 0.f}, si[2] = {0.f, 0.f};
    if (wave == 0) {
#pragma unroll
        for (int pb = 0; pb < 2; ++pb) { const size_t so = ((size_t)(((b0 + hh) * 2 + l) * 2 + dir) * 64 + g) * 64 + pb * 32 + r32; sr[pb] = p.in[9][so]; si[pb] = p.in[10][so]; } }
    const float s0r[2] = {sr[0], sr[1]}, s0i[2] = {si[0], si[1]};
    constexpr int SEGB = LL / 16 / 8;
    if (wave < 7) scan_seg<false>(p, l, T, g, dir, true, b0, lane, wave * SEGB, SEGB, ar, ai, bb, sr, si);
#pragma unroll
    for (int pb = 0; pb < 2; ++pb) { X[(wave * 4 + pb) * 64 + lane] = sr[pb]; X[(wave * 4 + 2 + pb) * 64 + lane] = si[pb]; }
    __syncthreads();
    float pr[2], pi[2];
#pragma unroll
    for (int pb = 0; pb < 2; ++pb) { float xr = ar[pb], xi = ai[pb];
#pragma unroll
        for (int k = 0; k < 9; ++k) { const float nr = xr * xr - xi * xi, ni = 2.f * xr * xi; xr = nr; xi = ni; }
        pr[pb] = xr; pi[pb] = xi; }
    float cr[2], ci[2];
    if (wave == 0) { cr[0] = s0r[0]; cr[1] = s0r[1]; ci[0] = s0i[0]; ci[1] = s0i[1]; }
    else {
#pragma unroll
        for (int pb = 0; pb < 2; ++pb) { float xr = X[(0 * 4 + pb) * 64 + lane], xi = X[(0 * 4 + 2 + pb) * 64 + lane];
            for (int j = 1; j < wave; ++j) { const float er = X[(j * 4 + pb) * 64 + lane], ei = X[(j * 4 + 2 + pb) * 64 + lane];
                const float nr = pr[pb] * xr - pi[pb] * xi + er, ni = pr[pb] * xi + pi[pb] * xr + ei; xr = nr; xi = ni; }
            cr[pb] = xr; ci[pb] = xi; } }
    scan_seg<true>(p, l, T, g, dir, true, b0, lane, wave * SEGB, SEGB, ar, ai, bb, cr, ci);
    __syncthreads();
}
__device__ __forceinline__ void combine_row(const P& p, const int l, const int r, const int lane) {
    const bf16_t* yf = (const bf16_t*)(p.ws + WS_YS5F) + (size_t)r * 1024; const bf16_t* yb = (const bf16_t*)(p.ws + WS_YS5B) + (size_t)r * 1024; const bf16_t* uu = (const bf16_t*)(p.ws + WS_S5U) + (size_t)r * 1024;
    bf16_t* o = (bf16_t*)(p.ws + WS_HB) + (size_t)r * 1024; const float* dv = p.in[29] + l * 1024;
#pragma unroll
    for (int j = 0; j < 2; ++j) { const int c = j * 512 + lane * 8; float a[8], b[8], u[8];
        { const u32x4 w = *(const u32x4*)(yf + c);
#pragma unroll
          for (int i = 0; i < 4; ++i) { a[2 * i] = bf2f(w[i]); a[2 * i + 1] = bf2f(w[i] >> 16); } }
        { const u32x4 w = *(const u32x4*)(yb + c);
#pragma unroll
          for (int i = 0; i < 4; ++i) { b[2 * i] = bf2f(w[i]); b[2 * i + 1] = bf2f(w[i] >> 16); } }
        { const u32x4 w = *(const u32x4*)(uu + c);
#pragma unroll
          for (int i = 0; i < 4; ++i) { u[2 * i] = bf2f(w[i]); u[2 * i + 1] = bf2f(w[i] >> 16); } }
        const f32x4 d0 = *(const f32x4*)(dv + c), d1 = *(const f32x4*)(dv + c + 4);
        float gq[8];
#pragma unroll
        for (int i = 0; i < 8; ++i) gq[i] = gelu_tanh(a[i] + b[i] + (i < 4 ? d0[i] : d1[i - 4]) * u[i]);
        u32x4 w; w.x = pk2(gq[0], gq[1]); w.y = pk2(gq[2], gq[3]); w.z = pk2(gq[4], gq[5]); w.w = pk2(gq[6], gq[7]);
        *(u32x4*)(o + c) = w; }
}
}

__device__ __forceinline__ float rope_lane(float x, int lane, int prow, int pcol, const float* rt) {
    const int part = lane >> 5, jj = lane & 31, idx = jj & 15, pos = part ? pcol : prow;
    const float c = rt[pos * 16 + idx], s = rt[1024 + pos * 16 + idx];
    const float o = __shfl_xor(x, 16);
    return (jj >= 16) ? (x * c + o * s) : (x * c - o * s);
}
__device__ __forceinline__ u32x4 rope8(const u32x4 x, const int d0  , const int prow, const int pcol, const float* rt, const int pmask) {
    const int part = d0 >> 5, jj = d0 & 31, idx0 = jj & 15, pos = part ? pcol : prow; const bool second = jj >= 16;
    u32x4 o, y;
#pragma unroll
    for (int i = 0; i < 4; ++i) o[i] = __shfl_xor(x[i], pmask);
    const f32x4 c0 = *(const f32x4*)(rt + pos * 16 + idx0), c1 = *(const f32x4*)(rt + pos * 16 + idx0 + 4), s0 = *(const f32x4*)(rt + 1024 + pos * 16 + idx0), s1 = *(const f32x4*)(rt + 1024 + pos * 16 + idx0 + 4);
#pragma unroll
    for (int i = 0; i < 4; ++i) { const float ca = i < 2 ? c0[2 * i] : c1[2 * i - 4], cb = i < 2 ? c0[2 * i + 1] : c1[2 * i - 3], sa = i < 2 ? s0[2 * i] : s1[2 * i - 4], sb = i < 2 ? s0[2 * i + 1] : s1[2 * i - 3];
        const float xa = bf2f(x[i]), xb = bf2f(x[i] >> 16), oa = bf2f(o[i]), ob = bf2f(o[i] >> 16);
        y[i] = second ? pk2(xa * ca + oa * sa, xb * cb + ob * sb) : pk2(xa * ca - oa * sa, xb * cb - ob * sb); }
    return y;
}
__device__ __forceinline__ void ph_prep_row(const P& p, int l, int r, int lane) {
    unsigned char* ws = p.ws;
    bf16_t* ckvn = (bf16_t*)(ws + WS_CKVN) + (size_t)r * 512;
    bf16_t* kf = (bf16_t*)(ws + WS_KFULL) + (size_t)r * 1536;
    bf16_t* dfk = (bf16_t*)(ws + WS_DFK) + (size_t)r * 1024;
    bf16_t* dfv = (bf16_t*)(ws + WS_DFV) + (size_t)r * 1024;
    if (r >= MTOK) {
        const int i = r - MTOK, b = i >> 8, t = i & 255; const size_t cr = (size_t)(b * 2 + l) * PAST + t;
        { const float* cc = p.in[2] + cr * 512 + lane * 8; const f32x4 a = *(const f32x4*)cc, c = *(const f32x4*)(cc + 4);
          u32x4 w; w.x = pk2(a[0], a[1]); w.y = pk2(a[2], a[3]); w.z = pk2(c[0], c[1]); w.w = pk2(c[2], c[3]); *(u32x4*)(ckvn + lane * 8) = w; }
        const float kr = p.in[3][cr * 64 + lane];
#pragma unroll
        for (int h = 0; h < 8; ++h) kf[h * 192 + 128 + lane] = (bf16_t)f2bf(kr);
        const float* ck = p.in[4] + cr * 1024 + lane * 16; const float* cv = p.in[5] + cr * 1024 + lane * 16;
#pragma unroll
        for (int j = 0; j < 2; ++j) { const f32x4 a = *(const f32x4*)(ck + 8 * j), c = *(const f32x4*)(ck + 8 * j + 4), d = *(const f32x4*)(cv + 8 * j), e = *(const f32x4*)(cv + 8 * j + 4);
            u32x4 w; w.x = pk2(a[0], a[1]); w.y = pk2(a[2], a[3]); w.z = pk2(c[0], c[1]); w.w = pk2(c[2], c[3]); *(u32x4*)(dfk + lane * 16 + 8 * j) = w;
            u32x4 v; v.x = pk2(d[0], d[1]); v.y = pk2(d[2], d[3]); v.z = pk2(e[0], e[1]); v.w = pk2(e[2], e[3]); *(u32x4*)(dfv + lane * 16 + 8 * j) = v; }
        return;
    }
    const float* kva = (const float*)(ws + WS_KVA) + (size_t)r * KVAW;
    const bool ctx = r < NCTX;
    const int cb = r >> 8, ct = r & 255;
    const int t = (r - NCTX) & 4095, prow = t >> 6, pcol = t & 63;
    const float* rt = (const float*)(ws + WS_ROPE);
    const f32x4 ka = *(const f32x4*)(kva + lane * 8), kb = *(const f32x4*)(kva + lane * 8 + 4);
    float kr = kva[512 + lane];
    const float graw = lane < 16 ? kva[576 + lane] + p.in[18][l * 16 + lane] : 0.f;
    bf16_t* mq = (bf16_t*)(ws + WS_MQ) + (size_t)r * 1536 + (lane >> 3) * 192 + 128 + (lane & 7) * 8;
    bf16_t* dfq = (bf16_t*)(ws + WS_DFQ) + (size_t)r * 1024 + lane * 16;
    u32x4 xq = {0u, 0u, 0u, 0u}, xd0 = xq, xd1 = xq, xk0 = xq, xk1 = xq, xv0 = xq, xv1 = xq;
    if (!ctx) { xq = *(const u32x4*)mq; xd0 = *(const u32x4*)dfq; xd1 = *(const u32x4*)(dfq + 8); }
    xk0 = *(const u32x4*)(dfk + lane * 16); xk1 = *(const u32x4*)(dfk + lane * 16 + 8);
    if (ctx) { xv0 = *(const u32x4*)(dfv + lane * 16); xv1 = *(const u32x4*)(dfv + lane * 16 + 8); }
    { float ss = ka[0] * ka[0] + ka[1] * ka[1] + ka[2] * ka[2] + ka[3] * ka[3] + kb[0] * kb[0] + kb[1] * kb[1] + kb[2] * kb[2] + kb[3] * kb[3];
      const float rstd = rsqrtf(wave_sum(ss) * (1.0f / 512.0f) + 1e-6f);
      const float* g = p.in[20] + l * 512 + lane * 8; const f32x4 g0 = *(const f32x4*)g, g1 = *(const f32x4*)(g + 4);
      const f32x4 y0 = ka * rstd * g0, y1 = kb * rstd * g1;
      u32x4 w; w.x = pk2(y0[0], y0[1]); w.y = pk2(y0[2], y0[3]); w.z = pk2(y1[0], y1[1]); w.w = pk2(y1[2], y1[3]); *(u32x4*)(ckvn + lane * 8) = w;
      if (ctx) { float* o = p.out + O_CKV + ((size_t)(cb * 2 + l) * CL + ct) * 512 + lane * 8; *(f32x4*)o = y0; *(f32x4*)(o + 4) = y1; } }
    { if (ctx) p.out[O_KR + ((size_t)(cb * 2 + l) * CL + ct) * 64 + lane] = kr; else kr = rope_lane(kr, lane, prow, pcol, rt);
#pragma unroll
      for (int h = 0; h < 8; ++h) kf[h * 192 + 128 + lane] = (bf16_t)f2bf(kr); }
    if (lane < 16) { const float o = ((lane >> 2) & 1) ? (fminf(graw, 0.f) - __logf(1.0f + __expf(-fabsf(graw)))) : graw; ((float*)(ws + WS_GATES))[(size_t)r * 16 + lane] = o; }
    if (ctx) {
        float* ok = p.out + O_DK + ((size_t)(cb * 2 + l) * CL + ct) * 1024 + lane * 16; float* ov = p.out + O_DV + ((size_t)(cb * 2 + l) * CL + ct) * 1024 + lane * 16;
#pragma unroll
        for (int i = 0; i < 4; ++i) { *(f32x2_*)(ok + 2 * i) = (f32x2_){bf2f(xk0[i]), bf2f(xk0[i] >> 16)}; *(f32x2_*)(ok + 8 + 2 * i) = (f32x2_){bf2f(xk1[i]), bf2f(xk1[i] >> 16)};
            *(f32x2_*)(ov + 2 * i) = (f32x2_){bf2f(xv0[i]), bf2f(xv0[i] >> 16)}; *(f32x2_*)(ov + 8 + 2 * i) = (f32x2_){bf2f(xv1[i]), bf2f(xv1[i] >> 16)}; }
    } else {
        *(u32x4*)mq = rope8(xq, (lane & 7) * 8, prow, pcol, rt, 2);
        const int q = lane & 3;
        *(u32x4*)dfq = rope8(xd0, q * 16, prow, pcol, rt, 1); *(u32x4*)(dfq + 8) = rope8(xd1, q * 16 + 8, prow, pcol, rt, 1);
        *(u32x4*)(dfk + lane * 16) = rope8(xk0, q * 16, prow, pcol, rt, 1); *(u32x4*)(dfk + lane * 16 + 8) = rope8(xk1, q * 16 + 8, prow, pcol, rt, 1);
    }
}

__device__ __forceinline__ void ph_ml_combine_row(const P& p, int l, int r, int lane) {
    bf16_t* hf = (bf16_t*)(p.ws + WS_HF) + (size_t)r * 1024 + lane * 4; const bf16_t* hb = (const bf16_t*)(p.ws + WS_HB) + (size_t)r * 1024 + lane * 4;
    const bf16_t* so = (const bf16_t*)(p.ws + WS_MLO) + (size_t)r * 1024 + lane * 4; const float* g = p.in[19] + l * 1024 + lane * 4;
    u32x2 a[4], b[4], c[4]; f32x4 gg[4];
#pragma unroll
    for (int h = 0; h < 4; ++h) { a[h] = *(const u32x2*)(hf + h * 256); b[h] = *(const u32x2*)(hb + h * 256); c[h] = *(const u32x2*)(so + h * 256); gg[h] = *(const f32x4*)(g + h * 256); }
#pragma unroll
    for (int h = 0; h < 4; ++h) { float v[4];
        v[0] = bf2f(a[h].x) + bf2f(b[h].x); v[1] = bf2f(a[h].x >> 16) + bf2f(b[h].x >> 16); v[2] = bf2f(a[h].y) + bf2f(b[h].y); v[3] = bf2f(a[h].y >> 16) + bf2f(b[h].y >> 16);
        const float rstd = rsqrtf(wave_sum(v[0] * v[0] + v[1] * v[1] + v[2] * v[2] + v[3] * v[3]) * (1.0f / 256.0f) + 1e-6f);
        u32x2 w; w.x = pk2(v[0] * rstd * gg[h][0] * bf2f(c[h].x), v[1] * rstd * gg[h][1] * bf2f(c[h].x >> 16)); w.y = pk2(v[2] * rstd * gg[h][2] * bf2f(c[h].y), v[3] * rstd * gg[h][3] * bf2f(c[h].y >> 16));
        *(u32x2*)(hf + h * 256) = w; }
}

__device__ __forceinline__ void ph_df_combine_row(const P& p, int l, float lam_init, float lam, int r, int lane) {
    const int h = lane >> 3, part = lane & 7;
    const bf16_t* o = (const bf16_t*)(p.ws + WS_DFO) + (size_t)r * 2048 + h * 256 + part * 16;
    const u32x4 a0 = *(const u32x4*)o, a1 = *(const u32x4*)(o + 8), b0 = *(const u32x4*)(o + 128), b1 = *(const u32x4*)(o + 136);
    const float* g = p.in[32] + l * 128 + part * 16;
    float v[16]; float ss = 0.f;
#pragma unroll
    for (int i = 0; i < 4; ++i) { v[2 * i] = bf2f(a0[i]) - lam * bf2f(b0[i]); v[2 * i + 1] = bf2f(a0[i] >> 16) - lam * bf2f(b0[i] >> 16); v[8 + 2 * i] = bf2f(a1[i]) - lam * bf2f(b1[i]); v[9 + 2 * i] = bf2f(a1[i] >> 16) - lam * bf2f(b1[i] >> 16); }
#pragma unroll
    for (int i = 0; i < 16; ++i) ss += v[i] * v[i];
    ss += __shfl_xor(ss, 1); ss += __shfl_xor(ss, 2); ss += __shfl_xor(ss, 4);
    const float sc = rsqrtf(ss * (1.0f / 128.0f) + 1e-6f) * (1.0f - lam_init);
    u32x4 w0, w1;
#pragma unroll
    for (int i = 0; i < 4; ++i) { w0[i] = pk2(v[2 * i] * sc * g[2 * i], v[2 * i + 1] * sc * g[2 * i + 1]); w1[i] = pk2(v[8 + 2 * i] * sc * g[8 + 2 * i], v[9 + 2 * i] * sc * g[9 + 2 * i]); }
    bf16_t* y = (bf16_t*)(p.ws + WS_DFQ) + (size_t)r * 1024 + h * 128 + part * 16;
    *(u32x4*)y = w0; *(u32x4*)(y + 8) = w1;
}
__device__ __forceinline__ void ph_final_row(const P& p, int r, int lane) {
    const float* x = (const float*)(p.ws + WS_X) + (size_t)r * D; const float* g = p.in[37];
    f32x4 v[8]; float ss = 0.f;
#pragma unroll
    for (int j = 0; j < 8; ++j) { v[j] = *(const f32x4*)(x + j * 256 + lane * 4); ss += v[j][0] * v[j][0] + v[j][1] * v[j][1] + v[j][2] * v[j][2] + v[j][3] * v[j][3]; }
    const float rstd = rsqrtf(wave_sum(ss) * (1.0f / 2048.0f) + 1e-6f);
    float* o = p.out + (r < NCTX ? O_YP + (size_t)r * D : O_YS + (size_t)(r - NCTX) * D);
#pragma unroll
    for (int j = 0; j < 8; ++j) { const int c = j * 256 + lane * 4; const f32x4 gg = *(const f32x4*)(g + c); *(f32x4*)(o + c) = v[j] * rstd * gg; }
}

__device__ __forceinline__ void load_args(P& p) {
#if defined(__HIP_DEVICE_COMPILE__)
    const __attribute__((address_space(4))) unsigned long long* q = (const __attribute__((address_space(4))) unsigned long long*)__builtin_amdgcn_kernarg_segment_ptr();
    asm volatile("" : "+s"(q));
#pragma unroll
    for (int i = 0; i < 38; ++i) p.in[i] = (const float*)q[i];
    p.out = (float*)q[38]; p.ws = (unsigned char*)q[39];
#endif
}
constexpr int NTHR = 512, LDS_BYTES = 147456, MISC_OFF = 131072;
#ifndef PROBE
#define PROBE 0
#endif
#ifndef PROBE_MASK_D
#define PROBE_MASK_D 0u
#endif
#ifndef PROBE_MASK_A
#define PROBE_MASK_A 0u
#endif
#define PROBE_MULT 10
#define PROBE_ADIV 100.0f
#define STAMP(idx) do { if (PROBE) { if (blockIdx.x == 0 && bar.w == 0u && lane_id_() == 0u) ((LAS unsigned long long*)((LAS unsigned char*)lds + MISC_OFF + 2048))[idx] = __builtin_amdgcn_s_memrealtime(); } } while (0)
#define GRID_BAR() do { XcdBarrier b_ = bar; asm volatile("" : "+s"(b_.x)); xcd_barrier(b_); } while (0)

#define PH_VARS P p; load_args(p); unsigned char* ws = p.ws; (void)ws; int tid_ = (int)(bar.w * 64u + lane_id_()); asm volatile("" : "+v"(tid_)); const int lane = tid_ & 63, wave = __builtin_amdgcn_readfirstlane(tid_ >> 6), half = tid_ >> 8, vt = tid_ & 255; \
    const int gw = blockIdx.x * 8 + wave, vb = blockIdx.x * 2 + half; (void)lane; (void)half; (void)vt; (void)gw; (void)vb;

template <int l>
__device__ __forceinline__ void run_layer(unsigned char* lds, const XcdBarrier& bar, const int G, const int NGW) {
        { PH_VARS ph_convert(p, l, gw, NGW, lane, (LAS float*)((LAS unsigned char*)lds + wave * 16384), l == 0, true); }
        { PH_VARS for (int r = gw; r < MTOK; r += NGW) ph_hnorm_row(p, l, 0, r, lane); }
        GRID_BAR(); STAMP(1 + 17 * l + 1);
        { PH_VARS pg8::Gemm g{(const bf16_t*)(ws + WS_H), (const bf16_t*)(ws + WS_WBF + WB_IN), MTOK, 10496, D}; pg8::StaticOrder S; S.init(MTOK, 10496, G, (int)blockIdx.x);
          pg8::gemm_phase<Epi8In, pg8::StaticOrder, true, true>((LAS unsigned char*)lds, g, S, Epi8In{ws}, tid_); }
        GRID_BAR(); STAMP(1 + 17 * l + 2);
        { PH_VARS for (int ch = blockIdx.x; ch < 160; ch += G) ml::scalars_wg(p, l, ch, wave, lane, (LAS float*)((LAS unsigned char*)lds)); for (int r = gw; r < MALL; r += NGW) ph_prep_row(p, l, r, lane); }
        GRID_BAR(); STAMP(1 + 17 * l + 3);
        { PH_VARS pg8::Gemm g{(const bf16_t*)(ws + WS_CKVN), (const bf16_t*)(ws + WS_WBF + WB_KVB), MALL, 2048, 512}; pg8::StaticOrder S; S.init(MALL, 2048, G, (int)blockIdx.x);
          pg8::gemm_phase<Epi8Kvb, pg8::StaticOrder, true, true>((LAS unsigned char*)lds, g, S, Epi8Kvb{(bf16_t*)(ws + WS_KFULL), (bf16_t*)(ws + WS_VFULL)}, tid_); }
        STAMP(1 + 17 * l + 4);
        { PH_VARS ml::intra_phase((LAS unsigned char*)lds, p, l, tid_); }
        GRID_BAR();
        { PH_VARS ml::seq_phase((LAS unsigned char*)lds, p, l, tid_); }
        GRID_BAR(); STAMP(1 + 17 * l + 5);
        { PH_VARS
          for (int u = xcd_slot(); u < 256; u += G) { int ln_ = lane; asm volatile("" : "+v"(ln_)); s5::lat_unit(p, l, (LAS unsigned char*)lds, u, wave, ln_); }
          if (wave < 4) { for (int u = wave * G + blockIdx.x; u < 1024; u += 4 * G) s5::ctx_unit(p, l, (LAS unsigned char*)lds + wave * 8192, u, lane); }
          else { for (int r = blockIdx.x * 4 + (wave - 4); r < MTOK; r += G * 4) ph_ml_combine_row(p, l, r, lane); } }
        GRID_BAR(); STAMP(1 + 17 * l + 6);
        { PH_VARS for (int r = gw; r < MTOK; r += NGW) s5::combine_row(p, l, r, lane); }
        GRID_BAR(); STAMP(1 + 17 * l + 7);
        { PH_VARS pg8::Gemm g{(const bf16_t*)(ws + WS_HB), (const bf16_t*)(ws + WS_WBF + WB_GLU), MTOK, 1024, 1024}; pg8::StaticOrder S; S.init(MTOK, 1024, G, (int)blockIdx.x);
          pg8::gemm_phase<Epi8Glu, pg8::StaticOrder, true, true>((LAS unsigned char*)lds, g, S, Epi8Glu{(const bf16_t*)(ws + WS_HB), (bf16_t*)(ws + WS_S5U)}, tid_); }
        STAMP(1 + 17 * l + 8);
        { PH_VARS fa::Args aa{(const bf16_t*)(ws + WS_MQ), (const bf16_t*)(ws + WS_KFULL), (const bf16_t*)(ws + WS_VFULL), (bf16_t*)(ws + WS_MLQ), 1536, 1536, 1024, 1024, 8, 1, 0.07216878364870322f, 0};
          fa::attn_phase<192>((LAS unsigned char*)lds, aa, tid_); }
        STAMP(1 + 17 * l + 9);
        { PH_VARS fa::Args aa{(const bf16_t*)(ws + WS_DFQ), (const bf16_t*)(ws + WS_DFK), (const bf16_t*)(ws + WS_DFV), (bf16_t*)(ws + WS_DFO), 1024, 1024, 1024, 2048, 16, 2, 0.125f, 0};
          fa::attn_phase<64>((LAS unsigned char*)lds, aa, tid_); }
        GRID_BAR(); STAMP(1 + 17 * l + 10);
        { PH_VARS const float lam_init = (l == 0) ? 0.2f : 0.35550906759096927f;
          const float* lp = p.in[31] + l * 256;
          const float lam = __expf(wave_sum(lp[lane] * lp[64 + lane])) - __expf(wave_sum(lp[128 + lane] * lp[192 + lane])) + lam_init;
          for (int r = gw; r < MTOK; r += NGW) ph_df_combine_row(p, l, lam_init, lam, r, lane); }
        GRID_BAR(); STAMP(1 + 17 * l + 11);
        { PH_VARS pg8::Gemm g{(const bf16_t*)(ws + WS_H), (const bf16_t*)(ws + WS_WBF + WB_IN) + (size_t)10496 * D, MTOK, GATE_COLS, D}; pg8::StaticOrder S; S.init(MTOK, GATE_COLS, G, (int)blockIdx.x);
          pg8::gemm_phase<Epi8Gate, pg8::StaticOrder, true, true>((LAS unsigned char*)lds, g, S, Epi8Gate{(bf16_t*)(ws + WS_GS)}, tid_); }
        GRID_BAR(); STAMP(1 + 17 * l + 12);
        { PH_VARS pg8::Gemm g{(const bf16_t*)(ws + WS_HF), (const bf16_t*)(ws + WS_WBF + WB_BR) + (size_t)0 * 2048 * 1024, MTOK, D, 1024}; pg8::StaticOrder S; S.init(MTOK, D, G, (int)blockIdx.x);
          pg8::gemm_phase<Epi8Merge, pg8::StaticOrder, true, true>((LAS unsigned char*)lds, g, S, Epi8Merge{(const bf16_t*)(ws + WS_GS), (bf16_t*)(ws + WS_H), 0, 0}, tid_); }
        { PH_VARS pg8::Gemm g{(const bf16_t*)(ws + WS_MLQ), (const bf16_t*)(ws + WS_WBF + WB_BR) + (size_t)1 * 2048 * 1024, MTOK, D, 1024}; pg8::StaticOrder S; S.init(MTOK, D, G, (int)blockIdx.x);
          pg8::gemm_phase<Epi8Merge, pg8::StaticOrder, true, true>((LAS unsigned char*)lds, g, S, Epi8Merge{(const bf16_t*)(ws + WS_GS), (bf16_t*)(ws + WS_H), 1, 0}, tid_); }
        { PH_VARS pg8::Gemm g{(const bf16_t*)(ws + WS_S5U), (const bf16_t*)(ws + WS_WBF + WB_BR) + (size_t)2 * 2048 * 1024, MTOK, D, 1024}; pg8::StaticOrder S; S.init(MTOK, D, G, (int)blockIdx.x);
          pg8::gemm_phase<Epi8Merge, pg8::StaticOrder, true, true>((LAS unsigned char*)lds, g, S, Epi8Merge{(const bf16_t*)(ws + WS_GS), (bf16_t*)(ws + WS_H), 2, 0}, tid_); }
        { PH_VARS pg8::Gemm g{(const bf16_t*)(ws + WS_DFQ), (const bf16_t*)(ws + WS_WBF + WB_BR) + (size_t)3 * 2048 * 1024, MTOK, D, 1024}; pg8::StaticOrder S; S.init(MTOK, D, G, (int)blockIdx.x);
          pg8::gemm_phase<Epi8Merge, pg8::StaticOrder, true, true>((LAS unsigned char*)lds, g, S, Epi8Merge{(const bf16_t*)(ws + WS_GS), (bf16_t*)(ws + WS_H), 3, 0}, tid_); }
        GRID_BAR(); STAMP(1 + 17 * l + 13);
        { PH_VARS pg8::Gemm g{(const bf16_t*)(ws + WS_H), (const bf16_t*)(ws + WS_WBF + WB_O), MTOK, D, D}; pg8::StaticOrder S; S.init(MTOK, D, G, (int)blockIdx.x);
          pg8::gemm_phase<Epi8Res, pg8::StaticOrder, true, true>((LAS unsigned char*)lds, g, S, Epi8Res{p, l, 4096, 0, 0}, tid_); }
        GRID_BAR(); STAMP(1 + 17 * l + 14);
        { PH_VARS for (int r = gw; r < MTOK; r += NGW) ph_hnorm_row(p, l, 1, r, lane); }
        GRID_BAR(); STAMP(1 + 17 * l + 15);
        { PH_VARS pg8::Gemm g{(const bf16_t*)(ws + WS_H), (const bf16_t*)(ws + WS_WBF + WB_FIN), MTOK, 2 * FFN, D}; pg8::StaticOrder S; S.init(MTOK, 2 * FFN, G, (int)blockIdx.x);
          pg8::gemm_phase<Epi8FfnIn, pg8::StaticOrder, true, true>((LAS unsigned char*)lds, g, S, Epi8FfnIn{(bf16_t*)(ws + WS_FFNH)}, tid_); }
        GRID_BAR(); STAMP(1 + 17 * l + 16);
        { PH_VARS pg8::Gemm g{(const bf16_t*)(ws + WS_FFNH), (const bf16_t*)(ws + WS_WBF + WB_FOUT), MTOK, D, FFN}; pg8::StaticOrder S; S.init(MTOK, D, G, (int)blockIdx.x);
          pg8::gemm_phase<Epi8Res, pg8::StaticOrder, true, true>((LAS unsigned char*)lds, g, S, Epi8Res{p, l, 10240, 1, 0}, tid_); }
        if (l == 0) { PH_VARS
          const int rem = 640 % G, nidle = rem ? G - rem : G, idx = rem ? (int)blockIdx.x - rem : (int)blockIdx.x;
          if (idx >= 0) ph_convert(p, 1, idx * 8 + wave, nidle * 8, lane, (LAS float*)((LAS unsigned char*)lds + wave * 16384), true, false); }
        GRID_BAR(); STAMP(1 + 17 * l + 17);
}

__global__ void __launch_bounds__(NTHR, 2) mega(P p_arg) {
    extern __shared__ __attribute__((aligned(16))) unsigned char lds[];
    const int tid = threadIdx.x;
    const int G = gridDim.x, NGW = G * 8;
    for (int u = tid; u < (LDS_BYTES - MISC_OFF) / 4; u += NTHR) ((LAS unsigned*)((LAS unsigned char*)lds + MISC_OFF))[u] = 0u;
    __syncthreads();
    XcdBarrier bar = xcd_barrier_post((unsigned*)(p_arg.ws + WS_CTL), (volatile LAS unsigned*)((LAS unsigned char*)lds + MISC_OFF + 32));
    STAMP(0);
    { PH_VARS ph_mod_partial(p, tid_, (float*)lds); }
    GRID_BAR();
    { PH_VARS ph_mod_reduce(p, tid_); }
    GRID_BAR(); STAMP(1);
    run_layer<0>(lds, bar, G, NGW);
    run_layer<1>(lds, bar, G, NGW);
    { PH_VARS for (int r = gw; r < MTOK; r += NGW) ph_final_row(p, r, lane);
#if PROBE
      STAMP(35);
      if (blockIdx.x == 0 && bar.w == 0u && lane_id_() == 0u) {
          asm volatile("s_waitcnt vmcnt(0) lgkmcnt(0)" ::: "memory");
          const LAS unsigned long long* ts = (const LAS unsigned long long*)((LAS unsigned char*)lds + MISC_OFF + 2048);
          unsigned long long sd = 0, sa = 0;
          for (int ll = 0; ll < 2; ++ll) for (int i = 0; i < 17; ++i) { const unsigned long long d = ts[1 + 17 * ll + i + 1] - ts[1 + 17 * ll + i]; if ((PROBE_MASK_D >> i) & 1u) sd += d; if ((PROBE_MASK_A >> i) & 1u) sa += d; }
          { const unsigned long long d = ts[1] - ts[0]; if ((PROBE_MASK_D >> 17) & 1u) sd += d; if ((PROBE_MASK_A >> 17) & 1u) sa += d; }
          { const unsigned long long d = ts[35] - ts[34]; if ((PROBE_MASK_D >> 18) & 1u) sd += d; if ((PROBE_MASK_A >> 18) & 1u) sa += d; }
          float v = (float)sa * 0.01f / PROBE_ADIV; v = v > 120.f ? 120.f : v;
          if (PROBE_MASK_A) p.out[O_YS] += v;
          const unsigned long long t0 = __builtin_amdgcn_s_memrealtime(), wait = sd * PROBE_MULT;
          while (__builtin_amdgcn_s_memrealtime() - t0 < wait) __builtin_amdgcn_s_sleep(32);
      }
#endif
    }
}

extern "C" void kernel_launch(void* const* d_in, const int* in_sizes, int n_in, void* d_out, int out_size, void* d_ws, size_t ws_size, hipStream_t stream) {
    static int grid = 0;
    if (grid == 0) {
        if (n_in != 38 || out_size != (int)O_END || ws_size < WS_END) { fprintf(stderr, "kernel_launch: unexpected shapes (n_in %d out %d ws %zu)\n", n_in, out_size, ws_size); grid = -1; return; }
        int dev = 0, cus = 0, per_cu = 0;
        if (hipGetDevice(&dev) != hipSuccess || hipDeviceGetAttribute(&cus, hipDeviceAttributeMultiprocessorCount, dev) != hipSuccess) { grid = -1; return; }
        if (hipFuncSetAttribute((const void*)mega, hipFuncAttributeMaxDynamicSharedMemorySize, LDS_BYTES) != hipSuccess) { fprintf(stderr, "kernel_launch: hipFuncSetAttribute failed\n"); grid = -1; return; }
        if (hipOccupancyMaxActiveBlocksPerMultiprocessor(&per_cu, (const void*)mega, NTHR, LDS_BYTES) != hipSuccess || per_cu < 1) { fprintf(stderr, "kernel_launch: occupancy query says %d workgroups per CU\n", per_cu); grid = -1; return; }
        (void)hipGetLastError();
        grid = cus;
    }
    if (grid < 0) return;
    if (hipMemsetAsync((char*)d_ws + WS_CTL, 0, CTL_BYTES, stream) != hipSuccess) return;
    P p{};
    for (int i = 0; i < 38; ++i) p.in[i] = (const float*)d_in[i];
    p.out = (float*)d_out; p.ws = (unsigned char*)d_ws;
    hipLaunchKernelGGL(mega, dim3(grid), dim3(NTHR), LDS_BYTES, stream, p);
}
```

```cpp
#include <hip/hip_runtime.h>
#include <cstdio>
#include <cstdint>

typedef unsigned short bf16_t;
typedef short bf16x8 __attribute__((ext_vector_type(8)));
typedef float f32x16 __attribute__((ext_vector_type(16)));
typedef float f32x4 __attribute__((ext_vector_type(4)));
typedef unsigned u32x4 __attribute__((ext_vector_type(4)));
typedef unsigned u32x2 __attribute__((ext_vector_type(2)));
typedef float f32x2_ __attribute__((ext_vector_type(2)));

constexpr int D = 2048, NCTX = 4096, NLAT = 16384, MTOK = 20480, MALL = 21504;
constexpr int CB = 16, CL = 256, LB = 4, LL = 4096, PAST = 256;
constexpr int IN_COLS = 18512, MIX_COLS = 10320, GATE_COLS = 8192;
constexpr int C_MLQ = 0, C_MLK = 1024, C_MLV = 2048, C_MLO = 3072, C_MLIF = 4096, C_MQ = 4112, C_KVA = 5648, C_S5U = 6224, C_DFQ = 7248, C_DFK = 8272, C_DFV = 9296;
constexpr int FFN = 5632;
constexpr int NTHR_ = 512;
constexpr int KVAW = 768;

constexpr size_t MiB = 1u << 20;
constexpr size_t WS_CTL = 0, CTL_BYTES = 64 * 1024;
constexpr size_t WS_MOD = 1 * MiB;
constexpr size_t WS_ROPE = WS_MOD + 512 * 1024;
constexpr size_t WS_X = 2 * MiB;
constexpr size_t WS_H = 162 * MiB;
constexpr size_t WS_HF = 242 * MiB;
constexpr size_t WS_HB = 282 * MiB;
constexpr size_t WS_MLQ = 322 * MiB;
constexpr size_t WS_S5U = 362 * MiB;
constexpr size_t WS_DFQ = 402 * MiB;
constexpr size_t WS_MLK = 442 * MiB;
constexpr size_t WS_MLV = 482 * MiB;
constexpr size_t WS_MLO = 522 * MiB;
constexpr size_t WS_MQ = 562 * MiB;
constexpr size_t WS_KVA = 622 * MiB;
constexpr size_t WS_DFK = 682 * MiB;
constexpr size_t WS_DFV = 724 * MiB;
constexpr size_t WS_CKVN = 766 * MiB;
constexpr size_t WS_KFULL = 787 * MiB;
constexpr size_t WS_VFULL = 850 * MiB;
constexpr size_t WS_GATES = 892 * MiB;
constexpr size_t WS_CT = 894 * MiB;
constexpr size_t WS_WBF = 934 * MiB;
constexpr size_t WS_GS = 442 * MiB;
constexpr size_t WS_FFNH = 442 * MiB;
constexpr size_t WS_DFO = 442 * MiB;
constexpr size_t WS_YS5F = 442 * MiB;
constexpr size_t WS_YS5B = 482 * MiB;
constexpr size_t WS_END = 1101 * MiB;

constexpr size_t O_YP = 0, O_YS = 8388608, O_CKV = 41943040, O_KR = 46137344, O_DK = 46661632, O_DV = 55050240,
                 O_MC = 63438848, O_MN = 80216064, O_MM = 80281600, O_SR = 80281856, O_SI = 80544000, O_END = 80806144;

__device__ __forceinline__ unsigned f2bf(float f) { unsigned u = __builtin_bit_cast(unsigned, f); return (u + 0x7fffu + ((u >> 16) & 1u)) >> 16; }
__device__ __forceinline__ float bf2f(unsigned b) { return __builtin_bit_cast(float, (b & 0xffffu) << 16); }
__device__ __forceinline__ unsigned pk2(float lo, float hi) { return f2bf(lo) | (f2bf(hi) << 16); }
__device__ __forceinline__ float wave_sum(float v) {
#pragma unroll
    for (int o = 1; o < 64; o <<= 1) v += __shfl_xor(v, o);
    return v;
}
__device__ __forceinline__ float wave_max(float v) {
#pragma unroll
    for (int o = 1; o < 64; o <<= 1) v = fmaxf(v, __shfl_xor(v, o));
    return v;
}
__device__ __forceinline__ float sigmoidf_(float x) { return __builtin_amdgcn_rcpf(1.0f + __expf(-x)); }
__device__ __forceinline__ float siluf_(float x) { return x * __builtin_amdgcn_rcpf(1.0f + __expf(-x)); }
__device__ __forceinline__ float gelu_tanh(float x) { const float u = 0.7978845608028654f * (x + 0.044715f * x * x * x); const float t = 1.0f - 2.0f / (1.0f + __expf(2.0f * u)); return 0.5f * x * (1.0f + t); }
__device__ __forceinline__ void sincos_small(float x, float& s, float& c) {
    const float k = rintf(x * 0.6366197723675814f);
    float r = fmaf(-k, 1.5707962513e+0f, x); r = fmaf(-k, 7.5497894159e-8f, r); r = fmaf(-k, 5.3903029534e-15f, r);
    const float r2 = r * r;
    const float sp = r + r * r2 * (-1.6666654611e-1f + r2 * (8.3321608736e-3f + r2 * (-1.9515295891e-4f)));
    const float cp = 1.0f - 0.5f * r2 + r2 * r2 * (4.166664568298827e-2f + r2 * (-1.388731625493765e-3f + r2 * 2.443315711809948e-5f));
    const int q = ((int)k) & 3;
    s = (q == 0) ? sp : (q == 1) ? cp : (q == 2) ? -sp : -cp;
    c = (q == 0) ? cp : (q == 1) ? -sp : (q == 2) ? -cp : sp;
}
__device__ __forceinline__ int cond_of_row(int r) { return r < NCTX ? 0 : 1 + ((r - NCTX) >> 12); }

struct P {
    const float* in[38];
    float* out;
    unsigned char* ws;
};
__device__ __forceinline__ const float* x_src(const P& p, int l, int r) {
    if (l == 0) return r < NCTX ? p.in[0] + (size_t)r * D : p.in[1] + (size_t)(r - NCTX) * D;
    return (const float*)(p.ws + WS_X) + (size_t)r * D;
}


#define XB_TMO      128
#define XB_XCNT(j)  (256  + 64 * (j))
#define XB_XSUB(j)  (1280 + 64 * (j))
#define XB_XGEN(j)  (2304 + 64 * (j))
#define XB_TOP      3328
#define XB_TOPGEN   3392
#define XCD_BAR_WORDS 3456
#define XB_SPIN_CAP (1u << 22)
#define LAS __attribute__((address_space(3)))

__device__ __forceinline__ unsigned xb_ld(unsigned* p)              { return __hip_atomic_load(p, __ATOMIC_RELAXED, __HIP_MEMORY_SCOPE_AGENT); }
__device__ __forceinline__ unsigned xb_add(unsigned* p, unsigned v) { return __hip_atomic_fetch_add(p, v, __ATOMIC_RELAXED, __HIP_MEMORY_SCOPE_AGENT); }
__device__ __forceinline__ unsigned xb_xcc_id() { return (unsigned)__builtin_amdgcn_s_getreg((3 << 11) | 20) & 0xFu; }
#define XB_SPIN(cond, bar) do { unsigned _sp = 0; while (cond) { __builtin_amdgcn_s_sleep(1); \
    if ((++_sp & 255u) == 0u) { if (xb_ld(&(bar)[XB_TMO])) break; if (_sp > XB_SPIN_CAP) { atomicAdd(&(bar)[XB_TMO], 1u); break; } } } } while (0)

__device__ __forceinline__ unsigned lane_id_() { unsigned l_; asm volatile("v_mbcnt_lo_u32_b32 %0, -1, 0\n\tv_mbcnt_hi_u32_b32 %0, -1, %0" : "=v"(l_)); return l_; }
struct XcdBarrier {
    unsigned* bar; unsigned x; unsigned w;
    volatile LAS unsigned* st;
};
__device__ __forceinline__ XcdBarrier xcd_barrier_post(unsigned* bar, volatile LAS unsigned* st) {
    XcdBarrier b; b.bar = bar; b.x = xb_xcc_id(); b.st = st; b.w = (unsigned)__builtin_amdgcn_readfirstlane(threadIdx.x >> 6);
    if (threadIdx.x == 0) (void)xb_add(&bar[XB_XCNT(b.x)], 1u);
    return b;
}
__device__ __forceinline__ void xcd_barrier_complete(unsigned* bar, unsigned x, unsigned& nloc, unsigned& nx) {
    const unsigned G = gridDim.x * gridDim.y * gridDim.z;
    unsigned sum, cnt, mine, sp = 0u;
    for (;;) {
        sum = 0u; cnt = 0u; mine = 0u;
#pragma unroll
        for (unsigned j = 0; j < 16; ++j) { const unsigned c = xb_ld(&bar[XB_XCNT(j)]); sum += c; cnt += (c > 0u) ? 1u : 0u; mine = (j == x) ? c : mine; }
        if (sum == G) break;
        __builtin_amdgcn_s_sleep(1);
        if ((++sp & 255u) == 0u) { if (xb_ld(&bar[XB_TMO])) break; if (sp > XB_SPIN_CAP) { atomicAdd(&bar[XB_TMO], 1u); break; } }
    }
    nloc = mine > 0u ? mine : 1u; nx = cnt > 0u ? cnt : 1u;
}
__device__ __forceinline__ void xcd_barrier(const XcdBarrier& b) {
    asm volatile("s_waitcnt vmcnt(0)" ::: "memory");
    __syncthreads();
    if (b.w == 0u && lane_id_() == 0u) {
        unsigned* bar = b.bar;
        __builtin_amdgcn_s_waitcnt(0);
        unsigned nloc = b.st[0], nx = b.st[1];
        if (nloc == 0u) { xcd_barrier_complete(bar, b.x, nloc, nx); b.st[0] = nloc; b.st[1] = nx; }
        const unsigned old = xb_add(&bar[XB_XSUB(b.x)], 1u);
        const unsigned gen = old / nloc;
        if (old + 1u == (gen + 1u) * nloc) {
            __builtin_amdgcn_fence(__ATOMIC_RELEASE, "agent");
            asm volatile("s_waitcnt vmcnt(0)" ::: "memory");
            const unsigned og = xb_add(&bar[XB_TOP], 1u);
            const unsigned tg = og / nx;
            if (og + 1u == (tg + 1u) * nx) xb_add(&bar[XB_TOPGEN], 1u);
            else XB_SPIN(xb_ld(&bar[XB_TOPGEN]) == tg, bar);
            __builtin_amdgcn_fence(__ATOMIC_ACQUIRE, "agent");
            xb_add(&bar[XB_XGEN(b.x)], 1u);
            asm volatile("s_waitcnt vmcnt(0)" ::: "memory");
        } else {
            XB_SPIN(xb_ld(&bar[XB_XGEN(b.x)]) == gen, bar);
            __builtin_amdgcn_fence(__ATOMIC_ACQUIRE, "agent");
            asm volatile("s_waitcnt vmcnt(0)" ::: "memory");
        }
    }
    __syncthreads();
}


constexpr int MOD_KS = 16, MOD_KC = 2048 / MOD_KS;
constexpr size_t WS_MODP = WS_X;
__device__ __forceinline__ void ph_mod_partial(const P& p, int tid, float* sc) {
    for (int i = tid; i < 5 * 2048; i += NTHR_) { const int c = i >> 11, k = i & 2047; const float v = c == 0 ? p.in[12][k] : p.in[11][(c - 1) * 2048 + k]; sc[i] = siluf_(v); }
    __syncthreads();
    const int NU = 2 * 3072 * MOD_KS;
    for (int u = blockIdx.x * NTHR_ + tid; u < NU; u += gridDim.x * NTHR_) {
        const int cg = u % 3072, kc = (u / 3072) % MOD_KS, l = u / (3072 * MOD_KS);
        const float* w = p.in[13] + ((size_t)l * 2048 + kc * MOD_KC) * 12288 + cg * 4;
        f32x4 a0 = {0.f, 0.f, 0.f, 0.f}, a1 = a0, a2 = a0, a3 = a0, a4 = a0;
#pragma unroll 8
        for (int k = 0; k < MOD_KC; ++k) { const f32x4 wv = *(const f32x4*)(w + (size_t)k * 12288); const int kk = kc * MOD_KC + k;
            a0 += wv * sc[kk]; a1 += wv * sc[2048 + kk]; a2 += wv * sc[4096 + kk]; a3 += wv * sc[6144 + kk]; a4 += wv * sc[8192 + kk]; }
        float* o = (float*)(p.ws + WS_MODP) + ((size_t)(kc * 2 + l) * 5) * 12288 + cg * 4;
        *(f32x4*)o = a0; *(f32x4*)(o + 12288) = a1; *(f32x4*)(o + 2 * 12288) = a2; *(f32x4*)(o + 3 * 12288) = a3; *(f32x4*)(o + 4 * 12288) = a4;
    }
    if (blockIdx.x == 0) {
        float* rt = (float*)(p.ws + WS_ROPE);
        for (int i = tid; i < 1024; i += NTHR_) { const int pos = i >> 4, j = i & 15; const float inv = exp2f(-(float)j * (13.287712379549449f / 16.0f)); float s_, c_; sincos_small((float)pos * inv, s_, c_); rt[i] = c_; rt[1024 + i] = s_; }
    }
}
__device__ __forceinline__ void ph_mod_reduce(const P& p, int tid) {
    for (int i = blockIdx.x * NTHR_ + tid; i < 2 * 5 * 12288; i += gridDim.x * NTHR_) {
        const int n = i % 12288, l = (i / 12288) / 5; float acc = p.in[14][l * 12288 + n];
#pragma unroll
        for (int kc = 0; kc < MOD_KS; ++kc) acc += ((const float*)(p.ws + WS_MODP))[(size_t)kc * 2 * 5 * 12288 + i];
        ((float*)(p.ws + WS_MOD))[i] = acc;
    }
}

__device__ __forceinline__ void ph_hnorm_row(const P& p, int l, int which, int r, int lane) {
    const float* x = which == 0 ? x_src(p, l, r) : (const float*)(p.ws + WS_X) + (size_t)r * D;
    const float* nw = p.in[which == 0 ? 15 : 16] + l * 2048;
    const float* mod = (const float*)(p.ws + WS_MOD) + ((size_t)l * 5 + cond_of_row(r)) * 12288 + (which == 0 ? 0 : 3 * 2048);
    f32x4 v[8]; float ss = 0.f;
#pragma unroll
    for (int j = 0; j < 8; ++j) { v[j] = *(const f32x4*)(x + j * 256 + lane * 4); ss += v[j][0] * v[j][0] + v[j][1] * v[j][1] + v[j][2] * v[j][2] + v[j][3] * v[j][3]; }
    const float rstd = rsqrtf(wave_sum(ss) * (1.0f / 2048.0f) + 1e-6f);
    bf16_t* o = (bf16_t*)(p.ws + WS_H) + (size_t)r * D;
#pragma unroll
    for (int j = 0; j < 8; ++j) { const int c = j * 256 + lane * 4; const f32x4 g = *(const f32x4*)(nw + c), sh = *(const f32x4*)(mod + c), s1 = *(const f32x4*)(mod + 2048 + c);
        float y[4];
#pragma unroll
        for (int e = 0; e < 4; ++e) y[e] = v[j][e] * rstd * g[e] * (1.0f + s1[e]) + sh[e];
        u32x2 w; w.x = pk2(y[0], y[1]); w.y = pk2(y[2], y[3]); *(u32x2*)(o + c) = w; }
}

namespace pg8 {
#define PG8_LAS __attribute__((address_space(3)))
typedef unsigned short bf16_t;
typedef short bf16x8 __attribute__((ext_vector_type(8)));
typedef float f32x4 __attribute__((ext_vector_type(4)));
typedef unsigned u32x4 __attribute__((ext_vector_type(4)));
constexpr int BM = 256, BK = 64, HALF = 128, HTB = HALF * BK * 2  , STAGE_BYTES = 8 * HTB, NXCD = 8, WGM = 8;

__host__ __device__ __forceinline__ int lds_byte(int r, int c) { const int st = (r >> 4) * 2 + (c >> 5), rr = r & 15, cc = c & 31, ob = rr * 64 + cc * 2; return st * 1024 + (ob ^ (((ob >> 9) & 1) << 5)); }
__host__ __device__ __forceinline__ void stage_rc(int b, int& R, int& C) { const int st = b / 1024, sb = b % 1024, swz = sb ^ (((sb >> 9) & 1) << 5); R = (st >> 1) * 16 + swz / 64; C = (st & 1) * 32 + (swz % 64) / 2; }
__host__ __device__ __forceinline__ int perm32(int rho) { const int n = rho >> 4, i = rho & 15; return 8 * (i >> 2) + 4 * n + (i & 3); }

struct Unit { int pm, pn; };
struct Gemm { const bf16_t* A; const bf16_t* Bt; int M, N, K; };

struct StaticOrder {
    int nM, nN, nwg, G, c;
    __host__ __device__ void init(int M, int N, int G_, int c_) { nM = M / BM; nN = N / BM; nwg = nM * nN; G = G_; c = c_; }
    __host__ __device__ bool next(int i, Unit& u) const {
        const long L = (long)i * G + c; if (L >= nwg) return false;
        int wgid = (int)L; { const int q = nwg / NXCD, r = nwg % NXCD, xcd = wgid % NXCD, off = wgid / NXCD; wgid = (xcd < r ? xcd * (q + 1) : r * (q + 1) + (xcd - r) * q) + off; }
        const int nig = WGM * nN, gid = wgid / nig, fm = gid * WGM, gsz = (nM - fm) < WGM ? (nM - fm) : WGM;
        u.pm = fm + ((wgid % nig) % gsz); u.pn = (wgid % nig) / gsz; return true;
    }
    __device__ __forceinline__ void a_ready(const Unit&) const {}
    __device__ __forceinline__ void done(const Unit&) const {}
};

__device__ __forceinline__ unsigned cvt_pk_bf16(float lo, float hi) { unsigned r; asm volatile("s_nop 0\n\tv_cvt_pk_bf16_f32 %0, %1, %2" : "=v"(r) : "v"(lo), "v"(hi)); return r; }

template <class Epi, class Sched, bool ALIGN_EPI = false, bool SP2 = false>
__device__ __forceinline__ void gemm_phase(PG8_LAS unsigned char* lds, const Gemm g, const Sched& S, const Epi& E, int tid_in) {
    int tid_l = tid_in; asm volatile("" : "+v"(tid_l));
    const int tid = tid_l, wid = __builtin_amdgcn_readfirstlane(tid >> 6), lane = tid & 63, wr = wid >> 2, wc = wid & 3, fr = lane & 15, fq = lane >> 4;
    const int K = g.K, nt = K / BK;
    unsigned voffA[2], voffB[2];
#pragma unroll
    for (int i = 0; i < 2; ++i) { int R, C; stage_rc(tid * 16 + i * 8192, R, C); const int Rb = Epi::PERM ? ((R & ~31) + perm32(R & 31)) : R;
        voffA[i] = (unsigned)(R * K + C) * 2u; voffB[i] = (unsigned)(Rb * K + C) * 2u; }
    const size_t kstep = (size_t)(BK * 2);
    const size_t hstep = (size_t)HALF * K * 2;
    const size_t tstep = 2 * hstep;
    const unsigned ldsw = (unsigned)wid * 1024u;
    const int aoff = lds_byte(wr * 64 + fr, fq * 8), boff = lds_byte(wc * 32 + fr, fq * 8);
#define PG8_SA(b, h) (((b) * 2 + (h)) * HTB)
#define PG8_SB(b, h) ((4 + (b) * 2 + (h)) * HTB)
#define PG8_STAGE(bufoff, gbase, voff) do { _Pragma("unroll") for (int _i = 0; _i < 2; ++_i) \
        __builtin_amdgcn_global_load_lds((const unsigned*)((const char*)(gbase) + (voff)[_i]), (PG8_LAS unsigned*)(lds + (bufoff) + ldsw + _i * 8192), 16, 0, 0); } while (0)
#define PG8_LDA(dst, b, h) do { _Pragma("unroll") for (int m = 0; m < 4; ++m) _Pragma("unroll") for (int k = 0; k < 2; ++k) dst[m][k] = *(const PG8_LAS bf16x8*)(lds + PG8_SA(b, h) + aoff + m * 2048 + k * 1024); } while (0)
#define PG8_LDB(dst, b, h) do { _Pragma("unroll") for (int n = 0; n < 2; ++n) _Pragma("unroll") for (int k = 0; k < 2; ++k) dst[n][k] = *(const PG8_LAS bf16x8*)(lds + PG8_SB(b, h) + boff + n * 2048 + k * 1024); } while (0)
#define PG8_MMA(ai, bj, At, Bt) do { __builtin_amdgcn_s_setprio(1); _Pragma("unroll") for (int m = 0; m < 4; ++m) _Pragma("unroll") for (int n = 0; n < 2; ++n) _Pragma("unroll") for (int k = 0; k < 2; ++k) \
        acc[ai][bj][m][n] = __builtin_amdgcn_mfma_f32_16x16x32_bf16(Bt[n][k], At[m][k], acc[ai][bj][m][n], 0, 0, 0); __builtin_amdgcn_s_setprio(0); } while (0)
#define PG8_WAIT_V(n) asm volatile("s_waitcnt vmcnt(" #n ")" ::: "memory")
#define PG8_WAIT_L(n) asm volatile("s_waitcnt lgkmcnt(" #n ")" ::: "memory")
#define PG8_BAR __builtin_amdgcn_s_barrier()
#define PG8_SCHED __builtin_amdgcn_sched_barrier(0)
    Unit cur, nxt; int ui = 0;
    if (!S.next(0, cur)) return;
    f32x4 acc[2][2][4][2];
    { float z0 = 0.f; asm volatile("" : "+v"(z0));
#pragma unroll
    for (int a = 0; a < 2; ++a)
#pragma unroll
        for (int b = 0; b < 2; ++b)
#pragma unroll
            for (int m = 0; m < 4; ++m)
#pragma unroll
                for (int n = 0; n < 2; ++n) acc[a][b][m][n] = (f32x4){z0, z0, z0, z0}; }
    bf16x8 At[4][2], B0[2][2], B1[2][2];
    const char* cA = (const char*)g.A + (size_t)cur.pm * tstep; const char* cB = (const char*)g.Bt + (size_t)cur.pn * tstep;
    S.a_ready(cur);
    if constexpr (SP2) {
        PG8_STAGE(PG8_SB(0, 0), cB, voffB); PG8_STAGE(PG8_SB(0, 1), cB + hstep, voffB); PG8_STAGE(PG8_SA(0, 0), cA, voffA); PG8_STAGE(PG8_SA(0, 1), cA + hstep, voffA);
        if (wr == 1) PG8_BAR;
        PG8_WAIT_V(2); PG8_BAR;
        PG8_STAGE(PG8_SB(1, 0), cB + kstep, voffB); PG8_STAGE(PG8_SA(1, 0), cA + kstep, voffA); PG8_STAGE(PG8_SB(1, 1), cB + hstep + kstep, voffB);
        PG8_WAIT_V(6); PG8_BAR;
    } else {
        PG8_STAGE(PG8_SB(0, 0), cB, voffB); PG8_STAGE(PG8_SA(0, 0), cA, voffA); PG8_STAGE(PG8_SB(0, 1), cB + hstep, voffB); PG8_STAGE(PG8_SA(0, 1), cA + hstep, voffA);
        if (wr == 1) PG8_BAR;
        PG8_WAIT_V(4); PG8_BAR;
        PG8_STAGE(PG8_SB(1, 0), cB + kstep, voffB); PG8_STAGE(PG8_SA(1, 0), cA + kstep, voffA); PG8_STAGE(PG8_SB(1, 1), cB + hstep + kstep, voffB);
        PG8_WAIT_V(6); PG8_BAR;
    }
    for (;;) {
        const bool has_next = S.next(ui + 1, nxt);
        const char* nA = has_next ? (const char*)g.A + (size_t)nxt.pm * tstep : cA; const char* nB = has_next ? (const char*)g.Bt + (size_t)nxt.pn * tstep : cB;
        for (int t = 0; t < nt; t += 2) {
            const bool last = (t == nt - 2);
            const char* a1 = cA + (size_t)(t + 1) * kstep;
            const char* a2 = last ? nA : cA + (size_t)(t + 2) * kstep; const char* b2 = last ? nB : cB + (size_t)(t + 2) * kstep;
            const char* a3 = a2 + kstep; const char* b3 = b2 + kstep;
            if (last && has_next) S.a_ready(nxt);
            if constexpr (SP2) {
            PG8_LDB(B0, 0, 0); PG8_LDB(B1, 0, 1); PG8_SCHED; PG8_LDA(At, 0, 0); PG8_STAGE(PG8_SA(1, 1), a1 + hstep, voffA);
            PG8_WAIT_V(8); PG8_WAIT_L(0); PG8_BAR; PG8_MMA(0, 0, At, B0); PG8_MMA(0, 1, At, B1); PG8_BAR; PG8_SCHED;
            PG8_LDA(At, 0, 1); PG8_STAGE(PG8_SB(0, 0), b2, voffB); PG8_STAGE(PG8_SB(0, 1), b2 + hstep, voffB); PG8_STAGE(PG8_SA(0, 0), a2, voffA);
            PG8_WAIT_V(8); PG8_WAIT_L(0); PG8_BAR; PG8_MMA(1, 0, At, B0); PG8_MMA(1, 1, At, B1); PG8_BAR; PG8_SCHED;
            PG8_LDB(B0, 1, 0); PG8_LDB(B1, 1, 1); PG8_SCHED; PG8_LDA(At, 1, 0); PG8_STAGE(PG8_SA(0, 1), a2 + hstep, voffA);
            PG8_WAIT_V(8); PG8_WAIT_L(0); PG8_BAR; PG8_MMA(0, 0, At, B0); PG8_MMA(0, 1, At, B1); PG8_BAR; PG8_SCHED;
            PG8_LDA(At, 1, 1); PG8_STAGE(PG8_SB(1, 0), b3, voffB); PG8_STAGE(PG8_SB(1, 1), b3 + hstep, voffB); PG8_STAGE(PG8_SA(1, 0), a3, voffA);
            PG8_WAIT_V(8); PG8_WAIT_L(0); PG8_BAR; PG8_MMA(1, 0, At, B0); PG8_MMA(1, 1, At, B1); PG8_BAR; PG8_SCHED;
            } else {
            PG8_LDB(B0, 0, 0); PG8_SCHED; PG8_LDA(At, 0, 0); PG8_STAGE(PG8_SA(1, 1), a1 + hstep, voffA);
            PG8_WAIT_L(8); PG8_BAR; PG8_WAIT_L(0); PG8_MMA(0, 0, At, B0); PG8_BAR; PG8_SCHED;
            PG8_LDB(B1, 0, 1); PG8_STAGE(PG8_SB(0, 0), b2, voffB);
            PG8_BAR; PG8_WAIT_L(0); PG8_MMA(0, 1, At, B1); PG8_BAR;
            PG8_LDA(At, 0, 1); PG8_STAGE(PG8_SA(0, 0), a2, voffA);
            PG8_BAR; PG8_WAIT_L(0); PG8_MMA(1, 0, At, B0); PG8_BAR; PG8_SCHED;
            PG8_STAGE(PG8_SB(0, 1), b2 + hstep, voffB);
            PG8_WAIT_V(6); PG8_BAR; PG8_MMA(1, 1, At, B1); PG8_BAR;
            PG8_LDB(B0, 1, 0); PG8_SCHED; PG8_LDA(At, 1, 0); PG8_STAGE(PG8_SA(0, 1), a2 + hstep, voffA);
            PG8_WAIT_L(8); PG8_BAR; PG8_WAIT_L(0); PG8_MMA(0, 0, At, B0); PG8_BAR; PG8_SCHED;
            PG8_LDB(B1, 1, 1); PG8_STAGE(PG8_SB(1, 0), b3, voffB);
            PG8_BAR; PG8_WAIT_L(0); PG8_MMA(0, 1, At, B1); PG8_BAR;
            PG8_LDA(At, 1, 1); PG8_STAGE(PG8_SA(1, 0), a3, voffA);
            PG8_BAR; PG8_WAIT_L(0); PG8_MMA(1, 0, At, B0); PG8_BAR; PG8_SCHED;
            PG8_STAGE(PG8_SB(1, 1), b3 + hstep, voffB);
            PG8_WAIT_V(6); PG8_BAR; PG8_MMA(1, 1, At, B1); PG8_BAR;
            }
        }
        if constexpr (ALIGN_EPI) { if (wr == 0) PG8_BAR; }
        if constexpr (!Epi::AFTER_DRAIN) { E(acc, cur, wr, wc, fr, fq); S.done(cur); }
        if (!has_next) break;
        { float z0 = 0.f; asm volatile("" : "+v"(z0));
#pragma unroll
        for (int a = 0; a < 2; ++a)
#pragma unroll
            for (int b = 0; b < 2; ++b)
#pragma unroll
                for (int m = 0; m < 4; ++m)
#pragma unroll
                    for (int n = 0; n < 2; ++n) acc[a][b][m][n] = (f32x4){z0, z0, z0, z0}; }
        cur = nxt; cA = nA; cB = nB; ++ui;
        if constexpr (ALIGN_EPI) { if (wr == 1) PG8_BAR; }
    }
    PG8_WAIT_V(0);
    if constexpr (!ALIGN_EPI) { if (wr == 0) PG8_BAR; }
    PG8_BAR;
    if constexpr (Epi::AFTER_DRAIN) { E.fused(acc, cur, wr, wc, fr, fq, lds, wid, lane); S.done(cur); }
#undef PG8_SA
#undef PG8_SB
#undef PG8_STAGE
#undef PG8_LDA
#undef PG8_LDB
#undef PG8_MMA
#undef PG8_WAIT_V
#undef PG8_WAIT_L
#undef PG8_BAR
#undef PG8_SCHED
}
}

#define PG8_ROW(ai, m) (u.pm * 256 + (ai) * 128 + wr * 64 + (m) * 16 + fr)
#define PG8_FOR(...) _Pragma("unroll") for (int ai = 0; ai < 2; ++ai) _Pragma("unroll") for (int m = 0; m < 4; ++m) { const int row = PG8_ROW(ai, m); _Pragma("unroll") for (int bj = 0; bj < 2; ++bj) { \
    const int ct = bj * 128 + wc * 32 + 8 * fq; const pg8::f32x4 v0 = acc[ai][bj][m][0], v1 = acc[ai][bj][m][1]; __VA_ARGS__ } }
__device__ __forceinline__ u32x4 pack8(const pg8::f32x4& a, const pg8::f32x4& b) { u32x4 w; w.x = pg8::cvt_pk_bf16(a[0], a[1]); w.y = pg8::cvt_pk_bf16(a[2], a[3]); w.z = pg8::cvt_pk_bf16(b[0], b[1]); w.w = pg8::cvt_pk_bf16(b[2], b[3]); return w; }
__device__ __forceinline__ void unpack8(const u32x4& w, float (&f)[8]) {
#pragma unroll
    for (int i = 0; i < 4; ++i) { f[2 * i] = bf2f(w[i]); f[2 * i + 1] = bf2f(w[i] >> 16); } }

struct Epi8In {
    static constexpr bool PERM = true, AFTER_DRAIN = false;
    unsigned char* ws;
    __device__ __forceinline__ void operator()(const pg8::f32x4 (&acc)[2][2][4][2], const pg8::Unit& u, int wr, int wc, int fr, int fq) const {
        const int pn = u.pn;
        if (pn >= 22 && pn < 25) {
            float* kva = (float*)(ws + WS_KVA);
            PG8_FOR({ float* o = kva + (size_t)row * KVAW + (pn - 22) * 256 + ct; *(pg8::f32x4*)o = v0; *(pg8::f32x4*)(o + 4) = v1; })
            return;
        }
        size_t base; int ldc, c0, mode = 0;
        if (pn < 4) { base = WS_MLQ; ldc = 1024; c0 = pn * 256; }
        else if (pn < 8) { base = WS_MLK; ldc = 1024; c0 = (pn - 4) * 256; mode = 1; }
        else if (pn < 12) { base = WS_MLV; ldc = 1024; c0 = (pn - 8) * 256; }
        else if (pn < 16) { base = WS_MLO; ldc = 1024; c0 = (pn - 12) * 256; mode = 2; }
        else if (pn < 22) { base = WS_MQ; ldc = 1536; c0 = (pn - 16) * 256; mode = 3; }
        else if (pn < 29) { base = WS_S5U; ldc = 1024; c0 = (pn - 25) * 256; }
        else if (pn < 33) { base = WS_DFQ; ldc = 1024; c0 = (pn - 29) * 256; mode = 4; }
        else if (pn < 37) { base = WS_DFK; ldc = 1024; c0 = (pn - 33) * 256; }
        else { base = WS_DFV; ldc = 1024; c0 = (pn - 37) * 256; }
        bf16_t* O = (bf16_t*)(ws + base);
        PG8_FOR({ pg8::f32x4 a = v0, b = v1;
            if (mode == 1) { a = a * 0.0625f; b = b * 0.0625f; }
            if (mode == 3) { a = a * (0.07216878364870322f * 1.4426950408889634f); b = b * (0.07216878364870322f * 1.4426950408889634f); }
            if (mode == 4) { a = a * (0.125f * 1.4426950408889634f); b = b * (0.125f * 1.4426950408889634f); }
            if (mode == 2) {
_Pragma("unroll")
                for (int e = 0; e < 4; ++e) { a[e] = sigmoidf_(a[e]); b[e] = sigmoidf_(b[e]); } }
            *(u32x4*)(O + (size_t)row * ldc + c0 + ct) = pack8(a, b); })
    }
};
struct Epi8Gate {
    static constexpr bool PERM = true, AFTER_DRAIN = false;
    bf16_t* gs;
    __device__ __forceinline__ void operator()(const pg8::f32x4 (&acc)[2][2][4][2], const pg8::Unit& u, int wr, int wc, int fr, int fq) const {
        PG8_FOR({ pg8::f32x4 a, b;
_Pragma("unroll")
            for (int e = 0; e < 4; ++e) { a[e] = sigmoidf_(v0[e]); b[e] = sigmoidf_(v1[e]); }
            *(u32x4*)(gs + (size_t)row * GATE_COLS + u.pn * 256 + ct) = pack8(a, b); })
    }
};
struct Epi8Kvb {
    static constexpr bool PERM = true, AFTER_DRAIN = false;
    bf16_t* kf; bf16_t* vf;
    __device__ __forceinline__ void operator()(const pg8::f32x4 (&acc)[2][2][4][2], const pg8::Unit& u, int wr, int wc, int fr, int fq) const {
        PG8_FOR({ bf16_t* o = bj == 0 ? kf + (size_t)row * 1536 + u.pn * 192 + wc * 32 + 8 * fq : vf + (size_t)row * 1024 + u.pn * 128 + wc * 32 + 8 * fq; (void)ct;
            *(u32x4*)o = pack8(v0, v1); })
    }
};
struct Epi8Glu {
    static constexpr bool PERM = true, AFTER_DRAIN = false;
    const bf16_t* g; bf16_t* y;
    __device__ __forceinline__ void operator()(const pg8::f32x4 (&acc)[2][2][4][2], const pg8::Unit& u, int wr, int wc, int fr, int fq) const {
        PG8_FOR({ const size_t i = (size_t)row * 1024 + u.pn * 256 + ct; float gf[8]; unpack8(*(const u32x4*)(g + i), gf); pg8::f32x4 a, b;
_Pragma("unroll")
            for (int e = 0; e < 4; ++e) { a[e] = gf[e] * sigmoidf_(v0[e]); b[e] = gf[4 + e] * sigmoidf_(v1[e]); }
            *(u32x4*)(y + i) = pack8(a, b); })
    }
};
struct Epi8Merge {
    static constexpr bool PERM = true, AFTER_DRAIN = false;
    const bf16_t* gs; bf16_t* mg; int b; int pad;
    __device__ __forceinline__ void operator()(const pg8::f32x4 (&acc)[2][2][4][2], const pg8::Unit& u, int wr, int wc, int fr, int fq) const {
        PG8_FOR({ const size_t i = (size_t)row * D + u.pn * 256 + ct; float gf[8], pf[8]; unpack8(*(const u32x4*)(gs + (size_t)row * GATE_COLS + b * D + u.pn * 256 + ct), gf);
            if (b) unpack8(*(const u32x4*)(mg + i), pf); else {
_Pragma("unroll")
                for (int e = 0; e < 8; ++e) pf[e] = 0.f; }
            pg8::f32x4 a, c;
_Pragma("unroll")
            for (int e = 0; e < 4; ++e) { a[e] = pf[e] + gf[e] * v0[e]; c[e] = pf[4 + e] + gf[4 + e] * v1[e]; }
            *(u32x4*)(mg + i) = pack8(a, c); })
    }
};
struct Epi8Res {
    static constexpr bool PERM = true, AFTER_DRAIN = false;
    P p; int l; int goff; int from_x; int pad;
    __device__ __forceinline__ void operator()(const pg8::f32x4 (&acc)[2][2][4][2], const pg8::Unit& u, int wr, int wc, int fr, int fq) const {
        float* X = (float*)(p.ws + WS_X);
        const float* gv = (const float*)(p.ws + WS_MOD) + ((size_t)l * 5 + cond_of_row(u.pm * 256)) * 12288 + goff + u.pn * 256;
        PG8_FOR({ const float* src = (from_x ? X + (size_t)row * D : x_src(p, l, row)) + u.pn * 256 + ct; float* dst = X + (size_t)row * D + u.pn * 256 + ct;
            const pg8::f32x4 g0 = *(const pg8::f32x4*)(gv + ct), g1 = *(const pg8::f32x4*)(gv + ct + 4), s0 = *(const pg8::f32x4*)src, s1 = *(const pg8::f32x4*)(src + 4);
            *(pg8::f32x4*)dst = s0 + g0 * v0; *(pg8::f32x4*)(dst + 4) = s1 + g1 * v1; })
    }
};
struct Epi8FfnIn {
    static constexpr bool PERM = true, AFTER_DRAIN = false;
    bf16_t* hh;
    __device__ __forceinline__ void operator()(const pg8::f32x4 (&acc)[2][2][4][2], const pg8::Unit& u, int wr, int wc, int fr, int fq) const {
_Pragma("unroll")
        for (int ai = 0; ai < 2; ++ai)
_Pragma("unroll")
            for (int m = 0; m < 4; ++m) { const int row = PG8_ROW(ai, m); pg8::f32x4 a, b;
_Pragma("unroll")
                for (int e = 0; e < 4; ++e) { a[e] = siluf_(acc[ai][0][m][0][e]) * acc[ai][1][m][0][e]; b[e] = siluf_(acc[ai][0][m][1][e]) * acc[ai][1][m][1][e]; }
                *(u32x4*)(hh + (size_t)row * FFN + u.pn * 128 + wc * 32 + 8 * fq) = pack8(a, b); }
    }
};

__device__ __forceinline__ int win_row(int n) {
    if (n < 4096) return n;
    if (n < 4112) return 6208 + (n - 4096);
    if (n < 5648) return 4096 + (n - 4112);
    if (n < 6224) return 5632 + (n - 5648);
    if (n < MIX_COLS) return 6400 + (n - 6224);
    return 10496 + (n - MIX_COLS);
}
template <int MAP>
__device__ __forceinline__ void cvt_item(const float* W, int K, int N, bf16_t* WT, int row_off, LAS float* scr, int item, int lane) {
    const int nblk = (N + 31) / 32, kb = item / nblk, nb = item % nblk, k0 = 64 * kb, n0 = 32 * nb;
    const int nl = (lane & 7) * 4, kr = lane >> 3;
    const bool nok = n0 + nl < N;
    const float* wp = W + (size_t)(k0 + kr) * N + n0 + nl;
    f32x4 v[8];
#pragma unroll
    for (int i = 0; i < 8; ++i) v[i] = nok ? *(const f32x4*)(wp + (size_t)(8 * i) * N) : (f32x4){0.f, 0.f, 0.f, 0.f};
#pragma unroll
    for (int i = 0; i < 8; ++i) { LAS float* d = scr + (kr + 8 * i) * 33 + nl; d[0] = v[i][0]; d[1] = v[i][1]; d[2] = v[i][2]; d[3] = v[i][3]; }
    asm volatile("s_waitcnt lgkmcnt(0)" ::: "memory");
    const int c = lane & 7;
#pragma unroll
    for (int j = 0; j < 4; ++j) { const int n = (lane >> 3) + 8 * j; const LAS float* s = scr + (8 * c) * 33 + n;
        u32x4 o; o.x = pk2(s[0 * 33], s[1 * 33]); o.y = pk2(s[2 * 33], s[3 * 33]); o.z = pk2(s[4 * 33], s[5 * 33]); o.w = pk2(s[6 * 33], s[7 * 33]);
        const int ng = n0 + n; int row;
        if (MAP == 0) row = row_off + ng; else if (MAP == 1) row = win_row(ng); else row = (ng < FFN) ? ((ng >> 7) * 256 + (ng & 127)) : (((ng - FFN) >> 7) * 256 + 128 + ((ng - FFN) & 127));
        if (ng < N) *(u32x4*)(WT + (size_t)row * K + k0 + 8 * c) = o; }
    asm volatile("s_waitcnt lgkmcnt(0)" ::: "memory");
}
constexpr size_t WB_IN = 0, WB_KVB = 73 * MiB, WB_GLU = 75 * MiB, WB_BR = 77 * MiB, WB_O = 93 * MiB, WB_FIN = 101 * MiB, WB_FOUT = 145 * MiB, WB_END = 167 * MiB;
constexpr int NIN_T = 18688;
__device__ __forceinline__ void ph_convert(const P& p, int l, int gw, int NGW, int lane, LAS float* scr, const bool early, const bool late) {
    unsigned char* wb = p.ws + WS_WBF;
    constexpr int I_IN = (D / 64) * ((IN_COLS + 31) / 32), I_KVB = (512 / 64) * (2048 / 32), I_GLU = (1024 / 64) * (1024 / 32), I_BR = (1024 / 64) * (2048 / 32), I_O = (D / 64) * (D / 32),
                  I_FIN = (D / 64) * (2 * FFN / 32), I_FOUT = (FFN / 64) * (D / 32);
    constexpr int NIT = I_IN + I_KVB + I_GLU + 4 * I_BR + I_O + I_FIN + I_FOUT;
    const int it_lo = early ? 0 : NIT - I_FOUT, it_hi = late ? NIT : NIT - I_FOUT;
    for (int it = it_lo + gw; it < it_hi; it += NGW) {
        int r = it;
        if (r < I_IN) { cvt_item<1>(p.in[17] + (size_t)l * D * IN_COLS, D, IN_COLS, (bf16_t*)(wb + WB_IN), 0, scr, r, lane); continue; } r -= I_IN;
        if (r < I_KVB) { cvt_item<0>(p.in[21] + (size_t)l * 512 * 2048, 512, 2048, (bf16_t*)(wb + WB_KVB), 0, scr, r, lane); continue; } r -= I_KVB;
        if (r < I_GLU) { cvt_item<0>(p.in[30] + (size_t)l * 1024 * 1024, 1024, 1024, (bf16_t*)(wb + WB_GLU), 0, scr, r, lane); continue; } r -= I_GLU;
        if (r < 4 * I_BR) { const int b = r / I_BR; cvt_item<0>(p.in[33] + ((size_t)l * 4 + b) * 1024 * 2048, 1024, 2048, (bf16_t*)(wb + WB_BR) + (size_t)b * 2048 * 1024, 0, scr, r % I_BR, lane); continue; } r -= 4 * I_BR;
        if (r < I_O) { cvt_item<0>(p.in[34] + (size_t)l * D * D, D, D, (bf16_t*)(wb + WB_O), 0, scr, r, lane); continue; } r -= I_O;
        if (r < I_FIN) { cvt_item<2>(p.in[35] + (size_t)l * D * 2 * FFN, D, 2 * FFN, (bf16_t*)(wb + WB_FIN), 0, scr, r, lane); continue; } r -= I_FIN;
        cvt_item<0>(p.in[36] + (size_t)l * FFN * D, FFN, D, (bf16_t*)(wb + WB_FOUT), 0, scr, r, lane);
    }
    if (early) for (int row = 6224 + gw; row < 6400; row += NGW) { u32x4* o = (u32x4*)((bf16_t*)(wb + WB_IN) + (size_t)row * D); for (int j = lane; j < D / 8; j += 64) o[j] = (u32x4){0u, 0u, 0u, 0u}; }
}


__device__ __forceinline__ int xcd_slot() { const int G_ = (int)gridDim.x, c_ = (int)blockIdx.x; return (G_ % 8 == 0) ? (c_ % 8) * (G_ / 8) + c_ / 8 : c_; }
namespace fa {
typedef short s16x4 __attribute__((ext_vector_type(4)));
__device__ __forceinline__ int crow(int r, int hi) { return (r & 3) + 8 * (r >> 2) + 4 * hi; }
__device__ __forceinline__ unsigned cvtpk(float lo, float hi) { unsigned r; asm volatile("v_cvt_pk_bf16_f32 %0, %1, %2" : "=v"(r) : "v"(lo), "v"(hi)); return r; }
#define FA_SBAR() __builtin_amdgcn_sched_barrier(0)
constexpr float THR = 8.f;
__device__ __forceinline__ void partialSM_fma(f32x16& p0, f32x16& p1, float& m_reg, float& mn, float& alpha, float SCALE) {
    const float C = SCALE * 1.4426950408889634f;
    float pmax = p0[0];
#pragma unroll
    for (int r = 1; r < 16; ++r) pmax = fmaxf(pmax, p0[r]);
#pragma unroll
    for (int r = 0; r < 16; ++r) pmax = fmaxf(pmax, p1[r]);
    { auto rr = __builtin_amdgcn_permlane32_swap(__float_as_uint(pmax), __float_as_uint(pmax), false, false);
      pmax = fmaxf(__uint_as_float(rr[0]), __uint_as_float(rr[1])); }
    if (__builtin_expect(__all(pmax - m_reg <= THR / SCALE), 1)) { mn = m_reg; alpha = 1.f; }
    else { mn = fmaxf(m_reg, pmax); alpha = __builtin_amdgcn_exp2f((m_reg - mn) * C); m_reg = mn; }
    const float mnC = -mn * C;
#pragma unroll
    for (int r = 0; r < 16; ++r) p0[r] = fmaf(p0[r], C, mnC);
#pragma unroll
    for (int r = 0; r < 16; ++r) p1[r] = fmaf(p1[r], C, mnC);
#pragma unroll
    for (int r = 0; r < 16; ++r) p0[r] = __builtin_amdgcn_exp2f(p0[r]);
}
constexpr float THR2 = THR * 1.4426950408889634f;
__device__ __forceinline__ void partialSM(f32x16& p0, f32x16& p1, float& m_reg, f32x16& nm, float& alpha, const bool first) {
    float pmax = p0[0];
#pragma unroll
    for (int r = 1; r < 16; ++r) pmax = fmaxf(pmax, p0[r]);
#pragma unroll
    for (int r = 0; r < 16; ++r) pmax = fmaxf(pmax, p1[r]);
    { auto rr = __builtin_amdgcn_permlane32_swap(__float_as_uint(pmax), __float_as_uint(pmax), false, false);
      pmax = fmaxf(__uint_as_float(rr[0]), __uint_as_float(rr[1])); }
    alpha = 1.f;
    if (first || !__all(pmax <= THR2)) {
        const float d = first ? pmax : fmaxf(pmax, 0.f);
        if (!first) alpha = __builtin_amdgcn_exp2f(-d);
        m_reg += d;
#pragma unroll
        for (int r = 0; r < 16; ++r) { p0[r] -= d; p1[r] -= d; nm[r] = -m_reg; }
    }
#pragma unroll
    for (int r = 0; r < 16; ++r) p0[r] = __builtin_amdgcn_exp2f(p0[r]);
}
__device__ __forceinline__ void finishSM(f32x16& p0, f32x16& p1, float alpha, float& l_reg, bf16x8& pa0, bf16x8& pa1, bf16x8& pa2, bf16x8& pa3) {
#pragma unroll
    for (int r = 0; r < 16; ++r) p1[r] = __builtin_amdgcn_exp2f(p1[r]);
    FA_SBAR(); asm volatile("s_nop 1");
    float ps = 0;
#pragma unroll
    for (int r = 0; r < 16; ++r) ps += p0[r];
#pragma unroll
    for (int r = 0; r < 16; ++r) ps += p1[r];
    { auto rr = __builtin_amdgcn_permlane32_swap(__float_as_uint(ps), __float_as_uint(ps), false, false);
      ps = __uint_as_float(rr[0]) + __uint_as_float(rr[1]); }
    l_reg = l_reg * alpha + ps;
#define FA_PK4(P, BASE, OUT) do { u32x4 w = {cvtpk(P[BASE + 0], P[BASE + 1]), cvtpk(P[BASE + 2], P[BASE + 3]), cvtpk(P[BASE + 4], P[BASE + 5]), cvtpk(P[BASE + 6], P[BASE + 7])}; \
    OUT = *reinterpret_cast<bf16x8*>(&w); } while (0)
    FA_PK4(p0, 0, pa0); FA_PK4(p0, 8, pa1); FA_PK4(p1, 0, pa2); FA_PK4(p1, 8, pa3);
#undef FA_PK4
}
__device__ __forceinline__ int v_rd_base(int lane) { return ((lane & 3) << 3) | (((lane >> 2) & 3) << 6) | (((lane >> 4) & 1) << 5) | (((lane >> 5) & 1) << 8); }
constexpr int v_rd_off(int d0, int ks, int half) { return d0 * 512 + ks * 4096 + half * 2048; }
__device__ __forceinline__ bf16x8 lds_rd128i(unsigned addr, const int off) { bf16x8 r; asm volatile("ds_read_b128 %0, %1 offset:%2" : "=&v"(r) : "v"(addr), "i"(off) : "memory"); return r; }
template <int OFF> __device__ __forceinline__ bf16x8 lds_rd128(unsigned addr) { bf16x8 r; asm volatile("ds_read_b128 %0, %1 offset:%2" : "=&v"(r) : "v"(addr), "i"(OFF) : "memory"); return r; }
template <int OFF> __device__ __forceinline__ s16x4 tr_read(unsigned vb) {
    s16x4 r; asm volatile("ds_read_b64_tr_b16 %0, %1 offset:%2" : "=&v"(r) : "v"(vb), "i"(OFF) : "memory"); return r;
}
template <int D0> __device__ __forceinline__ void pv_one(f32x16& od, unsigned vb, bf16x8 pa0, bf16x8 pa1, bf16x8 pa2, bf16x8 pa3) {
    const s16x4 l0 = tr_read<v_rd_off(D0, 0, 0)>(vb), h0 = tr_read<v_rd_off(D0, 0, 1)>(vb), l1 = tr_read<v_rd_off(D0, 1, 0)>(vb), h1 = tr_read<v_rd_off(D0, 1, 1)>(vb);
    const s16x4 l2 = tr_read<v_rd_off(D0, 2, 0)>(vb), h2 = tr_read<v_rd_off(D0, 2, 1)>(vb), l3 = tr_read<v_rd_off(D0, 3, 0)>(vb), h3 = tr_read<v_rd_off(D0, 3, 1)>(vb);
    asm volatile("s_waitcnt lgkmcnt(0)" ::: "memory"); FA_SBAR();
#define FA_PK(L, H) (bf16x8){L[0], L[1], L[2], L[3], H[0], H[1], H[2], H[3]}
    od = __builtin_amdgcn_mfma_f32_32x32x16_bf16(pa0, FA_PK(l0, h0), od, 0, 0, 0);
    od = __builtin_amdgcn_mfma_f32_32x32x16_bf16(pa1, FA_PK(l1, h1), od, 0, 0, 0);
    od = __builtin_amdgcn_mfma_f32_32x32x16_bf16(pa2, FA_PK(l2, h2), od, 0, 0, 0);
    od = __builtin_amdgcn_mfma_f32_32x32x16_bf16(pa3, FA_PK(l3, h3), od, 0, 0, 0);
#undef FA_PK
}
struct Args { const bf16_t* Q; const bf16_t* K; const bf16_t* V; bf16_t* O; int qpitch, kpitch, vpitch, opitch, nheads, vdiv; float scale; int pad; };

template <int DQK>
__device__ __forceinline__ void attn_phase(LAS unsigned char* lds, const Args& a, int tid) {
    constexpr int KROWB = DQK * 2, KCH = KROWB / 16, KTILE = 64 * KROWB, VTILE = 16384, STAGE = KTILE + VTILE, NKI = KTILE / 8192, NVI = 2, NDMA = NKI + NVI, ND = DQK / 16;
    constexpr int RING = (DQK == 64) ? 4 : 3;
    static_assert(RING * STAGE + 2048 <= 131072, "attention LDS");
    const int wid = __builtin_amdgcn_readfirstlane(tid >> 6), lane = tid & 63, r32 = lane & 31, hi = lane >> 5;
    const int krow = (r32 & ~0xC) | ((r32 & 4) << 1) | ((r32 & 8) >> 1);
    LAS float* wsc = (LAS float*)(lds + RING * STAGE) + wid * 64;
    unsigned koff_[NKI], voff_[NVI];
#pragma unroll
    for (int i = 0; i < NKI; ++i) { const int s = i * 512 + wid * 64 + lane, row = s / KCH, ch = s % KCH; koff_[i] = (unsigned)(row * a.kpitch + (ch ^ ((row & 3) | (((row >> 3) & 1) << 2))) * 8) * 2u; }
#pragma unroll
    for (int i = 0; i < NVI; ++i) { const int o = (i * 512 + wid * 64 + lane) * 16, sub = o >> 9, within = o & 511, kk = (sub >> 2) * 8 + (within >> 6), c = (sub & 3) * 32 + ((within & 63) >> 1);
        const int k = (kk & ~0xC) | ((kk & 4) << 1) | ((kk & 8) >> 1); voff_[i] = (unsigned)(k * a.vpitch + c) * 2u; }
    const unsigned vb0 = (unsigned)(uintptr_t)(lds + KTILE) + (unsigned)v_rd_base(lane);
    const int n_lat = a.nheads * 64, n_units = n_lat + a.nheads * 16;
    for (int u = xcd_slot(); u < n_units; u += gridDim.x) {
        int b, h, q0, nk, kbase, cbase;
        if (u < n_lat) { const int bh = u >> 4, qb = u & 15; b = bh / a.nheads; h = bh % a.nheads; q0 = NCTX + b * LL + qb * 256; nk = LL + PAST; kbase = NCTX + b * LL; cbase = MTOK + b * PAST; }
        else { const int v = u - n_lat; b = v / a.nheads; h = v % a.nheads; q0 = b * CL; nk = CL; kbase = b * CL; cbase = 0; }
        const int NT = nk >> 6, vh = h / a.vdiv;
        const bf16_t* Kh = a.K + h * DQK; const bf16_t* Vh = a.V + vh * 128;
#define FA_ISSUE(j) do { const int t0_ = (j) * 64; const int rb_ = (t0_ < LL || nk == CL) ? kbase + t0_ : cbase + (t0_ - LL); LAS unsigned char* st_ = lds + ((j) % RING) * STAGE; \
        const char* kb_ = (const char*)(Kh + (size_t)rb_ * a.kpitch); const char* vb_ = (const char*)(Vh + (size_t)rb_ * a.vpitch); \
        _Pragma("unroll") for (int i_ = 0; i_ < NKI; ++i_) __builtin_amdgcn_global_load_lds((const unsigned*)(kb_ + koff_[i_]), (LAS unsigned*)(st_ + i_ * 8192 + wid * 1024), 16, 0, 0); \
        _Pragma("unroll") for (int i_ = 0; i_ < NVI; ++i_) __builtin_amdgcn_global_load_lds((const unsigned*)(vb_ + voff_[i_]), (LAS unsigned*)(st_ + KTILE + i_ * 8192 + wid * 1024), 16, 0, 0); } while (0)
        bf16x8 qr[ND];
        { const bf16_t* Qw = a.Q + (size_t)(q0 + wid * 32 + r32) * a.qpitch + h * DQK + hi * 8;
#pragma unroll
          for (int d0 = 0; d0 < ND; ++d0) qr[d0] = *(const bf16x8*)(Qw + d0 * 16); }
        float m_reg = 0.f, l_reg = 0.f; f32x16 o[4], nm;
        float z0 = 0.f; asm volatile("" : "+v"(z0));
#pragma unroll
        for (int d = 0; d < 4; ++d)
#pragma unroll
            for (int r = 0; r < 16; ++r) o[d][r] = z0;
#pragma unroll
        for (int r = 0; r < 16; ++r) nm[r] = z0;
        FA_ISSUE(0); FA_ISSUE(1);
        if constexpr (DQK != 64) { if (NDMA == 5) asm volatile("s_waitcnt vmcnt(5)" ::: "memory"); else asm volatile("s_waitcnt vmcnt(3)" ::: "memory");
            __builtin_amdgcn_s_barrier(); asm volatile("" ::: "memory"); }
        auto tile = [&](const int j) __attribute__((always_inline)) {
            LAS unsigned char* Ks = lds + (j % RING) * STAGE;
            f32x16 p0 = nm, p1 = nm;
            constexpr int KD = (DQK == 64) ? 3 : 2;
            bf16x8 kb[KD][2];
            unsigned kae[4];
#pragma unroll
            for (int e = 0; e < 4; ++e) kae[e] = (unsigned)(uintptr_t)Ks + (unsigned)(krow * KROWB + (((2 * e + hi) ^ ((krow & 3) | (((krow >> 3) & 1) << 2))) << 4));
#define FA_LDK(d0_, s_) do { kb[s_][0] = lds_rd128i(kae[(d0_) & 3], ((d0_) >> 2) * 128); kb[s_][1] = lds_rd128i(kae[(d0_) & 3], 32 * KROWB + ((d0_) >> 2) * 128); } while (0)
#pragma unroll
            for (int d0 = 0; d0 < KD - 1; ++d0) FA_LDK(d0, d0);
#pragma unroll
            for (int d0 = 0; d0 < ND; ++d0) {
                if (d0 + KD - 1 < ND) FA_LDK(d0 + KD - 1, (d0 + KD - 1) % KD);
                const int ahead = (ND - 1 - d0) < (KD - 1) ? (ND - 1 - d0) : (KD - 1);
                if (ahead == 2) asm volatile("s_waitcnt lgkmcnt(4)" ::: "memory"); else if (ahead == 1) asm volatile("s_waitcnt lgkmcnt(2)" ::: "memory"); else asm volatile("s_waitcnt lgkmcnt(0)" ::: "memory");
                FA_SBAR();
                p0 = __builtin_amdgcn_mfma_f32_32x32x16_bf16(kb[d0 % KD][0], qr[d0], p0, 0, 0, 0);
                p1 = __builtin_amdgcn_mfma_f32_32x32x16_bf16(kb[d0 % KD][1], qr[d0], p1, 0, 0, 0);
                FA_SBAR(); }
#undef FA_LDK
            float alpha; partialSM(p0, p1, m_reg, nm, alpha, j == 0);
            if (__any(alpha < 1.f)) { if (hi == 0) wsc[32 + r32] = alpha; asm volatile("s_waitcnt lgkmcnt(0)" ::: "memory");
#pragma unroll
                for (int d = 0; d < 4; ++d)
#pragma unroll
                    for (int r = 0; r < 16; ++r) o[d][r] *= wsc[32 + crow(r, hi)]; }
            bf16x8 pa0, pa1, pa2, pa3; finishSM(p0, p1, alpha, l_reg, pa0, pa1, pa2, pa3); FA_SBAR();
            const unsigned vb = vb0 + (unsigned)((j % RING) * STAGE);
            pv_one<0>(o[0], vb, pa0, pa1, pa2, pa3); pv_one<1>(o[1], vb, pa0, pa1, pa2, pa3); pv_one<2>(o[2], vb, pa0, pa1, pa2, pa3); pv_one<3>(o[3], vb, pa0, pa1, pa2, pa3);
        };
        if constexpr (DQK == 64) {
            asm volatile("s_waitcnt vmcnt(0)" ::: "memory");
            __builtin_amdgcn_s_barrier(); asm volatile("" ::: "memory");
            for (int j = 0; j < NT; j += 2) {
                if (j + 2 < NT) { FA_ISSUE(j + 2); FA_ISSUE(j + 3); }
                tile(j); tile(j + 1);
                asm volatile("s_waitcnt vmcnt(0)" ::: "memory");
                asm volatile("s_waitcnt lgkmcnt(0)" ::: "memory");
                __builtin_amdgcn_s_barrier(); asm volatile("" ::: "memory");
            }
        } else
        for (int j = 0; j < NT; ++j) {
            if (j + 2 < NT) FA_ISSUE(j + 2);
            tile(j);
            if (j + 2 < NT) { if (NDMA == 5) asm volatile("s_waitcnt vmcnt(5)" ::: "memory"); else asm volatile("s_waitcnt vmcnt(3)" ::: "memory"); }
            else asm volatile("s_waitcnt vmcnt(0)" ::: "memory");
            asm volatile("s_waitcnt lgkmcnt(0)" ::: "memory");
            __builtin_amdgcn_s_barrier(); asm volatile("" ::: "memory");
        }
#undef FA_ISSUE
        if (hi == 0) wsc[r32] = l_reg; asm volatile("s_waitcnt lgkmcnt(0)" ::: "memory");
        bf16_t* Ow = a.O + (size_t)(q0 + wid * 32) * a.opitch + h * 128 + r32;
#pragma unroll
        for (int r = 0; r < 16; ++r) { const int orow = crow(r, hi); const float rl = __builtin_amdgcn_rcpf(wsc[orow]);
#pragma unroll
            for (int d0 = 0; d0 < 4; ++d0) Ow[(size_t)orow * a.opitch + d0 * 32] = (bf16_t)f2bf(o[d0][r] * rl); }
        asm volatile("s_waitcnt lgkmcnt(0)" ::: "memory");
    }
}
}


namespace ml {
typedef short s16x4 __attribute__((ext_vector_type(4)));
constexpr int QP = 528, VP = 80, CP = 528, PP = 144;
constexpr size_t WS_SCT = WS_CT, WS_WC = WS_CT + 4 * MiB, WS_DENI = WS_CT + 5 * MiB, WS_KW = WS_CT + 6 * MiB;
__device__ __forceinline__ s16x4 trr(unsigned addr) { s16x4 r; asm volatile("ds_read_b64_tr_b16 %0, %1" : "=&v"(r) : "v"(addr) : "memory"); return r; }
__device__ __forceinline__ unsigned cvtpk(float lo, float hi) { unsigned r; asm volatile("s_nop 0\n\tv_cvt_pk_bf16_f32 %0, %1, %2\n\ts_nop 1" : "=v"(r) : "v"(lo), "v"(hi)); return r; }
__device__ __forceinline__ int crow(int r, int hi) { return (r & 3) + 8 * (r >> 2) + 4 * hi; }
#define ML_BAR() do { asm volatile("s_waitcnt lgkmcnt(0)" ::: "memory"); __builtin_amdgcn_s_barrier(); asm volatile("" ::: "memory"); } while (0)
#define ML_TOK(c, i) (base + (dir ? (L - 1 - ((c) * 64 + (i))) : ((c) * 64 + (i))))
__device__ __forceinline__ float logsig(float g) { return fminf(g, 0.f) - __logf(1.0f + __expf(-fabsf(g))); }

__device__ __forceinline__ void scalars_wg(const P& p, const int l, const int chain, const int wave, const int lane, LAS float* sx) {
    const bool lat = chain >= 128; const int cc = lat ? chain - 128 : chain, b = cc >> 3, h = (cc >> 1) & 3, dir = cc & 1;
    const int L = lat ? LL : CL, base = lat ? NCTX + b * LL : b * CL, NC = L >> 6;
    const float* kva = (const float*)(p.ws + WS_KVA) + 576 + dir * 8 + h;
    const float bi = p.in[18][l * 16 + dir * 8 + h], bf = p.in[18][l * 16 + dir * 8 + 4 + h];
    float li_[8], lf_[8];
#pragma unroll
    for (int j = 0; j < 8; ++j) { const int c = wave + 8 * j; li_[j] = 0.f; lf_[j] = 0.f; if (c < NC) { const float* r_ = kva + (size_t)ML_TOK(c, lane) * KVAW; li_[j] = r_[0] + bi; lf_[j] = r_[4] + bf; } }
    float bb_[8], gg_[8], pm_[8];
#pragma unroll
    for (int j = 0; j < 8; ++j) { const int c = wave + 8 * j;
        float bc = logsig(lf_[j]);
#pragma unroll
        for (int o = 1; o < 64; o <<= 1) { const float t_ = __shfl_up(bc, o); if (lane >= o) bc += t_; }
        const float g = li_[j] - bc; float pm = g;
#pragma unroll
        for (int o = 1; o < 64; o <<= 1) { const float t_ = __shfl_up(pm, o); if (lane >= o) pm = fmaxf(pm, t_); }
        bb_[j] = bc; gg_[j] = g; pm_[j] = pm;
        if (lane == 63) { sx[c] = (c < NC) ? bc : 0.f; sx[64 + c] = (c < NC) ? bc + pm : -1e30f; } }
    __syncthreads();
    float al = sx[lane], be = sx[64 + lane];
#pragma unroll
    for (int o = 1; o < 64; o <<= 1) { const float ea = __shfl_up(al, o), eb = __shfl_up(be, o); if (lane >= o) { be = fmaxf(eb + al, be); al = ea + al; } }
    float m0 = 0.f; if (lat) m0 = p.in[8][(size_t)((b * 2 + l) * 2 + dir) * 4 + h];
    const float pa = __shfl_up(al, 1), pb = __shfl_up(be, 1);
    const float mst_all = lane == 0 ? m0 : fmaxf(m0 + pa, pb);
    if (!lat && wave == 0 && lane == NC - 1) p.out[O_MM + ((b * 2 + l) * 2 + dir) * 4 + h] = fmaxf(m0 + al, be);
    f32x4* sct = (f32x4*)(p.ws + WS_SCT);
#pragma unroll
    for (int j = 0; j < 8; ++j) { const int c = wave + 8 * j;
        const float m_st = __shfl(mst_all, c & 63);
        if (c < NC) { const float mxl = fmaxf(m_st, __shfl(pm_[j], 63)), mx = fmaxf(m_st, pm_[j]);
            sct[((size_t)ML_TOK(c, lane) * 2 + dir) * 4 + h] = (f32x4){__expf(pm_[j] - mx), __expf(m_st - mx), __expf(-(bb_[j] + mx)), __expf(gg_[j] - mxl)};
            if (lane == 0) ((float*)(p.ws + WS_WC))[chain * 64 + c] = __expf(m_st - mxl); } }
    __syncthreads();
}

constexpr int B_Q = 0, B_K = 33792, B_V = 67584, B_P = 101376, B_S = 110592, B_END = 112640;
__device__ __forceinline__ void intra_phase(LAS unsigned char* lds, const P& p, const int l, const int tid) {
    const int wid = __builtin_amdgcn_readfirstlane(tid >> 6), lane = tid & 63, r32 = lane & 31, hi = lane >> 5;
    const bf16_t* MQ_ = (const bf16_t*)(p.ws + WS_MLQ); const bf16_t* MK_ = (const bf16_t*)(p.ws + WS_MLK); const bf16_t* MV_ = (const bf16_t*)(p.ws + WS_MLV);
    LAS float* sg = (LAS float*)(lds + B_S); LAS float* spm = sg + 64; LAS float* sws = sg + 128; LAS float* sd0 = sg + 192; LAS float* sd1 = sg + 256;
    const unsigned ldsb = (unsigned)(uintptr_t)lds;
    const int tq = (lane & 15) >> 2, tp = lane & 3, tc0 = 16 * ((lane >> 4) & 1) + 4 * tp;
    u32x4 q4[4], k4[4], v4[4]; float gli = 0.f, glf = 0.f, gws = 0.f;
#define B_DECODE(uu) const bool lat = (uu) < 2048; const int chain = lat ? 128 + ((uu) >> 6) : ((uu) - 2048) >> 2, c = lat ? ((uu) & 63) : (((uu) - 2048) & 3); \
        const int cc = lat ? chain - 128 : chain, b = cc >> 3, h = (cc >> 1) & 3, dir = cc & 1; const int L = lat ? LL : CL, base = lat ? NCTX + b * LL : b * CL;
#define B_LOAD(uu) do { B_DECODE(uu) (void)chain; \
        _Pragma("unroll") for (int i = 0; i < 4; ++i) { const int ch = tid + 512 * i, row = ch >> 5, c16 = ch & 31; const size_t g_ = (size_t)ML_TOK(c, row) * 1024 + h * 256 + c16 * 8; \
            q4[i] = *(const u32x4*)(MQ_ + g_); k4[i] = *(const u32x4*)(MK_ + g_); v4[i] = *(const u32x4*)(MV_ + g_); } \
        if (wid == 7) { const int row = ML_TOK(c, lane); const float* r_ = (const float*)(p.ws + WS_KVA) + (size_t)row * KVAW + 576 + dir * 8 + h; \
            gli = r_[0] + p.in[18][l * 16 + dir * 8 + h]; glf = r_[4] + p.in[18][l * 16 + dir * 8 + 4 + h]; gws = ((const f32x4*)(p.ws + WS_SCT))[((size_t)row * 2 + dir) * 4 + h][3]; } } while (0)
    if ((int)blockIdx.x < 2560) B_LOAD((int)blockIdx.x);
    for (int u = blockIdx.x; u < 2560; u += gridDim.x) {
        B_DECODE(u)
        bf16_t* Hout = (bf16_t*)(p.ws + (dir ? WS_HB : WS_HF));
#pragma unroll
        for (int i = 0; i < 4; ++i) { const int ch = tid + 512 * i, row = ch >> 5, c16 = ch & 31;
            *(LAS u32x4*)(lds + B_Q + row * QP + c16 * 16) = q4[i]; *(LAS u32x4*)(lds + B_K + row * QP + c16 * 16) = k4[i]; *(LAS u32x4*)(lds + B_V + row * QP + c16 * 16) = v4[i]; }
        if (wid == 7) {
            float bc = logsig(glf);
#pragma unroll
            for (int o = 1; o < 64; o <<= 1) { const float t_ = __shfl_up(bc, o); if (lane >= o) bc += t_; }
            const float g = gli - bc; float pm = g;
#pragma unroll
            for (int o = 1; o < 64; o <<= 1) { const float t_ = __shfl_up(pm, o); if (lane >= o) pm = fmaxf(pm, t_); }
            sg[lane] = g; spm[lane] = pm; sws[lane] = gws;
        }
        if (u + (int)gridDim.x < 2560) B_LOAD(u + (int)gridDim.x);
        ML_BAR();
        if (wid < 3) {
            const int tb = wid == 0 ? 0 : 1, sb = wid == 2 ? 1 : 0, t = tb * 32 + r32;
            f32x16 p0; { float z0 = 0.f; asm volatile("" : "+v"(z0));
#pragma unroll
              for (int r = 0; r < 16; ++r) p0[r] = z0; }
#pragma unroll 4
            for (int ks = 0; ks < 16; ++ks) { const int cb = (ks * 16 + hi * 8) * 2;
                const bf16x8 qf = *(const LAS bf16x8*)(lds + B_Q + t * QP + cb), kf = *(const LAS bf16x8*)(lds + B_K + (sb * 32 + r32) * QP + cb);
                p0 = __builtin_amdgcn_mfma_f32_32x32x16_bf16(kf, qf, p0, 0, 0, 0); }
            const float mpm = -spm[t]; float dsum = 0.f;
#pragma unroll
            for (int r = 0; r < 16; ++r) { const int s = sb * 32 + crow(r, hi); const float w = (s <= t) ? __expf(sg[s] + mpm) : 0.f; p0[r] *= w; dsum += p0[r]; }
            { auto rr = __builtin_amdgcn_permlane32_swap(__float_as_uint(dsum), __float_as_uint(dsum), false, false); dsum = __uint_as_float(rr[0]) + __uint_as_float(rr[1]); }
            if (hi == 0) { if (sb == 0) sd0[t] = dsum; else sd1[r32] = dsum; }
#pragma unroll
            for (int i = 0; i < 4; ++i) { u32x2 w; w.x = cvtpk(p0[4 * i], p0[4 * i + 1]); w.y = cvtpk(p0[4 * i + 2], p0[4 * i + 3]);
                *(LAS u32x2*)(lds + B_P + t * PP + (sb * 32 + 8 * i + 4 * hi) * 2) = w; }
        } else if (wid >= 4) {
            const int k = tid - 256; float acc = 0.f;
#pragma unroll 8
            for (int s = 0; s < 64; ++s) acc += sws[s] * bf2f(*(const LAS unsigned short*)(lds + B_K + s * QP + k * 2));
            ((float*)(p.ws + WS_KW))[((size_t)chain * 64 + c) * 256 + k] = acc;
        }
        ML_BAR();
        {
            f32x16 h0, h1; { float z0 = 0.f; asm volatile("" : "+v"(z0));
#pragma unroll
              for (int r = 0; r < 16; ++r) { h0[r] = z0; h1[r] = z0; } }
#pragma unroll
            for (int ks = 0; ks < 4; ++ks) {
                const unsigned va = ldsb + B_V + (16 * ks + 8 * hi + tq) * QP + (wid * 32 + tc0) * 2;
                const s16x4 lo = trr(va), hh = trr(va + 4 * QP);
                const bf16x8 a1 = *(const LAS bf16x8*)(lds + B_P + (32 + r32) * PP + (ks * 16 + hi * 8) * 2);
                bf16x8 a0 = a1; if (ks < 2) a0 = *(const LAS bf16x8*)(lds + B_P + r32 * PP + (ks * 16 + hi * 8) * 2);
                asm volatile("s_waitcnt lgkmcnt(0)" ::: "memory"); __builtin_amdgcn_sched_barrier(0);
                const bf16x8 vf = (bf16x8){lo[0], lo[1], lo[2], lo[3], hh[0], hh[1], hh[2], hh[3]};
                if (ks < 2) h0 = __builtin_amdgcn_mfma_f32_32x32x16_bf16(a0, vf, h0, 0, 0, 0);
                h1 = __builtin_amdgcn_mfma_f32_32x32x16_bf16(a1, vf, h1, 0, 0, 0); }
#pragma unroll
            for (int r = 0; r < 16; ++r) { const int t0 = crow(r, hi);
                Hout[(size_t)ML_TOK(c, t0) * 1024 + h * 256 + wid * 32 + r32] = (bf16_t)f2bf(h0[r]); Hout[(size_t)ML_TOK(c, 32 + t0) * 1024 + h * 256 + wid * 32 + r32] = (bf16_t)f2bf(h1[r]); }
            if (tid < 64) ((float*)(p.ws + WS_DENI))[((size_t)ML_TOK(c, tid) * 2 + dir) * 4 + h] = sd0[tid] + (tid >= 32 ? sd1[tid - 32] : 0.f);
        }
        ML_BAR();
    }
}

constexpr int L_Q = 0, L_K = 33792, L_V = 67584, L_CT = 72704, L_SC = 89600, L_NQ = 95744, L_N = 96256, L_PART = 98304, L_END = 114688;
__device__ __forceinline__ void seq_phase(LAS unsigned char* lds, const P& p, const int l, const int tid) {
    const int wid = __builtin_amdgcn_readfirstlane(tid >> 6), lane = tid & 63, r32 = lane & 31, hi = lane >> 5;
    const bf16_t* MQ_ = (const bf16_t*)(p.ws + WS_MLQ); const bf16_t* MK_ = (const bf16_t*)(p.ws + WS_MLK); const bf16_t* MV_ = (const bf16_t*)(p.ws + WS_MLV);
    const unsigned ldsb = (unsigned)(uintptr_t)lds;
    const int tq = (lane & 15) >> 2, tp = lane & 3, tc0 = 16 * ((lane >> 4) & 1) + 4 * tp;
    for (int u = xcd_slot(); u < 1280; u += gridDim.x) {
        const bool lat = u < 256; const int uu = lat ? u : u - 256, cc = uu >> 3, sl = uu & 7, chain = lat ? 128 + cc : cc;
        const int b = cc >> 3, h = (cc >> 1) & 3, dir = cc & 1;
        const int L = lat ? LL : CL, base = lat ? NCTX + b * LL : b * CL, NC = L >> 6;
        const int colq = h * 256, colv = h * 256 + sl * 32;
        bf16_t* Hout = (bf16_t*)(p.ws + (dir ? WS_HB : WS_HF));
        f32x16 ct, ia;
        { float z0 = 0.f; asm volatile("" : "+v"(z0));
#pragma unroll
          for (int r = 0; r < 16; ++r) { ct[r] = z0; ia[r] = z0; } }
        LAS float* nb0 = (LAS float*)(lds + L_N); LAS float* nb1 = nb0 + 256;
        if (lat) {
            const size_t so = (size_t)((b * 2 + l) * 2 + dir) * 4 + h;
            const float* c0 = p.in[6] + so * 65536 + (size_t)(sl * 32 + r32) * 256 + wid * 32 + 4 * hi;
#pragma unroll
            for (int i = 0; i < 4; ++i) { const f32x4 v4 = *(const f32x4*)(c0 + 8 * i); ct[4 * i] = v4[0]; ct[4 * i + 1] = v4[1]; ct[4 * i + 2] = v4[2]; ct[4 * i + 3] = v4[3]; }
            if (tid < 256) nb0[tid] = p.in[7][so * 256 + tid];
        } else if (tid < 256) nb0[tid] = 0.f;
        u32x4 pq[4], pk[4], pv; pv = (u32x4){0u, 0u, 0u, 0u}; f32x4 psc = {0.f, 0.f, 0.f, 0.f}; float pdi = 0.f, pwc = 0.f, pkw = 0.f; unsigned hpre[16];
#pragma unroll
        for (int r = 0; r < 16; ++r) hpre[r] = 0u;
#define ML_HPRE(cc_) do { _Pragma("unroll") for (int rr = 0; rr < 8; ++rr) hpre[rr] = Hout[(size_t)ML_TOK(cc_, (wid & 1) * 32 + crow(8 * (wid >> 1) + rr, hi)) * 1024 + colv + r32]; } while (0)
#define ML_LOAD(c) do { _Pragma("unroll") for (int i_ = 0; i_ < 4; ++i_) { const int ch_ = tid + 512 * i_, row_ = ch_ >> 5, c16_ = ch_ & 31; const size_t g_ = (size_t)ML_TOK(c, row_) * 1024 + colq + c16_ * 8; \
            pq[i_] = *(const u32x4*)(MQ_ + g_); pk[i_] = *(const u32x4*)(MK_ + g_); } \
        if (tid < 256) { const int row_ = tid >> 2, c16_ = tid & 3; pv = *(const u32x4*)(MV_ + (size_t)ML_TOK(c, row_) * 1024 + colv + c16_ * 8); } \
        else pkw = ((const float*)(p.ws + WS_KW))[((size_t)chain * 64 + (c)) * 256 + tid - 256]; \
        if (wid == 0) { const size_t ix_ = ((size_t)ML_TOK(c, lane) * 2 + dir) * 4 + h; psc = ((const f32x4*)(p.ws + WS_SCT))[ix_]; pdi = ((const float*)(p.ws + WS_DENI))[ix_]; pwc = ((const float*)(p.ws + WS_WC))[chain * 64 + (c)]; } } while (0)
#define ML_WRITE(cc_) do { _Pragma("unroll") for (int i_ = 0; i_ < 4; ++i_) { const int ch_ = tid + 512 * i_, row_ = ch_ >> 5, c16_ = ch_ & 31; \
            *(LAS u32x4*)(lds + L_Q + row_ * QP + c16_ * 16) = pq[i_]; *(LAS u32x4*)(lds + L_K + row_ * QP + c16_ * 16) = pk[i_]; } \
        if (tid < 256) { const int row_ = tid >> 2, c16_ = tid & 3; *(LAS u32x4*)(lds + L_V + row_ * VP + c16_ * 16) = pv; } \
        if (wid == 0) { LAS float* S_ = (LAS float*)(lds + L_SC + ((cc_) % 3) * 2048); S_[lane] = psc[0]; S_[64 + lane] = psc[1]; S_[128 + lane] = psc[2]; S_[192 + lane] = psc[3]; S_[256 + lane] = pdi; if (lane == 0) S_[320] = pwc; } } while (0)
#define ML_CTB() do { _Pragma("unroll") for (int i_ = 0; i_ < 4; ++i_) { u32x2 w_; w_.x = cvtpk(ct[4 * i_], ct[4 * i_ + 1]); w_.y = cvtpk(ct[4 * i_ + 2], ct[4 * i_ + 3]); \
            *(LAS u32x2*)(lds + L_CT + r32 * CP + (wid * 32 + 8 * i_ + 4 * hi) * 2) = w_; } } while (0)
#define ML_COMB(cc_) do { const int tb_ = wid & 1, kh_ = wid >> 1; const LAS float* S_ = (const LAS float*)(lds + L_SC + ((cc_) % 3) * 2048); const LAS float* NQ_ = (const LAS float*)(lds + L_NQ + ((cc_) & 1) * 256); \
            const LAS float* PT_ = (const LAS float*)(lds + L_PART + (((cc_) & 1) * 4 + (wid ^ 2)) * 2048); \
            _Pragma("unroll") for (int rr = 0; rr < 8; ++rr) { const int r = 8 * kh_ + rr, tt = tb_ * 32 + crow(r, hi); bf16_t* hp_ = Hout + (size_t)ML_TOK(cc_, tt) * 1024 + colv + r32; \
                const float rr_ = S_[tt], wi = S_[64 + tt], den = rr_ * S_[256 + tt] + wi * NQ_[tt], it_ = (kh_ ? ia[8 + rr] : ia[rr]) + PT_[rr * 64 + lane]; \
                *hp_ = (bf16_t)f2bf((rr_ * bf2f(hpre[rr]) + wi * it_) / fmaxf(fabsf(den), S_[128 + tt])); } } while (0)
        float kwc = 0.f;
        ML_LOAD(0); ML_WRITE(0); ML_CTB(); kwc = pkw;
        int nsel = 0;
        for (int c = 0; c < NC; ++c) {
            ML_BAR();
            LAS float* ncur = nsel ? nb1 : nb0; LAS float* nnxt = nsel ? nb0 : nb1;
            const LAS float* SC = (const LAS float*)(lds + L_SC + (c % 3) * 2048);
            if (c + 1 < NC) ML_LOAD(c + 1);
            const float w_c = SC[320];
            if (wid < 4) {
                if (c > 0) ML_COMB(c - 1);
                ML_HPRE(c);
                const int tb = wid & 1, kh = wid >> 1;
                { float z0 = 0.f; asm volatile("" : "+v"(z0));
#pragma unroll
                  for (int r = 0; r < 16; ++r) ia[r] = z0; }
#pragma unroll
                for (int k1 = 0; k1 < 8; ++k1) { const int cb0 = ((kh * 8 + k1) * 16 + hi * 8) * 2;
                    const bf16x8 qf0 = *(const LAS bf16x8*)(lds + L_Q + (tb * 32 + r32) * QP + cb0), cf0 = *(const LAS bf16x8*)(lds + L_CT + r32 * CP + cb0);
                    ia = __builtin_amdgcn_mfma_f32_32x32x16_bf16(qf0, cf0, ia, 0, 0, 0); }
                { LAS float* PW = (LAS float*)(lds + L_PART + ((c & 1) * 4 + wid) * 2048);
#pragma unroll
                  for (int rr = 0; rr < 8; ++rr) PW[rr * 64 + lane] = kh ? ia[rr] : ia[8 + rr]; }
            } else if (wid >= 4) {
                const int j = tid - 256, t = j >> 2, part = j & 3;
                float acc = 0.f;
#pragma unroll
                for (int i = 0; i < 8; ++i) { const u32x4 qv = *(const LAS u32x4*)(lds + L_Q + t * QP + (part * 64 + i * 8) * 2);
                    const f32x4 n0 = *(const LAS f32x4*)(ncur + part * 64 + i * 8), n1 = *(const LAS f32x4*)(ncur + part * 64 + i * 8 + 4);
                    acc += bf2f(qv[0]) * n0[0] + bf2f(qv[0] >> 16) * n0[1] + bf2f(qv[1]) * n0[2] + bf2f(qv[1] >> 16) * n0[3] + bf2f(qv[2]) * n1[0] + bf2f(qv[2] >> 16) * n1[1] + bf2f(qv[3]) * n1[2] + bf2f(qv[3] >> 16) * n1[3]; }
                acc += __shfl_xor(acc, 1); acc += __shfl_xor(acc, 2);
                if (part == 0) ((LAS float*)(lds + L_NQ + (c & 1) * 256))[t] = acc;
                nnxt[j] = w_c * ncur[j] + kwc;
            }
            { f32x16 cc = ct;
#pragma unroll
              for (int r = 0; r < 16; ++r) cc[r] *= w_c;
#pragma unroll
              for (int ks = 0; ks < 4; ++ks) {
                const unsigned ka = ldsb + L_K + (16 * ks + 8 * hi + tq) * QP + (wid * 32 + tc0) * 2, va = ldsb + L_V + (16 * ks + 8 * hi + tq) * VP + tc0 * 2;
                const s16x4 kl = trr(ka), kh = trr(ka + 4 * QP), vl = trr(va), vh = trr(va + 4 * VP);
                const f32x4 wa = *(const LAS f32x4*)(SC + 192 + 16 * ks + 8 * hi), wb = *(const LAS f32x4*)(SC + 192 + 16 * ks + 8 * hi + 4);
                asm volatile("s_waitcnt lgkmcnt(0)" ::: "memory"); __builtin_amdgcn_sched_barrier(0);
                u32x4 vw; vw.x = cvtpk(bf2f((unsigned short)vl[0]) * wa[0], bf2f((unsigned short)vl[1]) * wa[1]); vw.y = cvtpk(bf2f((unsigned short)vl[2]) * wa[2], bf2f((unsigned short)vl[3]) * wa[3]);
                vw.z = cvtpk(bf2f((unsigned short)vh[0]) * wb[0], bf2f((unsigned short)vh[1]) * wb[1]); vw.w = cvtpk(bf2f((unsigned short)vh[2]) * wb[2], bf2f((unsigned short)vh[3]) * wb[3]);
                const bf16x8 kf = (bf16x8){kl[0], kl[1], kl[2], kl[3], kh[0], kh[1], kh[2], kh[3]};
                cc = __builtin_amdgcn_mfma_f32_32x32x16_bf16(kf, *reinterpret_cast<bf16x8*>(&vw), cc, 0, 0, 0); }
              ct = cc; }
            ML_BAR();
            if (c + 1 < NC) { ML_WRITE(c + 1); kwc = pkw; }
            ML_CTB();
            nsel ^= 1;
        }
        if (wid < 4) ML_COMB(NC - 1);
        if (!lat) {
            const size_t so = (size_t)((b * 2 + l) * 2 + dir) * 4 + h;
            float* oc = p.out + O_MC + so * 65536 + (size_t)(sl * 32 + r32) * 256 + wid * 32 + 4 * hi;
#pragma unroll
            for (int i = 0; i < 4; ++i) *(f32x4*)(oc + 8 * i) = (f32x4){ct[4 * i], ct[4 * i + 1], ct[4 * i + 2], ct[4 * i + 3]};
            if (sl == 0) { LAS float* nfin = nsel ? nb1 : nb0; if (tid < 256) p.out[O_MN + so * 256 + tid] = nfin[tid]; }
        }
        ML_BAR();
#undef ML_LOAD
#undef ML_WRITE
#undef ML_CTB
#undef ML_COMB
#undef ML_HPRE
    }
}
#undef ML_BAR
#undef ML_TOK
#undef B_LOAD
#undef B_DECODE
}


namespace s5 {
typedef short s16x4 __attribute__((ext_vector_type(4)));
__device__ __forceinline__ s16x4 trr(unsigned addr) { s16x4 r; asm volatile("ds_read_b64_tr_b16 %0, %1" : "=&v"(r) : "v"(addr) : "memory"); return r; }
__device__ __forceinline__ unsigned cvtpk(float lo, float hi) { unsigned r; asm volatile("s_nop 0\n\tv_cvt_pk_bf16_f32 %0, %1, %2\n\ts_nop 1" : "=v"(r) : "v"(lo), "v"(hi)); return r; }
template <bool FULL>
__device__ __forceinline__ void scan_seg(const P& p, const int l, LAS unsigned char* T, const int g, const int dir, const bool lat, const int b0, const int lane, const int blk0, const int nblk,
                                         const float (&ar)[2], const float (&ai)[2], const bf16x8 (&bb)[4], float (&sr)[2], float (&si)[2]) {
    const int r32 = lane & 31, hh = lane >> 5;
    const int L = lat ? LL : CL;
    const int baseA = lat ? NCTX + b0 * LL : b0 * CL, baseB = baseA + L;
    const size_t pg = (size_t)(l * 2 + dir) * 64 + g;
    bf16x8 cm[8];
    if (FULL) {
#pragma unroll
        for (int ks = 0; ks < 8; ++ks) { u32x4 w = {0u, 0u, 0u, 0u};
            if (r32 < 16) { const int k0 = 16 * ks + 8 * hh; const float* src = (k0 < 64 ? p.in[27] : p.in[28]) + (pg * 16 + r32) * 64 + (k0 & 63); const float sg = k0 < 64 ? 1.f : -1.f;
#pragma unroll
                for (int j = 0; j < 4; ++j) w[j] = cvtpk(sg * src[2 * j], sg * src[2 * j + 1]); }
            cm[ks] = *reinterpret_cast<bf16x8*>(&w); } }
    const int urow_tok = 4 * (r32 >> 3) + (r32 & 3), urow_base = ((r32 >> 2) & 1) ? baseB : baseA;
    const bf16_t* U = (const bf16_t*)(p.ws + WS_S5U) + g * 16 + 8 * hh;
    bf16_t* Yo2 = (bf16_t*)(p.ws + (dir ? WS_YS5B : WS_YS5F)) + g * 16;
#define S5_POS(n, j) (dir ? (L - 1 - ((n) * 16 + (j))) : ((n) * 16 + (j)))
    bf16x8 ucur[4], unxt[4];
#pragma unroll
    for (int i = 0; i < 4; ++i) { ucur[i] = *(const bf16x8*)(U + (size_t)(urow_base + S5_POS(blk0 + i, urow_tok)) * 1024); unxt[i] = ucur[i]; }
    const unsigned tb = (unsigned)(uintptr_t)T;
    const int tq = (lane & 15) >> 2, tp = lane & 3, tc0 = 16 * ((lane >> 4) & 1) + 4 * tp;
    for (int n4 = blk0; n4 < blk0 + nblk; n4 += 4) {
        if (n4 + 4 < blk0 + nblk) {
#pragma unroll
            for (int i = 0; i < 4; ++i) unxt[i] = *(const bf16x8*)(U + (size_t)(urow_base + S5_POS(n4 + 4 + i, urow_tok)) * 1024); }
#pragma unroll
      for (int i4 = 0; i4 < 4; ++i4) { const int n = n4 + i4; const bf16x8 ucur1 = ucur[i4];
        f32x16 acc[4]; { float z0 = 0.f; asm volatile("" : "+v"(z0));
#pragma unroll
          for (int q = 0; q < 4; ++q)
#pragma unroll
              for (int r = 0; r < 16; ++r) acc[q][r] = z0; }
#pragma unroll
        for (int q = 0; q < 4; ++q) acc[q] = __builtin_amdgcn_mfma_f32_32x32x16_bf16(ucur1, bb[q], acc[q], 0, 0, 0);
#pragma unroll
        for (int pb = 0; pb < 2; ++pb) { float xr = sr[pb], xi = si[pb]; const float a_r = ar[pb], a_i = ai[pb];
#pragma unroll
            for (int r = 0; r < 16; ++r) { const float nr_ = a_r * xr - a_i * xi + acc[pb][r], ni_ = a_r * xi + a_i * xr + acc[2 + pb][r]; xr = nr_; xi = ni_; acc[pb][r] = nr_; acc[2 + pb][r] = ni_; }
            sr[pb] = xr; si[pb] = xi; }
        if (FULL) {
#pragma unroll
        for (int q = 0; q < 4; ++q)
#pragma unroll
            for (int a4 = 0; a4 < 4; ++a4) { u32x2 w; w.x = cvtpk(acc[q][4 * a4], acc[q][4 * a4 + 1]); w.y = cvtpk(acc[q][4 * a4 + 2], acc[q][4 * a4 + 3]);
                *(LAS u32x2*)(T + (q * 32 + r32) * 64 + 16 * a4 + 8 * hh) = w; }
        f32x16 y, y2; { float z0 = 0.f; asm volatile("" : "+v"(z0));
#pragma unroll
          for (int r = 0; r < 16; ++r) { y[r] = z0; y2[r] = z0; } }
        { s16x4 lo_[8], hi_[8];
#pragma unroll
          for (int ks = 0; ks < 8; ++ks) { const unsigned ta = tb + (16 * ks + 8 * hh + tq) * 64 + tc0 * 2; lo_[ks] = trr(ta); hi_[ks] = trr(ta + 4 * 64); }
          asm volatile("s_waitcnt lgkmcnt(0)" ::: "memory"); __builtin_amdgcn_sched_barrier(0);
#pragma unroll
          for (int ks = 0; ks < 8; ks += 2) {
            const bf16x8 af0 = (bf16x8){lo_[ks][0], lo_[ks][1], lo_[ks][2], lo_[ks][3], hi_[ks][0], hi_[ks][1], hi_[ks][2], hi_[ks][3]};
            const bf16x8 af1 = (bf16x8){lo_[ks + 1][0], lo_[ks + 1][1], lo_[ks + 1][2], lo_[ks + 1][3], hi_[ks + 1][0], hi_[ks + 1][1], hi_[ks + 1][2], hi_[ks + 1][3]};
            y = __builtin_amdgcn_mfma_f32_32x32x16_bf16(cm[ks], af0, y, 0, 0, 0);
            y2 = __builtin_amdgcn_mfma_f32_32x32x16_bf16(cm[ks + 1], af1, y2, 0, 0, 0); }
#pragma unroll
          for (int r = 0; r < 16; ++r) y[r] += y2[r]; }
        {
          bf16_t* yo = Yo2 + (size_t)(urow_base + S5_POS(n, urow_tok)) * 1024 + 4 * hh;
          u32x2 w0, w1; w0.x = cvtpk(y[0], y[1]); w0.y = cvtpk(y[2], y[3]); w1.x = cvtpk(y[4], y[5]); w1.y = cvtpk(y[6], y[7]);
          *(u32x2*)yo = w0; *(u32x2*)(yo + 8) = w1; }
        }
      }
#pragma unroll
        for (int i = 0; i < 4; ++i) ucur[i] = unxt[i];
    }
#undef S5_POS
}
__device__ __forceinline__ void params(const P& p, const int l, const int g, const int dir, const int lane, float (&ar)[2], float (&ai)[2], bf16x8 (&bb)[4]) {
    const int r32 = lane & 31, hh = lane >> 5; const size_t pg = (size_t)(l * 2 + dir) * 64 + g;
    const float dt = __expf(p.in[24][pg]);
#pragma unroll
    for (int pb = 0; pb < 2; ++pb) { const int pp = pb * 32 + r32;
        const float lr = fminf(p.in[22][pg * 64 + pp], -1e-4f), li = p.in[23][pg * 64 + pp];
        const float mag = __expf(dt * lr); float sn, cs; sincos_small(dt * li, sn, cs);
        const float a_r = mag * cs, a_i = mag * sn, den = lr * lr + li * li, nr = a_r - 1.0f, ni = a_i, qr = (nr * lr + ni * li) / den, qi = (ni * lr - nr * li) / den;
        ar[pb] = a_r; ai[pb] = a_i;
        const float* br = p.in[25] + (pg * 64 + pp) * 16 + 8 * hh; const float* bi = p.in[26] + (pg * 64 + pp) * 16 + 8 * hh;
        u32x4 wr, wi;
#pragma unroll
        for (int j = 0; j < 4; ++j) { const float r0 = qr * br[2 * j] - qi * bi[2 * j], r1 = qr * br[2 * j + 1] - qi * bi[2 * j + 1], i0 = qr * bi[2 * j] + qi * br[2 * j], i1 = qr * bi[2 * j + 1] + qi * br[2 * j + 1];
            wr[j] = cvtpk(r0, r1); wi[j] = cvtpk(i0, i1); }
        bb[pb] = *reinterpret_cast<bf16x8*>(&wr); bb[2 + pb] = *reinterpret_cast<bf16x8*>(&wi); }
}
__device__ __forceinline__ void ctx_unit(const P& p, const int l, LAS unsigned char* T, const int u, const int lane) {
    const int dir = u & 1, g = (u >> 1) & 63, b0 = 2 * (u >> 7), r32 = lane & 31, hh = lane >> 5;
    float ar[2], ai[2]; bf16x8 bb[4]; params(p, l, g, dir, lane, ar, ai, bb);
    float sr[2] = {0.f, 0.f}, si[2] = {0.f, 0.f};
    scan_seg<true>(p, l, T, g, dir, false, b0, lane, 0, CL / 16, ar, ai, bb, sr, si);
#pragma unroll
    for (int pb = 0; pb < 2; ++pb) { const size_t so = ((size_t)(((b0 + hh) * 2 + l) * 2 + dir) * 64 + g) * 64 + pb * 32 + r32; p.out[O_SR + so] = sr[pb]; p.out[O_SI + so] = si[pb]; }
}
__device__ __forceinline__ void lat_unit(const P& p, const int l, LAS unsigned char* lds, const int u, const int wave, const int lane) {
    const int dir = u & 1, g = (u >> 1) & 63, b0 = 2 * (u >> 7), r32 = lane & 31, hh = lane >> 5;
    LAS unsigned char* T = lds + wave * 8192; LAS float* X = (LAS float*)(lds + 65536);
    float ar[2], ai[2]; bf16x8 bb[4]; params(p, l, g, dir, lane, ar, ai, bb);
    float sr[2] = {0.f, 0.f}, si[2] = {0.f, 0.f};
    if (wave == 0) {
#pragma unroll
        for (int pb = 0; pb < 2; ++pb) { const size_t so = ((size_t)(((b0 + hh) * 2 + l) * 2 + dir) * 64 + g) * 64 + pb * 32 + r32; sr[pb] = p.in[9][so]; si[pb] = p.in[10][so]; } }
    const float s0r[2] = {sr[0], sr[1]}, s0i[2] = {si[0], si[1]};
    constexpr int SEGB = LL / 16 / 8;
    if (wave < 7) scan_seg<false>(p, l, T, g, dir, true, b0, lane, wave * SEGB, SEGB, ar, ai, bb, sr, si);
#pragma unroll
    for (int pb = 0; pb < 2; ++pb) { X[(wave * 4 + pb) * 64 + lane] = sr[pb]; X[(wave * 4 + 2 + pb) * 64 + lane] = si[pb]; }
    __syncthreads();
    float pr[2], pi[2];
#pragma unroll
    for (int pb = 0; pb < 2; ++pb) { float xr = ar[pb], xi = ai[pb];
#pragma unroll
        for (int k = 0; k < 9; ++k) { const float nr = xr * xr - xi * xi, ni = 2.f * xr * xi; xr = nr; xi = ni; }
        pr[pb] = xr; pi[pb] = xi; }
    float cr[2], ci[2];
    if (wave == 0) { cr[0] = s0r[0]; cr[1] = s0r[1]; ci[0] = s0i[0]; ci[1] = s0i[1]; }
    else {
#pragma unroll
        for (int pb = 0; pb < 2; ++pb) { float xr = X[(0 * 4 + pb) * 64 + lane], xi = X[(0 * 4 + 2 + pb) * 64 + lane];
            for (int j = 1; j < wave; ++j) { const float er = X[(j * 4 + pb) * 64 + lane], ei = X[(j * 4 + 2 + pb) * 64 + lane];
                const float nr = pr[pb] * xr - pi[pb] * xi + er, ni = pr[pb] * xi + pi[pb] * xr + ei; xr = nr; xi = ni; }
            cr[pb] = xr; ci[pb] = xi; } }
    scan_seg<true>(p, l, T, g, dir, true, b0, lane, wave * SEGB, SEGB, ar, ai, bb, cr, ci);
    __syncthreads();
}
__device__ __forceinline__ void combine_row(const P& p, const int l, const int r, const int lane) {
    const bf16_t* yf = (const bf16_t*)(p.ws + WS_YS5F) + (size_t)r * 1024; const bf16_t* yb = (const bf16_t*)(p.ws + WS_YS5B) + (size_t)r * 1024; const bf16_t* uu = (const bf16_t*)(p.ws + WS_S5U) + (size_t)r * 1024;
    bf16_t* o = (bf16_t*)(p.ws + WS_HB) + (size_t)r * 1024; const float* dv = p.in[29] + l * 1024;
#pragma unroll
    for (int j = 0; j < 2; ++j) { const int c = j * 512 + lane * 8; float a[8], b[8], u[8];
        { const u32x4 w = *(const u32x4*)(yf + c);
#pragma unroll
          for (int i = 0; i < 4; ++i) { a[2 * i] = bf2f(w[i]); a[2 * i + 1] = bf2f(w[i] >> 16); } }
        { const u32x4 w = *(const u32x4*)(yb + c);
#pragma unroll
          for (int i = 0; i < 4; ++i) { b[2 * i] = bf2f(w[i]); b[2 * i + 1] = bf2f(w[i] >> 16); } }
        { const u32x4 w = *(const u32x4*)(uu + c);
#pragma unroll
          for (int i = 0; i < 4; ++i) { u[2 * i] = bf2f(w[i]); u[2 * i + 1] = bf2f(w[i] >> 16); } }
        const f32x4 d0 = *(const f32x4*)(dv + c), d1 = *(const f32x4*)(dv + c + 4);
        float gq[8];
#pragma unroll
        for (int i = 0; i < 8; ++i) gq[i] = gelu_tanh(a[i] + b[i] + (i < 4 ? d0[i] : d1[i - 4]) * u[i]);
        u32x4 w; w.x = pk2(gq[0], gq[1]); w.y = pk2(gq[2], gq[3]); w.z = pk2(gq[4], gq[5]); w.w = pk2(gq[6], gq[7]);
        *(u32x4*)(o + c) = w; }
}
}

__device__ __forceinline__ float rope_lane(float x, int lane, int prow, int pcol, const float* rt) {
    const int part = lane >> 5, jj = lane & 31, idx = jj & 15, pos = part ? pcol : prow;
    const float c = rt[pos * 16 + idx], s = rt[1024 + pos * 16 + idx];
    const float o = __shfl_xor(x, 16);
    return (jj >= 16) ? (x * c + o * s) : (x * c - o * s);
}
__device__ __forceinline__ u32x4 rope8(const u32x4 x, const int d0  , const int prow, const int pcol, const float* rt, const int pmask) {
    const int part = d0 >> 5, jj = d0 & 31, idx0 = jj & 15, pos = part ? pcol : prow; const bool second = jj >= 16;
    u32x4 o, y;
#pragma unroll
    for (int i = 0; i < 4; ++i) o[i] = __shfl_xor(x[i], pmask);
    const f32x4 c0 = *(const f32x4*)(rt + pos * 16 + idx0), c1 = *(const f32x4*)(rt + pos * 16 + idx0 + 4), s0 = *(const f32x4*)(rt + 1024 + pos * 16 + idx0), s1 = *(const f32x4*)(rt + 1024 + pos * 16 + idx0 + 4);
#pragma unroll
    for (int i = 0; i < 4; ++i) { const float ca = i < 2 ? c0[2 * i] : c1[2 * i - 4], cb = i < 2 ? c0[2 * i + 1] : c1[2 * i - 3], sa = i < 2 ? s0[2 * i] : s1[2 * i - 4], sb = i < 2 ? s0[2 * i + 1] : s1[2 * i - 3];
        const float xa = bf2f(x[i]), xb = bf2f(x[i] >> 16), oa = bf2f(o[i]), ob = bf2f(o[i] >> 16);
        y[i] = second ? pk2(xa * ca + oa * sa, xb * cb + ob * sb) : pk2(xa * ca - oa * sa, xb * cb - ob * sb); }
    return y;
}
__device__ __forceinline__ void ph_prep_row(const P& p, int l, int r, int lane) {
    unsigned char* ws = p.ws;
    bf16_t* ckvn = (bf16_t*)(ws + WS_CKVN) + (size_t)r * 512;
    bf16_t* kf = (bf16_t*)(ws + WS_KFULL) + (size_t)r * 1536;
    bf16_t* dfk = (bf16_t*)(ws + WS_DFK) + (size_t)r * 1024;
    bf16_t* dfv = (bf16_t*)(ws + WS_DFV) + (size_t)r * 1024;
    if (r >= MTOK) {
        const int i = r - MTOK, b = i >> 8, t = i & 255; const size_t cr = (size_t)(b * 2 + l) * PAST + t;
        { const float* cc = p.in[2] + cr * 512 + lane * 8; const f32x4 a = *(const f32x4*)cc, c = *(const f32x4*)(cc + 4);
          u32x4 w; w.x = pk2(a[0], a[1]); w.y = pk2(a[2], a[3]); w.z = pk2(c[0], c[1]); w.w = pk2(c[2], c[3]); *(u32x4*)(ckvn + lane * 8) = w; }
        const float kr = p.in[3][cr * 64 + lane];
#pragma unroll
        for (int h = 0; h < 8; ++h) kf[h * 192 + 128 + lane] = (bf16_t)f2bf(kr);
        const float* ck = p.in[4] + cr * 1024 + lane * 16; const float* cv = p.in[5] + cr * 1024 + lane * 16;
#pragma unroll
        for (int j = 0; j < 2; ++j) { const f32x4 a = *(const f32x4*)(ck + 8 * j), c = *(const f32x4*)(ck + 8 * j + 4), d = *(const f32x4*)(cv + 8 * j), e = *(const f32x4*)(cv + 8 * j + 4);
            u32x4 w; w.x = pk2(a[0], a[1]); w.y = pk2(a[2], a[3]); w.z = pk2(c[0], c[1]); w.w = pk2(c[2], c[3]); *(u32x4*)(dfk + lane * 16 + 8 * j) = w;
            u32x4 v; v.x = pk2(d[0], d[1]); v.y = pk2(d[2], d[3]); v.z = pk2(e[0], e[1]); v.w = pk2(e[2], e[3]); *(u32x4*)(dfv + lane * 16 + 8 * j) = v; }
        return;
    }
    const float* kva = (const float*)(ws + WS_KVA) + (size_t)r * KVAW;
    const bool ctx = r < NCTX;
    const int cb = r >> 8, ct = r & 255;
    const int t = (r - NCTX) & 4095, prow = t >> 6, pcol = t & 63;
    const float* rt = (const float*)(ws + WS_ROPE);
    const f32x4 ka = *(const f32x4*)(kva + lane * 8), kb = *(const f32x4*)(kva + lane * 8 + 4);
    float kr = kva[512 + lane];
    const float graw = lane < 16 ? kva[576 + lane] + p.in[18][l * 16 + lane] : 0.f;
    bf16_t* mq = (bf16_t*)(ws + WS_MQ) + (size_t)r * 1536 + (lane >> 3) * 192 + 128 + (lane & 7) * 8;
    bf16_t* dfq = (bf16_t*)(ws + WS_DFQ) + (size_t)r * 1024 + lane * 16;
    u32x4 xq = {0u, 0u, 0u, 0u}, xd0 = xq, xd1 = xq, xk0 = xq, xk1 = xq, xv0 = xq, xv1 = xq;
    if (!ctx) { xq = *(const u32x4*)mq; xd0 = *(const u32x4*)dfq; xd1 = *(const u32x4*)(dfq + 8); }
    xk0 = *(const u32x4*)(dfk + lane * 16); xk1 = *(const u32x4*)(dfk + lane * 16 + 8);
    if (ctx) { xv0 = *(const u32x4*)(dfv + lane * 16); xv1 = *(const u32x4*)(dfv + lane * 16 + 8); }
    { float ss = ka[0] * ka[0] + ka[1] * ka[1] + ka[2] * ka[2] + ka[3] * ka[3] + kb[0] * kb[0] + kb[1] * kb[1] + kb[2] * kb[2] + kb[3] * kb[3];
      const float rstd = rsqrtf(wave_sum(ss) * (1.0f / 512.0f) + 1e-6f);
      const float* g = p.in[20] + l * 512 + lane * 8; const f32x4 g0 = *(const f32x4*)g, g1 = *(const f32x4*)(g + 4);
      const f32x4 y0 = ka * rstd * g0, y1 = kb * rstd * g1;
      u32x4 w; w.x = pk2(y0[0], y0[1]); w.y = pk2(y0[2], y0[3]); w.z = pk2(y1[0], y1[1]); w.w = pk2(y1[2], y1[3]); *(u32x4*)(ckvn + lane * 8) = w;
      if (ctx) { float* o = p.out + O_CKV + ((size_t)(cb * 2 + l) * CL + ct) * 512 + lane * 8; *(f32x4*)o = y0; *(f32x4*)(o + 4) = y1; } }
    { if (ctx) p.out[O_KR + ((size_t)(cb * 2 + l) * CL + ct) * 64 + lane] = kr; else kr = rope_lane(kr, lane, prow, pcol, rt);
#pragma unroll
      for (int h = 0; h < 8; ++h) kf[h * 192 + 128 + lane] = (bf16_t)f2bf(kr); }
    if (lane < 16) { const float o = ((lane >> 2) & 1) ? (fminf(graw, 0.f) - __logf(1.0f + __expf(-fabsf(graw)))) : graw; ((float*)(ws + WS_GATES))[(size_t)r * 16 + lane] = o; }
    if (ctx) {
        float* ok = p.out + O_DK + ((size_t)(cb * 2 + l) * CL + ct) * 1024 + lane * 16; float* ov = p.out + O_DV + ((size_t)(cb * 2 + l) * CL + ct) * 1024 + lane * 16;
#pragma unroll
        for (int i = 0; i < 4; ++i) { *(f32x2_*)(ok + 2 * i) = (f32x2_){bf2f(xk0[i]), bf2f(xk0[i] >> 16)}; *(f32x2_*)(ok + 8 + 2 * i) = (f32x2_){bf2f(xk1[i]), bf2f(xk1[i] >> 16)};
            *(f32x2_*)(ov + 2 * i) = (f32x2_){bf2f(xv0[i]), bf2f(xv0[i] >> 16)}; *(f32x2_*)(ov + 8 + 2 * i) = (f32x2_){bf2f(xv1[i]), bf2f(xv1[i] >> 16)}; }
    } else {
        *(u32x4*)mq = rope8(xq, (lane & 7) * 8, prow, pcol, rt, 2);
        const int q = lane & 3;
        *(u32x4*)dfq = rope8(xd0, q * 16, prow, pcol, rt, 1); *(u32x4*)(dfq + 8) = rope8(xd1, q * 16 + 8, prow, pcol, rt, 1);
        *(u32x4*)(dfk + lane * 16) = rope8(xk0, q * 16, prow, pcol, rt, 1); *(u32x4*)(dfk + lane * 16 + 8) = rope8(xk1, q * 16 + 8, prow, pcol, rt, 1);
    }
}

__device__ __forceinline__ void ph_ml_combine_row(const P& p, int l, int r, int lane) {
    bf16_t* hf = (bf16_t*)(p.ws + WS_HF) + (size_t)r * 1024 + lane * 4; const bf16_t* hb = (const bf16_t*)(p.ws + WS_HB) + (size_t)r * 1024 + lane * 4;
    const bf16_t* so = (const bf16_t*)(p.ws + WS_MLO) + (size_t)r * 1024 + lane * 4; const float* g = p.in[19] + l * 1024 + lane * 4;
    u32x2 a[4], b[4], c[4]; f32x4 gg[4];
#pragma unroll
    for (int h = 0; h < 4; ++h) { a[h] = *(const u32x2*)(hf + h * 256); b[h] = *(const u32x2*)(hb + h * 256); c[h] = *(const u32x2*)(so + h * 256); gg[h] = *(const f32x4*)(g + h * 256); }
#pragma unroll
    for (int h = 0; h < 4; ++h) { float v[4];
        v[0] = bf2f(a[h].x) + bf2f(b[h].x); v[1] = bf2f(a[h].x >> 16) + bf2f(b[h].x >> 16); v[2] = bf2f(a[h].y) + bf2f(b[h].y); v[3] = bf2f(a[h].y >> 16) + bf2f(b[h].y >> 16);
        const float rstd = rsqrtf(wave_sum(v[0] * v[0] + v[1] * v[1] + v[2] * v[2] + v[3] * v[3]) * (1.0f / 256.0f) + 1e-6f);
        u32x2 w; w.x = pk2(v[0] * rstd * gg[h][0] * bf2f(c[h].x), v[1] * rstd * gg[h][1] * bf2f(c[h].x >> 16)); w.y = pk2(v[2] * rstd * gg[h][2] * bf2f(c[h].y), v[3] * rstd * gg[h][3] * bf2f(c[h].y >> 16));
        *(u32x2*)(hf + h * 256) = w; }
}

__device__ __forceinline__ void ph_df_combine_row(const P& p, int l, float lam_init, float lam, int r, int lane) {
    const int h = lane >> 3, part = lane & 7;
    const bf16_t* o = (const bf16_t*)(p.ws + WS_DFO) + (size_t)r * 2048 + h * 256 + part * 16;
    const u32x4 a0 = *(const u32x4*)o, a1 = *(const u32x4*)(o + 8), b0 = *(const u32x4*)(o + 128), b1 = *(const u32x4*)(o + 136);
    const float* g = p.in[32] + l * 128 + part * 16;
    float v[16]; float ss = 0.f;
#pragma unroll
    for (int i = 0; i < 4; ++i) { v[2 * i] = bf2f(a0[i]) - lam * bf2f(b0[i]); v[2 * i + 1] = bf2f(a0[i] >> 16) - lam * bf2f(b0[i] >> 16); v[8 + 2 * i] = bf2f(a1[i]) - lam * bf2f(b1[i]); v[9 + 2 * i] = bf2f(a1[i] >> 16) - lam * bf2f(b1[i] >> 16); }
#pragma unroll
    for (int i = 0; i < 16; ++i) ss += v[i] * v[i];
    ss += __shfl_xor(ss, 1); ss += __shfl_xor(ss, 2); ss += __shfl_xor(ss, 4);
    const float sc = rsqrtf(ss * (1.0f / 128.0f) + 1e-6f) * (1.0f - lam_init);
    u32x4 w0, w1;
#pragma unroll
    for (int i = 0; i < 4; ++i) { w0[i] = pk2(v[2 * i] * sc * g[2 * i], v[2 * i + 1] * sc * g[2 * i + 1]); w1[i] = pk2(v[8 + 2 * i] * sc * g[8 + 2 * i], v[9 + 2 * i] * sc * g[9 + 2 * i]); }
    bf16_t* y = (bf16_t*)(p.ws + WS_DFQ) + (size_t)r * 1024 + h * 128 + part * 16;
    *(u32x4*)y = w0; *(u32x4*)(y + 8) = w1;
}
__device__ __forceinline__ void ph_final_row(const P& p, int r, int lane) {
    const float* x = (const float*)(p.ws + WS_X) + (size_t)r * D; const float* g = p.in[37];
    f32x4 v[8]; float ss = 0.f;
#pragma unroll
    for (int j = 0; j < 8; ++j) { v[j] = *(const f32x4*)(x + j * 256 + lane * 4); ss += v[j][0] * v[j][0] + v[j][1] * v[j][1] + v[j][2] * v[j][2] + v[j][3] * v[j][3]; }
    const float rstd = rsqrtf(wave_sum(ss) * (1.0f / 2048.0f) + 1e-6f);
    float* o = p.out + (r < NCTX ? O_YP + (size_t)r * D : O_YS + (size_t)(r - NCTX) * D);
#pragma unroll
    for (int j = 0; j < 8; ++j) { const int c = j * 256 + lane * 4; const f32x4 gg = *(const f32x4*)(g + c); *(f32x4*)(o + c) = v[j] * rstd * gg; }
}

__device__ __forceinline__ void load_args(P& p) {
#if defined(__HIP_DEVICE_COMPILE__)
    const __attribute__((address_space(4))) unsigned long long* q = (const __attribute__((address_space(4))) unsigned long long*)__builtin_amdgcn_kernarg_segment_ptr();
    asm volatile("" : "+s"(q));
#pragma unroll
    for (int i = 0; i < 38; ++i) p.in[i] = (const float*)q[i];
    p.out = (float*)q[38]; p.ws = (unsigned char*)q[39];
#endif
}
constexpr int NTHR = 512, LDS_BYTES = 147456, MISC_OFF = 131072;
#ifndef PROBE
#define PROBE 0
#endif
#ifndef PROBE_MASK_D
#define PROBE_MASK_D 0u
#endif
#ifndef PROBE_MASK_A
#define PROBE_MASK_A 0u
#endif
#define PROBE_MULT 10
#define PROBE_ADIV 100.0f
#define STAMP(idx) do { if (PROBE) { if (blockIdx.x == 0 && bar.w == 0u && lane_id_() == 0u) ((LAS unsigned long long*)((LAS unsigned char*)lds + MISC_OFF + 2048))[idx] = __builtin_amdgcn_s_memrealtime(); } } while (0)
#define GRID_BAR() do { XcdBarrier b_ = bar; asm volatile("" : "+s"(b_.x)); xcd_barrier(b_); } while (0)

#define PH_VARS P p; load_args(p); unsigned char* ws = p.ws; (void)ws; int tid_ = (int)(bar.w * 64u + lane_id_()); asm volatile("" : "+v"(tid_)); const int lane = tid_ & 63, wave = __builtin_amdgcn_readfirstlane(tid_ >> 6), half = tid_ >> 8, vt = tid_ & 255; \
    const int gw = blockIdx.x * 8 + wave, vb = blockIdx.x * 2 + half; (void)lane; (void)half; (void)vt; (void)gw; (void)vb;

template <int l>
__device__ __forceinline__ void run_layer(unsigned char* lds, const XcdBarrier& bar, const int G, const int NGW) {
        { PH_VARS ph_convert(p, l, gw, NGW, lane, (LAS float*)((LAS unsigned char*)lds + wave * 16384), l == 0, true); }
        { PH_VARS for (int r = gw; r < MTOK; r += NGW) ph_hnorm_row(p, l, 0, r, lane); }
        GRID_BAR(); STAMP(1 + 17 * l + 1);
        { PH_VARS pg8::Gemm g{(const bf16_t*)(ws + WS_H), (const bf16_t*)(ws + WS_WBF + WB_IN), MTOK, 10496, D}; pg8::StaticOrder S; S.init(MTOK, 10496, G, (int)blockIdx.x);
          pg8::gemm_phase<Epi8In, pg8::StaticOrder, true, true>((LAS unsigned char*)lds, g, S, Epi8In{ws}, tid_); }
        GRID_BAR(); STAMP(1 + 17 * l + 2);
        { PH_VARS for (int ch = blockIdx.x; ch < 160; ch += G) ml::scalars_wg(p, l, ch, wave, lane, (LAS float*)((LAS unsigned char*)lds)); for (int r = gw; r < MALL; r += NGW) ph_prep_row(p, l, r, lane); }
        GRID_BAR(); STAMP(1 + 17 * l + 3);
        { PH_VARS pg8::Gemm g{(const bf16_t*)(ws + WS_CKVN), (const bf16_t*)(ws + WS_WBF + WB_KVB), MALL, 2048, 512}; pg8::StaticOrder S; S.init(MALL, 2048, G, (int)blockIdx.x);
          pg8::gemm_phase<Epi8Kvb, pg8::StaticOrder, true, true>((LAS unsigned char*)lds, g, S, Epi8Kvb{(bf16_t*)(ws + WS_KFULL), (bf16_t*)(ws + WS_VFULL)}, tid_); }
        STAMP(1 + 17 * l + 4);
        { PH_VARS ml::intra_phase((LAS unsigned char*)lds, p, l, tid_); }
        GRID_BAR();
        { PH_VARS ml::seq_phase((LAS unsigned char*)lds, p, l, tid_); }
        GRID_BAR(); STAMP(1 + 17 * l + 5);
        { PH_VARS
          for (int u = xcd_slot(); u < 256; u += G) { int ln_ = lane; asm volatile("" : "+v"(ln_)); s5::lat_unit(p, l, (LAS unsigned char*)lds, u, wave, ln_); }
          if (wave < 4) { for (int u = wave * G + blockIdx.x; u < 1024; u += 4 * G) s5::ctx_unit(p, l, (LAS unsigned char*)lds + wave * 8192, u, lane); }
          else { for (int r = blockIdx.x * 4 + (wave - 4); r < MTOK; r += G * 4) ph_ml_combine_row(p, l, r, lane); } }
        GRID_BAR(); STAMP(1 + 17 * l + 6);
        { PH_VARS for (int r = gw; r < MTOK; r += NGW) s5::combine_row(p, l, r, lane); }
        GRID_BAR(); STAMP(1 + 17 * l + 7);
        { PH_VARS pg8::Gemm g{(const bf16_t*)(ws + WS_HB), (const bf16_t*)(ws + WS_WBF + WB_GLU), MTOK, 1024, 1024}; pg8::StaticOrder S; S.init(MTOK, 1024, G, (int)blockIdx.x);
          pg8::gemm_phase<Epi8Glu, pg8::StaticOrder, true, true>((LAS unsigned char*)lds, g, S, Epi8Glu{(const bf16_t*)(ws + WS_HB), (bf16_t*)(ws + WS_S5U)}, tid_); }
        STAMP(1 + 17 * l + 8);
        { PH_VARS fa::Args aa{(const bf16_t*)(ws + WS_MQ), (const bf16_t*)(ws + WS_KFULL), (const bf16_t*)(ws + WS_VFULL), (bf16_t*)(ws + WS_MLQ), 1536, 1536, 1024, 1024, 8, 1, 0.07216878364870322f, 0};
          fa::attn_phase<192>((LAS unsigned char*)lds, aa, tid_); }
        STAMP(1 + 17 * l + 9);
        { PH_VARS fa::Args aa{(const bf16_t*)(ws + WS_DFQ), (const bf16_t*)(ws + WS_DFK), (const bf16_t*)(ws + WS_DFV), (bf16_t*)(ws + WS_DFO), 1024, 1024, 1024, 2048, 16, 2, 0.125f, 0};
          fa::attn_phase<64>((LAS unsigned char*)lds, aa, tid_); }
        GRID_BAR(); STAMP(1 + 17 * l + 10);
        { PH_VARS const float lam_init = (l == 0) ? 0.2f : 0.35550906759096927f;
          const float* lp = p.in[31] + l * 256;
          const float lam = __expf(wave_sum(lp[lane] * lp[64 + lane])) - __expf(wave_sum(lp[128 + lane] * lp[192 + lane])) + lam_init;
          for (int r = gw; r < MTOK; r += NGW) ph_df_combine_row(p, l, lam_init, lam, r, lane); }
        GRID_BAR(); STAMP(1 + 17 * l + 11);
        { PH_VARS pg8::Gemm g{(const bf16_t*)(ws + WS_H), (const bf16_t*)(ws + WS_WBF + WB_IN) + (size_t)10496 * D, MTOK, GATE_COLS, D}; pg8::StaticOrder S; S.init(MTOK, GATE_COLS, G, (int)blockIdx.x);
          pg8::gemm_phase<Epi8Gate, pg8::StaticOrder, true, true>((LAS unsigned char*)lds, g, S, Epi8Gate{(bf16_t*)(ws + WS_GS)}, tid_); }
        GRID_BAR(); STAMP(1 + 17 * l + 12);
        { PH_VARS pg8::Gemm g{(const bf16_t*)(ws + WS_HF), (const bf16_t*)(ws + WS_WBF + WB_BR) + (size_t)0 * 2048 * 1024, MTOK, D, 1024}; pg8::StaticOrder S; S.init(MTOK, D, G, (int)blockIdx.x);
          pg8::gemm_phase<Epi8Merge, pg8::StaticOrder, true, true>((LAS unsigned char*)lds, g, S, Epi8Merge{(const bf16_t*)(ws + WS_GS), (bf16_t*)(ws + WS_H), 0, 0}, tid_); }
        { PH_VARS pg8::Gemm g{(const bf16_t*)(ws + WS_MLQ), (const bf16_t*)(ws + WS_WBF + WB_BR) + (size_t)1 * 2048 * 1024, MTOK, D, 1024}; pg8::StaticOrder S; S.init(MTOK, D, G, (int)blockIdx.x);
          pg8::gemm_phase<Epi8Merge, pg8::StaticOrder, true, true>((LAS unsigned char*)lds, g, S, Epi8Merge{(const bf16_t*)(ws + WS_GS), (bf16_t*)(ws + WS_H), 1, 0}, tid_); }
        { PH_VARS pg8::Gemm g{(const bf16_t*)(ws + WS_S5U), (const bf16_t*)(ws + WS_WBF + WB_BR) + (size_t)2 * 2048 * 1024, MTOK, D, 1024}; pg8::StaticOrder S; S.init(MTOK, D, G, (int)blockIdx.x);
          pg8::gemm_phase<Epi8Merge, pg8::StaticOrder, true, true>((LAS unsigned char*)lds, g, S, Epi8Merge{(const bf16_t*)(ws + WS_GS), (bf16_t*)(ws + WS_H), 2, 0}, tid_); }
        { PH_VARS pg8::Gemm g{(const bf16_t*)(ws + WS_DFQ), (const bf16_t*)(ws + WS_WBF + WB_BR) + (size_t)3 * 2048 * 1024, MTOK, D, 1024}; pg8::StaticOrder S; S.init(MTOK, D, G, (int)blockIdx.x);
          pg8::gemm_phase<Epi8Merge, pg8::StaticOrder, true, true>((LAS unsigned char*)lds, g, S, Epi8Merge{(const bf16_t*)(ws + WS_GS), (bf16_t*)(ws + WS_H), 3, 0}, tid_); }
        GRID_BAR(); STAMP(1 + 17 * l + 13);
        { PH_VARS pg8::Gemm g{(const bf16_t*)(ws + WS_H), (const bf16_t*)(ws + WS_WBF + WB_O), MTOK, D, D}; pg8::StaticOrder S; S.init(MTOK, D, G, (int)blockIdx.x);
          pg8::gemm_phase<Epi8Res, pg8::StaticOrder, true, true>((LAS unsigned char*)lds, g, S, Epi8Res{p, l, 4096, 0, 0}, tid_); }
        GRID_BAR(); STAMP(1 + 17 * l + 14);
        { PH_VARS for (int r = gw; r < MTOK; r += NGW) ph_hnorm_row(p, l, 1, r, lane); }
        GRID_BAR(); STAMP(1 + 17 * l + 15);
        { PH_VARS pg8::Gemm g{(const bf16_t*)(ws + WS_H), (const bf16_t*)(ws + WS_WBF + WB_FIN), MTOK, 2 * FFN, D}; pg8::StaticOrder S; S.init(MTOK, 2 * FFN, G, (int)blockIdx.x);
          pg8::gemm_phase<Epi8FfnIn, pg8::StaticOrder, true, true>((LAS unsigned char*)lds, g, S, Epi8FfnIn{(bf16_t*)(ws + WS_FFNH)}, tid_); }
        GRID_BAR(); STAMP(1 + 17 * l + 16);
        { PH_VARS pg8::Gemm g{(const bf16_t*)(ws + WS_FFNH), (const bf16_t*)(ws + WS_WBF + WB_FOUT), MTOK, D, FFN}; pg8::StaticOrder S; S.init(MTOK, D, G, (int)blockIdx.x);
          pg8::gemm_phase<Epi8Res, pg8::StaticOrder, true, true>((LAS unsigned char*)lds, g, S, Epi8Res{p, l, 10240, 1, 0}, tid_); }
        if (l == 0) { PH_VARS
          const int rem = 640 % G, nidle = rem ? G - rem : G, idx = rem ? (int)blockIdx.x - rem : (int)blockIdx.x;
          if (idx >= 0) ph_convert(p, 1, idx * 8 + wave, nidle * 8, lane, (LAS float*)((LAS unsigned char*)lds + wave * 16384), true, false); }
        GRID_BAR(); STAMP(1 + 17 * l + 17);
}

__global__ void __launch_bounds__(NTHR, 2) mega(P p_arg) {
    extern __shared__ __attribute__((aligned(16))) unsigned char lds[];
    const int tid = threadIdx.x;
    const int G = gridDim.x, NGW = G * 8;
    for (int u = tid; u < (LDS_BYTES - MISC_OFF) / 4; u += NTHR) ((LAS unsigned*)((LAS unsigned char*)lds + MISC_OFF))[u] = 0u;
    __syncthreads();
    XcdBarrier bar = xcd_barrier_post((unsigned*)(p_arg.ws + WS_CTL), (volatile LAS unsigned*)((LAS unsigned char*)lds + MISC_OFF + 32));
    STAMP(0);
    { PH_VARS ph_mod_partial(p, tid_, (float*)lds); }
    GRID_BAR();
    { PH_VARS ph_mod_reduce(p, tid_); }
    GRID_BAR(); STAMP(1);
    run_layer<0>(lds, bar, G, NGW);
    run_layer<1>(lds, bar, G, NGW);
    { PH_VARS for (int r = gw; r < MTOK; r += NGW) ph_final_row(p, r, lane);
#if PROBE
      STAMP(35);
      if (blockIdx.x == 0 && bar.w == 0u && lane_id_() == 0u) {
          asm volatile("s_waitcnt vmcnt(0) lgkmcnt(0)" ::: "memory");
          const LAS unsigned long long* ts = (const LAS unsigned long long*)((LAS unsigned char*)lds + MISC_OFF + 2048);
          unsigned long long sd = 0, sa = 0;
          for (int ll = 0; ll < 2; ++ll) for (int i = 0; i < 17; ++i) { const unsigned long long d = ts[1 + 17 * ll + i + 1] - ts[1 + 17 * ll + i]; if ((PROBE_MASK_D >> i) & 1u) sd += d; if ((PROBE_MASK_A >> i) & 1u) sa += d; }
          { const unsigned long long d = ts[1] - ts[0]; if ((PROBE_MASK_D >> 17) & 1u) sd += d; if ((PROBE_MASK_A >> 17) & 1u) sa += d; }
          { const unsigned long long d = ts[35] - ts[34]; if ((PROBE_MASK_D >> 18) & 1u) sd += d; if ((PROBE_MASK_A >> 18) & 1u) sa += d; }
          float v = (float)sa * 0.01f / PROBE_ADIV; v = v > 120.f ? 120.f : v;
          if (PROBE_MASK_A) p.out[O_YS] += v;
          const unsigned long long t0 = __builtin_amdgcn_s_memrealtime(), wait = sd * PROBE_MULT;
          while (__builtin_amdgcn_s_memrealtime() - t0 < wait) __builtin_amdgcn_s_sleep(32);
      }
#endif
    }
}

extern "C" void kernel_launch(void* const* d_in, const int* in_sizes, int n_in, void* d_out, int out_size, void* d_ws, size_t ws_size, hipStream_t stream) {
    static int grid = 0;
    if (grid == 0) {
        if (n_in != 38 || out_size != (int)O_END || ws_size < WS_END) { fprintf(stderr, "kernel_launch: unexpected shapes (n_in %d out %d ws %zu)\n", n_in, out_size, ws_size); grid = -1; return; }
        int dev = 0, cus = 0, per_cu = 0;
        if (hipGetDevice(&dev) != hipSuccess || hipDeviceGetAttribute(&cus, hipDeviceAttributeMultiprocessorCount, dev) != hipSuccess) { grid = -1; return; }
        if (hipFuncSetAttribute((const void*)mega, hipFuncAttributeMaxDynamicSharedMemorySize, LDS_BYTES) != hipSuccess) { fprintf(stderr, "kernel_launch: hipFuncSetAttribute failed\n"); grid = -1; return; }
        if (hipOccupancyMaxActiveBlocksPerMultiprocessor(&per_cu, (const void*)mega, NTHR, LDS_BYTES) != hipSuccess || per_cu < 1) { fprintf(stderr, "kernel_launch: occupancy query says %d workgroups per CU\n", per_cu); grid = -1; return; }
        (void)hipGetLastError();
        grid = cus;
    }
    if (grid < 0) return;
    if (hipMemsetAsync((char*)d_ws + WS_CTL, 0, CTL_BYTES, stream) != hipSuccess) return;
    P p{};
    for (int i = 0; i < 38; ++i) p.in[i] = (const float*)d_in[i];
    p.out = (float*)d_out; p.ws = (unsigned char*)d_ws;
    hipLaunchKernelGGL(mega, dim3(grid), dim3(NTHR), LDS_BYTES, stream, p);
}
```

```cpp
#include <hip/hip_runtime.h>
#include <cstdio>
#include <cstdint>

typedef unsigned short bf16_t;
typedef short bf16x8 __attribute__((ext_vector_type(8)));
typedef float f32x16 __attribute__((ext_vector_type(16)));
typedef float f32x4 __attribute__((ext_vector_type(4)));
typedef unsigned u32x4 __attribute__((ext_vector_type(4)));
typedef unsigned u32x2 __attribute__((ext_vector_type(2)));
typedef float f32x2_ __attribute__((ext_vector_type(2)));

constexpr int D = 2048, NCTX = 4096, NLAT = 16384, MTOK = 20480, MALL = 21504;
constexpr int CB = 16, CL = 256, LB = 4, LL = 4096, PAST = 256;
constexpr int IN_COLS = 18512, MIX_COLS = 10320, GATE_COLS = 8192;
constexpr int C_MLQ = 0, C_MLK = 1024, C_MLV = 2048, C_MLO = 3072, C_MLIF = 4096, C_MQ = 4112, C_KVA = 5648, C_S5U = 6224, C_DFQ = 7248, C_DFK = 8272, C_DFV = 9296;
constexpr int FFN = 5632;
constexpr int NTHR_ = 512;
constexpr int KVAW = 768;

constexpr size_t MiB = 1u << 20;
constexpr size_t WS_CTL = 0, CTL_BYTES = 64 * 1024;
constexpr size_t WS_MOD = 1 * MiB;
constexpr size_t WS_ROPE = WS_MOD + 512 * 1024;
constexpr size_t WS_X = 2 * MiB;
constexpr size_t WS_H = 162 * MiB;
constexpr size_t WS_HF = 242 * MiB;
constexpr size_t WS_HB = 282 * MiB;
constexpr size_t WS_MLQ = 322 * MiB;
constexpr size_t WS_S5U = 362 * MiB;
constexpr size_t WS_DFQ = 402 * MiB;
constexpr size_t WS_MLK = 442 * MiB;
constexpr size_t WS_MLV = 482 * MiB;
constexpr size_t WS_MLO = 522 * MiB;
constexpr size_t WS_MQ = 562 * MiB;
constexpr size_t WS_KVA = 622 * MiB;
constexpr size_t WS_DFK = 682 * MiB;
constexpr size_t WS_DFV = 724 * MiB;
constexpr size_t WS_CKVN = 766 * MiB;
constexpr size_t WS_KFULL = 787 * MiB;
constexpr size_t WS_VFULL = 850 * MiB;
constexpr size_t WS_GATES = 892 * MiB;
constexpr size_t WS_CT = 894 * MiB;
constexpr size_t WS_WBF = 934 * MiB;
constexpr size_t WS_GS = 442 * MiB;
constexpr size_t WS_FFNH = 442 * MiB;
constexpr size_t WS_DFO = 442 * MiB;
constexpr size_t WS_YS5F = 442 * MiB;
constexpr size_t WS_YS5B = 482 * MiB;
constexpr size_t WS_END = 1101 * MiB;

constexpr size_t O_YP = 0, O_YS = 8388608, O_CKV = 41943040, O_KR = 46137344, O_DK = 46661632, O_DV = 55050240,
                 O_MC = 63438848, O_MN = 80216064, O_MM = 80281600, O_SR = 80281856, O_SI = 80544000, O_END = 80806144;

__device__ __forceinline__ unsigned f2bf(float f) { unsigned u = __builtin_bit_cast(unsigned, f); return (u + 0x7fffu + ((u >> 16) & 1u)) >> 16; }
__device__ __forceinline__ float bf2f(unsigned b) { return __builtin_bit_cast(float, (b & 0xffffu) << 16); }
__device__ __forceinline__ unsigned pk2(float lo, float hi) { return f2bf(lo) | (f2bf(hi) << 16); }
__device__ __forceinline__ float wave_sum(float v) {
#pragma unroll
    for (int o = 1; o < 64; o <<= 1) v += __shfl_xor(v, o);
    return v;
}
__device__ __forceinline__ float wave_max(float v) {
#pragma unroll
    for (int o = 1; o < 64; o <<= 1) v = fmaxf(v, __shfl_xor(v, o));
    return v;
}
__device__ __forceinline__ float sigmoidf_(float x) { return __builtin_amdgcn_rcpf(1.0f + __expf(-x)); }
__device__ __forceinline__ float siluf_(float x) { return x * __builtin_amdgcn_rcpf(1.0f + __expf(-x)); }
__device__ __forceinline__ float gelu_tanh(float x) { const float u = 0.7978845608028654f * (x + 0.044715f * x * x * x); const float t = 1.0f - 2.0f * __builtin_amdgcn_rcpf(1.0f + __expf(2.0f * u)); return 0.5f * x * (1.0f + t); }
__device__ __forceinline__ void sincos_small(float x, float& s, float& c) {
    const float k = rintf(x * 0.6366197723675814f);
    float r = fmaf(-k, 1.5707962513e+0f, x); r = fmaf(-k, 7.5497894159e-8f, r); r = fmaf(-k, 5.3903029534e-15f, r);
    const float r2 = r * r;
    const float sp = r + r * r2 * (-1.6666654611e-1f + r2 * (8.3321608736e-3f + r2 * (-1.9515295891e-4f)));
    const float cp = 1.0f - 0.5f * r2 + r2 * r2 * (4.166664568298827e-2f + r2 * (-1.388731625493765e-3f + r2 * 2.443315711809948e-5f));
    const int q = ((int)k) & 3;
    s = (q == 0) ? sp : (q == 1) ? cp : (q == 2) ? -sp : -cp;
    c = (q == 0) ? cp : (q == 1) ? -sp : (q == 2) ? -cp : sp;
}
__device__ __forceinline__ int cond_of_row(int r) { return r < NCTX ? 0 : 1 + ((r - NCTX) >> 12); }

struct P {
    const float* in[38];
    float* out;
    unsigned char* ws;
};
__device__ __forceinline__ const float* x_src(const P& p, int l, int r) {
    if (l == 0) return r < NCTX ? p.in[0] + (size_t)r * D : p.in[1] + (size_t)(r - NCTX) * D;
    return (const float*)(p.ws + WS_X) + (size_t)r * D;
}


#define XB_TMO      128
#define XB_XCNT(j)  (256  + 64 * (j))
#define XB_XSUB(j)  (1280 + 64 * (j))
#define XB_XGEN(j)  (2304 + 64 * (j))
#define XB_TOP      3328
#define XB_TOPGEN   3392
#define XCD_BAR_WORDS 3456
#define XB_SPIN_CAP (1u << 22)
#define LAS __attribute__((address_space(3)))

__device__ __forceinline__ unsigned xb_ld(unsigned* p)              { return __hip_atomic_load(p, __ATOMIC_RELAXED, __HIP_MEMORY_SCOPE_AGENT); }
__device__ __forceinline__ unsigned xb_add(unsigned* p, unsigned v) { return __hip_atomic_fetch_add(p, v, __ATOMIC_RELAXED, __HIP_MEMORY_SCOPE_AGENT); }
__device__ __forceinline__ unsigned xb_xcc_id() { return (unsigned)__builtin_amdgcn_s_getreg((3 << 11) | 20) & 0xFu; }
#define XB_SPIN(cond, bar) do { unsigned _sp = 0; while (cond) { __builtin_amdgcn_s_sleep(1); \
    if ((++_sp & 255u) == 0u) { if (xb_ld(&(bar)[XB_TMO])) break; if (_sp > XB_SPIN_CAP) { atomicAdd(&(bar)[XB_TMO], 1u); break; } } } } while (0)

__device__ __forceinline__ unsigned lane_id_() { unsigned l_; asm volatile("v_mbcnt_lo_u32_b32 %0, -1, 0\n\tv_mbcnt_hi_u32_b32 %0, -1, %0" : "=v"(l_)); return l_; }
struct XcdBarrier {
    unsigned* bar; unsigned x; unsigned w;
    volatile LAS unsigned* st;
};
__device__ __forceinline__ XcdBarrier xcd_barrier_post(unsigned* bar, volatile LAS unsigned* st) {
    XcdBarrier b; b.bar = bar; b.x = xb_xcc_id(); b.st = st; b.w = (unsigned)__builtin_amdgcn_readfirstlane(threadIdx.x >> 6);
    if (threadIdx.x == 0) (void)xb_add(&bar[XB_XCNT(b.x)], 1u);
    return b;
}
__device__ __forceinline__ void xcd_barrier_complete(unsigned* bar, unsigned x, unsigned& nloc, unsigned& nx) {
    const unsigned G = gridDim.x * gridDim.y * gridDim.z;
    unsigned sum, cnt, mine, sp = 0u;
    for (;;) {
        sum = 0u; cnt = 0u; mine = 0u;
#pragma unroll
        for (unsigned j = 0; j < 16; ++j) { const unsigned c = xb_ld(&bar[XB_XCNT(j)]); sum += c; cnt += (c > 0u) ? 1u : 0u; mine = (j == x) ? c : mine; }
        if (sum == G) break;
        __builtin_amdgcn_s_sleep(1);
        if ((++sp & 255u) == 0u) { if (xb_ld(&bar[XB_TMO])) break; if (sp > XB_SPIN_CAP) { atomicAdd(&bar[XB_TMO], 1u); break; } }
    }
    nloc = mine > 0u ? mine : 1u; nx = cnt > 0u ? cnt : 1u;
}
__device__ __forceinline__ void xcd_barrier(const XcdBarrier& b) {
    asm volatile("s_waitcnt vmcnt(0)" ::: "memory");
    __syncthreads();
    if (b.w == 0u && lane_id_() == 0u) {
        unsigned* bar = b.bar;
        __builtin_amdgcn_s_waitcnt(0);
        unsigned nloc = b.st[0], nx = b.st[1];
        if (nloc == 0u) { xcd_barrier_complete(bar, b.x, nloc, nx); b.st[0] = nloc; b.st[1] = nx; }
        const unsigned old = xb_add(&bar[XB_XSUB(b.x)], 1u);
        const unsigned gen = old / nloc;
        if (old + 1u == (gen + 1u) * nloc) {
            __builtin_amdgcn_fence(__ATOMIC_RELEASE, "agent");
            asm volatile("s_waitcnt vmcnt(0)" ::: "memory");
            const unsigned og = xb_add(&bar[XB_TOP], 1u);
            const unsigned tg = og / nx;
            if (og + 1u == (tg + 1u) * nx) xb_add(&bar[XB_TOPGEN], 1u);
            else XB_SPIN(xb_ld(&bar[XB_TOPGEN]) == tg, bar);
            __builtin_amdgcn_fence(__ATOMIC_ACQUIRE, "agent");
            xb_add(&bar[XB_XGEN(b.x)], 1u);
            asm volatile("s_waitcnt vmcnt(0)" ::: "memory");
        } else {
            XB_SPIN(xb_ld(&bar[XB_XGEN(b.x)]) == gen, bar);
            __builtin_amdgcn_fence(__ATOMIC_ACQUIRE, "agent");
            asm volatile("s_waitcnt vmcnt(0)" ::: "memory");
        }
    }
    __syncthreads();
}


constexpr int MOD_KS = 16, MOD_KC = 2048 / MOD_KS;
constexpr size_t WS_MODP = WS_X;
__device__ __forceinline__ void ph_mod_partial(const P& p, int tid, float* sc) {
    for (int i = tid; i < 5 * 2048; i += NTHR_) { const int c = i >> 11, k = i & 2047; const float v = c == 0 ? p.in[12][k] : p.in[11][(c - 1) * 2048 + k]; sc[i] = siluf_(v); }
    __syncthreads();
    const int NU = 2 * 3072 * MOD_KS;
    for (int u = blockIdx.x * NTHR_ + tid; u < NU; u += gridDim.x * NTHR_) {
        const int cg = u % 3072, kc = (u / 3072) % MOD_KS, l = u / (3072 * MOD_KS);
        const float* w = p.in[13] + ((size_t)l * 2048 + kc * MOD_KC) * 12288 + cg * 4;
        f32x4 a0 = {0.f, 0.f, 0.f, 0.f}, a1 = a0, a2 = a0, a3 = a0, a4 = a0;
#pragma unroll 8
        for (int k = 0; k < MOD_KC; ++k) { const f32x4 wv = *(const f32x4*)(w + (size_t)k * 12288); const int kk = kc * MOD_KC + k;
            a0 += wv * sc[kk]; a1 += wv * sc[2048 + kk]; a2 += wv * sc[4096 + kk]; a3 += wv * sc[6144 + kk]; a4 += wv * sc[8192 + kk]; }
        float* o = (float*)(p.ws + WS_MODP) + ((size_t)(kc * 2 + l) * 5) * 12288 + cg * 4;
        *(f32x4*)o = a0; *(f32x4*)(o + 12288) = a1; *(f32x4*)(o + 2 * 12288) = a2; *(f32x4*)(o + 3 * 12288) = a3; *(f32x4*)(o + 4 * 12288) = a4;
    }
    if (blockIdx.x == 0) {
        float* rt = (float*)(p.ws + WS_ROPE);
        for (int i = tid; i < 1024; i += NTHR_) { const int pos = i >> 4, j = i & 15; const float inv = exp2f(-(float)j * (13.287712379549449f / 16.0f)); float s_, c_; sincos_small((float)pos * inv, s_, c_); rt[i] = c_; rt[1024 + i] = s_; }
    }
}
__device__ __forceinline__ void ph_mod_reduce(const P& p, int tid) {
    for (int i = blockIdx.x * NTHR_ + tid; i < 2 * 5 * 12288; i += gridDim.x * NTHR_) {
        const int n = i % 12288, l = (i / 12288) / 5; float acc = p.in[14][l * 12288 + n];
#pragma unroll
        for (int kc = 0; kc < MOD_KS; ++kc) acc += ((const float*)(p.ws + WS_MODP))[(size_t)kc * 2 * 5 * 12288 + i];
        ((float*)(p.ws + WS_MOD))[i] = acc;
    }
}

__device__ __forceinline__ void ph_hnorm_row(const P& p, int l, int which, int r, int lane) {
    const float* x = which == 0 ? x_src(p, l, r) : (const float*)(p.ws + WS_X) + (size_t)r * D;
    const float* nw = p.in[which == 0 ? 15 : 16] + l * 2048;
    const float* mod = (const float*)(p.ws + WS_MOD) + ((size_t)l * 5 + cond_of_row(r)) * 12288 + (which == 0 ? 0 : 3 * 2048);
    f32x4 v[8]; float ss = 0.f;
#pragma unroll
    for (int j = 0; j < 8; ++j) { v[j] = *(const f32x4*)(x + j * 256 + lane * 4); ss += v[j][0] * v[j][0] + v[j][1] * v[j][1] + v[j][2] * v[j][2] + v[j][3] * v[j][3]; }
    const float rstd = rsqrtf(wave_sum(ss) * (1.0f / 2048.0f) + 1e-6f);
    bf16_t* o = (bf16_t*)(p.ws + WS_H) + (size_t)r * D;
#pragma unroll
    for (int j = 0; j < 8; ++j) { const int c = j * 256 + lane * 4; const f32x4 g = *(const f32x4*)(nw + c), sh = *(const f32x4*)(mod + c), s1 = *(const f32x4*)(mod + 2048 + c);
        float y[4];
#pragma unroll
        for (int e = 0; e < 4; ++e) y[e] = v[j][e] * rstd * g[e] * (1.0f + s1[e]) + sh[e];
        u32x2 w; w.x = pk2(y[0], y[1]); w.y = pk2(y[2], y[3]); *(u32x2*)(o + c) = w; }
}

namespace pg8 {
#define PG8_LAS __attribute__((address_space(3)))
typedef unsigned short bf16_t;
typedef short bf16x8 __attribute__((ext_vector_type(8)));
typedef float f32x4 __attribute__((ext_vector_type(4)));
typedef unsigned u32x4 __attribute__((ext_vector_type(4)));
constexpr int BM = 256, BK = 64, HALF = 128, HTB = HALF * BK * 2  , STAGE_BYTES = 8 * HTB, NXCD = 8, WGM = 8;

__host__ __device__ __forceinline__ int lds_byte(int r, int c) { const int st = (r >> 4) * 2 + (c >> 5), rr = r & 15, cc = c & 31, ob = rr * 64 + cc * 2; return st * 1024 + (ob ^ (((ob >> 9) & 1) << 5)); }
__host__ __device__ __forceinline__ void stage_rc(int b, int& R, int& C) { const int st = b / 1024, sb = b % 1024, swz = sb ^ (((sb >> 9) & 1) << 5); R = (st >> 1) * 16 + swz / 64; C = (st & 1) * 32 + (swz % 64) / 2; }
__host__ __device__ __forceinline__ int perm32(int rho) { const int n = rho >> 4, i = rho & 15; return 8 * (i >> 2) + 4 * n + (i & 3); }

struct Unit { int pm, pn; };
struct Gemm { const bf16_t* A; const bf16_t* Bt; int M, N, K; };

struct StaticOrder {
    int nM, nN, nwg, G, c;
    __host__ __device__ void init(int M, int N, int G_, int c_) { nM = M / BM; nN = N / BM; nwg = nM * nN; G = G_; c = c_; }
    __host__ __device__ bool next(int i, Unit& u) const {
        const long L = (long)i * G + c; if (L >= nwg) return false;
        int wgid = (int)L; { const int q = nwg / NXCD, r = nwg % NXCD, xcd = wgid % NXCD, off = wgid / NXCD; wgid = (xcd < r ? xcd * (q + 1) : r * (q + 1) + (xcd - r) * q) + off; }
        const int nig = WGM * nN, gid = wgid / nig, fm = gid * WGM, gsz = (nM - fm) < WGM ? (nM - fm) : WGM;
        u.pm = fm + ((wgid % nig) % gsz); u.pn = (wgid % nig) / gsz; return true;
    }
    __device__ __forceinline__ void a_ready(const Unit&) const {}
    __device__ __forceinline__ void done(const Unit&) const {}
};

__device__ __forceinline__ unsigned cvt_pk_bf16(float lo, float hi) { unsigned r; asm volatile("s_nop 0\n\tv_cvt_pk_bf16_f32 %0, %1, %2" : "=v"(r) : "v"(lo), "v"(hi)); return r; }

template <class Epi, class Sched, bool ALIGN_EPI = false, bool SP2 = false>
__device__ __forceinline__ void gemm_phase(PG8_LAS unsigned char* lds, const Gemm g, const Sched& S, const Epi& E, int tid_in) {
    int tid_l = tid_in; asm volatile("" : "+v"(tid_l));
    const int tid = tid_l, wid = __builtin_amdgcn_readfirstlane(tid >> 6), lane = tid & 63, wr = wid >> 2, wc = wid & 3, fr = lane & 15, fq = lane >> 4;
    const int K = g.K, nt = K / BK;
    unsigned voffA[2], voffB[2];
#pragma unroll
    for (int i = 0; i < 2; ++i) { int R, C; stage_rc(tid * 16 + i * 8192, R, C); const int Rb = Epi::PERM ? ((R & ~31) + perm32(R & 31)) : R;
        voffA[i] = (unsigned)(R * K + C) * 2u; voffB[i] = (unsigned)(Rb * K + C) * 2u; }
    const size_t kstep = (size_t)(BK * 2);
    const size_t hstep = (size_t)HALF * K * 2;
    const size_t tstep = 2 * hstep;
    const unsigned ldsw = (unsigned)wid * 1024u;
    const int aoff = lds_byte(wr * 64 + fr, fq * 8), boff = lds_byte(wc * 32 + fr, fq * 8);
#define PG8_SA(b, h) (((b) * 2 + (h)) * HTB)
#define PG8_SB(b, h) ((4 + (b) * 2 + (h)) * HTB)
#define PG8_STAGE(bufoff, gbase, voff) do { _Pragma("unroll") for (int _i = 0; _i < 2; ++_i) \
        __builtin_amdgcn_global_load_lds((const unsigned*)((const char*)(gbase) + (voff)[_i]), (PG8_LAS unsigned*)(lds + (bufoff) + ldsw + _i * 8192), 16, 0, 0); } while (0)
#define PG8_LDA(dst, b, h) do { _Pragma("unroll") for (int m = 0; m < 4; ++m) _Pragma("unroll") for (int k = 0; k < 2; ++k) dst[m][k] = *(const PG8_LAS bf16x8*)(lds + PG8_SA(b, h) + aoff + m * 2048 + k * 1024); } while (0)
#define PG8_LDB(dst, b, h) do { _Pragma("unroll") for (int n = 0; n < 2; ++n) _Pragma("unroll") for (int k = 0; k < 2; ++k) dst[n][k] = *(const PG8_LAS bf16x8*)(lds + PG8_SB(b, h) + boff + n * 2048 + k * 1024); } while (0)
#define PG8_MMA(ai, bj, At, Bt) do { __builtin_amdgcn_s_setprio(1); _Pragma("unroll") for (int m = 0; m < 4; ++m) _Pragma("unroll") for (int n = 0; n < 2; ++n) _Pragma("unroll") for (int k = 0; k < 2; ++k) \
        acc[ai][bj][m][n] = __builtin_amdgcn_mfma_f32_16x16x32_bf16(Bt[n][k], At[m][k], acc[ai][bj][m][n], 0, 0, 0); __builtin_amdgcn_s_setprio(0); } while (0)
#define PG8_WAIT_V(n) asm volatile("s_waitcnt vmcnt(" #n ")" ::: "memory")
#define PG8_WAIT_L(n) asm volatile("s_waitcnt lgkmcnt(" #n ")" ::: "memory")
#define PG8_BAR __builtin_amdgcn_s_barrier()
#define PG8_SCHED __builtin_amdgcn_sched_barrier(0)
    Unit cur, nxt; int ui = 0;
    if (!S.next(0, cur)) return;
    f32x4 acc[2][2][4][2];
    { float z0 = 0.f; asm volatile("" : "+v"(z0));
#pragma unroll
    for (int a = 0; a < 2; ++a)
#pragma unroll
        for (int b = 0; b < 2; ++b)
#pragma unroll
            for (int m = 0; m < 4; ++m)
#pragma unroll
                for (int n = 0; n < 2; ++n) acc[a][b][m][n] = (f32x4){z0, z0, z0, z0}; }
    bf16x8 At[4][2], B0[2][2], B1[2][2];
    const char* cA = (const char*)g.A + (size_t)cur.pm * tstep; const char* cB = (const char*)g.Bt + (size_t)cur.pn * tstep;
    S.a_ready(cur);
    if constexpr (SP2) {
        PG8_STAGE(PG8_SB(0, 0), cB, voffB); PG8_STAGE(PG8_SB(0, 1), cB + hstep, voffB); PG8_STAGE(PG8_SA(0, 0), cA, voffA); PG8_STAGE(PG8_SA(0, 1), cA + hstep, voffA);
        if (wr == 1) PG8_BAR;
        PG8_WAIT_V(2); PG8_BAR;
        PG8_STAGE(PG8_SB(1, 0), cB + kstep, voffB); PG8_STAGE(PG8_SA(1, 0), cA + kstep, voffA); PG8_STAGE(PG8_SB(1, 1), cB + hstep + kstep, voffB);
        PG8_WAIT_V(6); PG8_BAR;
    } else {
        PG8_STAGE(PG8_SB(0, 0), cB, voffB); PG8_STAGE(PG8_SA(0, 0), cA, voffA); PG8_STAGE(PG8_SB(0, 1), cB + hstep, voffB); PG8_STAGE(PG8_SA(0, 1), cA + hstep, voffA);
        if (wr == 1) PG8_BAR;
        PG8_WAIT_V(4); PG8_BAR;
        PG8_STAGE(PG8_SB(1, 0), cB + kstep, voffB); PG8_STAGE(PG8_SA(1, 0), cA + kstep, voffA); PG8_STAGE(PG8_SB(1, 1), cB + hstep + kstep, voffB);
        PG8_WAIT_V(6); PG8_BAR;
    }
    for (;;) {
        const bool has_next = S.next(ui + 1, nxt);
        const char* nA = has_next ? (const char*)g.A + (size_t)nxt.pm * tstep : cA; const char* nB = has_next ? (const char*)g.Bt + (size_t)nxt.pn * tstep : cB;
        for (int t = 0; t < nt; t += 2) {
            const bool last = (t == nt - 2);
            const char* a1 = cA + (size_t)(t + 1) * kstep;
            const char* a2 = last ? nA : cA + (size_t)(t + 2) * kstep; const char* b2 = last ? nB : cB + (size_t)(t + 2) * kstep;
            const char* a3 = a2 + kstep; const char* b3 = b2 + kstep;
            if (last && has_next) S.a_ready(nxt);
            if constexpr (SP2) {
            PG8_LDB(B0, 0, 0); PG8_LDB(B1, 0, 1); PG8_SCHED; PG8_LDA(At, 0, 0); PG8_STAGE(PG8_SA(1, 1), a1 + hstep, voffA);
            PG8_WAIT_V(8); PG8_WAIT_L(0); PG8_BAR; PG8_MMA(0, 0, At, B0); PG8_MMA(0, 1, At, B1); PG8_BAR; PG8_SCHED;
            PG8_LDA(At, 0, 1); PG8_STAGE(PG8_SB(0, 0), b2, voffB); PG8_STAGE(PG8_SB(0, 1), b2 + hstep, voffB); PG8_STAGE(PG8_SA(0, 0), a2, voffA);
            PG8_WAIT_V(8); PG8_WAIT_L(0); PG8_BAR; PG8_MMA(1, 0, At, B0); PG8_MMA(1, 1, At, B1); PG8_BAR; PG8_SCHED;
            PG8_LDB(B0, 1, 0); PG8_LDB(B1, 1, 1); PG8_SCHED; PG8_LDA(At, 1, 0); PG8_STAGE(PG8_SA(0, 1), a2 + hstep, voffA);
            PG8_WAIT_V(8); PG8_WAIT_L(0); PG8_BAR; PG8_MMA(0, 0, At, B0); PG8_MMA(0, 1, At, B1); PG8_BAR; PG8_SCHED;
            PG8_LDA(At, 1, 1); PG8_STAGE(PG8_SB(1, 0), b3, voffB); PG8_STAGE(PG8_SB(1, 1), b3 + hstep, voffB); PG8_STAGE(PG8_SA(1, 0), a3, voffA);
            PG8_WAIT_V(8); PG8_WAIT_L(0); PG8_BAR; PG8_MMA(1, 0, At, B0); PG8_MMA(1, 1, At, B1); PG8_BAR; PG8_SCHED;
            } else {
            PG8_LDB(B0, 0, 0); PG8_SCHED; PG8_LDA(At, 0, 0); PG8_STAGE(PG8_SA(1, 1), a1 + hstep, voffA);
            PG8_WAIT_L(8); PG8_BAR; PG8_WAIT_L(0); PG8_MMA(0, 0, At, B0); PG8_BAR; PG8_SCHED;
            PG8_LDB(B1, 0, 1); PG8_STAGE(PG8_SB(0, 0), b2, voffB);
            PG8_BAR; PG8_WAIT_L(0); PG8_MMA(0, 1, At, B1); PG8_BAR;
            PG8_LDA(At, 0, 1); PG8_STAGE(PG8_SA(0, 0), a2, voffA);
            PG8_BAR; PG8_WAIT_L(0); PG8_MMA(1, 0, At, B0); PG8_BAR; PG8_SCHED;
            PG8_STAGE(PG8_SB(0, 1), b2 + hstep, voffB);
            PG8_WAIT_V(6); PG8_BAR; PG8_MMA(1, 1, At, B1); PG8_BAR;
            PG8_LDB(B0, 1, 0); PG8_SCHED; PG8_LDA(At, 1, 0); PG8_STAGE(PG8_SA(0, 1), a2 + hstep, voffA);
            PG8_WAIT_L(8); PG8_BAR; PG8_WAIT_L(0); PG8_MMA(0, 0, At, B0); PG8_BAR; PG8_SCHED;
            PG8_LDB(B1, 1, 1); PG8_STAGE(PG8_SB(1, 0), b3, voffB);
            PG8_BAR; PG8_WAIT_L(0); PG8_MMA(0, 1, At, B1); PG8_BAR;
            PG8_LDA(At, 1, 1); PG8_STAGE(PG8_SA(1, 0), a3, voffA);
            PG8_BAR; PG8_WAIT_L(0); PG8_MMA(1, 0, At, B0); PG8_BAR; PG8_SCHED;
            PG8_STAGE(PG8_SB(1, 1), b3 + hstep, voffB);
            PG8_WAIT_V(6); PG8_BAR; PG8_MMA(1, 1, At, B1); PG8_BAR;
            }
        }
        if constexpr (ALIGN_EPI) { if (wr == 0) PG8_BAR; }
        if constexpr (!Epi::AFTER_DRAIN) { E(acc, cur, wr, wc, fr, fq); S.done(cur); }
        if (!has_next) break;
        { float z0 = 0.f; asm volatile("" : "+v"(z0));
#pragma unroll
        for (int a = 0; a < 2; ++a)
#pragma unroll
            for (int b = 0; b < 2; ++b)
#pragma unroll
                for (int m = 0; m < 4; ++m)
#pragma unroll
                    for (int n = 0; n < 2; ++n) acc[a][b][m][n] = (f32x4){z0, z0, z0, z0}; }
        cur = nxt; cA = nA; cB = nB; ++ui;
        if constexpr (ALIGN_EPI) { if (wr == 1) PG8_BAR; }
    }
    PG8_WAIT_V(0);
    if constexpr (!ALIGN_EPI) { if (wr == 0) PG8_BAR; }
    PG8_BAR;
    if constexpr (Epi::AFTER_DRAIN) { E.fused(acc, cur, wr, wc, fr, fq, lds, wid, lane); S.done(cur); }
#undef PG8_SA
#undef PG8_SB
#undef PG8_STAGE
#undef PG8_LDA
#undef PG8_LDB
#undef PG8_MMA
#undef PG8_WAIT_V
#undef PG8_WAIT_L
#undef PG8_BAR
#undef PG8_SCHED
}
}

#define PG8_ROW(ai, m) (u.pm * 256 + (ai) * 128 + wr * 64 + (m) * 16 + fr)
#define PG8_FOR(...) _Pragma("unroll") for (int ai = 0; ai < 2; ++ai) _Pragma("unroll") for (int m = 0; m < 4; ++m) { const int row = PG8_ROW(ai, m); _Pragma("unroll") for (int bj = 0; bj < 2; ++bj) { \
    const int ct = bj * 128 + wc * 32 + 8 * fq; const pg8::f32x4 v0 = acc[ai][bj][m][0], v1 = acc[ai][bj][m][1]; __VA_ARGS__ } }
__device__ __forceinline__ u32x4 pack8(const pg8::f32x4& a, const pg8::f32x4& b) { u32x4 w; w.x = pg8::cvt_pk_bf16(a[0], a[1]); w.y = pg8::cvt_pk_bf16(a[2], a[3]); w.z = pg8::cvt_pk_bf16(b[0], b[1]); w.w = pg8::cvt_pk_bf16(b[2], b[3]); return w; }
__device__ __forceinline__ void unpack8(const u32x4& w, float (&f)[8]) {
#pragma unroll
    for (int i = 0; i < 4; ++i) { f[2 * i] = bf2f(w[i]); f[2 * i + 1] = bf2f(w[i] >> 16); } }

struct Epi8In {
    static constexpr bool PERM = true, AFTER_DRAIN = false;
    unsigned char* ws;
    __device__ __forceinline__ void operator()(const pg8::f32x4 (&acc)[2][2][4][2], const pg8::Unit& u, int wr, int wc, int fr, int fq) const {
        const int pn = u.pn;
        if (pn >= 22 && pn < 25) {
            float* kva = (float*)(ws + WS_KVA);
            PG8_FOR({ float* o = kva + (size_t)row * KVAW + (pn - 22) * 256 + ct; *(pg8::f32x4*)o = v0; *(pg8::f32x4*)(o + 4) = v1; })
            return;
        }
        size_t base; int ldc, c0, mode = 0;
        if (pn < 4) { base = WS_MLQ; ldc = 1024; c0 = pn * 256; }
        else if (pn < 8) { base = WS_MLK; ldc = 1024; c0 = (pn - 4) * 256; mode = 1; }
        else if (pn < 12) { base = WS_MLV; ldc = 1024; c0 = (pn - 8) * 256; }
        else if (pn < 16) { base = WS_MLO; ldc = 1024; c0 = (pn - 12) * 256; mode = 2; }
        else if (pn < 22) { base = WS_MQ; ldc = 1536; c0 = (pn - 16) * 256; mode = 3; }
        else if (pn < 29) { base = WS_S5U; ldc = 1024; c0 = (pn - 25) * 256; }
        else if (pn < 33) { base = WS_DFQ; ldc = 1024; c0 = (pn - 29) * 256; mode = 4; }
        else if (pn < 37) { base = WS_DFK; ldc = 1024; c0 = (pn - 33) * 256; }
        else { base = WS_DFV; ldc = 1024; c0 = (pn - 37) * 256; }
        bf16_t* O = (bf16_t*)(ws + base);
        PG8_FOR({ pg8::f32x4 a = v0, b = v1;
            if (mode == 1) { a = a * 0.0625f; b = b * 0.0625f; }
            if (mode == 3) { a = a * (0.07216878364870322f * 1.4426950408889634f); b = b * (0.07216878364870322f * 1.4426950408889634f); }
            if (mode == 4) { a = a * (0.125f * 1.4426950408889634f); b = b * (0.125f * 1.4426950408889634f); }
            if (mode == 2) {
_Pragma("unroll")
                for (int e = 0; e < 4; ++e) { a[e] = sigmoidf_(a[e]); b[e] = sigmoidf_(b[e]); } }
            *(u32x4*)(O + (size_t)row * ldc + c0 + ct) = pack8(a, b); })
    }
};
struct Epi8Gate {
    static constexpr bool PERM = true, AFTER_DRAIN = false;
    bf16_t* gs;
    __device__ __forceinline__ void operator()(const pg8::f32x4 (&acc)[2][2][4][2], const pg8::Unit& u, int wr, int wc, int fr, int fq) const {
        PG8_FOR({ pg8::f32x4 a, b;
_Pragma("unroll")
            for (int e = 0; e < 4; ++e) { a[e] = sigmoidf_(v0[e]); b[e] = sigmoidf_(v1[e]); }
            *(u32x4*)(gs + (size_t)row * GATE_COLS + u.pn * 256 + ct) = pack8(a, b); })
    }
};
struct Epi8Kvb {
    static constexpr bool PERM = true, AFTER_DRAIN = false;
    bf16_t* kf; bf16_t* vf;
    __device__ __forceinline__ void operator()(const pg8::f32x4 (&acc)[2][2][4][2], const pg8::Unit& u, int wr, int wc, int fr, int fq) const {
        PG8_FOR({ bf16_t* o = bj == 0 ? kf + (size_t)row * 1536 + u.pn * 192 + wc * 32 + 8 * fq : vf + (size_t)row * 1024 + u.pn * 128 + wc * 32 + 8 * fq; (void)ct;
            *(u32x4*)o = pack8(v0, v1); })
    }
};
struct Epi8Glu {
    static constexpr bool PERM = true, AFTER_DRAIN = false;
    const bf16_t* g; bf16_t* y;
    __device__ __forceinline__ void operator()(const pg8::f32x4 (&acc)[2][2][4][2], const pg8::Unit& u, int wr, int wc, int fr, int fq) const {
        PG8_FOR({ const size_t i = (size_t)row * 1024 + u.pn * 256 + ct; float gf[8]; unpack8(*(const u32x4*)(g + i), gf); pg8::f32x4 a, b;
_Pragma("unroll")
            for (int e = 0; e < 4; ++e) { a[e] = gf[e] * sigmoidf_(v0[e]); b[e] = gf[4 + e] * sigmoidf_(v1[e]); }
            *(u32x4*)(y + i) = pack8(a, b); })
    }
};
struct Epi8Merge {
    static constexpr bool PERM = true, AFTER_DRAIN = false;
    const bf16_t* gs; bf16_t* mg; int b; int pad;
    __device__ __forceinline__ void operator()(const pg8::f32x4 (&acc)[2][2][4][2], const pg8::Unit& u, int wr, int wc, int fr, int fq) const {
        PG8_FOR({ const size_t i = (size_t)row * D + u.pn * 256 + ct; float gf[8], pf[8]; unpack8(*(const u32x4*)(gs + (size_t)row * GATE_COLS + b * D + u.pn * 256 + ct), gf);
            if (b) unpack8(*(const u32x4*)(mg + i), pf); else {
_Pragma("unroll")
                for (int e = 0; e < 8; ++e) pf[e] = 0.f; }
            pg8::f32x4 a, c;
_Pragma("unroll")
            for (int e = 0; e < 4; ++e) { a[e] = pf[e] + gf[e] * v0[e]; c[e] = pf[4 + e] + gf[4 + e] * v1[e]; }
            *(u32x4*)(mg + i) = pack8(a, c); })
    }
};
struct Epi8Res {
    static constexpr bool PERM = true, AFTER_DRAIN = false;
    P p; int l; int goff; int from_x; int pad;
    __device__ __forceinline__ void operator()(const pg8::f32x4 (&acc)[2][2][4][2], const pg8::Unit& u, int wr, int wc, int fr, int fq) const {
        float* X = (float*)(p.ws + WS_X);
        const float* gv = (const float*)(p.ws + WS_MOD) + ((size_t)l * 5 + cond_of_row(u.pm * 256)) * 12288 + goff + u.pn * 256;
        PG8_FOR({ const float* src = (from_x ? X + (size_t)row * D : x_src(p, l, row)) + u.pn * 256 + ct; float* dst = X + (size_t)row * D + u.pn * 256 + ct;
            const pg8::f32x4 g0 = *(const pg8::f32x4*)(gv + ct), g1 = *(const pg8::f32x4*)(gv + ct + 4), s0 = *(const pg8::f32x4*)src, s1 = *(const pg8::f32x4*)(src + 4);
            *(pg8::f32x4*)dst = s0 + g0 * v0; *(pg8::f32x4*)(dst + 4) = s1 + g1 * v1; })
    }
};
struct Epi8FfnIn {
    static constexpr bool PERM = true, AFTER_DRAIN = false;
    bf16_t* hh;
    __device__ __forceinline__ void operator()(const pg8::f32x4 (&acc)[2][2][4][2], const pg8::Unit& u, int wr, int wc, int fr, int fq) const {
_Pragma("unroll")
        for (int ai = 0; ai < 2; ++ai)
_Pragma("unroll")
            for (int m = 0; m < 4; ++m) { const int row = PG8_ROW(ai, m); pg8::f32x4 a, b;
_Pragma("unroll")
                for (int e = 0; e < 4; ++e) { a[e] = siluf_(acc[ai][0][m][0][e]) * acc[ai][1][m][0][e]; b[e] = siluf_(acc[ai][0][m][1][e]) * acc[ai][1][m][1][e]; }
                *(u32x4*)(hh + (size_t)row * FFN + u.pn * 128 + wc * 32 + 8 * fq) = pack8(a, b); }
    }
};

__device__ __forceinline__ int win_row(int n) {
    if (n < 4096) return n;
    if (n < 4112) return 6208 + (n - 4096);
    if (n < 5648) return 4096 + (n - 4112);
    if (n < 6224) return 5632 + (n - 5648);
    if (n < MIX_COLS) return 6400 + (n - 6224);
    return 10496 + (n - MIX_COLS);
}
template <int MAP>
__device__ __forceinline__ void cvt_item(const float* W, int K, int N, bf16_t* WT, int row_off, LAS float* scr, int item, int lane) {
    const int nblk = (N + 31) / 32, kb = item / nblk, nb = item % nblk, k0 = 64 * kb, n0 = 32 * nb;
    const int nl = (lane & 7) * 4, kr = lane >> 3;
    const bool nok = n0 + nl < N;
    const float* wp = W + (size_t)(k0 + kr) * N + n0 + nl;
    f32x4 v[8];
#pragma unroll
    for (int i = 0; i < 8; ++i) v[i] = nok ? *(const f32x4*)(wp + (size_t)(8 * i) * N) : (f32x4){0.f, 0.f, 0.f, 0.f};
#pragma unroll
    for (int i = 0; i < 8; ++i) { LAS float* d = scr + (kr + 8 * i) * 33 + nl; d[0] = v[i][0]; d[1] = v[i][1]; d[2] = v[i][2]; d[3] = v[i][3]; }
    asm volatile("s_waitcnt lgkmcnt(0)" ::: "memory");
    const int c = lane & 7;
#pragma unroll
    for (int j = 0; j < 4; ++j) { const int n = (lane >> 3) + 8 * j; const LAS float* s = scr + (8 * c) * 33 + n;
        u32x4 o; o.x = pk2(s[0 * 33], s[1 * 33]); o.y = pk2(s[2 * 33], s[3 * 33]); o.z = pk2(s[4 * 33], s[5 * 33]); o.w = pk2(s[6 * 33], s[7 * 33]);
        const int ng = n0 + n; int row;
        if (MAP == 0) row = row_off + ng; else if (MAP == 1) row = win_row(ng); else row = (ng < FFN) ? ((ng >> 7) * 256 + (ng & 127)) : (((ng - FFN) >> 7) * 256 + 128 + ((ng - FFN) & 127));
        if (ng < N) *(u32x4*)(WT + (size_t)row * K + k0 + 8 * c) = o; }
    asm volatile("s_waitcnt lgkmcnt(0)" ::: "memory");
}
constexpr size_t WB_IN = 0, WB_KVB = 73 * MiB, WB_GLU = 75 * MiB, WB_BR = 77 * MiB, WB_O = 93 * MiB, WB_FIN = 101 * MiB, WB_FOUT = 145 * MiB, WB_END = 167 * MiB;
constexpr int NIN_T = 18688;
__device__ __forceinline__ void ph_convert(const P& p, int l, int gw, int NGW, int lane, LAS float* scr, const bool early, const bool late) {
    unsigned char* wb = p.ws + WS_WBF;
    constexpr int I_IN = (D / 64) * ((IN_COLS + 31) / 32), I_KVB = (512 / 64) * (2048 / 32), I_GLU = (1024 / 64) * (1024 / 32), I_BR = (1024 / 64) * (2048 / 32), I_O = (D / 64) * (D / 32),
                  I_FIN = (D / 64) * (2 * FFN / 32), I_FOUT = (FFN / 64) * (D / 32);
    constexpr int NIT = I_IN + I_KVB + I_GLU + 4 * I_BR + I_O + I_FIN + I_FOUT;
    const int it_lo = early ? 0 : NIT - I_FOUT, it_hi = late ? NIT : NIT - I_FOUT;
    for (int it = it_lo + gw; it < it_hi; it += NGW) {
        int r = it;
        if (r < I_IN) { cvt_item<1>(p.in[17] + (size_t)l * D * IN_COLS, D, IN_COLS, (bf16_t*)(wb + WB_IN), 0, scr, r, lane); continue; } r -= I_IN;
        if (r < I_KVB) { cvt_item<0>(p.in[21] + (size_t)l * 512 * 2048, 512, 2048, (bf16_t*)(wb + WB_KVB), 0, scr, r, lane); continue; } r -= I_KVB;
        if (r < I_GLU) { cvt_item<0>(p.in[30] + (size_t)l * 1024 * 1024, 1024, 1024, (bf16_t*)(wb + WB_GLU), 0, scr, r, lane); continue; } r -= I_GLU;
        if (r < 4 * I_BR) { const int b = r / I_BR; cvt_item<0>(p.in[33] + ((size_t)l * 4 + b) * 1024 * 2048, 1024, 2048, (bf16_t*)(wb + WB_BR) + (size_t)b * 2048 * 1024, 0, scr, r % I_BR, lane); continue; } r -= 4 * I_BR;
        if (r < I_O) { cvt_item<0>(p.in[34] + (size_t)l * D * D, D, D, (bf16_t*)(wb + WB_O), 0, scr, r, lane); continue; } r -= I_O;
        if (r < I_FIN) { cvt_item<2>(p.in[35] + (size_t)l * D * 2 * FFN, D, 2 * FFN, (bf16_t*)(wb + WB_FIN), 0, scr, r, lane); continue; } r -= I_FIN;
        cvt_item<0>(p.in[36] + (size_t)l * FFN * D, FFN, D, (bf16_t*)(wb + WB_FOUT), 0, scr, r, lane);
    }
    if (early) for (int row = 6224 + gw; row < 6400; row += NGW) { u32x4* o = (u32x4*)((bf16_t*)(wb + WB_IN) + (size_t)row * D); for (int j = lane; j < D / 8; j += 64) o[j] = (u32x4){0u, 0u, 0u, 0u}; }
}


__device__ __forceinline__ int xcd_slot() { const int G_ = (int)gridDim.x, c_ = (int)blockIdx.x; return (G_ % 8 == 0) ? (c_ % 8) * (G_ / 8) + c_ / 8 : c_; }
namespace fa {
typedef short s16x4 __attribute__((ext_vector_type(4)));
__device__ __forceinline__ int crow(int r, int hi) { return (r & 3) + 8 * (r >> 2) + 4 * hi; }
__device__ __forceinline__ unsigned cvtpk(float lo, float hi) { unsigned r; asm volatile("v_cvt_pk_bf16_f32 %0, %1, %2" : "=v"(r) : "v"(lo), "v"(hi)); return r; }
#define FA_SBAR() __builtin_amdgcn_sched_barrier(0)
constexpr float THR = 8.f;
__device__ __forceinline__ void partialSM_fma(f32x16& p0, f32x16& p1, float& m_reg, float& mn, float& alpha, float SCALE) {
    const float C = SCALE * 1.4426950408889634f;
    float pmax = p0[0];
#pragma unroll
    for (int r = 1; r < 16; ++r) pmax = fmaxf(pmax, p0[r]);
#pragma unroll
    for (int r = 0; r < 16; ++r) pmax = fmaxf(pmax, p1[r]);
    { auto rr = __builtin_amdgcn_permlane32_swap(__float_as_uint(pmax), __float_as_uint(pmax), false, false);
      pmax = fmaxf(__uint_as_float(rr[0]), __uint_as_float(rr[1])); }
    if (__builtin_expect(__all(pmax - m_reg <= THR / SCALE), 1)) { mn = m_reg; alpha = 1.f; }
    else { mn = fmaxf(m_reg, pmax); alpha = __builtin_amdgcn_exp2f((m_reg - mn) * C); m_reg = mn; }
    const float mnC = -mn * C;
#pragma unroll
    for (int r = 0; r < 16; ++r) p0[r] = fmaf(p0[r], C, mnC);
#pragma unroll
    for (int r = 0; r < 16; ++r) p1[r] = fmaf(p1[r], C, mnC);
#pragma unroll
    for (int r = 0; r < 16; ++r) p0[r] = __builtin_amdgcn_exp2f(p0[r]);
}
constexpr float THR2 = THR * 1.4426950408889634f;
__device__ __forceinline__ void partialSM(f32x16& p0, f32x16& p1, float& m_reg, f32x16& nm, float& alpha, const bool first) {
    float pmax = p0[0];
#pragma unroll
    for (int r = 1; r < 16; ++r) pmax = fmaxf(pmax, p0[r]);
#pragma unroll
    for (int r = 0; r < 16; ++r) pmax = fmaxf(pmax, p1[r]);
    { auto rr = __builtin_amdgcn_permlane32_swap(__float_as_uint(pmax), __float_as_uint(pmax), false, false);
      pmax = fmaxf(__uint_as_float(rr[0]), __uint_as_float(rr[1])); }
    alpha = 1.f;
    if (first || !__all(pmax <= THR2)) {
        const float d = first ? pmax : fmaxf(pmax, 0.f);
        if (!first) alpha = __builtin_amdgcn_exp2f(-d);
        m_reg += d;
#pragma unroll
        for (int r = 0; r < 16; ++r) { p0[r] -= d; p1[r] -= d; nm[r] = -m_reg; }
    }
#pragma unroll
    for (int r = 0; r < 16; ++r) p0[r] = __builtin_amdgcn_exp2f(p0[r]);
}
__device__ __forceinline__ void finishSM(f32x16& p0, f32x16& p1, float alpha, float& l_reg, bf16x8& pa0, bf16x8& pa1, bf16x8& pa2, bf16x8& pa3) {
#pragma unroll
    for (int r = 0; r < 16; ++r) p1[r] = __builtin_amdgcn_exp2f(p1[r]);
    FA_SBAR(); asm volatile("s_nop 1");
    float ps = 0;
#pragma unroll
    for (int r = 0; r < 16; ++r) ps += p0[r];
#pragma unroll
    for (int r = 0; r < 16; ++r) ps += p1[r];
    { auto rr = __builtin_amdgcn_permlane32_swap(__float_as_uint(ps), __float_as_uint(ps), false, false);
      ps = __uint_as_float(rr[0]) + __uint_as_float(rr[1]); }
    l_reg = l_reg * alpha + ps;
#define FA_PK4(P, BASE, OUT) do { u32x4 w = {cvtpk(P[BASE + 0], P[BASE + 1]), cvtpk(P[BASE + 2], P[BASE + 3]), cvtpk(P[BASE + 4], P[BASE + 5]), cvtpk(P[BASE + 6], P[BASE + 7])}; \
    OUT = *reinterpret_cast<bf16x8*>(&w); } while (0)
    FA_PK4(p0, 0, pa0); FA_PK4(p0, 8, pa1); FA_PK4(p1, 0, pa2); FA_PK4(p1, 8, pa3);
#undef FA_PK4
}
__device__ __forceinline__ int v_rd_base(int lane) { return ((lane & 3) << 3) | (((lane >> 2) & 3) << 6) | (((lane >> 4) & 1) << 5) | (((lane >> 5) & 1) << 8); }
constexpr int v_rd_off(int d0, int ks, int half) { return d0 * 512 + ks * 4096 + half * 2048; }
__device__ __forceinline__ bf16x8 lds_rd128i(unsigned addr, const int off) { bf16x8 r; asm volatile("ds_read_b128 %0, %1 offset:%2" : "=&v"(r) : "v"(addr), "i"(off) : "memory"); return r; }
template <int OFF> __device__ __forceinline__ bf16x8 lds_rd128(unsigned addr) { bf16x8 r; asm volatile("ds_read_b128 %0, %1 offset:%2" : "=&v"(r) : "v"(addr), "i"(OFF) : "memory"); return r; }
template <int OFF> __device__ __forceinline__ s16x4 tr_read(unsigned vb) {
    s16x4 r; asm volatile("ds_read_b64_tr_b16 %0, %1 offset:%2" : "=&v"(r) : "v"(vb), "i"(OFF) : "memory"); return r;
}
template <int D0> __device__ __forceinline__ void pv_one(f32x16& od, unsigned vb, bf16x8 pa0, bf16x8 pa1, bf16x8 pa2, bf16x8 pa3) {
    const s16x4 l0 = tr_read<v_rd_off(D0, 0, 0)>(vb), h0 = tr_read<v_rd_off(D0, 0, 1)>(vb), l1 = tr_read<v_rd_off(D0, 1, 0)>(vb), h1 = tr_read<v_rd_off(D0, 1, 1)>(vb);
    const s16x4 l2 = tr_read<v_rd_off(D0, 2, 0)>(vb), h2 = tr_read<v_rd_off(D0, 2, 1)>(vb), l3 = tr_read<v_rd_off(D0, 3, 0)>(vb), h3 = tr_read<v_rd_off(D0, 3, 1)>(vb);
    asm volatile("s_waitcnt lgkmcnt(0)" ::: "memory"); FA_SBAR();
#define FA_PK(L, H) (bf16x8){L[0], L[1], L[2], L[3], H[0], H[1], H[2], H[3]}
    od = __builtin_amdgcn_mfma_f32_32x32x16_bf16(pa0, FA_PK(l0, h0), od, 0, 0, 0);
    od = __builtin_amdgcn_mfma_f32_32x32x16_bf16(pa1, FA_PK(l1, h1), od, 0, 0, 0);
    od = __builtin_amdgcn_mfma_f32_32x32x16_bf16(pa2, FA_PK(l2, h2), od, 0, 0, 0);
    od = __builtin_amdgcn_mfma_f32_32x32x16_bf16(pa3, FA_PK(l3, h3), od, 0, 0, 0);
#undef FA_PK
}
struct Args { const bf16_t* Q; const bf16_t* K; const bf16_t* V; bf16_t* O; int qpitch, kpitch, vpitch, opitch, nheads, vdiv; float scale; int pad; };

template <int DQK>
__device__ __forceinline__ void attn_phase(LAS unsigned char* lds, const Args& a, int tid) {
    constexpr int KROWB = DQK * 2, KCH = KROWB / 16, KTILE = 64 * KROWB, VTILE = 16384, STAGE = KTILE + VTILE, NKI = KTILE / 8192, NVI = 2, NDMA = NKI + NVI, ND = DQK / 16;
    constexpr int RING = (DQK == 64) ? 4 : 3;
    static_assert(RING * STAGE + 2048 <= 131072, "attention LDS");
    const int wid = __builtin_amdgcn_readfirstlane(tid >> 6), lane = tid & 63, r32 = lane & 31, hi = lane >> 5;
    const int krow = (r32 & ~0xC) | ((r32 & 4) << 1) | ((r32 & 8) >> 1);
    LAS float* wsc = (LAS float*)(lds + RING * STAGE) + wid * 64;
    unsigned koff_[NKI], voff_[NVI];
#pragma unroll
    for (int i = 0; i < NKI; ++i) { const int s = i * 512 + wid * 64 + lane, row = s / KCH, ch = s % KCH; koff_[i] = (unsigned)(row * a.kpitch + (ch ^ ((row & 3) | (((row >> 3) & 1) << 2))) * 8) * 2u; }
#pragma unroll
    for (int i = 0; i < NVI; ++i) { const int o = (i * 512 + wid * 64 + lane) * 16, sub = o >> 9, within = o & 511, kk = (sub >> 2) * 8 + (within >> 6), c = (sub & 3) * 32 + ((within & 63) >> 1);
        const int k = (kk & ~0xC) | ((kk & 4) << 1) | ((kk & 8) >> 1); voff_[i] = (unsigned)(k * a.vpitch + c) * 2u; }
    const unsigned vb0 = (unsigned)(uintptr_t)(lds + KTILE) + (unsigned)v_rd_base(lane);
    const int n_lat = a.nheads * 64, n_units = n_lat + a.nheads * 16;
    for (int u = xcd_slot(); u < n_units; u += gridDim.x) {
        int b, h, q0, nk, kbase, cbase;
        if (u < n_lat) { const int bh = u >> 4, qb = u & 15; b = bh / a.nheads; h = bh % a.nheads; q0 = NCTX + b * LL + qb * 256; nk = LL + PAST; kbase = NCTX + b * LL; cbase = MTOK + b * PAST; }
        else { const int v = u - n_lat; b = v / a.nheads; h = v % a.nheads; q0 = b * CL; nk = CL; kbase = b * CL; cbase = 0; }
        const int NT = nk >> 6, vh = h / a.vdiv;
        const bf16_t* Kh = a.K + h * DQK; const bf16_t* Vh = a.V + vh * 128;
#define FA_ISSUE(j) do { const int t0_ = (j) * 64; const int rb_ = (t0_ < LL || nk == CL) ? kbase + t0_ : cbase + (t0_ - LL); LAS unsigned char* st_ = lds + ((j) % RING) * STAGE; \
        const char* kb_ = (const char*)(Kh + (size_t)rb_ * a.kpitch); const char* vb_ = (const char*)(Vh + (size_t)rb_ * a.vpitch); \
        _Pragma("unroll") for (int i_ = 0; i_ < NKI; ++i_) __builtin_amdgcn_global_load_lds((const unsigned*)(kb_ + koff_[i_]), (LAS unsigned*)(st_ + i_ * 8192 + wid * 1024), 16, 0, 0); \
        _Pragma("unroll") for (int i_ = 0; i_ < NVI; ++i_) __builtin_amdgcn_global_load_lds((const unsigned*)(vb_ + voff_[i_]), (LAS unsigned*)(st_ + KTILE + i_ * 8192 + wid * 1024), 16, 0, 0); } while (0)
        bf16x8 qr[ND];
        { const bf16_t* Qw = a.Q + (size_t)(q0 + wid * 32 + r32) * a.qpitch + h * DQK + hi * 8;
#pragma unroll
          for (int d0 = 0; d0 < ND; ++d0) qr[d0] = *(const bf16x8*)(Qw + d0 * 16); }
        float m_reg = 0.f, l_reg = 0.f; f32x16 o[4], nm;
        float z0 = 0.f; asm volatile("" : "+v"(z0));
#pragma unroll
        for (int d = 0; d < 4; ++d)
#pragma unroll
            for (int r = 0; r < 16; ++r) o[d][r] = z0;
#pragma unroll
        for (int r = 0; r < 16; ++r) nm[r] = z0;
        FA_ISSUE(0); FA_ISSUE(1);
        if constexpr (DQK != 64) { if (NDMA == 5) asm volatile("s_waitcnt vmcnt(5)" ::: "memory"); else asm volatile("s_waitcnt vmcnt(3)" ::: "memory");
            __builtin_amdgcn_s_barrier(); asm volatile("" ::: "memory"); }
        auto tile = [&](const int j) __attribute__((always_inline)) {
            LAS unsigned char* Ks = lds + (j % RING) * STAGE;
            f32x16 p0 = nm, p1 = nm;
            constexpr int KD = (DQK == 64) ? 3 : 2;
            bf16x8 kb[KD][2];
            unsigned kae[4];
#pragma unroll
            for (int e = 0; e < 4; ++e) kae[e] = (unsigned)(uintptr_t)Ks + (unsigned)(krow * KROWB + (((2 * e + hi) ^ ((krow & 3) | (((krow >> 3) & 1) << 2))) << 4));
#define FA_LDK(d0_, s_) do { kb[s_][0] = lds_rd128i(kae[(d0_) & 3], ((d0_) >> 2) * 128); kb[s_][1] = lds_rd128i(kae[(d0_) & 3], 32 * KROWB + ((d0_) >> 2) * 128); } while (0)
#pragma unroll
            for (int d0 = 0; d0 < KD - 1; ++d0) FA_LDK(d0, d0);
#pragma unroll
            for (int d0 = 0; d0 < ND; ++d0) {
                if (d0 + KD - 1 < ND) FA_LDK(d0 + KD - 1, (d0 + KD - 1) % KD);
                const int ahead = (ND - 1 - d0) < (KD - 1) ? (ND - 1 - d0) : (KD - 1);
                if (ahead == 2) asm volatile("s_waitcnt lgkmcnt(4)" ::: "memory"); else if (ahead == 1) asm volatile("s_waitcnt lgkmcnt(2)" ::: "memory"); else asm volatile("s_waitcnt lgkmcnt(0)" ::: "memory");
                FA_SBAR();
                p0 = __builtin_amdgcn_mfma_f32_32x32x16_bf16(kb[d0 % KD][0], qr[d0], p0, 0, 0, 0);
                p1 = __builtin_amdgcn_mfma_f32_32x32x16_bf16(kb[d0 % KD][1], qr[d0], p1, 0, 0, 0);
                FA_SBAR(); }
#undef FA_LDK
            float alpha; partialSM(p0, p1, m_reg, nm, alpha, j == 0);
            if (__any(alpha < 1.f)) { if (hi == 0) wsc[32 + r32] = alpha; asm volatile("s_waitcnt lgkmcnt(0)" ::: "memory");
#pragma unroll
                for (int d = 0; d < 4; ++d)
#pragma unroll
                    for (int r = 0; r < 16; ++r) o[d][r] *= wsc[32 + crow(r, hi)]; }
            bf16x8 pa0, pa1, pa2, pa3; finishSM(p0, p1, alpha, l_reg, pa0, pa1, pa2, pa3); FA_SBAR();
            const unsigned vb = vb0 + (unsigned)((j % RING) * STAGE);
            pv_one<0>(o[0], vb, pa0, pa1, pa2, pa3); pv_one<1>(o[1], vb, pa0, pa1, pa2, pa3); pv_one<2>(o[2], vb, pa0, pa1, pa2, pa3); pv_one<3>(o[3], vb, pa0, pa1, pa2, pa3);
        };
        if constexpr (DQK == 64) {
            asm volatile("s_waitcnt vmcnt(0)" ::: "memory");
            __builtin_amdgcn_s_barrier(); asm volatile("" ::: "memory");
            for (int j = 0; j < NT; j += 2) {
                if (j + 2 < NT) { FA_ISSUE(j + 2); FA_ISSUE(j + 3); }
                tile(j); tile(j + 1);
                asm volatile("s_waitcnt vmcnt(0)" ::: "memory");
                asm volatile("s_waitcnt lgkmcnt(0)" ::: "memory");
                __builtin_amdgcn_s_barrier(); asm volatile("" ::: "memory");
            }
        } else
        for (int j = 0; j < NT; ++j) {
            if (j + 2 < NT) FA_ISSUE(j + 2);
            tile(j);
            if (j + 2 < NT) { if (NDMA == 5) asm volatile("s_waitcnt vmcnt(5)" ::: "memory"); else asm volatile("s_waitcnt vmcnt(3)" ::: "memory"); }
            else asm volatile("s_waitcnt vmcnt(0)" ::: "memory");
            asm volatile("s_waitcnt lgkmcnt(0)" ::: "memory");
            __builtin_amdgcn_s_barrier(); asm volatile("" ::: "memory");
        }
#undef FA_ISSUE
        if (hi == 0) wsc[r32] = l_reg; asm volatile("s_waitcnt lgkmcnt(0)" ::: "memory");
        bf16_t* Ow = a.O + (size_t)(q0 + wid * 32) * a.opitch + h * 128 + r32;
#pragma unroll
        for (int r = 0; r < 16; ++r) { const int orow = crow(r, hi); const float rl = __builtin_amdgcn_rcpf(wsc[orow]);
#pragma unroll
            for (int d0 = 0; d0 < 4; ++d0) Ow[(size_t)orow * a.opitch + d0 * 32] = (bf16_t)f2bf(o[d0][r] * rl); }
        asm volatile("s_waitcnt lgkmcnt(0)" ::: "memory");
    }
}
}


namespace ml {
typedef short s16x4 __attribute__((ext_vector_type(4)));
constexpr int QP = 528, VP = 80, CP = 528, PP = 144;
constexpr size_t WS_SCT = WS_CT, WS_WC = WS_CT + 4 * MiB, WS_DENI = WS_CT + 5 * MiB, WS_KW = WS_CT + 6 * MiB;
__device__ __forceinline__ s16x4 trr(unsigned addr) { s16x4 r; asm volatile("ds_read_b64_tr_b16 %0, %1" : "=&v"(r) : "v"(addr) : "memory"); return r; }
__device__ __forceinline__ unsigned cvtpk(float lo, float hi) { unsigned r; asm volatile("s_nop 0\n\tv_cvt_pk_bf16_f32 %0, %1, %2\n\ts_nop 1" : "=v"(r) : "v"(lo), "v"(hi)); return r; }
__device__ __forceinline__ int crow(int r, int hi) { return (r & 3) + 8 * (r >> 2) + 4 * hi; }
#define ML_BAR() do { asm volatile("s_waitcnt lgkmcnt(0)" ::: "memory"); __builtin_amdgcn_s_barrier(); asm volatile("" ::: "memory"); } while (0)
#define ML_TOK(c, i) (base + (dir ? (L - 1 - ((c) * 64 + (i))) : ((c) * 64 + (i))))
__device__ __forceinline__ float logsig(float g) { return fminf(g, 0.f) - __logf(1.0f + __expf(-fabsf(g))); }

__device__ __forceinline__ void scalars_wg(const P& p, const int l, const int chain, const int wave, const int lane, LAS float* sx) {
    const bool lat = chain >= 128; const int cc = lat ? chain - 128 : chain, b = cc >> 3, h = (cc >> 1) & 3, dir = cc & 1;
    const int L = lat ? LL : CL, base = lat ? NCTX + b * LL : b * CL, NC = L >> 6;
    const float* kva = (const float*)(p.ws + WS_KVA) + 576 + dir * 8 + h;
    const float bi = p.in[18][l * 16 + dir * 8 + h], bf = p.in[18][l * 16 + dir * 8 + 4 + h];
    float li_[8], lf_[8];
#pragma unroll
    for (int j = 0; j < 8; ++j) { const int c = wave + 8 * j; li_[j] = 0.f; lf_[j] = 0.f; if (c < NC) { const float* r_ = kva + (size_t)ML_TOK(c, lane) * KVAW; li_[j] = r_[0] + bi; lf_[j] = r_[4] + bf; } }
    float bb_[8], gg_[8], pm_[8];
#pragma unroll
    for (int j = 0; j < 8; ++j) { const int c = wave + 8 * j;
        float bc = logsig(lf_[j]);
#pragma unroll
        for (int o = 1; o < 64; o <<= 1) { const float t_ = __shfl_up(bc, o); if (lane >= o) bc += t_; }
        const float g = li_[j] - bc; float pm = g;
#pragma unroll
        for (int o = 1; o < 64; o <<= 1) { const float t_ = __shfl_up(pm, o); if (lane >= o) pm = fmaxf(pm, t_); }
        bb_[j] = bc; gg_[j] = g; pm_[j] = pm;
        if (lane == 63) { sx[c] = (c < NC) ? bc : 0.f; sx[64 + c] = (c < NC) ? bc + pm : -1e30f; } }
    __syncthreads();
    float al = sx[lane], be = sx[64 + lane];
#pragma unroll
    for (int o = 1; o < 64; o <<= 1) { const float ea = __shfl_up(al, o), eb = __shfl_up(be, o); if (lane >= o) { be = fmaxf(eb + al, be); al = ea + al; } }
    float m0 = 0.f; if (lat) m0 = p.in[8][(size_t)((b * 2 + l) * 2 + dir) * 4 + h];
    const float pa = __shfl_up(al, 1), pb = __shfl_up(be, 1);
    const float mst_all = lane == 0 ? m0 : fmaxf(m0 + pa, pb);
    if (!lat && wave == 0 && lane == NC - 1) p.out[O_MM + ((b * 2 + l) * 2 + dir) * 4 + h] = fmaxf(m0 + al, be);
    f32x4* sct = (f32x4*)(p.ws + WS_SCT);
#pragma unroll
    for (int j = 0; j < 8; ++j) { const int c = wave + 8 * j;
        const float m_st = __shfl(mst_all, c & 63);
        if (c < NC) { const float mxl = fmaxf(m_st, __shfl(pm_[j], 63)), mx = fmaxf(m_st, pm_[j]);
            sct[((size_t)ML_TOK(c, lane) * 2 + dir) * 4 + h] = (f32x4){__expf(pm_[j] - mx), __expf(m_st - mx), __expf(-(bb_[j] + mx)), __expf(gg_[j] - mxl)};
            if (lane == 0) ((float*)(p.ws + WS_WC))[chain * 64 + c] = __expf(m_st - mxl); } }
    __syncthreads();
}

constexpr int B_Q = 0, B_K = 33792, B_V = 67584, B_P = 101376, B_S = 110592, B_END = 112640;
__device__ __forceinline__ void intra_phase(LAS unsigned char* lds, const P& p, const int l, const int tid) {
    const int wid = __builtin_amdgcn_readfirstlane(tid >> 6), lane = tid & 63, r32 = lane & 31, hi = lane >> 5;
    const bf16_t* MQ_ = (const bf16_t*)(p.ws + WS_MLQ); const bf16_t* MK_ = (const bf16_t*)(p.ws + WS_MLK); const bf16_t* MV_ = (const bf16_t*)(p.ws + WS_MLV);
    LAS float* sg = (LAS float*)(lds + B_S); LAS float* spm = sg + 64; LAS float* sws = sg + 128; LAS float* sd0 = sg + 192; LAS float* sd1 = sg + 256;
    const unsigned ldsb = (unsigned)(uintptr_t)lds;
    const int tq = (lane & 15) >> 2, tp = lane & 3, tc0 = 16 * ((lane >> 4) & 1) + 4 * tp;
    u32x4 q4[4], k4[4], v4[4]; float gli = 0.f, glf = 0.f, gws = 0.f;
#define B_DECODE(uu) const bool lat = (uu) < 2048; const int chain = lat ? 128 + ((uu) >> 6) : ((uu) - 2048) >> 2, c = lat ? ((uu) & 63) : (((uu) - 2048) & 3); \
        const int cc = lat ? chain - 128 : chain, b = cc >> 3, h = (cc >> 1) & 3, dir = cc & 1; const int L = lat ? LL : CL, base = lat ? NCTX + b * LL : b * CL;
#define B_LOAD(uu) do { B_DECODE(uu) (void)chain; \
        _Pragma("unroll") for (int i = 0; i < 4; ++i) { const int ch = tid + 512 * i, row = ch >> 5, c16 = ch & 31; const size_t g_ = (size_t)ML_TOK(c, row) * 1024 + h * 256 + c16 * 8; \
            q4[i] = *(const u32x4*)(MQ_ + g_); k4[i] = *(const u32x4*)(MK_ + g_); v4[i] = *(const u32x4*)(MV_ + g_); } \
        if (wid == 7) { const int row = ML_TOK(c, lane); const float* r_ = (const float*)(p.ws + WS_KVA) + (size_t)row * KVAW + 576 + dir * 8 + h; \
            gli = r_[0] + p.in[18][l * 16 + dir * 8 + h]; glf = r_[4] + p.in[18][l * 16 + dir * 8 + 4 + h]; gws = ((const f32x4*)(p.ws + WS_SCT))[((size_t)row * 2 + dir) * 4 + h][3]; } } while (0)
    if ((int)blockIdx.x < 2560) B_LOAD((int)blockIdx.x);
    for (int u = blockIdx.x; u < 2560; u += gridDim.x) {
        B_DECODE(u)
        bf16_t* Hout = (bf16_t*)(p.ws + (dir ? WS_HB : WS_HF));
#pragma unroll
        for (int i = 0; i < 4; ++i) { const int ch = tid + 512 * i, row = ch >> 5, c16 = ch & 31;
            *(LAS u32x4*)(lds + B_Q + row * QP + c16 * 16) = q4[i]; *(LAS u32x4*)(lds + B_K + row * QP + c16 * 16) = k4[i]; *(LAS u32x4*)(lds + B_V + row * QP + c16 * 16) = v4[i]; }
        if (wid == 7) {
            float bc = logsig(glf);
#pragma unroll
            for (int o = 1; o < 64; o <<= 1) { const float t_ = __shfl_up(bc, o); if (lane >= o) bc += t_; }
            const float g = gli - bc; float pm = g;
#pragma unroll
            for (int o = 1; o < 64; o <<= 1) { const float t_ = __shfl_up(pm, o); if (lane >= o) pm = fmaxf(pm, t_); }
            sg[lane] = g; spm[lane] = pm; sws[lane] = gws;
        }
        if (u + (int)gridDim.x < 2560) B_LOAD(u + (int)gridDim.x);
        ML_BAR();
        if (wid < 3) {
            const int tb = wid == 0 ? 0 : 1, sb = wid == 2 ? 1 : 0, t = tb * 32 + r32;
            f32x16 p0; { float z0 = 0.f; asm volatile("" : "+v"(z0));
#pragma unroll
              for (int r = 0; r < 16; ++r) p0[r] = z0; }
#pragma unroll 4
            for (int ks = 0; ks < 16; ++ks) { const int cb = (ks * 16 + hi * 8) * 2;
                const bf16x8 qf = *(const LAS bf16x8*)(lds + B_Q + t * QP + cb), kf = *(const LAS bf16x8*)(lds + B_K + (sb * 32 + r32) * QP + cb);
                p0 = __builtin_amdgcn_mfma_f32_32x32x16_bf16(kf, qf, p0, 0, 0, 0); }
            const float mpm = -spm[t]; float dsum = 0.f;
#pragma unroll
            for (int r = 0; r < 16; ++r) { const int s = sb * 32 + crow(r, hi); const float w = (s <= t) ? __expf(sg[s] + mpm) : 0.f; p0[r] *= w; dsum += p0[r]; }
            { auto rr = __builtin_amdgcn_permlane32_swap(__float_as_uint(dsum), __float_as_uint(dsum), false, false); dsum = __uint_as_float(rr[0]) + __uint_as_float(rr[1]); }
            if (hi == 0) { if (sb == 0) sd0[t] = dsum; else sd1[r32] = dsum; }
#pragma unroll
            for (int i = 0; i < 4; ++i) { u32x2 w; w.x = cvtpk(p0[4 * i], p0[4 * i + 1]); w.y = cvtpk(p0[4 * i + 2], p0[4 * i + 3]);
                *(LAS u32x2*)(lds + B_P + t * PP + (sb * 32 + 8 * i + 4 * hi) * 2) = w; }
        } else if (wid >= 4) {
            const int k = tid - 256; float acc = 0.f;
#pragma unroll 8
            for (int s = 0; s < 64; ++s) acc += sws[s] * bf2f(*(const LAS unsigned short*)(lds + B_K + s * QP + k * 2));
            ((float*)(p.ws + WS_KW))[((size_t)chain * 64 + c) * 256 + k] = acc;
        }
        ML_BAR();
        {
            f32x16 h0, h1; { float z0 = 0.f; asm volatile("" : "+v"(z0));
#pragma unroll
              for (int r = 0; r < 16; ++r) { h0[r] = z0; h1[r] = z0; } }
#pragma unroll
            for (int ks = 0; ks < 4; ++ks) {
                const unsigned va = ldsb + B_V + (16 * ks + 8 * hi + tq) * QP + (wid * 32 + tc0) * 2;
                const s16x4 lo = trr(va), hh = trr(va + 4 * QP);
                const bf16x8 a1 = *(const LAS bf16x8*)(lds + B_P + (32 + r32) * PP + (ks * 16 + hi * 8) * 2);
                bf16x8 a0 = a1; if (ks < 2) a0 = *(const LAS bf16x8*)(lds + B_P + r32 * PP + (ks * 16 + hi * 8) * 2);
                asm volatile("s_waitcnt lgkmcnt(0)" ::: "memory"); __builtin_amdgcn_sched_barrier(0);
                const bf16x8 vf = (bf16x8){lo[0], lo[1], lo[2], lo[3], hh[0], hh[1], hh[2], hh[3]};
                if (ks < 2) h0 = __builtin_amdgcn_mfma_f32_32x32x16_bf16(a0, vf, h0, 0, 0, 0);
                h1 = __builtin_amdgcn_mfma_f32_32x32x16_bf16(a1, vf, h1, 0, 0, 0); }
#pragma unroll
            for (int r = 0; r < 16; ++r) { const int t0 = crow(r, hi);
                Hout[(size_t)ML_TOK(c, t0) * 1024 + h * 256 + wid * 32 + r32] = (bf16_t)f2bf(h0[r]); Hout[(size_t)ML_TOK(c, 32 + t0) * 1024 + h * 256 + wid * 32 + r32] = (bf16_t)f2bf(h1[r]); }
            if (tid < 64) ((float*)(p.ws + WS_DENI))[((size_t)ML_TOK(c, tid) * 2 + dir) * 4 + h] = sd0[tid] + (tid >= 32 ? sd1[tid - 32] : 0.f);
        }
        ML_BAR();
    }
}

constexpr int L_Q = 0, L_K = 33792, L_V = 67584, L_CT = 72704, L_SC = 89600, L_NQ = 95744, L_N = 96256, L_PART = 98304, L_END = 114688;
__device__ __forceinline__ void seq_phase(LAS unsigned char* lds, const P& p, const int l, const int tid) {
    const int wid = __builtin_amdgcn_readfirstlane(tid >> 6), lane = tid & 63, r32 = lane & 31, hi = lane >> 5;
    const bf16_t* MQ_ = (const bf16_t*)(p.ws + WS_MLQ); const bf16_t* MK_ = (const bf16_t*)(p.ws + WS_MLK); const bf16_t* MV_ = (const bf16_t*)(p.ws + WS_MLV);
    const unsigned ldsb = (unsigned)(uintptr_t)lds;
    const int tq = (lane & 15) >> 2, tp = lane & 3, tc0 = 16 * ((lane >> 4) & 1) + 4 * tp;
    for (int u = xcd_slot(); u < 1280; u += gridDim.x) {
        const bool lat = u < 256; const int uu = lat ? u : u - 256, cc = uu >> 3, sl = uu & 7, chain = lat ? 128 + cc : cc;
        const int b = cc >> 3, h = (cc >> 1) & 3, dir = cc & 1;
        const int L = lat ? LL : CL, base = lat ? NCTX + b * LL : b * CL, NC = L >> 6;
        const int colq = h * 256, colv = h * 256 + sl * 32;
        bf16_t* Hout = (bf16_t*)(p.ws + (dir ? WS_HB : WS_HF));
        f32x16 ct, ia;
        { float z0 = 0.f; asm volatile("" : "+v"(z0));
#pragma unroll
          for (int r = 0; r < 16; ++r) { ct[r] = z0; ia[r] = z0; } }
        LAS float* nb0 = (LAS float*)(lds + L_N); LAS float* nb1 = nb0 + 256;
        if (lat) {
            const size_t so = (size_t)((b * 2 + l) * 2 + dir) * 4 + h;
            const float* c0 = p.in[6] + so * 65536 + (size_t)(sl * 32 + r32) * 256 + wid * 32 + 4 * hi;
#pragma unroll
            for (int i = 0; i < 4; ++i) { const f32x4 v4 = *(const f32x4*)(c0 + 8 * i); ct[4 * i] = v4[0]; ct[4 * i + 1] = v4[1]; ct[4 * i + 2] = v4[2]; ct[4 * i + 3] = v4[3]; }
            if (tid < 256) nb0[tid] = p.in[7][so * 256 + tid];
        } else if (tid < 256) nb0[tid] = 0.f;
        u32x4 pq[4], pk[4], pv; pv = (u32x4){0u, 0u, 0u, 0u}; f32x4 psc = {0.f, 0.f, 0.f, 0.f}; float pdi = 0.f, pwc = 0.f, pkw = 0.f; unsigned hpre[16];
#pragma unroll
        for (int r = 0; r < 16; ++r) hpre[r] = 0u;
#define ML_HPRE(cc_) do { _Pragma("unroll") for (int rr = 0; rr < 8; ++rr) hpre[rr] = Hout[(size_t)ML_TOK(cc_, (wid & 1) * 32 + crow(8 * (wid >> 1) + rr, hi)) * 1024 + colv + r32]; } while (0)
#define ML_LOAD(c) do { _Pragma("unroll") for (int i_ = 0; i_ < 4; ++i_) { const int ch_ = tid + 512 * i_, row_ = ch_ >> 5, c16_ = ch_ & 31; const size_t g_ = (size_t)ML_TOK(c, row_) * 1024 + colq + c16_ * 8; \
            pq[i_] = *(const u32x4*)(MQ_ + g_); pk[i_] = *(const u32x4*)(MK_ + g_); } \
        if (tid < 256) { const int row_ = tid >> 2, c16_ = tid & 3; pv = *(const u32x4*)(MV_ + (size_t)ML_TOK(c, row_) * 1024 + colv + c16_ * 8); } \
        else pkw = ((const float*)(p.ws + WS_KW))[((size_t)chain * 64 + (c)) * 256 + tid - 256]; \
        if (wid == 0) { const size_t ix_ = ((size_t)ML_TOK(c, lane) * 2 + dir) * 4 + h; psc = ((const f32x4*)(p.ws + WS_SCT))[ix_]; pdi = ((const float*)(p.ws + WS_DENI))[ix_]; pwc = ((const float*)(p.ws + WS_WC))[chain * 64 + (c)]; } } while (0)
#define ML_WRITE(cc_) do { _Pragma("unroll") for (int i_ = 0; i_ < 4; ++i_) { const int ch_ = tid + 512 * i_, row_ = ch_ >> 5, c16_ = ch_ & 31; \
            *(LAS u32x4*)(lds + L_Q + row_ * QP + c16_ * 16) = pq[i_]; *(LAS u32x4*)(lds + L_K + row_ * QP + c16_ * 16) = pk[i_]; } \
        if (tid < 256) { const int row_ = tid >> 2, c16_ = tid & 3; *(LAS u32x4*)(lds + L_V + row_ * VP + c16_ * 16) = pv; } \
        if (wid == 0) { LAS float* S_ = (LAS float*)(lds + L_SC + ((cc_) % 3) * 2048); S_[lane] = psc[0]; S_[64 + lane] = psc[1]; S_[128 + lane] = psc[2]; S_[192 + lane] = psc[3]; S_[256 + lane] = pdi; if (lane == 0) S_[320] = pwc; } } while (0)
#define ML_CTB() do { _Pragma("unroll") for (int i_ = 0; i_ < 4; ++i_) { u32x2 w_; w_.x = cvtpk(ct[4 * i_], ct[4 * i_ + 1]); w_.y = cvtpk(ct[4 * i_ + 2], ct[4 * i_ + 3]); \
            *(LAS u32x2*)(lds + L_CT + r32 * CP + (wid * 32 + 8 * i_ + 4 * hi) * 2) = w_; } } while (0)
#define ML_COMB(cc_) do { const int tb_ = wid & 1, kh_ = wid >> 1; const LAS float* S_ = (const LAS float*)(lds + L_SC + ((cc_) % 3) * 2048); const LAS float* NQ_ = (const LAS float*)(lds + L_NQ + ((cc_) & 1) * 256); \
            const LAS float* PT_ = (const LAS float*)(lds + L_PART + (((cc_) & 1) * 4 + (wid ^ 2)) * 2048); \
            _Pragma("unroll") for (int rr = 0; rr < 8; ++rr) { const int r = 8 * kh_ + rr, tt = tb_ * 32 + crow(r, hi); bf16_t* hp_ = Hout + (size_t)ML_TOK(cc_, tt) * 1024 + colv + r32; \
                const float rr_ = S_[tt], wi = S_[64 + tt], den = rr_ * S_[256 + tt] + wi * NQ_[tt], it_ = (kh_ ? ia[8 + rr] : ia[rr]) + PT_[rr * 64 + lane]; \
                *hp_ = (bf16_t)f2bf((rr_ * bf2f(hpre[rr]) + wi * it_) * __builtin_amdgcn_rcpf(fmaxf(fabsf(den), S_[128 + tt]))); } } while (0)
        float kwc = 0.f;
        ML_LOAD(0); ML_WRITE(0); ML_CTB(); kwc = pkw;
        int nsel = 0;
        for (int c = 0; c < NC; ++c) {
            ML_BAR();
            LAS float* ncur = nsel ? nb1 : nb0; LAS float* nnxt = nsel ? nb0 : nb1;
            const LAS float* SC = (const LAS float*)(lds + L_SC + (c % 3) * 2048);
            if (c + 1 < NC) ML_LOAD(c + 1);
            const float w_c = SC[320];
            if (wid < 4) {
                if (c > 0) ML_COMB(c - 1);
                ML_HPRE(c);
                const int tb = wid & 1, kh = wid >> 1;
                { float z0 = 0.f; asm volatile("" : "+v"(z0));
#pragma unroll
                  for (int r = 0; r < 16; ++r) ia[r] = z0; }
#pragma unroll
                for (int k1 = 0; k1 < 8; ++k1) { const int cb0 = ((kh * 8 + k1) * 16 + hi * 8) * 2;
                    const bf16x8 qf0 = *(const LAS bf16x8*)(lds + L_Q + (tb * 32 + r32) * QP + cb0), cf0 = *(const LAS bf16x8*)(lds + L_CT + r32 * CP + cb0);
                    ia = __builtin_amdgcn_mfma_f32_32x32x16_bf16(qf0, cf0, ia, 0, 0, 0); }
                { LAS float* PW = (LAS float*)(lds + L_PART + ((c & 1) * 4 + wid) * 2048);
#pragma unroll
                  for (int rr = 0; rr < 8; ++rr) PW[rr * 64 + lane] = kh ? ia[rr] : ia[8 + rr]; }
            } else if (wid >= 4) {
                const int j = tid - 256, t = j >> 2, part = j & 3;
                float acc = 0.f;
#pragma unroll
                for (int i = 0; i < 8; ++i) { const u32x4 qv = *(const LAS u32x4*)(lds + L_Q + t * QP + (part * 64 + i * 8) * 2);
                    const f32x4 n0 = *(const LAS f32x4*)(ncur + part * 64 + i * 8), n1 = *(const LAS f32x4*)(ncur + part * 64 + i * 8 + 4);
                    acc += bf2f(qv[0]) * n0[0] + bf2f(qv[0] >> 16) * n0[1] + bf2f(qv[1]) * n0[2] + bf2f(qv[1] >> 16) * n0[3] + bf2f(qv[2]) * n1[0] + bf2f(qv[2] >> 16) * n1[1] + bf2f(qv[3]) * n1[2] + bf2f(qv[3] >> 16) * n1[3]; }
                acc += __shfl_xor(acc, 1); acc += __shfl_xor(acc, 2);
                if (part == 0) ((LAS float*)(lds + L_NQ + (c & 1) * 256))[t] = acc;
                nnxt[j] = w_c * ncur[j] + kwc;
            }
            { f32x16 cc = ct;
#pragma unroll
              for (int r = 0; r < 16; ++r) cc[r] *= w_c;
#pragma unroll
              for (int ks = 0; ks < 4; ++ks) {
                const unsigned ka = ldsb + L_K + (16 * ks + 8 * hi + tq) * QP + (wid * 32 + tc0) * 2, va = ldsb + L_V + (16 * ks + 8 * hi + tq) * VP + tc0 * 2;
                const s16x4 kl = trr(ka), kh = trr(ka + 4 * QP), vl = trr(va), vh = trr(va + 4 * VP);
                const f32x4 wa = *(const LAS f32x4*)(SC + 192 + 16 * ks + 8 * hi), wb = *(const LAS f32x4*)(SC + 192 + 16 * ks + 8 * hi + 4);
                asm volatile("s_waitcnt lgkmcnt(0)" ::: "memory"); __builtin_amdgcn_sched_barrier(0);
                u32x4 vw; vw.x = cvtpk(bf2f((unsigned short)vl[0]) * wa[0], bf2f((unsigned short)vl[1]) * wa[1]); vw.y = cvtpk(bf2f((unsigned short)vl[2]) * wa[2], bf2f((unsigned short)vl[3]) * wa[3]);
                vw.z = cvtpk(bf2f((unsigned short)vh[0]) * wb[0], bf2f((unsigned short)vh[1]) * wb[1]); vw.w = cvtpk(bf2f((unsigned short)vh[2]) * wb[2], bf2f((unsigned short)vh[3]) * wb[3]);
                const bf16x8 kf = (bf16x8){kl[0], kl[1], kl[2], kl[3], kh[0], kh[1], kh[2], kh[3]};
                cc = __builtin_amdgcn_mfma_f32_32x32x16_bf16(kf, *reinterpret_cast<bf16x8*>(&vw), cc, 0, 0, 0); }
              ct = cc; }
            ML_BAR();
            if (c + 1 < NC) { ML_WRITE(c + 1); kwc = pkw; }
            ML_CTB();
            nsel ^= 1;
        }
        if (wid < 4) ML_COMB(NC - 1);
        if (!lat) {
            const size_t so = (size_t)((b * 2 + l) * 2 + dir) * 4 + h;
            float* oc = p.out + O_MC + so * 65536 + (size_t)(sl * 32 + r32) * 256 + wid * 32 + 4 * hi;
#pragma unroll
            for (int i = 0; i < 4; ++i) *(f32x4*)(oc + 8 * i) = (f32x4){ct[4 * i], ct[4 * i + 1], ct[4 * i + 2], ct[4 * i + 3]};
            if (sl == 0) { LAS float* nfin = nsel ? nb1 : nb0; if (tid < 256) p.out[O_MN + so * 256 + tid] = nfin[tid]; }
        }
        ML_BAR();
#undef ML_LOAD
#undef ML_WRITE
#undef ML_CTB
#undef ML_COMB
#undef ML_HPRE
    }
}
#undef ML_BAR
#undef ML_TOK
#undef B_LOAD
#undef B_DECODE
}


namespace s5 {
typedef short s16x4 __attribute__((ext_vector_type(4)));
__device__ __forceinline__ s16x4 trr(unsigned addr) { s16x4 r; asm volatile("ds_read_b64_tr_b16 %0, %1" : "=&v"(r) : "v"(addr) : "memory"); return r; }
__device__ __forceinline__ unsigned cvtpk(float lo, float hi) { unsigned r; asm volatile("s_nop 0\n\tv_cvt_pk_bf16_f32 %0, %1, %2\n\ts_nop 1" : "=v"(r) : "v"(lo), "v"(hi)); return r; }
template <bool FULL>
__device__ __forceinline__ void scan_seg(const P& p, const int l, LAS unsigned char* T, const int g, const int dir, const bool lat, const int b0, const int lane, const int blk0, const int nblk,
                                         const float (&ar)[2], const float (&ai)[2], const bf16x8 (&bb)[4], float (&sr)[2], float (&si)[2]) {
    const int r32 = lane & 31, hh = lane >> 5;
    const int L = lat ? LL : CL;
    const int baseA = lat ? NCTX + b0 * LL : b0 * CL, baseB = baseA + L;
    const size_t pg = (size_t)(l * 2 + dir) * 64 + g;
    bf16x8 cm[8];
    if (FULL) {
#pragma unroll
        for (int ks = 0; ks < 8; ++ks) { u32x4 w = {0u, 0u, 0u, 0u};
            if (r32 < 16) { const int k0 = 16 * ks + 8 * hh; const float* src = (k0 < 64 ? p.in[27] : p.in[28]) + (pg * 16 + r32) * 64 + (k0 & 63); const float sg = k0 < 64 ? 1.f : -1.f;
#pragma unroll
                for (int j = 0; j < 4; ++j) w[j] = cvtpk(sg * src[2 * j], sg * src[2 * j + 1]); }
            cm[ks] = *reinterpret_cast<bf16x8*>(&w); } }
    const int urow_tok = 4 * (r32 >> 3) + (r32 & 3), urow_base = ((r32 >> 2) & 1) ? baseB : baseA;
    const bf16_t* U = (const bf16_t*)(p.ws + WS_S5U) + g * 16 + 8 * hh;
    bf16_t* Yo2 = (bf16_t*)(p.ws + (dir ? WS_YS5B : WS_YS5F)) + g * 16;
#define S5_POS(n, j) (dir ? (L - 1 - ((n) * 16 + (j))) : ((n) * 16 + (j)))
    bf16x8 ucur[4], unxt[4];
#pragma unroll
    for (int i = 0; i < 4; ++i) { ucur[i] = *(const bf16x8*)(U + (size_t)(urow_base + S5_POS(blk0 + i, urow_tok)) * 1024); unxt[i] = ucur[i]; }
    const unsigned tb = (unsigned)(uintptr_t)T;
    const int tq = (lane & 15) >> 2, tp = lane & 3, tc0 = 16 * ((lane >> 4) & 1) + 4 * tp;
    for (int n4 = blk0; n4 < blk0 + nblk; n4 += 4) {
        if (n4 + 4 < blk0 + nblk) {
#pragma unroll
            for (int i = 0; i < 4; ++i) unxt[i] = *(const bf16x8*)(U + (size_t)(urow_base + S5_POS(n4 + 4 + i, urow_tok)) * 1024); }
#pragma unroll
      for (int i4 = 0; i4 < 4; ++i4) { const int n = n4 + i4; const bf16x8 ucur1 = ucur[i4];
        f32x16 acc[4]; { float z0 = 0.f; asm volatile("" : "+v"(z0));
#pragma unroll
          for (int q = 0; q < 4; ++q)
#pragma unroll
              for (int r = 0; r < 16; ++r) acc[q][r] = z0; }
#pragma unroll
        for (int q = 0; q < 4; ++q) acc[q] = __builtin_amdgcn_mfma_f32_32x32x16_bf16(ucur1, bb[q], acc[q], 0, 0, 0);
#pragma unroll
        for (int pb = 0; pb < 2; ++pb) { float xr = sr[pb], xi = si[pb]; const float a_r = ar[pb], a_i = ai[pb];
#pragma unroll
            for (int r = 0; r < 16; ++r) { const float nr_ = a_r * xr - a_i * xi + acc[pb][r], ni_ = a_r * xi + a_i * xr + acc[2 + pb][r]; xr = nr_; xi = ni_; acc[pb][r] = nr_; acc[2 + pb][r] = ni_; }
            sr[pb] = xr; si[pb] = xi; }
        if (FULL) {
#pragma unroll
        for (int q = 0; q < 4; ++q)
#pragma unroll
            for (int a4 = 0; a4 < 4; ++a4) { u32x2 w; w.x = cvtpk(acc[q][4 * a4], acc[q][4 * a4 + 1]); w.y = cvtpk(acc[q][4 * a4 + 2], acc[q][4 * a4 + 3]);
                *(LAS u32x2*)(T + (q * 32 + r32) * 64 + 16 * a4 + 8 * hh) = w; }
        f32x16 y, y2; { float z0 = 0.f; asm volatile("" : "+v"(z0));
#pragma unroll
          for (int r = 0; r < 16; ++r) { y[r] = z0; y2[r] = z0; } }
        { s16x4 lo_[8], hi_[8];
#pragma unroll
          for (int ks = 0; ks < 8; ++ks) { const unsigned ta = tb + (16 * ks + 8 * hh + tq) * 64 + tc0 * 2; lo_[ks] = trr(ta); hi_[ks] = trr(ta + 4 * 64); }
          asm volatile("s_waitcnt lgkmcnt(0)" ::: "memory"); __builtin_amdgcn_sched_barrier(0);
#pragma unroll
          for (int ks = 0; ks < 8; ks += 2) {
            const bf16x8 af0 = (bf16x8){lo_[ks][0], lo_[ks][1], lo_[ks][2], lo_[ks][3], hi_[ks][0], hi_[ks][1], hi_[ks][2], hi_[ks][3]};
            const bf16x8 af1 = (bf16x8){lo_[ks + 1][0], lo_[ks + 1][1], lo_[ks + 1][2], lo_[ks + 1][3], hi_[ks + 1][0], hi_[ks + 1][1], hi_[ks + 1][2], hi_[ks + 1][3]};
            y = __builtin_amdgcn_mfma_f32_32x32x16_bf16(cm[ks], af0, y, 0, 0, 0);
            y2 = __builtin_amdgcn_mfma_f32_32x32x16_bf16(cm[ks + 1], af1, y2, 0, 0, 0); }
#pragma unroll
          for (int r = 0; r < 16; ++r) y[r] += y2[r]; }
        {
          bf16_t* yo = Yo2 + (size_t)(urow_base + S5_POS(n, urow_tok)) * 1024 + 4 * hh;
          u32x2 w0, w1; w0.x = cvtpk(y[0], y[1]); w0.y = cvtpk(y[2], y[3]); w1.x = cvtpk(y[4], y[5]); w1.y = cvtpk(y[6], y[7]);
          *(u32x2*)yo = w0; *(u32x2*)(yo + 8) = w1; }
        }
      }
#pragma unroll
        for (int i = 0; i < 4; ++i) ucur[i] = unxt[i];
    }
#undef S5_POS
}
__device__ __forceinline__ void params(const P& p, const int l, const int g, const int dir, const int lane, float (&ar)[2], float (&ai)[2], bf16x8 (&bb)[4]) {
    const int r32 = lane & 31, hh = lane >> 5; const size_t pg = (size_t)(l * 2 + dir) * 64 + g;
    const float dt = __expf(p.in[24][pg]);
#pragma unroll
    for (int pb = 0; pb < 2; ++pb) { const int pp = pb * 32 + r32;
        const float lr = fminf(p.in[22][pg * 64 + pp], -1e-4f), li = p.in[23][pg * 64 + pp];
        const float mag = __expf(dt * lr); float sn, cs; sincos_small(dt * li, sn, cs);
        const float a_r = mag * cs, a_i = mag * sn, den = lr * lr + li * li, nr = a_r - 1.0f, ni = a_i, qr = (nr * lr + ni * li) / den, qi = (ni * lr - nr * li) / den;
        ar[pb] = a_r; ai[pb] = a_i;
        const float* br = p.in[25] + (pg * 64 + pp) * 16 + 8 * hh; const float* bi = p.in[26] + (pg * 64 + pp) * 16 + 8 * hh;
        u32x4 wr, wi;
#pragma unroll
        for (int j = 0; j < 4; ++j) { const float r0 = qr * br[2 * j] - qi * bi[2 * j], r1 = qr * br[2 * j + 1] - qi * bi[2 * j + 1], i0 = qr * bi[2 * j] + qi * br[2 * j], i1 = qr * bi[2 * j + 1] + qi * br[2 * j + 1];
            wr[j] = cvtpk(r0, r1); wi[j] = cvtpk(i0, i1); }
        bb[pb] = *reinterpret_cast<bf16x8*>(&wr); bb[2 + pb] = *reinterpret_cast<bf16x8*>(&wi); }
}
__device__ __forceinline__ void ctx_unit(const P& p, const int l, LAS unsigned char* T, const int u, const int lane) {
    const int dir = u & 1, g = (u >> 1) & 63, b0 = 2 * (u >> 7), r32 = lane & 31, hh = lane >> 5;
    float ar[2], ai[2]; bf16x8 bb[4]; params(p, l, g, dir, lane, ar, ai, bb);
    float sr[2] = {0.f, 0.f}, si[2] = {0.f, 0.f};
    scan_seg<true>(p, l, T, g, dir, false, b0, lane, 0, CL / 16, ar, ai, bb, sr, si);
#pragma unroll
    for (int pb = 0; pb < 2; ++pb) { const size_t so = ((size_t)(((b0 + hh) * 2 + l) * 2 + dir) * 64 + g) * 64 + pb * 32 + r32; p.out[O_SR + so] = sr[pb]; p.out[O_SI + so] = si[pb]; }
}
__device__ __forceinline__ void lat_unit(const P& p, const int l, LAS unsigned char* lds, const int u, const int wave, const int lane) {
    const int dir = u & 1, g = (u >> 1) & 63, b0 = 2 * (u >> 7), r32 = lane & 31, hh = lane >> 5;
    LAS unsigned char* T = lds + wave * 8192; LAS float* X = (LAS float*)(lds + 65536);
    float ar[2], ai[2]; bf16x8 bb[4]; params(p, l, g, dir, lane, ar, ai, bb);
    float sr[2] = {0.f, 0.f}, si[2] = {0.f, 0.f};
    if (wave == 0) {
#pragma unroll
        for (int pb = 0; pb < 2; ++pb) { const size_t so = ((size_t)(((b0 + hh) * 2 + l) * 2 + dir) * 64 + g) * 64 + pb * 32 + r32; sr[pb] = p.in[9][so]; si[pb] = p.in[10][so]; } }
    const float s0r[2] = {sr[0], sr[1]}, s0i[2] = {si[0], si[1]};
    constexpr int SEGB = LL / 16 / 8;
    if (wave < 7) scan_seg<false>(p, l, T, g, dir, true, b0, lane, wave * SEGB, SEGB, ar, ai, bb, sr, si);
#pragma unroll
    for (int pb = 0; pb < 2; ++pb) { X[(wave * 4 + pb) * 64 + lane] = sr[pb]; X[(wave * 4 + 2 + pb) * 64 + lane] = si[pb]; }
    __syncthreads();
    float pr[2], pi[2];
#pragma unroll
    for (int pb = 0; pb < 2; ++pb) { float xr = ar[pb], xi = ai[pb];
#pragma unroll
        for (int k = 0; k < 9; ++k) { const float nr = xr * xr - xi * xi, ni = 2.f * xr * xi; xr = nr; xi = ni; }
        pr[pb] = xr; pi[pb] = xi; }
    float cr[2], ci[2];
    if (wave == 0) { cr[0] = s0r[0]; cr[1] = s0r[1]; ci[0] = s0i[0]; ci[1] = s0i[1]; }
    else {
#pragma unroll
        for (int pb = 0; pb < 2; ++pb) { float xr = X[(0 * 4 + pb) * 64 + lane], xi = X[(0 * 4 + 2 + pb) * 64 + lane];
            for (int j = 1; j < wave; ++j) { const float er = X[(j * 4 + pb) * 64 + lane], ei = X[(j * 4 + 2 + pb) * 64 + lane];
                const float nr = pr[pb] * xr - pi[pb] * xi + er, ni = pr[pb] * xi + pi[pb] * xr + ei; xr = nr; xi = ni; }
            cr[pb] = xr; ci[pb] = xi; } }
    scan_seg<true>(p, l, T, g, dir, true, b0, lane, wave * SEGB, SEGB, ar, ai, bb, cr, ci);
    __syncthreads();
}
__device__ __forceinline__ void combine_row(const P& p, const int l, const int r, const int lane) {
    const bf16_t* yf = (const bf16_t*)(p.ws + WS_YS5F) + (size_t)r * 1024; const bf16_t* yb = (const bf16_t*)(p.ws + WS_YS5B) + (size_t)r * 1024; const bf16_t* uu = (const bf16_t*)(p.ws + WS_S5U) + (size_t)r * 1024;
    bf16_t* o = (bf16_t*)(p.ws + WS_HB) + (size_t)r * 1024; const float* dv = p.in[29] + l * 1024;
#pragma unroll
    for (int j = 0; j < 2; ++j) { const int c = j * 512 + lane * 8; float a[8], b[8], u[8];
        { const u32x4 w = *(const u32x4*)(yf + c);
#pragma unroll
          for (int i = 0; i < 4; ++i) { a[2 * i] = bf2f(w[i]); a[2 * i + 1] = bf2f(w[i] >> 16); } }
        { const u32x4 w = *(const u32x4*)(yb + c);
#pragma unroll
          for (int i = 0; i < 4; ++i) { b[2 * i] = bf2f(w[i]); b[2 * i + 1] = bf2f(w[i] >> 16); } }
        { const u32x4 w = *(const u32x4*)(uu + c);
#pragma unroll
          for (int i = 0; i < 4; ++i) { u[2 * i] = bf2f(w[i]); u[2 * i + 1] = bf2f(w[i] >> 16); } }
        const f32x4 d0 = *(const f32x4*)(dv + c), d1 = *(const f32x4*)(dv + c + 4);
        float gq[8];
#pragma unroll
        for (int i = 0; i < 8; ++i) gq[i] = gelu_tanh(a[i] + b[i] + (i < 4 ? d0[i] : d1[i - 4]) * u[i]);
        u32x4 w; w.x = pk2(gq[0], gq[1]); w.y = pk2(gq[2], gq[3]); w.z = pk2(gq[4], gq[5]); w.w = pk2(gq[6], gq[7]);
        *(u32x4*)(o + c) = w; }
}
}

__device__ __forceinline__ float rope_lane(float x, int lane, int prow, int pcol, const float* rt) {
    const int part = lane >> 5, jj = lane & 31, idx = jj & 15, pos = part ? pcol : prow;
    const float c = rt[pos * 16 + idx], s = rt[1024 + pos * 16 + idx];
    const float o = __shfl_xor(x, 16);
    return (jj >= 16) ? (x * c + o * s) : (x * c - o * s);
}
__device__ __forceinline__ u32x4 rope8(const u32x4 x, const int d0  , const int prow, const int pcol, const float* rt, const int pmask) {
    const int part = d0 >> 5, jj = d0 & 31, idx0 = jj & 15, pos = part ? pcol : prow; const bool second = jj >= 16;
    u32x4 o, y;
#pragma unroll
    for (int i = 0; i < 4; ++i) o[i] = __shfl_xor(x[i], pmask);
    const f32x4 c0 = *(const f32x4*)(rt + pos * 16 + idx0), c1 = *(const f32x4*)(rt + pos * 16 + idx0 + 4), s0 = *(const f32x4*)(rt + 1024 + pos * 16 + idx0), s1 = *(const f32x4*)(rt + 1024 + pos * 16 + idx0 + 4);
#pragma unroll
    for (int i = 0; i < 4; ++i) { const float ca = i < 2 ? c0[2 * i] : c1[2 * i - 4], cb = i < 2 ? c0[2 * i + 1] : c1[2 * i - 3], sa = i < 2 ? s0[2 * i] : s1[2 * i - 4], sb = i < 2 ? s0[2 * i + 1] : s1[2 * i - 3];
        const float xa = bf2f(x[i]), xb = bf2f(x[i] >> 16), oa = bf2f(o[i]), ob = bf2f(o[i] >> 16);
        y[i] = second ? pk2(xa * ca + oa * sa, xb * cb + ob * sb) : pk2(xa * ca - oa * sa, xb * cb - ob * sb); }
    return y;
}
__device__ __forceinline__ void ph_prep_row(const P& p, int l, int r, int lane) {
    unsigned char* ws = p.ws;
    bf16_t* ckvn = (bf16_t*)(ws + WS_CKVN) + (size_t)r * 512;
    bf16_t* kf = (bf16_t*)(ws + WS_KFULL) + (size_t)r * 1536;
    bf16_t* dfk = (bf16_t*)(ws + WS_DFK) + (size_t)r * 1024;
    bf16_t* dfv = (bf16_t*)(ws + WS_DFV) + (size_t)r * 1024;
    if (r >= MTOK) {
        const int i = r - MTOK, b = i >> 8, t = i & 255; const size_t cr = (size_t)(b * 2 + l) * PAST + t;
        { const float* cc = p.in[2] + cr * 512 + lane * 8; const f32x4 a = *(const f32x4*)cc, c = *(const f32x4*)(cc + 4);
          u32x4 w; w.x = pk2(a[0], a[1]); w.y = pk2(a[2], a[3]); w.z = pk2(c[0], c[1]); w.w = pk2(c[2], c[3]); *(u32x4*)(ckvn + lane * 8) = w; }
        const float kr = p.in[3][cr * 64 + lane];
#pragma unroll
        for (int h = 0; h < 8; ++h) kf[h * 192 + 128 + lane] = (bf16_t)f2bf(kr);
        const float* ck = p.in[4] + cr * 1024 + lane * 16; const float* cv = p.in[5] + cr * 1024 + lane * 16;
#pragma unroll
        for (int j = 0; j < 2; ++j) { const f32x4 a = *(const f32x4*)(ck + 8 * j), c = *(const f32x4*)(ck + 8 * j + 4), d = *(const f32x4*)(cv + 8 * j), e = *(const f32x4*)(cv + 8 * j + 4);
            u32x4 w; w.x = pk2(a[0], a[1]); w.y = pk2(a[2], a[3]); w.z = pk2(c[0], c[1]); w.w = pk2(c[2], c[3]); *(u32x4*)(dfk + lane * 16 + 8 * j) = w;
            u32x4 v; v.x = pk2(d[0], d[1]); v.y = pk2(d[2], d[3]); v.z = pk2(e[0], e[1]); v.w = pk2(e[2], e[3]); *(u32x4*)(dfv + lane * 16 + 8 * j) = v; }
        return;
    }
    const float* kva = (const float*)(ws + WS_KVA) + (size_t)r * KVAW;
    const bool ctx = r < NCTX;
    const int cb = r >> 8, ct = r & 255;
    const int t = (r - NCTX) & 4095, prow = t >> 6, pcol = t & 63;
    const float* rt = (const float*)(ws + WS_ROPE);
    const f32x4 ka = *(const f32x4*)(kva + lane * 8), kb = *(const f32x4*)(kva + lane * 8 + 4);
    float kr = kva[512 + lane];
    const float graw = lane < 16 ? kva[576 + lane] + p.in[18][l * 16 + lane] : 0.f;
    bf16_t* mq = (bf16_t*)(ws + WS_MQ) + (size_t)r * 1536 + (lane >> 3) * 192 + 128 + (lane & 7) * 8;
    bf16_t* dfq = (bf16_t*)(ws + WS_DFQ) + (size_t)r * 1024 + lane * 16;
    u32x4 xq = {0u, 0u, 0u, 0u}, xd0 = xq, xd1 = xq, xk0 = xq, xk1 = xq, xv0 = xq, xv1 = xq;
    if (!ctx) { xq = *(const u32x4*)mq; xd0 = *(const u32x4*)dfq; xd1 = *(const u32x4*)(dfq + 8); }
    xk0 = *(const u32x4*)(dfk + lane * 16); xk1 = *(const u32x4*)(dfk + lane * 16 + 8);
    if (ctx) { xv0 = *(const u32x4*)(dfv + lane * 16); xv1 = *(const u32x4*)(dfv + lane * 16 + 8); }
    { float ss = ka[0] * ka[0] + ka[1] * ka[1] + ka[2] * ka[2] + ka[3] * ka[3] + kb[0] * kb[0] + kb[1] * kb[1] + kb[2] * kb[2] + kb[3] * kb[3];
      const float rstd = rsqrtf(wave_sum(ss) * (1.0f / 512.0f) + 1e-6f);
      const float* g = p.in[20] + l * 512 + lane * 8; const f32x4 g0 = *(const f32x4*)g, g1 = *(const f32x4*)(g + 4);
      const f32x4 y0 = ka * rstd * g0, y1 = kb * rstd * g1;
      u32x4 w; w.x = pk2(y0[0], y0[1]); w.y = pk2(y0[2], y0[3]); w.z = pk2(y1[0], y1[1]); w.w = pk2(y1[2], y1[3]); *(u32x4*)(ckvn + lane * 8) = w;
      if (ctx) { float* o = p.out + O_CKV + ((size_t)(cb * 2 + l) * CL + ct) * 512 + lane * 8; *(f32x4*)o = y0; *(f32x4*)(o + 4) = y1; } }
    { if (ctx) p.out[O_KR + ((size_t)(cb * 2 + l) * CL + ct) * 64 + lane] = kr; else kr = rope_lane(kr, lane, prow, pcol, rt);
#pragma unroll
      for (int h = 0; h < 8; ++h) kf[h * 192 + 128 + lane] = (bf16_t)f2bf(kr); }
    if (lane < 16) { const float o = ((lane >> 2) & 1) ? (fminf(graw, 0.f) - __logf(1.0f + __expf(-fabsf(graw)))) : graw; ((float*)(ws + WS_GATES))[(size_t)r * 16 + lane] = o; }
    if (ctx) {
        float* ok = p.out + O_DK + ((size_t)(cb * 2 + l) * CL + ct) * 1024 + lane * 16; float* ov = p.out + O_DV + ((size_t)(cb * 2 + l) * CL + ct) * 1024 + lane * 16;
#pragma unroll
        for (int i = 0; i < 4; ++i) { *(f32x2_*)(ok + 2 * i) = (f32x2_){bf2f(xk0[i]), bf2f(xk0[i] >> 16)}; *(f32x2_*)(ok + 8 + 2 * i) = (f32x2_){bf2f(xk1[i]), bf2f(xk1[i] >> 16)};
            *(f32x2_*)(ov + 2 * i) = (f32x2_){bf2f(xv0[i]), bf2f(xv0[i] >> 16)}; *(f32x2_*)(ov + 8 + 2 * i) = (f32x2_){bf2f(xv1[i]), bf2f(xv1[i] >> 16)}; }
    } else {
        *(u32x4*)mq = rope8(xq, (lane & 7) * 8, prow, pcol, rt, 2);
        const int q = lane & 3;
        *(u32x4*)dfq = rope8(xd0, q * 16, prow, pcol, rt, 1); *(u32x4*)(dfq + 8) = rope8(xd1, q * 16 + 8, prow, pcol, rt, 1);
        *(u32x4*)(dfk + lane * 16) = rope8(xk0, q * 16, prow, pcol, rt, 1); *(u32x4*)(dfk + lane * 16 + 8) = rope8(xk1, q * 16 + 8, prow, pcol, rt, 1);
    }
}

__device__ __forceinline__ void ph_ml_combine_row(const P& p, int l, int r, int lane) {
    bf16_t* hf = (bf16_t*)(p.ws + WS_HF) + (size_t)r * 1024 + lane * 4; const bf16_t* hb = (const bf16_t*)(p.ws + WS_HB) + (size_t)r * 1024 + lane * 4;
    const bf16_t* so = (const bf16_t*)(p.ws + WS_MLO) + (size_t)r * 1024 + lane * 4; const float* g = p.in[19] + l * 1024 + lane * 4;
    u32x2 a[4], b[4], c[4]; f32x4 gg[4];
#pragma unroll
    for (int h = 0; h < 4; ++h) { a[h] = *(const u32x2*)(hf + h * 256); b[h] = *(const u32x2*)(hb + h * 256); c[h] = *(const u32x2*)(so + h * 256); gg[h] = *(const f32x4*)(g + h * 256); }
#pragma unroll
    for (int h = 0; h < 4; ++h) { float v[4];
        v[0] = bf2f(a[h].x) + bf2f(b[h].x); v[1] = bf2f(a[h].x >> 16) + bf2f(b[h].x >> 16); v[2] = bf2f(a[h].y) + bf2f(b[h].y); v[3] = bf2f(a[h].y >> 16) + bf2f(b[h].y >> 16);
        const float rstd = rsqrtf(wave_sum(v[0] * v[0] + v[1] * v[1] + v[2] * v[2] + v[3] * v[3]) * (1.0f / 256.0f) + 1e-6f);
        u32x2 w; w.x = pk2(v[0] * rstd * gg[h][0] * bf2f(c[h].x), v[1] * rstd * gg[h][1] * bf2f(c[h].x >> 16)); w.y = pk2(v[2] * rstd * gg[h][2] * bf2f(c[h].y), v[3] * rstd * gg[h][3] * bf2f(c[h].y >> 16));
        *(u32x2*)(hf + h * 256) = w; }
}

__device__ __forceinline__ void ph_df_combine_row(const P& p, int l, float lam_init, float lam, int r, int lane) {
    const int h = lane >> 3, part = lane & 7;
    const bf16_t* o = (const bf16_t*)(p.ws + WS_DFO) + (size_t)r * 2048 + h * 256 + part * 16;
    const u32x4 a0 = *(const u32x4*)o, a1 = *(const u32x4*)(o + 8), b0 = *(const u32x4*)(o + 128), b1 = *(const u32x4*)(o + 136);
    const float* g = p.in[32] + l * 128 + part * 16;
    float v[16]; float ss = 0.f;
#pragma unroll
    for (int i = 0; i < 4; ++i) { v[2 * i] = bf2f(a0[i]) - lam * bf2f(b0[i]); v[2 * i + 1] = bf2f(a0[i] >> 16) - lam * bf2f(b0[i] >> 16); v[8 + 2 * i] = bf2f(a1[i]) - lam * bf2f(b1[i]); v[9 + 2 * i] = bf2f(a1[i] >> 16) - lam * bf2f(b1[i] >> 16); }
#pragma unroll
    for (int i = 0; i < 16; ++i) ss += v[i] * v[i];
    ss += __shfl_xor(ss, 1); ss += __shfl_xor(ss, 2); ss += __shfl_xor(ss, 4);
    const float sc = rsqrtf(ss * (1.0f / 128.0f) + 1e-6f) * (1.0f - lam_init);
    u32x4 w0, w1;
#pragma unroll
    for (int i = 0; i < 4; ++i) { w0[i] = pk2(v[2 * i] * sc * g[2 * i], v[2 * i + 1] * sc * g[2 * i + 1]); w1[i] = pk2(v[8 + 2 * i] * sc * g[8 + 2 * i], v[9 + 2 * i] * sc * g[9 + 2 * i]); }
    bf16_t* y = (bf16_t*)(p.ws + WS_DFQ) + (size_t)r * 1024 + h * 128 + part * 16;
    *(u32x4*)y = w0; *(u32x4*)(y + 8) = w1;
}
__device__ __forceinline__ void ph_final_row(const P& p, int r, int lane) {
    const float* x = (const float*)(p.ws + WS_X) + (size_t)r * D; const float* g = p.in[37];
    f32x4 v[8]; float ss = 0.f;
#pragma unroll
    for (int j = 0; j < 8; ++j) { v[j] = *(const f32x4*)(x + j * 256 + lane * 4); ss += v[j][0] * v[j][0] + v[j][1] * v[j][1] + v[j][2] * v[j][2] + v[j][3] * v[j][3]; }
    const float rstd = rsqrtf(wave_sum(ss) * (1.0f / 2048.0f) + 1e-6f);
    float* o = p.out + (r < NCTX ? O_YP + (size_t)r * D : O_YS + (size_t)(r - NCTX) * D);
#pragma unroll
    for (int j = 0; j < 8; ++j) { const int c = j * 256 + lane * 4; const f32x4 gg = *(const f32x4*)(g + c); *(f32x4*)(o + c) = v[j] * rstd * gg; }
}

__device__ __forceinline__ void load_args(P& p) {
#if defined(__HIP_DEVICE_COMPILE__)
    const __attribute__((address_space(4))) unsigned long long* q = (const __attribute__((address_space(4))) unsigned long long*)__builtin_amdgcn_kernarg_segment_ptr();
    asm volatile("" : "+s"(q));
#pragma unroll
    for (int i = 0; i < 38; ++i) p.in[i] = (const float*)q[i];
    p.out = (float*)q[38]; p.ws = (unsigned char*)q[39];
#endif
}
constexpr int NTHR = 512, LDS_BYTES = 147456, MISC_OFF = 131072;
#ifndef PROBE
#define PROBE 0
#endif
#ifndef PROBE_MASK_D
#define PROBE_MASK_D 0u
#endif
#ifndef PROBE_MASK_A
#define PROBE_MASK_A 0u
#endif
#define PROBE_MULT 10
#define PROBE_ADIV 100.0f
#define STAMP(idx) do { if (PROBE) { if (blockIdx.x == 0 && bar.w == 0u && lane_id_() == 0u) ((LAS unsigned long long*)((LAS unsigned char*)lds + MISC_OFF + 2048))[idx] = __builtin_amdgcn_s_memrealtime(); } } while (0)
#define GRID_BAR() do { XcdBarrier b_ = bar; asm volatile("" : "+s"(b_.x)); xcd_barrier(b_); } while (0)

#define PH_VARS P p; load_args(p); unsigned char* ws = p.ws; (void)ws; int tid_ = (int)(bar.w * 64u + lane_id_()); asm volatile("" : "+v"(tid_)); const int lane = tid_ & 63, wave = __builtin_amdgcn_readfirstlane(tid_ >> 6), half = tid_ >> 8, vt = tid_ & 255; \
    const int gw = blockIdx.x * 8 + wave, vb = blockIdx.x * 2 + half; (void)lane; (void)half; (void)vt; (void)gw; (void)vb;

template <int l>
__device__ __forceinline__ void run_layer(unsigned char* lds, const XcdBarrier& bar, const int G, const int NGW) {
        { PH_VARS ph_convert(p, l, gw, NGW, lane, (LAS float*)((LAS unsigned char*)lds + wave * 16384), l == 0, true); }
        { PH_VARS for (int r = gw; r < MTOK; r += NGW) ph_hnorm_row(p, l, 0, r, lane); }
        GRID_BAR(); STAMP(1 + 17 * l + 1);
        { PH_VARS pg8::Gemm g{(const bf16_t*)(ws + WS_H), (const bf16_t*)(ws + WS_WBF + WB_IN), MTOK, 10496, D}; pg8::StaticOrder S; S.init(MTOK, 10496, G, (int)blockIdx.x);
          pg8::gemm_phase<Epi8In, pg8::StaticOrder, true, true>((LAS unsigned char*)lds, g, S, Epi8In{ws}, tid_); }
        GRID_BAR(); STAMP(1 + 17 * l + 2);
        { PH_VARS for (int ch = blockIdx.x; ch < 160; ch += G) ml::scalars_wg(p, l, ch, wave, lane, (LAS float*)((LAS unsigned char*)lds)); for (int r = gw; r < MALL; r += NGW) ph_prep_row(p, l, r, lane); }
        GRID_BAR(); STAMP(1 + 17 * l + 3);
        { PH_VARS pg8::Gemm g{(const bf16_t*)(ws + WS_CKVN), (const bf16_t*)(ws + WS_WBF + WB_KVB), MALL, 2048, 512}; pg8::StaticOrder S; S.init(MALL, 2048, G, (int)blockIdx.x);
          pg8::gemm_phase<Epi8Kvb, pg8::StaticOrder, true, true>((LAS unsigned char*)lds, g, S, Epi8Kvb{(bf16_t*)(ws + WS_KFULL), (bf16_t*)(ws + WS_VFULL)}, tid_); }
        STAMP(1 + 17 * l + 4);
        { PH_VARS ml::intra_phase((LAS unsigned char*)lds, p, l, tid_); }
        GRID_BAR();
        { PH_VARS ml::seq_phase((LAS unsigned char*)lds, p, l, tid_); }
        GRID_BAR(); STAMP(1 + 17 * l + 5);
        { PH_VARS
          for (int u = xcd_slot(); u < 256; u += G) { int ln_ = lane; asm volatile("" : "+v"(ln_)); s5::lat_unit(p, l, (LAS unsigned char*)lds, u, wave, ln_); }
          if (wave < 4) { for (int u = wave * G + blockIdx.x; u < 1024; u += 4 * G) s5::ctx_unit(p, l, (LAS unsigned char*)lds + wave * 8192, u, lane); }
          else { for (int r = blockIdx.x * 4 + (wave - 4); r < MTOK; r += G * 4) ph_ml_combine_row(p, l, r, lane); } }
        GRID_BAR(); STAMP(1 + 17 * l + 6);
        { PH_VARS for (int r = gw; r < MTOK; r += NGW) s5::combine_row(p, l, r, lane); }
        GRID_BAR(); STAMP(1 + 17 * l + 7);
        { PH_VARS pg8::Gemm g{(const bf16_t*)(ws + WS_HB), (const bf16_t*)(ws + WS_WBF + WB_GLU), MTOK, 1024, 1024}; pg8::StaticOrder S; S.init(MTOK, 1024, G, (int)blockIdx.x);
          pg8::gemm_phase<Epi8Glu, pg8::StaticOrder, true, true>((LAS unsigned char*)lds, g, S, Epi8Glu{(const bf16_t*)(ws + WS_HB), (bf16_t*)(ws + WS_S5U)}, tid_); }
        STAMP(1 + 17 * l + 8);
        { PH_VARS fa::Args aa{(const bf16_t*)(ws + WS_MQ), (const bf16_t*)(ws + WS_KFULL), (const bf16_t*)(ws + WS_VFULL), (bf16_t*)(ws + WS_MLQ), 1536, 1536, 1024, 1024, 8, 1, 0.07216878364870322f, 0};
          fa::attn_phase<192>((LAS unsigned char*)lds, aa, tid_); }
        STAMP(1 + 17 * l + 9);
        { PH_VARS fa::Args aa{(const bf16_t*)(ws + WS_DFQ), (const bf16_t*)(ws + WS_DFK), (const bf16_t*)(ws + WS_DFV), (bf16_t*)(ws + WS_DFO), 1024, 1024, 1024, 2048, 16, 2, 0.125f, 0};
          fa::attn_phase<64>((LAS unsigned char*)lds, aa, tid_); }
        GRID_BAR(); STAMP(1 + 17 * l + 10);
        { PH_VARS const float lam_init = (l == 0) ? 0.2f : 0.35550906759096927f;
          const float* lp = p.in[31] + l * 256;
          const float lam = __expf(wave_sum(lp[lane] * lp[64 + lane])) - __expf(wave_sum(lp[128 + lane] * lp[192 + lane])) + lam_init;
          for (int r = gw; r < MTOK; r += NGW) ph_df_combine_row(p, l, lam_init, lam, r, lane); }
        GRID_BAR(); STAMP(1 + 17 * l + 11);
        { PH_VARS pg8::Gemm g{(const bf16_t*)(ws + WS_H), (const bf16_t*)(ws + WS_WBF + WB_IN) + (size_t)10496 * D, MTOK, GATE_COLS, D}; pg8::StaticOrder S; S.init(MTOK, GATE_COLS, G, (int)blockIdx.x);
          pg8::gemm_phase<Epi8Gate, pg8::StaticOrder, true, true>((LAS unsigned char*)lds, g, S, Epi8Gate{(bf16_t*)(ws + WS_GS)}, tid_); }
        GRID_BAR(); STAMP(1 + 17 * l + 12);
        { PH_VARS pg8::Gemm g{(const bf16_t*)(ws + WS_HF), (const bf16_t*)(ws + WS_WBF + WB_BR) + (size_t)0 * 2048 * 1024, MTOK, D, 1024}; pg8::StaticOrder S; S.init(MTOK, D, G, (int)blockIdx.x);
          pg8::gemm_phase<Epi8Merge, pg8::StaticOrder, true, true>((LAS unsigned char*)lds, g, S, Epi8Merge{(const bf16_t*)(ws + WS_GS), (bf16_t*)(ws + WS_H), 0, 0}, tid_); }
        { PH_VARS pg8::Gemm g{(const bf16_t*)(ws + WS_MLQ), (const bf16_t*)(ws + WS_WBF + WB_BR) + (size_t)1 * 2048 * 1024, MTOK, D, 1024}; pg8::StaticOrder S; S.init(MTOK, D, G, (int)blockIdx.x);
          pg8::gemm_phase<Epi8Merge, pg8::StaticOrder, true, true>((LAS unsigned char*)lds, g, S, Epi8Merge{(const bf16_t*)(ws + WS_GS), (bf16_t*)(ws + WS_H), 1, 0}, tid_); }
        { PH_VARS pg8::Gemm g{(const bf16_t*)(ws + WS_S5U), (const bf16_t*)(ws + WS_WBF + WB_BR) + (size_t)2 * 2048 * 1024, MTOK, D, 1024}; pg8::StaticOrder S; S.init(MTOK, D, G, (int)blockIdx.x);
          pg8::gemm_phase<Epi8Merge, pg8::StaticOrder, true, true>((LAS unsigned char*)lds, g, S, Epi8Merge{(const bf16_t*)(ws + WS_GS), (bf16_t*)(ws + WS_H), 2, 0}, tid_); }
        { PH_VARS pg8::Gemm g{(const bf16_t*)(ws + WS_DFQ), (const bf16_t*)(ws + WS_WBF + WB_BR) + (size_t)3 * 2048 * 1024, MTOK, D, 1024}; pg8::StaticOrder S; S.init(MTOK, D, G, (int)blockIdx.x);
          pg8::gemm_phase<Epi8Merge, pg8::StaticOrder, true, true>((LAS unsigned char*)lds, g, S, Epi8Merge{(const bf16_t*)(ws + WS_GS), (bf16_t*)(ws + WS_H), 3, 0}, tid_); }
        GRID_BAR(); STAMP(1 + 17 * l + 13);
        { PH_VARS pg8::Gemm g{(const bf16_t*)(ws + WS_H), (const bf16_t*)(ws + WS_WBF + WB_O), MTOK, D, D}; pg8::StaticOrder S; S.init(MTOK, D, G, (int)blockIdx.x);
          pg8::gemm_phase<Epi8Res, pg8::StaticOrder, true, true>((LAS unsigned char*)lds, g, S, Epi8Res{p, l, 4096, 0, 0}, tid_); }
        GRID_BAR(); STAMP(1 + 17 * l + 14);
        { PH_VARS for (int r = gw; r < MTOK; r += NGW) ph_hnorm_row(p, l, 1, r, lane); }
        GRID_BAR(); STAMP(1 + 17 * l + 15);
        { PH_VARS pg8::Gemm g{(const bf16_t*)(ws + WS_H), (const bf16_t*)(ws + WS_WBF + WB_FIN), MTOK, 2 * FFN, D}; pg8::StaticOrder S; S.init(MTOK, 2 * FFN, G, (int)blockIdx.x);
          pg8::gemm_phase<Epi8FfnIn, pg8::StaticOrder, true, true>((LAS unsigned char*)lds, g, S, Epi8FfnIn{(bf16_t*)(ws + WS_FFNH)}, tid_); }
        GRID_BAR(); STAMP(1 + 17 * l + 16);
        { PH_VARS pg8::Gemm g{(const bf16_t*)(ws + WS_FFNH), (const bf16_t*)(ws + WS_WBF + WB_FOUT), MTOK, D, FFN}; pg8::StaticOrder S; S.init(MTOK, D, G, (int)blockIdx.x);
          pg8::gemm_phase<Epi8Res, pg8::StaticOrder, true, true>((LAS unsigned char*)lds, g, S, Epi8Res{p, l, 10240, 1, 0}, tid_); }
        if (l == 0) { PH_VARS
          const int rem = 640 % G, nidle = rem ? G - rem : G, idx = rem ? (int)blockIdx.x - rem : (int)blockIdx.x;
          if (idx >= 0) ph_convert(p, 1, idx * 8 + wave, nidle * 8, lane, (LAS float*)((LAS unsigned char*)lds + wave * 16384), true, false); }
        GRID_BAR(); STAMP(1 + 17 * l + 17);
}

__global__ void __launch_bounds__(NTHR, 2) mega(P p_arg) {
    extern __shared__ __attribute__((aligned(16))) unsigned char lds[];
    const int tid = threadIdx.x;
    const int G = gridDim.x, NGW = G * 8;
    for (int u = tid; u < (LDS_BYTES - MISC_OFF) / 4; u += NTHR) ((LAS unsigned*)((LAS unsigned char*)lds + MISC_OFF))[u] = 0u;
    __syncthreads();
    XcdBarrier bar = xcd_barrier_post((unsigned*)(p_arg.ws + WS_CTL), (volatile LAS unsigned*)((LAS unsigned char*)lds + MISC_OFF + 32));
    STAMP(0);
    { PH_VARS ph_mod_partial(p, tid_, (float*)lds); }
    GRID_BAR();
    { PH_VARS ph_mod_reduce(p, tid_); }
    GRID_BAR(); STAMP(1);
    run_layer<0>(lds, bar, G, NGW);
    run_layer<1>(lds, bar, G, NGW);
    { PH_VARS for (int r = gw; r < MTOK; r += NGW) ph_final_row(p, r, lane);
#if PROBE
      STAMP(35);
      if (blockIdx.x == 0 && bar.w == 0u && lane_id_() == 0u) {
          asm volatile("s_waitcnt vmcnt(0) lgkmcnt(0)" ::: "memory");
          const LAS unsigned long long* ts = (const LAS unsigned long long*)((LAS unsigned char*)lds + MISC_OFF + 2048);
          unsigned long long sd = 0, sa = 0;
          for (int ll = 0; ll < 2; ++ll) for (int i = 0; i < 17; ++i) { const unsigned long long d = ts[1 + 17 * ll + i + 1] - ts[1 + 17 * ll + i]; if ((PROBE_MASK_D >> i) & 1u) sd += d; if ((PROBE_MASK_A >> i) & 1u) sa += d; }
          { const unsigned long long d = ts[1] - ts[0]; if ((PROBE_MASK_D >> 17) & 1u) sd += d; if ((PROBE_MASK_A >> 17) & 1u) sa += d; }
          { const unsigned long long d = ts[35] - ts[34]; if ((PROBE_MASK_D >> 18) & 1u) sd += d; if ((PROBE_MASK_A >> 18) & 1u) sa += d; }
          float v = (float)sa * 0.01f / PROBE_ADIV; v = v > 120.f ? 120.f : v;
          if (PROBE_MASK_A) p.out[O_YS] += v;
          const unsigned long long t0 = __builtin_amdgcn_s_memrealtime(), wait = sd * PROBE_MULT;
          while (__builtin_amdgcn_s_memrealtime() - t0 < wait) __builtin_amdgcn_s_sleep(32);
      }
#endif
    }
}

extern "C" void kernel_launch(void* const* d_in, const int* in_sizes, int n_in, void* d_out, int out_size, void* d_ws, size_t ws_size, hipStream_t stream) {
    static int grid = 0;
    if (grid == 0) {
        if (n_in != 38 || out_size != (int)O_END || ws_size < WS_END) { fprintf(stderr, "kernel_launch: unexpected shapes (n_in %d out %d ws %zu)\n", n_in, out_size, ws_size); grid = -1; return; }
        int dev = 0, cus = 0, per_cu = 0;
        if (hipGetDevice(&dev) != hipSuccess || hipDeviceGetAttribute(&cus, hipDeviceAttributeMultiprocessorCount, dev) != hipSuccess) { grid = -1; return; }
        if (hipFuncSetAttribute((const void*)mega, hipFuncAttributeMaxDynamicSharedMemorySize, LDS_BYTES) != hipSuccess) { fprintf(stderr, "kernel_launch: hipFuncSetAttribute failed\n"); grid = -1; return; }
        if (hipOccupancyMaxActiveBlocksPerMultiprocessor(&per_cu, (const void*)mega, NTHR, LDS_BYTES) != hipSuccess || per_cu < 1) { fprintf(stderr, "kernel_launch: occupancy query says %d workgroups per CU\n", per_cu); grid = -1; return; }
        (void)hipGetLastError();
        grid = cus;
    }
    if (grid < 0) return;
    if (hipMemsetAsync((char*)d_ws + WS_CTL, 0, CTL_BYTES, stream) != hipSuccess) return;
    P p{};
    for (int i = 0; i < 38; ++i) p.in[i] = (const float*)d_in[i];
    p.out = (float*)d_out; p.ws = (unsigned char*)d_ws;
    hipLaunchKernelGGL(mega, dim3(grid), dim3(NTHR), LDS_BYTES, stream, p);
}
```

```cpp
#include <hip/hip_runtime.h>
#include <cstdio>
#include <cstdint>

typedef unsigned short bf16_t;
typedef short bf16x8 __attribute__((ext_vector_type(8)));
typedef float f32x16 __attribute__((ext_vector_type(16)));
typedef float f32x4 __attribute__((ext_vector_type(4)));
typedef unsigned u32x4 __attribute__((ext_vector_type(4)));
typedef unsigned u32x2 __attribute__((ext_vector_type(2)));
typedef float f32x2_ __attribute__((ext_vector_type(2)));

constexpr int D = 2048, NCTX = 4096, NLAT = 16384, MTOK = 20480, MALL = 21504;
constexpr int CB = 16, CL = 256, LB = 4, LL = 4096, PAST = 256;
constexpr int IN_COLS = 18512, MIX_COLS = 10320, GATE_COLS = 8192;
constexpr int C_MLQ = 0, C_MLK = 1024, C_MLV = 2048, C_MLO = 3072, C_MLIF = 4096, C_MQ = 4112, C_KVA = 5648, C_S5U = 6224, C_DFQ = 7248, C_DFK = 8272, C_DFV = 9296;
constexpr int FFN = 5632;
constexpr int NTHR_ = 512;
constexpr int KVAW = 768;

constexpr size_t MiB = 1u << 20;
constexpr size_t WS_CTL = 0, CTL_BYTES = 64 * 1024;
constexpr size_t WS_MOD = 1 * MiB;
constexpr size_t WS_ROPE = WS_MOD + 512 * 1024;
constexpr size_t WS_X = 2 * MiB;
constexpr size_t WS_H = 162 * MiB;
constexpr size_t WS_HF = 242 * MiB;
constexpr size_t WS_HB = 282 * MiB;
constexpr size_t WS_MLQ = 322 * MiB;
constexpr size_t WS_S5U = 362 * MiB;
constexpr size_t WS_DFQ = 402 * MiB;
constexpr size_t WS_MLK = 442 * MiB;
constexpr size_t WS_MLV = 482 * MiB;
constexpr size_t WS_MLO = 522 * MiB;
constexpr size_t WS_MQ = 562 * MiB;
constexpr size_t WS_KVA = 622 * MiB;
constexpr size_t WS_DFK = 682 * MiB;
constexpr size_t WS_DFV = 724 * MiB;
constexpr size_t WS_CKVN = 766 * MiB;
constexpr size_t WS_KFULL = 787 * MiB;
constexpr size_t WS_VFULL = 850 * MiB;
constexpr size_t WS_GATES = 892 * MiB;
constexpr size_t WS_CT = 894 * MiB;
constexpr size_t WS_WBF = 934 * MiB;
constexpr size_t WS_GS = 442 * MiB;
constexpr size_t WS_FFNH = 442 * MiB;
constexpr size_t WS_DFO = 442 * MiB;
constexpr size_t WS_YS5F = 442 * MiB;
constexpr size_t WS_YS5B = 482 * MiB;
constexpr size_t WS_END = 1101 * MiB;

constexpr size_t O_YP = 0, O_YS = 8388608, O_CKV = 41943040, O_KR = 46137344, O_DK = 46661632, O_DV = 55050240,
                 O_MC = 63438848, O_MN = 80216064, O_MM = 80281600, O_SR = 80281856, O_SI = 80544000, O_END = 80806144;

__device__ __forceinline__ unsigned f2bf(float f) { unsigned u = __builtin_bit_cast(unsigned, f); return (u + 0x7fffu + ((u >> 16) & 1u)) >> 16; }
__device__ __forceinline__ float bf2f(unsigned b) { return __builtin_bit_cast(float, (b & 0xffffu) << 16); }
__device__ __forceinline__ unsigned pk2(float lo, float hi) { return f2bf(lo) | (f2bf(hi) << 16); }
__device__ __forceinline__ float wave_sum(float v) {
#pragma unroll
    for (int o = 1; o < 64; o <<= 1) v += __shfl_xor(v, o);
    return v;
}
__device__ __forceinline__ float wave_max(float v) {
#pragma unroll
    for (int o = 1; o < 64; o <<= 1) v = fmaxf(v, __shfl_xor(v, o));
    return v;
}
__device__ __forceinline__ float sigmoidf_(float x) { return __builtin_amdgcn_rcpf(1.0f + __expf(-x)); }
__device__ __forceinline__ float siluf_(float x) { return x * __builtin_amdgcn_rcpf(1.0f + __expf(-x)); }
__device__ __forceinline__ float gelu_tanh(float x) { const float u = 0.7978845608028654f * (x + 0.044715f * x * x * x); const float t = 1.0f - 2.0f * __builtin_amdgcn_rcpf(1.0f + __expf(2.0f * u)); return 0.5f * x * (1.0f + t); }
__device__ __forceinline__ void sincos_small(float x, float& s, float& c) {
    const float k = rintf(x * 0.6366197723675814f);
    float r = fmaf(-k, 1.5707962513e+0f, x); r = fmaf(-k, 7.5497894159e-8f, r); r = fmaf(-k, 5.3903029534e-15f, r);
    const float r2 = r * r;
    const float sp = r + r * r2 * (-1.6666654611e-1f + r2 * (8.3321608736e-3f + r2 * (-1.9515295891e-4f)));
    const float cp = 1.0f - 0.5f * r2 + r2 * r2 * (4.166664568298827e-2f + r2 * (-1.388731625493765e-3f + r2 * 2.443315711809948e-5f));
    const int q = ((int)k) & 3;
    s = (q == 0) ? sp : (q == 1) ? cp : (q == 2) ? -sp : -cp;
    c = (q == 0) ? cp : (q == 1) ? -sp : (q == 2) ? -cp : sp;
}
__device__ __forceinline__ int cond_of_row(int r) { return r < NCTX ? 0 : 1 + ((r - NCTX) >> 12); }

struct P {
    const float* in[38];
    float* out;
    unsigned char* ws;
};
__device__ __forceinline__ const float* x_in(const P& p, int r) { return r < NCTX ? p.in[0] + (size_t)r * D : p.in[1] + (size_t)(r - NCTX) * D; }


#define XB_TMO      128
#define XB_XCNT(j)  (256  + 64 * (j))
#define XB_XSUB(j)  (1280 + 64 * (j))
#define XB_XGEN(j)  (2304 + 64 * (j))
#define XB_TOP      3328
#define XB_TOPGEN   3392
#define XCD_BAR_WORDS 3456
#define XB_SPIN_CAP (1u << 22)
#define LAS __attribute__((address_space(3)))

__device__ __forceinline__ unsigned xb_ld(unsigned* p)              { return __hip_atomic_load(p, __ATOMIC_RELAXED, __HIP_MEMORY_SCOPE_AGENT); }
__device__ __forceinline__ unsigned xb_add(unsigned* p, unsigned v) { return __hip_atomic_fetch_add(p, v, __ATOMIC_RELAXED, __HIP_MEMORY_SCOPE_AGENT); }
__device__ __forceinline__ unsigned xb_xcc_id() { return (unsigned)__builtin_amdgcn_s_getreg((3 << 11) | 20) & 0xFu; }
#define XB_SPIN(cond, bar) do { unsigned _sp = 0; while (cond) { __builtin_amdgcn_s_sleep(1); \
    if ((++_sp & 255u) == 0u) { if (xb_ld(&(bar)[XB_TMO])) break; if (_sp > XB_SPIN_CAP) { atomicAdd(&(bar)[XB_TMO], 1u); break; } } } } while (0)

__device__ __forceinline__ unsigned lane_id_() { unsigned l_; asm volatile("v_mbcnt_lo_u32_b32 %0, -1, 0\n\tv_mbcnt_hi_u32_b32 %0, -1, %0" : "=v"(l_)); return l_; }
struct XcdBarrier {
    unsigned* bar; unsigned x; unsigned w;
    volatile LAS unsigned* st;
};
__device__ __forceinline__ XcdBarrier xcd_barrier_post(unsigned* bar, volatile LAS unsigned* st) {
    XcdBarrier b; b.bar = bar; b.x = xb_xcc_id(); b.st = st; b.w = (unsigned)__builtin_amdgcn_readfirstlane(threadIdx.x >> 6);
    if (threadIdx.x == 0) (void)xb_add(&bar[XB_XCNT(b.x)], 1u);
    return b;
}
__device__ __forceinline__ void xcd_barrier_complete(unsigned* bar, unsigned x, unsigned& nloc, unsigned& nx) {
    const unsigned G = gridDim.x * gridDim.y * gridDim.z;
    unsigned sum, cnt, mine, sp = 0u;
    for (;;) {
        sum = 0u; cnt = 0u; mine = 0u;
#pragma unroll
        for (unsigned j = 0; j < 16; ++j) { const unsigned c = xb_ld(&bar[XB_XCNT(j)]); sum += c; cnt += (c > 0u) ? 1u : 0u; mine = (j == x) ? c : mine; }
        if (sum == G) break;
        __builtin_amdgcn_s_sleep(1);
        if ((++sp & 255u) == 0u) { if (xb_ld(&bar[XB_TMO])) break; if (sp > XB_SPIN_CAP) { atomicAdd(&bar[XB_TMO], 1u); break; } }
    }
    nloc = mine > 0u ? mine : 1u; nx = cnt > 0u ? cnt : 1u;
}
__device__ __forceinline__ void xcd_barrier(const XcdBarrier& b) {
    asm volatile("s_waitcnt vmcnt(0)" ::: "memory");
    __syncthreads();
    if (b.w == 0u && lane_id_() == 0u) {
        unsigned* bar = b.bar;
        __builtin_amdgcn_s_waitcnt(0);
        unsigned nloc = b.st[0], nx = b.st[1];
        if (nloc == 0u) { xcd_barrier_complete(bar, b.x, nloc, nx); b.st[0] = nloc; b.st[1] = nx; }
        const unsigned old = xb_add(&bar[XB_XSUB(b.x)], 1u);
        const unsigned gen = old / nloc;
        if (old + 1u == (gen + 1u) * nloc) {
            __builtin_amdgcn_fence(__ATOMIC_RELEASE, "agent");
            asm volatile("s_waitcnt vmcnt(0)" ::: "memory");
            const unsigned og = xb_add(&bar[XB_TOP], 1u);
            const unsigned tg = og / nx;
            if (og + 1u == (tg + 1u) * nx) xb_add(&bar[XB_TOPGEN], 1u);
            else XB_SPIN(xb_ld(&bar[XB_TOPGEN]) == tg, bar);
            __builtin_amdgcn_fence(__ATOMIC_ACQUIRE, "agent");
            xb_add(&bar[XB_XGEN(b.x)], 1u);
            asm volatile("s_waitcnt vmcnt(0)" ::: "memory");
        } else {
            XB_SPIN(xb_ld(&bar[XB_XGEN(b.x)]) == gen, bar);
            __builtin_amdgcn_fence(__ATOMIC_ACQUIRE, "agent");
            asm volatile("s_waitcnt vmcnt(0)" ::: "memory");
        }
    }
    __syncthreads();
}


constexpr int MOD_KS = 16, MOD_KC = 2048 / MOD_KS;
constexpr size_t WS_MODP = WS_X;
__device__ __forceinline__ void ph_mod_partial(const P& p, int tid, float* sc) {
    for (int i = tid; i < 5 * 2048; i += NTHR_) { const int c = i >> 11, k = i & 2047; const float v = c == 0 ? p.in[12][k] : p.in[11][(c - 1) * 2048 + k]; sc[i] = siluf_(v); }
    __syncthreads();
    const int NU = 2 * 3072 * MOD_KS;
    for (int u = blockIdx.x * NTHR_ + tid; u < NU; u += gridDim.x * NTHR_) {
        const int cg = u % 3072, kc = (u / 3072) % MOD_KS, l = u / (3072 * MOD_KS);
        const float* w = p.in[13] + ((size_t)l * 2048 + kc * MOD_KC) * 12288 + cg * 4;
        f32x4 a0 = {0.f, 0.f, 0.f, 0.f}, a1 = a0, a2 = a0, a3 = a0, a4 = a0;
#pragma unroll 8
        for (int k = 0; k < MOD_KC; ++k) { const f32x4 wv = *(const f32x4*)(w + (size_t)k * 12288); const int kk = kc * MOD_KC + k;
            a0 += wv * sc[kk]; a1 += wv * sc[2048 + kk]; a2 += wv * sc[4096 + kk]; a3 += wv * sc[6144 + kk]; a4 += wv * sc[8192 + kk]; }
        float* o = (float*)(p.ws + WS_MODP) + ((size_t)(kc * 2 + l) * 5) * 12288 + cg * 4;
        *(f32x4*)o = a0; *(f32x4*)(o + 12288) = a1; *(f32x4*)(o + 2 * 12288) = a2; *(f32x4*)(o + 3 * 12288) = a3; *(f32x4*)(o + 4 * 12288) = a4;
    }
    if (blockIdx.x == 0) {
        float* rt = (float*)(p.ws + WS_ROPE);
        for (int i = tid; i < 1024; i += NTHR_) { const int pos = i >> 4, j = i & 15; const float inv = exp2f(-(float)j * (13.287712379549449f / 16.0f)); float s_, c_; sincos_small((float)pos * inv, s_, c_); rt[i] = c_; rt[1024 + i] = s_; }
    }
}
__device__ __forceinline__ void ph_mod_reduce(const P& p, int tid) {
    for (int i = blockIdx.x * NTHR_ + tid; i < 2 * 5 * 12288; i += gridDim.x * NTHR_) {
        const int n = i % 12288, l = (i / 12288) / 5; float acc = p.in[14][l * 12288 + n];
#pragma unroll
        for (int kc = 0; kc < MOD_KS; ++kc) acc += ((const float*)(p.ws + WS_MODP))[(size_t)kc * 2 * 5 * 12288 + i];
        ((float*)(p.ws + WS_MOD))[i] = acc;
    }
}

__device__ __forceinline__ void ph_hnorm_row(const P& p, int l, int which, int r, int lane) {
    const bool from_in = (which == 0 && l == 0);
    const float* x = x_in(p, r); const bf16_t* xb = (const bf16_t*)(p.ws + WS_X) + (size_t)r * D;
    const float* nw = p.in[which == 0 ? 15 : 16] + l * 2048;
    const float* mod = (const float*)(p.ws + WS_MOD) + ((size_t)l * 5 + cond_of_row(r)) * 12288 + (which == 0 ? 0 : 3 * 2048);
    f32x4 v[8]; float ss = 0.f;
#pragma unroll
    for (int j = 0; j < 8; ++j) {
        if (from_in) v[j] = *(const f32x4*)(x + j * 256 + lane * 4);
        else { const u32x2 w = *(const u32x2*)(xb + j * 256 + lane * 4); v[j] = (f32x4){bf2f(w.x), bf2f(w.x >> 16), bf2f(w.y), bf2f(w.y >> 16)}; }
        ss += v[j][0] * v[j][0] + v[j][1] * v[j][1] + v[j][2] * v[j][2] + v[j][3] * v[j][3]; }
    const float rstd = rsqrtf(wave_sum(ss) * (1.0f / 2048.0f) + 1e-6f);
    bf16_t* o = (bf16_t*)(p.ws + WS_H) + (size_t)r * D;
#pragma unroll
    for (int j = 0; j < 8; ++j) { const int c = j * 256 + lane * 4; const f32x4 g = *(const f32x4*)(nw + c), sh = *(const f32x4*)(mod + c), s1 = *(const f32x4*)(mod + 2048 + c);
        float y[4];
#pragma unroll
        for (int e = 0; e < 4; ++e) y[e] = v[j][e] * rstd * g[e] * (1.0f + s1[e]) + sh[e];
        u32x2 w; w.x = pk2(y[0], y[1]); w.y = pk2(y[2], y[3]); *(u32x2*)(o + c) = w; }
}

namespace pg8 {
#define PG8_LAS __attribute__((address_space(3)))
typedef unsigned short bf16_t;
typedef short bf16x8 __attribute__((ext_vector_type(8)));
typedef float f32x4 __attribute__((ext_vector_type(4)));
typedef unsigned u32x4 __attribute__((ext_vector_type(4)));
constexpr int BM = 256, BK = 64, HALF = 128, HTB = HALF * BK * 2  , STAGE_BYTES = 8 * HTB, NXCD = 8, WGM = 8;

__host__ __device__ __forceinline__ int lds_byte(int r, int c) { const int st = (r >> 4) * 2 + (c >> 5), rr = r & 15, cc = c & 31, ob = rr * 64 + cc * 2; return st * 1024 + (ob ^ (((ob >> 9) & 1) << 5)); }
__host__ __device__ __forceinline__ void stage_rc(int b, int& R, int& C) { const int st = b / 1024, sb = b % 1024, swz = sb ^ (((sb >> 9) & 1) << 5); R = (st >> 1) * 16 + swz / 64; C = (st & 1) * 32 + (swz % 64) / 2; }
__host__ __device__ __forceinline__ int perm32(int rho) { const int n = rho >> 4, i = rho & 15; return 8 * (i >> 2) + 4 * n + (i & 3); }

struct Unit { int pm, pn; };
struct Gemm { const bf16_t* A; const bf16_t* Bt; int M, N, K; };

struct StaticOrder {
    int nM, nN, nwg, G, c;
    __host__ __device__ void init(int M, int N, int G_, int c_) { nM = M / BM; nN = N / BM; nwg = nM * nN; G = G_; c = c_; }
    __host__ __device__ bool next(int i, Unit& u) const {
        const long L = (long)i * G + c; if (L >= nwg) return false;
        int wgid = (int)L; { const int q = nwg / NXCD, r = nwg % NXCD, xcd = wgid % NXCD, off = wgid / NXCD; wgid = (xcd < r ? xcd * (q + 1) : r * (q + 1) + (xcd - r) * q) + off; }
        const int nig = WGM * nN, gid = wgid / nig, fm = gid * WGM, gsz = (nM - fm) < WGM ? (nM - fm) : WGM;
        u.pm = fm + ((wgid % nig) % gsz); u.pn = (wgid % nig) / gsz; return true;
    }
    __device__ __forceinline__ void a_ready(const Unit&) const {}
    __device__ __forceinline__ void done(const Unit&) const {}
};

__device__ __forceinline__ unsigned cvt_pk_bf16(float lo, float hi) { unsigned r; asm volatile("s_nop 0\n\tv_cvt_pk_bf16_f32 %0, %1, %2" : "=v"(r) : "v"(lo), "v"(hi)); return r; }

template <class Epi, class Sched, bool ALIGN_EPI = false, bool SP2 = false>
__device__ __forceinline__ void gemm_phase(PG8_LAS unsigned char* lds, const Gemm g, const Sched& S, const Epi& E, int tid_in) {
    int tid_l = tid_in; asm volatile("" : "+v"(tid_l));
    const int tid = tid_l, wid = __builtin_amdgcn_readfirstlane(tid >> 6), lane = tid & 63, wr = wid >> 2, wc = wid & 3, fr = lane & 15, fq = lane >> 4;
    const int K = g.K, nt = K / BK;
    unsigned voffA[2], voffB[2];
#pragma unroll
    for (int i = 0; i < 2; ++i) { int R, C; stage_rc(tid * 16 + i * 8192, R, C); const int Rb = Epi::PERM ? ((R & ~31) + perm32(R & 31)) : R;
        voffA[i] = (unsigned)(R * K + C) * 2u; voffB[i] = (unsigned)(Rb * K + C) * 2u; }
    const size_t kstep = (size_t)(BK * 2);
    const size_t hstep = (size_t)HALF * K * 2;
    const size_t tstep = 2 * hstep;
    const unsigned ldsw = (unsigned)wid * 1024u;
    const int aoff = lds_byte(wr * 64 + fr, fq * 8), boff = lds_byte(wc * 32 + fr, fq * 8);
#define PG8_SA(b, h) (((b) * 2 + (h)) * HTB)
#define PG8_SB(b, h) ((4 + (b) * 2 + (h)) * HTB)
#define PG8_STAGE(bufoff, gbase, voff) do { _Pragma("unroll") for (int _i = 0; _i < 2; ++_i) \
        __builtin_amdgcn_global_load_lds((const unsigned*)((const char*)(gbase) + (voff)[_i]), (PG8_LAS unsigned*)(lds + (bufoff) + ldsw + _i * 8192), 16, 0, 0); } while (0)
#define PG8_LDA(dst, b, h) do { _Pragma("unroll") for (int m = 0; m < 4; ++m) _Pragma("unroll") for (int k = 0; k < 2; ++k) dst[m][k] = *(const PG8_LAS bf16x8*)(lds + PG8_SA(b, h) + aoff + m * 2048 + k * 1024); } while (0)
#define PG8_LDB(dst, b, h) do { _Pragma("unroll") for (int n = 0; n < 2; ++n) _Pragma("unroll") for (int k = 0; k < 2; ++k) dst[n][k] = *(const PG8_LAS bf16x8*)(lds + PG8_SB(b, h) + boff + n * 2048 + k * 1024); } while (0)
#define PG8_MMA(ai, bj, At, Bt) do { __builtin_amdgcn_s_setprio(1); _Pragma("unroll") for (int m = 0; m < 4; ++m) _Pragma("unroll") for (int n = 0; n < 2; ++n) _Pragma("unroll") for (int k = 0; k < 2; ++k) \
        acc[ai][bj][m][n] = __builtin_amdgcn_mfma_f32_16x16x32_bf16(Bt[n][k], At[m][k], acc[ai][bj][m][n], 0, 0, 0); __builtin_amdgcn_s_setprio(0); } while (0)
#define PG8_WAIT_V(n) asm volatile("s_waitcnt vmcnt(" #n ")" ::: "memory")
#define PG8_WAIT_L(n) asm volatile("s_waitcnt lgkmcnt(" #n ")" ::: "memory")
#define PG8_BAR __builtin_amdgcn_s_barrier()
#define PG8_SCHED __builtin_amdgcn_sched_barrier(0)
    Unit cur, nxt; int ui = 0;
    if (!S.next(0, cur)) return;
    f32x4 acc[2][2][4][2];
    { float z0 = 0.f; asm volatile("" : "+v"(z0));
#pragma unroll
    for (int a = 0; a < 2; ++a)
#pragma unroll
        for (int b = 0; b < 2; ++b)
#pragma unroll
            for (int m = 0; m < 4; ++m)
#pragma unroll
                for (int n = 0; n < 2; ++n) acc[a][b][m][n] = (f32x4){z0, z0, z0, z0}; }
    bf16x8 At[4][2], B0[2][2], B1[2][2];
    const char* cA = (const char*)g.A + (size_t)cur.pm * tstep; const char* cB = (const char*)g.Bt + (size_t)cur.pn * tstep;
    S.a_ready(cur);
    if constexpr (SP2) {
        PG8_STAGE(PG8_SB(0, 0), cB, voffB); PG8_STAGE(PG8_SB(0, 1), cB + hstep, voffB); PG8_STAGE(PG8_SA(0, 0), cA, voffA); PG8_STAGE(PG8_SA(0, 1), cA + hstep, voffA);
        if (wr == 1) PG8_BAR;
        PG8_WAIT_V(2); PG8_BAR;
        PG8_STAGE(PG8_SB(1, 0), cB + kstep, voffB); PG8_STAGE(PG8_SA(1, 0), cA + kstep, voffA); PG8_STAGE(PG8_SB(1, 1), cB + hstep + kstep, voffB);
        PG8_WAIT_V(6); PG8_BAR;
    } else {
        PG8_STAGE(PG8_SB(0, 0), cB, voffB); PG8_STAGE(PG8_SA(0, 0), cA, voffA); PG8_STAGE(PG8_SB(0, 1), cB + hstep, voffB); PG8_STAGE(PG8_SA(0, 1), cA + hstep, voffA);
        if (wr == 1) PG8_BAR;
        PG8_WAIT_V(4); PG8_BAR;
        PG8_STAGE(PG8_SB(1, 0), cB + kstep, voffB); PG8_STAGE(PG8_SA(1, 0), cA + kstep, voffA); PG8_STAGE(PG8_SB(1, 1), cB + hstep + kstep, voffB);
        PG8_WAIT_V(6); PG8_BAR;
    }
    for (;;) {
        const bool has_next = S.next(ui + 1, nxt);
        const char* nA = has_next ? (const char*)g.A + (size_t)nxt.pm * tstep : cA; const char* nB = has_next ? (const char*)g.Bt + (size_t)nxt.pn * tstep : cB;
        for (int t = 0; t < nt; t += 2) {
            const bool last = (t == nt - 2);
            const char* a1 = cA + (size_t)(t + 1) * kstep;
            const char* a2 = last ? nA : cA + (size_t)(t + 2) * kstep; const char* b2 = last ? nB : cB + (size_t)(t + 2) * kstep;
            const char* a3 = a2 + kstep; const char* b3 = b2 + kstep;
            if (last && has_next) S.a_ready(nxt);
            if constexpr (SP2) {
            PG8_LDB(B0, 0, 0); PG8_LDB(B1, 0, 1); PG8_SCHED; PG8_LDA(At, 0, 0); PG8_STAGE(PG8_SA(1, 1), a1 + hstep, voffA);
            PG8_WAIT_V(8); PG8_WAIT_L(0); PG8_BAR; PG8_MMA(0, 0, At, B0); PG8_MMA(0, 1, At, B1); PG8_BAR; PG8_SCHED;
            PG8_LDA(At, 0, 1); PG8_STAGE(PG8_SB(0, 0), b2, voffB); PG8_STAGE(PG8_SB(0, 1), b2 + hstep, voffB); PG8_STAGE(PG8_SA(0, 0), a2, voffA);
            PG8_WAIT_V(8); PG8_WAIT_L(0); PG8_BAR; PG8_MMA(1, 0, At, B0); PG8_MMA(1, 1, At, B1); PG8_BAR; PG8_SCHED;
            PG8_LDB(B0, 1, 0); PG8_LDB(B1, 1, 1); PG8_SCHED; PG8_LDA(At, 1, 0); PG8_STAGE(PG8_SA(0, 1), a2 + hstep, voffA);
            PG8_WAIT_V(8); PG8_WAIT_L(0); PG8_BAR; PG8_MMA(0, 0, At, B0); PG8_MMA(0, 1, At, B1); PG8_BAR; PG8_SCHED;
            PG8_LDA(At, 1, 1); PG8_STAGE(PG8_SB(1, 0), b3, voffB); PG8_STAGE(PG8_SB(1, 1), b3 + hstep, voffB); PG8_STAGE(PG8_SA(1, 0), a3, voffA);
            PG8_WAIT_V(8); PG8_WAIT_L(0); PG8_BAR; PG8_MMA(1, 0, At, B0); PG8_MMA(1, 1, At, B1); PG8_BAR; PG8_SCHED;
            } else {
            PG8_LDB(B0, 0, 0); PG8_SCHED; PG8_LDA(At, 0, 0); PG8_STAGE(PG8_SA(1, 1), a1 + hstep, voffA);
            PG8_WAIT_L(8); PG8_BAR; PG8_WAIT_L(0); PG8_MMA(0, 0, At, B0); PG8_BAR; PG8_SCHED;
            PG8_LDB(B1, 0, 1); PG8_STAGE(PG8_SB(0, 0), b2, voffB);
            PG8_BAR; PG8_WAIT_L(0); PG8_MMA(0, 1, At, B1); PG8_BAR;
            PG8_LDA(At, 0, 1); PG8_STAGE(PG8_SA(0, 0), a2, voffA);
            PG8_BAR; PG8_WAIT_L(0); PG8_MMA(1, 0, At, B0); PG8_BAR; PG8_SCHED;
            PG8_STAGE(PG8_SB(0, 1), b2 + hstep, voffB);
            PG8_WAIT_V(6); PG8_BAR; PG8_MMA(1, 1, At, B1); PG8_BAR;
            PG8_LDB(B0, 1, 0); PG8_SCHED; PG8_LDA(At, 1, 0); PG8_STAGE(PG8_SA(0, 1), a2 + hstep, voffA);
            PG8_WAIT_L(8); PG8_BAR; PG8_WAIT_L(0); PG8_MMA(0, 0, At, B0); PG8_BAR; PG8_SCHED;
            PG8_LDB(B1, 1, 1); PG8_STAGE(PG8_SB(1, 0), b3, voffB);
            PG8_BAR; PG8_WAIT_L(0); PG8_MMA(0, 1, At, B1); PG8_BAR;
            PG8_LDA(At, 1, 1); PG8_STAGE(PG8_SA(1, 0), a3, voffA);
            PG8_BAR; PG8_WAIT_L(0); PG8_MMA(1, 0, At, B0); PG8_BAR; PG8_SCHED;
            PG8_STAGE(PG8_SB(1, 1), b3 + hstep, voffB);
            PG8_WAIT_V(6); PG8_BAR; PG8_MMA(1, 1, At, B1); PG8_BAR;
            }
        }
        if constexpr (ALIGN_EPI) { if (wr == 0) PG8_BAR; }
        if constexpr (!Epi::AFTER_DRAIN) { E(acc, cur, wr, wc, fr, fq); S.done(cur); }
        if (!has_next) break;
        { float z0 = 0.f; asm volatile("" : "+v"(z0));
#pragma unroll
        for (int a = 0; a < 2; ++a)
#pragma unroll
            for (int b = 0; b < 2; ++b)
#pragma unroll
                for (int m = 0; m < 4; ++m)
#pragma unroll
                    for (int n = 0; n < 2; ++n) acc[a][b][m][n] = (f32x4){z0, z0, z0, z0}; }
        cur = nxt; cA = nA; cB = nB; ++ui;
        if constexpr (ALIGN_EPI) { if (wr == 1) PG8_BAR; }
    }
    PG8_WAIT_V(0);
    if constexpr (!ALIGN_EPI) { if (wr == 0) PG8_BAR; }
    PG8_BAR;
    if constexpr (Epi::AFTER_DRAIN) { E.fused(acc, cur, wr, wc, fr, fq, lds, wid, lane); S.done(cur); }
#undef PG8_SA
#undef PG8_SB
#undef PG8_STAGE
#undef PG8_LDA
#undef PG8_LDB
#undef PG8_MMA
#undef PG8_WAIT_V
#undef PG8_WAIT_L
#undef PG8_BAR
#undef PG8_SCHED
}
}

#define PG8_ROW(ai, m) (u.pm * 256 + (ai) * 128 + wr * 64 + (m) * 16 + fr)
#define PG8_FOR(...) _Pragma("unroll") for (int ai = 0; ai < 2; ++ai) _Pragma("unroll") for (int m = 0; m < 4; ++m) { const int row = PG8_ROW(ai, m); _Pragma("unroll") for (int bj = 0; bj < 2; ++bj) { \
    const int ct = bj * 128 + wc * 32 + 8 * fq; const pg8::f32x4 v0 = acc[ai][bj][m][0], v1 = acc[ai][bj][m][1]; __VA_ARGS__ } }
__device__ __forceinline__ u32x4 pack8(const pg8::f32x4& a, const pg8::f32x4& b) { u32x4 w; w.x = pg8::cvt_pk_bf16(a[0], a[1]); w.y = pg8::cvt_pk_bf16(a[2], a[3]); w.z = pg8::cvt_pk_bf16(b[0], b[1]); w.w = pg8::cvt_pk_bf16(b[2], b[3]); return w; }
__device__ __forceinline__ void unpack8(const u32x4& w, float (&f)[8]) {
#pragma unroll
    for (int i = 0; i < 4; ++i) { f[2 * i] = bf2f(w[i]); f[2 * i + 1] = bf2f(w[i] >> 16); } }

struct Epi8In {
    static constexpr bool PERM = true, AFTER_DRAIN = false;
    unsigned char* ws;
    __device__ __forceinline__ void operator()(const pg8::f32x4 (&acc)[2][2][4][2], const pg8::Unit& u, int wr, int wc, int fr, int fq) const {
        const int pn = u.pn;
        if (pn >= 22 && pn < 25) {
            float* kva = (float*)(ws + WS_KVA);
            PG8_FOR({ float* o = kva + (size_t)row * KVAW + (pn - 22) * 256 + ct; *(pg8::f32x4*)o = v0; *(pg8::f32x4*)(o + 4) = v1; })
            return;
        }
        size_t base; int ldc, c0, mode = 0;
        if (pn < 4) { base = WS_MLQ; ldc = 1024; c0 = pn * 256; }
        else if (pn < 8) { base = WS_MLK; ldc = 1024; c0 = (pn - 4) * 256; mode = 1; }
        else if (pn < 12) { base = WS_MLV; ldc = 1024; c0 = (pn - 8) * 256; }
        else if (pn < 16) { base = WS_MLO; ldc = 1024; c0 = (pn - 12) * 256; mode = 2; }
        else if (pn < 22) { base = WS_MQ; ldc = 1536; c0 = (pn - 16) * 256; mode = 3; }
        else if (pn < 29) { base = WS_S5U; ldc = 1024; c0 = (pn - 25) * 256; }
        else if (pn < 33) { base = WS_DFQ; ldc = 1024; c0 = (pn - 29) * 256; mode = 4; }
        else if (pn < 37) { base = WS_DFK; ldc = 1024; c0 = (pn - 33) * 256; }
        else { base = WS_DFV; ldc = 1024; c0 = (pn - 37) * 256; }
        bf16_t* O = (bf16_t*)(ws + base);
        PG8_FOR({ pg8::f32x4 a = v0, b = v1;
            if (mode == 1) { a = a * 0.0625f; b = b * 0.0625f; }
            if (mode == 3) { a = a * (0.07216878364870322f * 1.4426950408889634f); b = b * (0.07216878364870322f * 1.4426950408889634f); }
            if (mode == 4) { a = a * (0.125f * 1.4426950408889634f); b = b * (0.125f * 1.4426950408889634f); }
            if (mode == 2) {
_Pragma("unroll")
                for (int e = 0; e < 4; ++e) { a[e] = sigmoidf_(a[e]); b[e] = sigmoidf_(b[e]); } }
            *(u32x4*)(O + (size_t)row * ldc + c0 + ct) = pack8(a, b); })
    }
};
struct Epi8Gate {
    static constexpr bool PERM = true, AFTER_DRAIN = false;
    bf16_t* gs;
    __device__ __forceinline__ void operator()(const pg8::f32x4 (&acc)[2][2][4][2], const pg8::Unit& u, int wr, int wc, int fr, int fq) const {
        PG8_FOR({ pg8::f32x4 a, b;
_Pragma("unroll")
            for (int e = 0; e < 4; ++e) { a[e] = sigmoidf_(v0[e]); b[e] = sigmoidf_(v1[e]); }
            *(u32x4*)(gs + (size_t)row * GATE_COLS + u.pn * 256 + ct) = pack8(a, b); })
    }
};
struct Epi8Kvb {
    static constexpr bool PERM = true, AFTER_DRAIN = false;
    bf16_t* kf; bf16_t* vf;
    __device__ __forceinline__ void operator()(const pg8::f32x4 (&acc)[2][2][4][2], const pg8::Unit& u, int wr, int wc, int fr, int fq) const {
        PG8_FOR({ bf16_t* o = bj == 0 ? kf + (size_t)row * 1536 + u.pn * 192 + wc * 32 + 8 * fq : vf + (size_t)row * 1024 + u.pn * 128 + wc * 32 + 8 * fq; (void)ct;
            *(u32x4*)o = pack8(v0, v1); })
    }
};
struct Epi8Glu {
    static constexpr bool PERM = true, AFTER_DRAIN = false;
    const bf16_t* g; bf16_t* y;
    __device__ __forceinline__ void operator()(const pg8::f32x4 (&acc)[2][2][4][2], const pg8::Unit& u, int wr, int wc, int fr, int fq) const {
        PG8_FOR({ const size_t i = (size_t)row * 1024 + u.pn * 256 + ct; float gf[8]; unpack8(*(const u32x4*)(g + i), gf); pg8::f32x4 a, b;
_Pragma("unroll")
            for (int e = 0; e < 4; ++e) { a[e] = gf[e] * sigmoidf_(v0[e]); b[e] = gf[4 + e] * sigmoidf_(v1[e]); }
            *(u32x4*)(y + i) = pack8(a, b); })
    }
};
struct Epi8Merge {
    static constexpr bool PERM = true, AFTER_DRAIN = false;
    const bf16_t* gs; bf16_t* mg; int b; int pad;
    __device__ __forceinline__ void operator()(const pg8::f32x4 (&acc)[2][2][4][2], const pg8::Unit& u, int wr, int wc, int fr, int fq) const {
        PG8_FOR({ const size_t i = (size_t)row * D + u.pn * 256 + ct; float gf[8], pf[8]; unpack8(*(const u32x4*)(gs + (size_t)row * GATE_COLS + b * D + u.pn * 256 + ct), gf);
            if (b) unpack8(*(const u32x4*)(mg + i), pf); else {
_Pragma("unroll")
                for (int e = 0; e < 8; ++e) pf[e] = 0.f; }
            pg8::f32x4 a, c;
_Pragma("unroll")
            for (int e = 0; e < 4; ++e) { a[e] = pf[e] + gf[e] * v0[e]; c[e] = pf[4 + e] + gf[4 + e] * v1[e]; }
            *(u32x4*)(mg + i) = pack8(a, c); })
    }
};
struct Epi8Res {
    static constexpr bool PERM = true, AFTER_DRAIN = false;
    P p; int l; int goff; int from_x; int pad;
    __device__ __forceinline__ void operator()(const pg8::f32x4 (&acc)[2][2][4][2], const pg8::Unit& u, int wr, int wc, int fr, int fq) const {
        bf16_t* X = (bf16_t*)(p.ws + WS_X);
        const float* gv = (const float*)(p.ws + WS_MOD) + ((size_t)l * 5 + cond_of_row(u.pm * 256)) * 12288 + goff + u.pn * 256;
        const bool from_in = (!from_x && l == 0);
        PG8_FOR({ bf16_t* dst = X + (size_t)row * D + u.pn * 256 + ct;
            const pg8::f32x4 g0 = *(const pg8::f32x4*)(gv + ct), g1 = *(const pg8::f32x4*)(gv + ct + 4); pg8::f32x4 s0, s1;
            if (from_in) { const float* src = x_in(p, row) + u.pn * 256 + ct; s0 = *(const pg8::f32x4*)src; s1 = *(const pg8::f32x4*)(src + 4); }
            else { float sf[8]; unpack8(*(const u32x4*)dst, sf); s0 = (pg8::f32x4){sf[0], sf[1], sf[2], sf[3]}; s1 = (pg8::f32x4){sf[4], sf[5], sf[6], sf[7]}; }
            *(u32x4*)dst = pack8(s0 + g0 * v0, s1 + g1 * v1); })
    }
};
struct Epi8FfnIn {
    static constexpr bool PERM = true, AFTER_DRAIN = false;
    bf16_t* hh;
    __device__ __forceinline__ void operator()(const pg8::f32x4 (&acc)[2][2][4][2], const pg8::Unit& u, int wr, int wc, int fr, int fq) const {
_Pragma("unroll")
        for (int ai = 0; ai < 2; ++ai)
_Pragma("unroll")
            for (int m = 0; m < 4; ++m) { const int row = PG8_ROW(ai, m); pg8::f32x4 a, b;
_Pragma("unroll")
                for (int e = 0; e < 4; ++e) { a[e] = siluf_(acc[ai][0][m][0][e]) * acc[ai][1][m][0][e]; b[e] = siluf_(acc[ai][0][m][1][e]) * acc[ai][1][m][1][e]; }
                *(u32x4*)(hh + (size_t)row * FFN + u.pn * 128 + wc * 32 + 8 * fq) = pack8(a, b); }
    }
};

__device__ __forceinline__ int win_row(int n) {
    if (n < 4096) return n;
    if (n < 4112) return 6208 + (n - 4096);
    if (n < 5648) return 4096 + (n - 4112);
    if (n < 6224) return 5632 + (n - 5648);
    if (n < MIX_COLS) return 6400 + (n - 6224);
    return 10496 + (n - MIX_COLS);
}
template <int MAP>
__device__ __forceinline__ void cvt_item(const float* W, int K, int N, bf16_t* WT, int row_off, LAS float* scr, int item, int lane) {
    const int nblk = (N + 31) / 32, kb = item / nblk, nb = item % nblk, k0 = 64 * kb, n0 = 32 * nb;
    const int nl = (lane & 7) * 4, kr = lane >> 3;
    const bool nok = n0 + nl < N;
    const float* wp = W + (size_t)(k0 + kr) * N + n0 + nl;
    f32x4 v[8];
#pragma unroll
    for (int i = 0; i < 8; ++i) v[i] = nok ? *(const f32x4*)(wp + (size_t)(8 * i) * N) : (f32x4){0.f, 0.f, 0.f, 0.f};
#pragma unroll
    for (int i = 0; i < 8; ++i) { LAS float* d = scr + (kr + 8 * i) * 33 + nl; d[0] = v[i][0]; d[1] = v[i][1]; d[2] = v[i][2]; d[3] = v[i][3]; }
    asm volatile("s_waitcnt lgkmcnt(0)" ::: "memory");
    const int c = lane & 7;
#pragma unroll
    for (int j = 0; j < 4; ++j) { const int n = (lane >> 3) + 8 * j; const LAS float* s = scr + (8 * c) * 33 + n;
        u32x4 o; o.x = pk2(s[0 * 33], s[1 * 33]); o.y = pk2(s[2 * 33], s[3 * 33]); o.z = pk2(s[4 * 33], s[5 * 33]); o.w = pk2(s[6 * 33], s[7 * 33]);
        const int ng = n0 + n; int row;
        if (MAP == 0) row = row_off + ng; else if (MAP == 1) row = win_row(ng); else row = (ng < FFN) ? ((ng >> 7) * 256 + (ng & 127)) : (((ng - FFN) >> 7) * 256 + 128 + ((ng - FFN) & 127));
        if (ng < N) *(u32x4*)(WT + (size_t)row * K + k0 + 8 * c) = o; }
    asm volatile("s_waitcnt lgkmcnt(0)" ::: "memory");
}
constexpr size_t WB_IN = 0, WB_KVB = 73 * MiB, WB_GLU = 75 * MiB, WB_BR = 77 * MiB, WB_O = 93 * MiB, WB_FIN = 101 * MiB, WB_FOUT = 145 * MiB, WB_END = 167 * MiB;
constexpr int NIN_T = 18688;
__device__ __forceinline__ void ph_convert(const P& p, int l, int gw, int NGW, int lane, LAS float* scr, const bool early, const bool late) {
    unsigned char* wb = p.ws + WS_WBF;
    constexpr int I_IN = (D / 64) * ((IN_COLS + 31) / 32), I_KVB = (512 / 64) * (2048 / 32), I_GLU = (1024 / 64) * (1024 / 32), I_BR = (1024 / 64) * (2048 / 32), I_O = (D / 64) * (D / 32),
                  I_FIN = (D / 64) * (2 * FFN / 32), I_FOUT = (FFN / 64) * (D / 32);
    constexpr int NIT = I_IN + I_KVB + I_GLU + 4 * I_BR + I_O + I_FIN + I_FOUT;
    const int it_lo = early ? 0 : NIT - I_FOUT, it_hi = late ? NIT : NIT - I_FOUT;
    for (int it = it_lo + gw; it < it_hi; it += NGW) {
        int r = it;
        if (r < I_IN) { cvt_item<1>(p.in[17] + (size_t)l * D * IN_COLS, D, IN_COLS, (bf16_t*)(wb + WB_IN), 0, scr, r, lane); continue; } r -= I_IN;
        if (r < I_KVB) { cvt_item<0>(p.in[21] + (size_t)l * 512 * 2048, 512, 2048, (bf16_t*)(wb + WB_KVB), 0, scr, r, lane); continue; } r -= I_KVB;
        if (r < I_GLU) { cvt_item<0>(p.in[30] + (size_t)l * 1024 * 1024, 1024, 1024, (bf16_t*)(wb + WB_GLU), 0, scr, r, lane); continue; } r -= I_GLU;
        if (r < 4 * I_BR) { const int b = r / I_BR; cvt_item<0>(p.in[33] + ((size_t)l * 4 + b) * 1024 * 2048, 1024, 2048, (bf16_t*)(wb + WB_BR) + (size_t)b * 2048 * 1024, 0, scr, r % I_BR, lane); continue; } r -= 4 * I_BR;
        if (r < I_O) { cvt_item<0>(p.in[34] + (size_t)l * D * D, D, D, (bf16_t*)(wb + WB_O), 0, scr, r, lane); continue; } r -= I_O;
        if (r < I_FIN) { cvt_item<2>(p.in[35] + (size_t)l * D * 2 * FFN, D, 2 * FFN, (bf16_t*)(wb + WB_FIN), 0, scr, r, lane); continue; } r -= I_FIN;
        cvt_item<0>(p.in[36] + (size_t)l * FFN * D, FFN, D, (bf16_t*)(wb + WB_FOUT), 0, scr, r, lane);
    }
    if (early) for (int row = 6224 + gw; row < 6400; row += NGW) { u32x4* o = (u32x4*)((bf16_t*)(wb + WB_IN) + (size_t)row * D); for (int j = lane; j < D / 8; j += 64) o[j] = (u32x4){0u, 0u, 0u, 0u}; }
}


__device__ __forceinline__ int xcd_slot() { const int G_ = (int)gridDim.x, c_ = (int)blockIdx.x; return (G_ % 8 == 0) ? (c_ % 8) * (G_ / 8) + c_ / 8 : c_; }
namespace fa {
typedef short s16x4 __attribute__((ext_vector_type(4)));
__device__ __forceinline__ int crow(int r, int hi) { return (r & 3) + 8 * (r >> 2) + 4 * hi; }
__device__ __forceinline__ unsigned cvtpk(float lo, float hi) { unsigned r; asm volatile("v_cvt_pk_bf16_f32 %0, %1, %2" : "=v"(r) : "v"(lo), "v"(hi)); return r; }
#define FA_SBAR() __builtin_amdgcn_sched_barrier(0)
constexpr float THR = 8.f;
__device__ __forceinline__ void partialSM_fma(f32x16& p0, f32x16& p1, float& m_reg, float& mn, float& alpha, float SCALE) {
    const float C = SCALE * 1.4426950408889634f;
    float pmax = p0[0];
#pragma unroll
    for (int r = 1; r < 16; ++r) pmax = fmaxf(pmax, p0[r]);
#pragma unroll
    for (int r = 0; r < 16; ++r) pmax = fmaxf(pmax, p1[r]);
    { auto rr = __builtin_amdgcn_permlane32_swap(__float_as_uint(pmax), __float_as_uint(pmax), false, false);
      pmax = fmaxf(__uint_as_float(rr[0]), __uint_as_float(rr[1])); }
    if (__builtin_expect(__all(pmax - m_reg <= THR / SCALE), 1)) { mn = m_reg; alpha = 1.f; }
    else { mn = fmaxf(m_reg, pmax); alpha = __builtin_amdgcn_exp2f((m_reg - mn) * C); m_reg = mn; }
    const float mnC = -mn * C;
#pragma unroll
    for (int r = 0; r < 16; ++r) p0[r] = fmaf(p0[r], C, mnC);
#pragma unroll
    for (int r = 0; r < 16; ++r) p1[r] = fmaf(p1[r], C, mnC);
#pragma unroll
    for (int r = 0; r < 16; ++r) p0[r] = __builtin_amdgcn_exp2f(p0[r]);
}
constexpr float THR2 = THR * 1.4426950408889634f;
__device__ __forceinline__ void partialSM(f32x16& p0, f32x16& p1, float& m_reg, f32x16& nm, float& alpha, const bool first) {
    float pmax = p0[0];
#pragma unroll
    for (int r = 1; r < 16; ++r) pmax = fmaxf(pmax, p0[r]);
#pragma unroll
    for (int r = 0; r < 16; ++r) pmax = fmaxf(pmax, p1[r]);
    { auto rr = __builtin_amdgcn_permlane32_swap(__float_as_uint(pmax), __float_as_uint(pmax), false, false);
      pmax = fmaxf(__uint_as_float(rr[0]), __uint_as_float(rr[1])); }
    alpha = 1.f;
    if (first || !__all(pmax <= THR2)) {
        const float d = first ? pmax : fmaxf(pmax, 0.f);
        if (!first) alpha = __builtin_amdgcn_exp2f(-d);
        m_reg += d;
#pragma unroll
        for (int r = 0; r < 16; ++r) { p0[r] -= d; p1[r] -= d; nm[r] = -m_reg; }
    }
#pragma unroll
    for (int r = 0; r < 16; ++r) p0[r] = __builtin_amdgcn_exp2f(p0[r]);
}
__device__ __forceinline__ void finishSM(f32x16& p0, f32x16& p1, float alpha, float& l_reg, bf16x8& pa0, bf16x8& pa1, bf16x8& pa2, bf16x8& pa3) {
#pragma unroll
    for (int r = 0; r < 16; ++r) p1[r] = __builtin_amdgcn_exp2f(p1[r]);
    FA_SBAR(); asm volatile("s_nop 1");
    float ps = 0;
#pragma unroll
    for (int r = 0; r < 16; ++r) ps += p0[r];
#pragma unroll
    for (int r = 0; r < 16; ++r) ps += p1[r];
    { auto rr = __builtin_amdgcn_permlane32_swap(__float_as_uint(ps), __float_as_uint(ps), false, false);
      ps = __uint_as_float(rr[0]) + __uint_as_float(rr[1]); }
    l_reg = l_reg * alpha + ps;
#define FA_PK4(P, BASE, OUT) do { u32x4 w = {cvtpk(P[BASE + 0], P[BASE + 1]), cvtpk(P[BASE + 2], P[BASE + 3]), cvtpk(P[BASE + 4], P[BASE + 5]), cvtpk(P[BASE + 6], P[BASE + 7])}; \
    OUT = *reinterpret_cast<bf16x8*>(&w); } while (0)
    FA_PK4(p0, 0, pa0); FA_PK4(p0, 8, pa1); FA_PK4(p1, 0, pa2); FA_PK4(p1, 8, pa3);
#undef FA_PK4
}
__device__ __forceinline__ int v_rd_base(int lane) { return ((lane & 3) << 3) | (((lane >> 2) & 3) << 6) | (((lane >> 4) & 1) << 5) | (((lane >> 5) & 1) << 8); }
constexpr int v_rd_off(int d0, int ks, int half) { return d0 * 512 + ks * 4096 + half * 2048; }
__device__ __forceinline__ bf16x8 lds_rd128i(unsigned addr, const int off) { bf16x8 r; asm volatile("ds_read_b128 %0, %1 offset:%2" : "=&v"(r) : "v"(addr), "i"(off) : "memory"); return r; }
template <int OFF> __device__ __forceinline__ bf16x8 lds_rd128(unsigned addr) { bf16x8 r; asm volatile("ds_read_b128 %0, %1 offset:%2" : "=&v"(r) : "v"(addr), "i"(OFF) : "memory"); return r; }
template <int OFF> __device__ __forceinline__ s16x4 tr_read(unsigned vb) {
    s16x4 r; asm volatile("ds_read_b64_tr_b16 %0, %1 offset:%2" : "=&v"(r) : "v"(vb), "i"(OFF) : "memory"); return r;
}
template <int D0> __device__ __forceinline__ void pv_one(f32x16& od, unsigned vb, bf16x8 pa0, bf16x8 pa1, bf16x8 pa2, bf16x8 pa3) {
    const s16x4 l0 = tr_read<v_rd_off(D0, 0, 0)>(vb), h0 = tr_read<v_rd_off(D0, 0, 1)>(vb), l1 = tr_read<v_rd_off(D0, 1, 0)>(vb), h1 = tr_read<v_rd_off(D0, 1, 1)>(vb);
    const s16x4 l2 = tr_read<v_rd_off(D0, 2, 0)>(vb), h2 = tr_read<v_rd_off(D0, 2, 1)>(vb), l3 = tr_read<v_rd_off(D0, 3, 0)>(vb), h3 = tr_read<v_rd_off(D0, 3, 1)>(vb);
    asm volatile("s_waitcnt lgkmcnt(0)" ::: "memory"); FA_SBAR();
#define FA_PK(L, H) (bf16x8){L[0], L[1], L[2], L[3], H[0], H[1], H[2], H[3]}
    od = __builtin_amdgcn_mfma_f32_32x32x16_bf16(pa0, FA_PK(l0, h0), od, 0, 0, 0);
    od = __builtin_amdgcn_mfma_f32_32x32x16_bf16(pa1, FA_PK(l1, h1), od, 0, 0, 0);
    od = __builtin_amdgcn_mfma_f32_32x32x16_bf16(pa2, FA_PK(l2, h2), od, 0, 0, 0);
    od = __builtin_amdgcn_mfma_f32_32x32x16_bf16(pa3, FA_PK(l3, h3), od, 0, 0, 0);
#undef FA_PK
}
struct Args { const bf16_t* Q; const bf16_t* K; const bf16_t* V; bf16_t* O; int qpitch, kpitch, vpitch, opitch, nheads, vdiv; float scale; int pad; };

template <int DQK>
__device__ __forceinline__ void attn_phase(LAS unsigned char* lds, const Args& a, int tid) {
    constexpr int KROWB = DQK * 2, KCH = KROWB / 16, KTILE = 64 * KROWB, VTILE = 16384, STAGE = KTILE + VTILE, NKI = KTILE / 8192, NVI = 2, NDMA = NKI + NVI, ND = DQK / 16;
    constexpr int RING = (DQK == 64) ? 4 : 3;
    static_assert(RING * STAGE + 2048 <= 131072, "attention LDS");
    const int wid = __builtin_amdgcn_readfirstlane(tid >> 6), lane = tid & 63, r32 = lane & 31, hi = lane >> 5;
    const int krow = (r32 & ~0xC) | ((r32 & 4) << 1) | ((r32 & 8) >> 1);
    LAS float* wsc = (LAS float*)(lds + RING * STAGE) + wid * 64;
    unsigned koff_[NKI], voff_[NVI];
#pragma unroll
    for (int i = 0; i < NKI; ++i) { const int s = i * 512 + wid * 64 + lane, row = s / KCH, ch = s % KCH; koff_[i] = (unsigned)(row * a.kpitch + (ch ^ ((row & 3) | (((row >> 3) & 1) << 2))) * 8) * 2u; }
#pragma unroll
    for (int i = 0; i < NVI; ++i) { const int o = (i * 512 + wid * 64 + lane) * 16, sub = o >> 9, within = o & 511, kk = (sub >> 2) * 8 + (within >> 6), c = (sub & 3) * 32 + ((within & 63) >> 1);
        const int k = (kk & ~0xC) | ((kk & 4) << 1) | ((kk & 8) >> 1); voff_[i] = (unsigned)(k * a.vpitch + c) * 2u; }
    const unsigned vb0 = (unsigned)(uintptr_t)(lds + KTILE) + (unsigned)v_rd_base(lane);
    const int n_lat = a.nheads * 64, n_units = n_lat + a.nheads * 16;
    for (int u = xcd_slot(); u < n_units; u += gridDim.x) {
        int b, h, q0, nk, kbase, cbase;
        if (u < n_lat) { const int bh = u >> 4, qb = u & 15; b = bh / a.nheads; h = bh % a.nheads; q0 = NCTX + b * LL + qb * 256; nk = LL + PAST; kbase = NCTX + b * LL; cbase = MTOK + b * PAST; }
        else { const int v = u - n_lat; b = v / a.nheads; h = v % a.nheads; q0 = b * CL; nk = CL; kbase = b * CL; cbase = 0; }
        const int NT = nk >> 6, vh = h / a.vdiv;
        const bf16_t* Kh = a.K + h * DQK; const bf16_t* Vh = a.V + vh * 128;
#define FA_ISSUE(j) do { const int t0_ = (j) * 64; const int rb_ = (t0_ < LL || nk == CL) ? kbase + t0_ : cbase + (t0_ - LL); LAS unsigned char* st_ = lds + ((j) % RING) * STAGE; \
        const char* kb_ = (const char*)(Kh + (size_t)rb_ * a.kpitch); const char* vb_ = (const char*)(Vh + (size_t)rb_ * a.vpitch); \
        _Pragma("unroll") for (int i_ = 0; i_ < NKI; ++i_) __builtin_amdgcn_global_load_lds((const unsigned*)(kb_ + koff_[i_]), (LAS unsigned*)(st_ + i_ * 8192 + wid * 1024), 16, 0, 0); \
        _Pragma("unroll") for (int i_ = 0; i_ < NVI; ++i_) __builtin_amdgcn_global_load_lds((const unsigned*)(vb_ + voff_[i_]), (LAS unsigned*)(st_ + KTILE + i_ * 8192 + wid * 1024), 16, 0, 0); } while (0)
        bf16x8 qr[ND];
        { const bf16_t* Qw = a.Q + (size_t)(q0 + wid * 32 + r32) * a.qpitch + h * DQK + hi * 8;
#pragma unroll
          for (int d0 = 0; d0 < ND; ++d0) qr[d0] = *(const bf16x8*)(Qw + d0 * 16); }
        float m_reg = 0.f, l_reg = 0.f; f32x16 o[4], nm;
        float z0 = 0.f; asm volatile("" : "+v"(z0));
#pragma unroll
        for (int d = 0; d < 4; ++d)
#pragma unroll
            for (int r = 0; r < 16; ++r) o[d][r] = z0;
#pragma unroll
        for (int r = 0; r < 16; ++r) nm[r] = z0;
        FA_ISSUE(0); FA_ISSUE(1);
        if constexpr (DQK != 64) { if (NDMA == 5) asm volatile("s_waitcnt vmcnt(5)" ::: "memory"); else asm volatile("s_waitcnt vmcnt(3)" ::: "memory");
            __builtin_amdgcn_s_barrier(); asm volatile("" ::: "memory"); }
        auto tile = [&](const int j) __attribute__((always_inline)) {
            LAS unsigned char* Ks = lds + (j % RING) * STAGE;
            f32x16 p0 = nm, p1 = nm;
            constexpr int KD = (DQK == 64) ? 3 : 2;
            bf16x8 kb[KD][2];
            unsigned kae[4];
#pragma unroll
            for (int e = 0; e < 4; ++e) kae[e] = (unsigned)(uintptr_t)Ks + (unsigned)(krow * KROWB + (((2 * e + hi) ^ ((krow & 3) | (((krow >> 3) & 1) << 2))) << 4));
#define FA_LDK(d0_, s_) do { kb[s_][0] = lds_rd128i(kae[(d0_) & 3], ((d0_) >> 2) * 128); kb[s_][1] = lds_rd128i(kae[(d0_) & 3], 32 * KROWB + ((d0_) >> 2) * 128); } while (0)
#pragma unroll
            for (int d0 = 0; d0 < KD - 1; ++d0) FA_LDK(d0, d0);
#pragma unroll
            for (int d0 = 0; d0 < ND; ++d0) {
                if (d0 + KD - 1 < ND) FA_LDK(d0 + KD - 1, (d0 + KD - 1) % KD);
                const int ahead = (ND - 1 - d0) < (KD - 1) ? (ND - 1 - d0) : (KD - 1);
                if (ahead == 2) asm volatile("s_waitcnt lgkmcnt(4)" ::: "memory"); else if (ahead == 1) asm volatile("s_waitcnt lgkmcnt(2)" ::: "memory"); else asm volatile("s_waitcnt lgkmcnt(0)" ::: "memory");
                FA_SBAR();
                p0 = __builtin_amdgcn_mfma_f32_32x32x16_bf16(kb[d0 % KD][0], qr[d0], p0, 0, 0, 0);
                p1 = __builtin_amdgcn_mfma_f32_32x32x16_bf16(kb[d0 % KD][1], qr[d0], p1, 0, 0, 0);
                FA_SBAR(); }
#undef FA_LDK
            float alpha; partialSM(p0, p1, m_reg, nm, alpha, j == 0);
            if (__any(alpha < 1.f)) { if (hi == 0) wsc[32 + r32] = alpha; asm volatile("s_waitcnt lgkmcnt(0)" ::: "memory");
#pragma unroll
                for (int d = 0; d < 4; ++d)
#pragma unroll
                    for (int r = 0; r < 16; ++r) o[d][r] *= wsc[32 + crow(r, hi)]; }
            bf16x8 pa0, pa1, pa2, pa3; finishSM(p0, p1, alpha, l_reg, pa0, pa1, pa2, pa3); FA_SBAR();
            const unsigned vb = vb0 + (unsigned)((j % RING) * STAGE);
            pv_one<0>(o[0], vb, pa0, pa1, pa2, pa3); pv_one<1>(o[1], vb, pa0, pa1, pa2, pa3); pv_one<2>(o[2], vb, pa0, pa1, pa2, pa3); pv_one<3>(o[3], vb, pa0, pa1, pa2, pa3);
        };
        if constexpr (DQK == 64) {
            asm volatile("s_waitcnt vmcnt(0)" ::: "memory");
            __builtin_amdgcn_s_barrier(); asm volatile("" ::: "memory");
            for (int j = 0; j < NT; j += 2) {
                if (j + 2 < NT) { FA_ISSUE(j + 2); FA_ISSUE(j + 3); }
                tile(j); tile(j + 1);
                asm volatile("s_waitcnt vmcnt(0)" ::: "memory");
                asm volatile("s_waitcnt lgkmcnt(0)" ::: "memory");
                __builtin_amdgcn_s_barrier(); asm volatile("" ::: "memory");
            }
        } else
        for (int j = 0; j < NT; ++j) {
            if (j + 2 < NT) FA_ISSUE(j + 2);
            tile(j);
            if (j + 2 < NT) { if (NDMA == 5) asm volatile("s_waitcnt vmcnt(5)" ::: "memory"); else asm volatile("s_waitcnt vmcnt(3)" ::: "memory"); }
            else asm volatile("s_waitcnt vmcnt(0)" ::: "memory");
            asm volatile("s_waitcnt lgkmcnt(0)" ::: "memory");
            __builtin_amdgcn_s_barrier(); asm volatile("" ::: "memory");
        }
#undef FA_ISSUE
        if (hi == 0) wsc[r32] = l_reg; asm volatile("s_waitcnt lgkmcnt(0)" ::: "memory");
        bf16_t* Ow = a.O + (size_t)(q0 + wid * 32) * a.opitch + h * 128 + r32;
#pragma unroll
        for (int r = 0; r < 16; ++r) { const int orow = crow(r, hi); const float rl = __builtin_amdgcn_rcpf(wsc[orow]);
#pragma unroll
            for (int d0 = 0; d0 < 4; ++d0) Ow[(size_t)orow * a.opitch + d0 * 32] = (bf16_t)f2bf(o[d0][r] * rl); }
        asm volatile("s_waitcnt lgkmcnt(0)" ::: "memory");
    }
}
}


namespace ml {
typedef short s16x4 __attribute__((ext_vector_type(4)));
constexpr int QP = 528, VP = 80, CP = 528, PP = 144;
constexpr size_t WS_SCT = WS_CT, WS_WC = WS_CT + 4 * MiB, WS_DENI = WS_CT + 5 * MiB, WS_KW = WS_CT + 6 * MiB;
__device__ __forceinline__ s16x4 trr(unsigned addr) { s16x4 r; asm volatile("ds_read_b64_tr_b16 %0, %1" : "=&v"(r) : "v"(addr) : "memory"); return r; }
__device__ __forceinline__ unsigned cvtpk(float lo, float hi) { unsigned r; asm volatile("s_nop 0\n\tv_cvt_pk_bf16_f32 %0, %1, %2\n\ts_nop 1" : "=v"(r) : "v"(lo), "v"(hi)); return r; }
__device__ __forceinline__ int crow(int r, int hi) { return (r & 3) + 8 * (r >> 2) + 4 * hi; }
#define ML_BAR() do { asm volatile("s_waitcnt lgkmcnt(0)" ::: "memory"); __builtin_amdgcn_s_barrier(); asm volatile("" ::: "memory"); } while (0)
#define ML_TOK(c, i) (base + (dir ? (L - 1 - ((c) * 64 + (i))) : ((c) * 64 + (i))))
__device__ __forceinline__ float logsig(float g) { return fminf(g, 0.f) - __logf(1.0f + __expf(-fabsf(g))); }

__device__ __forceinline__ void scalars_wg(const P& p, const int l, const int chain, const int wave, const int lane, LAS float* sx) {
    const bool lat = chain >= 128; const int cc = lat ? chain - 128 : chain, b = cc >> 3, h = (cc >> 1) & 3, dir = cc & 1;
    const int L = lat ? LL : CL, base = lat ? NCTX + b * LL : b * CL, NC = L >> 6;
    const float* kva = (const float*)(p.ws + WS_KVA) + 576 + dir * 8 + h;
    const float bi = p.in[18][l * 16 + dir * 8 + h], bf = p.in[18][l * 16 + dir * 8 + 4 + h];
    float li_[8], lf_[8];
#pragma unroll
    for (int j = 0; j < 8; ++j) { const int c = wave + 8 * j; li_[j] = 0.f; lf_[j] = 0.f; if (c < NC) { const float* r_ = kva + (size_t)ML_TOK(c, lane) * KVAW; li_[j] = r_[0] + bi; lf_[j] = r_[4] + bf; } }
    float bb_[8], gg_[8], pm_[8];
#pragma unroll
    for (int j = 0; j < 8; ++j) { const int c = wave + 8 * j;
        float bc = logsig(lf_[j]);
#pragma unroll
        for (int o = 1; o < 64; o <<= 1) { const float t_ = __shfl_up(bc, o); if (lane >= o) bc += t_; }
        const float g = li_[j] - bc; float pm = g;
#pragma unroll
        for (int o = 1; o < 64; o <<= 1) { const float t_ = __shfl_up(pm, o); if (lane >= o) pm = fmaxf(pm, t_); }
        bb_[j] = bc; gg_[j] = g; pm_[j] = pm;
        if (lane == 63) { sx[c] = (c < NC) ? bc : 0.f; sx[64 + c] = (c < NC) ? bc + pm : -1e30f; } }
    __syncthreads();
    float al = sx[lane], be = sx[64 + lane];
#pragma unroll
    for (int o = 1; o < 64; o <<= 1) { const float ea = __shfl_up(al, o), eb = __shfl_up(be, o); if (lane >= o) { be = fmaxf(eb + al, be); al = ea + al; } }
    float m0 = 0.f; if (lat) m0 = p.in[8][(size_t)((b * 2 + l) * 2 + dir) * 4 + h];
    const float pa = __shfl_up(al, 1), pb = __shfl_up(be, 1);
    const float mst_all = lane == 0 ? m0 : fmaxf(m0 + pa, pb);
    if (!lat && wave == 0 && lane == NC - 1) p.out[O_MM + ((b * 2 + l) * 2 + dir) * 4 + h] = fmaxf(m0 + al, be);
    f32x4* sct = (f32x4*)(p.ws + WS_SCT);
#pragma unroll
    for (int j = 0; j < 8; ++j) { const int c = wave + 8 * j;
        const float m_st = __shfl(mst_all, c & 63);
        if (c < NC) { const float mxl = fmaxf(m_st, __shfl(pm_[j], 63)), mx = fmaxf(m_st, pm_[j]);
            sct[((size_t)ML_TOK(c, lane) * 2 + dir) * 4 + h] = (f32x4){__expf(pm_[j] - mx), __expf(m_st - mx), __expf(-(bb_[j] + mx)), __expf(gg_[j] - mxl)};
            if (lane == 0) ((float*)(p.ws + WS_WC))[chain * 64 + c] = __expf(m_st - mxl); } }
    __syncthreads();
}

constexpr int B_Q = 0, B_K = 33792, B_V = 67584, B_P = 101376, B_S = 110592, B_END = 112640;
__device__ __forceinline__ void intra_phase(LAS unsigned char* lds, const P& p, const int l, const int tid) {
    const int wid = __builtin_amdgcn_readfirstlane(tid >> 6), lane = tid & 63, r32 = lane & 31, hi = lane >> 5;
    const bf16_t* MQ_ = (const bf16_t*)(p.ws + WS_MLQ); const bf16_t* MK_ = (const bf16_t*)(p.ws + WS_MLK); const bf16_t* MV_ = (const bf16_t*)(p.ws + WS_MLV);
    LAS float* sg = (LAS float*)(lds + B_S); LAS float* spm = sg + 64; LAS float* sws = sg + 128; LAS float* sd0 = sg + 192; LAS float* sd1 = sg + 256;
    const unsigned ldsb = (unsigned)(uintptr_t)lds;
    const int tq = (lane & 15) >> 2, tp = lane & 3, tc0 = 16 * ((lane >> 4) & 1) + 4 * tp;
    u32x4 q4[4], k4[4], v4[4]; float gli = 0.f, glf = 0.f, gws = 0.f;
#define B_DECODE(uu) const bool lat = (uu) < 2048; const int chain = lat ? 128 + ((uu) >> 6) : ((uu) - 2048) >> 2, c = lat ? ((uu) & 63) : (((uu) - 2048) & 3); \
        const int cc = lat ? chain - 128 : chain, b = cc >> 3, h = (cc >> 1) & 3, dir = cc & 1; const int L = lat ? LL : CL, base = lat ? NCTX + b * LL : b * CL;
#define B_LOAD(uu) do { B_DECODE(uu) (void)chain; \
        _Pragma("unroll") for (int i = 0; i < 4; ++i) { const int ch = tid + 512 * i, row = ch >> 5, c16 = ch & 31; const size_t g_ = (size_t)ML_TOK(c, row) * 1024 + h * 256 + c16 * 8; \
            q4[i] = *(const u32x4*)(MQ_ + g_); k4[i] = *(const u32x4*)(MK_ + g_); v4[i] = *(const u32x4*)(MV_ + g_); } \
        if (wid == 7) { const int row = ML_TOK(c, lane); const float* r_ = (const float*)(p.ws + WS_KVA) + (size_t)row * KVAW + 576 + dir * 8 + h; \
            gli = r_[0] + p.in[18][l * 16 + dir * 8 + h]; glf = r_[4] + p.in[18][l * 16 + dir * 8 + 4 + h]; gws = ((const f32x4*)(p.ws + WS_SCT))[((size_t)row * 2 + dir) * 4 + h][3]; } } while (0)
    if ((int)blockIdx.x < 2560) B_LOAD((int)blockIdx.x);
    for (int u = blockIdx.x; u < 2560; u += gridDim.x) {
        B_DECODE(u)
        bf16_t* Hout = (bf16_t*)(p.ws + (dir ? WS_HB : WS_HF));
#pragma unroll
        for (int i = 0; i < 4; ++i) { const int ch = tid + 512 * i, row = ch >> 5, c16 = ch & 31;
            *(LAS u32x4*)(lds + B_Q + row * QP + c16 * 16) = q4[i]; *(LAS u32x4*)(lds + B_K + row * QP + c16 * 16) = k4[i]; *(LAS u32x4*)(lds + B_V + row * QP + c16 * 16) = v4[i]; }
        if (wid == 7) {
            float bc = logsig(glf);
#pragma unroll
            for (int o = 1; o < 64; o <<= 1) { const float t_ = __shfl_up(bc, o); if (lane >= o) bc += t_; }
            const float g = gli - bc; float pm = g;
#pragma unroll
            for (int o = 1; o < 64; o <<= 1) { const float t_ = __shfl_up(pm, o); if (lane >= o) pm = fmaxf(pm, t_); }
            sg[lane] = g; spm[lane] = pm; sws[lane] = gws;
        }
        if (u + (int)gridDim.x < 2560) B_LOAD(u + (int)gridDim.x);
        ML_BAR();
        if (wid < 3) {
            const int tb = wid == 0 ? 0 : 1, sb = wid == 2 ? 1 : 0, t = tb * 32 + r32;
            f32x16 p0; { float z0 = 0.f; asm volatile("" : "+v"(z0));
#pragma unroll
              for (int r = 0; r < 16; ++r) p0[r] = z0; }
#pragma unroll 4
            for (int ks = 0; ks < 16; ++ks) { const int cb = (ks * 16 + hi * 8) * 2;
                const bf16x8 qf = *(const LAS bf16x8*)(lds + B_Q + t * QP + cb), kf = *(const LAS bf16x8*)(lds + B_K + (sb * 32 + r32) * QP + cb);
                p0 = __builtin_amdgcn_mfma_f32_32x32x16_bf16(kf, qf, p0, 0, 0, 0); }
            const float mpm = -spm[t]; float dsum = 0.f;
#pragma unroll
            for (int r = 0; r < 16; ++r) { const int s = sb * 32 + crow(r, hi); const float w = (s <= t) ? __expf(sg[s] + mpm) : 0.f; p0[r] *= w; dsum += p0[r]; }
            { auto rr = __builtin_amdgcn_permlane32_swap(__float_as_uint(dsum), __float_as_uint(dsum), false, false); dsum = __uint_as_float(rr[0]) + __uint_as_float(rr[1]); }
            if (hi == 0) { if (sb == 0) sd0[t] = dsum; else sd1[r32] = dsum; }
#pragma unroll
            for (int i = 0; i < 4; ++i) { u32x2 w; w.x = cvtpk(p0[4 * i], p0[4 * i + 1]); w.y = cvtpk(p0[4 * i + 2], p0[4 * i + 3]);
                *(LAS u32x2*)(lds + B_P + t * PP + (sb * 32 + 8 * i + 4 * hi) * 2) = w; }
        } else if (wid >= 4) {
            const int k = tid - 256; float acc = 0.f;
#pragma unroll 8
            for (int s = 0; s < 64; ++s) acc += sws[s] * bf2f(*(const LAS unsigned short*)(lds + B_K + s * QP + k * 2));
            ((float*)(p.ws + WS_KW))[((size_t)chain * 64 + c) * 256 + k] = acc;
        }
        ML_BAR();
        {
            f32x16 h0, h1; { float z0 = 0.f; asm volatile("" : "+v"(z0));
#pragma unroll
              for (int r = 0; r < 16; ++r) { h0[r] = z0; h1[r] = z0; } }
#pragma unroll
            for (int ks = 0; ks < 4; ++ks) {
                const unsigned va = ldsb + B_V + (16 * ks + 8 * hi + tq) * QP + (wid * 32 + tc0) * 2;
                const s16x4 lo = trr(va), hh = trr(va + 4 * QP);
                const bf16x8 a1 = *(const LAS bf16x8*)(lds + B_P + (32 + r32) * PP + (ks * 16 + hi * 8) * 2);
                bf16x8 a0 = a1; if (ks < 2) a0 = *(const LAS bf16x8*)(lds + B_P + r32 * PP + (ks * 16 + hi * 8) * 2);
                asm volatile("s_waitcnt lgkmcnt(0)" ::: "memory"); __builtin_amdgcn_sched_barrier(0);
                const bf16x8 vf = (bf16x8){lo[0], lo[1], lo[2], lo[3], hh[0], hh[1], hh[2], hh[3]};
                if (ks < 2) h0 = __builtin_amdgcn_mfma_f32_32x32x16_bf16(a0, vf, h0, 0, 0, 0);
                h1 = __builtin_amdgcn_mfma_f32_32x32x16_bf16(a1, vf, h1, 0, 0, 0); }
#pragma unroll
            for (int r = 0; r < 16; ++r) { const int t0 = crow(r, hi);
                Hout[(size_t)ML_TOK(c, t0) * 1024 + h * 256 + wid * 32 + r32] = (bf16_t)f2bf(h0[r]); Hout[(size_t)ML_TOK(c, 32 + t0) * 1024 + h * 256 + wid * 32 + r32] = (bf16_t)f2bf(h1[r]); }
            if (tid < 64) ((float*)(p.ws + WS_DENI))[((size_t)ML_TOK(c, tid) * 2 + dir) * 4 + h] = sd0[tid] + (tid >= 32 ? sd1[tid - 32] : 0.f);
        }
        ML_BAR();
    }
}

constexpr int L_Q = 0, L_K = 33792, L_V = 67584, L_CT = 72704, L_SC = 89600, L_NQ = 95744, L_N = 96256, L_PART = 98304, L_END = 114688;
__device__ __forceinline__ void seq_phase(LAS unsigned char* lds, const P& p, const int l, const int tid) {
    const int wid = __builtin_amdgcn_readfirstlane(tid >> 6), lane = tid & 63, r32 = lane & 31, hi = lane >> 5;
    const bf16_t* MQ_ = (const bf16_t*)(p.ws + WS_MLQ); const bf16_t* MK_ = (const bf16_t*)(p.ws + WS_MLK); const bf16_t* MV_ = (const bf16_t*)(p.ws + WS_MLV);
    const unsigned ldsb = (unsigned)(uintptr_t)lds;
    const int tq = (lane & 15) >> 2, tp = lane & 3, tc0 = 16 * ((lane >> 4) & 1) + 4 * tp;
    for (int u = xcd_slot(); u < 1280; u += gridDim.x) {
        const bool lat = u < 256; const int uu = lat ? u : u - 256, cc = uu >> 3, sl = uu & 7, chain = lat ? 128 + cc : cc;
        const int b = cc >> 3, h = (cc >> 1) & 3, dir = cc & 1;
        const int L = lat ? LL : CL, base = lat ? NCTX + b * LL : b * CL, NC = L >> 6;
        const int colq = h * 256, colv = h * 256 + sl * 32;
        bf16_t* Hout = (bf16_t*)(p.ws + (dir ? WS_HB : WS_HF));
        f32x16 ct, ia;
        { float z0 = 0.f; asm volatile("" : "+v"(z0));
#pragma unroll
          for (int r = 0; r < 16; ++r) { ct[r] = z0; ia[r] = z0; } }
        LAS float* nb0 = (LAS float*)(lds + L_N); LAS float* nb1 = nb0 + 256;
        if (lat) {
            const size_t so = (size_t)((b * 2 + l) * 2 + dir) * 4 + h;
            const float* c0 = p.in[6] + so * 65536 + (size_t)(sl * 32 + r32) * 256 + wid * 32 + 4 * hi;
#pragma unroll
            for (int i = 0; i < 4; ++i) { const f32x4 v4 = *(const f32x4*)(c0 + 8 * i); ct[4 * i] = v4[0]; ct[4 * i + 1] = v4[1]; ct[4 * i + 2] = v4[2]; ct[4 * i + 3] = v4[3]; }
            if (tid < 256) nb0[tid] = p.in[7][so * 256 + tid];
        } else if (tid < 256) nb0[tid] = 0.f;
        u32x4 pq[4], pk[4], pv; pv = (u32x4){0u, 0u, 0u, 0u}; f32x4 psc = {0.f, 0.f, 0.f, 0.f}; float pdi = 0.f, pwc = 0.f, pkw = 0.f; unsigned hpre[16];
#pragma unroll
        for (int r = 0; r < 16; ++r) hpre[r] = 0u;
#define ML_HPRE(cc_) do { _Pragma("unroll") for (int rr = 0; rr < 8; ++rr) hpre[rr] = Hout[(size_t)ML_TOK(cc_, (wid & 1) * 32 + crow(8 * (wid >> 1) + rr, hi)) * 1024 + colv + r32]; } while (0)
#define ML_LOAD(c) do { _Pragma("unroll") for (int i_ = 0; i_ < 4; ++i_) { const int ch_ = tid + 512 * i_, row_ = ch_ >> 5, c16_ = ch_ & 31; const size_t g_ = (size_t)ML_TOK(c, row_) * 1024 + colq + c16_ * 8; \
            pq[i_] = *(const u32x4*)(MQ_ + g_); pk[i_] = *(const u32x4*)(MK_ + g_); } \
        if (tid < 256) { const int row_ = tid >> 2, c16_ = tid & 3; pv = *(const u32x4*)(MV_ + (size_t)ML_TOK(c, row_) * 1024 + colv + c16_ * 8); } \
        else pkw = ((const float*)(p.ws + WS_KW))[((size_t)chain * 64 + (c)) * 256 + tid - 256]; \
        if (wid == 0) { const size_t ix_ = ((size_t)ML_TOK(c, lane) * 2 + dir) * 4 + h; psc = ((const f32x4*)(p.ws + WS_SCT))[ix_]; pdi = ((const float*)(p.ws + WS_DENI))[ix_]; pwc = ((const float*)(p.ws + WS_WC))[chain * 64 + (c)]; } } while (0)
#define ML_WRITE(cc_) do { _Pragma("unroll") for (int i_ = 0; i_ < 4; ++i_) { const int ch_ = tid + 512 * i_, row_ = ch_ >> 5, c16_ = ch_ & 31; \
            *(LAS u32x4*)(lds + L_Q + row_ * QP + c16_ * 16) = pq[i_]; *(LAS u32x4*)(lds + L_K + row_ * QP + c16_ * 16) = pk[i_]; } \
        if (tid < 256) { const int row_ = tid >> 2, c16_ = tid & 3; *(LAS u32x4*)(lds + L_V + row_ * VP + c16_ * 16) = pv; } \
        if (wid == 0) { LAS float* S_ = (LAS float*)(lds + L_SC + ((cc_) % 3) * 2048); S_[lane] = psc[0]; S_[64 + lane] = psc[1]; S_[128 + lane] = psc[2]; S_[192 + lane] = psc[3]; S_[256 + lane] = pdi; if (lane == 0) S_[320] = pwc; } } while (0)
#define ML_CTB() do { _Pragma("unroll") for (int i_ = 0; i_ < 4; ++i_) { u32x2 w_; w_.x = cvtpk(ct[4 * i_], ct[4 * i_ + 1]); w_.y = cvtpk(ct[4 * i_ + 2], ct[4 * i_ + 3]); \
            *(LAS u32x2*)(lds + L_CT + r32 * CP + (wid * 32 + 8 * i_ + 4 * hi) * 2) = w_; } } while (0)
#define ML_COMB(cc_) do { const int tb_ = wid & 1, kh_ = wid >> 1; const LAS float* S_ = (const LAS float*)(lds + L_SC + ((cc_) % 3) * 2048); const LAS float* NQ_ = (const LAS float*)(lds + L_NQ + ((cc_) & 1) * 256); \
            const LAS float* PT_ = (const LAS float*)(lds + L_PART + (((cc_) & 1) * 4 + (wid ^ 2)) * 2048); \
            _Pragma("unroll") for (int rr = 0; rr < 8; ++rr) { const int r = 8 * kh_ + rr, tt = tb_ * 32 + crow(r, hi); bf16_t* hp_ = Hout + (size_t)ML_TOK(cc_, tt) * 1024 + colv + r32; \
                const float rr_ = S_[tt], wi = S_[64 + tt], den = rr_ * S_[256 + tt] + wi * NQ_[tt], it_ = (kh_ ? ia[8 + rr] : ia[rr]) + PT_[rr * 64 + lane]; \
                *hp_ = (bf16_t)f2bf((rr_ * bf2f(hpre[rr]) + wi * it_) * __builtin_amdgcn_rcpf(fmaxf(fabsf(den), S_[128 + tt]))); } } while (0)
        float kwc = 0.f;
        ML_LOAD(0); ML_WRITE(0); ML_CTB(); kwc = pkw;
        int nsel = 0;
        for (int c = 0; c < NC; ++c) {
            ML_BAR();
            LAS float* ncur = nsel ? nb1 : nb0; LAS float* nnxt = nsel ? nb0 : nb1;
            const LAS float* SC = (const LAS float*)(lds + L_SC + (c % 3) * 2048);
            if (c + 1 < NC) ML_LOAD(c + 1);
            const float w_c = SC[320];
            if (wid < 4) {
                if (c > 0) ML_COMB(c - 1);
                ML_HPRE(c);
                const int tb = wid & 1, kh = wid >> 1;
                { float z0 = 0.f; asm volatile("" : "+v"(z0));
#pragma unroll
                  for (int r = 0; r < 16; ++r) ia[r] = z0; }
#pragma unroll
                for (int k1 = 0; k1 < 8; ++k1) { const int cb0 = ((kh * 8 + k1) * 16 + hi * 8) * 2;
                    const bf16x8 qf0 = *(const LAS bf16x8*)(lds + L_Q + (tb * 32 + r32) * QP + cb0), cf0 = *(const LAS bf16x8*)(lds + L_CT + r32 * CP + cb0);
                    ia = __builtin_amdgcn_mfma_f32_32x32x16_bf16(qf0, cf0, ia, 0, 0, 0); }
                { LAS float* PW = (LAS float*)(lds + L_PART + ((c & 1) * 4 + wid) * 2048);
#pragma unroll
                  for (int rr = 0; rr < 8; ++rr) PW[rr * 64 + lane] = kh ? ia[rr] : ia[8 + rr]; }
            } else if (wid >= 4) {
                const int j = tid - 256, t = j >> 2, part = j & 3;
                float acc = 0.f;
#pragma unroll
                for (int i = 0; i < 8; ++i) { const u32x4 qv = *(const LAS u32x4*)(lds + L_Q + t * QP + (part * 64 + i * 8) * 2);
                    const f32x4 n0 = *(const LAS f32x4*)(ncur + part * 64 + i * 8), n1 = *(const LAS f32x4*)(ncur + part * 64 + i * 8 + 4);
                    acc += bf2f(qv[0]) * n0[0] + bf2f(qv[0] >> 16) * n0[1] + bf2f(qv[1]) * n0[2] + bf2f(qv[1] >> 16) * n0[3] + bf2f(qv[2]) * n1[0] + bf2f(qv[2] >> 16) * n1[1] + bf2f(qv[3]) * n1[2] + bf2f(qv[3] >> 16) * n1[3]; }
                acc += __shfl_xor(acc, 1); acc += __shfl_xor(acc, 2);
                if (part == 0) ((LAS float*)(lds + L_NQ + (c & 1) * 256))[t] = acc;
                nnxt[j] = w_c * ncur[j] + kwc;
            }
            { f32x16 cc = ct;
#pragma unroll
              for (int r = 0; r < 16; ++r) cc[r] *= w_c;
#pragma unroll
              for (int ks = 0; ks < 4; ++ks) {
                const unsigned ka = ldsb + L_K + (16 * ks + 8 * hi + tq) * QP + (wid * 32 + tc0) * 2, va = ldsb + L_V + (16 * ks + 8 * hi + tq) * VP + tc0 * 2;
                const s16x4 kl = trr(ka), kh = trr(ka + 4 * QP), vl = trr(va), vh = trr(va + 4 * VP);
                const f32x4 wa = *(const LAS f32x4*)(SC + 192 + 16 * ks + 8 * hi), wb = *(const LAS f32x4*)(SC + 192 + 16 * ks + 8 * hi + 4);
                asm volatile("s_waitcnt lgkmcnt(0)" ::: "memory"); __builtin_amdgcn_sched_barrier(0);
                u32x4 vw; vw.x = cvtpk(bf2f((unsigned short)vl[0]) * wa[0], bf2f((unsigned short)vl[1]) * wa[1]); vw.y = cvtpk(bf2f((unsigned short)vl[2]) * wa[2], bf2f((unsigned short)vl[3]) * wa[3]);
                vw.z = cvtpk(bf2f((unsigned short)vh[0]) * wb[0], bf2f((unsigned short)vh[1]) * wb[1]); vw.w = cvtpk(bf2f((unsigned short)vh[2]) * wb[2], bf2f((unsigned short)vh[3]) * wb[3]);
                const bf16x8 kf = (bf16x8){kl[0], kl[1], kl[2], kl[3], kh[0], kh[1], kh[2], kh[3]};
                cc = __builtin_amdgcn_mfma_f32_32x32x16_bf16(kf, *reinterpret_cast<bf16x8*>(&vw), cc, 0, 0, 0); }
              ct = cc; }
            ML_BAR();
            if (c + 1 < NC) { ML_WRITE(c + 1); kwc = pkw; }
            ML_CTB();
            nsel ^= 1;
        }
        if (wid < 4) ML_COMB(NC - 1);
        if (!lat) {
            const size_t so = (size_t)((b * 2 + l) * 2 + dir) * 4 + h;
            float* oc = p.out + O_MC + so * 65536 + (size_t)(sl * 32 + r32) * 256 + wid * 32 + 4 * hi;
#pragma unroll
            for (int i = 0; i < 4; ++i) *(f32x4*)(oc + 8 * i) = (f32x4){ct[4 * i], ct[4 * i + 1], ct[4 * i + 2], ct[4 * i + 3]};
            if (sl == 0) { LAS float* nfin = nsel ? nb1 : nb0; if (tid < 256) p.out[O_MN + so * 256 + tid] = nfin[tid]; }
        }
        ML_BAR();
#undef ML_LOAD
#undef ML_WRITE
#undef ML_CTB
#undef ML_COMB
#undef ML_HPRE
    }
}
#undef ML_BAR
#undef ML_TOK
#undef B_LOAD
#undef B_DECODE
}


namespace s5 {
typedef short s16x4 __attribute__((ext_vector_type(4)));
__device__ __forceinline__ s16x4 trr(unsigned addr) { s16x4 r; asm volatile("ds_read_b64_tr_b16 %0, %1" : "=&v"(r) : "v"(addr) : "memory"); return r; }
__device__ __forceinline__ unsigned cvtpk(float lo, float hi) { unsigned r; asm volatile("s_nop 0\n\tv_cvt_pk_bf16_f32 %0, %1, %2\n\ts_nop 1" : "=v"(r) : "v"(lo), "v"(hi)); return r; }
template <bool FULL>
__device__ __forceinline__ void scan_seg(const P& p, const int l, LAS unsigned char* T, const int g, const int dir, const bool lat, const int b0, const int lane, const int blk0, const int nblk,
                                         const float (&ar)[2], const float (&ai)[2], const bf16x8 (&bb)[4], float (&sr)[2], float (&si)[2]) {
    const int r32 = lane & 31, hh = lane >> 5;
    const int L = lat ? LL : CL;
    const int baseA = lat ? NCTX + b0 * LL : b0 * CL, baseB = baseA + L;
    const size_t pg = (size_t)(l * 2 + dir) * 64 + g;
    bf16x8 cm[8];
    if (FULL) {
#pragma unroll
        for (int ks = 0; ks < 8; ++ks) { u32x4 w = {0u, 0u, 0u, 0u};
            if (r32 < 16) { const int k0 = 16 * ks + 8 * hh; const float* src = (k0 < 64 ? p.in[27] : p.in[28]) + (pg * 16 + r32) * 64 + (k0 & 63); const float sg = k0 < 64 ? 1.f : -1.f;
#pragma unroll
                for (int j = 0; j < 4; ++j) w[j] = cvtpk(sg * src[2 * j], sg * src[2 * j + 1]); }
            cm[ks] = *reinterpret_cast<bf16x8*>(&w); } }
    const int urow_tok = 4 * (r32 >> 3) + (r32 & 3), urow_base = ((r32 >> 2) & 1) ? baseB : baseA;
    const bf16_t* U = (const bf16_t*)(p.ws + WS_S5U) + g * 16 + 8 * hh;
    bf16_t* Yo2 = (bf16_t*)(p.ws + (dir ? WS_YS5B : WS_YS5F)) + g * 16;
#define S5_POS(n, j) (dir ? (L - 1 - ((n) * 16 + (j))) : ((n) * 16 + (j)))
    bf16x8 ucur[4], unxt[4];
#pragma unroll
    for (int i = 0; i < 4; ++i) { ucur[i] = *(const bf16x8*)(U + (size_t)(urow_base + S5_POS(blk0 + i, urow_tok)) * 1024); unxt[i] = ucur[i]; }
    const unsigned tb = (unsigned)(uintptr_t)T;
    const int tq = (lane & 15) >> 2, tp = lane & 3, tc0 = 16 * ((lane >> 4) & 1) + 4 * tp;
    for (int n4 = blk0; n4 < blk0 + nblk; n4 += 4) {
        if (n4 + 4 < blk0 + nblk) {
#pragma unroll
            for (int i = 0; i < 4; ++i) unxt[i] = *(const bf16x8*)(U + (size_t)(urow_base + S5_POS(n4 + 4 + i, urow_tok)) * 1024); }
#pragma unroll
      for (int i4 = 0; i4 < 4; ++i4) { const int n = n4 + i4; const bf16x8 ucur1 = ucur[i4];
        f32x16 acc[4]; { float z0 = 0.f; asm volatile("" : "+v"(z0));
#pragma unroll
          for (int q = 0; q < 4; ++q)
#pragma unroll
              for (int r = 0; r < 16; ++r) acc[q][r] = z0; }
#pragma unroll
        for (int q = 0; q < 4; ++q) acc[q] = __builtin_amdgcn_mfma_f32_32x32x16_bf16(ucur1, bb[q], acc[q], 0, 0, 0);
#pragma unroll
        for (int pb = 0; pb < 2; ++pb) { float xr = sr[pb], xi = si[pb]; const float a_r = ar[pb], a_i = ai[pb];
#pragma unroll
            for (int r = 0; r < 16; ++r) { const float nr_ = a_r * xr - a_i * xi + acc[pb][r], ni_ = a_r * xi + a_i * xr + acc[2 + pb][r]; xr = nr_; xi = ni_; acc[pb][r] = nr_; acc[2 + pb][r] = ni_; }
            sr[pb] = xr; si[pb] = xi; }
        if (FULL) {
#pragma unroll
        for (int q = 0; q < 4; ++q)
#pragma unroll
            for (int a4 = 0; a4 < 4; ++a4) { u32x2 w; w.x = cvtpk(acc[q][4 * a4], acc[q][4 * a4 + 1]); w.y = cvtpk(acc[q][4 * a4 + 2], acc[q][4 * a4 + 3]);
                *(LAS u32x2*)(T + (q * 32 + r32) * 64 + 16 * a4 + 8 * hh) = w; }
        f32x16 y, y2; { float z0 = 0.f; asm volatile("" : "+v"(z0));
#pragma unroll
          for (int r = 0; r < 16; ++r) { y[r] = z0; y2[r] = z0; } }
        { s16x4 lo_[8], hi_[8];
#pragma unroll
          for (int ks = 0; ks < 8; ++ks) { const unsigned ta = tb + (16 * ks + 8 * hh + tq) * 64 + tc0 * 2; lo_[ks] = trr(ta); hi_[ks] = trr(ta + 4 * 64); }
          asm volatile("s_waitcnt lgkmcnt(0)" ::: "memory"); __builtin_amdgcn_sched_barrier(0);
#pragma unroll
          for (int ks = 0; ks < 8; ks += 2) {
            const bf16x8 af0 = (bf16x8){lo_[ks][0], lo_[ks][1], lo_[ks][2], lo_[ks][3], hi_[ks][0], hi_[ks][1], hi_[ks][2], hi_[ks][3]};
            const bf16x8 af1 = (bf16x8){lo_[ks + 1][0], lo_[ks + 1][1], lo_[ks + 1][2], lo_[ks + 1][3], hi_[ks + 1][0], hi_[ks + 1][1], hi_[ks + 1][2], hi_[ks + 1][3]};
            y = __builtin_amdgcn_mfma_f32_32x32x16_bf16(cm[ks], af0, y, 0, 0, 0);
            y2 = __builtin_amdgcn_mfma_f32_32x32x16_bf16(cm[ks + 1], af1, y2, 0, 0, 0); }
#pragma unroll
          for (int r = 0; r < 16; ++r) y[r] += y2[r]; }
        {
          bf16_t* yo = Yo2 + (size_t)(urow_base + S5_POS(n, urow_tok)) * 1024 + 4 * hh;
          u32x2 w0, w1; w0.x = cvtpk(y[0], y[1]); w0.y = cvtpk(y[2], y[3]); w1.x = cvtpk(y[4], y[5]); w1.y = cvtpk(y[6], y[7]);
          *(u32x2*)yo = w0; *(u32x2*)(yo + 8) = w1; }
        }
      }
#pragma unroll
        for (int i = 0; i < 4; ++i) ucur[i] = unxt[i];
    }
#undef S5_POS
}
__device__ __forceinline__ void params(const P& p, const int l, const int g, const int dir, const int lane, float (&ar)[2], float (&ai)[2], bf16x8 (&bb)[4]) {
    const int r32 = lane & 31, hh = lane >> 5; const size_t pg = (size_t)(l * 2 + dir) * 64 + g;
    const float dt = __expf(p.in[24][pg]);
#pragma unroll
    for (int pb = 0; pb < 2; ++pb) { const int pp = pb * 32 + r32;
        const float lr = fminf(p.in[22][pg * 64 + pp], -1e-4f), li = p.in[23][pg * 64 + pp];
        const float mag = __expf(dt * lr); float sn, cs; sincos_small(dt * li, sn, cs);
        const float a_r = mag * cs, a_i = mag * sn, den = lr * lr + li * li, nr = a_r - 1.0f, ni = a_i, qr = (nr * lr + ni * li) / den, qi = (ni * lr - nr * li) / den;
        ar[pb] = a_r; ai[pb] = a_i;
        const float* br = p.in[25] + (pg * 64 + pp) * 16 + 8 * hh; const float* bi = p.in[26] + (pg * 64 + pp) * 16 + 8 * hh;
        u32x4 wr, wi;
#pragma unroll
        for (int j = 0; j < 4; ++j) { const float r0 = qr * br[2 * j] - qi * bi[2 * j], r1 = qr * br[2 * j + 1] - qi * bi[2 * j + 1], i0 = qr * bi[2 * j] + qi * br[2 * j], i1 = qr * bi[2 * j + 1] + qi * br[2 * j + 1];
            wr[j] = cvtpk(r0, r1); wi[j] = cvtpk(i0, i1); }
        bb[pb] = *reinterpret_cast<bf16x8*>(&wr); bb[2 + pb] = *reinterpret_cast<bf16x8*>(&wi); }
}
__device__ __forceinline__ void ctx_unit(const P& p, const int l, LAS unsigned char* T, const int u, const int lane) {
    const int dir = u & 1, g = (u >> 1) & 63, b0 = 2 * (u >> 7), r32 = lane & 31, hh = lane >> 5;
    float ar[2], ai[2]; bf16x8 bb[4]; params(p, l, g, dir, lane, ar, ai, bb);
    float sr[2] = {0.f, 0.f}, si[2] = {0.f, 0.f};
    scan_seg<true>(p, l, T, g, dir, false, b0, lane, 0, CL / 16, ar, ai, bb, sr, si);
#pragma unroll
    for (int pb = 0; pb < 2; ++pb) { const size_t so = ((size_t)(((b0 + hh) * 2 + l) * 2 + dir) * 64 + g) * 64 + pb * 32 + r32; p.out[O_SR + so] = sr[pb]; p.out[O_SI + so] = si[pb]; }
}
__device__ __forceinline__ void lat_unit(const P& p, const int l, LAS unsigned char* lds, const int u, const int wave, const int lane) {
    const int dir = u & 1, g = (u >> 1) & 63, b0 = 2 * (u >> 7), r32 = lane & 31, hh = lane >> 5;
    LAS unsigned char* T = lds + wave * 8192; LAS float* X = (LAS float*)(lds + 65536);
    float ar[2], ai[2]; bf16x8 bb[4]; params(p, l, g, dir, lane, ar, ai, bb);
    float sr[2] = {0.f, 0.f}, si[2] = {0.f, 0.f};
    if (wave == 0) {
#pragma unroll
        for (int pb = 0; pb < 2; ++pb) { const size_t so = ((size_t)(((b0 + hh) * 2 + l) * 2 + dir) * 64 + g) * 64 + pb * 32 + r32; sr[pb] = p.in[9][so]; si[pb] = p.in[10][so]; } }
    const float s0r[2] = {sr[0], sr[1]}, s0i[2] = {si[0], si[1]};
    constexpr int SEGB = LL / 16 / 8;
    if (wave < 7) scan_seg<false>(p, l, T, g, dir, true, b0, lane, wave * SEGB, SEGB, ar, ai, bb, sr, si);
#pragma unroll
    for (int pb = 0; pb < 2; ++pb) { X[(wave * 4 + pb) * 64 + lane] = sr[pb]; X[(wave * 4 + 2 + pb) * 64 + lane] = si[pb]; }
    __syncthreads();
    float pr[2], pi[2];
#pragma unroll
    for (int pb = 0; pb < 2; ++pb) { float xr = ar[pb], xi = ai[pb];
#pragma unroll
        for (int k = 0; k < 9; ++k) { const float nr = xr * xr - xi * xi, ni = 2.f * xr * xi; xr = nr; xi = ni; }
        pr[pb] = xr; pi[pb] = xi; }
    float cr[2], ci[2];
    if (wave == 0) { cr[0] = s0r[0]; cr[1] = s0r[1]; ci[0] = s0i[0]; ci[1] = s0i[1]; }
    else {
#pragma unroll
        for (int pb = 0; pb < 2; ++pb) { float xr = X[(0 * 4 + pb) * 64 + lane], xi = X[(0 * 4 + 2 + pb) * 64 + lane];
            for (int j = 1; j < wave; ++j) { const float er = X[(j * 4 + pb) * 64 + lane], ei = X[(j * 4 + 2 + pb) * 64 + lane];
                const float nr = pr[pb] * xr - pi[pb] * xi + er, ni = pr[pb] * xi + pi[pb] * xr + ei; xr = nr; xi = ni; }
            cr[pb] = xr; ci[pb] = xi; } }
    scan_seg<true>(p, l, T, g, dir, true, b0, lane, wave * SEGB, SEGB, ar, ai, bb, cr, ci);
    __syncthreads();
}
__device__ __forceinline__ void combine_row(const P& p, const int l, const int r, const int lane) {
    const bf16_t* yf = (const bf16_t*)(p.ws + WS_YS5F) + (size_t)r * 1024; const bf16_t* yb = (const bf16_t*)(p.ws + WS_YS5B) + (size_t)r * 1024; const bf16_t* uu = (const bf16_t*)(p.ws + WS_S5U) + (size_t)r * 1024;
    bf16_t* o = (bf16_t*)(p.ws + WS_HB) + (size_t)r * 1024; const float* dv = p.in[29] + l * 1024;
#pragma unroll
    for (int j = 0; j < 2; ++j) { const int c = j * 512 + lane * 8; float a[8], b[8], u[8];
        { const u32x4 w = *(const u32x4*)(yf + c);
#pragma unroll
          for (int i = 0; i < 4; ++i) { a[2 * i] = bf2f(w[i]); a[2 * i + 1] = bf2f(w[i] >> 16); } }
        { const u32x4 w = *(const u32x4*)(yb + c);
#pragma unroll
          for (int i = 0; i < 4; ++i) { b[2 * i] = bf2f(w[i]); b[2 * i + 1] = bf2f(w[i] >> 16); } }
        { const u32x4 w = *(const u32x4*)(uu + c);
#pragma unroll
          for (int i = 0; i < 4; ++i) { u[2 * i] = bf2f(w[i]); u[2 * i + 1] = bf2f(w[i] >> 16); } }
        const f32x4 d0 = *(const f32x4*)(dv + c), d1 = *(const f32x4*)(dv + c + 4);
        float gq[8];
#pragma unroll
        for (int i = 0; i < 8; ++i) gq[i] = gelu_tanh(a[i] + b[i] + (i < 4 ? d0[i] : d1[i - 4]) * u[i]);
        u32x4 w; w.x = pk2(gq[0], gq[1]); w.y = pk2(gq[2], gq[3]); w.z = pk2(gq[4], gq[5]); w.w = pk2(gq[6], gq[7]);
        *(u32x4*)(o + c) = w; }
}
}

__device__ __forceinline__ float rope_lane(float x, int lane, int prow, int pcol, const float* rt) {
    const int part = lane >> 5, jj = lane & 31, idx = jj & 15, pos = part ? pcol : prow;
    const float c = rt[pos * 16 + idx], s = rt[1024 + pos * 16 + idx];
    const float o = __shfl_xor(x, 16);
    return (jj >= 16) ? (x * c + o * s) : (x * c - o * s);
}
__device__ __forceinline__ u32x4 rope8(const u32x4 x, const int d0  , const int prow, const int pcol, const float* rt, const int pmask) {
    const int part = d0 >> 5, jj = d0 & 31, idx0 = jj & 15, pos = part ? pcol : prow; const bool second = jj >= 16;
    u32x4 o, y;
#pragma unroll
    for (int i = 0; i < 4; ++i) o[i] = __shfl_xor(x[i], pmask);
    const f32x4 c0 = *(const f32x4*)(rt + pos * 16 + idx0), c1 = *(const f32x4*)(rt + pos * 16 + idx0 + 4), s0 = *(const f32x4*)(rt + 1024 + pos * 16 + idx0), s1 = *(const f32x4*)(rt + 1024 + pos * 16 + idx0 + 4);
#pragma unroll
    for (int i = 0; i < 4; ++i) { const float ca = i < 2 ? c0[2 * i] : c1[2 * i - 4], cb = i < 2 ? c0[2 * i + 1] : c1[2 * i - 3], sa = i < 2 ? s0[2 * i] : s1[2 * i - 4], sb = i < 2 ? s0[2 * i + 1] : s1[2 * i - 3];
        const float xa = bf2f(x[i]), xb = bf2f(x[i] >> 16), oa = bf2f(o[i]), ob = bf2f(o[i] >> 16);
        y[i] = second ? pk2(xa * ca + oa * sa, xb * cb + ob * sb) : pk2(xa * ca - oa * sa, xb * cb - ob * sb); }
    return y;
}
__device__ __forceinline__ void ph_prep_row(const P& p, int l, int r, int lane) {
    unsigned char* ws = p.ws;
    bf16_t* ckvn = (bf16_t*)(ws + WS_CKVN) + (size_t)r * 512;
    bf16_t* kf = (bf16_t*)(ws + WS_KFULL) + (size_t)r * 1536;
    bf16_t* dfk = (bf16_t*)(ws + WS_DFK) + (size_t)r * 1024;
    bf16_t* dfv = (bf16_t*)(ws + WS_DFV) + (size_t)r * 1024;
    if (r >= MTOK) {
        const int i = r - MTOK, b = i >> 8, t = i & 255; const size_t cr = (size_t)(b * 2 + l) * PAST + t;
        { const float* cc = p.in[2] + cr * 512 + lane * 8; const f32x4 a = *(const f32x4*)cc, c = *(const f32x4*)(cc + 4);
          u32x4 w; w.x = pk2(a[0], a[1]); w.y = pk2(a[2], a[3]); w.z = pk2(c[0], c[1]); w.w = pk2(c[2], c[3]); *(u32x4*)(ckvn + lane * 8) = w; }
        const float kr = p.in[3][cr * 64 + lane];
#pragma unroll
        for (int h = 0; h < 8; ++h) kf[h * 192 + 128 + lane] = (bf16_t)f2bf(kr);
        const float* ck = p.in[4] + cr * 1024 + lane * 16; const float* cv = p.in[5] + cr * 1024 + lane * 16;
#pragma unroll
        for (int j = 0; j < 2; ++j) { const f32x4 a = *(const f32x4*)(ck + 8 * j), c = *(const f32x4*)(ck + 8 * j + 4), d = *(const f32x4*)(cv + 8 * j), e = *(const f32x4*)(cv + 8 * j + 4);
            u32x4 w; w.x = pk2(a[0], a[1]); w.y = pk2(a[2], a[3]); w.z = pk2(c[0], c[1]); w.w = pk2(c[2], c[3]); *(u32x4*)(dfk + lane * 16 + 8 * j) = w;
            u32x4 v; v.x = pk2(d[0], d[1]); v.y = pk2(d[2], d[3]); v.z = pk2(e[0], e[1]); v.w = pk2(e[2], e[3]); *(u32x4*)(dfv + lane * 16 + 8 * j) = v; }
        return;
    }
    const float* kva = (const float*)(ws + WS_KVA) + (size_t)r * KVAW;
    const bool ctx = r < NCTX;
    const int cb = r >> 8, ct = r & 255;
    const int t = (r - NCTX) & 4095, prow = t >> 6, pcol = t & 63;
    const float* rt = (const float*)(ws + WS_ROPE);
    const f32x4 ka = *(const f32x4*)(kva + lane * 8), kb = *(const f32x4*)(kva + lane * 8 + 4);
    float kr = kva[512 + lane];
    const float graw = lane < 16 ? kva[576 + lane] + p.in[18][l * 16 + lane] : 0.f;
    bf16_t* mq = (bf16_t*)(ws + WS_MQ) + (size_t)r * 1536 + (lane >> 3) * 192 + 128 + (lane & 7) * 8;
    bf16_t* dfq = (bf16_t*)(ws + WS_DFQ) + (size_t)r * 1024 + lane * 16;
    u32x4 xq = {0u, 0u, 0u, 0u}, xd0 = xq, xd1 = xq, xk0 = xq, xk1 = xq, xv0 = xq, xv1 = xq;
    if (!ctx) { xq = *(const u32x4*)mq; xd0 = *(const u32x4*)dfq; xd1 = *(const u32x4*)(dfq + 8); }
    xk0 = *(const u32x4*)(dfk + lane * 16); xk1 = *(const u32x4*)(dfk + lane * 16 + 8);
    if (ctx) { xv0 = *(const u32x4*)(dfv + lane * 16); xv1 = *(const u32x4*)(dfv + lane * 16 + 8); }
    { float ss = ka[0] * ka[0] + ka[1] * ka[1] + ka[2] * ka[2] + ka[3] * ka[3] + kb[0] * kb[0] + kb[1] * kb[1] + kb[2] * kb[2] + kb[3] * kb[3];
      const float rstd = rsqrtf(wave_sum(ss) * (1.0f / 512.0f) + 1e-6f);
      const float* g = p.in[20] + l * 512 + lane * 8; const f32x4 g0 = *(const f32x4*)g, g1 = *(const f32x4*)(g + 4);
      const f32x4 y0 = ka * rstd * g0, y1 = kb * rstd * g1;
      u32x4 w; w.x = pk2(y0[0], y0[1]); w.y = pk2(y0[2], y0[3]); w.z = pk2(y1[0], y1[1]); w.w = pk2(y1[2], y1[3]); *(u32x4*)(ckvn + lane * 8) = w;
      if (ctx) { float* o = p.out + O_CKV + ((size_t)(cb * 2 + l) * CL + ct) * 512 + lane * 8; *(f32x4*)o = y0; *(f32x4*)(o + 4) = y1; } }
    { if (ctx) p.out[O_KR + ((size_t)(cb * 2 + l) * CL + ct) * 64 + lane] = kr; else kr = rope_lane(kr, lane, prow, pcol, rt);
#pragma unroll
      for (int h = 0; h < 8; ++h) kf[h * 192 + 128 + lane] = (bf16_t)f2bf(kr); }
    if (lane < 16) { const float o = ((lane >> 2) & 1) ? (fminf(graw, 0.f) - __logf(1.0f + __expf(-fabsf(graw)))) : graw; ((float*)(ws + WS_GATES))[(size_t)r * 16 + lane] = o; }
    if (ctx) {
        float* ok = p.out + O_DK + ((size_t)(cb * 2 + l) * CL + ct) * 1024 + lane * 16; float* ov = p.out + O_DV + ((size_t)(cb * 2 + l) * CL + ct) * 1024 + lane * 16;
#pragma unroll
        for (int i = 0; i < 4; ++i) { *(f32x2_*)(ok + 2 * i) = (f32x2_){bf2f(xk0[i]), bf2f(xk0[i] >> 16)}; *(f32x2_*)(ok + 8 + 2 * i) = (f32x2_){bf2f(xk1[i]), bf2f(xk1[i] >> 16)};
            *(f32x2_*)(ov + 2 * i) = (f32x2_){bf2f(xv0[i]), bf2f(xv0[i] >> 16)}; *(f32x2_*)(ov + 8 + 2 * i) = (f32x2_){bf2f(xv1[i]), bf2f(xv1[i] >> 16)}; }
    } else {
        *(u32x4*)mq = rope8(xq, (lane & 7) * 8, prow, pcol, rt, 2);
        const int q = lane & 3;
        *(u32x4*)dfq = rope8(xd0, q * 16, prow, pcol, rt, 1); *(u32x4*)(dfq + 8) = rope8(xd1, q * 16 + 8, prow, pcol, rt, 1);
        *(u32x4*)(dfk + lane * 16) = rope8(xk0, q * 16, prow, pcol, rt, 1); *(u32x4*)(dfk + lane * 16 + 8) = rope8(xk1, q * 16 + 8, prow, pcol, rt, 1);
    }
}

__device__ __forceinline__ void ph_ml_combine_row(const P& p, int l, int r, int lane) {
    bf16_t* hf = (bf16_t*)(p.ws + WS_HF) + (size_t)r * 1024 + lane * 4; const bf16_t* hb = (const bf16_t*)(p.ws + WS_HB) + (size_t)r * 1024 + lane * 4;
    const bf16_t* so = (const bf16_t*)(p.ws + WS_MLO) + (size_t)r * 1024 + lane * 4; const float* g = p.in[19] + l * 1024 + lane * 4;
    u32x2 a[4], b[4], c[4]; f32x4 gg[4];
#pragma unroll
    for (int h = 0; h < 4; ++h) { a[h] = *(const u32x2*)(hf + h * 256); b[h] = *(const u32x2*)(hb + h * 256); c[h] = *(const u32x2*)(so + h * 256); gg[h] = *(const f32x4*)(g + h * 256); }
#pragma unroll
    for (int h = 0; h < 4; ++h) { float v[4];
        v[0] = bf2f(a[h].x) + bf2f(b[h].x); v[1] = bf2f(a[h].x >> 16) + bf2f(b[h].x >> 16); v[2] = bf2f(a[h].y) + bf2f(b[h].y); v[3] = bf2f(a[h].y >> 16) + bf2f(b[h].y >> 16);
        const float rstd = rsqrtf(wave_sum(v[0] * v[0] + v[1] * v[1] + v[2] * v[2] + v[3] * v[3]) * (1.0f / 256.0f) + 1e-6f);
        u32x2 w; w.x = pk2(v[0] * rstd * gg[h][0] * bf2f(c[h].x), v[1] * rstd * gg[h][1] * bf2f(c[h].x >> 16)); w.y = pk2(v[2] * rstd * gg[h][2] * bf2f(c[h].y), v[3] * rstd * gg[h][3] * bf2f(c[h].y >> 16));
        *(u32x2*)(hf + h * 256) = w; }
}

__device__ __forceinline__ void ph_df_combine_row(const P& p, int l, float lam_init, float lam, int r, int lane) {
    const int h = lane >> 3, part = lane & 7;
    const bf16_t* o = (const bf16_t*)(p.ws + WS_DFO) + (size_t)r * 2048 + h * 256 + part * 16;
    const u32x4 a0 = *(const u32x4*)o, a1 = *(const u32x4*)(o + 8), b0 = *(const u32x4*)(o + 128), b1 = *(const u32x4*)(o + 136);
    const float* g = p.in[32] + l * 128 + part * 16;
    float v[16]; float ss = 0.f;
#pragma unroll
    for (int i = 0; i < 4; ++i) { v[2 * i] = bf2f(a0[i]) - lam * bf2f(b0[i]); v[2 * i + 1] = bf2f(a0[i] >> 16) - lam * bf2f(b0[i] >> 16); v[8 + 2 * i] = bf2f(a1[i]) - lam * bf2f(b1[i]); v[9 + 2 * i] = bf2f(a1[i] >> 16) - lam * bf2f(b1[i] >> 16); }
#pragma unroll
    for (int i = 0; i < 16; ++i) ss += v[i] * v[i];
    ss += __shfl_xor(ss, 1); ss += __shfl_xor(ss, 2); ss += __shfl_xor(ss, 4);
    const float sc = rsqrtf(ss * (1.0f / 128.0f) + 1e-6f) * (1.0f - lam_init);
    u32x4 w0, w1;
#pragma unroll
    for (int i = 0; i < 4; ++i) { w0[i] = pk2(v[2 * i] * sc * g[2 * i], v[2 * i + 1] * sc * g[2 * i + 1]); w1[i] = pk2(v[8 + 2 * i] * sc * g[8 + 2 * i], v[9 + 2 * i] * sc * g[9 + 2 * i]); }
    bf16_t* y = (bf16_t*)(p.ws + WS_DFQ) + (size_t)r * 1024 + h * 128 + part * 16;
    *(u32x4*)y = w0; *(u32x4*)(y + 8) = w1;
}
__device__ __forceinline__ void ph_final_row(const P& p, int r, int lane) {
    const bf16_t* xb = (const bf16_t*)(p.ws + WS_X) + (size_t)r * D; const float* g = p.in[37];
    f32x4 v[8]; float ss = 0.f;
#pragma unroll
    for (int j = 0; j < 8; ++j) { const u32x2 w = *(const u32x2*)(xb + j * 256 + lane * 4); v[j] = (f32x4){bf2f(w.x), bf2f(w.x >> 16), bf2f(w.y), bf2f(w.y >> 16)}; ss += v[j][0] * v[j][0] + v[j][1] * v[j][1] + v[j][2] * v[j][2] + v[j][3] * v[j][3]; }
    const float rstd = rsqrtf(wave_sum(ss) * (1.0f / 2048.0f) + 1e-6f);
    float* o = p.out + (r < NCTX ? O_YP + (size_t)r * D : O_YS + (size_t)(r - NCTX) * D);
#pragma unroll
    for (int j = 0; j < 8; ++j) { const int c = j * 256 + lane * 4; const f32x4 gg = *(const f32x4*)(g + c); *(f32x4*)(o + c) = v[j] * rstd * gg; }
}

__device__ __forceinline__ void load_args(P& p) {
#if defined(__HIP_DEVICE_COMPILE__)
    const __attribute__((address_space(4))) unsigned long long* q = (const __attribute__((address_space(4))) unsigned long long*)__builtin_amdgcn_kernarg_segment_ptr();
    asm volatile("" : "+s"(q));
#pragma unroll
    for (int i = 0; i < 38; ++i) p.in[i] = (const float*)q[i];
    p.out = (float*)q[38]; p.ws = (unsigned char*)q[39];
#endif
}
constexpr int NTHR = 512, LDS_BYTES = 147456, MISC_OFF = 131072;
#ifndef PROBE
#define PROBE 0
#endif
#ifndef PROBE_MASK_D
#define PROBE_MASK_D 0u
#endif
#ifndef PROBE_MASK_A
#define PROBE_MASK_A 0u
#endif
#define PROBE_MULT 10
#define PROBE_ADIV 100.0f
#define STAMP(idx) do { if (PROBE) { if (blockIdx.x == 0 && bar.w == 0u && lane_id_() == 0u) ((LAS unsigned long long*)((LAS unsigned char*)lds + MISC_OFF + 2048))[idx] = __builtin_amdgcn_s_memrealtime(); } } while (0)
#define GRID_BAR() do { XcdBarrier b_ = bar; asm volatile("" : "+s"(b_.x)); xcd_barrier(b_); } while (0)

#define PH_VARS P p; load_args(p); unsigned char* ws = p.ws; (void)ws; int tid_ = (int)(bar.w * 64u + lane_id_()); asm volatile("" : "+v"(tid_)); const int lane = tid_ & 63, wave = __builtin_amdgcn_readfirstlane(tid_ >> 6), half = tid_ >> 8, vt = tid_ & 255; \
    const int gw = blockIdx.x * 8 + wave, vb = blockIdx.x * 2 + half; (void)lane; (void)half; (void)vt; (void)gw; (void)vb;

template <int l>
__device__ __forceinline__ void run_layer(unsigned char* lds, const XcdBarrier& bar, const int G, const int NGW) {
        { PH_VARS ph_convert(p, l, gw, NGW, lane, (LAS float*)((LAS unsigned char*)lds + wave * 16384), l == 0, true); }
        { PH_VARS for (int r = gw; r < MTOK; r += NGW) ph_hnorm_row(p, l, 0, r, lane); }
        GRID_BAR(); STAMP(1 + 17 * l + 1);
        { PH_VARS pg8::Gemm g{(const bf16_t*)(ws + WS_H), (const bf16_t*)(ws + WS_WBF + WB_IN), MTOK, 10496, D}; pg8::StaticOrder S; S.init(MTOK, 10496, G, (int)blockIdx.x);
          pg8::gemm_phase<Epi8In, pg8::StaticOrder, true, true>((LAS unsigned char*)lds, g, S, Epi8In{ws}, tid_); }
        GRID_BAR(); STAMP(1 + 17 * l + 2);
        { PH_VARS for (int ch = blockIdx.x; ch < 160; ch += G) ml::scalars_wg(p, l, ch, wave, lane, (LAS float*)((LAS unsigned char*)lds)); for (int r = gw; r < MALL; r += NGW) ph_prep_row(p, l, r, lane); }
        GRID_BAR(); STAMP(1 + 17 * l + 3);
        { PH_VARS pg8::Gemm g{(const bf16_t*)(ws + WS_CKVN), (const bf16_t*)(ws + WS_WBF + WB_KVB), MALL, 2048, 512}; pg8::StaticOrder S; S.init(MALL, 2048, G, (int)blockIdx.x);
          pg8::gemm_phase<Epi8Kvb, pg8::StaticOrder, true, true>((LAS unsigned char*)lds, g, S, Epi8Kvb{(bf16_t*)(ws + WS_KFULL), (bf16_t*)(ws + WS_VFULL)}, tid_); }
        STAMP(1 + 17 * l + 4);
        { PH_VARS ml::intra_phase((LAS unsigned char*)lds, p, l, tid_); }
        GRID_BAR();
        { PH_VARS ml::seq_phase((LAS unsigned char*)lds, p, l, tid_); }
        GRID_BAR(); STAMP(1 + 17 * l + 5);
        { PH_VARS
          for (int u = xcd_slot(); u < 256; u += G) { int ln_ = lane; asm volatile("" : "+v"(ln_)); s5::lat_unit(p, l, (LAS unsigned char*)lds, u, wave, ln_); }
          if (wave < 4) { for (int u = wave * G + blockIdx.x; u < 1024; u += 4 * G) s5::ctx_unit(p, l, (LAS unsigned char*)lds + wave * 8192, u, lane); }
          else { for (int r = blockIdx.x * 4 + (wave - 4); r < MTOK; r += G * 4) ph_ml_combine_row(p, l, r, lane); } }
        GRID_BAR(); STAMP(1 + 17 * l + 6);
        { PH_VARS for (int r = gw; r < MTOK; r += NGW) s5::combine_row(p, l, r, lane); }
        GRID_BAR(); STAMP(1 + 17 * l + 7);
        { PH_VARS pg8::Gemm g{(const bf16_t*)(ws + WS_HB), (const bf16_t*)(ws + WS_WBF + WB_GLU), MTOK, 1024, 1024}; pg8::StaticOrder S; S.init(MTOK, 1024, G, (int)blockIdx.x);
          pg8::gemm_phase<Epi8Glu, pg8::StaticOrder, true, true>((LAS unsigned char*)lds, g, S, Epi8Glu{(const bf16_t*)(ws + WS_HB), (bf16_t*)(ws + WS_S5U)}, tid_); }
        STAMP(1 + 17 * l + 8);
        { PH_VARS fa::Args aa{(const bf16_t*)(ws + WS_MQ), (const bf16_t*)(ws + WS_KFULL), (const bf16_t*)(ws + WS_VFULL), (bf16_t*)(ws + WS_MLQ), 1536, 1536, 1024, 1024, 8, 1, 0.07216878364870322f, 0};
          fa::attn_phase<192>((LAS unsigned char*)lds, aa, tid_); }
        STAMP(1 + 17 * l + 9);
        { PH_VARS fa::Args aa{(const bf16_t*)(ws + WS_DFQ), (const bf16_t*)(ws + WS_DFK), (const bf16_t*)(ws + WS_DFV), (bf16_t*)(ws + WS_DFO), 1024, 1024, 1024, 2048, 16, 2, 0.125f, 0};
          fa::attn_phase<64>((LAS unsigned char*)lds, aa, tid_); }
        GRID_BAR(); STAMP(1 + 17 * l + 10);
        { PH_VARS const float lam_init = (l == 0) ? 0.2f : 0.35550906759096927f;
          const float* lp = p.in[31] + l * 256;
          const float lam = __expf(wave_sum(lp[lane] * lp[64 + lane])) - __expf(wave_sum(lp[128 + lane] * lp[192 + lane])) + lam_init;
          for (int r = gw; r < MTOK; r += NGW) ph_df_combine_row(p, l, lam_init, lam, r, lane); }
        GRID_BAR(); STAMP(1 + 17 * l + 11);
        { PH_VARS pg8::Gemm g{(const bf16_t*)(ws + WS_H), (const bf16_t*)(ws + WS_WBF + WB_IN) + (size_t)10496 * D, MTOK, GATE_COLS, D}; pg8::StaticOrder S; S.init(MTOK, GATE_COLS, G, (int)blockIdx.x);
          pg8::gemm_phase<Epi8Gate, pg8::StaticOrder, true, true>((LAS unsigned char*)lds, g, S, Epi8Gate{(bf16_t*)(ws + WS_GS)}, tid_); }
        GRID_BAR(); STAMP(1 + 17 * l + 12);
        { PH_VARS pg8::Gemm g{(const bf16_t*)(ws + WS_HF), (const bf16_t*)(ws + WS_WBF + WB_BR) + (size_t)0 * 2048 * 1024, MTOK, D, 1024}; pg8::StaticOrder S; S.init(MTOK, D, G, (int)blockIdx.x);
          pg8::gemm_phase<Epi8Merge, pg8::StaticOrder, true, true>((LAS unsigned char*)lds, g, S, Epi8Merge{(const bf16_t*)(ws + WS_GS), (bf16_t*)(ws + WS_H), 0, 0}, tid_); }
        { PH_VARS pg8::Gemm g{(const bf16_t*)(ws + WS_MLQ), (const bf16_t*)(ws + WS_WBF + WB_BR) + (size_t)1 * 2048 * 1024, MTOK, D, 1024}; pg8::StaticOrder S; S.init(MTOK, D, G, (int)blockIdx.x);
          pg8::gemm_phase<Epi8Merge, pg8::StaticOrder, true, true>((LAS unsigned char*)lds, g, S, Epi8Merge{(const bf16_t*)(ws + WS_GS), (bf16_t*)(ws + WS_H), 1, 0}, tid_); }
        { PH_VARS pg8::Gemm g{(const bf16_t*)(ws + WS_S5U), (const bf16_t*)(ws + WS_WBF + WB_BR) + (size_t)2 * 2048 * 1024, MTOK, D, 1024}; pg8::StaticOrder S; S.init(MTOK, D, G, (int)blockIdx.x);
          pg8::gemm_phase<Epi8Merge, pg8::StaticOrder, true, true>((LAS unsigned char*)lds, g, S, Epi8Merge{(const bf16_t*)(ws + WS_GS), (bf16_t*)(ws + WS_H), 2, 0}, tid_); }
        { PH_VARS pg8::Gemm g{(const bf16_t*)(ws + WS_DFQ), (const bf16_t*)(ws + WS_WBF + WB_BR) + (size_t)3 * 2048 * 1024, MTOK, D, 1024}; pg8::StaticOrder S; S.init(MTOK, D, G, (int)blockIdx.x);
          pg8::gemm_phase<Epi8Merge, pg8::StaticOrder, true, true>((LAS unsigned char*)lds, g, S, Epi8Merge{(const bf16_t*)(ws + WS_GS), (bf16_t*)(ws + WS_H), 3, 0}, tid_); }
        GRID_BAR(); STAMP(1 + 17 * l + 13);
        { PH_VARS pg8::Gemm g{(const bf16_t*)(ws + WS_H), (const bf16_t*)(ws + WS_WBF + WB_O), MTOK, D, D}; pg8::StaticOrder S; S.init(MTOK, D, G, (int)blockIdx.x);
          pg8::gemm_phase<Epi8Res, pg8::StaticOrder, true, true>((LAS unsigned char*)lds, g, S, Epi8Res{p, l, 4096, 0, 0}, tid_); }
        GRID_BAR(); STAMP(1 + 17 * l + 14);
        { PH_VARS for (int r = gw; r < MTOK; r += NGW) ph_hnorm_row(p, l, 1, r, lane); }
        GRID_BAR(); STAMP(1 + 17 * l + 15);
        { PH_VARS pg8::Gemm g{(const bf16_t*)(ws + WS_H), (const bf16_t*)(ws + WS_WBF + WB_FIN), MTOK, 2 * FFN, D}; pg8::StaticOrder S; S.init(MTOK, 2 * FFN, G, (int)blockIdx.x);
          pg8::gemm_phase<Epi8FfnIn, pg8::StaticOrder, true, true>((LAS unsigned char*)lds, g, S, Epi8FfnIn{(bf16_t*)(ws + WS_FFNH)}, tid_); }
        GRID_BAR(); STAMP(1 + 17 * l + 16);
        { PH_VARS pg8::Gemm g{(const bf16_t*)(ws + WS_FFNH), (const bf16_t*)(ws + WS_WBF + WB_FOUT), MTOK, D, FFN}; pg8::StaticOrder S; S.init(MTOK, D, G, (int)blockIdx.x);
          pg8::gemm_phase<Epi8Res, pg8::StaticOrder, true, true>((LAS unsigned char*)lds, g, S, Epi8Res{p, l, 10240, 1, 0}, tid_); }
        if (l == 0) { PH_VARS
          const int rem = 640 % G, nidle = rem ? G - rem : G, idx = rem ? (int)blockIdx.x - rem : (int)blockIdx.x;
          if (idx >= 0) ph_convert(p, 1, idx * 8 + wave, nidle * 8, lane, (LAS float*)((LAS unsigned char*)lds + wave * 16384), true, false); }
        GRID_BAR(); STAMP(1 + 17 * l + 17);
}

__global__ void __launch_bounds__(NTHR, 2) mega(P p_arg) {
    extern __shared__ __attribute__((aligned(16))) unsigned char lds[];
    const int tid = threadIdx.x;
    const int G = gridDim.x, NGW = G * 8;
    for (int u = tid; u < (LDS_BYTES - MISC_OFF) / 4; u += NTHR) ((LAS unsigned*)((LAS unsigned char*)lds + MISC_OFF))[u] = 0u;
    __syncthreads();
    XcdBarrier bar = xcd_barrier_post((unsigned*)(p_arg.ws + WS_CTL), (volatile LAS unsigned*)((LAS unsigned char*)lds + MISC_OFF + 32));
    STAMP(0);
    { PH_VARS ph_mod_partial(p, tid_, (float*)lds); }
    GRID_BAR();
    { PH_VARS ph_mod_reduce(p, tid_); }
    GRID_BAR(); STAMP(1);
    run_layer<0>(lds, bar, G, NGW);
    run_layer<1>(lds, bar, G, NGW);
    { PH_VARS for (int r = gw; r < MTOK; r += NGW) ph_final_row(p, r, lane);
#if PROBE
      STAMP(35);
      if (blockIdx.x == 0 && bar.w == 0u && lane_id_() == 0u) {
          asm volatile("s_waitcnt vmcnt(0) lgkmcnt(0)" ::: "memory");
          const LAS unsigned long long* ts = (const LAS unsigned long long*)((LAS unsigned char*)lds + MISC_OFF + 2048);
          unsigned long long sd = 0, sa = 0;
          for (int ll = 0; ll < 2; ++ll) for (int i = 0; i < 17; ++i) { const unsigned long long d = ts[1 + 17 * ll + i + 1] - ts[1 + 17 * ll + i]; if ((PROBE_MASK_D >> i) & 1u) sd += d; if ((PROBE_MASK_A >> i) & 1u) sa += d; }
          { const unsigned long long d = ts[1] - ts[0]; if ((PROBE_MASK_D >> 17) & 1u) sd += d; if ((PROBE_MASK_A >> 17) & 1u) sa += d; }
          { const unsigned long long d = ts[35] - ts[34]; if ((PROBE_MASK_D >> 18) & 1u) sd += d; if ((PROBE_MASK_A >> 18) & 1u) sa += d; }
          float v = (float)sa * 0.01f / PROBE_ADIV; v = v > 120.f ? 120.f : v;
          if (PROBE_MASK_A) p.out[O_YS] += v;
          const unsigned long long t0 = __builtin_amdgcn_s_memrealtime(), wait = sd * PROBE_MULT;
          while (__builtin_amdgcn_s_memrealtime() - t0 < wait) __builtin_amdgcn_s_sleep(32);
      }
#endif
    }
}

extern "C" void kernel_launch(void* const* d_in, const int* in_sizes, int n_in, void* d_out, int out_size, void* d_ws, size_t ws_size, hipStream_t stream) {
    static int grid = 0;
    if (grid == 0) {
        if (n_in != 38 || out_size != (int)O_END || ws_size < WS_END) { fprintf(stderr, "kernel_launch: unexpected shapes (n_in %d out %d ws %zu)\n", n_in, out_size, ws_size); grid = -1; return; }
        int dev = 0, cus = 0, per_cu = 0;
        if (hipGetDevice(&dev) != hipSuccess || hipDeviceGetAttribute(&cus, hipDeviceAttributeMultiprocessorCount, dev) != hipSuccess) { grid = -1; return; }
        if (hipFuncSetAttribute((const void*)mega, hipFuncAttributeMaxDynamicSharedMemorySize, LDS_BYTES) != hipSuccess) { fprintf(stderr, "kernel_launch: hipFuncSetAttribute failed\n"); grid = -1; return; }
        if (hipOccupancyMaxActiveBlocksPerMultiprocessor(&per_cu, (const void*)mega, NTHR, LDS_BYTES) != hipSuccess || per_cu < 1) { fprintf(stderr, "kernel_launch: occupancy query says %d workgroups per CU\n", per_cu); grid = -1; return; }
        (void)hipGetLastError();
        grid = cus;
    }
    if (grid < 0) return;
    if (hipMemsetAsync((char*)d_ws + WS_CTL, 0, CTL_BYTES, stream) != hipSuccess) return;
    P p{};
    for (int i = 0; i < 38; ++i) p.in[i] = (const float*)d_in[i];
    p.out = (float*)d_out; p.ws = (unsigned char*)d_ws;
    hipLaunchKernelGGL(mega, dim3(grid), dim3(NTHR), LDS_BYTES, stream, p);
}
```

```cpp
#include <hip/hip_runtime.h>
#include <cstdio>
#include <cstdint>

typedef unsigned short bf16_t;
typedef short bf16x8 __attribute__((ext_vector_type(8)));
typedef float f32x16 __attribute__((ext_vector_type(16)));
typedef float f32x4 __attribute__((ext_vector_type(4)));
typedef unsigned u32x4 __attribute__((ext_vector_type(4)));
typedef unsigned u32x2 __attribute__((ext_vector_type(2)));
typedef float f32x2_ __attribute__((ext_vector_type(2)));

constexpr int D = 2048, NCTX = 4096, NLAT = 16384, MTOK = 20480, MALL = 21504;
constexpr int CB = 16, CL = 256, LB = 4, LL = 4096, PAST = 256;
constexpr int IN_COLS = 18512, MIX_COLS = 10320, GATE_COLS = 8192;
constexpr int C_MLQ = 0, C_MLK = 1024, C_MLV = 2048, C_MLO = 3072, C_MLIF = 4096, C_MQ = 4112, C_KVA = 5648, C_S5U = 6224, C_DFQ = 7248, C_DFK = 8272, C_DFV = 9296;
constexpr int FFN = 5632;
constexpr int NTHR_ = 512;
constexpr int KVAW = 768;

constexpr size_t MiB = 1u << 20;
constexpr size_t WS_CTL = 0, CTL_BYTES = 64 * 1024;
constexpr size_t WS_MOD = 1 * MiB;
constexpr size_t WS_ROPE = WS_MOD + 512 * 1024;
constexpr size_t WS_X = 2 * MiB;
constexpr size_t WS_H = 162 * MiB;
constexpr size_t WS_HF = 242 * MiB;
constexpr size_t WS_HB = 282 * MiB;
constexpr size_t WS_MLQ = 322 * MiB;
constexpr size_t WS_S5U = 362 * MiB;
constexpr size_t WS_DFQ = 402 * MiB;
constexpr size_t WS_MLK = 442 * MiB;
constexpr size_t WS_MLV = 482 * MiB;
constexpr size_t WS_MLO = 522 * MiB;
constexpr size_t WS_MQ = 562 * MiB;
constexpr size_t WS_KVA = 622 * MiB;
constexpr size_t WS_DFK = 682 * MiB;
constexpr size_t WS_DFV = 724 * MiB;
constexpr size_t WS_CKVN = 766 * MiB;
constexpr size_t WS_KFULL = 787 * MiB;
constexpr size_t WS_VFULL = 850 * MiB;
constexpr size_t WS_GATES = 892 * MiB;
constexpr size_t WS_CT = 894 * MiB;
constexpr size_t WS_WBF = 934 * MiB;
constexpr size_t WS_GS = 442 * MiB;
constexpr size_t WS_FFNH = 442 * MiB;
constexpr size_t WS_DFO = 442 * MiB;
constexpr size_t WS_YS5F = 442 * MiB;
constexpr size_t WS_YS5B = 482 * MiB;
constexpr size_t WS_END = 1101 * MiB;

constexpr size_t O_YP = 0, O_YS = 8388608, O_CKV = 41943040, O_KR = 46137344, O_DK = 46661632, O_DV = 55050240,
                 O_MC = 63438848, O_MN = 80216064, O_MM = 80281600, O_SR = 80281856, O_SI = 80544000, O_END = 80806144;

__device__ __forceinline__ unsigned f2bf(float f) { unsigned u = __builtin_bit_cast(unsigned, f); return (u + 0x7fffu + ((u >> 16) & 1u)) >> 16; }
__device__ __forceinline__ float bf2f(unsigned b) { return __builtin_bit_cast(float, (b & 0xffffu) << 16); }
__device__ __forceinline__ unsigned pk2(float lo, float hi) { return f2bf(lo) | (f2bf(hi) << 16); }
__device__ __forceinline__ float wave_sum(float v) {
#pragma unroll
    for (int o = 1; o < 64; o <<= 1) v += __shfl_xor(v, o);
    return v;
}
__device__ __forceinline__ float wave_max(float v) {
#pragma unroll
    for (int o = 1; o < 64; o <<= 1) v = fmaxf(v, __shfl_xor(v, o));
    return v;
}
__device__ __forceinline__ float sigmoidf_(float x) { return __builtin_amdgcn_rcpf(1.0f + __expf(-x)); }
__device__ __forceinline__ float siluf_(float x) { return x * __builtin_amdgcn_rcpf(1.0f + __expf(-x)); }
__device__ __forceinline__ float gelu_tanh(float x) { const float u = 0.7978845608028654f * (x + 0.044715f * x * x * x); const float t = 1.0f - 2.0f * __builtin_amdgcn_rcpf(1.0f + __expf(2.0f * u)); return 0.5f * x * (1.0f + t); }
__device__ __forceinline__ void sincos_small(float x, float& s, float& c) {
    const float k = rintf(x * 0.6366197723675814f);
    float r = fmaf(-k, 1.5707962513e+0f, x); r = fmaf(-k, 7.5497894159e-8f, r); r = fmaf(-k, 5.3903029534e-15f, r);
    const float r2 = r * r;
    const float sp = r + r * r2 * (-1.6666654611e-1f + r2 * (8.3321608736e-3f + r2 * (-1.9515295891e-4f)));
    const float cp = 1.0f - 0.5f * r2 + r2 * r2 * (4.166664568298827e-2f + r2 * (-1.388731625493765e-3f + r2 * 2.443315711809948e-5f));
    const int q = ((int)k) & 3;
    s = (q == 0) ? sp : (q == 1) ? cp : (q == 2) ? -sp : -cp;
    c = (q == 0) ? cp : (q == 1) ? -sp : (q == 2) ? -cp : sp;
}
__device__ __forceinline__ int cond_of_row(int r) { return r < NCTX ? 0 : 1 + ((r - NCTX) >> 12); }

struct P {
    const float* in[38];
    float* out;
    unsigned char* ws;
};
__device__ __forceinline__ const float* x_in(const P& p, int r) { return r < NCTX ? p.in[0] + (size_t)r * D : p.in[1] + (size_t)(r - NCTX) * D; }


#define XB_TMO      128
#define XB_XCNT(j)  (256  + 64 * (j))
#define XB_XSUB(j)  (1280 + 64 * (j))
#define XB_XGEN(j)  (2304 + 64 * (j))
#define XB_TOP      3328
#define XB_TOPGEN   3392
#define XCD_BAR_WORDS 3456
#define XB_SPIN_CAP (1u << 22)
#define LAS __attribute__((address_space(3)))

__device__ __forceinline__ unsigned xb_ld(unsigned* p)              { return __hip_atomic_load(p, __ATOMIC_RELAXED, __HIP_MEMORY_SCOPE_AGENT); }
__device__ __forceinline__ unsigned xb_add(unsigned* p, unsigned v) { return __hip_atomic_fetch_add(p, v, __ATOMIC_RELAXED, __HIP_MEMORY_SCOPE_AGENT); }
__device__ __forceinline__ unsigned xb_xcc_id() { return (unsigned)__builtin_amdgcn_s_getreg((3 << 11) | 20) & 0xFu; }
#define XB_SPIN(cond, bar) do { unsigned _sp = 0; while (cond) { __builtin_amdgcn_s_sleep(1); \
    if ((++_sp & 255u) == 0u) { if (xb_ld(&(bar)[XB_TMO])) break; if (_sp > XB_SPIN_CAP) { atomicAdd(&(bar)[XB_TMO], 1u); break; } } } } while (0)

__device__ __forceinline__ unsigned lane_id_() { unsigned l_; asm volatile("v_mbcnt_lo_u32_b32 %0, -1, 0\n\tv_mbcnt_hi_u32_b32 %0, -1, %0" : "=v"(l_)); return l_; }
struct XcdBarrier {
    unsigned* bar; unsigned x; unsigned w;
    volatile LAS unsigned* st;
};
__device__ __forceinline__ XcdBarrier xcd_barrier_post(unsigned* bar, volatile LAS unsigned* st) {
    XcdBarrier b; b.bar = bar; b.x = xb_xcc_id(); b.st = st; b.w = (unsigned)__builtin_amdgcn_readfirstlane(threadIdx.x >> 6);
    if (threadIdx.x == 0) (void)xb_add(&bar[XB_XCNT(b.x)], 1u);
    return b;
}
__device__ __forceinline__ void xcd_barrier_complete(unsigned* bar, unsigned x, unsigned& nloc, unsigned& nx) {
    const unsigned G = gridDim.x * gridDim.y * gridDim.z;
    unsigned sum, cnt, mine, sp = 0u;
    for (;;) {
        sum = 0u; cnt = 0u; mine = 0u;
#pragma unroll
        for (unsigned j = 0; j < 16; ++j) { const unsigned c = xb_ld(&bar[XB_XCNT(j)]); sum += c; cnt += (c > 0u) ? 1u : 0u; mine = (j == x) ? c : mine; }
        if (sum == G) break;
        __builtin_amdgcn_s_sleep(1);
        if ((++sp & 255u) == 0u) { if (xb_ld(&bar[XB_TMO])) break; if (sp > XB_SPIN_CAP) { atomicAdd(&bar[XB_TMO], 1u); break; } }
    }
    nloc = mine > 0u ? mine : 1u; nx = cnt > 0u ? cnt : 1u;
}
__device__ __forceinline__ void xcd_barrier(const XcdBarrier& b) {
    asm volatile("s_waitcnt vmcnt(0)" ::: "memory");
    __syncthreads();
    if (b.w == 0u && lane_id_() == 0u) {
        unsigned* bar = b.bar;
        __builtin_amdgcn_s_waitcnt(0);
        unsigned nloc = b.st[0], nx = b.st[1];
        if (nloc == 0u) { xcd_barrier_complete(bar, b.x, nloc, nx); b.st[0] = nloc; b.st[1] = nx; }
        const unsigned old = xb_add(&bar[XB_XSUB(b.x)], 1u);
        const unsigned gen = old / nloc;
        if (old + 1u == (gen + 1u) * nloc) {
            __builtin_amdgcn_fence(__ATOMIC_RELEASE, "agent");
            asm volatile("s_waitcnt vmcnt(0)" ::: "memory");
            const unsigned og = xb_add(&bar[XB_TOP], 1u);
            const unsigned tg = og / nx;
            if (og + 1u == (tg + 1u) * nx) xb_add(&bar[XB_TOPGEN], 1u);
            else XB_SPIN(xb_ld(&bar[XB_TOPGEN]) == tg, bar);
            __builtin_amdgcn_fence(__ATOMIC_ACQUIRE, "agent");
            xb_add(&bar[XB_XGEN(b.x)], 1u);
            asm volatile("s_waitcnt vmcnt(0)" ::: "memory");
        } else {
            XB_SPIN(xb_ld(&bar[XB_XGEN(b.x)]) == gen, bar);
            __builtin_amdgcn_fence(__ATOMIC_ACQUIRE, "agent");
            asm volatile("s_waitcnt vmcnt(0)" ::: "memory");
        }
    }
    __syncthreads();
}


constexpr int MOD_KS = 16, MOD_KC = 2048 / MOD_KS;
constexpr size_t WS_MODP = WS_X;
__device__ __forceinline__ void ph_mod_partial(const P& p, int tid, float* sc) {
    for (int i = tid; i < 5 * 2048; i += NTHR_) { const int c = i >> 11, k = i & 2047; const float v = c == 0 ? p.in[12][k] : p.in[11][(c - 1) * 2048 + k]; sc[i] = siluf_(v); }
    __syncthreads();
    const int NU = 2 * 3072 * MOD_KS;
    for (int u = blockIdx.x * NTHR_ + tid; u < NU; u += gridDim.x * NTHR_) {
        const int cg = u % 3072, kc = (u / 3072) % MOD_KS, l = u / (3072 * MOD_KS);
        const float* w = p.in[13] + ((size_t)l * 2048 + kc * MOD_KC) * 12288 + cg * 4;
        f32x4 a0 = {0.f, 0.f, 0.f, 0.f}, a1 = a0, a2 = a0, a3 = a0, a4 = a0;
#pragma unroll 8
        for (int k = 0; k < MOD_KC; ++k) { const f32x4 wv = *(const f32x4*)(w + (size_t)k * 12288); const int kk = kc * MOD_KC + k;
            a0 += wv * sc[kk]; a1 += wv * sc[2048 + kk]; a2 += wv * sc[4096 + kk]; a3 += wv * sc[6144 + kk]; a4 += wv * sc[8192 + kk]; }
        float* o = (float*)(p.ws + WS_MODP) + ((size_t)(kc * 2 + l) * 5) * 12288 + cg * 4;
        *(f32x4*)o = a0; *(f32x4*)(o + 12288) = a1; *(f32x4*)(o + 2 * 12288) = a2; *(f32x4*)(o + 3 * 12288) = a3; *(f32x4*)(o + 4 * 12288) = a4;
    }
    if (blockIdx.x == 0) {
        float* rt = (float*)(p.ws + WS_ROPE);
        for (int i = tid; i < 1024; i += NTHR_) { const int pos = i >> 4, j = i & 15; const float inv = exp2f(-(float)j * (13.287712379549449f / 16.0f)); float s_, c_; sincos_small((float)pos * inv, s_, c_); rt[i] = c_; rt[1024 + i] = s_; }
    }
}
__device__ __forceinline__ void ph_mod_reduce(const P& p, int tid) {
    for (int i = blockIdx.x * NTHR_ + tid; i < 2 * 5 * 12288; i += gridDim.x * NTHR_) {
        const int n = i % 12288, l = (i / 12288) / 5; float acc = p.in[14][l * 12288 + n];
#pragma unroll
        for (int kc = 0; kc < MOD_KS; ++kc) acc += ((const float*)(p.ws + WS_MODP))[(size_t)kc * 2 * 5 * 12288 + i];
        ((float*)(p.ws + WS_MOD))[i] = acc;
    }
}

__device__ __forceinline__ void ph_hnorm_rows(const P& p, int l, int which, int r0, int r1, int lane) {
    const bool from_in = (which == 0 && l == 0);
    const float* nw = p.in[which == 0 ? 15 : 16] + l * 2048;
    int ccur = -1; f32x4 A[8], S[8];
    for (int r = r0; r < r1; ++r) {
        const int cnd = cond_of_row(r);
        if (cnd != ccur) { ccur = cnd;
            const float* mod = (const float*)(p.ws + WS_MOD) + ((size_t)l * 5 + cnd) * 12288 + (which == 0 ? 0 : 3 * 2048);
#pragma unroll
            for (int j = 0; j < 8; ++j) { const int c = j * 256 + lane * 4; const f32x4 g = *(const f32x4*)(nw + c), s1 = *(const f32x4*)(mod + 2048 + c); S[j] = *(const f32x4*)(mod + c);
#pragma unroll
                for (int e = 0; e < 4; ++e) A[j][e] = g[e] * (1.0f + s1[e]); } }
        const float* x = x_in(p, r); const bf16_t* xb = (const bf16_t*)(p.ws + WS_X) + (size_t)r * D;
        f32x4 v[8]; float ss = 0.f;
#pragma unroll
        for (int j = 0; j < 8; ++j) {
            if (from_in) v[j] = *(const f32x4*)(x + j * 256 + lane * 4);
            else { const u32x2 w = *(const u32x2*)(xb + j * 256 + lane * 4); v[j] = (f32x4){bf2f(w.x), bf2f(w.x >> 16), bf2f(w.y), bf2f(w.y >> 16)}; }
            ss += v[j][0] * v[j][0] + v[j][1] * v[j][1] + v[j][2] * v[j][2] + v[j][3] * v[j][3]; }
        const float rstd = rsqrtf(wave_sum(ss) * (1.0f / 2048.0f) + 1e-6f);
        bf16_t* o = (bf16_t*)(p.ws + WS_H) + (size_t)r * D;
#pragma unroll
        for (int j = 0; j < 8; ++j) { const int c = j * 256 + lane * 4; float y[4];
#pragma unroll
            for (int e = 0; e < 4; ++e) y[e] = v[j][e] * rstd * A[j][e] + S[j][e];
            u32x2 w; w.x = pk2(y[0], y[1]); w.y = pk2(y[2], y[3]); *(u32x2*)(o + c) = w; }
    }
}

namespace pg8 {
#define PG8_LAS __attribute__((address_space(3)))
typedef unsigned short bf16_t;
typedef short bf16x8 __attribute__((ext_vector_type(8)));
typedef float f32x4 __attribute__((ext_vector_type(4)));
typedef unsigned u32x4 __attribute__((ext_vector_type(4)));
constexpr int BM = 256, BK = 64, HALF = 128, HTB = HALF * BK * 2  , STAGE_BYTES = 8 * HTB, NXCD = 8, WGM = 8;

__host__ __device__ __forceinline__ int lds_byte(int r, int c) { const int st = (r >> 4) * 2 + (c >> 5), rr = r & 15, cc = c & 31, ob = rr * 64 + cc * 2; return st * 1024 + (ob ^ (((ob >> 9) & 1) << 5)); }
__host__ __device__ __forceinline__ void stage_rc(int b, int& R, int& C) { const int st = b / 1024, sb = b % 1024, swz = sb ^ (((sb >> 9) & 1) << 5); R = (st >> 1) * 16 + swz / 64; C = (st & 1) * 32 + (swz % 64) / 2; }
__host__ __device__ __forceinline__ int perm32(int rho) { const int n = rho >> 4, i = rho & 15; return 8 * (i >> 2) + 4 * n + (i & 3); }

struct Unit { int pm, pn; };
struct Gemm { const bf16_t* A; const bf16_t* Bt; int M, N, K; };

struct StaticOrder {
    int nM, nN, nwg, G, c;
    __host__ __device__ void init(int M, int N, int G_, int c_) { nM = M / BM; nN = N / BM; nwg = nM * nN; G = G_; c = c_; }
    __host__ __device__ bool next(int i, Unit& u) const {
        const long L = (long)i * G + c; if (L >= nwg) return false;
        int wgid = (int)L; { const int q = nwg / NXCD, r = nwg % NXCD, xcd = wgid % NXCD, off = wgid / NXCD; wgid = (xcd < r ? xcd * (q + 1) : r * (q + 1) + (xcd - r) * q) + off; }
        const int nig = WGM * nN, gid = wgid / nig, fm = gid * WGM, gsz = (nM - fm) < WGM ? (nM - fm) : WGM;
        u.pm = fm + ((wgid % nig) % gsz); u.pn = (wgid % nig) / gsz; return true;
    }
    __device__ __forceinline__ void a_ready(const Unit&) const {}
    __device__ __forceinline__ void done(const Unit&) const {}
};

__device__ __forceinline__ unsigned cvt_pk_bf16(float lo, float hi) { unsigned r; asm volatile("s_nop 0\n\tv_cvt_pk_bf16_f32 %0, %1, %2" : "=v"(r) : "v"(lo), "v"(hi)); return r; }

template <class Epi, class Sched, bool ALIGN_EPI = false, bool SP2 = false>
__device__ __forceinline__ void gemm_phase(PG8_LAS unsigned char* lds, const Gemm g, const Sched& S, const Epi& E, int tid_in) {
    int tid_l = tid_in; asm volatile("" : "+v"(tid_l));
    const int tid = tid_l, wid = __builtin_amdgcn_readfirstlane(tid >> 6), lane = tid & 63, wr = wid >> 2, wc = wid & 3, fr = lane & 15, fq = lane >> 4;
    const int K = g.K, nt = K / BK;
    unsigned voffA[2], voffB[2];
#pragma unroll
    for (int i = 0; i < 2; ++i) { int R, C; stage_rc(tid * 16 + i * 8192, R, C); const int Rb = Epi::PERM ? ((R & ~31) + perm32(R & 31)) : R;
        voffA[i] = (unsigned)(R * K + C) * 2u; voffB[i] = (unsigned)(Rb * K + C) * 2u; }
    const size_t kstep = (size_t)(BK * 2);
    const size_t hstep = (size_t)HALF * K * 2;
    const size_t tstep = 2 * hstep;
    const unsigned ldsw = (unsigned)wid * 1024u;
    const int aoff = lds_byte(wr * 64 + fr, fq * 8), boff = lds_byte(wc * 32 + fr, fq * 8);
#define PG8_SA(b, h) (((b) * 2 + (h)) * HTB)
#define PG8_SB(b, h) ((4 + (b) * 2 + (h)) * HTB)
#define PG8_STAGE(bufoff, gbase, voff) do { _Pragma("unroll") for (int _i = 0; _i < 2; ++_i) \
        __builtin_amdgcn_global_load_lds((const unsigned*)((const char*)(gbase) + (voff)[_i]), (PG8_LAS unsigned*)(lds + (bufoff) + ldsw + _i * 8192), 16, 0, 0); } while (0)
#define PG8_LDA(dst, b, h) do { _Pragma("unroll") for (int m = 0; m < 4; ++m) _Pragma("unroll") for (int k = 0; k < 2; ++k) dst[m][k] = *(const PG8_LAS bf16x8*)(lds + PG8_SA(b, h) + aoff + m * 2048 + k * 1024); } while (0)
#define PG8_LDB(dst, b, h) do { _Pragma("unroll") for (int n = 0; n < 2; ++n) _Pragma("unroll") for (int k = 0; k < 2; ++k) dst[n][k] = *(const PG8_LAS bf16x8*)(lds + PG8_SB(b, h) + boff + n * 2048 + k * 1024); } while (0)
#define PG8_MMA(ai, bj, At, Bt) do { __builtin_amdgcn_s_setprio(1); _Pragma("unroll") for (int m = 0; m < 4; ++m) _Pragma("unroll") for (int n = 0; n < 2; ++n) _Pragma("unroll") for (int k = 0; k < 2; ++k) \
        acc[ai][bj][m][n] = __builtin_amdgcn_mfma_f32_16x16x32_bf16(Bt[n][k], At[m][k], acc[ai][bj][m][n], 0, 0, 0); __builtin_amdgcn_s_setprio(0); } while (0)
#define PG8_WAIT_V(n) asm volatile("s_waitcnt vmcnt(" #n ")" ::: "memory")
#define PG8_WAIT_L(n) asm volatile("s_waitcnt lgkmcnt(" #n ")" ::: "memory")
#define PG8_BAR __builtin_amdgcn_s_barrier()
#define PG8_SCHED __builtin_amdgcn_sched_barrier(0)
    Unit cur, nxt; int ui = 0;
    if (!S.next(0, cur)) return;
    f32x4 acc[2][2][4][2];
    { float z0 = 0.f; asm volatile("" : "+v"(z0));
#pragma unroll
    for (int a = 0; a < 2; ++a)
#pragma unroll
        for (int b = 0; b < 2; ++b)
#pragma unroll
            for (int m = 0; m < 4; ++m)
#pragma unroll
                for (int n = 0; n < 2; ++n) acc[a][b][m][n] = (f32x4){z0, z0, z0, z0}; }
    bf16x8 At[4][2], B0[2][2], B1[2][2];
    const char* cA = (const char*)g.A + (size_t)cur.pm * tstep; const char* cB = (const char*)g.Bt + (size_t)cur.pn * tstep;
    S.a_ready(cur);
    if constexpr (SP2) {
        PG8_STAGE(PG8_SB(0, 0), cB, voffB); PG8_STAGE(PG8_SB(0, 1), cB + hstep, voffB); PG8_STAGE(PG8_SA(0, 0), cA, voffA); PG8_STAGE(PG8_SA(0, 1), cA + hstep, voffA);
        if (wr == 1) PG8_BAR;
        PG8_WAIT_V(2); PG8_BAR;
        PG8_STAGE(PG8_SB(1, 0), cB + kstep, voffB); PG8_STAGE(PG8_SA(1, 0), cA + kstep, voffA); PG8_STAGE(PG8_SB(1, 1), cB + hstep + kstep, voffB);
        PG8_WAIT_V(6); PG8_BAR;
    } else {
        PG8_STAGE(PG8_SB(0, 0), cB, voffB); PG8_STAGE(PG8_SA(0, 0), cA, voffA); PG8_STAGE(PG8_SB(0, 1), cB + hstep, voffB); PG8_STAGE(PG8_SA(0, 1), cA + hstep, voffA);
        if (wr == 1) PG8_BAR;
        PG8_WAIT_V(4); PG8_BAR;
        PG8_STAGE(PG8_SB(1, 0), cB + kstep, voffB); PG8_STAGE(PG8_SA(1, 0), cA + kstep, voffA); PG8_STAGE(PG8_SB(1, 1), cB + hstep + kstep, voffB);
        PG8_WAIT_V(6); PG8_BAR;
    }
    for (;;) {
        const bool has_next = S.next(ui + 1, nxt);
        const char* nA = has_next ? (const char*)g.A + (size_t)nxt.pm * tstep : cA; const char* nB = has_next ? (const char*)g.Bt + (size_t)nxt.pn * tstep : cB;
        for (int t = 0; t < nt; t += 2) {
            const bool last = (t == nt - 2);
            const char* a1 = cA + (size_t)(t + 1) * kstep;
            const char* a2 = last ? nA : cA + (size_t)(t + 2) * kstep; const char* b2 = last ? nB : cB + (size_t)(t + 2) * kstep;
            const char* a3 = a2 + kstep; const char* b3 = b2 + kstep;
            if (last && has_next) S.a_ready(nxt);
            if constexpr (SP2) {
            PG8_LDB(B0, 0, 0); PG8_LDB(B1, 0, 1); PG8_SCHED; PG8_LDA(At, 0, 0); PG8_STAGE(PG8_SA(1, 1), a1 + hstep, voffA);
            PG8_WAIT_V(8); PG8_WAIT_L(0); PG8_BAR; PG8_MMA(0, 0, At, B0); PG8_MMA(0, 1, At, B1); PG8_BAR; PG8_SCHED;
            PG8_LDA(At, 0, 1); PG8_STAGE(PG8_SB(0, 0), b2, voffB); PG8_STAGE(PG8_SB(0, 1), b2 + hstep, voffB); PG8_STAGE(PG8_SA(0, 0), a2, voffA);
            PG8_WAIT_V(8); PG8_WAIT_L(0); PG8_BAR; PG8_MMA(1, 0, At, B0); PG8_MMA(1, 1, At, B1); PG8_BAR; PG8_SCHED;
            PG8_LDB(B0, 1, 0); PG8_LDB(B1, 1, 1); PG8_SCHED; PG8_LDA(At, 1, 0); PG8_STAGE(PG8_SA(0, 1), a2 + hstep, voffA);
            PG8_WAIT_V(8); PG8_WAIT_L(0); PG8_BAR; PG8_MMA(0, 0, At, B0); PG8_MMA(0, 1, At, B1); PG8_BAR; PG8_SCHED;
            PG8_LDA(At, 1, 1); PG8_STAGE(PG8_SB(1, 0), b3, voffB); PG8_STAGE(PG8_SB(1, 1), b3 + hstep, voffB); PG8_STAGE(PG8_SA(1, 0), a3, voffA);
            PG8_WAIT_V(8); PG8_WAIT_L(0); PG8_BAR; PG8_MMA(1, 0, At, B0); PG8_MMA(1, 1, At, B1); PG8_BAR; PG8_SCHED;
            } else {
            PG8_LDB(B0, 0, 0); PG8_SCHED; PG8_LDA(At, 0, 0); PG8_STAGE(PG8_SA(1, 1), a1 + hstep, voffA);
            PG8_WAIT_L(8); PG8_BAR; PG8_WAIT_L(0); PG8_MMA(0, 0, At, B0); PG8_BAR; PG8_SCHED;
            PG8_LDB(B1, 0, 1); PG8_STAGE(PG8_SB(0, 0), b2, voffB);
            PG8_BAR; PG8_WAIT_L(0); PG8_MMA(0, 1, At, B1); PG8_BAR;
            PG8_LDA(At, 0, 1); PG8_STAGE(PG8_SA(0, 0), a2, voffA);
            PG8_BAR; PG8_WAIT_L(0); PG8_MMA(1, 0, At, B0); PG8_BAR; PG8_SCHED;
            PG8_STAGE(PG8_SB(0, 1), b2 + hstep, voffB);
            PG8_WAIT_V(6); PG8_BAR; PG8_MMA(1, 1, At, B1); PG8_BAR;
            PG8_LDB(B0, 1, 0); PG8_SCHED; PG8_LDA(At, 1, 0); PG8_STAGE(PG8_SA(0, 1), a2 + hstep, voffA);
            PG8_WAIT_L(8); PG8_BAR; PG8_WAIT_L(0); PG8_MMA(0, 0, At, B0); PG8_BAR; PG8_SCHED;
            PG8_LDB(B1, 1, 1); PG8_STAGE(PG8_SB(1, 0), b3, voffB);
            PG8_BAR; PG8_WAIT_L(0); PG8_MMA(0, 1, At, B1); PG8_BAR;
            PG8_LDA(At, 1, 1); PG8_STAGE(PG8_SA(1, 0), a3, voffA);
            PG8_BAR; PG8_WAIT_L(0); PG8_MMA(1, 0, At, B0); PG8_BAR; PG8_SCHED;
            PG8_STAGE(PG8_SB(1, 1), b3 + hstep, voffB);
            PG8_WAIT_V(6); PG8_BAR; PG8_MMA(1, 1, At, B1); PG8_BAR;
            }
        }
        if constexpr (ALIGN_EPI) { if (wr == 0) PG8_BAR; }
        if constexpr (!Epi::AFTER_DRAIN) { E(acc, cur, wr, wc, fr, fq); S.done(cur); }
        if (!has_next) break;
        { float z0 = 0.f; asm volatile("" : "+v"(z0));
#pragma unroll
        for (int a = 0; a < 2; ++a)
#pragma unroll
            for (int b = 0; b < 2; ++b)
#pragma unroll
                for (int m = 0; m < 4; ++m)
#pragma unroll
                    for (int n = 0; n < 2; ++n) acc[a][b][m][n] = (f32x4){z0, z0, z0, z0}; }
        cur = nxt; cA = nA; cB = nB; ++ui;
        if constexpr (ALIGN_EPI) { if (wr == 1) PG8_BAR; }
    }
    PG8_WAIT_V(0);
    if constexpr (!ALIGN_EPI) { if (wr == 0) PG8_BAR; }
    PG8_BAR;
    if constexpr (Epi::AFTER_DRAIN) { E.fused(acc, cur, wr, wc, fr, fq, lds, wid, lane); S.done(cur); }
#undef PG8_SA
#undef PG8_SB
#undef PG8_STAGE
#undef PG8_LDA
#undef PG8_LDB
#undef PG8_MMA
#undef PG8_WAIT_V
#undef PG8_WAIT_L
#undef PG8_BAR
#undef PG8_SCHED
}
}

#define PG8_ROW(ai, m) (u.pm * 256 + (ai) * 128 + wr * 64 + (m) * 16 + fr)
#define PG8_FOR(...) _Pragma("unroll") for (int ai = 0; ai < 2; ++ai) _Pragma("unroll") for (int m = 0; m < 4; ++m) { const int row = PG8_ROW(ai, m); _Pragma("unroll") for (int bj = 0; bj < 2; ++bj) { \
    const int ct = bj * 128 + wc * 32 + 8 * fq; const pg8::f32x4 v0 = acc[ai][bj][m][0], v1 = acc[ai][bj][m][1]; __VA_ARGS__ } }
__device__ __forceinline__ u32x4 pack8(const pg8::f32x4& a, const pg8::f32x4& b) { u32x4 w; w.x = pg8::cvt_pk_bf16(a[0], a[1]); w.y = pg8::cvt_pk_bf16(a[2], a[3]); w.z = pg8::cvt_pk_bf16(b[0], b[1]); w.w = pg8::cvt_pk_bf16(b[2], b[3]); return w; }
__device__ __forceinline__ void unpack8(const u32x4& w, float (&f)[8]) {
#pragma unroll
    for (int i = 0; i < 4; ++i) { f[2 * i] = bf2f(w[i]); f[2 * i + 1] = bf2f(w[i] >> 16); } }

struct Epi8In {
    static constexpr bool PERM = true, AFTER_DRAIN = false;
    unsigned char* ws;
    __device__ __forceinline__ void operator()(const pg8::f32x4 (&acc)[2][2][4][2], const pg8::Unit& u, int wr, int wc, int fr, int fq) const {
        const int pn = u.pn;
        if (pn >= 22 && pn < 25) {
            float* kva = (float*)(ws + WS_KVA);
            PG8_FOR({ float* o = kva + (size_t)row * KVAW + (pn - 22) * 256 + ct; *(pg8::f32x4*)o = v0; *(pg8::f32x4*)(o + 4) = v1; })
            return;
        }
        size_t base; int ldc, c0, mode = 0;
        if (pn < 4) { base = WS_MLQ; ldc = 1024; c0 = pn * 256; }
        else if (pn < 8) { base = WS_MLK; ldc = 1024; c0 = (pn - 4) * 256; mode = 1; }
        else if (pn < 12) { base = WS_MLV; ldc = 1024; c0 = (pn - 8) * 256; }
        else if (pn < 16) { base = WS_MLO; ldc = 1024; c0 = (pn - 12) * 256; mode = 2; }
        else if (pn < 22) { base = WS_MQ; ldc = 1536; c0 = (pn - 16) * 256; mode = 3; }
        else if (pn < 29) { base = WS_S5U; ldc = 1024; c0 = (pn - 25) * 256; }
        else if (pn < 33) { base = WS_DFQ; ldc = 1024; c0 = (pn - 29) * 256; mode = 4; }
        else if (pn < 37) { base = WS_DFK; ldc = 1024; c0 = (pn - 33) * 256; }
        else { base = WS_DFV; ldc = 1024; c0 = (pn - 37) * 256; }
        bf16_t* O = (bf16_t*)(ws + base);
        PG8_FOR({ pg8::f32x4 a = v0, b = v1;
            if (mode == 1) { a = a * 0.0625f; b = b * 0.0625f; }
            if (mode == 3) { a = a * (0.07216878364870322f * 1.4426950408889634f); b = b * (0.07216878364870322f * 1.4426950408889634f); }
            if (mode == 4) { a = a * (0.125f * 1.4426950408889634f); b = b * (0.125f * 1.4426950408889634f); }
            if (mode == 2) {
_Pragma("unroll")
                for (int e = 0; e < 4; ++e) { a[e] = sigmoidf_(a[e]); b[e] = sigmoidf_(b[e]); } }
            *(u32x4*)(O + (size_t)row * ldc + c0 + ct) = pack8(a, b); })
    }
};
struct Epi8Gate {
    static constexpr bool PERM = true, AFTER_DRAIN = false;
    bf16_t* gs;
    __device__ __forceinline__ void operator()(const pg8::f32x4 (&acc)[2][2][4][2], const pg8::Unit& u, int wr, int wc, int fr, int fq) const {
        PG8_FOR({ pg8::f32x4 a, b;
_Pragma("unroll")
            for (int e = 0; e < 4; ++e) { a[e] = sigmoidf_(v0[e]); b[e] = sigmoidf_(v1[e]); }
            *(u32x4*)(gs + (size_t)row * GATE_COLS + u.pn * 256 + ct) = pack8(a, b); })
    }
};
struct Epi8Kvb {
    static constexpr bool PERM = true, AFTER_DRAIN = false;
    bf16_t* kf; bf16_t* vf;
    __device__ __forceinline__ void operator()(const pg8::f32x4 (&acc)[2][2][4][2], const pg8::Unit& u, int wr, int wc, int fr, int fq) const {
        PG8_FOR({ bf16_t* o = bj == 0 ? kf + (size_t)row * 1536 + u.pn * 192 + wc * 32 + 8 * fq : vf + (size_t)row * 1024 + u.pn * 128 + wc * 32 + 8 * fq; (void)ct;
            *(u32x4*)o = pack8(v0, v1); })
    }
};
struct Epi8Glu {
    static constexpr bool PERM = true, AFTER_DRAIN = false;
    const bf16_t* g; bf16_t* y;
    __device__ __forceinline__ void operator()(const pg8::f32x4 (&acc)[2][2][4][2], const pg8::Unit& u, int wr, int wc, int fr, int fq) const {
        PG8_FOR({ const size_t i = (size_t)row * 1024 + u.pn * 256 + ct; float gf[8]; unpack8(*(const u32x4*)(g + i), gf); pg8::f32x4 a, b;
_Pragma("unroll")
            for (int e = 0; e < 4; ++e) { a[e] = gf[e] * sigmoidf_(v0[e]); b[e] = gf[4 + e] * sigmoidf_(v1[e]); }
            *(u32x4*)(y + i) = pack8(a, b); })
    }
};
struct Epi8Merge {
    static constexpr bool PERM = true, AFTER_DRAIN = false;
    const bf16_t* gs; bf16_t* mg; int b; int pad;
    __device__ __forceinline__ void operator()(const pg8::f32x4 (&acc)[2][2][4][2], const pg8::Unit& u, int wr, int wc, int fr, int fq) const {
        PG8_FOR({ const size_t i = (size_t)row * D + u.pn * 256 + ct; float gf[8], pf[8]; unpack8(*(const u32x4*)(gs + (size_t)row * GATE_COLS + b * D + u.pn * 256 + ct), gf);
            if (b) unpack8(*(const u32x4*)(mg + i), pf); else {
_Pragma("unroll")
                for (int e = 0; e < 8; ++e) pf[e] = 0.f; }
            pg8::f32x4 a, c;
_Pragma("unroll")
            for (int e = 0; e < 4; ++e) { a[e] = pf[e] + gf[e] * v0[e]; c[e] = pf[4 + e] + gf[4 + e] * v1[e]; }
            *(u32x4*)(mg + i) = pack8(a, c); })
    }
};
struct Epi8Res {
    static constexpr bool PERM = true, AFTER_DRAIN = false;
    P p; int l; int goff; int from_x; int pad;
    __device__ __forceinline__ void operator()(const pg8::f32x4 (&acc)[2][2][4][2], const pg8::Unit& u, int wr, int wc, int fr, int fq) const {
        bf16_t* X = (bf16_t*)(p.ws + WS_X);
        const float* gv = (const float*)(p.ws + WS_MOD) + ((size_t)l * 5 + cond_of_row(u.pm * 256)) * 12288 + goff + u.pn * 256;
        const bool from_in = (!from_x && l == 0);
        PG8_FOR({ bf16_t* dst = X + (size_t)row * D + u.pn * 256 + ct;
            const pg8::f32x4 g0 = *(const pg8::f32x4*)(gv + ct), g1 = *(const pg8::f32x4*)(gv + ct + 4); pg8::f32x4 s0, s1;
            if (from_in) { const float* src = x_in(p, row) + u.pn * 256 + ct; s0 = *(const pg8::f32x4*)src; s1 = *(const pg8::f32x4*)(src + 4); }
            else { float sf[8]; unpack8(*(const u32x4*)dst, sf); s0 = (pg8::f32x4){sf[0], sf[1], sf[2], sf[3]}; s1 = (pg8::f32x4){sf[4], sf[5], sf[6], sf[7]}; }
            *(u32x4*)dst = pack8(s0 + g0 * v0, s1 + g1 * v1); })
    }
};
struct Epi8FfnIn {
    static constexpr bool PERM = true, AFTER_DRAIN = false;
    bf16_t* hh;
    __device__ __forceinline__ void operator()(const pg8::f32x4 (&acc)[2][2][4][2], const pg8::Unit& u, int wr, int wc, int fr, int fq) const {
_Pragma("unroll")
        for (int ai = 0; ai < 2; ++ai)
_Pragma("unroll")
            for (int m = 0; m < 4; ++m) { const int row = PG8_ROW(ai, m); pg8::f32x4 a, b;
_Pragma("unroll")
                for (int e = 0; e < 4; ++e) { a[e] = siluf_(acc[ai][0][m][0][e]) * acc[ai][1][m][0][e]; b[e] = siluf_(acc[ai][0][m][1][e]) * acc[ai][1][m][1][e]; }
                *(u32x4*)(hh + (size_t)row * FFN + u.pn * 128 + wc * 32 + 8 * fq) = pack8(a, b); }
    }
};

__device__ __forceinline__ int win_row(int n) {
    if (n < 4096) return n;
    if (n < 4112) return 6208 + (n - 4096);
    if (n < 5648) return 4096 + (n - 4112);
    if (n < 6224) return 5632 + (n - 5648);
    if (n < MIX_COLS) return 6400 + (n - 6224);
    return 10496 + (n - MIX_COLS);
}
template <int MAP>
__device__ __forceinline__ void cvt_item(const float* W, int K, int N, bf16_t* WT, int row_off, LAS float* scr, int item, int lane) {
    const int nblk = (N + 31) / 32, kb = item / nblk, nb = item % nblk, k0 = 64 * kb, n0 = 32 * nb;
    const int nl = (lane & 7) * 4, kr = lane >> 3;
    const bool nok = n0 + nl < N;
    const float* wp = W + (size_t)(k0 + kr) * N + n0 + nl;
    f32x4 v[8];
#pragma unroll
    for (int i = 0; i < 8; ++i) v[i] = nok ? *(const f32x4*)(wp + (size_t)(8 * i) * N) : (f32x4){0.f, 0.f, 0.f, 0.f};
#pragma unroll
    for (int i = 0; i < 8; ++i) { LAS float* d = scr + (kr + 8 * i) * 33 + nl; d[0] = v[i][0]; d[1] = v[i][1]; d[2] = v[i][2]; d[3] = v[i][3]; }
    asm volatile("s_waitcnt lgkmcnt(0)" ::: "memory");
    const int c = lane & 7;
#pragma unroll
    for (int j = 0; j < 4; ++j) { const int n = (lane >> 3) + 8 * j; const LAS float* s = scr + (8 * c) * 33 + n;
        u32x4 o; o.x = pk2(s[0 * 33], s[1 * 33]); o.y = pk2(s[2 * 33], s[3 * 33]); o.z = pk2(s[4 * 33], s[5 * 33]); o.w = pk2(s[6 * 33], s[7 * 33]);
        const int ng = n0 + n; int row;
        if (MAP == 0) row = row_off + ng; else if (MAP == 1) row = win_row(ng); else row = (ng < FFN) ? ((ng >> 7) * 256 + (ng & 127)) : (((ng - FFN) >> 7) * 256 + 128 + ((ng - FFN) & 127));
        if (ng < N) *(u32x4*)(WT + (size_t)row * K + k0 + 8 * c) = o; }
    asm volatile("s_waitcnt lgkmcnt(0)" ::: "memory");
}
constexpr size_t WB_IN = 0, WB_KVB = 73 * MiB, WB_GLU = 75 * MiB, WB_BR = 77 * MiB, WB_O = 93 * MiB, WB_FIN = 101 * MiB, WB_FOUT = 145 * MiB, WB_END = 167 * MiB;
constexpr int NIN_T = 18688;
__device__ __forceinline__ void ph_convert(const P& p, int l, int gw, int NGW, int lane, LAS float* scr, const bool early, const bool late) {
    unsigned char* wb = p.ws + WS_WBF;
    constexpr int I_IN = (D / 64) * ((IN_COLS + 31) / 32), I_KVB = (512 / 64) * (2048 / 32), I_GLU = (1024 / 64) * (1024 / 32), I_BR = (1024 / 64) * (2048 / 32), I_O = (D / 64) * (D / 32),
                  I_FIN = (D / 64) * (2 * FFN / 32), I_FOUT = (FFN / 64) * (D / 32);
    constexpr int NIT = I_IN + I_KVB + I_GLU + 4 * I_BR + I_O + I_FIN + I_FOUT;
    const int it_lo = early ? 0 : NIT - I_FOUT, it_hi = late ? NIT : NIT - I_FOUT;
    for (int it = it_lo + gw; it < it_hi; it += NGW) {
        int r = it;
        if (r < I_IN) { cvt_item<1>(p.in[17] + (size_t)l * D * IN_COLS, D, IN_COLS, (bf16_t*)(wb + WB_IN), 0, scr, r, lane); continue; } r -= I_IN;
        if (r < I_KVB) { cvt_item<0>(p.in[21] + (size_t)l * 512 * 2048, 512, 2048, (bf16_t*)(wb + WB_KVB), 0, scr, r, lane); continue; } r -= I_KVB;
        if (r < I_GLU) { cvt_item<0>(p.in[30] + (size_t)l * 1024 * 1024, 1024, 1024, (bf16_t*)(wb + WB_GLU), 0, scr, r, lane); continue; } r -= I_GLU;
        if (r < 4 * I_BR) { const int b = r / I_BR; cvt_item<0>(p.in[33] + ((size_t)l * 4 + b) * 1024 * 2048, 1024, 2048, (bf16_t*)(wb + WB_BR) + (size_t)b * 2048 * 1024, 0, scr, r % I_BR, lane); continue; } r -= 4 * I_BR;
        if (r < I_O) { cvt_item<0>(p.in[34] + (size_t)l * D * D, D, D, (bf16_t*)(wb + WB_O), 0, scr, r, lane); continue; } r -= I_O;
        if (r < I_FIN) { cvt_item<2>(p.in[35] + (size_t)l * D * 2 * FFN, D, 2 * FFN, (bf16_t*)(wb + WB_FIN), 0, scr, r, lane); continue; } r -= I_FIN;
        cvt_item<0>(p.in[36] + (size_t)l * FFN * D, FFN, D, (bf16_t*)(wb + WB_FOUT), 0, scr, r, lane);
    }
    if (early) for (int row = 6224 + gw; row < 6400; row += NGW) { u32x4* o = (u32x4*)((bf16_t*)(wb + WB_IN) + (size_t)row * D); for (int j = lane; j < D / 8; j += 64) o[j] = (u32x4){0u, 0u, 0u, 0u}; }
}


__device__ __forceinline__ int xcd_slot() { const int G_ = (int)gridDim.x, c_ = (int)blockIdx.x; return (G_ % 8 == 0) ? (c_ % 8) * (G_ / 8) + c_ / 8 : c_; }
namespace fa {
typedef short s16x4 __attribute__((ext_vector_type(4)));
__device__ __forceinline__ int crow(int r, int hi) { return (r & 3) + 8 * (r >> 2) + 4 * hi; }
__device__ __forceinline__ unsigned cvtpk(float lo, float hi) { unsigned r; asm volatile("v_cvt_pk_bf16_f32 %0, %1, %2" : "=v"(r) : "v"(lo), "v"(hi)); return r; }
#define FA_SBAR() __builtin_amdgcn_sched_barrier(0)
constexpr float THR = 8.f;
__device__ __forceinline__ void partialSM_fma(f32x16& p0, f32x16& p1, float& m_reg, float& mn, float& alpha, float SCALE) {
    const float C = SCALE * 1.4426950408889634f;
    float pmax = p0[0];
#pragma unroll
    for (int r = 1; r < 16; ++r) pmax = fmaxf(pmax, p0[r]);
#pragma unroll
    for (int r = 0; r < 16; ++r) pmax = fmaxf(pmax, p1[r]);
    { auto rr = __builtin_amdgcn_permlane32_swap(__float_as_uint(pmax), __float_as_uint(pmax), false, false);
      pmax = fmaxf(__uint_as_float(rr[0]), __uint_as_float(rr[1])); }
    if (__builtin_expect(__all(pmax - m_reg <= THR / SCALE), 1)) { mn = m_reg; alpha = 1.f; }
    else { mn = fmaxf(m_reg, pmax); alpha = __builtin_amdgcn_exp2f((m_reg - mn) * C); m_reg = mn; }
    const float mnC = -mn * C;
#pragma unroll
    for (int r = 0; r < 16; ++r) p0[r] = fmaf(p0[r], C, mnC);
#pragma unroll
    for (int r = 0; r < 16; ++r) p1[r] = fmaf(p1[r], C, mnC);
#pragma unroll
    for (int r = 0; r < 16; ++r) p0[r] = __builtin_amdgcn_exp2f(p0[r]);
}
constexpr float THR2 = THR * 1.4426950408889634f;
__device__ __forceinline__ void partialSM(f32x16& p0, f32x16& p1, float& m_reg, f32x16& nm, float& alpha, const bool first) {
    float pmax = p0[0];
#pragma unroll
    for (int r = 1; r < 16; ++r) pmax = fmaxf(pmax, p0[r]);
#pragma unroll
    for (int r = 0; r < 16; ++r) pmax = fmaxf(pmax, p1[r]);
    { auto rr = __builtin_amdgcn_permlane32_swap(__float_as_uint(pmax), __float_as_uint(pmax), false, false);
      pmax = fmaxf(__uint_as_float(rr[0]), __uint_as_float(rr[1])); }
    alpha = 1.f;
    if (first || !__all(pmax <= THR2)) {
        const float d = first ? pmax : fmaxf(pmax, 0.f);
        if (!first) alpha = __builtin_amdgcn_exp2f(-d);
        m_reg += d;
#pragma unroll
        for (int r = 0; r < 16; ++r) { p0[r] -= d; p1[r] -= d; nm[r] = -m_reg; }
    }
#pragma unroll
    for (int r = 0; r < 16; ++r) p0[r] = __builtin_amdgcn_exp2f(p0[r]);
}
__device__ __forceinline__ void finishSM(f32x16& p0, f32x16& p1, float alpha, float& l_reg, bf16x8& pa0, bf16x8& pa1, bf16x8& pa2, bf16x8& pa3) {
#pragma unroll
    for (int r = 0; r < 16; ++r) p1[r] = __builtin_amdgcn_exp2f(p1[r]);
    FA_SBAR(); asm volatile("s_nop 1");
    float ps = 0;
#pragma unroll
    for (int r = 0; r < 16; ++r) ps += p0[r];
#pragma unroll
    for (int r = 0; r < 16; ++r) ps += p1[r];
    { auto rr = __builtin_amdgcn_permlane32_swap(__float_as_uint(ps), __float_as_uint(ps), false, false);
      ps = __uint_as_float(rr[0]) + __uint_as_float(rr[1]); }
    l_reg = l_reg * alpha + ps;
#define FA_PK4(P, BASE, OUT) do { u32x4 w = {cvtpk(P[BASE + 0], P[BASE + 1]), cvtpk(P[BASE + 2], P[BASE + 3]), cvtpk(P[BASE + 4], P[BASE + 5]), cvtpk(P[BASE + 6], P[BASE + 7])}; \
    OUT = *reinterpret_cast<bf16x8*>(&w); } while (0)
    FA_PK4(p0, 0, pa0); FA_PK4(p0, 8, pa1); FA_PK4(p1, 0, pa2); FA_PK4(p1, 8, pa3);
#undef FA_PK4
}
__device__ __forceinline__ int v_rd_base(int lane) { return ((lane & 3) << 3) | (((lane >> 2) & 3) << 6) | (((lane >> 4) & 1) << 5) | (((lane >> 5) & 1) << 8); }
constexpr int v_rd_off(int d0, int ks, int half) { return d0 * 512 + ks * 4096 + half * 2048; }
__device__ __forceinline__ bf16x8 lds_rd128i(unsigned addr, const int off) { bf16x8 r; asm volatile("ds_read_b128 %0, %1 offset:%2" : "=&v"(r) : "v"(addr), "i"(off) : "memory"); return r; }
template <int OFF> __device__ __forceinline__ bf16x8 lds_rd128(unsigned addr) { bf16x8 r; asm volatile("ds_read_b128 %0, %1 offset:%2" : "=&v"(r) : "v"(addr), "i"(OFF) : "memory"); return r; }
template <int OFF> __device__ __forceinline__ s16x4 tr_read(unsigned vb) {
    s16x4 r; asm volatile("ds_read_b64_tr_b16 %0, %1 offset:%2" : "=&v"(r) : "v"(vb), "i"(OFF) : "memory"); return r;
}
template <int D0> __device__ __forceinline__ void pv_one(f32x16& od, unsigned vb, bf16x8 pa0, bf16x8 pa1, bf16x8 pa2, bf16x8 pa3) {
    const s16x4 l0 = tr_read<v_rd_off(D0, 0, 0)>(vb), h0 = tr_read<v_rd_off(D0, 0, 1)>(vb), l1 = tr_read<v_rd_off(D0, 1, 0)>(vb), h1 = tr_read<v_rd_off(D0, 1, 1)>(vb);
    const s16x4 l2 = tr_read<v_rd_off(D0, 2, 0)>(vb), h2 = tr_read<v_rd_off(D0, 2, 1)>(vb), l3 = tr_read<v_rd_off(D0, 3, 0)>(vb), h3 = tr_read<v_rd_off(D0, 3, 1)>(vb);
    asm volatile("s_waitcnt lgkmcnt(0)" ::: "memory"); FA_SBAR();
#define FA_PK(L, H) (bf16x8){L[0], L[1], L[2], L[3], H[0], H[1], H[2], H[3]}
    od = __builtin_amdgcn_mfma_f32_32x32x16_bf16(pa0, FA_PK(l0, h0), od, 0, 0, 0);
    od = __builtin_amdgcn_mfma_f32_32x32x16_bf16(pa1, FA_PK(l1, h1), od, 0, 0, 0);
    od = __builtin_amdgcn_mfma_f32_32x32x16_bf16(pa2, FA_PK(l2, h2), od, 0, 0, 0);
    od = __builtin_amdgcn_mfma_f32_32x32x16_bf16(pa3, FA_PK(l3, h3), od, 0, 0, 0);
#undef FA_PK
}
struct Args { const bf16_t* Q; const bf16_t* K; const bf16_t* V; bf16_t* O; int qpitch, kpitch, vpitch, opitch, nheads, vdiv; float scale; int pad; };

template <int DQK>
__device__ __forceinline__ void attn_phase(LAS unsigned char* lds, const Args& a, int tid) {
    constexpr int KROWB = DQK * 2, KCH = KROWB / 16, KTILE = 64 * KROWB, VTILE = 16384, STAGE = KTILE + VTILE, NKI = KTILE / 8192, NVI = 2, NDMA = NKI + NVI, ND = DQK / 16;
    constexpr int RING = (DQK == 64) ? 4 : 3;
    static_assert(RING * STAGE + 2048 <= 131072, "attention LDS");
    const int wid = __builtin_amdgcn_readfirstlane(tid >> 6), lane = tid & 63, r32 = lane & 31, hi = lane >> 5;
    const int krow = (r32 & ~0xC) | ((r32 & 4) << 1) | ((r32 & 8) >> 1);
    LAS float* wsc = (LAS float*)(lds + RING * STAGE) + wid * 64;
    unsigned koff_[NKI], voff_[NVI];
#pragma unroll
    for (int i = 0; i < NKI; ++i) { const int s = i * 512 + wid * 64 + lane, row = s / KCH, ch = s % KCH; koff_[i] = (unsigned)(row * a.kpitch + (ch ^ ((row & 3) | (((row >> 3) & 1) << 2))) * 8) * 2u; }
#pragma unroll
    for (int i = 0; i < NVI; ++i) { const int o = (i * 512 + wid * 64 + lane) * 16, sub = o >> 9, within = o & 511, kk = (sub >> 2) * 8 + (within >> 6), c = (sub & 3) * 32 + ((within & 63) >> 1);
        const int k = (kk & ~0xC) | ((kk & 4) << 1) | ((kk & 8) >> 1); voff_[i] = (unsigned)(k * a.vpitch + c) * 2u; }
    const unsigned vb0 = (unsigned)(uintptr_t)(lds + KTILE) + (unsigned)v_rd_base(lane);
    const int n_lat = a.nheads * 64, n_units = n_lat + a.nheads * 16;
    for (int u = xcd_slot(); u < n_units; u += gridDim.x) {
        int b, h, q0, nk, kbase, cbase;
        if (u < n_lat) { const int bh = u >> 4, qb = u & 15; b = bh / a.nheads; h = bh % a.nheads; q0 = NCTX + b * LL + qb * 256; nk = LL + PAST; kbase = NCTX + b * LL; cbase = MTOK + b * PAST; }
        else { const int v = u - n_lat; b = v / a.nheads; h = v % a.nheads; q0 = b * CL; nk = CL; kbase = b * CL; cbase = 0; }
        const int NT = nk >> 6, vh = h / a.vdiv;
        const bf16_t* Kh = a.K + h * DQK; const bf16_t* Vh = a.V + vh * 128;
#define FA_ISSUE(j) do { const int t0_ = (j) * 64; const int rb_ = (t0_ < LL || nk == CL) ? kbase + t0_ : cbase + (t0_ - LL); LAS unsigned char* st_ = lds + ((j) % RING) * STAGE; \
        const char* kb_ = (const char*)(Kh + (size_t)rb_ * a.kpitch); const char* vb_ = (const char*)(Vh + (size_t)rb_ * a.vpitch); \
        _Pragma("unroll") for (int i_ = 0; i_ < NKI; ++i_) __builtin_amdgcn_global_load_lds((const unsigned*)(kb_ + koff_[i_]), (LAS unsigned*)(st_ + i_ * 8192 + wid * 1024), 16, 0, 0); \
        _Pragma("unroll") for (int i_ = 0; i_ < NVI; ++i_) __builtin_amdgcn_global_load_lds((const unsigned*)(vb_ + voff_[i_]), (LAS unsigned*)(st_ + KTILE + i_ * 8192 + wid * 1024), 16, 0, 0); } while (0)
        bf16x8 qr[ND];
        { const bf16_t* Qw = a.Q + (size_t)(q0 + wid * 32 + r32) * a.qpitch + h * DQK + hi * 8;
#pragma unroll
          for (int d0 = 0; d0 < ND; ++d0) qr[d0] = *(const bf16x8*)(Qw + d0 * 16); }
        float m_reg = 0.f, l_reg = 0.f; f32x16 o[4], nm;
        float z0 = 0.f; asm volatile("" : "+v"(z0));
#pragma unroll
        for (int d = 0; d < 4; ++d)
#pragma unroll
            for (int r = 0; r < 16; ++r) o[d][r] = z0;
#pragma unroll
        for (int r = 0; r < 16; ++r) nm[r] = z0;
        FA_ISSUE(0); FA_ISSUE(1);
        if constexpr (DQK != 64) { if (NDMA == 5) asm volatile("s_waitcnt vmcnt(5)" ::: "memory"); else asm volatile("s_waitcnt vmcnt(3)" ::: "memory");
            __builtin_amdgcn_s_barrier(); asm volatile("" ::: "memory"); }
        auto tile = [&](const int j) __attribute__((always_inline)) {
            LAS unsigned char* Ks = lds + (j % RING) * STAGE;
            f32x16 p0 = nm, p1 = nm;
            constexpr int KD = (DQK == 64) ? 3 : 2;
            bf16x8 kb[KD][2];
            unsigned kae[4];
#pragma unroll
            for (int e = 0; e < 4; ++e) kae[e] = (unsigned)(uintptr_t)Ks + (unsigned)(krow * KROWB + (((2 * e + hi) ^ ((krow & 3) | (((krow >> 3) & 1) << 2))) << 4));
#define FA_LDK(d0_, s_) do { kb[s_][0] = lds_rd128i(kae[(d0_) & 3], ((d0_) >> 2) * 128); kb[s_][1] = lds_rd128i(kae[(d0_) & 3], 32 * KROWB + ((d0_) >> 2) * 128); } while (0)
#pragma unroll
            for (int d0 = 0; d0 < KD - 1; ++d0) FA_LDK(d0, d0);
#pragma unroll
            for (int d0 = 0; d0 < ND; ++d0) {
                if (d0 + KD - 1 < ND) FA_LDK(d0 + KD - 1, (d0 + KD - 1) % KD);
                const int ahead = (ND - 1 - d0) < (KD - 1) ? (ND - 1 - d0) : (KD - 1);
                if (ahead == 2) asm volatile("s_waitcnt lgkmcnt(4)" ::: "memory"); else if (ahead == 1) asm volatile("s_waitcnt lgkmcnt(2)" ::: "memory"); else asm volatile("s_waitcnt lgkmcnt(0)" ::: "memory");
                FA_SBAR();
                p0 = __builtin_amdgcn_mfma_f32_32x32x16_bf16(kb[d0 % KD][0], qr[d0], p0, 0, 0, 0);
                p1 = __builtin_amdgcn_mfma_f32_32x32x16_bf16(kb[d0 % KD][1], qr[d0], p1, 0, 0, 0);
                FA_SBAR(); }
#undef FA_LDK
            float alpha; partialSM(p0, p1, m_reg, nm, alpha, j == 0);
            if (__any(alpha < 1.f)) { if (hi == 0) wsc[32 + r32] = alpha; asm volatile("s_waitcnt lgkmcnt(0)" ::: "memory");
#pragma unroll
                for (int d = 0; d < 4; ++d)
#pragma unroll
                    for (int r = 0; r < 16; ++r) o[d][r] *= wsc[32 + crow(r, hi)]; }
            bf16x8 pa0, pa1, pa2, pa3; finishSM(p0, p1, alpha, l_reg, pa0, pa1, pa2, pa3); FA_SBAR();
            const unsigned vb = vb0 + (unsigned)((j % RING) * STAGE);
            pv_one<0>(o[0], vb, pa0, pa1, pa2, pa3); pv_one<1>(o[1], vb, pa0, pa1, pa2, pa3); pv_one<2>(o[2], vb, pa0, pa1, pa2, pa3); pv_one<3>(o[3], vb, pa0, pa1, pa2, pa3);
        };
        if constexpr (DQK == 64) {
            asm volatile("s_waitcnt vmcnt(0)" ::: "memory");
            __builtin_amdgcn_s_barrier(); asm volatile("" ::: "memory");
            for (int j = 0; j < NT; j += 2) {
                if (j + 2 < NT) { FA_ISSUE(j + 2); FA_ISSUE(j + 3); }
                tile(j); tile(j + 1);
                asm volatile("s_waitcnt vmcnt(0)" ::: "memory");
                asm volatile("s_waitcnt lgkmcnt(0)" ::: "memory");
                __builtin_amdgcn_s_barrier(); asm volatile("" ::: "memory");
            }
        } else
        for (int j = 0; j < NT; ++j) {
            if (j + 2 < NT) FA_ISSUE(j + 2);
            tile(j);
            if (j + 2 < NT) { if (NDMA == 5) asm volatile("s_waitcnt vmcnt(5)" ::: "memory"); else asm volatile("s_waitcnt vmcnt(3)" ::: "memory"); }
            else asm volatile("s_waitcnt vmcnt(0)" ::: "memory");
            asm volatile("s_waitcnt lgkmcnt(0)" ::: "memory");
            __builtin_amdgcn_s_barrier(); asm volatile("" ::: "memory");
        }
#undef FA_ISSUE
        if (hi == 0) wsc[r32] = l_reg; asm volatile("s_waitcnt lgkmcnt(0)" ::: "memory");
        bf16_t* Ow = a.O + (size_t)(q0 + wid * 32) * a.opitch + h * 128 + r32;
#pragma unroll
        for (int r = 0; r < 16; ++r) { const int orow = crow(r, hi); const float rl = __builtin_amdgcn_rcpf(wsc[orow]);
#pragma unroll
            for (int d0 = 0; d0 < 4; ++d0) Ow[(size_t)orow * a.opitch + d0 * 32] = (bf16_t)f2bf(o[d0][r] * rl); }
        asm volatile("s_waitcnt lgkmcnt(0)" ::: "memory");
    }
}
}


namespace ml {
typedef short s16x4 __attribute__((ext_vector_type(4)));
constexpr int QP = 528, VP = 80, CP = 528, PP = 144;
constexpr size_t WS_SCT = WS_CT, WS_WC = WS_CT + 4 * MiB, WS_DENI = WS_CT + 5 * MiB, WS_KW = WS_CT + 6 * MiB;
__device__ __forceinline__ s16x4 trr(unsigned addr) { s16x4 r; asm volatile("ds_read_b64_tr_b16 %0, %1" : "=&v"(r) : "v"(addr) : "memory"); return r; }
__device__ __forceinline__ unsigned cvtpk(float lo, float hi) { unsigned r; asm volatile("s_nop 0\n\tv_cvt_pk_bf16_f32 %0, %1, %2\n\ts_nop 1" : "=v"(r) : "v"(lo), "v"(hi)); return r; }
__device__ __forceinline__ int crow(int r, int hi) { return (r & 3) + 8 * (r >> 2) + 4 * hi; }
#define ML_BAR() do { asm volatile("s_waitcnt lgkmcnt(0)" ::: "memory"); __builtin_amdgcn_s_barrier(); asm volatile("" ::: "memory"); } while (0)
#define ML_TOK(c, i) (base + (dir ? (L - 1 - ((c) * 64 + (i))) : ((c) * 64 + (i))))
__device__ __forceinline__ float logsig(float g) { return fminf(g, 0.f) - __logf(1.0f + __expf(-fabsf(g))); }

__device__ __forceinline__ void scalars_wg(const P& p, const int l, const int chain, const int wave, const int lane, LAS float* sx) {
    const bool lat = chain >= 128; const int cc = lat ? chain - 128 : chain, b = cc >> 3, h = (cc >> 1) & 3, dir = cc & 1;
    const int L = lat ? LL : CL, base = lat ? NCTX + b * LL : b * CL, NC = L >> 6;
    const float* kva = (const float*)(p.ws + WS_KVA) + 576 + dir * 8 + h;
    const float bi = p.in[18][l * 16 + dir * 8 + h], bf = p.in[18][l * 16 + dir * 8 + 4 + h];
    float li_[8], lf_[8];
#pragma unroll
    for (int j = 0; j < 8; ++j) { const int c = wave + 8 * j; li_[j] = 0.f; lf_[j] = 0.f; if (c < NC) { const float* r_ = kva + (size_t)ML_TOK(c, lane) * KVAW; li_[j] = r_[0] + bi; lf_[j] = r_[4] + bf; } }
    float bb_[8], gg_[8], pm_[8];
#pragma unroll
    for (int j = 0; j < 8; ++j) { const int c = wave + 8 * j;
        float bc = logsig(lf_[j]);
#pragma unroll
        for (int o = 1; o < 64; o <<= 1) { const float t_ = __shfl_up(bc, o); if (lane >= o) bc += t_; }
        const float g = li_[j] - bc; float pm = g;
#pragma unroll
        for (int o = 1; o < 64; o <<= 1) { const float t_ = __shfl_up(pm, o); if (lane >= o) pm = fmaxf(pm, t_); }
        bb_[j] = bc; gg_[j] = g; pm_[j] = pm;
        if (lane == 63) { sx[c] = (c < NC) ? bc : 0.f; sx[64 + c] = (c < NC) ? bc + pm : -1e30f; } }
    __syncthreads();
    float al = sx[lane], be = sx[64 + lane];
#pragma unroll
    for (int o = 1; o < 64; o <<= 1) { const float ea = __shfl_up(al, o), eb = __shfl_up(be, o); if (lane >= o) { be = fmaxf(eb + al, be); al = ea + al; } }
    float m0 = 0.f; if (lat) m0 = p.in[8][(size_t)((b * 2 + l) * 2 + dir) * 4 + h];
    const float pa = __shfl_up(al, 1), pb = __shfl_up(be, 1);
    const float mst_all = lane == 0 ? m0 : fmaxf(m0 + pa, pb);
    if (!lat && wave == 0 && lane == NC - 1) p.out[O_MM + ((b * 2 + l) * 2 + dir) * 4 + h] = fmaxf(m0 + al, be);
    f32x4* sct = (f32x4*)(p.ws + WS_SCT);
#pragma unroll
    for (int j = 0; j < 8; ++j) { const int c = wave + 8 * j;
        const float m_st = __shfl(mst_all, c & 63);
        if (c < NC) { const float mxl = fmaxf(m_st, __shfl(pm_[j], 63)), mx = fmaxf(m_st, pm_[j]);
            sct[((size_t)ML_TOK(c, lane) * 2 + dir) * 4 + h] = (f32x4){__expf(pm_[j] - mx), __expf(m_st - mx), __expf(-(bb_[j] + mx)), __expf(gg_[j] - mxl)};
            if (lane == 0) ((float*)(p.ws + WS_WC))[chain * 64 + c] = __expf(m_st - mxl); } }
    __syncthreads();
}

constexpr int B_Q = 0, B_K = 33792, B_V = 67584, B_P = 101376, B_S = 110592, B_END = 112640;
__device__ __forceinline__ void intra_phase(LAS unsigned char* lds, const P& p, const int l, const int tid) {
    const int wid = __builtin_amdgcn_readfirstlane(tid >> 6), lane = tid & 63, r32 = lane & 31, hi = lane >> 5;
    const bf16_t* MQ_ = (const bf16_t*)(p.ws + WS_MLQ); const bf16_t* MK_ = (const bf16_t*)(p.ws + WS_MLK); const bf16_t* MV_ = (const bf16_t*)(p.ws + WS_MLV);
    LAS float* sg = (LAS float*)(lds + B_S); LAS float* spm = sg + 64; LAS float* sws = sg + 128; LAS float* sd0 = sg + 192; LAS float* sd1 = sg + 256;
    const unsigned ldsb = (unsigned)(uintptr_t)lds;
    const int tq = (lane & 15) >> 2, tp = lane & 3, tc0 = 16 * ((lane >> 4) & 1) + 4 * tp;
    u32x4 q4[4], k4[4], v4[4]; float gli = 0.f, glf = 0.f, gws = 0.f;
#define B_DECODE(uu) const bool lat = (uu) < 2048; const int chain = lat ? 128 + ((uu) >> 6) : ((uu) - 2048) >> 2, c = lat ? ((uu) & 63) : (((uu) - 2048) & 3); \
        const int cc = lat ? chain - 128 : chain, b = cc >> 3, h = (cc >> 1) & 3, dir = cc & 1; const int L = lat ? LL : CL, base = lat ? NCTX + b * LL : b * CL;
#define B_LOAD(uu) do { B_DECODE(uu) (void)chain; \
        _Pragma("unroll") for (int i = 0; i < 4; ++i) { const int ch = tid + 512 * i, row = ch >> 5, c16 = ch & 31; const size_t g_ = (size_t)ML_TOK(c, row) * 1024 + h * 256 + c16 * 8; \
            q4[i] = *(const u32x4*)(MQ_ + g_); k4[i] = *(const u32x4*)(MK_ + g_); v4[i] = *(const u32x4*)(MV_ + g_); } \
        if (wid == 7) { const int row = ML_TOK(c, lane); const float* r_ = (const float*)(p.ws + WS_KVA) + (size_t)row * KVAW + 576 + dir * 8 + h; \
            gli = r_[0] + p.in[18][l * 16 + dir * 8 + h]; glf = r_[4] + p.in[18][l * 16 + dir * 8 + 4 + h]; gws = ((const f32x4*)(p.ws + WS_SCT))[((size_t)row * 2 + dir) * 4 + h][3]; } } while (0)
    if ((int)blockIdx.x < 2560) B_LOAD((int)blockIdx.x);
    for (int u = blockIdx.x; u < 2560; u += gridDim.x) {
        B_DECODE(u)
        bf16_t* Hout = (bf16_t*)(p.ws + (dir ? WS_HB : WS_HF));
#pragma unroll
        for (int i = 0; i < 4; ++i) { const int ch = tid + 512 * i, row = ch >> 5, c16 = ch & 31;
            *(LAS u32x4*)(lds + B_Q + row * QP + c16 * 16) = q4[i]; *(LAS u32x4*)(lds + B_K + row * QP + c16 * 16) = k4[i]; *(LAS u32x4*)(lds + B_V + row * QP + c16 * 16) = v4[i]; }
        if (wid == 7) {
            float bc = logsig(glf);
#pragma unroll
            for (int o = 1; o < 64; o <<= 1) { const float t_ = __shfl_up(bc, o); if (lane >= o) bc += t_; }
            const float g = gli - bc; float pm = g;
#pragma unroll
            for (int o = 1; o < 64; o <<= 1) { const float t_ = __shfl_up(pm, o); if (lane >= o) pm = fmaxf(pm, t_); }
            sg[lane] = g; spm[lane] = pm; sws[lane] = gws;
        }
        if (u + (int)gridDim.x < 2560) B_LOAD(u + (int)gridDim.x);
        ML_BAR();
        if (wid < 3) {
            const int tb = wid == 0 ? 0 : 1, sb = wid == 2 ? 1 : 0, t = tb * 32 + r32;
            f32x16 p0; { float z0 = 0.f; asm volatile("" : "+v"(z0));
#pragma unroll
              for (int r = 0; r < 16; ++r) p0[r] = z0; }
#pragma unroll 4
            for (int ks = 0; ks < 16; ++ks) { const int cb = (ks * 16 + hi * 8) * 2;
                const bf16x8 qf = *(const LAS bf16x8*)(lds + B_Q + t * QP + cb), kf = *(const LAS bf16x8*)(lds + B_K + (sb * 32 + r32) * QP + cb);
                p0 = __builtin_amdgcn_mfma_f32_32x32x16_bf16(kf, qf, p0, 0, 0, 0); }
            const float mpm = -spm[t]; float dsum = 0.f;
#pragma unroll
            for (int r = 0; r < 16; ++r) { const int s = sb * 32 + crow(r, hi); const float w = (s <= t) ? __expf(sg[s] + mpm) : 0.f; p0[r] *= w; dsum += p0[r]; }
            { auto rr = __builtin_amdgcn_permlane32_swap(__float_as_uint(dsum), __float_as_uint(dsum), false, false); dsum = __uint_as_float(rr[0]) + __uint_as_float(rr[1]); }
            if (hi == 0) { if (sb == 0) sd0[t] = dsum; else sd1[r32] = dsum; }
#pragma unroll
            for (int i = 0; i < 4; ++i) { u32x2 w; w.x = cvtpk(p0[4 * i], p0[4 * i + 1]); w.y = cvtpk(p0[4 * i + 2], p0[4 * i + 3]);
                *(LAS u32x2*)(lds + B_P + t * PP + (sb * 32 + 8 * i + 4 * hi) * 2) = w; }
        } else if (wid >= 4) {
            const int k = tid - 256; float acc = 0.f;
#pragma unroll 8
            for (int s = 0; s < 64; ++s) acc += sws[s] * bf2f(*(const LAS unsigned short*)(lds + B_K + s * QP + k * 2));
            ((float*)(p.ws + WS_KW))[((size_t)chain * 64 + c) * 256 + k] = acc;
        }
        ML_BAR();
        {
            f32x16 h0, h1; { float z0 = 0.f; asm volatile("" : "+v"(z0));
#pragma unroll
              for (int r = 0; r < 16; ++r) { h0[r] = z0; h1[r] = z0; } }
#pragma unroll
            for (int ks = 0; ks < 4; ++ks) {
                const unsigned va = ldsb + B_V + (16 * ks + 8 * hi + tq) * QP + (wid * 32 + tc0) * 2;
                const s16x4 lo = trr(va), hh = trr(va + 4 * QP);
                const bf16x8 a1 = *(const LAS bf16x8*)(lds + B_P + (32 + r32) * PP + (ks * 16 + hi * 8) * 2);
                bf16x8 a0 = a1; if (ks < 2) a0 = *(const LAS bf16x8*)(lds + B_P + r32 * PP + (ks * 16 + hi * 8) * 2);
                asm volatile("s_waitcnt lgkmcnt(0)" ::: "memory"); __builtin_amdgcn_sched_barrier(0);
                const bf16x8 vf = (bf16x8){lo[0], lo[1], lo[2], lo[3], hh[0], hh[1], hh[2], hh[3]};
                if (ks < 2) h0 = __builtin_amdgcn_mfma_f32_32x32x16_bf16(a0, vf, h0, 0, 0, 0);
                h1 = __builtin_amdgcn_mfma_f32_32x32x16_bf16(a1, vf, h1, 0, 0, 0); }
#pragma unroll
            for (int r = 0; r < 16; ++r) { const int t0 = crow(r, hi);
                Hout[(size_t)ML_TOK(c, t0) * 1024 + h * 256 + wid * 32 + r32] = (bf16_t)f2bf(h0[r]); Hout[(size_t)ML_TOK(c, 32 + t0) * 1024 + h * 256 + wid * 32 + r32] = (bf16_t)f2bf(h1[r]); }
            if (tid < 64) ((float*)(p.ws + WS_DENI))[((size_t)ML_TOK(c, tid) * 2 + dir) * 4 + h] = sd0[tid] + (tid >= 32 ? sd1[tid - 32] : 0.f);
        }
        ML_BAR();
    }
}

constexpr int L_Q = 0, L_K = 33792, L_V = 67584, L_CT = 72704, L_SC = 89600, L_NQ = 95744, L_N = 96256, L_PART = 98304, L_END = 114688;
__device__ __forceinline__ void seq_phase(LAS unsigned char* lds, const P& p, const int l, const int tid) {
    const int wid = __builtin_amdgcn_readfirstlane(tid >> 6), lane = tid & 63, r32 = lane & 31, hi = lane >> 5;
    const bf16_t* MQ_ = (const bf16_t*)(p.ws + WS_MLQ); const bf16_t* MK_ = (const bf16_t*)(p.ws + WS_MLK); const bf16_t* MV_ = (const bf16_t*)(p.ws + WS_MLV);
    const unsigned ldsb = (unsigned)(uintptr_t)lds;
    const int tq = (lane & 15) >> 2, tp = lane & 3, tc0 = 16 * ((lane >> 4) & 1) + 4 * tp;
    for (int u = xcd_slot(); u < 1280; u += gridDim.x) {
        const bool lat = u < 256; const int uu = lat ? u : u - 256, cc = uu >> 3, sl = uu & 7, chain = lat ? 128 + cc : cc;
        const int b = cc >> 3, h = (cc >> 1) & 3, dir = cc & 1;
        const int L = lat ? LL : CL, base = lat ? NCTX + b * LL : b * CL, NC = L >> 6;
        const int colq = h * 256, colv = h * 256 + sl * 32;
        bf16_t* Hout = (bf16_t*)(p.ws + (dir ? WS_HB : WS_HF));
        f32x16 ct, ia;
        { float z0 = 0.f; asm volatile("" : "+v"(z0));
#pragma unroll
          for (int r = 0; r < 16; ++r) { ct[r] = z0; ia[r] = z0; } }
        LAS float* nb0 = (LAS float*)(lds + L_N); LAS float* nb1 = nb0 + 256;
        if (lat) {
            const size_t so = (size_t)((b * 2 + l) * 2 + dir) * 4 + h;
            const float* c0 = p.in[6] + so * 65536 + (size_t)(sl * 32 + r32) * 256 + wid * 32 + 4 * hi;
#pragma unroll
            for (int i = 0; i < 4; ++i) { const f32x4 v4 = *(const f32x4*)(c0 + 8 * i); ct[4 * i] = v4[0]; ct[4 * i + 1] = v4[1]; ct[4 * i + 2] = v4[2]; ct[4 * i + 3] = v4[3]; }
            if (tid < 256) nb0[tid] = p.in[7][so * 256 + tid];
        } else if (tid < 256) nb0[tid] = 0.f;
        u32x4 pq[4], pk[4], pv; pv = (u32x4){0u, 0u, 0u, 0u}; f32x4 psc = {0.f, 0.f, 0.f, 0.f}; float pdi = 0.f, pwc = 0.f, pkw = 0.f; unsigned hpre[16];
#pragma unroll
        for (int r = 0; r < 16; ++r) hpre[r] = 0u;
#define ML_HPRE(cc_) do { _Pragma("unroll") for (int rr = 0; rr < 8; ++rr) hpre[rr] = Hout[(size_t)ML_TOK(cc_, (wid & 1) * 32 + crow(8 * (wid >> 1) + rr, hi)) * 1024 + colv + r32]; } while (0)
#define ML_LOAD(c) do { _Pragma("unroll") for (int i_ = 0; i_ < 4; ++i_) { const int ch_ = tid + 512 * i_, row_ = ch_ >> 5, c16_ = ch_ & 31; const size_t g_ = (size_t)ML_TOK(c, row_) * 1024 + colq + c16_ * 8; \
            pq[i_] = *(const u32x4*)(MQ_ + g_); pk[i_] = *(const u32x4*)(MK_ + g_); } \
        if (tid < 256) { const int row_ = tid >> 2, c16_ = tid & 3; pv = *(const u32x4*)(MV_ + (size_t)ML_TOK(c, row_) * 1024 + colv + c16_ * 8); } \
        else pkw = ((const float*)(p.ws + WS_KW))[((size_t)chain * 64 + (c)) * 256 + tid - 256]; \
        if (wid == 0) { const size_t ix_ = ((size_t)ML_TOK(c, lane) * 2 + dir) * 4 + h; psc = ((const f32x4*)(p.ws + WS_SCT))[ix_]; pdi = ((const float*)(p.ws + WS_DENI))[ix_]; pwc = ((const float*)(p.ws + WS_WC))[chain * 64 + (c)]; } } while (0)
#define ML_WRITE(cc_) do { _Pragma("unroll") for (int i_ = 0; i_ < 4; ++i_) { const int ch_ = tid + 512 * i_, row_ = ch_ >> 5, c16_ = ch_ & 31; \
            *(LAS u32x4*)(lds + L_Q + row_ * QP + c16_ * 16) = pq[i_]; *(LAS u32x4*)(lds + L_K + row_ * QP + c16_ * 16) = pk[i_]; } \
        if (tid < 256) { const int row_ = tid >> 2, c16_ = tid & 3; *(LAS u32x4*)(lds + L_V + row_ * VP + c16_ * 16) = pv; } \
        if (wid == 0) { LAS float* S_ = (LAS float*)(lds + L_SC + ((cc_) % 3) * 2048); S_[lane] = psc[0]; S_[64 + lane] = psc[1]; S_[128 + lane] = psc[2]; S_[192 + lane] = psc[3]; S_[256 + lane] = pdi; if (lane == 0) S_[320] = pwc; } } while (0)
#define ML_CTB() do { _Pragma("unroll") for (int i_ = 0; i_ < 4; ++i_) { u32x2 w_; w_.x = cvtpk(ct[4 * i_], ct[4 * i_ + 1]); w_.y = cvtpk(ct[4 * i_ + 2], ct[4 * i_ + 3]); \
            *(LAS u32x2*)(lds + L_CT + r32 * CP + (wid * 32 + 8 * i_ + 4 * hi) * 2) = w_; } } while (0)
#define ML_COMB(cc_) do { const int tb_ = wid & 1, kh_ = wid >> 1; const LAS float* S_ = (const LAS float*)(lds + L_SC + ((cc_) % 3) * 2048); const LAS float* NQ_ = (const LAS float*)(lds + L_NQ + ((cc_) & 1) * 256); \
            const LAS float* PT_ = (const LAS float*)(lds + L_PART + (((cc_) & 1) * 4 + (wid ^ 2)) * 2048); \
            _Pragma("unroll") for (int rr = 0; rr < 8; ++rr) { const int r = 8 * kh_ + rr, tt = tb_ * 32 + crow(r, hi); bf16_t* hp_ = Hout + (size_t)ML_TOK(cc_, tt) * 1024 + colv + r32; \
                const float rr_ = S_[tt], wi = S_[64 + tt], den = rr_ * S_[256 + tt] + wi * NQ_[tt], it_ = (kh_ ? ia[8 + rr] : ia[rr]) + PT_[rr * 64 + lane]; \
                *hp_ = (bf16_t)f2bf((rr_ * bf2f(hpre[rr]) + wi * it_) * __builtin_amdgcn_rcpf(fmaxf(fabsf(den), S_[128 + tt]))); } } while (0)
        float kwc = 0.f;
        ML_LOAD(0); ML_WRITE(0); ML_CTB(); kwc = pkw;
        int nsel = 0;
        for (int c = 0; c < NC; ++c) {
            ML_BAR();
            LAS float* ncur = nsel ? nb1 : nb0; LAS float* nnxt = nsel ? nb0 : nb1;
            const LAS float* SC = (const LAS float*)(lds + L_SC + (c % 3) * 2048);
            if (c + 1 < NC) ML_LOAD(c + 1);
            const float w_c = SC[320];
            if (wid < 4) {
                if (c > 0) ML_COMB(c - 1);
                ML_HPRE(c);
                const int tb = wid & 1, kh = wid >> 1;
                { float z0 = 0.f; asm volatile("" : "+v"(z0));
#pragma unroll
                  for (int r = 0; r < 16; ++r) ia[r] = z0; }
#pragma unroll
                for (int k1 = 0; k1 < 8; ++k1) { const int cb0 = ((kh * 8 + k1) * 16 + hi * 8) * 2;
                    const bf16x8 qf0 = *(const LAS bf16x8*)(lds + L_Q + (tb * 32 + r32) * QP + cb0), cf0 = *(const LAS bf16x8*)(lds + L_CT + r32 * CP + cb0);
                    ia = __builtin_amdgcn_mfma_f32_32x32x16_bf16(qf0, cf0, ia, 0, 0, 0); }
                { LAS float* PW = (LAS float*)(lds + L_PART + ((c & 1) * 4 + wid) * 2048);
#pragma unroll
                  for (int rr = 0; rr < 8; ++rr) PW[rr * 64 + lane] = kh ? ia[rr] : ia[8 + rr]; }
            } else if (wid >= 4) {
                const int j = tid - 256, t = j >> 2, part = j & 3;
                float acc = 0.f;
#pragma unroll
                for (int i = 0; i < 8; ++i) { const u32x4 qv = *(const LAS u32x4*)(lds + L_Q + t * QP + (part * 64 + i * 8) * 2);
                    const f32x4 n0 = *(const LAS f32x4*)(ncur + part * 64 + i * 8), n1 = *(const LAS f32x4*)(ncur + part * 64 + i * 8 + 4);
                    acc += bf2f(qv[0]) * n0[0] + bf2f(qv[0] >> 16) * n0[1] + bf2f(qv[1]) * n0[2] + bf2f(qv[1] >> 16) * n0[3] + bf2f(qv[2]) * n1[0] + bf2f(qv[2] >> 16) * n1[1] + bf2f(qv[3]) * n1[2] + bf2f(qv[3] >> 16) * n1[3]; }
                acc += __shfl_xor(acc, 1); acc += __shfl_xor(acc, 2);
                if (part == 0) ((LAS float*)(lds + L_NQ + (c & 1) * 256))[t] = acc;
                nnxt[j] = w_c * ncur[j] + kwc;
            }
            { f32x16 cc = ct;
#pragma unroll
              for (int r = 0; r < 16; ++r) cc[r] *= w_c;
#pragma unroll
              for (int ks = 0; ks < 4; ++ks) {
                const unsigned ka = ldsb + L_K + (16 * ks + 8 * hi + tq) * QP + (wid * 32 + tc0) * 2, va = ldsb + L_V + (16 * ks + 8 * hi + tq) * VP + tc0 * 2;
                const s16x4 kl = trr(ka), kh = trr(ka + 4 * QP), vl = trr(va), vh = trr(va + 4 * VP);
                const f32x4 wa = *(const LAS f32x4*)(SC + 192 + 16 * ks + 8 * hi), wb = *(const LAS f32x4*)(SC + 192 + 16 * ks + 8 * hi + 4);
                asm volatile("s_waitcnt lgkmcnt(0)" ::: "memory"); __builtin_amdgcn_sched_barrier(0);
                u32x4 vw; vw.x = cvtpk(bf2f((unsigned short)vl[0]) * wa[0], bf2f((unsigned short)vl[1]) * wa[1]); vw.y = cvtpk(bf2f((unsigned short)vl[2]) * wa[2], bf2f((unsigned short)vl[3]) * wa[3]);
                vw.z = cvtpk(bf2f((unsigned short)vh[0]) * wb[0], bf2f((unsigned short)vh[1]) * wb[1]); vw.w = cvtpk(bf2f((unsigned short)vh[2]) * wb[2], bf2f((unsigned short)vh[3]) * wb[3]);
                const bf16x8 kf = (bf16x8){kl[0], kl[1], kl[2], kl[3], kh[0], kh[1], kh[2], kh[3]};
                cc = __builtin_amdgcn_mfma_f32_32x32x16_bf16(kf, *reinterpret_cast<bf16x8*>(&vw), cc, 0, 0, 0); }
              ct = cc; }
            ML_BAR();
            if (c + 1 < NC) { ML_WRITE(c + 1); kwc = pkw; }
            ML_CTB();
            nsel ^= 1;
        }
        if (wid < 4) ML_COMB(NC - 1);
        if (!lat) {
            const size_t so = (size_t)((b * 2 + l) * 2 + dir) * 4 + h;
            float* oc = p.out + O_MC + so * 65536 + (size_t)(sl * 32 + r32) * 256 + wid * 32 + 4 * hi;
#pragma unroll
            for (int i = 0; i < 4; ++i) *(f32x4*)(oc + 8 * i) = (f32x4){ct[4 * i], ct[4 * i + 1], ct[4 * i + 2], ct[4 * i + 3]};
            if (sl == 0) { LAS float* nfin = nsel ? nb1 : nb0; if (tid < 256) p.out[O_MN + so * 256 + tid] = nfin[tid]; }
        }
        ML_BAR();
#undef ML_LOAD
#undef ML_WRITE
#undef ML_CTB
#undef ML_COMB
#undef ML_HPRE
    }
}
#undef ML_BAR
#undef ML_TOK
#undef B_LOAD
#undef B_DECODE
}


namespace s5 {
typedef short s16x4 __attribute__((ext_vector_type(4)));
__device__ __forceinline__ s16x4 trr(unsigned addr) { s16x4 r; asm volatile("ds_read_b64_tr_b16 %0, %1" : "=&v"(r) : "v"(addr) : "memory"); return r; }
__device__ __forceinline__ unsigned cvtpk(float lo, float hi) { unsigned r; asm volatile("s_nop 0\n\tv_cvt_pk_bf16_f32 %0, %1, %2\n\ts_nop 1" : "=v"(r) : "v"(lo), "v"(hi)); return r; }
template <bool FULL>
__device__ __forceinline__ void scan_seg(const P& p, const int l, LAS unsigned char* T, const int g, const int dir, const bool lat, const int b0, const int lane, const int blk0, const int nblk,
                                         const float (&ar)[2], const float (&ai)[2], const bf16x8 (&bb)[4], float (&sr)[2], float (&si)[2]) {
    const int r32 = lane & 31, hh = lane >> 5;
    const int L = lat ? LL : CL;
    const int baseA = lat ? NCTX + b0 * LL : b0 * CL, baseB = baseA + L;
    const size_t pg = (size_t)(l * 2 + dir) * 64 + g;
    bf16x8 cm[8];
    if (FULL) {
#pragma unroll
        for (int ks = 0; ks < 8; ++ks) { u32x4 w = {0u, 0u, 0u, 0u};
            if (r32 < 16) { const int k0 = 16 * ks + 8 * hh; const float* src = (k0 < 64 ? p.in[27] : p.in[28]) + (pg * 16 + r32) * 64 + (k0 & 63); const float sg = k0 < 64 ? 1.f : -1.f;
#pragma unroll
                for (int j = 0; j < 4; ++j) w[j] = cvtpk(sg * src[2 * j], sg * src[2 * j + 1]); }
            cm[ks] = *reinterpret_cast<bf16x8*>(&w); } }
    const int urow_tok = 4 * (r32 >> 3) + (r32 & 3), urow_base = ((r32 >> 2) & 1) ? baseB : baseA;
    const bf16_t* U = (const bf16_t*)(p.ws + WS_S5U) + g * 16 + 8 * hh;
    bf16_t* Yo2 = (bf16_t*)(p.ws + (dir ? WS_YS5B : WS_YS5F)) + g * 16;
#define S5_POS(n, j) (dir ? (L - 1 - ((n) * 16 + (j))) : ((n) * 16 + (j)))
    bf16x8 ucur[4], unxt[4];
#pragma unroll
    for (int i = 0; i < 4; ++i) { ucur[i] = *(const bf16x8*)(U + (size_t)(urow_base + S5_POS(blk0 + i, urow_tok)) * 1024); unxt[i] = ucur[i]; }
    const unsigned tb = (unsigned)(uintptr_t)T;
    const int tq = (lane & 15) >> 2, tp = lane & 3, tc0 = 16 * ((lane >> 4) & 1) + 4 * tp;
    for (int n4 = blk0; n4 < blk0 + nblk; n4 += 4) {
        if (n4 + 4 < blk0 + nblk) {
#pragma unroll
            for (int i = 0; i < 4; ++i) unxt[i] = *(const bf16x8*)(U + (size_t)(urow_base + S5_POS(n4 + 4 + i, urow_tok)) * 1024); }
#pragma unroll
      for (int i4 = 0; i4 < 4; ++i4) { const int n = n4 + i4; const bf16x8 ucur1 = ucur[i4];
        f32x16 acc[4]; { float z0 = 0.f; asm volatile("" : "+v"(z0));
#pragma unroll
          for (int q = 0; q < 4; ++q)
#pragma unroll
              for (int r = 0; r < 16; ++r) acc[q][r] = z0; }
#pragma unroll
        for (int q = 0; q < 4; ++q) acc[q] = __builtin_amdgcn_mfma_f32_32x32x16_bf16(ucur1, bb[q], acc[q], 0, 0, 0);
#pragma unroll
        for (int pb = 0; pb < 2; ++pb) { float xr = sr[pb], xi = si[pb]; const float a_r = ar[pb], a_i = ai[pb];
#pragma unroll
            for (int r = 0; r < 16; ++r) { const float nr_ = a_r * xr - a_i * xi + acc[pb][r], ni_ = a_r * xi + a_i * xr + acc[2 + pb][r]; xr = nr_; xi = ni_; acc[pb][r] = nr_; acc[2 + pb][r] = ni_; }
            sr[pb] = xr; si[pb] = xi; }
        if (FULL) {
#pragma unroll
        for (int q = 0; q < 4; ++q)
#pragma unroll
            for (int a4 = 0; a4 < 4; ++a4) { u32x2 w; w.x = cvtpk(acc[q][4 * a4], acc[q][4 * a4 + 1]); w.y = cvtpk(acc[q][4 * a4 + 2], acc[q][4 * a4 + 3]);
                *(LAS u32x2*)(T + (q * 32 + r32) * 64 + 16 * a4 + 8 * hh) = w; }
        f32x16 y, y2; { float z0 = 0.f; asm volatile("" : "+v"(z0));
#pragma unroll
          for (int r = 0; r < 16; ++r) { y[r] = z0; y2[r] = z0; } }
        { s16x4 lo_[8], hi_[8];
#pragma unroll
          for (int ks = 0; ks < 8; ++ks) { const unsigned ta = tb + (16 * ks + 8 * hh + tq) * 64 + tc0 * 2; lo_[ks] = trr(ta); hi_[ks] = trr(ta + 4 * 64); }
          asm volatile("s_waitcnt lgkmcnt(0)" ::: "memory"); __builtin_amdgcn_sched_barrier(0);
#pragma unroll
          for (int ks = 0; ks < 8; ks += 2) {
            const bf16x8 af0 = (bf16x8){lo_[ks][0], lo_[ks][1], lo_[ks][2], lo_[ks][3], hi_[ks][0], hi_[ks][1], hi_[ks][2], hi_[ks][3]};
            const bf16x8 af1 = (bf16x8){lo_[ks + 1][0], lo_[ks + 1][1], lo_[ks + 1][2], lo_[ks + 1][3], hi_[ks + 1][0], hi_[ks + 1][1], hi_[ks + 1][2], hi_[ks + 1][3]};
            y = __builtin_amdgcn_mfma_f32_32x32x16_bf16(cm[ks], af0, y, 0, 0, 0);
            y2 = __builtin_amdgcn_mfma_f32_32x32x16_bf16(cm[ks + 1], af1, y2, 0, 0, 0); }
#pragma unroll
          for (int r = 0; r < 16; ++r) y[r] += y2[r]; }
        {
          bf16_t* yo = Yo2 + (size_t)(urow_base + S5_POS(n, urow_tok)) * 1024 + 4 * hh;
          u32x2 w0, w1; w0.x = cvtpk(y[0], y[1]); w0.y = cvtpk(y[2], y[3]); w1.x = cvtpk(y[4], y[5]); w1.y = cvtpk(y[6], y[7]);
          *(u32x2*)yo = w0; *(u32x2*)(yo + 8) = w1; }
        }
      }
#pragma unroll
        for (int i = 0; i < 4; ++i) ucur[i] = unxt[i];
    }
#undef S5_POS
}
__device__ __forceinline__ void params(const P& p, const int l, const int g, const int dir, const int lane, float (&ar)[2], float (&ai)[2], bf16x8 (&bb)[4]) {
    const int r32 = lane & 31, hh = lane >> 5; const size_t pg = (size_t)(l * 2 + dir) * 64 + g;
    const float dt = __expf(p.in[24][pg]);
#pragma unroll
    for (int pb = 0; pb < 2; ++pb) { const int pp = pb * 32 + r32;
        const float lr = fminf(p.in[22][pg * 64 + pp], -1e-4f), li = p.in[23][pg * 64 + pp];
        const float mag = __expf(dt * lr); float sn, cs; sincos_small(dt * li, sn, cs);
        const float a_r = mag * cs, a_i = mag * sn, den = lr * lr + li * li, nr = a_r - 1.0f, ni = a_i, qr = (nr * lr + ni * li) / den, qi = (ni * lr - nr * li) / den;
        ar[pb] = a_r; ai[pb] = a_i;
        const float* br = p.in[25] + (pg * 64 + pp) * 16 + 8 * hh; const float* bi = p.in[26] + (pg * 64 + pp) * 16 + 8 * hh;
        u32x4 wr, wi;
#pragma unroll
        for (int j = 0; j < 4; ++j) { const float r0 = qr * br[2 * j] - qi * bi[2 * j], r1 = qr * br[2 * j + 1] - qi * bi[2 * j + 1], i0 = qr * bi[2 * j] + qi * br[2 * j], i1 = qr * bi[2 * j + 1] + qi * br[2 * j + 1];
            wr[j] = cvtpk(r0, r1); wi[j] = cvtpk(i0, i1); }
        bb[pb] = *reinterpret_cast<bf16x8*>(&wr); bb[2 + pb] = *reinterpret_cast<bf16x8*>(&wi); }
}
__device__ __forceinline__ void ctx_unit(const P& p, const int l, LAS unsigned char* T, const int u, const int lane) {
    const int dir = u & 1, g = (u >> 1) & 63, b0 = 2 * (u >> 7), r32 = lane & 31, hh = lane >> 5;
    float ar[2], ai[2]; bf16x8 bb[4]; params(p, l, g, dir, lane, ar, ai, bb);
    float sr[2] = {0.f, 0.f}, si[2] = {0.f, 0.f};
    scan_seg<true>(p, l, T, g, dir, false, b0, lane, 0, CL / 16, ar, ai, bb, sr, si);
#pragma unroll
    for (int pb = 0; pb < 2; ++pb) { const size_t so = ((size_t)(((b0 + hh) * 2 + l) * 2 + dir) * 64 + g) * 64 + pb * 32 + r32; p.out[O_SR + so] = sr[pb]; p.out[O_SI + so] = si[pb]; }
}
__device__ __forceinline__ void lat_unit(const P& p, const int l, LAS unsigned char* lds, const int u, const int wave, const int lane) {
    const int dir = u & 1, g = (u >> 1) & 63, b0 = 2 * (u >> 7), r32 = lane & 31, hh = lane >> 5;
    LAS unsigned char* T = lds + wave * 8192; LAS float* X = (LAS float*)(lds + 65536);
    float ar[2], ai[2]; bf16x8 bb[4]; params(p, l, g, dir, lane, ar, ai, bb);
    float sr[2] = {0.f, 0.f}, si[2] = {0.f, 0.f};
    if (wave == 0) {
#pragma unroll
        for (int pb = 0; pb < 2; ++pb) { const size_t so = ((size_t)(((b0 + hh) * 2 + l) * 2 + dir) * 64 + g) * 64 + pb * 32 + r32; sr[pb] = p.in[9][so]; si[pb] = p.in[10][so]; } }
    const float s0r[2] = {sr[0], sr[1]}, s0i[2] = {si[0], si[1]};
    constexpr int SEGB = LL / 16 / 8;
    if (wave < 7) scan_seg<false>(p, l, T, g, dir, true, b0, lane, wave * SEGB, SEGB, ar, ai, bb, sr, si);
#pragma unroll
    for (int pb = 0; pb < 2; ++pb) { X[(wave * 4 + pb) * 64 + lane] = sr[pb]; X[(wave * 4 + 2 + pb) * 64 + lane] = si[pb]; }
    __syncthreads();
    float pr[2], pi[2];
#pragma unroll
    for (int pb = 0; pb < 2; ++pb) { float xr = ar[pb], xi = ai[pb];
#pragma unroll
        for (int k = 0; k < 9; ++k) { const float nr = xr * xr - xi * xi, ni = 2.f * xr * xi; xr = nr; xi = ni; }
        pr[pb] = xr; pi[pb] = xi; }
    float cr[2], ci[2];
    if (wave == 0) { cr[0] = s0r[0]; cr[1] = s0r[1]; ci[0] = s0i[0]; ci[1] = s0i[1]; }
    else {
#pragma unroll
        for (int pb = 0; pb < 2; ++pb) { float xr = X[(0 * 4 + pb) * 64 + lane], xi = X[(0 * 4 + 2 + pb) * 64 + lane];
            for (int j = 1; j < wave; ++j) { const float er = X[(j * 4 + pb) * 64 + lane], ei = X[(j * 4 + 2 + pb) * 64 + lane];
                const float nr = pr[pb] * xr - pi[pb] * xi + er, ni = pr[pb] * xi + pi[pb] * xr + ei; xr = nr; xi = ni; }
            cr[pb] = xr; ci[pb] = xi; } }
    scan_seg<true>(p, l, T, g, dir, true, b0, lane, wave * SEGB, SEGB, ar, ai, bb, cr, ci);
    __syncthreads();
}
__device__ __forceinline__ void combine_row(const P& p, const int l, const int r, const int lane) {
    const bf16_t* yf = (const bf16_t*)(p.ws + WS_YS5F) + (size_t)r * 1024; const bf16_t* yb = (const bf16_t*)(p.ws + WS_YS5B) + (size_t)r * 1024; const bf16_t* uu = (const bf16_t*)(p.ws + WS_S5U) + (size_t)r * 1024;
    bf16_t* o = (bf16_t*)(p.ws + WS_HB) + (size_t)r * 1024; const float* dv = p.in[29] + l * 1024;
#pragma unroll
    for (int j = 0; j < 2; ++j) { const int c = j * 512 + lane * 8; float a[8], b[8], u[8];
        { const u32x4 w = *(const u32x4*)(yf + c);
#pragma unroll
          for (int i = 0; i < 4; ++i) { a[2 * i] = bf2f(w[i]); a[2 * i + 1] = bf2f(w[i] >> 16); } }
        { const u32x4 w = *(const u32x4*)(yb + c);
#pragma unroll
          for (int i = 0; i < 4; ++i) { b[2 * i] = bf2f(w[i]); b[2 * i + 1] = bf2f(w[i] >> 16); } }
        { const u32x4 w = *(const u32x4*)(uu + c);
#pragma unroll
          for (int i = 0; i < 4; ++i) { u[2 * i] = bf2f(w[i]); u[2 * i + 1] = bf2f(w[i] >> 16); } }
        const f32x4 d0 = *(const f32x4*)(dv + c), d1 = *(const f32x4*)(dv + c + 4);
        float gq[8];
#pragma unroll
        for (int i = 0; i < 8; ++i) gq[i] = gelu_tanh(a[i] + b[i] + (i < 4 ? d0[i] : d1[i - 4]) * u[i]);
        u32x4 w; w.x = pk2(gq[0], gq[1]); w.y = pk2(gq[2], gq[3]); w.z = pk2(gq[4], gq[5]); w.w = pk2(gq[6], gq[7]);
        *(u32x4*)(o + c) = w; }
}
}

__device__ __forceinline__ float rope_lane(float x, int lane, int prow, int pcol, const float* rt) {
    const int part = lane >> 5, jj = lane & 31, idx = jj & 15, pos = part ? pcol : prow;
    const float c = rt[pos * 16 + idx], s = rt[1024 + pos * 16 + idx];
    const float o = __shfl_xor(x, 16);
    return (jj >= 16) ? (x * c + o * s) : (x * c - o * s);
}
__device__ __forceinline__ u32x4 rope8(const u32x4 x, const int d0  , const int prow, const int pcol, const float* rt, const int pmask) {
    const int part = d0 >> 5, jj = d0 & 31, idx0 = jj & 15, pos = part ? pcol : prow; const bool second = jj >= 16;
    u32x4 o, y;
#pragma unroll
    for (int i = 0; i < 4; ++i) o[i] = __shfl_xor(x[i], pmask);
    const f32x4 c0 = *(const f32x4*)(rt + pos * 16 + idx0), c1 = *(const f32x4*)(rt + pos * 16 + idx0 + 4), s0 = *(const f32x4*)(rt + 1024 + pos * 16 + idx0), s1 = *(const f32x4*)(rt + 1024 + pos * 16 + idx0 + 4);
#pragma unroll
    for (int i = 0; i < 4; ++i) { const float ca = i < 2 ? c0[2 * i] : c1[2 * i - 4], cb = i < 2 ? c0[2 * i + 1] : c1[2 * i - 3], sa = i < 2 ? s0[2 * i] : s1[2 * i - 4], sb = i < 2 ? s0[2 * i + 1] : s1[2 * i - 3];
        const float xa = bf2f(x[i]), xb = bf2f(x[i] >> 16), oa = bf2f(o[i]), ob = bf2f(o[i] >> 16);
        y[i] = second ? pk2(xa * ca + oa * sa, xb * cb + ob * sb) : pk2(xa * ca - oa * sa, xb * cb - ob * sb); }
    return y;
}
__device__ __forceinline__ void ph_prep_row(const P& p, int l, int r, int lane) {
    unsigned char* ws = p.ws;
    bf16_t* ckvn = (bf16_t*)(ws + WS_CKVN) + (size_t)r * 512;
    bf16_t* kf = (bf16_t*)(ws + WS_KFULL) + (size_t)r * 1536;
    bf16_t* dfk = (bf16_t*)(ws + WS_DFK) + (size_t)r * 1024;
    bf16_t* dfv = (bf16_t*)(ws + WS_DFV) + (size_t)r * 1024;
    if (r >= MTOK) {
        const int i = r - MTOK, b = i >> 8, t = i & 255; const size_t cr = (size_t)(b * 2 + l) * PAST + t;
        { const float* cc = p.in[2] + cr * 512 + lane * 8; const f32x4 a = *(const f32x4*)cc, c = *(const f32x4*)(cc + 4);
          u32x4 w; w.x = pk2(a[0], a[1]); w.y = pk2(a[2], a[3]); w.z = pk2(c[0], c[1]); w.w = pk2(c[2], c[3]); *(u32x4*)(ckvn + lane * 8) = w; }
        const float kr = p.in[3][cr * 64 + lane];
#pragma unroll
        for (int h = 0; h < 8; ++h) kf[h * 192 + 128 + lane] = (bf16_t)f2bf(kr);
        const float* ck = p.in[4] + cr * 1024 + lane * 16; const float* cv = p.in[5] + cr * 1024 + lane * 16;
#pragma unroll
        for (int j = 0; j < 2; ++j) { const f32x4 a = *(const f32x4*)(ck + 8 * j), c = *(const f32x4*)(ck + 8 * j + 4), d = *(const f32x4*)(cv + 8 * j), e = *(const f32x4*)(cv + 8 * j + 4);
            u32x4 w; w.x = pk2(a[0], a[1]); w.y = pk2(a[2], a[3]); w.z = pk2(c[0], c[1]); w.w = pk2(c[2], c[3]); *(u32x4*)(dfk + lane * 16 + 8 * j) = w;
            u32x4 v; v.x = pk2(d[0], d[1]); v.y = pk2(d[2], d[3]); v.z = pk2(e[0], e[1]); v.w = pk2(e[2], e[3]); *(u32x4*)(dfv + lane * 16 + 8 * j) = v; }
        return;
    }
    const float* kva = (const float*)(ws + WS_KVA) + (size_t)r * KVAW;
    const bool ctx = r < NCTX;
    const int cb = r >> 8, ct = r & 255;
    const int t = (r - NCTX) & 4095, prow = t >> 6, pcol = t & 63;
    const float* rt = (const float*)(ws + WS_ROPE);
    const f32x4 ka = *(const f32x4*)(kva + lane * 8), kb = *(const f32x4*)(kva + lane * 8 + 4);
    float kr = kva[512 + lane];
    const float graw = lane < 16 ? kva[576 + lane] + p.in[18][l * 16 + lane] : 0.f;
    bf16_t* mq = (bf16_t*)(ws + WS_MQ) + (size_t)r * 1536 + (lane >> 3) * 192 + 128 + (lane & 7) * 8;
    bf16_t* dfq = (bf16_t*)(ws + WS_DFQ) + (size_t)r * 1024 + lane * 16;
    u32x4 xq = {0u, 0u, 0u, 0u}, xd0 = xq, xd1 = xq, xk0 = xq, xk1 = xq, xv0 = xq, xv1 = xq;
    if (!ctx) { xq = *(const u32x4*)mq; xd0 = *(const u32x4*)dfq; xd1 = *(const u32x4*)(dfq + 8); }
    xk0 = *(const u32x4*)(dfk + lane * 16); xk1 = *(const u32x4*)(dfk + lane * 16 + 8);
    if (ctx) { xv0 = *(const u32x4*)(dfv + lane * 16); xv1 = *(const u32x4*)(dfv + lane * 16 + 8); }
    { float ss = ka[0] * ka[0] + ka[1] * ka[1] + ka[2] * ka[2] + ka[3] * ka[3] + kb[0] * kb[0] + kb[1] * kb[1] + kb[2] * kb[2] + kb[3] * kb[3];
      const float rstd = rsqrtf(wave_sum(ss) * (1.0f / 512.0f) + 1e-6f);
      const float* g = p.in[20] + l * 512 + lane * 8; const f32x4 g0 = *(const f32x4*)g, g1 = *(const f32x4*)(g + 4);
      const f32x4 y0 = ka * rstd * g0, y1 = kb * rstd * g1;
      u32x4 w; w.x = pk2(y0[0], y0[1]); w.y = pk2(y0[2], y0[3]); w.z = pk2(y1[0], y1[1]); w.w = pk2(y1[2], y1[3]); *(u32x4*)(ckvn + lane * 8) = w;
      if (ctx) { float* o = p.out + O_CKV + ((size_t)(cb * 2 + l) * CL + ct) * 512 + lane * 8; *(f32x4*)o = y0; *(f32x4*)(o + 4) = y1; } }
    { if (ctx) p.out[O_KR + ((size_t)(cb * 2 + l) * CL + ct) * 64 + lane] = kr; else kr = rope_lane(kr, lane, prow, pcol, rt);
#pragma unroll
      for (int h = 0; h < 8; ++h) kf[h * 192 + 128 + lane] = (bf16_t)f2bf(kr); }
    if (lane < 16) { const float o = ((lane >> 2) & 1) ? (fminf(graw, 0.f) - __logf(1.0f + __expf(-fabsf(graw)))) : graw; ((float*)(ws + WS_GATES))[(size_t)r * 16 + lane] = o; }
    if (ctx) {
        float* ok = p.out + O_DK + ((size_t)(cb * 2 + l) * CL + ct) * 1024 + lane * 16; float* ov = p.out + O_DV + ((size_t)(cb * 2 + l) * CL + ct) * 1024 + lane * 16;
#pragma unroll
        for (int i = 0; i < 4; ++i) { *(f32x2_*)(ok + 2 * i) = (f32x2_){bf2f(xk0[i]), bf2f(xk0[i] >> 16)}; *(f32x2_*)(ok + 8 + 2 * i) = (f32x2_){bf2f(xk1[i]), bf2f(xk1[i] >> 16)};
            *(f32x2_*)(ov + 2 * i) = (f32x2_){bf2f(xv0[i]), bf2f(xv0[i] >> 16)}; *(f32x2_*)(ov + 8 + 2 * i) = (f32x2_){bf2f(xv1[i]), bf2f(xv1[i] >> 16)}; }
    } else {
        *(u32x4*)mq = rope8(xq, (lane & 7) * 8, prow, pcol, rt, 2);
        const int q = lane & 3;
        *(u32x4*)dfq = rope8(xd0, q * 16, prow, pcol, rt, 1); *(u32x4*)(dfq + 8) = rope8(xd1, q * 16 + 8, prow, pcol, rt, 1);
        *(u32x4*)(dfk + lane * 16) = rope8(xk0, q * 16, prow, pcol, rt, 1); *(u32x4*)(dfk + lane * 16 + 8) = rope8(xk1, q * 16 + 8, prow, pcol, rt, 1);
    }
}

__device__ __forceinline__ void ph_ml_combine_row(const P& p, int l, int r, int lane) {
    bf16_t* hf = (bf16_t*)(p.ws + WS_HF) + (size_t)r * 1024 + lane * 4; const bf16_t* hb = (const bf16_t*)(p.ws + WS_HB) + (size_t)r * 1024 + lane * 4;
    const bf16_t* so = (const bf16_t*)(p.ws + WS_MLO) + (size_t)r * 1024 + lane * 4; const float* g = p.in[19] + l * 1024 + lane * 4;
    u32x2 a[4], b[4], c[4]; f32x4 gg[4];
#pragma unroll
    for (int h = 0; h < 4; ++h) { a[h] = *(const u32x2*)(hf + h * 256); b[h] = *(const u32x2*)(hb + h * 256); c[h] = *(const u32x2*)(so + h * 256); gg[h] = *(const f32x4*)(g + h * 256); }
#pragma unroll
    for (int h = 0; h < 4; ++h) { float v[4];
        v[0] = bf2f(a[h].x) + bf2f(b[h].x); v[1] = bf2f(a[h].x >> 16) + bf2f(b[h].x >> 16); v[2] = bf2f(a[h].y) + bf2f(b[h].y); v[3] = bf2f(a[h].y >> 16) + bf2f(b[h].y >> 16);
        const float rstd = rsqrtf(wave_sum(v[0] * v[0] + v[1] * v[1] + v[2] * v[2] + v[3] * v[3]) * (1.0f / 256.0f) + 1e-6f);
        u32x2 w; w.x = pk2(v[0] * rstd * gg[h][0] * bf2f(c[h].x), v[1] * rstd * gg[h][1] * bf2f(c[h].x >> 16)); w.y = pk2(v[2] * rstd * gg[h][2] * bf2f(c[h].y), v[3] * rstd * gg[h][3] * bf2f(c[h].y >> 16));
        *(u32x2*)(hf + h * 256) = w; }
}

__device__ __forceinline__ void ph_df_combine_row(const P& p, int l, float lam_init, float lam, int r, int lane) {
    const int h = lane >> 3, part = lane & 7;
    const bf16_t* o = (const bf16_t*)(p.ws + WS_DFO) + (size_t)r * 2048 + h * 256 + part * 16;
    const u32x4 a0 = *(const u32x4*)o, a1 = *(const u32x4*)(o + 8), b0 = *(const u32x4*)(o + 128), b1 = *(const u32x4*)(o + 136);
    const float* g = p.in[32] + l * 128 + part * 16;
    float v[16]; float ss = 0.f;
#pragma unroll
    for (int i = 0; i < 4; ++i) { v[2 * i] = bf2f(a0[i]) - lam * bf2f(b0[i]); v[2 * i + 1] = bf2f(a0[i] >> 16) - lam * bf2f(b0[i] >> 16); v[8 + 2 * i] = bf2f(a1[i]) - lam * bf2f(b1[i]); v[9 + 2 * i] = bf2f(a1[i] >> 16) - lam * bf2f(b1[i] >> 16); }
#pragma unroll
    for (int i = 0; i < 16; ++i) ss += v[i] * v[i];
    ss += __shfl_xor(ss, 1); ss += __shfl_xor(ss, 2); ss += __shfl_xor(ss, 4);
    const float sc = rsqrtf(ss * (1.0f / 128.0f) + 1e-6f) * (1.0f - lam_init);
    u32x4 w0, w1;
#pragma unroll
    for (int i = 0; i < 4; ++i) { w0[i] = pk2(v[2 * i] * sc * g[2 * i], v[2 * i + 1] * sc * g[2 * i + 1]); w1[i] = pk2(v[8 + 2 * i] * sc * g[8 + 2 * i], v[9 + 2 * i] * sc * g[9 + 2 * i]); }
    bf16_t* y = (bf16_t*)(p.ws + WS_DFQ) + (size_t)r * 1024 + h * 128 + part * 16;
    *(u32x4*)y = w0; *(u32x4*)(y + 8) = w1;
}
__device__ __forceinline__ void ph_final_row(const P& p, int r, int lane) {
    const bf16_t* xb = (const bf16_t*)(p.ws + WS_X) + (size_t)r * D; const float* g = p.in[37];
    f32x4 v[8]; float ss = 0.f;
#pragma unroll
    for (int j = 0; j < 8; ++j) { const u32x2 w = *(const u32x2*)(xb + j * 256 + lane * 4); v[j] = (f32x4){bf2f(w.x), bf2f(w.x >> 16), bf2f(w.y), bf2f(w.y >> 16)}; ss += v[j][0] * v[j][0] + v[j][1] * v[j][1] + v[j][2] * v[j][2] + v[j][3] * v[j][3]; }
    const float rstd = rsqrtf(wave_sum(ss) * (1.0f / 2048.0f) + 1e-6f);
    float* o = p.out + (r < NCTX ? O_YP + (size_t)r * D : O_YS + (size_t)(r - NCTX) * D);
#pragma unroll
    for (int j = 0; j < 8; ++j) { const int c = j * 256 + lane * 4; const f32x4 gg = *(const f32x4*)(g + c); *(f32x4*)(o + c) = v[j] * rstd * gg; }
}

__device__ __forceinline__ void load_args(P& p) {
#if defined(__HIP_DEVICE_COMPILE__)
    const __attribute__((address_space(4))) unsigned long long* q = (const __attribute__((address_space(4))) unsigned long long*)__builtin_amdgcn_kernarg_segment_ptr();
    asm volatile("" : "+s"(q));
#pragma unroll
    for (int i = 0; i < 38; ++i) p.in[i] = (const float*)q[i];
    p.out = (float*)q[38]; p.ws = (unsigned char*)q[39];
#endif
}
constexpr int NTHR = 512, LDS_BYTES = 147456, MISC_OFF = 131072;
#ifndef PROBE
#define PROBE 0
#endif
#ifndef PROBE_MASK_D
#define PROBE_MASK_D 0u
#endif
#ifndef PROBE_MASK_A
#define PROBE_MASK_A 0u
#endif
#define PROBE_MULT 10
#define PROBE_ADIV 100.0f
#define STAMP(idx) do { if (PROBE) { if (blockIdx.x == 0 && bar.w == 0u && lane_id_() == 0u) ((LAS unsigned long long*)((LAS unsigned char*)lds + MISC_OFF + 2048))[idx] = __builtin_amdgcn_s_memrealtime(); } } while (0)
#define GRID_BAR() do { XcdBarrier b_ = bar; asm volatile("" : "+s"(b_.x)); xcd_barrier(b_); } while (0)

#define PH_VARS P p; load_args(p); unsigned char* ws = p.ws; (void)ws; int tid_ = (int)(bar.w * 64u + lane_id_()); asm volatile("" : "+v"(tid_)); const int lane = tid_ & 63, wave = __builtin_amdgcn_readfirstlane(tid_ >> 6), half = tid_ >> 8, vt = tid_ & 255; \
    const int gw = blockIdx.x * 8 + wave, vb = blockIdx.x * 2 + half; (void)lane; (void)half; (void)vt; (void)gw; (void)vb;

template <int l>
__device__ __forceinline__ void run_layer(unsigned char* lds, const XcdBarrier& bar, const int G, const int NGW) {
        { PH_VARS ph_convert(p, l, gw, NGW, lane, (LAS float*)((LAS unsigned char*)lds + wave * 16384), l == 0, true); }
        { PH_VARS const int per_ = (MTOK + NGW - 1) / NGW, r0_ = gw * per_; ph_hnorm_rows(p, l, 0, r0_, r0_ + per_ < MTOK ? r0_ + per_ : MTOK, lane); }
        GRID_BAR(); STAMP(1 + 17 * l + 1);
        { PH_VARS pg8::Gemm g{(const bf16_t*)(ws + WS_H), (const bf16_t*)(ws + WS_WBF + WB_IN), MTOK, 10496, D}; pg8::StaticOrder S; S.init(MTOK, 10496, G, (int)blockIdx.x);
          pg8::gemm_phase<Epi8In, pg8::StaticOrder, true, true>((LAS unsigned char*)lds, g, S, Epi8In{ws}, tid_); }
        GRID_BAR(); STAMP(1 + 17 * l + 2);
        { PH_VARS for (int ch = blockIdx.x; ch < 160; ch += G) ml::scalars_wg(p, l, ch, wave, lane, (LAS float*)((LAS unsigned char*)lds)); for (int r = gw; r < MALL; r += NGW) ph_prep_row(p, l, r, lane); }
        GRID_BAR(); STAMP(1 + 17 * l + 3);
        { PH_VARS pg8::Gemm g{(const bf16_t*)(ws + WS_CKVN), (const bf16_t*)(ws + WS_WBF + WB_KVB), MALL, 2048, 512}; pg8::StaticOrder S; S.init(MALL, 2048, G, (int)blockIdx.x);
          pg8::gemm_phase<Epi8Kvb, pg8::StaticOrder, true, true>((LAS unsigned char*)lds, g, S, Epi8Kvb{(bf16_t*)(ws + WS_KFULL), (bf16_t*)(ws + WS_VFULL)}, tid_); }
        STAMP(1 + 17 * l + 4);
        { PH_VARS ml::intra_phase((LAS unsigned char*)lds, p, l, tid_); }
        GRID_BAR();
        { PH_VARS ml::seq_phase((LAS unsigned char*)lds, p, l, tid_); }
        GRID_BAR(); STAMP(1 + 17 * l + 5);
        { PH_VARS
          for (int u = xcd_slot(); u < 256; u += G) { int ln_ = lane; asm volatile("" : "+v"(ln_)); s5::lat_unit(p, l, (LAS unsigned char*)lds, u, wave, ln_); }
          if (wave < 4) { for (int u = wave * G + blockIdx.x; u < 1024; u += 4 * G) s5::ctx_unit(p, l, (LAS unsigned char*)lds + wave * 8192, u, lane); }
          else { for (int r = blockIdx.x * 4 + (wave - 4); r < MTOK; r += G * 4) ph_ml_combine_row(p, l, r, lane); } }
        GRID_BAR(); STAMP(1 + 17 * l + 6);
        { PH_VARS for (int r = gw; r < MTOK; r += NGW) s5::combine_row(p, l, r, lane); }
        GRID_BAR(); STAMP(1 + 17 * l + 7);
        { PH_VARS pg8::Gemm g{(const bf16_t*)(ws + WS_HB), (const bf16_t*)(ws + WS_WBF + WB_GLU), MTOK, 1024, 1024}; pg8::StaticOrder S; S.init(MTOK, 1024, G, (int)blockIdx.x);
          pg8::gemm_phase<Epi8Glu, pg8::StaticOrder, true, true>((LAS unsigned char*)lds, g, S, Epi8Glu{(const bf16_t*)(ws + WS_HB), (bf16_t*)(ws + WS_S5U)}, tid_); }
        STAMP(1 + 17 * l + 8);
        { PH_VARS fa::Args aa{(const bf16_t*)(ws + WS_MQ), (const bf16_t*)(ws + WS_KFULL), (const bf16_t*)(ws + WS_VFULL), (bf16_t*)(ws + WS_MLQ), 1536, 1536, 1024, 1024, 8, 1, 0.07216878364870322f, 0};
          fa::attn_phase<192>((LAS unsigned char*)lds, aa, tid_); }
        STAMP(1 + 17 * l + 9);
        { PH_VARS fa::Args aa{(const bf16_t*)(ws + WS_DFQ), (const bf16_t*)(ws + WS_DFK), (const bf16_t*)(ws + WS_DFV), (bf16_t*)(ws + WS_DFO), 1024, 1024, 1024, 2048, 16, 2, 0.125f, 0};
          fa::attn_phase<64>((LAS unsigned char*)lds, aa, tid_); }
        GRID_BAR(); STAMP(1 + 17 * l + 10);
        { PH_VARS const float lam_init = (l == 0) ? 0.2f : 0.35550906759096927f;
          const float* lp = p.in[31] + l * 256;
          const float lam = __expf(wave_sum(lp[lane] * lp[64 + lane])) - __expf(wave_sum(lp[128 + lane] * lp[192 + lane])) + lam_init;
          for (int r = gw; r < MTOK; r += NGW) ph_df_combine_row(p, l, lam_init, lam, r, lane); }
        GRID_BAR(); STAMP(1 + 17 * l + 11);
        { PH_VARS pg8::Gemm g{(const bf16_t*)(ws + WS_H), (const bf16_t*)(ws + WS_WBF + WB_IN) + (size_t)10496 * D, MTOK, GATE_COLS, D}; pg8::StaticOrder S; S.init(MTOK, GATE_COLS, G, (int)blockIdx.x);
          pg8::gemm_phase<Epi8Gate, pg8::StaticOrder, true, true>((LAS unsigned char*)lds, g, S, Epi8Gate{(bf16_t*)(ws + WS_GS)}, tid_); }
        GRID_BAR(); STAMP(1 + 17 * l + 12);
        { PH_VARS pg8::Gemm g{(const bf16_t*)(ws + WS_HF), (const bf16_t*)(ws + WS_WBF + WB_BR) + (size_t)0 * 2048 * 1024, MTOK, D, 1024}; pg8::StaticOrder S; S.init(MTOK, D, G, (int)blockIdx.x);
          pg8::gemm_phase<Epi8Merge, pg8::StaticOrder, true, true>((LAS unsigned char*)lds, g, S, Epi8Merge{(const bf16_t*)(ws + WS_GS), (bf16_t*)(ws + WS_H), 0, 0}, tid_); }
        { PH_VARS pg8::Gemm g{(const bf16_t*)(ws + WS_MLQ), (const bf16_t*)(ws + WS_WBF + WB_BR) + (size_t)1 * 2048 * 1024, MTOK, D, 1024}; pg8::StaticOrder S; S.init(MTOK, D, G, (int)blockIdx.x);
          pg8::gemm_phase<Epi8Merge, pg8::StaticOrder, true, true>((LAS unsigned char*)lds, g, S, Epi8Merge{(const bf16_t*)(ws + WS_GS), (bf16_t*)(ws + WS_H), 1, 0}, tid_); }
        { PH_VARS pg8::Gemm g{(const bf16_t*)(ws + WS_S5U), (const bf16_t*)(ws + WS_WBF + WB_BR) + (size_t)2 * 2048 * 1024, MTOK, D, 1024}; pg8::StaticOrder S; S.init(MTOK, D, G, (int)blockIdx.x);
          pg8::gemm_phase<Epi8Merge, pg8::StaticOrder, true, true>((LAS unsigned char*)lds, g, S, Epi8Merge{(const bf16_t*)(ws + WS_GS), (bf16_t*)(ws + WS_H), 2, 0}, tid_); }
        { PH_VARS pg8::Gemm g{(const bf16_t*)(ws + WS_DFQ), (const bf16_t*)(ws + WS_WBF + WB_BR) + (size_t)3 * 2048 * 1024, MTOK, D, 1024}; pg8::StaticOrder S; S.init(MTOK, D, G, (int)blockIdx.x);
          pg8::gemm_phase<Epi8Merge, pg8::StaticOrder, true, true>((LAS unsigned char*)lds, g, S, Epi8Merge{(const bf16_t*)(ws + WS_GS), (bf16_t*)(ws + WS_H), 3, 0}, tid_); }
        GRID_BAR(); STAMP(1 + 17 * l + 13);
        { PH_VARS pg8::Gemm g{(const bf16_t*)(ws + WS_H), (const bf16_t*)(ws + WS_WBF + WB_O), MTOK, D, D}; pg8::StaticOrder S; S.init(MTOK, D, G, (int)blockIdx.x);
          pg8::gemm_phase<Epi8Res, pg8::StaticOrder, true, true>((LAS unsigned char*)lds, g, S, Epi8Res{p, l, 4096, 0, 0}, tid_); }
        GRID_BAR(); STAMP(1 + 17 * l + 14);
        { PH_VARS const int per_ = (MTOK + NGW - 1) / NGW, r0_ = gw * per_; ph_hnorm_rows(p, l, 1, r0_, r0_ + per_ < MTOK ? r0_ + per_ : MTOK, lane); }
        GRID_BAR(); STAMP(1 + 17 * l + 15);
        { PH_VARS pg8::Gemm g{(const bf16_t*)(ws + WS_H), (const bf16_t*)(ws + WS_WBF + WB_FIN), MTOK, 2 * FFN, D}; pg8::StaticOrder S; S.init(MTOK, 2 * FFN, G, (int)blockIdx.x);
          pg8::gemm_phase<Epi8FfnIn, pg8::StaticOrder, true, true>((LAS unsigned char*)lds, g, S, Epi8FfnIn{(bf16_t*)(ws + WS_FFNH)}, tid_); }
        GRID_BAR(); STAMP(1 + 17 * l + 16);
        { PH_VARS pg8::Gemm g{(const bf16_t*)(ws + WS_FFNH), (const bf16_t*)(ws + WS_WBF + WB_FOUT), MTOK, D, FFN}; pg8::StaticOrder S; S.init(MTOK, D, G, (int)blockIdx.x);
          pg8::gemm_phase<Epi8Res, pg8::StaticOrder, true, true>((LAS unsigned char*)lds, g, S, Epi8Res{p, l, 10240, 1, 0}, tid_); }
        if (l == 0) { PH_VARS
          const int rem = 640 % G, nidle = rem ? G - rem : G, idx = rem ? (int)blockIdx.x - rem : (int)blockIdx.x;
          if (idx >= 0) ph_convert(p, 1, idx * 8 + wave, nidle * 8, lane, (LAS float*)((LAS unsigned char*)lds + wave * 16384), true, false); }
        GRID_BAR(); STAMP(1 + 17 * l + 17);
}

__global__ void __launch_bounds__(NTHR, 2) mega(P p_arg) {
    extern __shared__ __attribute__((aligned(16))) unsigned char lds[];
    const int tid = threadIdx.x;
    const int G = gridDim.x, NGW = G * 8;
    for (int u = tid; u < (LDS_BYTES - MISC_OFF) / 4; u += NTHR) ((LAS unsigned*)((LAS unsigned char*)lds + MISC_OFF))[u] = 0u;
    __syncthreads();
    XcdBarrier bar = xcd_barrier_post((unsigned*)(p_arg.ws + WS_CTL), (volatile LAS unsigned*)((LAS unsigned char*)lds + MISC_OFF + 32));
    STAMP(0);
    { PH_VARS ph_mod_partial(p, tid_, (float*)lds); }
    GRID_BAR();
    { PH_VARS ph_mod_reduce(p, tid_); }
    GRID_BAR(); STAMP(1);
    run_layer<0>(lds, bar, G, NGW);
    run_layer<1>(lds, bar, G, NGW);
    { PH_VARS for (int r = gw; r < MTOK; r += NGW) ph_final_row(p, r, lane);
#if PROBE
      STAMP(35);
      if (blockIdx.x == 0 && bar.w == 0u && lane_id_() == 0u) {
          asm volatile("s_waitcnt vmcnt(0) lgkmcnt(0)" ::: "memory");
          const LAS unsigned long long* ts = (const LAS unsigned long long*)((LAS unsigned char*)lds + MISC_OFF + 2048);
          unsigned long long sd = 0, sa = 0;
          for (int ll = 0; ll < 2; ++ll) for (int i = 0; i < 17; ++i) { const unsigned long long d = ts[1 + 17 * ll + i + 1] - ts[1 + 17 * ll + i]; if ((PROBE_MASK_D >> i) & 1u) sd += d; if ((PROBE_MASK_A >> i) & 1u) sa += d; }
          { const unsigned long long d = ts[1] - ts[0]; if ((PROBE_MASK_D >> 17) & 1u) sd += d; if ((PROBE_MASK_A >> 17) & 1u) sa += d; }
          { const unsigned long long d = ts[35] - ts[34]; if ((PROBE_MASK_D >> 18) & 1u) sd += d; if ((PROBE_MASK_A >> 18) & 1u) sa += d; }
          float v = (float)sa * 0.01f / PROBE_ADIV; v = v > 120.f ? 120.f : v;
          if (PROBE_MASK_A) p.out[O_YS] += v;
          const unsigned long long t0 = __builtin_amdgcn_s_memrealtime(), wait = sd * PROBE_MULT;
          while (__builtin_amdgcn_s_memrealtime() - t0 < wait) __builtin_amdgcn_s_sleep(32);
      }
#endif
    }
}

extern "C" void kernel_launch(void* const* d_in, const int* in_sizes, int n_in, void* d_out, int out_size, void* d_ws, size_t ws_size, hipStream_t stream) {
    static int grid = 0;
    if (grid == 0) {
        if (n_in != 38 || out_size != (int)O_END || ws_size < WS_END) { fprintf(stderr, "kernel_launch: unexpected shapes (n_in %d out %d ws %zu)\n", n_in, out_size, ws_size); grid = -1; return; }
        int dev = 0, cus = 0, per_cu = 0;
        if (hipGetDevice(&dev) != hipSuccess || hipDeviceGetAttribute(&cus, hipDeviceAttributeMultiprocessorCount, dev) != hipSuccess) { grid = -1; return; }
        if (hipFuncSetAttribute((const void*)mega, hipFuncAttributeMaxDynamicSharedMemorySize, LDS_BYTES) != hipSuccess) { fprintf(stderr, "kernel_launch: hipFuncSetAttribute failed\n"); grid = -1; return; }
        if (hipOccupancyMaxActiveBlocksPerMultiprocessor(&per_cu, (const void*)mega, NTHR, LDS_BYTES) != hipSuccess || per_cu < 1) { fprintf(stderr, "kernel_launch: occupancy query says %d workgroups per CU\n", per_cu); grid = -1; return; }
        (void)hipGetLastError();
        grid = cus;
    }
    if (grid < 0) return;
    if (hipMemsetAsync((char*)d_ws + WS_CTL, 0, CTL_BYTES, stream) != hipSuccess) return;
    P p{};
    for (int i = 0; i < 38; ++i) p.in[i] = (const float*)d_in[i];
    p.out = (float*)d_out; p.ws = (unsigned char*)d_ws;
    hipLaunchKernelGGL(mega, dim3(grid), dim3(NTHR), LDS_BYTES, stream, p);
}
```

```cpp
#include <hip/hip_runtime.h>
#include <cstdio>
#include <cstdint>

typedef unsigned short bf16_t;
typedef short bf16x8 __attribute__((ext_vector_type(8)));
typedef float f32x16 __attribute__((ext_vector_type(16)));
typedef float f32x4 __attribute__((ext_vector_type(4)));
typedef unsigned u32x4 __attribute__((ext_vector_type(4)));
typedef unsigned u32x2 __attribute__((ext_vector_type(2)));
typedef float f32x2_ __attribute__((ext_vector_type(2)));

constexpr int D = 2048, NCTX = 4096, NLAT = 16384, MTOK = 20480, MALL = 21504;
constexpr int CB = 16, CL = 256, LB = 4, LL = 4096, PAST = 256;
constexpr int IN_COLS = 18512, MIX_COLS = 10320, GATE_COLS = 8192;
constexpr int C_MLQ = 0, C_MLK = 1024, C_MLV = 2048, C_MLO = 3072, C_MLIF = 4096, C_MQ = 4112, C_KVA = 5648, C_S5U = 6224, C_DFQ = 7248, C_DFK = 8272, C_DFV = 9296;
constexpr int FFN = 5632;
constexpr int NTHR_ = 512;
constexpr int KVAW = 768;

constexpr size_t MiB = 1u << 20;
constexpr size_t WS_CTL = 0, CTL_BYTES = 64 * 1024;
constexpr size_t WS_MOD = 1 * MiB;
constexpr size_t WS_ROPE = WS_MOD + 512 * 1024;
constexpr size_t WS_X = 2 * MiB;
constexpr size_t WS_H = 162 * MiB;
constexpr size_t WS_HF = 242 * MiB;
constexpr size_t WS_HB = 282 * MiB;
constexpr size_t WS_MLQ = 322 * MiB;
constexpr size_t WS_S5U = 362 * MiB;
constexpr size_t WS_DFQ = 402 * MiB;
constexpr size_t WS_MLK = 442 * MiB;
constexpr size_t WS_MLV = 482 * MiB;
constexpr size_t WS_MLO = 522 * MiB;
constexpr size_t WS_MQ = 562 * MiB;
constexpr size_t WS_KVA = 622 * MiB;
constexpr size_t WS_DFK = 682 * MiB;
constexpr size_t WS_DFV = 724 * MiB;
constexpr size_t WS_CKVN = 766 * MiB;
constexpr size_t WS_KFULL = 787 * MiB;
constexpr size_t WS_VFULL = 850 * MiB;
constexpr size_t WS_GATES = 892 * MiB;
constexpr size_t WS_CT = 894 * MiB;
constexpr size_t WS_WBF = 934 * MiB;
constexpr size_t WS_GS = 442 * MiB;
constexpr size_t WS_FFNH = 442 * MiB;
constexpr size_t WS_DFO = 442 * MiB;
constexpr size_t WS_YS5F = 442 * MiB;
constexpr size_t WS_YS5B = 482 * MiB;
constexpr size_t WS_END = 1101 * MiB;

constexpr size_t O_YP = 0, O_YS = 8388608, O_CKV = 41943040, O_KR = 46137344, O_DK = 46661632, O_DV = 55050240,
                 O_MC = 63438848, O_MN = 80216064, O_MM = 80281600, O_SR = 80281856, O_SI = 80544000, O_END = 80806144;

__device__ __forceinline__ unsigned f2bf(float f) { unsigned u = __builtin_bit_cast(unsigned, f); return (u + 0x7fffu + ((u >> 16) & 1u)) >> 16; }
__device__ __forceinline__ float bf2f(unsigned b) { return __builtin_bit_cast(float, (b & 0xffffu) << 16); }
__device__ __forceinline__ unsigned pk2(float lo, float hi) { return f2bf(lo) | (f2bf(hi) << 16); }
__device__ __forceinline__ float wave_sum(float v) {
#pragma unroll
    for (int o = 1; o < 64; o <<= 1) v += __shfl_xor(v, o);
    return v;
}
__device__ __forceinline__ float wave_max(float v) {
#pragma unroll
    for (int o = 1; o < 64; o <<= 1) v = fmaxf(v, __shfl_xor(v, o));
    return v;
}
__device__ __forceinline__ float sigmoidf_(float x) { return __builtin_amdgcn_rcpf(1.0f + __expf(-x)); }
__device__ __forceinline__ float siluf_(float x) { return x * __builtin_amdgcn_rcpf(1.0f + __expf(-x)); }
__device__ __forceinline__ float gelu_tanh(float x) { const float u = 0.7978845608028654f * (x + 0.044715f * x * x * x); const float t = 1.0f - 2.0f * __builtin_amdgcn_rcpf(1.0f + __expf(2.0f * u)); return 0.5f * x * (1.0f + t); }
__device__ __forceinline__ void sincos_small(float x, float& s, float& c) {
    const float k = rintf(x * 0.6366197723675814f);
    float r = fmaf(-k, 1.5707962513e+0f, x); r = fmaf(-k, 7.5497894159e-8f, r); r = fmaf(-k, 5.3903029534e-15f, r);
    const float r2 = r * r;
    const float sp = r + r * r2 * (-1.6666654611e-1f + r2 * (8.3321608736e-3f + r2 * (-1.9515295891e-4f)));
    const float cp = 1.0f - 0.5f * r2 + r2 * r2 * (4.166664568298827e-2f + r2 * (-1.388731625493765e-3f + r2 * 2.443315711809948e-5f));
    const int q = ((int)k) & 3;
    s = (q == 0) ? sp : (q == 1) ? cp : (q == 2) ? -sp : -cp;
    c = (q == 0) ? cp : (q == 1) ? -sp : (q == 2) ? -cp : sp;
}
__device__ __forceinline__ int cond_of_row(int r) { return r < NCTX ? 0 : 1 + ((r - NCTX) >> 12); }

struct P {
    const float* in[38];
    float* out;
    unsigned char* ws;
};
__device__ __forceinline__ const float* x_in(const P& p, int r) { return r < NCTX ? p.in[0] + (size_t)r * D : p.in[1] + (size_t)(r - NCTX) * D; }


#define XB_TMO      128
#define XB_XCNT(j)  (256  + 64 * (j))
#define XB_XSUB(j)  (1280 + 64 * (j))
#define XB_XGEN(j)  (2304 + 64 * (j))
#define XB_TOP      3328
#define XB_TOPGEN   3392
#define XCD_BAR_WORDS 3456
#define XB_SPIN_CAP (1u << 22)
#define LAS __attribute__((address_space(3)))

__device__ __forceinline__ unsigned xb_ld(unsigned* p)              { return __hip_atomic_load(p, __ATOMIC_RELAXED, __HIP_MEMORY_SCOPE_AGENT); }
__device__ __forceinline__ unsigned xb_add(unsigned* p, unsigned v) { return __hip_atomic_fetch_add(p, v, __ATOMIC_RELAXED, __HIP_MEMORY_SCOPE_AGENT); }
__device__ __forceinline__ unsigned xb_xcc_id() { return (unsigned)__builtin_amdgcn_s_getreg((3 << 11) | 20) & 0xFu; }
#define XB_SPIN(cond, bar) do { unsigned _sp = 0; while (cond) { __builtin_amdgcn_s_sleep(1); \
    if ((++_sp & 255u) == 0u) { if (xb_ld(&(bar)[XB_TMO])) break; if (_sp > XB_SPIN_CAP) { atomicAdd(&(bar)[XB_TMO], 1u); break; } } } } while (0)

__device__ __forceinline__ unsigned lane_id_() { unsigned l_; asm volatile("v_mbcnt_lo_u32_b32 %0, -1, 0\n\tv_mbcnt_hi_u32_b32 %0, -1, %0" : "=v"(l_)); return l_; }
struct XcdBarrier {
    unsigned* bar; unsigned x; unsigned w;
    volatile LAS unsigned* st;
};
__device__ __forceinline__ XcdBarrier xcd_barrier_post(unsigned* bar, volatile LAS unsigned* st) {
    XcdBarrier b; b.bar = bar; b.x = xb_xcc_id(); b.st = st; b.w = (unsigned)__builtin_amdgcn_readfirstlane(threadIdx.x >> 6);
    if (threadIdx.x == 0) (void)xb_add(&bar[XB_XCNT(b.x)], 1u);
    return b;
}
__device__ __forceinline__ void xcd_barrier_complete(unsigned* bar, unsigned x, unsigned& nloc, unsigned& nx) {
    const unsigned G = gridDim.x * gridDim.y * gridDim.z;
    unsigned sum, cnt, mine, sp = 0u;
    for (;;) {
        sum = 0u; cnt = 0u; mine = 0u;
#pragma unroll
        for (unsigned j = 0; j < 16; ++j) { const unsigned c = xb_ld(&bar[XB_XCNT(j)]); sum += c; cnt += (c > 0u) ? 1u : 0u; mine = (j == x) ? c : mine; }
        if (sum == G) break;
        __builtin_amdgcn_s_sleep(1);
        if ((++sp & 255u) == 0u) { if (xb_ld(&bar[XB_TMO])) break; if (sp > XB_SPIN_CAP) { atomicAdd(&bar[XB_TMO], 1u); break; } }
    }
    nloc = mine > 0u ? mine : 1u; nx = cnt > 0u ? cnt : 1u;
}
__device__ __forceinline__ void xcd_barrier(const XcdBarrier& b) {
    asm volatile("s_waitcnt vmcnt(0)" ::: "memory");
    __syncthreads();
    if (b.w == 0u && lane_id_() == 0u) {
        unsigned* bar = b.bar;
        __builtin_amdgcn_s_waitcnt(0);
        unsigned nloc = b.st[0], nx = b.st[1];
        if (nloc == 0u) { xcd_barrier_complete(bar, b.x, nloc, nx); b.st[0] = nloc; b.st[1] = nx; }
        const unsigned old = xb_add(&bar[XB_XSUB(b.x)], 1u);
        const unsigned gen = old / nloc;
        if (old + 1u == (gen + 1u) * nloc) {
            __builtin_amdgcn_fence(__ATOMIC_RELEASE, "agent");
            asm volatile("s_waitcnt vmcnt(0)" ::: "memory");
            const unsigned og = xb_add(&bar[XB_TOP], 1u);
            const unsigned tg = og / nx;
            if (og + 1u == (tg + 1u) * nx) xb_add(&bar[XB_TOPGEN], 1u);
            else XB_SPIN(xb_ld(&bar[XB_TOPGEN]) == tg, bar);
            __builtin_amdgcn_fence(__ATOMIC_ACQUIRE, "agent");
            xb_add(&bar[XB_XGEN(b.x)], 1u);
            asm volatile("s_waitcnt vmcnt(0)" ::: "memory");
        } else {
            XB_SPIN(xb_ld(&bar[XB_XGEN(b.x)]) == gen, bar);
            __builtin_amdgcn_fence(__ATOMIC_ACQUIRE, "agent");
            asm volatile("s_waitcnt vmcnt(0)" ::: "memory");
        }
    }
    __syncthreads();
}


constexpr int MOD_KS = 16, MOD_KC = 2048 / MOD_KS;
constexpr size_t WS_MODP = WS_X;
__device__ __forceinline__ void ph_mod_partial(const P& p, int tid, float* sc) {
    for (int i = tid; i < 5 * 2048; i += NTHR_) { const int c = i >> 11, k = i & 2047; const float v = c == 0 ? p.in[12][k] : p.in[11][(c - 1) * 2048 + k]; sc[i] = siluf_(v); }
    __syncthreads();
    const int NU = 2 * 3072 * MOD_KS;
    for (int u = blockIdx.x * NTHR_ + tid; u < NU; u += gridDim.x * NTHR_) {
        const int cg = u % 3072, kc = (u / 3072) % MOD_KS, l = u / (3072 * MOD_KS);
        const float* w = p.in[13] + ((size_t)l * 2048 + kc * MOD_KC) * 12288 + cg * 4;
        f32x4 a0 = {0.f, 0.f, 0.f, 0.f}, a1 = a0, a2 = a0, a3 = a0, a4 = a0;
#pragma unroll 8
        for (int k = 0; k < MOD_KC; ++k) { const f32x4 wv = *(const f32x4*)(w + (size_t)k * 12288); const int kk = kc * MOD_KC + k;
            a0 += wv * sc[kk]; a1 += wv * sc[2048 + kk]; a2 += wv * sc[4096 + kk]; a3 += wv * sc[6144 + kk]; a4 += wv * sc[8192 + kk]; }
        float* o = (float*)(p.ws + WS_MODP) + ((size_t)(kc * 2 + l) * 5) * 12288 + cg * 4;
        *(f32x4*)o = a0; *(f32x4*)(o + 12288) = a1; *(f32x4*)(o + 2 * 12288) = a2; *(f32x4*)(o + 3 * 12288) = a3; *(f32x4*)(o + 4 * 12288) = a4;
    }
    if (blockIdx.x == 0) {
        float* rt = (float*)(p.ws + WS_ROPE);
        for (int i = tid; i < 1024; i += NTHR_) { const int pos = i >> 4, j = i & 15; const float inv = exp2f(-(float)j * (13.287712379549449f / 16.0f)); float s_, c_; sincos_small((float)pos * inv, s_, c_); rt[i] = c_; rt[1024 + i] = s_; }
    }
}
__device__ __forceinline__ void ph_mod_reduce(const P& p, int tid) {
    for (int i = blockIdx.x * NTHR_ + tid; i < 2 * 5 * 12288; i += gridDim.x * NTHR_) {
        const int n = i % 12288, l = (i / 12288) / 5; float acc = p.in[14][l * 12288 + n];
#pragma unroll
        for (int kc = 0; kc < MOD_KS; ++kc) acc += ((const float*)(p.ws + WS_MODP))[(size_t)kc * 2 * 5 * 12288 + i];
        ((float*)(p.ws + WS_MOD))[i] = acc;
    }
}

__device__ __forceinline__ void ph_hnorm_rows(const P& p, int l, int which, int r0, int r1, int lane) {
    const bool from_in = (which == 0 && l == 0);
    const float* nw = p.in[which == 0 ? 15 : 16] + l * 2048;
    int ccur = -1; f32x4 A[8], S[8];
    for (int r = r0; r < r1; ++r) {
        const int cnd = cond_of_row(r);
        if (cnd != ccur) { ccur = cnd;
            const float* mod = (const float*)(p.ws + WS_MOD) + ((size_t)l * 5 + cnd) * 12288 + (which == 0 ? 0 : 3 * 2048);
#pragma unroll
            for (int j = 0; j < 8; ++j) { const int c = j * 256 + lane * 4; const f32x4 g = *(const f32x4*)(nw + c), s1 = *(const f32x4*)(mod + 2048 + c); S[j] = *(const f32x4*)(mod + c);
#pragma unroll
                for (int e = 0; e < 4; ++e) A[j][e] = g[e] * (1.0f + s1[e]); } }
        const float* x = x_in(p, r); const bf16_t* xb = (const bf16_t*)(p.ws + WS_X) + (size_t)r * D;
        f32x4 v[8]; float ss = 0.f;
#pragma unroll
        for (int j = 0; j < 8; ++j) {
            if (from_in) v[j] = *(const f32x4*)(x + j * 256 + lane * 4);
            else { const u32x2 w = *(const u32x2*)(xb + j * 256 + lane * 4); v[j] = (f32x4){bf2f(w.x), bf2f(w.x >> 16), bf2f(w.y), bf2f(w.y >> 16)}; }
            ss += v[j][0] * v[j][0] + v[j][1] * v[j][1] + v[j][2] * v[j][2] + v[j][3] * v[j][3]; }
        const float rstd = rsqrtf(wave_sum(ss) * (1.0f / 2048.0f) + 1e-6f);
        bf16_t* o = (bf16_t*)(p.ws + WS_H) + (size_t)r * D;
#pragma unroll
        for (int j = 0; j < 8; ++j) { const int c = j * 256 + lane * 4; float y[4];
#pragma unroll
            for (int e = 0; e < 4; ++e) y[e] = v[j][e] * rstd * A[j][e] + S[j][e];
            u32x2 w; w.x = pk2(y[0], y[1]); w.y = pk2(y[2], y[3]); *(u32x2*)(o + c) = w; }
    }
}

namespace pg8 {
#define PG8_LAS __attribute__((address_space(3)))
typedef unsigned short bf16_t;
typedef short bf16x8 __attribute__((ext_vector_type(8)));
typedef float f32x4 __attribute__((ext_vector_type(4)));
typedef unsigned u32x4 __attribute__((ext_vector_type(4)));
constexpr int BM = 256, BK = 64, HALF = 128, HTB = HALF * BK * 2  , STAGE_BYTES = 8 * HTB, NXCD = 8, WGM = 8;

__host__ __device__ __forceinline__ int lds_byte(int r, int c) { const int st = (r >> 4) * 2 + (c >> 5), rr = r & 15, cc = c & 31, ob = rr * 64 + cc * 2; return st * 1024 + (ob ^ (((ob >> 9) & 1) << 5)); }
__host__ __device__ __forceinline__ void stage_rc(int b, int& R, int& C) { const int st = b / 1024, sb = b % 1024, swz = sb ^ (((sb >> 9) & 1) << 5); R = (st >> 1) * 16 + swz / 64; C = (st & 1) * 32 + (swz % 64) / 2; }
__host__ __device__ __forceinline__ int perm32(int rho) { const int n = rho >> 4, i = rho & 15; return 8 * (i >> 2) + 4 * n + (i & 3); }

struct Unit { int pm, pn; };
struct Gemm { const bf16_t* A; const bf16_t* Bt; int M, N, K; };

struct StaticOrder {
    int nM, nN, nwg, G, c;
    __host__ __device__ void init(int M, int N, int G_, int c_) { nM = M / BM; nN = N / BM; nwg = nM * nN; G = G_; c = c_; }
    __host__ __device__ bool next(int i, Unit& u) const {
        const long L = (long)i * G + c; if (L >= nwg) return false;
        int wgid = (int)L; { const int q = nwg / NXCD, r = nwg % NXCD, xcd = wgid % NXCD, off = wgid / NXCD; wgid = (xcd < r ? xcd * (q + 1) : r * (q + 1) + (xcd - r) * q) + off; }
        const int nig = WGM * nN, gid = wgid / nig, fm = gid * WGM, gsz = (nM - fm) < WGM ? (nM - fm) : WGM;
        u.pm = fm + ((wgid % nig) % gsz); u.pn = (wgid % nig) / gsz; return true;
    }
    __device__ __forceinline__ void a_ready(const Unit&) const {}
    __device__ __forceinline__ void done(const Unit&) const {}
};

__device__ __forceinline__ unsigned cvt_pk_bf16(float lo, float hi) { unsigned r; asm volatile("s_nop 0\n\tv_cvt_pk_bf16_f32 %0, %1, %2" : "=v"(r) : "v"(lo), "v"(hi)); return r; }

template <class Epi, class Sched, bool ALIGN_EPI = false, bool SP2 = false>
__device__ __forceinline__ void gemm_phase(PG8_LAS unsigned char* lds, const Gemm g, const Sched& S, const Epi& E, int tid_in) {
    int tid_l = tid_in; asm volatile("" : "+v"(tid_l));
    const int tid = tid_l, wid = __builtin_amdgcn_readfirstlane(tid >> 6), lane = tid & 63, wr = wid >> 2, wc = wid & 3, fr = lane & 15, fq = lane >> 4;
    const int K = g.K, nt = K / BK;
    unsigned voffA[2], voffB[2];
#pragma unroll
    for (int i = 0; i < 2; ++i) { int R, C; stage_rc(tid * 16 + i * 8192, R, C); const int Rb = Epi::PERM ? ((R & ~31) + perm32(R & 31)) : R;
        voffA[i] = (unsigned)(R * K + C) * 2u; voffB[i] = (unsigned)(Rb * K + C) * 2u; }
    const size_t kstep = (size_t)(BK * 2);
    const size_t hstep = (size_t)HALF * K * 2;
    const size_t tstep = 2 * hstep;
    const unsigned ldsw = (unsigned)wid * 1024u;
    const int aoff = lds_byte(wr * 64 + fr, fq * 8), boff = lds_byte(wc * 32 + fr, fq * 8);
#define PG8_SA(b, h) (((b) * 2 + (h)) * HTB)
#define PG8_SB(b, h) ((4 + (b) * 2 + (h)) * HTB)
#define PG8_STAGE(bufoff, gbase, voff) do { _Pragma("unroll") for (int _i = 0; _i < 2; ++_i) \
        __builtin_amdgcn_global_load_lds((const unsigned*)((const char*)(gbase) + (voff)[_i]), (PG8_LAS unsigned*)(lds + (bufoff) + ldsw + _i * 8192), 16, 0, 0); } while (0)
#define PG8_LDA(dst, b, h) do { _Pragma("unroll") for (int m = 0; m < 4; ++m) _Pragma("unroll") for (int k = 0; k < 2; ++k) dst[m][k] = *(const PG8_LAS bf16x8*)(lds + PG8_SA(b, h) + aoff + m * 2048 + k * 1024); } while (0)
#define PG8_LDB(dst, b, h) do { _Pragma("unroll") for (int n = 0; n < 2; ++n) _Pragma("unroll") for (int k = 0; k < 2; ++k) dst[n][k] = *(const PG8_LAS bf16x8*)(lds + PG8_SB(b, h) + boff + n * 2048 + k * 1024); } while (0)
#define PG8_MMA(ai, bj, At, Bt) do { __builtin_amdgcn_s_setprio(1); _Pragma("unroll") for (int m = 0; m < 4; ++m) _Pragma("unroll") for (int n = 0; n < 2; ++n) _Pragma("unroll") for (int k = 0; k < 2; ++k) \
        acc[ai][bj][m][n] = __builtin_amdgcn_mfma_f32_16x16x32_bf16(Bt[n][k], At[m][k], acc[ai][bj][m][n], 0, 0, 0); __builtin_amdgcn_s_setprio(0); } while (0)
#define PG8_WAIT_V(n) asm volatile("s_waitcnt vmcnt(" #n ")" ::: "memory")
#define PG8_WAIT_L(n) asm volatile("s_waitcnt lgkmcnt(" #n ")" ::: "memory")
#define PG8_BAR __builtin_amdgcn_s_barrier()
#define PG8_SCHED __builtin_amdgcn_sched_barrier(0)
    Unit cur, nxt; int ui = 0;
    if (!S.next(0, cur)) return;
    f32x4 acc[2][2][4][2];
    { float z0 = 0.f; asm volatile("" : "+v"(z0));
#pragma unroll
    for (int a = 0; a < 2; ++a)
#pragma unroll
        for (int b = 0; b < 2; ++b)
#pragma unroll
            for (int m = 0; m < 4; ++m)
#pragma unroll
                for (int n = 0; n < 2; ++n) acc[a][b][m][n] = (f32x4){z0, z0, z0, z0}; }
    bf16x8 At[4][2], B0[2][2], B1[2][2];
    const char* cA = (const char*)g.A + (size_t)cur.pm * tstep; const char* cB = (const char*)g.Bt + (size_t)cur.pn * tstep;
    S.a_ready(cur);
    if constexpr (SP2) {
        PG8_STAGE(PG8_SB(0, 0), cB, voffB); PG8_STAGE(PG8_SB(0, 1), cB + hstep, voffB); PG8_STAGE(PG8_SA(0, 0), cA, voffA); PG8_STAGE(PG8_SA(0, 1), cA + hstep, voffA);
        if (wr == 1) PG8_BAR;
        PG8_WAIT_V(2); PG8_BAR;
        PG8_STAGE(PG8_SB(1, 0), cB + kstep, voffB); PG8_STAGE(PG8_SA(1, 0), cA + kstep, voffA); PG8_STAGE(PG8_SB(1, 1), cB + hstep + kstep, voffB);
        PG8_WAIT_V(6); PG8_BAR;
    } else {
        PG8_STAGE(PG8_SB(0, 0), cB, voffB); PG8_STAGE(PG8_SA(0, 0), cA, voffA); PG8_STAGE(PG8_SB(0, 1), cB + hstep, voffB); PG8_STAGE(PG8_SA(0, 1), cA + hstep, voffA);
        if (wr == 1) PG8_BAR;
        PG8_WAIT_V(4); PG8_BAR;
        PG8_STAGE(PG8_SB(1, 0), cB + kstep, voffB); PG8_STAGE(PG8_SA(1, 0), cA + kstep, voffA); PG8_STAGE(PG8_SB(1, 1), cB + hstep + kstep, voffB);
        PG8_WAIT_V(6); PG8_BAR;
    }
    for (;;) {
        const bool has_next = S.next(ui + 1, nxt);
        const char* nA = has_next ? (const char*)g.A + (size_t)nxt.pm * tstep : cA; const char* nB = has_next ? (const char*)g.Bt + (size_t)nxt.pn * tstep : cB;
        for (int t = 0; t < nt; t += 2) {
            const bool last = (t == nt - 2);
            const char* a1 = cA + (size_t)(t + 1) * kstep;
            const char* a2 = last ? nA : cA + (size_t)(t + 2) * kstep; const char* b2 = last ? nB : cB + (size_t)(t + 2) * kstep;
            const char* a3 = a2 + kstep; const char* b3 = b2 + kstep;
            if (last && has_next) S.a_ready(nxt);
            if constexpr (SP2) {
            PG8_LDB(B0, 0, 0); PG8_LDB(B1, 0, 1); PG8_SCHED; PG8_LDA(At, 0, 0); PG8_STAGE(PG8_SA(1, 1), a1 + hstep, voffA);
            PG8_WAIT_V(8); PG8_WAIT_L(0); PG8_BAR; PG8_MMA(0, 0, At, B0); PG8_MMA(0, 1, At, B1); PG8_BAR; PG8_SCHED;
            PG8_LDA(At, 0, 1); PG8_STAGE(PG8_SB(0, 0), b2, voffB); PG8_STAGE(PG8_SB(0, 1), b2 + hstep, voffB); PG8_STAGE(PG8_SA(0, 0), a2, voffA);
            PG8_WAIT_V(8); PG8_WAIT_L(0); PG8_BAR; PG8_MMA(1, 0, At, B0); PG8_MMA(1, 1, At, B1); PG8_BAR; PG8_SCHED;
            PG8_LDB(B0, 1, 0); PG8_LDB(B1, 1, 1); PG8_SCHED; PG8_LDA(At, 1, 0); PG8_STAGE(PG8_SA(0, 1), a2 + hstep, voffA);
            PG8_WAIT_V(8); PG8_WAIT_L(0); PG8_BAR; PG8_MMA(0, 0, At, B0); PG8_MMA(0, 1, At, B1); PG8_BAR; PG8_SCHED;
            PG8_LDA(At, 1, 1); PG8_STAGE(PG8_SB(1, 0), b3, voffB); PG8_STAGE(PG8_SB(1, 1), b3 + hstep, voffB); PG8_STAGE(PG8_SA(1, 0), a3, voffA);
            PG8_WAIT_V(8); PG8_WAIT_L(0); PG8_BAR; PG8_MMA(1, 0, At, B0); PG8_MMA(1, 1, At, B1); PG8_BAR; PG8_SCHED;
            } else {
            PG8_LDB(B0, 0, 0); PG8_SCHED; PG8_LDA(At, 0, 0); PG8_STAGE(PG8_SA(1, 1), a1 + hstep, voffA);
            PG8_WAIT_L(8); PG8_BAR; PG8_WAIT_L(0); PG8_MMA(0, 0, At, B0); PG8_BAR; PG8_SCHED;
            PG8_LDB(B1, 0, 1); PG8_STAGE(PG8_SB(0, 0), b2, voffB);
            PG8_BAR; PG8_WAIT_L(0); PG8_MMA(0, 1, At, B1); PG8_BAR;
            PG8_LDA(At, 0, 1); PG8_STAGE(PG8_SA(0, 0), a2, voffA);
            PG8_BAR; PG8_WAIT_L(0); PG8_MMA(1, 0, At, B0); PG8_BAR; PG8_SCHED;
            PG8_STAGE(PG8_SB(0, 1), b2 + hstep, voffB);
            PG8_WAIT_V(6); PG8_BAR; PG8_MMA(1, 1, At, B1); PG8_BAR;
            PG8_LDB(B0, 1, 0); PG8_SCHED; PG8_LDA(At, 1, 0); PG8_STAGE(PG8_SA(0, 1), a2 + hstep, voffA);
            PG8_WAIT_L(8); PG8_BAR; PG8_WAIT_L(0); PG8_MMA(0, 0, At, B0); PG8_BAR; PG8_SCHED;
            PG8_LDB(B1, 1, 1); PG8_STAGE(PG8_SB(1, 0), b3, voffB);
            PG8_BAR; PG8_WAIT_L(0); PG8_MMA(0, 1, At, B1); PG8_BAR;
            PG8_LDA(At, 1, 1); PG8_STAGE(PG8_SA(1, 0), a3, voffA);
            PG8_BAR; PG8_WAIT_L(0); PG8_MMA(1, 0, At, B0); PG8_BAR; PG8_SCHED;
            PG8_STAGE(PG8_SB(1, 1), b3 + hstep, voffB);
            PG8_WAIT_V(6); PG8_BAR; PG8_MMA(1, 1, At, B1); PG8_BAR;
            }
        }
        if constexpr (ALIGN_EPI) { if (wr == 0) PG8_BAR; }
        if constexpr (!Epi::AFTER_DRAIN) { E(acc, cur, wr, wc, fr, fq); S.done(cur); }
        if (!has_next) break;
        { float z0 = 0.f; asm volatile("" : "+v"(z0));
#pragma unroll
        for (int a = 0; a < 2; ++a)
#pragma unroll
            for (int b = 0; b < 2; ++b)
#pragma unroll
                for (int m = 0; m < 4; ++m)
#pragma unroll
                    for (int n = 0; n < 2; ++n) acc[a][b][m][n] = (f32x4){z0, z0, z0, z0}; }
        cur = nxt; cA = nA; cB = nB; ++ui;
        if constexpr (ALIGN_EPI) { if (wr == 1) PG8_BAR; }
    }
    PG8_WAIT_V(0);
    if constexpr (!ALIGN_EPI) { if (wr == 0) PG8_BAR; }
    PG8_BAR;
    if constexpr (Epi::AFTER_DRAIN) { E.fused(acc, cur, wr, wc, fr, fq, lds, wid, lane); S.done(cur); }
#undef PG8_SA
#undef PG8_SB
#undef PG8_STAGE
#undef PG8_LDA
#undef PG8_LDB
#undef PG8_MMA
#undef PG8_WAIT_V
#undef PG8_WAIT_L
#undef PG8_BAR
#undef PG8_SCHED
}
}

#define PG8_ROW(ai, m) (u.pm * 256 + (ai) * 128 + wr * 64 + (m) * 16 + fr)
#define PG8_FOR(...) _Pragma("unroll") for (int ai = 0; ai < 2; ++ai) _Pragma("unroll") for (int m = 0; m < 4; ++m) { const int row = PG8_ROW(ai, m); _Pragma("unroll") for (int bj = 0; bj < 2; ++bj) { \
    const int ct = bj * 128 + wc * 32 + 8 * fq; const pg8::f32x4 v0 = acc[ai][bj][m][0], v1 = acc[ai][bj][m][1]; __VA_ARGS__ } }
__device__ __forceinline__ u32x4 pack8(const pg8::f32x4& a, const pg8::f32x4& b) { u32x4 w; w.x = pg8::cvt_pk_bf16(a[0], a[1]); w.y = pg8::cvt_pk_bf16(a[2], a[3]); w.z = pg8::cvt_pk_bf16(b[0], b[1]); w.w = pg8::cvt_pk_bf16(b[2], b[3]); return w; }
__device__ __forceinline__ void unpack8(const u32x4& w, float (&f)[8]) {
#pragma unroll
    for (int i = 0; i < 4; ++i) { f[2 * i] = bf2f(w[i]); f[2 * i + 1] = bf2f(w[i] >> 16); } }

struct Epi8In {
    static constexpr bool PERM = true, AFTER_DRAIN = false;
    unsigned char* ws;
    __device__ __forceinline__ void operator()(const pg8::f32x4 (&acc)[2][2][4][2], const pg8::Unit& u, int wr, int wc, int fr, int fq) const {
        const int pn = u.pn;
        if (pn >= 22 && pn < 25) {
            float* kva = (float*)(ws + WS_KVA);
            PG8_FOR({ float* o = kva + (size_t)row * KVAW + (pn - 22) * 256 + ct; *(pg8::f32x4*)o = v0; *(pg8::f32x4*)(o + 4) = v1; })
            return;
        }
        size_t base; int ldc, c0, mode = 0;
        if (pn < 4) { base = WS_MLQ; ldc = 1024; c0 = pn * 256; }
        else if (pn < 8) { base = WS_MLK; ldc = 1024; c0 = (pn - 4) * 256; mode = 1; }
        else if (pn < 12) { base = WS_MLV; ldc = 1024; c0 = (pn - 8) * 256; }
        else if (pn < 16) { base = WS_MLO; ldc = 1024; c0 = (pn - 12) * 256; mode = 2; }
        else if (pn < 22) { base = WS_MQ; ldc = 1536; c0 = (pn - 16) * 256; mode = 3; }
        else if (pn < 29) { base = WS_S5U; ldc = 1024; c0 = (pn - 25) * 256; }
        else if (pn < 33) { base = WS_DFQ; ldc = 1024; c0 = (pn - 29) * 256; mode = 4; }
        else if (pn < 37) { base = WS_DFK; ldc = 1024; c0 = (pn - 33) * 256; }
        else { base = WS_DFV; ldc = 1024; c0 = (pn - 37) * 256; }
        bf16_t* O = (bf16_t*)(ws + base);
        PG8_FOR({ pg8::f32x4 a = v0, b = v1;
            if (mode == 1) { a = a * 0.0625f; b = b * 0.0625f; }
            if (mode == 3) { a = a * (0.07216878364870322f * 1.4426950408889634f); b = b * (0.07216878364870322f * 1.4426950408889634f); }
            if (mode == 4) { a = a * (0.125f * 1.4426950408889634f); b = b * (0.125f * 1.4426950408889634f); }
            if (mode == 2) {
_Pragma("unroll")
                for (int e = 0; e < 4; ++e) { a[e] = sigmoidf_(a[e]); b[e] = sigmoidf_(b[e]); } }
            *(u32x4*)(O + (size_t)row * ldc + c0 + ct) = pack8(a, b); })
    }
};
struct Epi8Gate {
    static constexpr bool PERM = true, AFTER_DRAIN = false;
    bf16_t* gs;
    __device__ __forceinline__ void operator()(const pg8::f32x4 (&acc)[2][2][4][2], const pg8::Unit& u, int wr, int wc, int fr, int fq) const {
        PG8_FOR({ pg8::f32x4 a, b;
_Pragma("unroll")
            for (int e = 0; e < 4; ++e) { a[e] = sigmoidf_(v0[e]); b[e] = sigmoidf_(v1[e]); }
            *(u32x4*)(gs + (size_t)row * GATE_COLS + u.pn * 256 + ct) = pack8(a, b); })
    }
};
struct Epi8Kvb {
    static constexpr bool PERM = true, AFTER_DRAIN = false;
    bf16_t* kf; bf16_t* vf;
    __device__ __forceinline__ void operator()(const pg8::f32x4 (&acc)[2][2][4][2], const pg8::Unit& u, int wr, int wc, int fr, int fq) const {
        PG8_FOR({ bf16_t* o = bj == 0 ? kf + (size_t)row * 1536 + u.pn * 192 + wc * 32 + 8 * fq : vf + (size_t)row * 1024 + u.pn * 128 + wc * 32 + 8 * fq; (void)ct;
            *(u32x4*)o = pack8(v0, v1); })
    }
};
struct Epi8Glu {
    static constexpr bool PERM = true, AFTER_DRAIN = false;
    const bf16_t* g; bf16_t* y;
    __device__ __forceinline__ void operator()(const pg8::f32x4 (&acc)[2][2][4][2], const pg8::Unit& u, int wr, int wc, int fr, int fq) const {
        PG8_FOR({ const size_t i = (size_t)row * 1024 + u.pn * 256 + ct; float gf[8]; unpack8(*(const u32x4*)(g + i), gf); pg8::f32x4 a, b;
_Pragma("unroll")
            for (int e = 0; e < 4; ++e) { a[e] = gf[e] * sigmoidf_(v0[e]); b[e] = gf[4 + e] * sigmoidf_(v1[e]); }
            *(u32x4*)(y + i) = pack8(a, b); })
    }
};
struct Epi8Merge {
    static constexpr bool PERM = true, AFTER_DRAIN = false;
    const bf16_t* gs; bf16_t* mg; int b; int pad;
    __device__ __forceinline__ void operator()(const pg8::f32x4 (&acc)[2][2][4][2], const pg8::Unit& u, int wr, int wc, int fr, int fq) const {
        PG8_FOR({ const size_t i = (size_t)row * D + u.pn * 256 + ct; float gf[8], pf[8]; unpack8(*(const u32x4*)(gs + (size_t)row * GATE_COLS + b * D + u.pn * 256 + ct), gf);
            if (b) unpack8(*(const u32x4*)(mg + i), pf); else {
_Pragma("unroll")
                for (int e = 0; e < 8; ++e) pf[e] = 0.f; }
            pg8::f32x4 a, c;
_Pragma("unroll")
            for (int e = 0; e < 4; ++e) { a[e] = pf[e] + gf[e] * v0[e]; c[e] = pf[4 + e] + gf[4 + e] * v1[e]; }
            *(u32x4*)(mg + i) = pack8(a, c); })
    }
};
struct Epi8Res {
    static constexpr bool PERM = true, AFTER_DRAIN = false;
    P p; int l; int goff; int from_x; int pad;
    __device__ __forceinline__ void operator()(const pg8::f32x4 (&acc)[2][2][4][2], const pg8::Unit& u, int wr, int wc, int fr, int fq) const {
        bf16_t* X = (bf16_t*)(p.ws + WS_X);
        const float* gv = (const float*)(p.ws + WS_MOD) + ((size_t)l * 5 + cond_of_row(u.pm * 256)) * 12288 + goff + u.pn * 256;
        const bool from_in = (!from_x && l == 0);
        PG8_FOR({ bf16_t* dst = X + (size_t)row * D + u.pn * 256 + ct;
            const pg8::f32x4 g0 = *(const pg8::f32x4*)(gv + ct), g1 = *(const pg8::f32x4*)(gv + ct + 4); pg8::f32x4 s0, s1;
            if (from_in) { const float* src = x_in(p, row) + u.pn * 256 + ct; s0 = *(const pg8::f32x4*)src; s1 = *(const pg8::f32x4*)(src + 4); }
            else { float sf[8]; unpack8(*(const u32x4*)dst, sf); s0 = (pg8::f32x4){sf[0], sf[1], sf[2], sf[3]}; s1 = (pg8::f32x4){sf[4], sf[5], sf[6], sf[7]}; }
            *(u32x4*)dst = pack8(s0 + g0 * v0, s1 + g1 * v1); })
    }
};
struct Epi8FfnIn {
    static constexpr bool PERM = true, AFTER_DRAIN = false;
    bf16_t* hh;
    __device__ __forceinline__ void operator()(const pg8::f32x4 (&acc)[2][2][4][2], const pg8::Unit& u, int wr, int wc, int fr, int fq) const {
_Pragma("unroll")
        for (int ai = 0; ai < 2; ++ai)
_Pragma("unroll")
            for (int m = 0; m < 4; ++m) { const int row = PG8_ROW(ai, m); pg8::f32x4 a, b;
_Pragma("unroll")
                for (int e = 0; e < 4; ++e) { a[e] = siluf_(acc[ai][0][m][0][e]) * acc[ai][1][m][0][e]; b[e] = siluf_(acc[ai][0][m][1][e]) * acc[ai][1][m][1][e]; }
                *(u32x4*)(hh + (size_t)row * FFN + u.pn * 128 + wc * 32 + 8 * fq) = pack8(a, b); }
    }
};

__device__ __forceinline__ int win_row(int n) {
    if (n < 4096) return n;
    if (n < 4112) return 6208 + (n - 4096);
    if (n < 5648) return 4096 + (n - 4112);
    if (n < 6224) return 5632 + (n - 5648);
    if (n < MIX_COLS) return 6400 + (n - 6224);
    return 10496 + (n - MIX_COLS);
}
template <int MAP>
__device__ __forceinline__ void cvt_item(const float* W, int K, int N, bf16_t* WT, int row_off, LAS float* scr, int item, int lane) {
    const int nblk = (N + 31) / 32, kb = item / nblk, nb = item % nblk, k0 = 64 * kb, n0 = 32 * nb;
    const int nl = (lane & 7) * 4, kr = lane >> 3;
    const bool nok = n0 + nl < N;
    const float* wp = W + (size_t)(k0 + kr) * N + n0 + nl;
    f32x4 v[8];
#pragma unroll
    for (int i = 0; i < 8; ++i) v[i] = nok ? *(const f32x4*)(wp + (size_t)(8 * i) * N) : (f32x4){0.f, 0.f, 0.f, 0.f};
#pragma unroll
    for (int i = 0; i < 8; ++i) { LAS float* d = scr + (kr + 8 * i) * 33 + nl; d[0] = v[i][0]; d[1] = v[i][1]; d[2] = v[i][2]; d[3] = v[i][3]; }
    asm volatile("s_waitcnt lgkmcnt(0)" ::: "memory");
    const int c = lane & 7;
#pragma unroll
    for (int j = 0; j < 4; ++j) { const int n = (lane >> 3) + 8 * j; const LAS float* s = scr + (8 * c) * 33 + n;
        u32x4 o; o.x = pk2(s[0 * 33], s[1 * 33]); o.y = pk2(s[2 * 33], s[3 * 33]); o.z = pk2(s[4 * 33], s[5 * 33]); o.w = pk2(s[6 * 33], s[7 * 33]);
        const int ng = n0 + n; int row;
        if (MAP == 0) row = row_off + ng; else if (MAP == 1) row = win_row(ng); else row = (ng < FFN) ? ((ng >> 7) * 256 + (ng & 127)) : (((ng - FFN) >> 7) * 256 + 128 + ((ng - FFN) & 127));
        if (ng < N) *(u32x4*)(WT + (size_t)row * K + k0 + 8 * c) = o; }
    asm volatile("s_waitcnt lgkmcnt(0)" ::: "memory");
}
constexpr size_t WB_IN = 0, WB_KVB = 73 * MiB, WB_GLU = 75 * MiB, WB_BR = 77 * MiB, WB_O = 93 * MiB, WB_FIN = 101 * MiB, WB_FOUT = 145 * MiB, WB_END = 167 * MiB;
constexpr int NIN_T = 18688;
__device__ __forceinline__ void ph_convert(const P& p, int l, int gw, int NGW, int lane, LAS float* scr, const bool early, const bool late) {
    unsigned char* wb = p.ws + WS_WBF;
    constexpr int I_IN = (D / 64) * ((IN_COLS + 31) / 32), I_KVB = (512 / 64) * (2048 / 32), I_GLU = (1024 / 64) * (1024 / 32), I_BR = (1024 / 64) * (2048 / 32), I_O = (D / 64) * (D / 32),
                  I_FIN = (D / 64) * (2 * FFN / 32), I_FOUT = (FFN / 64) * (D / 32);
    constexpr int NIT = I_IN + I_KVB + I_GLU + 4 * I_BR + I_O + I_FIN + I_FOUT;
    const int it_lo = early ? 0 : NIT - I_FOUT, it_hi = late ? NIT : NIT - I_FOUT;
    for (int it = it_lo + gw; it < it_hi; it += NGW) {
        int r = it;
        if (r < I_IN) { cvt_item<1>(p.in[17] + (size_t)l * D * IN_COLS, D, IN_COLS, (bf16_t*)(wb + WB_IN), 0, scr, r, lane); continue; } r -= I_IN;
        if (r < I_KVB) { cvt_item<0>(p.in[21] + (size_t)l * 512 * 2048, 512, 2048, (bf16_t*)(wb + WB_KVB), 0, scr, r, lane); continue; } r -= I_KVB;
        if (r < I_GLU) { cvt_item<0>(p.in[30] + (size_t)l * 1024 * 1024, 1024, 1024, (bf16_t*)(wb + WB_GLU), 0, scr, r, lane); continue; } r -= I_GLU;
        if (r < 4 * I_BR) { const int b = r / I_BR; cvt_item<0>(p.in[33] + ((size_t)l * 4 + b) * 1024 * 2048, 1024, 2048, (bf16_t*)(wb + WB_BR) + (size_t)b * 2048 * 1024, 0, scr, r % I_BR, lane); continue; } r -= 4 * I_BR;
        if (r < I_O) { cvt_item<0>(p.in[34] + (size_t)l * D * D, D, D, (bf16_t*)(wb + WB_O), 0, scr, r, lane); continue; } r -= I_O;
        if (r < I_FIN) { cvt_item<2>(p.in[35] + (size_t)l * D * 2 * FFN, D, 2 * FFN, (bf16_t*)(wb + WB_FIN), 0, scr, r, lane); continue; } r -= I_FIN;
        cvt_item<0>(p.in[36] + (size_t)l * FFN * D, FFN, D, (bf16_t*)(wb + WB_FOUT), 0, scr, r, lane);
    }
    if (early) for (int row = 6224 + gw; row < 6400; row += NGW) { u32x4* o = (u32x4*)((bf16_t*)(wb + WB_IN) + (size_t)row * D); for (int j = lane; j < D / 8; j += 64) o[j] = (u32x4){0u, 0u, 0u, 0u}; }
}


__device__ __forceinline__ int xcd_slot() { const int G_ = (int)gridDim.x, c_ = (int)blockIdx.x; return (G_ % 8 == 0) ? (c_ % 8) * (G_ / 8) + c_ / 8 : c_; }
namespace fa {
typedef short s16x4 __attribute__((ext_vector_type(4)));
__device__ __forceinline__ int crow(int r, int hi) { return (r & 3) + 8 * (r >> 2) + 4 * hi; }
__device__ __forceinline__ unsigned cvtpk(float lo, float hi) { unsigned r; asm volatile("v_cvt_pk_bf16_f32 %0, %1, %2" : "=v"(r) : "v"(lo), "v"(hi)); return r; }
#define FA_SBAR() __builtin_amdgcn_sched_barrier(0)
constexpr float THR = 8.f;
__device__ __forceinline__ void partialSM_fma(f32x16& p0, f32x16& p1, float& m_reg, float& mn, float& alpha, float SCALE) {
    const float C = SCALE * 1.4426950408889634f;
    float pmax = p0[0];
#pragma unroll
    for (int r = 1; r < 16; ++r) pmax = fmaxf(pmax, p0[r]);
#pragma unroll
    for (int r = 0; r < 16; ++r) pmax = fmaxf(pmax, p1[r]);
    { auto rr = __builtin_amdgcn_permlane32_swap(__float_as_uint(pmax), __float_as_uint(pmax), false, false);
      pmax = fmaxf(__uint_as_float(rr[0]), __uint_as_float(rr[1])); }
    if (__builtin_expect(__all(pmax - m_reg <= THR / SCALE), 1)) { mn = m_reg; alpha = 1.f; }
    else { mn = fmaxf(m_reg, pmax); alpha = __builtin_amdgcn_exp2f((m_reg - mn) * C); m_reg = mn; }
    const float mnC = -mn * C;
#pragma unroll
    for (int r = 0; r < 16; ++r) p0[r] = fmaf(p0[r], C, mnC);
#pragma unroll
    for (int r = 0; r < 16; ++r) p1[r] = fmaf(p1[r], C, mnC);
#pragma unroll
    for (int r = 0; r < 16; ++r) p0[r] = __builtin_amdgcn_exp2f(p0[r]);
}
constexpr float THR2 = THR * 1.4426950408889634f;
__device__ __forceinline__ void partialSM(f32x16& p0, f32x16& p1, float& m_reg, f32x16& nm, float& alpha, const bool first) {
    float pmax = p0[0];
#pragma unroll
    for (int r = 1; r < 16; ++r) pmax = fmaxf(pmax, p0[r]);
#pragma unroll
    for (int r = 0; r < 16; ++r) pmax = fmaxf(pmax, p1[r]);
    { auto rr = __builtin_amdgcn_permlane32_swap(__float_as_uint(pmax), __float_as_uint(pmax), false, false);
      pmax = fmaxf(__uint_as_float(rr[0]), __uint_as_float(rr[1])); }
    alpha = 1.f;
    if (first || !__all(pmax <= THR2)) {
        const float d = first ? pmax : fmaxf(pmax, 0.f);
        if (!first) alpha = __builtin_amdgcn_exp2f(-d);
        m_reg += d;
#pragma unroll
        for (int r = 0; r < 16; ++r) { p0[r] -= d; p1[r] -= d; nm[r] = -m_reg; }
    }
#pragma unroll
    for (int r = 0; r < 16; ++r) p0[r] = __builtin_amdgcn_exp2f(p0[r]);
}
__device__ __forceinline__ void finishSM(f32x16& p0, f32x16& p1, float alpha, float& l_reg, bf16x8& pa0, bf16x8& pa1, bf16x8& pa2, bf16x8& pa3) {
#pragma unroll
    for (int r = 0; r < 16; ++r) p1[r] = __builtin_amdgcn_exp2f(p1[r]);
    FA_SBAR(); asm volatile("s_nop 1");
    float ps = 0;
#pragma unroll
    for (int r = 0; r < 16; ++r) ps += p0[r];
#pragma unroll
    for (int r = 0; r < 16; ++r) ps += p1[r];
    { auto rr = __builtin_amdgcn_permlane32_swap(__float_as_uint(ps), __float_as_uint(ps), false, false);
      ps = __uint_as_float(rr[0]) + __uint_as_float(rr[1]); }
    l_reg = l_reg * alpha + ps;
#define FA_PK4(P, BASE, OUT) do { u32x4 w = {cvtpk(P[BASE + 0], P[BASE + 1]), cvtpk(P[BASE + 2], P[BASE + 3]), cvtpk(P[BASE + 4], P[BASE + 5]), cvtpk(P[BASE + 6], P[BASE + 7])}; \
    OUT = *reinterpret_cast<bf16x8*>(&w); } while (0)
    FA_PK4(p0, 0, pa0); FA_PK4(p0, 8, pa1); FA_PK4(p1, 0, pa2); FA_PK4(p1, 8, pa3);
#undef FA_PK4
}
__device__ __forceinline__ int v_rd_base(int lane) { return ((lane & 3) << 3) | (((lane >> 2) & 3) << 6) | (((lane >> 4) & 1) << 5) | (((lane >> 5) & 1) << 8); }
constexpr int v_rd_off(int d0, int ks, int half) { return d0 * 512 + ks * 4096 + half * 2048; }
__device__ __forceinline__ bf16x8 lds_rd128i(unsigned addr, const int off) { bf16x8 r; asm volatile("ds_read_b128 %0, %1 offset:%2" : "=&v"(r) : "v"(addr), "i"(off) : "memory"); return r; }
template <int OFF> __device__ __forceinline__ bf16x8 lds_rd128(unsigned addr) { bf16x8 r; asm volatile("ds_read_b128 %0, %1 offset:%2" : "=&v"(r) : "v"(addr), "i"(OFF) : "memory"); return r; }
template <int OFF> __device__ __forceinline__ s16x4 tr_read(unsigned vb) {
    s16x4 r; asm volatile("ds_read_b64_tr_b16 %0, %1 offset:%2" : "=&v"(r) : "v"(vb), "i"(OFF) : "memory"); return r;
}
template <int D0> __device__ __forceinline__ void pv_one(f32x16& od, unsigned vb, bf16x8 pa0, bf16x8 pa1, bf16x8 pa2, bf16x8 pa3) {
    const s16x4 l0 = tr_read<v_rd_off(D0, 0, 0)>(vb), h0 = tr_read<v_rd_off(D0, 0, 1)>(vb), l1 = tr_read<v_rd_off(D0, 1, 0)>(vb), h1 = tr_read<v_rd_off(D0, 1, 1)>(vb);
    const s16x4 l2 = tr_read<v_rd_off(D0, 2, 0)>(vb), h2 = tr_read<v_rd_off(D0, 2, 1)>(vb), l3 = tr_read<v_rd_off(D0, 3, 0)>(vb), h3 = tr_read<v_rd_off(D0, 3, 1)>(vb);
    asm volatile("s_waitcnt lgkmcnt(0)" ::: "memory"); FA_SBAR();
#define FA_PK(L, H) (bf16x8){L[0], L[1], L[2], L[3], H[0], H[1], H[2], H[3]}
    od = __builtin_amdgcn_mfma_f32_32x32x16_bf16(pa0, FA_PK(l0, h0), od, 0, 0, 0);
    od = __builtin_amdgcn_mfma_f32_32x32x16_bf16(pa1, FA_PK(l1, h1), od, 0, 0, 0);
    od = __builtin_amdgcn_mfma_f32_32x32x16_bf16(pa2, FA_PK(l2, h2), od, 0, 0, 0);
    od = __builtin_amdgcn_mfma_f32_32x32x16_bf16(pa3, FA_PK(l3, h3), od, 0, 0, 0);
#undef FA_PK
}
struct Args { const bf16_t* Q; const bf16_t* K; const bf16_t* V; bf16_t* O; int qpitch, kpitch, vpitch, opitch, nheads, vdiv; float scale; int pad; };

template <int DQK>
__device__ __forceinline__ void attn_phase(LAS unsigned char* lds, const Args& a, int tid) {
    constexpr int KROWB = DQK * 2, KCH = KROWB / 16, KTILE = 64 * KROWB, VTILE = 16384, STAGE = KTILE + VTILE, NKI = KTILE / 8192, NVI = 2, NDMA = NKI + NVI, ND = DQK / 16;
    constexpr int RING = (DQK == 64) ? 4 : 3;
    static_assert(RING * STAGE + 2048 <= 131072, "attention LDS");
    const int wid = __builtin_amdgcn_readfirstlane(tid >> 6), lane = tid & 63, r32 = lane & 31, hi = lane >> 5;
    const int krow = (r32 & ~0xC) | ((r32 & 4) << 1) | ((r32 & 8) >> 1);
    LAS float* wsc = (LAS float*)(lds + RING * STAGE) + wid * 64;
    unsigned koff_[NKI], voff_[NVI];
#pragma unroll
    for (int i = 0; i < NKI; ++i) { const int s = i * 512 + wid * 64 + lane, row = s / KCH, ch = s % KCH; koff_[i] = (unsigned)(row * a.kpitch + (ch ^ ((row & 3) | (((row >> 3) & 1) << 2))) * 8) * 2u; }
#pragma unroll
    for (int i = 0; i < NVI; ++i) { const int o = (i * 512 + wid * 64 + lane) * 16, sub = o >> 9, within = o & 511, kk = (sub >> 2) * 8 + (within >> 6), c = (sub & 3) * 32 + ((within & 63) >> 1);
        const int k = (kk & ~0xC) | ((kk & 4) << 1) | ((kk & 8) >> 1); voff_[i] = (unsigned)(k * a.vpitch + c) * 2u; }
    const unsigned vb0 = (unsigned)(uintptr_t)(lds + KTILE) + (unsigned)v_rd_base(lane);
    const int n_lat = a.nheads * 64, n_units = n_lat + a.nheads * 16;
    for (int u = xcd_slot(); u < n_units; u += gridDim.x) {
        int b, h, q0, nk, kbase, cbase;
        if (u < n_lat) { const int bh = u >> 4, qb = u & 15; b = bh / a.nheads; h = bh % a.nheads; q0 = NCTX + b * LL + qb * 256; nk = LL + PAST; kbase = NCTX + b * LL; cbase = MTOK + b * PAST; }
        else { const int v = u - n_lat; b = v / a.nheads; h = v % a.nheads; q0 = b * CL; nk = CL; kbase = b * CL; cbase = 0; }
        const int NT = nk >> 6, vh = h / a.vdiv;
        const bf16_t* Kh = a.K + h * DQK; const bf16_t* Vh = a.V + vh * 128;
#define FA_ISSUE(j) do { const int t0_ = (j) * 64; const int rb_ = (t0_ < LL || nk == CL) ? kbase + t0_ : cbase + (t0_ - LL); LAS unsigned char* st_ = lds + ((j) % RING) * STAGE; \
        const char* kb_ = (const char*)(Kh + (size_t)rb_ * a.kpitch); const char* vb_ = (const char*)(Vh + (size_t)rb_ * a.vpitch); \
        _Pragma("unroll") for (int i_ = 0; i_ < NKI; ++i_) __builtin_amdgcn_global_load_lds((const unsigned*)(kb_ + koff_[i_]), (LAS unsigned*)(st_ + i_ * 8192 + wid * 1024), 16, 0, 0); \
        _Pragma("unroll") for (int i_ = 0; i_ < NVI; ++i_) __builtin_amdgcn_global_load_lds((const unsigned*)(vb_ + voff_[i_]), (LAS unsigned*)(st_ + KTILE + i_ * 8192 + wid * 1024), 16, 0, 0); } while (0)
        bf16x8 qr[ND];
        { const bf16_t* Qw = a.Q + (size_t)(q0 + wid * 32 + r32) * a.qpitch + h * DQK + hi * 8;
#pragma unroll
          for (int d0 = 0; d0 < ND; ++d0) qr[d0] = *(const bf16x8*)(Qw + d0 * 16); }
        float m_reg = 0.f, l_reg = 0.f; f32x16 o[4], nm;
        float z0 = 0.f; asm volatile("" : "+v"(z0));
#pragma unroll
        for (int d = 0; d < 4; ++d)
#pragma unroll
            for (int r = 0; r < 16; ++r) o[d][r] = z0;
#pragma unroll
        for (int r = 0; r < 16; ++r) nm[r] = z0;
        FA_ISSUE(0); FA_ISSUE(1);
        if constexpr (DQK != 64) { if (NDMA == 5) asm volatile("s_waitcnt vmcnt(5)" ::: "memory"); else asm volatile("s_waitcnt vmcnt(3)" ::: "memory");
            __builtin_amdgcn_s_barrier(); asm volatile("" ::: "memory"); }
        auto tile = [&](const int j) __attribute__((always_inline)) {
            LAS unsigned char* Ks = lds + (j % RING) * STAGE;
            f32x16 p0 = nm, p1 = nm;
            constexpr int KD = (DQK == 64) ? 3 : 2;
            bf16x8 kb[KD][2];
            unsigned kae[4];
#pragma unroll
            for (int e = 0; e < 4; ++e) kae[e] = (unsigned)(uintptr_t)Ks + (unsigned)(krow * KROWB + (((2 * e + hi) ^ ((krow & 3) | (((krow >> 3) & 1) << 2))) << 4));
#define FA_LDK(d0_, s_) do { kb[s_][0] = lds_rd128i(kae[(d0_) & 3], ((d0_) >> 2) * 128); kb[s_][1] = lds_rd128i(kae[(d0_) & 3], 32 * KROWB + ((d0_) >> 2) * 128); } while (0)
#pragma unroll
            for (int d0 = 0; d0 < KD - 1; ++d0) FA_LDK(d0, d0);
#pragma unroll
            for (int d0 = 0; d0 < ND; ++d0) {
                if (d0 + KD - 1 < ND) FA_LDK(d0 + KD - 1, (d0 + KD - 1) % KD);
                const int ahead = (ND - 1 - d0) < (KD - 1) ? (ND - 1 - d0) : (KD - 1);
                if (ahead == 2) asm volatile("s_waitcnt lgkmcnt(4)" ::: "memory"); else if (ahead == 1) asm volatile("s_waitcnt lgkmcnt(2)" ::: "memory"); else asm volatile("s_waitcnt lgkmcnt(0)" ::: "memory");
                FA_SBAR();
                p0 = __builtin_amdgcn_mfma_f32_32x32x16_bf16(kb[d0 % KD][0], qr[d0], p0, 0, 0, 0);
                p1 = __builtin_amdgcn_mfma_f32_32x32x16_bf16(kb[d0 % KD][1], qr[d0], p1, 0, 0, 0);
                FA_SBAR(); }
#undef FA_LDK
            float alpha; partialSM(p0, p1, m_reg, nm, alpha, j == 0);
            if (__any(alpha < 1.f)) { if (hi == 0) wsc[32 + r32] = alpha; asm volatile("s_waitcnt lgkmcnt(0)" ::: "memory");
#pragma unroll
                for (int d = 0; d < 4; ++d)
#pragma unroll
                    for (int r = 0; r < 16; ++r) o[d][r] *= wsc[32 + crow(r, hi)]; }
            bf16x8 pa0, pa1, pa2, pa3; finishSM(p0, p1, alpha, l_reg, pa0, pa1, pa2, pa3); FA_SBAR();
            const unsigned vb = vb0 + (unsigned)((j % RING) * STAGE);
            pv_one<0>(o[0], vb, pa0, pa1, pa2, pa3); pv_one<1>(o[1], vb, pa0, pa1, pa2, pa3); pv_one<2>(o[2], vb, pa0, pa1, pa2, pa3); pv_one<3>(o[3], vb, pa0, pa1, pa2, pa3);
        };
        if constexpr (DQK == 64) {
            asm volatile("s_waitcnt vmcnt(0)" ::: "memory");
            __builtin_amdgcn_s_barrier(); asm volatile("" ::: "memory");
            for (int j = 0; j < NT; j += 2) {
                if (j + 2 < NT) { FA_ISSUE(j + 2); FA_ISSUE(j + 3); }
                tile(j); tile(j + 1);
                asm volatile("s_waitcnt vmcnt(0)" ::: "memory");
                asm volatile("s_waitcnt lgkmcnt(0)" ::: "memory");
                __builtin_amdgcn_s_barrier(); asm volatile("" ::: "memory");
            }
        } else
        for (int j = 0; j < NT; ++j) {
            if (j + 2 < NT) FA_ISSUE(j + 2);
            tile(j);
            if (j + 2 < NT) { if (NDMA == 5) asm volatile("s_waitcnt vmcnt(5)" ::: "memory"); else asm volatile("s_waitcnt vmcnt(3)" ::: "memory"); }
            else asm volatile("s_waitcnt vmcnt(0)" ::: "memory");
            asm volatile("s_waitcnt lgkmcnt(0)" ::: "memory");
            __builtin_amdgcn_s_barrier(); asm volatile("" ::: "memory");
        }
#undef FA_ISSUE
        if (hi == 0) wsc[r32] = l_reg; asm volatile("s_waitcnt lgkmcnt(0)" ::: "memory");
        bf16_t* Ow = a.O + (size_t)(q0 + wid * 32) * a.opitch + h * 128 + r32;
#pragma unroll
        for (int r = 0; r < 16; ++r) { const int orow = crow(r, hi); const float rl = __builtin_amdgcn_rcpf(wsc[orow]);
#pragma unroll
            for (int d0 = 0; d0 < 4; ++d0) Ow[(size_t)orow * a.opitch + d0 * 32] = (bf16_t)f2bf(o[d0][r] * rl); }
        asm volatile("s_waitcnt lgkmcnt(0)" ::: "memory");
    }
}
}


namespace ml {
typedef short s16x4 __attribute__((ext_vector_type(4)));
constexpr int QP = 528, VP = 80, CP = 528, PP = 144;
constexpr size_t WS_SCT = WS_CT, WS_WC = WS_CT + 4 * MiB, WS_DENI = WS_CT + 5 * MiB, WS_KW = WS_CT + 6 * MiB;
__device__ __forceinline__ s16x4 trr(unsigned addr) { s16x4 r; asm volatile("ds_read_b64_tr_b16 %0, %1" : "=&v"(r) : "v"(addr) : "memory"); return r; }
__device__ __forceinline__ unsigned cvtpk(float lo, float hi) { unsigned r; asm volatile("s_nop 0\n\tv_cvt_pk_bf16_f32 %0, %1, %2\n\ts_nop 1" : "=v"(r) : "v"(lo), "v"(hi)); return r; }
__device__ __forceinline__ int crow(int r, int hi) { return (r & 3) + 8 * (r >> 2) + 4 * hi; }
#define ML_BAR() do { asm volatile("s_waitcnt lgkmcnt(0)" ::: "memory"); __builtin_amdgcn_s_barrier(); asm volatile("" ::: "memory"); } while (0)
#define ML_TOK(c, i) (base + (dir ? (L - 1 - ((c) * 64 + (i))) : ((c) * 64 + (i))))
__device__ __forceinline__ float logsig(float g) { return fminf(g, 0.f) - __logf(1.0f + __expf(-fabsf(g))); }

__device__ __forceinline__ void scalars_wg(const P& p, const int l, const int chain, const int wave, const int lane, LAS float* sx) {
    const bool lat = chain >= 128; const int cc = lat ? chain - 128 : chain, b = cc >> 3, h = (cc >> 1) & 3, dir = cc & 1;
    const int L = lat ? LL : CL, base = lat ? NCTX + b * LL : b * CL, NC = L >> 6;
    const float* kva = (const float*)(p.ws + WS_KVA) + 576 + dir * 8 + h;
    const float bi = p.in[18][l * 16 + dir * 8 + h], bf = p.in[18][l * 16 + dir * 8 + 4 + h];
    float li_[8], lf_[8];
#pragma unroll
    for (int j = 0; j < 8; ++j) { const int c = wave + 8 * j; li_[j] = 0.f; lf_[j] = 0.f; if (c < NC) { const float* r_ = kva + (size_t)ML_TOK(c, lane) * KVAW; li_[j] = r_[0] + bi; lf_[j] = r_[4] + bf; } }
    float bb_[8], gg_[8], pm_[8];
#pragma unroll
    for (int j = 0; j < 8; ++j) { const int c = wave + 8 * j;
        float bc = logsig(lf_[j]);
#pragma unroll
        for (int o = 1; o < 64; o <<= 1) { const float t_ = __shfl_up(bc, o); if (lane >= o) bc += t_; }
        const float g = li_[j] - bc; float pm = g;
#pragma unroll
        for (int o = 1; o < 64; o <<= 1) { const float t_ = __shfl_up(pm, o); if (lane >= o) pm = fmaxf(pm, t_); }
        bb_[j] = bc; gg_[j] = g; pm_[j] = pm;
        if (lane == 63) { sx[c] = (c < NC) ? bc : 0.f; sx[64 + c] = (c < NC) ? bc + pm : -1e30f; } }
    __syncthreads();
    float al = sx[lane], be = sx[64 + lane];
#pragma unroll
    for (int o = 1; o < 64; o <<= 1) { const float ea = __shfl_up(al, o), eb = __shfl_up(be, o); if (lane >= o) { be = fmaxf(eb + al, be); al = ea + al; } }
    float m0 = 0.f; if (lat) m0 = p.in[8][(size_t)((b * 2 + l) * 2 + dir) * 4 + h];
    const float pa = __shfl_up(al, 1), pb = __shfl_up(be, 1);
    const float mst_all = lane == 0 ? m0 : fmaxf(m0 + pa, pb);
    if (!lat && wave == 0 && lane == NC - 1) p.out[O_MM + ((b * 2 + l) * 2 + dir) * 4 + h] = fmaxf(m0 + al, be);
    f32x4* sct = (f32x4*)(p.ws + WS_SCT);
#pragma unroll
    for (int j = 0; j < 8; ++j) { const int c = wave + 8 * j;
        const float m_st = __shfl(mst_all, c & 63);
        if (c < NC) { const float mxl = fmaxf(m_st, __shfl(pm_[j], 63)), mx = fmaxf(m_st, pm_[j]);
            sct[((size_t)ML_TOK(c, lane) * 2 + dir) * 4 + h] = (f32x4){__expf(pm_[j] - mx), __expf(m_st - mx), __expf(-(bb_[j] + mx)), __expf(gg_[j] - mxl)};
            if (lane == 0) ((float*)(p.ws + WS_WC))[chain * 64 + c] = __expf(m_st - mxl); } }
    __syncthreads();
}

constexpr int B_Q = 0, B_K = 33792, B_V = 67584, B_P = 101376, B_S = 110592, B_END = 112640;
__device__ __forceinline__ void intra_phase(LAS unsigned char* lds, const P& p, const int l, const int tid) {
    const int wid = __builtin_amdgcn_readfirstlane(tid >> 6), lane = tid & 63, r32 = lane & 31, hi = lane >> 5;
    const bf16_t* MQ_ = (const bf16_t*)(p.ws + WS_MLQ); const bf16_t* MK_ = (const bf16_t*)(p.ws + WS_MLK); const bf16_t* MV_ = (const bf16_t*)(p.ws + WS_MLV);
    LAS float* sg = (LAS float*)(lds + B_S); LAS float* spm = sg + 64; LAS float* sws = sg + 128; LAS float* sd0 = sg + 192; LAS float* sd1 = sg + 256;
    const unsigned ldsb = (unsigned)(uintptr_t)lds;
    const int tq = (lane & 15) >> 2, tp = lane & 3, tc0 = 16 * ((lane >> 4) & 1) + 4 * tp;
    u32x4 q4[4], k4[4], v4[4]; float gli = 0.f, glf = 0.f, gws = 0.f;
#define B_DECODE(uu) const bool lat = (uu) < 2048; const int chain = lat ? 128 + ((uu) >> 6) : ((uu) - 2048) >> 2, c = lat ? ((uu) & 63) : (((uu) - 2048) & 3); \
        const int cc = lat ? chain - 128 : chain, b = cc >> 3, h = (cc >> 1) & 3, dir = cc & 1; const int L = lat ? LL : CL, base = lat ? NCTX + b * LL : b * CL;
#define B_LOAD(uu) do { B_DECODE(uu) (void)chain; \
        _Pragma("unroll") for (int i = 0; i < 4; ++i) { const int ch = tid + 512 * i, row = ch >> 5, c16 = ch & 31; const size_t g_ = (size_t)ML_TOK(c, row) * 1024 + h * 256 + c16 * 8; \
            q4[i] = *(const u32x4*)(MQ_ + g_); k4[i] = *(const u32x4*)(MK_ + g_); v4[i] = *(const u32x4*)(MV_ + g_); } \
        if (wid == 7) { const int row = ML_TOK(c, lane); const float* r_ = (const float*)(p.ws + WS_KVA) + (size_t)row * KVAW + 576 + dir * 8 + h; \
            gli = r_[0] + p.in[18][l * 16 + dir * 8 + h]; glf = r_[4] + p.in[18][l * 16 + dir * 8 + 4 + h]; gws = ((const f32x4*)(p.ws + WS_SCT))[((size_t)row * 2 + dir) * 4 + h][3]; } } while (0)
    if ((int)blockIdx.x < 2560) B_LOAD((int)blockIdx.x);
    for (int u = blockIdx.x; u < 2560; u += gridDim.x) {
        B_DECODE(u)
        bf16_t* Hout = (bf16_t*)(p.ws + (dir ? WS_HB : WS_HF));
#pragma unroll
        for (int i = 0; i < 4; ++i) { const int ch = tid + 512 * i, row = ch >> 5, c16 = ch & 31;
            *(LAS u32x4*)(lds + B_Q + row * QP + c16 * 16) = q4[i]; *(LAS u32x4*)(lds + B_K + row * QP + c16 * 16) = k4[i]; *(LAS u32x4*)(lds + B_V + row * QP + c16 * 16) = v4[i]; }
        if (wid == 7) {
            float bc = logsig(glf);
#pragma unroll
            for (int o = 1; o < 64; o <<= 1) { const float t_ = __shfl_up(bc, o); if (lane >= o) bc += t_; }
            const float g = gli - bc; float pm = g;
#pragma unroll
            for (int o = 1; o < 64; o <<= 1) { const float t_ = __shfl_up(pm, o); if (lane >= o) pm = fmaxf(pm, t_); }
            sg[lane] = g; spm[lane] = pm; sws[lane] = gws;
        }
        if (u + (int)gridDim.x < 2560) B_LOAD(u + (int)gridDim.x);
        ML_BAR();
        if (wid < 3) {
            const int tb = wid == 0 ? 0 : 1, sb = wid == 2 ? 1 : 0, t = tb * 32 + r32;
            f32x16 p0; { float z0 = 0.f; asm volatile("" : "+v"(z0));
#pragma unroll
              for (int r = 0; r < 16; ++r) p0[r] = z0; }
#pragma unroll 4
            for (int ks = 0; ks < 16; ++ks) { const int cb = (ks * 16 + hi * 8) * 2;
                const bf16x8 qf = *(const LAS bf16x8*)(lds + B_Q + t * QP + cb), kf = *(const LAS bf16x8*)(lds + B_K + (sb * 32 + r32) * QP + cb);
                p0 = __builtin_amdgcn_mfma_f32_32x32x16_bf16(kf, qf, p0, 0, 0, 0); }
            const float mpm = -spm[t]; float dsum = 0.f;
#pragma unroll
            for (int r = 0; r < 16; ++r) { const int s = sb * 32 + crow(r, hi); const float w = (s <= t) ? __expf(sg[s] + mpm) : 0.f; p0[r] *= w; dsum += p0[r]; }
            { auto rr = __builtin_amdgcn_permlane32_swap(__float_as_uint(dsum), __float_as_uint(dsum), false, false); dsum = __uint_as_float(rr[0]) + __uint_as_float(rr[1]); }
            if (hi == 0) { if (sb == 0) sd0[t] = dsum; else sd1[r32] = dsum; }
#pragma unroll
            for (int i = 0; i < 4; ++i) { u32x2 w; w.x = cvtpk(p0[4 * i], p0[4 * i + 1]); w.y = cvtpk(p0[4 * i + 2], p0[4 * i + 3]);
                *(LAS u32x2*)(lds + B_P + t * PP + (sb * 32 + 8 * i + 4 * hi) * 2) = w; }
        } else if (wid >= 4) {
            const int k = tid - 256; float acc = 0.f;
#pragma unroll 8
            for (int s = 0; s < 64; ++s) acc += sws[s] * bf2f(*(const LAS unsigned short*)(lds + B_K + s * QP + k * 2));
            ((float*)(p.ws + WS_KW))[((size_t)chain * 64 + c) * 256 + k] = acc;
        }
        ML_BAR();
        {
            f32x16 h0, h1; { float z0 = 0.f; asm volatile("" : "+v"(z0));
#pragma unroll
              for (int r = 0; r < 16; ++r) { h0[r] = z0; h1[r] = z0; } }
#pragma unroll
            for (int ks = 0; ks < 4; ++ks) {
                const unsigned va = ldsb + B_V + (16 * ks + 8 * hi + tq) * QP + (wid * 32 + tc0) * 2;
                const s16x4 lo = trr(va), hh = trr(va + 4 * QP);
                const bf16x8 a1 = *(const LAS bf16x8*)(lds + B_P + (32 + r32) * PP + (ks * 16 + hi * 8) * 2);
                bf16x8 a0 = a1; if (ks < 2) a0 = *(const LAS bf16x8*)(lds + B_P + r32 * PP + (ks * 16 + hi * 8) * 2);
                asm volatile("s_waitcnt lgkmcnt(0)" ::: "memory"); __builtin_amdgcn_sched_barrier(0);
                const bf16x8 vf = (bf16x8){lo[0], lo[1], lo[2], lo[3], hh[0], hh[1], hh[2], hh[3]};
                if (ks < 2) h0 = __builtin_amdgcn_mfma_f32_32x32x16_bf16(a0, vf, h0, 0, 0, 0);
                h1 = __builtin_amdgcn_mfma_f32_32x32x16_bf16(a1, vf, h1, 0, 0, 0); }
#pragma unroll
            for (int r = 0; r < 16; ++r) { const int t0 = crow(r, hi);
                Hout[(size_t)ML_TOK(c, t0) * 1024 + h * 256 + wid * 32 + r32] = (bf16_t)f2bf(h0[r]); Hout[(size_t)ML_TOK(c, 32 + t0) * 1024 + h * 256 + wid * 32 + r32] = (bf16_t)f2bf(h1[r]); }
            if (tid < 64) ((float*)(p.ws + WS_DENI))[((size_t)ML_TOK(c, tid) * 2 + dir) * 4 + h] = sd0[tid] + (tid >= 32 ? sd1[tid - 32] : 0.f);
        }
        ML_BAR();
    }
}

constexpr int L_Q = 0, L_K = 33792, L_V = 67584, L_CT = 72704, L_SC = 89600, L_NQ = 95744, L_N = 96256, L_PART = 98304, L_END = 114688;
__device__ __forceinline__ void seq_phase(LAS unsigned char* lds, const P& p, const int l, const int tid) {
    const int wid = __builtin_amdgcn_readfirstlane(tid >> 6), lane = tid & 63, r32 = lane & 31, hi = lane >> 5;
    const bf16_t* MQ_ = (const bf16_t*)(p.ws + WS_MLQ); const bf16_t* MK_ = (const bf16_t*)(p.ws + WS_MLK); const bf16_t* MV_ = (const bf16_t*)(p.ws + WS_MLV);
    const unsigned ldsb = (unsigned)(uintptr_t)lds;
    const int tq = (lane & 15) >> 2, tp = lane & 3, tc0 = 16 * ((lane >> 4) & 1) + 4 * tp;
    for (int u = xcd_slot(); u < 1280; u += gridDim.x) {
        const bool lat = u < 256; const int uu = lat ? u : u - 256, cc = uu >> 3, sl = uu & 7, chain = lat ? 128 + cc : cc;
        const int b = cc >> 3, h = (cc >> 1) & 3, dir = cc & 1;
        const int L = lat ? LL : CL, base = lat ? NCTX + b * LL : b * CL, NC = L >> 6;
        const int colq = h * 256, colv = h * 256 + sl * 32;
        bf16_t* Hout = (bf16_t*)(p.ws + (dir ? WS_HB : WS_HF));
        f32x16 ct, ia;
        { float z0 = 0.f; asm volatile("" : "+v"(z0));
#pragma unroll
          for (int r = 0; r < 16; ++r) { ct[r] = z0; ia[r] = z0; } }
        LAS float* nb0 = (LAS float*)(lds + L_N); LAS float* nb1 = nb0 + 256;
        if (lat) {
            const size_t so = (size_t)((b * 2 + l) * 2 + dir) * 4 + h;
            const float* c0 = p.in[6] + so * 65536 + (size_t)(sl * 32 + r32) * 256 + wid * 32 + 4 * hi;
#pragma unroll
            for (int i = 0; i < 4; ++i) { const f32x4 v4 = *(const f32x4*)(c0 + 8 * i); ct[4 * i] = v4[0]; ct[4 * i + 1] = v4[1]; ct[4 * i + 2] = v4[2]; ct[4 * i + 3] = v4[3]; }
            if (tid < 256) nb0[tid] = p.in[7][so * 256 + tid];
        } else if (tid < 256) nb0[tid] = 0.f;
        u32x4 pq[4], pk[4], pv; pv = (u32x4){0u, 0u, 0u, 0u}; f32x4 psc = {0.f, 0.f, 0.f, 0.f}; float pdi = 0.f, pwc = 0.f, pkw = 0.f; unsigned hpre[16];
#pragma unroll
        for (int r = 0; r < 16; ++r) hpre[r] = 0u;
#define ML_HPRE(cc_) do { _Pragma("unroll") for (int rr = 0; rr < 8; ++rr) hpre[rr] = Hout[(size_t)ML_TOK(cc_, (wid & 1) * 32 + crow(8 * (wid >> 1) + rr, hi)) * 1024 + colv + r32]; } while (0)
#define ML_LOAD(c) do { _Pragma("unroll") for (int i_ = 0; i_ < 4; ++i_) { const int ch_ = tid + 512 * i_, row_ = ch_ >> 5, c16_ = ch_ & 31; const size_t g_ = (size_t)ML_TOK(c, row_) * 1024 + colq + c16_ * 8; \
            pq[i_] = *(const u32x4*)(MQ_ + g_); pk[i_] = *(const u32x4*)(MK_ + g_); } \
        if (tid < 256) { const int row_ = tid >> 2, c16_ = tid & 3; pv = *(const u32x4*)(MV_ + (size_t)ML_TOK(c, row_) * 1024 + colv + c16_ * 8); } \
        else pkw = ((const float*)(p.ws + WS_KW))[((size_t)chain * 64 + (c)) * 256 + tid - 256]; \
        if (wid == 0) { const size_t ix_ = ((size_t)ML_TOK(c, lane) * 2 + dir) * 4 + h; psc = ((const f32x4*)(p.ws + WS_SCT))[ix_]; pdi = ((const float*)(p.ws + WS_DENI))[ix_]; pwc = ((const float*)(p.ws + WS_WC))[chain * 64 + (c)]; } } while (0)
#define ML_WRITE(cc_) do { _Pragma("unroll") for (int i_ = 0; i_ < 4; ++i_) { const int ch_ = tid + 512 * i_, row_ = ch_ >> 5, c16_ = ch_ & 31; \
            *(LAS u32x4*)(lds + L_Q + row_ * QP + c16_ * 16) = pq[i_]; *(LAS u32x4*)(lds + L_K + row_ * QP + c16_ * 16) = pk[i_]; } \
        if (tid < 256) { const int row_ = tid >> 2, c16_ = tid & 3; *(LAS u32x4*)(lds + L_V + row_ * VP + c16_ * 16) = pv; } \
        if (wid == 0) { LAS float* S_ = (LAS float*)(lds + L_SC + ((cc_) % 3) * 2048); S_[lane] = psc[0]; S_[64 + lane] = psc[1]; S_[128 + lane] = psc[2]; S_[192 + lane] = psc[3]; S_[256 + lane] = pdi; if (lane == 0) S_[320] = pwc; } } while (0)
#define ML_CTB() do { _Pragma("unroll") for (int i_ = 0; i_ < 4; ++i_) { u32x2 w_; w_.x = cvtpk(ct[4 * i_], ct[4 * i_ + 1]); w_.y = cvtpk(ct[4 * i_ + 2], ct[4 * i_ + 3]); \
            *(LAS u32x2*)(lds + L_CT + r32 * CP + (wid * 32 + 8 * i_ + 4 * hi) * 2) = w_; } } while (0)
#define ML_COMB(cc_) do { const int tb_ = wid & 1, kh_ = wid >> 1; const LAS float* S_ = (const LAS float*)(lds + L_SC + ((cc_) % 3) * 2048); const LAS float* NQ_ = (const LAS float*)(lds + L_NQ + ((cc_) & 1) * 256); \
            const LAS float* PT_ = (const LAS float*)(lds + L_PART + (((cc_) & 1) * 4 + (wid ^ 2)) * 2048); \
            _Pragma("unroll") for (int rr = 0; rr < 8; ++rr) { const int r = 8 * kh_ + rr, tt = tb_ * 32 + crow(r, hi); bf16_t* hp_ = Hout + (size_t)ML_TOK(cc_, tt) * 1024 + colv + r32; \
                const float rr_ = S_[tt], wi = S_[64 + tt], den = rr_ * S_[256 + tt] + wi * NQ_[tt], it_ = (kh_ ? ia[8 + rr] : ia[rr]) + PT_[rr * 64 + lane]; \
                *hp_ = (bf16_t)f2bf((rr_ * bf2f(hpre[rr]) + wi * it_) * __builtin_amdgcn_rcpf(fmaxf(fabsf(den), S_[128 + tt]))); } } while (0)
        float kwc = 0.f;
        ML_LOAD(0); ML_WRITE(0); ML_CTB(); kwc = pkw;
        int nsel = 0;
        for (int c = 0; c < NC; ++c) {
            ML_BAR();
            LAS float* ncur = nsel ? nb1 : nb0; LAS float* nnxt = nsel ? nb0 : nb1;
            const LAS float* SC = (const LAS float*)(lds + L_SC + (c % 3) * 2048);
            if (c + 1 < NC) ML_LOAD(c + 1);
            const float w_c = SC[320];
            if (wid < 4) {
                if (c > 0) ML_COMB(c - 1);
                ML_HPRE(c);
                const int tb = wid & 1, kh = wid >> 1;
                { float z0 = 0.f; asm volatile("" : "+v"(z0));
#pragma unroll
                  for (int r = 0; r < 16; ++r) ia[r] = z0; }
#pragma unroll
                for (int k1 = 0; k1 < 8; ++k1) { const int cb0 = ((kh * 8 + k1) * 16 + hi * 8) * 2;
                    const bf16x8 qf0 = *(const LAS bf16x8*)(lds + L_Q + (tb * 32 + r32) * QP + cb0), cf0 = *(const LAS bf16x8*)(lds + L_CT + r32 * CP + cb0);
                    ia = __builtin_amdgcn_mfma_f32_32x32x16_bf16(qf0, cf0, ia, 0, 0, 0); }
                { LAS float* PW = (LAS float*)(lds + L_PART + ((c & 1) * 4 + wid) * 2048);
#pragma unroll
                  for (int rr = 0; rr < 8; ++rr) PW[rr * 64 + lane] = kh ? ia[rr] : ia[8 + rr]; }
            } else if (wid >= 4) {
                const int j = tid - 256, t = j >> 2, part = j & 3;
                float acc = 0.f;
#pragma unroll
                for (int i = 0; i < 8; ++i) { const u32x4 qv = *(const LAS u32x4*)(lds + L_Q + t * QP + (part * 64 + i * 8) * 2);
                    const f32x4 n0 = *(const LAS f32x4*)(ncur + part * 64 + i * 8), n1 = *(const LAS f32x4*)(ncur + part * 64 + i * 8 + 4);
                    acc += bf2f(qv[0]) * n0[0] + bf2f(qv[0] >> 16) * n0[1] + bf2f(qv[1]) * n0[2] + bf2f(qv[1] >> 16) * n0[3] + bf2f(qv[2]) * n1[0] + bf2f(qv[2] >> 16) * n1[1] + bf2f(qv[3]) * n1[2] + bf2f(qv[3] >> 16) * n1[3]; }
                acc += __shfl_xor(acc, 1); acc += __shfl_xor(acc, 2);
                if (part == 0) ((LAS float*)(lds + L_NQ + (c & 1) * 256))[t] = acc;
                nnxt[j] = w_c * ncur[j] + kwc;
            }
            { f32x16 cc = ct;
#pragma unroll
              for (int r = 0; r < 16; ++r) cc[r] *= w_c;
#pragma unroll
              for (int ks = 0; ks < 4; ++ks) {
                const unsigned ka = ldsb + L_K + (16 * ks + 8 * hi + tq) * QP + (wid * 32 + tc0) * 2, va = ldsb + L_V + (16 * ks + 8 * hi + tq) * VP + tc0 * 2;
                const s16x4 kl = trr(ka), kh = trr(ka + 4 * QP), vl = trr(va), vh = trr(va + 4 * VP);
                const f32x4 wa = *(const LAS f32x4*)(SC + 192 + 16 * ks + 8 * hi), wb = *(const LAS f32x4*)(SC + 192 + 16 * ks + 8 * hi + 4);
                asm volatile("s_waitcnt lgkmcnt(0)" ::: "memory"); __builtin_amdgcn_sched_barrier(0);
                u32x4 vw; vw.x = cvtpk(bf2f((unsigned short)vl[0]) * wa[0], bf2f((unsigned short)vl[1]) * wa[1]); vw.y = cvtpk(bf2f((unsigned short)vl[2]) * wa[2], bf2f((unsigned short)vl[3]) * wa[3]);
                vw.z = cvtpk(bf2f((unsigned short)vh[0]) * wb[0], bf2f((unsigned short)vh[1]) * wb[1]); vw.w = cvtpk(bf2f((unsigned short)vh[2]) * wb[2], bf2f((unsigned short)vh[3]) * wb[3]);
                const bf16x8 kf = (bf16x8){kl[0], kl[1], kl[2], kl[3], kh[0], kh[1], kh[2], kh[3]};
                cc = __builtin_amdgcn_mfma_f32_32x32x16_bf16(kf, *reinterpret_cast<bf16x8*>(&vw), cc, 0, 0, 0); }
              ct = cc; }
            ML_BAR();
            if (c + 1 < NC) { ML_WRITE(c + 1); kwc = pkw; }
            ML_CTB();
            nsel ^= 1;
        }
        if (wid < 4) ML_COMB(NC - 1);
        if (!lat) {
            const size_t so = (size_t)((b * 2 + l) * 2 + dir) * 4 + h;
            float* oc = p.out + O_MC + so * 65536 + (size_t)(sl * 32 + r32) * 256 + wid * 32 + 4 * hi;
#pragma unroll
            for (int i = 0; i < 4; ++i) *(f32x4*)(oc + 8 * i) = (f32x4){ct[4 * i], ct[4 * i + 1], ct[4 * i + 2], ct[4 * i + 3]};
            if (sl == 0) { LAS float* nfin = nsel ? nb1 : nb0; if (tid < 256) p.out[O_MN + so * 256 + tid] = nfin[tid]; }
        }
        ML_BAR();
#undef ML_LOAD
#undef ML_WRITE
#undef ML_CTB
#undef ML_COMB
#undef ML_HPRE
    }
}
#undef ML_BAR
#undef ML_TOK
#undef B_LOAD
#undef B_DECODE
}


namespace s5 {
typedef short s16x4 __attribute__((ext_vector_type(4)));
__device__ __forceinline__ s16x4 trr(unsigned addr) { s16x4 r; asm volatile("ds_read_b64_tr_b16 %0, %1" : "=&v"(r) : "v"(addr) : "memory"); return r; }
__device__ __forceinline__ unsigned cvtpk(float lo, float hi) { unsigned r; asm volatile("s_nop 0\n\tv_cvt_pk_bf16_f32 %0, %1, %2\n\ts_nop 1" : "=v"(r) : "v"(lo), "v"(hi)); return r; }
template <bool FULL>
__device__ __forceinline__ void scan_seg(const P& p, const int l, LAS unsigned char* T, const int g, const int dir, const bool lat, const int b0, const int lane, const int blk0, const int nblk,
                                         const float (&ar)[2], const float (&ai)[2], const bf16x8 (&bb)[4], float (&sr)[2], float (&si)[2]) {
    const int r32 = lane & 31, hh = lane >> 5;
    const int L = lat ? LL : CL;
    const int baseA = lat ? NCTX + b0 * LL : b0 * CL, baseB = baseA + L;
    const size_t pg = (size_t)(l * 2 + dir) * 64 + g;
    bf16x8 cm[8];
    if (FULL) {
#pragma unroll
        for (int ks = 0; ks < 8; ++ks) { u32x4 w = {0u, 0u, 0u, 0u};
            if (r32 < 16) { const int k0 = 16 * ks + 8 * hh; const float* src = (k0 < 64 ? p.in[27] : p.in[28]) + (pg * 16 + r32) * 64 + (k0 & 63); const float sg = k0 < 64 ? 1.f : -1.f;
#pragma unroll
                for (int j = 0; j < 4; ++j) w[j] = cvtpk(sg * src[2 * j], sg * src[2 * j + 1]); }
            cm[ks] = *reinterpret_cast<bf16x8*>(&w); } }
    const int urow_tok = 4 * (r32 >> 3) + (r32 & 3), urow_base = ((r32 >> 2) & 1) ? baseB : baseA;
    const bf16_t* U = (const bf16_t*)(p.ws + WS_S5U) + g * 16 + 8 * hh;
    bf16_t* Yo2 = (bf16_t*)(p.ws + (dir ? WS_YS5B : WS_YS5F)) + g * 16;
#define S5_POS(n, j) (dir ? (L - 1 - ((n) * 16 + (j))) : ((n) * 16 + (j)))
    bf16x8 ucur[4], unxt[4];
#pragma unroll
    for (int i = 0; i < 4; ++i) { ucur[i] = *(const bf16x8*)(U + (size_t)(urow_base + S5_POS(blk0 + i, urow_tok)) * 1024); unxt[i] = ucur[i]; }
    const unsigned tb = (unsigned)(uintptr_t)T;
    const int tq = (lane & 15) >> 2, tp = lane & 3, tc0 = 16 * ((lane >> 4) & 1) + 4 * tp;
    for (int n4 = blk0; n4 < blk0 + nblk; n4 += 4) {
        if (n4 + 4 < blk0 + nblk) {
#pragma unroll
            for (int i = 0; i < 4; ++i) unxt[i] = *(const bf16x8*)(U + (size_t)(urow_base + S5_POS(n4 + 4 + i, urow_tok)) * 1024); }
#pragma unroll
      for (int i4 = 0; i4 < 4; ++i4) { const int n = n4 + i4; const bf16x8 ucur1 = ucur[i4];
        f32x16 acc[4]; { float z0 = 0.f; asm volatile("" : "+v"(z0));
#pragma unroll
          for (int q = 0; q < 4; ++q)
#pragma unroll
              for (int r = 0; r < 16; ++r) acc[q][r] = z0; }
#pragma unroll
        for (int q = 0; q < 4; ++q) acc[q] = __builtin_amdgcn_mfma_f32_32x32x16_bf16(ucur1, bb[q], acc[q], 0, 0, 0);
#pragma unroll
        for (int pb = 0; pb < 2; ++pb) { float xr = sr[pb], xi = si[pb]; const float a_r = ar[pb], a_i = ai[pb];
#pragma unroll
            for (int r = 0; r < 16; ++r) { const float nr_ = a_r * xr - a_i * xi + acc[pb][r], ni_ = a_r * xi + a_i * xr + acc[2 + pb][r]; xr = nr_; xi = ni_; acc[pb][r] = nr_; acc[2 + pb][r] = ni_; }
            sr[pb] = xr; si[pb] = xi; }
        if (FULL) {
#pragma unroll
        for (int q = 0; q < 4; ++q)
#pragma unroll
            for (int a4 = 0; a4 < 4; ++a4) { u32x2 w; w.x = cvtpk(acc[q][4 * a4], acc[q][4 * a4 + 1]); w.y = cvtpk(acc[q][4 * a4 + 2], acc[q][4 * a4 + 3]);
                *(LAS u32x2*)(T + (q * 32 + r32) * 64 + 16 * a4 + 8 * hh) = w; }
        f32x16 y, y2; { float z0 = 0.f; asm volatile("" : "+v"(z0));
#pragma unroll
          for (int r = 0; r < 16; ++r) { y[r] = z0; y2[r] = z0; } }
        { s16x4 lo_[8], hi_[8];
#pragma unroll
          for (int ks = 0; ks < 8; ++ks) { const unsigned ta = tb + (16 * ks + 8 * hh + tq) * 64 + tc0 * 2; lo_[ks] = trr(ta); hi_[ks] = trr(ta + 4 * 64); }
          asm volatile("s_waitcnt lgkmcnt(0)" ::: "memory"); __builtin_amdgcn_sched_barrier(0);
#pragma unroll
          for (int ks = 0; ks < 8; ks += 2) {
            const bf16x8 af0 = (bf16x8){lo_[ks][0], lo_[ks][1], lo_[ks][2], lo_[ks][3], hi_[ks][0], hi_[ks][1], hi_[ks][2], hi_[ks][3]};
            const bf16x8 af1 = (bf16x8){lo_[ks + 1][0], lo_[ks + 1][1], lo_[ks + 1][2], lo_[ks + 1][3], hi_[ks + 1][0], hi_[ks + 1][1], hi_[ks + 1][2], hi_[ks + 1][3]};
            y = __builtin_amdgcn_mfma_f32_32x32x16_bf16(cm[ks], af0, y, 0, 0, 0);
            y2 = __builtin_amdgcn_mfma_f32_32x32x16_bf16(cm[ks + 1], af1, y2, 0, 0, 0); }
#pragma unroll
          for (int r = 0; r < 16; ++r) y[r] += y2[r]; }
        {
          bf16_t* yo = Yo2 + (size_t)(urow_base + S5_POS(n, urow_tok)) * 1024 + 4 * hh;
          u32x2 w0, w1; w0.x = cvtpk(y[0], y[1]); w0.y = cvtpk(y[2], y[3]); w1.x = cvtpk(y[4], y[5]); w1.y = cvtpk(y[6], y[7]);
          *(u32x2*)yo = w0; *(u32x2*)(yo + 8) = w1; }
        }
      }
#pragma unroll
        for (int i = 0; i < 4; ++i) ucur[i] = unxt[i];
    }
#undef S5_POS
}
__device__ __forceinline__ void params(const P& p, const int l, const int g, const int dir, const int lane, float (&ar)[2], float (&ai)[2], bf16x8 (&bb)[4]) {
    const int r32 = lane & 31, hh = lane >> 5; const size_t pg = (size_t)(l * 2 + dir) * 64 + g;
    const float dt = __expf(p.in[24][pg]);
#pragma unroll
    for (int pb = 0; pb < 2; ++pb) { const int pp = pb * 32 + r32;
        const float lr = fminf(p.in[22][pg * 64 + pp], -1e-4f), li = p.in[23][pg * 64 + pp];
        const float mag = __expf(dt * lr); float sn, cs; sincos_small(dt * li, sn, cs);
        const float a_r = mag * cs, a_i = mag * sn, den = lr * lr + li * li, nr = a_r - 1.0f, ni = a_i, qr = (nr * lr + ni * li) / den, qi = (ni * lr - nr * li) / den;
        ar[pb] = a_r; ai[pb] = a_i;
        const float* br = p.in[25] + (pg * 64 + pp) * 16 + 8 * hh; const float* bi = p.in[26] + (pg * 64 + pp) * 16 + 8 * hh;
        u32x4 wr, wi;
#pragma unroll
        for (int j = 0; j < 4; ++j) { const float r0 = qr * br[2 * j] - qi * bi[2 * j], r1 = qr * br[2 * j + 1] - qi * bi[2 * j + 1], i0 = qr * bi[2 * j] + qi * br[2 * j], i1 = qr * bi[2 * j + 1] + qi * br[2 * j + 1];
            wr[j] = cvtpk(r0, r1); wi[j] = cvtpk(i0, i1); }
        bb[pb] = *reinterpret_cast<bf16x8*>(&wr); bb[2 + pb] = *reinterpret_cast<bf16x8*>(&wi); }
}
__device__ __forceinline__ void ctx_unit(const P& p, const int l, LAS unsigned char* T, const int u, const int lane) {
    const int dir = u & 1, g = (u >> 1) & 63, b0 = 2 * (u >> 7), r32 = lane & 31, hh = lane >> 5;
    float ar[2], ai[2]; bf16x8 bb[4]; params(p, l, g, dir, lane, ar, ai, bb);
    float sr[2] = {0.f, 0.f}, si[2] = {0.f, 0.f};
    scan_seg<true>(p, l, T, g, dir, false, b0, lane, 0, CL / 16, ar, ai, bb, sr, si);
#pragma unroll
    for (int pb = 0; pb < 2; ++pb) { const size_t so = ((size_t)(((b0 + hh) * 2 + l) * 2 + dir) * 64 + g) * 64 + pb * 32 + r32; p.out[O_SR + so] = sr[pb]; p.out[O_SI + so] = si[pb]; }
}
__device__ __forceinline__ void lat_unit(const P& p, const int l, LAS unsigned char* lds, const int u, const int wave, const int lane) {
    const int dir = u & 1, g = (u >> 1) & 63, b0 = 2 * (u >> 7), r32 = lane & 31, hh = lane >> 5;
    LAS unsigned char* T = lds + wave * 8192; LAS float* X = (LAS float*)(lds + 65536);
    float ar[2], ai[2]; bf16x8 bb[4]; params(p, l, g, dir, lane, ar, ai, bb);
    float sr[2] = {0.f, 0.f}, si[2] = {0.f, 0.f};
    if (wave == 0) {
#pragma unroll
        for (int pb = 0; pb < 2; ++pb) { const size_t so = ((size_t)(((b0 + hh) * 2 + l) * 2 + dir) * 64 + g) * 64 + pb * 32 + r32; sr[pb] = p.in[9][so]; si[pb] = p.in[10][so]; } }
    const float s0r[2] = {sr[0], sr[1]}, s0i[2] = {si[0], si[1]};
    constexpr int SEGB = LL / 16 / 8;
    if (wave < 7) scan_seg<false>(p, l, T, g, dir, true, b0, lane, wave * SEGB, SEGB, ar, ai, bb, sr, si);
#pragma unroll
    for (int pb = 0; pb < 2; ++pb) { X[(wave * 4 + pb) * 64 + lane] = sr[pb]; X[(wave * 4 + 2 + pb) * 64 + lane] = si[pb]; }
    __syncthreads();
    float pr[2], pi[2];
#pragma unroll
    for (int pb = 0; pb < 2; ++pb) { float xr = ar[pb], xi = ai[pb];
#pragma unroll
        for (int k = 0; k < 9; ++k) { const float nr = xr * xr - xi * xi, ni = 2.f * xr * xi; xr = nr; xi = ni; }
        pr[pb] = xr; pi[pb] = xi; }
    float cr[2], ci[2];
    if (wave == 0) { cr[0] = s0r[0]; cr[1] = s0r[1]; ci[0] = s0i[0]; ci[1] = s0i[1]; }
    else {
#pragma unroll
        for (int pb = 0; pb < 2; ++pb) { float xr = X[(0 * 4 + pb) * 64 + lane], xi = X[(0 * 4 + 2 + pb) * 64 + lane];
            for (int j = 1; j < wave; ++j) { const float er = X[(j * 4 + pb) * 64 + lane], ei = X[(j * 4 + 2 + pb) * 64 + lane];
                const float nr = pr[pb] * xr - pi[pb] * xi + er, ni = pr[pb] * xi + pi[pb] * xr + ei; xr = nr; xi = ni; }
            cr[pb] = xr; ci[pb] = xi; } }
    scan_seg<true>(p, l, T, g, dir, true, b0, lane, wave * SEGB, SEGB, ar, ai, bb, cr, ci);
    __syncthreads();
}
__device__ __forceinline__ void combine_row(const P& p, const int l, const int r, const int lane, const f32x4 (&dpre)[4]) {
    const bf16_t* yf = (const bf16_t*)(p.ws + WS_YS5F) + (size_t)r * 1024; const bf16_t* yb = (const bf16_t*)(p.ws + WS_YS5B) + (size_t)r * 1024; const bf16_t* uu = (const bf16_t*)(p.ws + WS_S5U) + (size_t)r * 1024;
    bf16_t* o = (bf16_t*)(p.ws + WS_HB) + (size_t)r * 1024;
#pragma unroll
    for (int j = 0; j < 2; ++j) { const int c = j * 512 + lane * 8; float a[8], b[8], u[8];
        { const u32x4 w = *(const u32x4*)(yf + c);
#pragma unroll
          for (int i = 0; i < 4; ++i) { a[2 * i] = bf2f(w[i]); a[2 * i + 1] = bf2f(w[i] >> 16); } }
        { const u32x4 w = *(const u32x4*)(yb + c);
#pragma unroll
          for (int i = 0; i < 4; ++i) { b[2 * i] = bf2f(w[i]); b[2 * i + 1] = bf2f(w[i] >> 16); } }
        { const u32x4 w = *(const u32x4*)(uu + c);
#pragma unroll
          for (int i = 0; i < 4; ++i) { u[2 * i] = bf2f(w[i]); u[2 * i + 1] = bf2f(w[i] >> 16); } }
        const f32x4 d0 = dpre[2 * j], d1 = dpre[2 * j + 1];
        float gq[8];
#pragma unroll
        for (int i = 0; i < 8; ++i) gq[i] = gelu_tanh(a[i] + b[i] + (i < 4 ? d0[i] : d1[i - 4]) * u[i]);
        u32x4 w; w.x = pk2(gq[0], gq[1]); w.y = pk2(gq[2], gq[3]); w.z = pk2(gq[4], gq[5]); w.w = pk2(gq[6], gq[7]);
        *(u32x4*)(o + c) = w; }
}
}

__device__ __forceinline__ float rope_lane(float x, int lane, int prow, int pcol, const float* rt) {
    const int part = lane >> 5, jj = lane & 31, idx = jj & 15, pos = part ? pcol : prow;
    const float c = rt[pos * 16 + idx], s = rt[1024 + pos * 16 + idx];
    const float o = __shfl_xor(x, 16);
    return (jj >= 16) ? (x * c + o * s) : (x * c - o * s);
}
__device__ __forceinline__ u32x4 rope8(const u32x4 x, const int d0  , const int prow, const int pcol, const float* rt, const int pmask) {
    const int part = d0 >> 5, jj = d0 & 31, idx0 = jj & 15, pos = part ? pcol : prow; const bool second = jj >= 16;
    u32x4 o, y;
#pragma unroll
    for (int i = 0; i < 4; ++i) o[i] = __shfl_xor(x[i], pmask);
    const f32x4 c0 = *(const f32x4*)(rt + pos * 16 + idx0), c1 = *(const f32x4*)(rt + pos * 16 + idx0 + 4), s0 = *(const f32x4*)(rt + 1024 + pos * 16 + idx0), s1 = *(const f32x4*)(rt + 1024 + pos * 16 + idx0 + 4);
#pragma unroll
    for (int i = 0; i < 4; ++i) { const float ca = i < 2 ? c0[2 * i] : c1[2 * i - 4], cb = i < 2 ? c0[2 * i + 1] : c1[2 * i - 3], sa = i < 2 ? s0[2 * i] : s1[2 * i - 4], sb = i < 2 ? s0[2 * i + 1] : s1[2 * i - 3];
        const float xa = bf2f(x[i]), xb = bf2f(x[i] >> 16), oa = bf2f(o[i]), ob = bf2f(o[i] >> 16);
        y[i] = second ? pk2(xa * ca + oa * sa, xb * cb + ob * sb) : pk2(xa * ca - oa * sa, xb * cb - ob * sb); }
    return y;
}
__device__ __forceinline__ void ph_prep_row(const P& p, int l, int r, int lane) {
    unsigned char* ws = p.ws;
    bf16_t* ckvn = (bf16_t*)(ws + WS_CKVN) + (size_t)r * 512;
    bf16_t* kf = (bf16_t*)(ws + WS_KFULL) + (size_t)r * 1536;
    bf16_t* dfk = (bf16_t*)(ws + WS_DFK) + (size_t)r * 1024;
    bf16_t* dfv = (bf16_t*)(ws + WS_DFV) + (size_t)r * 1024;
    if (r >= MTOK) {
        const int i = r - MTOK, b = i >> 8, t = i & 255; const size_t cr = (size_t)(b * 2 + l) * PAST + t;
        { const float* cc = p.in[2] + cr * 512 + lane * 8; const f32x4 a = *(const f32x4*)cc, c = *(const f32x4*)(cc + 4);
          u32x4 w; w.x = pk2(a[0], a[1]); w.y = pk2(a[2], a[3]); w.z = pk2(c[0], c[1]); w.w = pk2(c[2], c[3]); *(u32x4*)(ckvn + lane * 8) = w; }
        const float kr = p.in[3][cr * 64 + lane];
#pragma unroll
        for (int h = 0; h < 8; ++h) kf[h * 192 + 128 + lane] = (bf16_t)f2bf(kr);
        const float* ck = p.in[4] + cr * 1024 + lane * 16; const float* cv = p.in[5] + cr * 1024 + lane * 16;
#pragma unroll
        for (int j = 0; j < 2; ++j) { const f32x4 a = *(const f32x4*)(ck + 8 * j), c = *(const f32x4*)(ck + 8 * j + 4), d = *(const f32x4*)(cv + 8 * j), e = *(const f32x4*)(cv + 8 * j + 4);
            u32x4 w; w.x = pk2(a[0], a[1]); w.y = pk2(a[2], a[3]); w.z = pk2(c[0], c[1]); w.w = pk2(c[2], c[3]); *(u32x4*)(dfk + lane * 16 + 8 * j) = w;
            u32x4 v; v.x = pk2(d[0], d[1]); v.y = pk2(d[2], d[3]); v.z = pk2(e[0], e[1]); v.w = pk2(e[2], e[3]); *(u32x4*)(dfv + lane * 16 + 8 * j) = v; }
        return;
    }
    const float* kva = (const float*)(ws + WS_KVA) + (size_t)r * KVAW;
    const bool ctx = r < NCTX;
    const int cb = r >> 8, ct = r & 255;
    const int t = (r - NCTX) & 4095, prow = t >> 6, pcol = t & 63;
    const float* rt = (const float*)(ws + WS_ROPE);
    const f32x4 ka = *(const f32x4*)(kva + lane * 8), kb = *(const f32x4*)(kva + lane * 8 + 4);
    float kr = kva[512 + lane];
    const float graw = lane < 16 ? kva[576 + lane] + p.in[18][l * 16 + lane] : 0.f;
    bf16_t* mq = (bf16_t*)(ws + WS_MQ) + (size_t)r * 1536 + (lane >> 3) * 192 + 128 + (lane & 7) * 8;
    bf16_t* dfq = (bf16_t*)(ws + WS_DFQ) + (size_t)r * 1024 + lane * 16;
    u32x4 xq = {0u, 0u, 0u, 0u}, xd0 = xq, xd1 = xq, xk0 = xq, xk1 = xq, xv0 = xq, xv1 = xq;
    if (!ctx) { xq = *(const u32x4*)mq; xd0 = *(const u32x4*)dfq; xd1 = *(const u32x4*)(dfq + 8); }
    xk0 = *(const u32x4*)(dfk + lane * 16); xk1 = *(const u32x4*)(dfk + lane * 16 + 8);
    if (ctx) { xv0 = *(const u32x4*)(dfv + lane * 16); xv1 = *(const u32x4*)(dfv + lane * 16 + 8); }
    { float ss = ka[0] * ka[0] + ka[1] * ka[1] + ka[2] * ka[2] + ka[3] * ka[3] + kb[0] * kb[0] + kb[1] * kb[1] + kb[2] * kb[2] + kb[3] * kb[3];
      const float rstd = rsqrtf(wave_sum(ss) * (1.0f / 512.0f) + 1e-6f);
      const float* g = p.in[20] + l * 512 + lane * 8; const f32x4 g0 = *(const f32x4*)g, g1 = *(const f32x4*)(g + 4);
      const f32x4 y0 = ka * rstd * g0, y1 = kb * rstd * g1;
      u32x4 w; w.x = pk2(y0[0], y0[1]); w.y = pk2(y0[2], y0[3]); w.z = pk2(y1[0], y1[1]); w.w = pk2(y1[2], y1[3]); *(u32x4*)(ckvn + lane * 8) = w;
      if (ctx) { float* o = p.out + O_CKV + ((size_t)(cb * 2 + l) * CL + ct) * 512 + lane * 8; *(f32x4*)o = y0; *(f32x4*)(o + 4) = y1; } }
    { if (ctx) p.out[O_KR + ((size_t)(cb * 2 + l) * CL + ct) * 64 + lane] = kr; else kr = rope_lane(kr, lane, prow, pcol, rt);
#pragma unroll
      for (int h = 0; h < 8; ++h) kf[h * 192 + 128 + lane] = (bf16_t)f2bf(kr); }
    if (lane < 16) { const float o = ((lane >> 2) & 1) ? (fminf(graw, 0.f) - __logf(1.0f + __expf(-fabsf(graw)))) : graw; ((float*)(ws + WS_GATES))[(size_t)r * 16 + lane] = o; }
    if (ctx) {
        float* ok = p.out + O_DK + ((size_t)(cb * 2 + l) * CL + ct) * 1024 + lane * 16; float* ov = p.out + O_DV + ((size_t)(cb * 2 + l) * CL + ct) * 1024 + lane * 16;
#pragma unroll
        for (int i = 0; i < 4; ++i) { *(f32x2_*)(ok + 2 * i) = (f32x2_){bf2f(xk0[i]), bf2f(xk0[i] >> 16)}; *(f32x2_*)(ok + 8 + 2 * i) = (f32x2_){bf2f(xk1[i]), bf2f(xk1[i] >> 16)};
            *(f32x2_*)(ov + 2 * i) = (f32x2_){bf2f(xv0[i]), bf2f(xv0[i] >> 16)}; *(f32x2_*)(ov + 8 + 2 * i) = (f32x2_){bf2f(xv1[i]), bf2f(xv1[i] >> 16)}; }
    } else {
        *(u32x4*)mq = rope8(xq, (lane & 7) * 8, prow, pcol, rt, 2);
        const int q = lane & 3;
        *(u32x4*)dfq = rope8(xd0, q * 16, prow, pcol, rt, 1); *(u32x4*)(dfq + 8) = rope8(xd1, q * 16 + 8, prow, pcol, rt, 1);
        *(u32x4*)(dfk + lane * 16) = rope8(xk0, q * 16, prow, pcol, rt, 1); *(u32x4*)(dfk + lane * 16 + 8) = rope8(xk1, q * 16 + 8, prow, pcol, rt, 1);
    }
}

__device__ __forceinline__ void ph_ml_combine_row(const P& p, int l, int r, int lane, const f32x4 (&gg)[4]) {
    bf16_t* hf = (bf16_t*)(p.ws + WS_HF) + (size_t)r * 1024 + lane * 4; const bf16_t* hb = (const bf16_t*)(p.ws + WS_HB) + (size_t)r * 1024 + lane * 4;
    const bf16_t* so = (const bf16_t*)(p.ws + WS_MLO) + (size_t)r * 1024 + lane * 4;
    u32x2 a[4], b[4], c[4];
#pragma unroll
    for (int h = 0; h < 4; ++h) { a[h] = *(const u32x2*)(hf + h * 256); b[h] = *(const u32x2*)(hb + h * 256); c[h] = *(const u32x2*)(so + h * 256); }
#pragma unroll
    for (int h = 0; h < 4; ++h) { float v[4];
        v[0] = bf2f(a[h].x) + bf2f(b[h].x); v[1] = bf2f(a[h].x >> 16) + bf2f(b[h].x >> 16); v[2] = bf2f(a[h].y) + bf2f(b[h].y); v[3] = bf2f(a[h].y >> 16) + bf2f(b[h].y >> 16);
        const float rstd = rsqrtf(wave_sum(v[0] * v[0] + v[1] * v[1] + v[2] * v[2] + v[3] * v[3]) * (1.0f / 256.0f) + 1e-6f);
        u32x2 w; w.x = pk2(v[0] * rstd * gg[h][0] * bf2f(c[h].x), v[1] * rstd * gg[h][1] * bf2f(c[h].x >> 16)); w.y = pk2(v[2] * rstd * gg[h][2] * bf2f(c[h].y), v[3] * rstd * gg[h][3] * bf2f(c[h].y >> 16));
        *(u32x2*)(hf + h * 256) = w; }
}

__device__ __forceinline__ void ph_df_combine_row(const P& p, int l, float lam_init, float lam, int r, int lane) {
    const int h = lane >> 3, part = lane & 7;
    const bf16_t* o = (const bf16_t*)(p.ws + WS_DFO) + (size_t)r * 2048 + h * 256 + part * 16;
    const u32x4 a0 = *(const u32x4*)o, a1 = *(const u32x4*)(o + 8), b0 = *(const u32x4*)(o + 128), b1 = *(const u32x4*)(o + 136);
    const float* g = p.in[32] + l * 128 + part * 16;
    float v[16]; float ss = 0.f;
#pragma unroll
    for (int i = 0; i < 4; ++i) { v[2 * i] = bf2f(a0[i]) - lam * bf2f(b0[i]); v[2 * i + 1] = bf2f(a0[i] >> 16) - lam * bf2f(b0[i] >> 16); v[8 + 2 * i] = bf2f(a1[i]) - lam * bf2f(b1[i]); v[9 + 2 * i] = bf2f(a1[i] >> 16) - lam * bf2f(b1[i] >> 16); }
#pragma unroll
    for (int i = 0; i < 16; ++i) ss += v[i] * v[i];
    ss += __shfl_xor(ss, 1); ss += __shfl_xor(ss, 2); ss += __shfl_xor(ss, 4);
    const float sc = rsqrtf(ss * (1.0f / 128.0f) + 1e-6f) * (1.0f - lam_init);
    u32x4 w0, w1;
#pragma unroll
    for (int i = 0; i < 4; ++i) { w0[i] = pk2(v[2 * i] * sc * g[2 * i], v[2 * i + 1] * sc * g[2 * i + 1]); w1[i] = pk2(v[8 + 2 * i] * sc * g[8 + 2 * i], v[9 + 2 * i] * sc * g[9 + 2 * i]); }
    bf16_t* y = (bf16_t*)(p.ws + WS_DFQ) + (size_t)r * 1024 + h * 128 + part * 16;
    *(u32x4*)y = w0; *(u32x4*)(y + 8) = w1;
}
__device__ __forceinline__ void ph_final_row(const P& p, int r, int lane, const f32x4 (&gpre)[8]) {
    const bf16_t* xb = (const bf16_t*)(p.ws + WS_X) + (size_t)r * D;
    f32x4 v[8]; float ss = 0.f;
#pragma unroll
    for (int j = 0; j < 8; ++j) { const u32x2 w = *(const u32x2*)(xb + j * 256 + lane * 4); v[j] = (f32x4){bf2f(w.x), bf2f(w.x >> 16), bf2f(w.y), bf2f(w.y >> 16)}; ss += v[j][0] * v[j][0] + v[j][1] * v[j][1] + v[j][2] * v[j][2] + v[j][3] * v[j][3]; }
    const float rstd = rsqrtf(wave_sum(ss) * (1.0f / 2048.0f) + 1e-6f);
    float* o = p.out + (r < NCTX ? O_YP + (size_t)r * D : O_YS + (size_t)(r - NCTX) * D);
#pragma unroll
    for (int j = 0; j < 8; ++j) { const int c = j * 256 + lane * 4; *(f32x4*)(o + c) = v[j] * rstd * gpre[j]; }
}

__device__ __forceinline__ void load_args(P& p) {
#if defined(__HIP_DEVICE_COMPILE__)
    const __attribute__((address_space(4))) unsigned long long* q = (const __attribute__((address_space(4))) unsigned long long*)__builtin_amdgcn_kernarg_segment_ptr();
    asm volatile("" : "+s"(q));
#pragma unroll
    for (int i = 0; i < 38; ++i) p.in[i] = (const float*)q[i];
    p.out = (float*)q[38]; p.ws = (unsigned char*)q[39];
#endif
}
constexpr int NTHR = 512, LDS_BYTES = 147456, MISC_OFF = 131072;
#ifndef PROBE
#define PROBE 0
#endif
#ifndef PROBE_MASK_D
#define PROBE_MASK_D 0u
#endif
#ifndef PROBE_MASK_A
#define PROBE_MASK_A 0u
#endif
#define PROBE_MULT 10
#define PROBE_ADIV 100.0f
#define STAMP(idx) do { if (PROBE) { if (blockIdx.x == 0 && bar.w == 0u && lane_id_() == 0u) ((LAS unsigned long long*)((LAS unsigned char*)lds + MISC_OFF + 2048))[idx] = __builtin_amdgcn_s_memrealtime(); } } while (0)
#define GRID_BAR() do { XcdBarrier b_ = bar; asm volatile("" : "+s"(b_.x)); xcd_barrier(b_); } while (0)

#define PH_VARS P p; load_args(p); unsigned char* ws = p.ws; (void)ws; int tid_ = (int)(bar.w * 64u + lane_id_()); asm volatile("" : "+v"(tid_)); const int lane = tid_ & 63, wave = __builtin_amdgcn_readfirstlane(tid_ >> 6), half = tid_ >> 8, vt = tid_ & 255; \
    const int gw = blockIdx.x * 8 + wave, vb = blockIdx.x * 2 + half; (void)lane; (void)half; (void)vt; (void)gw; (void)vb;

template <int l>
__device__ __forceinline__ void run_layer(unsigned char* lds, const XcdBarrier& bar, const int G, const int NGW) {
        { PH_VARS ph_convert(p, l, gw, NGW, lane, (LAS float*)((LAS unsigned char*)lds + wave * 16384), l == 0, true); }
        { PH_VARS const int per_ = (MTOK + NGW - 1) / NGW, r0_ = gw * per_; ph_hnorm_rows(p, l, 0, r0_, r0_ + per_ < MTOK ? r0_ + per_ : MTOK, lane); }
        GRID_BAR(); STAMP(1 + 17 * l + 1);
        { PH_VARS pg8::Gemm g{(const bf16_t*)(ws + WS_H), (const bf16_t*)(ws + WS_WBF + WB_IN), MTOK, 10496, D}; pg8::StaticOrder S; S.init(MTOK, 10496, G, (int)blockIdx.x);
          pg8::gemm_phase<Epi8In, pg8::StaticOrder, true, true>((LAS unsigned char*)lds, g, S, Epi8In{ws}, tid_); }
        GRID_BAR(); STAMP(1 + 17 * l + 2);
        { PH_VARS for (int ch = blockIdx.x; ch < 160; ch += G) ml::scalars_wg(p, l, ch, wave, lane, (LAS float*)((LAS unsigned char*)lds)); for (int r = gw; r < MALL; r += NGW) ph_prep_row(p, l, r, lane); }
        GRID_BAR(); STAMP(1 + 17 * l + 3);
        { PH_VARS pg8::Gemm g{(const bf16_t*)(ws + WS_CKVN), (const bf16_t*)(ws + WS_WBF + WB_KVB), MALL, 2048, 512}; pg8::StaticOrder S; S.init(MALL, 2048, G, (int)blockIdx.x);
          pg8::gemm_phase<Epi8Kvb, pg8::StaticOrder, true, true>((LAS unsigned char*)lds, g, S, Epi8Kvb{(bf16_t*)(ws + WS_KFULL), (bf16_t*)(ws + WS_VFULL)}, tid_); }
        STAMP(1 + 17 * l + 4);
        { PH_VARS ml::intra_phase((LAS unsigned char*)lds, p, l, tid_); }
        GRID_BAR();
        { PH_VARS ml::seq_phase((LAS unsigned char*)lds, p, l, tid_); }
        GRID_BAR(); STAMP(1 + 17 * l + 5);
        { PH_VARS
          for (int u = xcd_slot(); u < 256; u += G) { int ln_ = lane; asm volatile("" : "+v"(ln_)); s5::lat_unit(p, l, (LAS unsigned char*)lds, u, wave, ln_); }
          if (wave < 4) { for (int u = wave * G + blockIdx.x; u < 1024; u += 4 * G) s5::ctx_unit(p, l, (LAS unsigned char*)lds + wave * 8192, u, lane); }
          else { const float* g_ = p.in[19] + l * 1024 + lane * 4; f32x4 gg_[4];
#pragma unroll
            for (int h = 0; h < 4; ++h) gg_[h] = *(const f32x4*)(g_ + h * 256);
            for (int r = blockIdx.x * 4 + (wave - 4); r < MTOK; r += G * 4) ph_ml_combine_row(p, l, r, lane, gg_); } }
        GRID_BAR(); STAMP(1 + 17 * l + 6);
        { PH_VARS const float* dv_ = p.in[29] + l * 1024; f32x4 dpre_[4];
#pragma unroll
          for (int j = 0; j < 2; ++j) { dpre_[2 * j] = *(const f32x4*)(dv_ + j * 512 + lane * 8); dpre_[2 * j + 1] = *(const f32x4*)(dv_ + j * 512 + lane * 8 + 4); }
          for (int r = gw; r < MTOK; r += NGW) s5::combine_row(p, l, r, lane, dpre_); }
        GRID_BAR(); STAMP(1 + 17 * l + 7);
        { PH_VARS pg8::Gemm g{(const bf16_t*)(ws + WS_HB), (const bf16_t*)(ws + WS_WBF + WB_GLU), MTOK, 1024, 1024}; pg8::StaticOrder S; S.init(MTOK, 1024, G, (int)blockIdx.x);
          pg8::gemm_phase<Epi8Glu, pg8::StaticOrder, true, true>((LAS unsigned char*)lds, g, S, Epi8Glu{(const bf16_t*)(ws + WS_HB), (bf16_t*)(ws + WS_S5U)}, tid_); }
        STAMP(1 + 17 * l + 8);
        { PH_VARS fa::Args aa{(const bf16_t*)(ws + WS_MQ), (const bf16_t*)(ws + WS_KFULL), (const bf16_t*)(ws + WS_VFULL), (bf16_t*)(ws + WS_MLQ), 1536, 1536, 1024, 1024, 8, 1, 0.07216878364870322f, 0};
          fa::attn_phase<192>((LAS unsigned char*)lds, aa, tid_); }
        STAMP(1 + 17 * l + 9);
        { PH_VARS fa::Args aa{(const bf16_t*)(ws + WS_DFQ), (const bf16_t*)(ws + WS_DFK), (const bf16_t*)(ws + WS_DFV), (bf16_t*)(ws + WS_DFO), 1024, 1024, 1024, 2048, 16, 2, 0.125f, 0};
          fa::attn_phase<64>((LAS unsigned char*)lds, aa, tid_); }
        GRID_BAR(); STAMP(1 + 17 * l + 10);
        { PH_VARS const float lam_init = (l == 0) ? 0.2f : 0.35550906759096927f;
          const float* lp = p.in[31] + l * 256;
          const float lam = __expf(wave_sum(lp[lane] * lp[64 + lane])) - __expf(wave_sum(lp[128 + lane] * lp[192 + lane])) + lam_init;
          for (int r = gw; r < MTOK; r += NGW) ph_df_combine_row(p, l, lam_init, lam, r, lane); }
        GRID_BAR(); STAMP(1 + 17 * l + 11);
        { PH_VARS pg8::Gemm g{(const bf16_t*)(ws + WS_H), (const bf16_t*)(ws + WS_WBF + WB_IN) + (size_t)10496 * D, MTOK, GATE_COLS, D}; pg8::StaticOrder S; S.init(MTOK, GATE_COLS, G, (int)blockIdx.x);
          pg8::gemm_phase<Epi8Gate, pg8::StaticOrder, true, true>((LAS unsigned char*)lds, g, S, Epi8Gate{(bf16_t*)(ws + WS_GS)}, tid_); }
        GRID_BAR(); STAMP(1 + 17 * l + 12);
        { PH_VARS pg8::Gemm g{(const bf16_t*)(ws + WS_HF), (const bf16_t*)(ws + WS_WBF + WB_BR) + (size_t)0 * 2048 * 1024, MTOK, D, 1024}; pg8::StaticOrder S; S.init(MTOK, D, G, (int)blockIdx.x);
          pg8::gemm_phase<Epi8Merge, pg8::StaticOrder, true, true>((LAS unsigned char*)lds, g, S, Epi8Merge{(const bf16_t*)(ws + WS_GS), (bf16_t*)(ws + WS_H), 0, 0}, tid_); }
        { PH_VARS pg8::Gemm g{(const bf16_t*)(ws + WS_MLQ), (const bf16_t*)(ws + WS_WBF + WB_BR) + (size_t)1 * 2048 * 1024, MTOK, D, 1024}; pg8::StaticOrder S; S.init(MTOK, D, G, (int)blockIdx.x);
          pg8::gemm_phase<Epi8Merge, pg8::StaticOrder, true, true>((LAS unsigned char*)lds, g, S, Epi8Merge{(const bf16_t*)(ws + WS_GS), (bf16_t*)(ws + WS_H), 1, 0}, tid_); }
        { PH_VARS pg8::Gemm g{(const bf16_t*)(ws + WS_S5U), (const bf16_t*)(ws + WS_WBF + WB_BR) + (size_t)2 * 2048 * 1024, MTOK, D, 1024}; pg8::StaticOrder S; S.init(MTOK, D, G, (int)blockIdx.x);
          pg8::gemm_phase<Epi8Merge, pg8::StaticOrder, true, true>((LAS unsigned char*)lds, g, S, Epi8Merge{(const bf16_t*)(ws + WS_GS), (bf16_t*)(ws + WS_H), 2, 0}, tid_); }
        { PH_VARS pg8::Gemm g{(const bf16_t*)(ws + WS_DFQ), (const bf16_t*)(ws + WS_WBF + WB_BR) + (size_t)3 * 2048 * 1024, MTOK, D, 1024}; pg8::StaticOrder S; S.init(MTOK, D, G, (int)blockIdx.x);
          pg8::gemm_phase<Epi8Merge, pg8::StaticOrder, true, true>((LAS unsigned char*)lds, g, S, Epi8Merge{(const bf16_t*)(ws + WS_GS), (bf16_t*)(ws + WS_H), 3, 0}, tid_); }
        GRID_BAR(); STAMP(1 + 17 * l + 13);
        { PH_VARS pg8::Gemm g{(const bf16_t*)(ws + WS_H), (const bf16_t*)(ws + WS_WBF + WB_O), MTOK, D, D}; pg8::StaticOrder S; S.init(MTOK, D, G, (int)blockIdx.x);
          pg8::gemm_phase<Epi8Res, pg8::StaticOrder, true, true>((LAS unsigned char*)lds, g, S, Epi8Res{p, l, 4096, 0, 0}, tid_); }
        GRID_BAR(); STAMP(1 + 17 * l + 14);
        { PH_VARS const int per_ = (MTOK + NGW - 1) / NGW, r0_ = gw * per_; ph_hnorm_rows(p, l, 1, r0_, r0_ + per_ < MTOK ? r0_ + per_ : MTOK, lane); }
        GRID_BAR(); STAMP(1 + 17 * l + 15);
        { PH_VARS pg8::Gemm g{(const bf16_t*)(ws + WS_H), (const bf16_t*)(ws + WS_WBF + WB_FIN), MTOK, 2 * FFN, D}; pg8::StaticOrder S; S.init(MTOK, 2 * FFN, G, (int)blockIdx.x);
          pg8::gemm_phase<Epi8FfnIn, pg8::StaticOrder, true, true>((LAS unsigned char*)lds, g, S, Epi8FfnIn{(bf16_t*)(ws + WS_FFNH)}, tid_); }
        GRID_BAR(); STAMP(1 + 17 * l + 16);
        { PH_VARS pg8::Gemm g{(const bf16_t*)(ws + WS_FFNH), (const bf16_t*)(ws + WS_WBF + WB_FOUT), MTOK, D, FFN}; pg8::StaticOrder S; S.init(MTOK, D, G, (int)blockIdx.x);
          pg8::gemm_phase<Epi8Res, pg8::StaticOrder, true, true>((LAS unsigned char*)lds, g, S, Epi8Res{p, l, 10240, 1, 0}, tid_); }
        if (l == 0) { PH_VARS
          const int rem = 640 % G, nidle = rem ? G - rem : G, idx = rem ? (int)blockIdx.x - rem : (int)blockIdx.x;
          if (idx >= 0) ph_convert(p, 1, idx * 8 + wave, nidle * 8, lane, (LAS float*)((LAS unsigned char*)lds + wave * 16384), true, false); }
        GRID_BAR(); STAMP(1 + 17 * l + 17);
}

__global__ void __launch_bounds__(NTHR, 2) mega(P p_arg) {
    extern __shared__ __attribute__((aligned(16))) unsigned char lds[];
    const int tid = threadIdx.x;
    const int G = gridDim.x, NGW = G * 8;
    for (int u = tid; u < (LDS_BYTES - MISC_OFF) / 4; u += NTHR) ((LAS unsigned*)((LAS unsigned char*)lds + MISC_OFF))[u] = 0u;
    __syncthreads();
    XcdBarrier bar = xcd_barrier_post((unsigned*)(p_arg.ws + WS_CTL), (volatile LAS unsigned*)((LAS unsigned char*)lds + MISC_OFF + 32));
    STAMP(0);
    { PH_VARS ph_mod_partial(p, tid_, (float*)lds); }
    GRID_BAR();
    { PH_VARS ph_mod_reduce(p, tid_); }
    GRID_BAR(); STAMP(1);
    run_layer<0>(lds, bar, G, NGW);
    run_layer<1>(lds, bar, G, NGW);
    { PH_VARS f32x4 gpre_[8];
#pragma unroll
      for (int j = 0; j < 8; ++j) gpre_[j] = *(const f32x4*)(p.in[37] + j * 256 + lane * 4);
      for (int r = gw; r < MTOK; r += NGW) ph_final_row(p, r, lane, gpre_);
#if PROBE
      STAMP(35);
      if (blockIdx.x == 0 && bar.w == 0u && lane_id_() == 0u) {
          asm volatile("s_waitcnt vmcnt(0) lgkmcnt(0)" ::: "memory");
          const LAS unsigned long long* ts = (const LAS unsigned long long*)((LAS unsigned char*)lds + MISC_OFF + 2048);
          unsigned long long sd = 0, sa = 0;
          for (int ll = 0; ll < 2; ++ll) for (int i = 0; i < 17; ++i) { const unsigned long long d = ts[1 + 17 * ll + i + 1] - ts[1 + 17 * ll + i]; if ((PROBE_MASK_D >> i) & 1u) sd += d; if ((PROBE_MASK_A >> i) & 1u) sa += d; }
          { const unsigned long long d = ts[1] - ts[0]; if ((PROBE_MASK_D >> 17) & 1u) sd += d; if ((PROBE_MASK_A >> 17) & 1u) sa += d; }
          { const unsigned long long d = ts[35] - ts[34]; if ((PROBE_MASK_D >> 18) & 1u) sd += d; if ((PROBE_MASK_A >> 18) & 1u) sa += d; }
          float v = (float)sa * 0.01f / PROBE_ADIV; v = v > 120.f ? 120.f : v;
          if (PROBE_MASK_A) p.out[O_YS] += v;
          const unsigned long long t0 = __builtin_amdgcn_s_memrealtime(), wait = sd * PROBE_MULT;
          while (__builtin_amdgcn_s_memrealtime() - t0 < wait) __builtin_amdgcn_s_sleep(32);
      }
#endif
    }
}

extern "C" void kernel_launch(void* const* d_in, const int* in_sizes, int n_in, void* d_out, int out_size, void* d_ws, size_t ws_size, hipStream_t stream) {
    static int grid = 0;
    if (grid == 0) {
        if (n_in != 38 || out_size != (int)O_END || ws_size < WS_END) { fprintf(stderr, "kernel_launch: unexpected shapes (n_in %d out %d ws %zu)\n", n_in, out_size, ws_size); grid = -1; return; }
        int dev = 0, cus = 0, per_cu = 0;
        if (hipGetDevice(&dev) != hipSuccess || hipDeviceGetAttribute(&cus, hipDeviceAttributeMultiprocessorCount, dev) != hipSuccess) { grid = -1; return; }
        if (hipFuncSetAttribute((const void*)mega, hipFuncAttributeMaxDynamicSharedMemorySize, LDS_BYTES) != hipSuccess) { fprintf(stderr, "kernel_launch: hipFuncSetAttribute failed\n"); grid = -1; return; }
        if (hipOccupancyMaxActiveBlocksPerMultiprocessor(&per_cu, (const void*)mega, NTHR, LDS_BYTES) != hipSuccess || per_cu < 1) { fprintf(stderr, "kernel_launch: occupancy query says %d workgroups per CU\n", per_cu); grid = -1; return; }
        (void)hipGetLastError();
        grid = cus;
    }
    if (grid < 0) return;
    if (hipMemsetAsync((char*)d_ws + WS_CTL, 0, CTL_BYTES, stream) != hipSuccess) return;
    P p{};
    for (int i = 0; i < 38; ++i) p.in[i] = (const float*)d_in[i];
    p.out = (float*)d_out; p.ws = (unsigned char*)d_ws;
    hipLaunchKernelGGL(mega, dim3(grid), dim3(NTHR), LDS_BYTES, stream, p);
}
```

```cpp
#include <hip/hip_runtime.h>
#include <cstdio>
#include <cstdint>

typedef unsigned short bf16_t;
typedef short bf16x8 __attribute__((ext_vector_type(8)));
typedef float f32x16 __attribute__((ext_vector_type(16)));
typedef float f32x4 __attribute__((ext_vector_type(4)));
typedef unsigned u32x4 __attribute__((ext_vector_type(4)));
typedef unsigned u32x2 __attribute__((ext_vector_type(2)));
typedef float f32x2_ __attribute__((ext_vector_type(2)));

constexpr int D = 2048, NCTX = 4096, NLAT = 16384, MTOK = 20480, MALL = 21504;
constexpr int CB = 16, CL = 256, LB = 4, LL = 4096, PAST = 256;
constexpr int IN_COLS = 18512, MIX_COLS = 10320, GATE_COLS = 8192;
constexpr int C_MLQ = 0, C_MLK = 1024, C_MLV = 2048, C_MLO = 3072, C_MLIF = 4096, C_MQ = 4112, C_KVA = 5648, C_S5U = 6224, C_DFQ = 7248, C_DFK = 8272, C_DFV = 9296;
constexpr int FFN = 5632;
constexpr int NTHR_ = 512;
constexpr int KVAW = 768;

constexpr size_t MiB = 1u << 20;
constexpr size_t WS_CTL = 0, CTL_BYTES = 64 * 1024;
constexpr size_t WS_MOD = 1 * MiB;
constexpr size_t WS_ROPE = WS_MOD + 512 * 1024;
constexpr size_t WS_X = 2 * MiB;
constexpr size_t WS_H = 162 * MiB;
constexpr size_t WS_HF = 242 * MiB;
constexpr size_t WS_HB = 282 * MiB;
constexpr size_t WS_MLQ = 322 * MiB;
constexpr size_t WS_S5U = 362 * MiB;
constexpr size_t WS_DFQ = 402 * MiB;
constexpr size_t WS_MLK = 442 * MiB;
constexpr size_t WS_MLV = 482 * MiB;
constexpr size_t WS_MLO = 522 * MiB;
constexpr size_t WS_MQ = 562 * MiB;
constexpr size_t WS_KVA = 622 * MiB;
constexpr size_t WS_DFK = 682 * MiB;
constexpr size_t WS_DFV = 724 * MiB;
constexpr size_t WS_CKVN = 766 * MiB;
constexpr size_t WS_KFULL = 787 * MiB;
constexpr size_t WS_VFULL = 850 * MiB;
constexpr size_t WS_GATES = 892 * MiB;
constexpr size_t WS_CT = 894 * MiB;
constexpr size_t WS_WBF = 934 * MiB;
constexpr size_t WS_GS = 442 * MiB;
constexpr size_t WS_FFNH = 442 * MiB;
constexpr size_t WS_DFO = 442 * MiB;
constexpr size_t WS_YS5F = 442 * MiB;
constexpr size_t WS_YS5B = 482 * MiB;
constexpr size_t WS_END = 1101 * MiB;

constexpr size_t O_YP = 0, O_YS = 8388608, O_CKV = 41943040, O_KR = 46137344, O_DK = 46661632, O_DV = 55050240,
                 O_MC = 63438848, O_MN = 80216064, O_MM = 80281600, O_SR = 80281856, O_SI = 80544000, O_END = 80806144;

__device__ __forceinline__ unsigned f2bf(float f) { unsigned u = __builtin_bit_cast(unsigned, f); return (u + 0x7fffu + ((u >> 16) & 1u)) >> 16; }
__device__ __forceinline__ float bf2f(unsigned b) { return __builtin_bit_cast(float, (b & 0xffffu) << 16); }
__device__ __forceinline__ unsigned pk2(float lo, float hi) { return f2bf(lo) | (f2bf(hi) << 16); }
__device__ __forceinline__ float wave_sum(float v) {
#pragma unroll
    for (int o = 1; o < 64; o <<= 1) v += __shfl_xor(v, o);
    return v;
}
__device__ __forceinline__ float wave_max(float v) {
#pragma unroll
    for (int o = 1; o < 64; o <<= 1) v = fmaxf(v, __shfl_xor(v, o));
    return v;
}
__device__ __forceinline__ float sigmoidf_(float x) { return __builtin_amdgcn_rcpf(1.0f + __expf(-x)); }
__device__ __forceinline__ float siluf_(float x) { return x * __builtin_amdgcn_rcpf(1.0f + __expf(-x)); }
__device__ __forceinline__ float gelu_tanh(float x) { const float u = 0.7978845608028654f * (x + 0.044715f * x * x * x); const float t = 1.0f - 2.0f * __builtin_amdgcn_rcpf(1.0f + __expf(2.0f * u)); return 0.5f * x * (1.0f + t); }
__device__ __forceinline__ void sincos_small(float x, float& s, float& c) {
    const float k = rintf(x * 0.6366197723675814f);
    float r = fmaf(-k, 1.5707962513e+0f, x); r = fmaf(-k, 7.5497894159e-8f, r); r = fmaf(-k, 5.3903029534e-15f, r);
    const float r2 = r * r;
    const float sp = r + r * r2 * (-1.6666654611e-1f + r2 * (8.3321608736e-3f + r2 * (-1.9515295891e-4f)));
    const float cp = 1.0f - 0.5f * r2 + r2 * r2 * (4.166664568298827e-2f + r2 * (-1.388731625493765e-3f + r2 * 2.443315711809948e-5f));
    const int q = ((int)k) & 3;
    s = (q == 0) ? sp : (q == 1) ? cp : (q == 2) ? -sp : -cp;
    c = (q == 0) ? cp : (q == 1) ? -sp : (q == 2) ? -cp : sp;
}
__device__ __forceinline__ int cond_of_row(int r) { return r < NCTX ? 0 : 1 + ((r - NCTX) >> 12); }

struct P {
    const float* in[38];
    float* out;
    unsigned char* ws;
};
__device__ __forceinline__ const float* x_in(const P& p, int r) { return r < NCTX ? p.in[0] + (size_t)r * D : p.in[1] + (size_t)(r - NCTX) * D; }


#define XB_TMO      128
#define XB_XCNT(j)  (256  + 64 * (j))
#define XB_XSUB(j)  (1280 + 64 * (j))
#define XB_XGEN(j)  (2304 + 64 * (j))
#define XB_TOP      3328
#define XB_TOPGEN   3392
#define XCD_BAR_WORDS 3456
#define XB_SPIN_CAP (1u << 22)
#define LAS __attribute__((address_space(3)))

__device__ __forceinline__ unsigned xb_ld(unsigned* p)              { return __hip_atomic_load(p, __ATOMIC_RELAXED, __HIP_MEMORY_SCOPE_AGENT); }
__device__ __forceinline__ unsigned xb_add(unsigned* p, unsigned v) { return __hip_atomic_fetch_add(p, v, __ATOMIC_RELAXED, __HIP_MEMORY_SCOPE_AGENT); }
__device__ __forceinline__ unsigned xb_xcc_id() { return (unsigned)__builtin_amdgcn_s_getreg((3 << 11) | 20) & 0xFu; }
#define XB_SPIN(cond, bar) do { unsigned _sp = 0; while (cond) { __builtin_amdgcn_s_sleep(1); \
    if ((++_sp & 255u) == 0u) { if (xb_ld(&(bar)[XB_TMO])) break; if (_sp > XB_SPIN_CAP) { atomicAdd(&(bar)[XB_TMO], 1u); break; } } } } while (0)

__device__ __forceinline__ unsigned lane_id_() { unsigned l_; asm volatile("v_mbcnt_lo_u32_b32 %0, -1, 0\n\tv_mbcnt_hi_u32_b32 %0, -1, %0" : "=v"(l_)); return l_; }
struct XcdBarrier {
    unsigned* bar; unsigned x; unsigned w;
    volatile LAS unsigned* st;
};
__device__ __forceinline__ XcdBarrier xcd_barrier_post(unsigned* bar, volatile LAS unsigned* st) {
    XcdBarrier b; b.bar = bar; b.x = xb_xcc_id(); b.st = st; b.w = (unsigned)__builtin_amdgcn_readfirstlane(threadIdx.x >> 6);
    if (threadIdx.x == 0) (void)xb_add(&bar[XB_XCNT(b.x)], 1u);
    return b;
}
__device__ __forceinline__ void xcd_barrier_complete(unsigned* bar, unsigned x, unsigned& nloc, unsigned& nx) {
    const unsigned G = gridDim.x * gridDim.y * gridDim.z;
    unsigned sum, cnt, mine, sp = 0u;
    for (;;) {
        sum = 0u; cnt = 0u; mine = 0u;
#pragma unroll
        for (unsigned j = 0; j < 16; ++j) { const unsigned c = xb_ld(&bar[XB_XCNT(j)]); sum += c; cnt += (c > 0u) ? 1u : 0u; mine = (j == x) ? c : mine; }
        if (sum == G) break;
        __builtin_amdgcn_s_sleep(1);
        if ((++sp & 255u) == 0u) { if (xb_ld(&bar[XB_TMO])) break; if (sp > XB_SPIN_CAP) { atomicAdd(&bar[XB_TMO], 1u); break; } }
    }
    nloc = mine > 0u ? mine : 1u; nx = cnt > 0u ? cnt : 1u;
}
__device__ __forceinline__ void xcd_barrier(const XcdBarrier& b) {
    asm volatile("s_waitcnt vmcnt(0)" ::: "memory");
    __syncthreads();
    if (b.w == 0u && lane_id_() == 0u) {
        unsigned* bar = b.bar;
        __builtin_amdgcn_s_waitcnt(0);
        unsigned nloc = b.st[0], nx = b.st[1];
        if (nloc == 0u) { xcd_barrier_complete(bar, b.x, nloc, nx); b.st[0] = nloc; b.st[1] = nx; }
        const unsigned old = xb_add(&bar[XB_XSUB(b.x)], 1u);
        const unsigned gen = old / nloc;
        if (old + 1u == (gen + 1u) * nloc) {
            __builtin_amdgcn_fence(__ATOMIC_RELEASE, "agent");
            asm volatile("s_waitcnt vmcnt(0)" ::: "memory");
            const unsigned og = xb_add(&bar[XB_TOP], 1u);
            const unsigned tg = og / nx;
            if (og + 1u == (tg + 1u) * nx) xb_add(&bar[XB_TOPGEN], 1u);
            else XB_SPIN(xb_ld(&bar[XB_TOPGEN]) == tg, bar);
            __builtin_amdgcn_fence(__ATOMIC_ACQUIRE, "agent");
            xb_add(&bar[XB_XGEN(b.x)], 1u);
            asm volatile("s_waitcnt vmcnt(0)" ::: "memory");
        } else {
            XB_SPIN(xb_ld(&bar[XB_XGEN(b.x)]) == gen, bar);
            __builtin_amdgcn_fence(__ATOMIC_ACQUIRE, "agent");
            asm volatile("s_waitcnt vmcnt(0)" ::: "memory");
        }
    }
    __syncthreads();
}


constexpr int MOD_KS = 16, MOD_KC = 2048 / MOD_KS;
constexpr size_t WS_MODP = WS_X;
__device__ __forceinline__ void ph_mod_partial(const P& p, int tid, float* sc) {
    for (int i = tid; i < 5 * 2048; i += NTHR_) { const int c = i >> 11, k = i & 2047; const float v = c == 0 ? p.in[12][k] : p.in[11][(c - 1) * 2048 + k]; sc[i] = siluf_(v); }
    __syncthreads();
    const int NU = 2 * 3072 * MOD_KS;
    for (int u = blockIdx.x * NTHR_ + tid; u < NU; u += gridDim.x * NTHR_) {
        const int cg = u % 3072, kc = (u / 3072) % MOD_KS, l = u / (3072 * MOD_KS);
        const float* w = p.in[13] + ((size_t)l * 2048 + kc * MOD_KC) * 12288 + cg * 4;
        f32x4 a0 = {0.f, 0.f, 0.f, 0.f}, a1 = a0, a2 = a0, a3 = a0, a4 = a0;
#pragma unroll 8
        for (int k = 0; k < MOD_KC; ++k) { const f32x4 wv = *(const f32x4*)(w + (size_t)k * 12288); const int kk = kc * MOD_KC + k;
            a0 += wv * sc[kk]; a1 += wv * sc[2048 + kk]; a2 += wv * sc[4096 + kk]; a3 += wv * sc[6144 + kk]; a4 += wv * sc[8192 + kk]; }
        float* o = (float*)(p.ws + WS_MODP) + ((size_t)(kc * 2 + l) * 5) * 12288 + cg * 4;
        *(f32x4*)o = a0; *(f32x4*)(o + 12288) = a1; *(f32x4*)(o + 2 * 12288) = a2; *(f32x4*)(o + 3 * 12288) = a3; *(f32x4*)(o + 4 * 12288) = a4;
    }
    if (blockIdx.x == 0) {
        float* rt = (float*)(p.ws + WS_ROPE);
        for (int i = tid; i < 1024; i += NTHR_) { const int pos = i >> 4, j = i & 15; const float inv = exp2f(-(float)j * (13.287712379549449f / 16.0f)); float s_, c_; sincos_small((float)pos * inv, s_, c_); rt[i] = c_; rt[1024 + i] = s_; }
    }
}
__device__ __forceinline__ void ph_mod_reduce(const P& p, int tid) {
    for (int i = blockIdx.x * NTHR_ + tid; i < 2 * 5 * 12288; i += gridDim.x * NTHR_) {
        const int n = i % 12288, l = (i / 12288) / 5; float acc = p.in[14][l * 12288 + n];
#pragma unroll
        for (int kc = 0; kc < MOD_KS; ++kc) acc += ((const float*)(p.ws + WS_MODP))[(size_t)kc * 2 * 5 * 12288 + i];
        ((float*)(p.ws + WS_MOD))[i] = acc;
    }
}

__device__ __forceinline__ void ph_hnorm_rows(const P& p, int l, int which, int r0, int r1, int lane) {
    const bool from_in = (which == 0 && l == 0);
    const float* nw = p.in[which == 0 ? 15 : 16] + l * 2048;
    int ccur = -1; f32x4 A[8], S[8];
    for (int r = r0; r < r1; ++r) {
        const int cnd = cond_of_row(r);
        if (cnd != ccur) { ccur = cnd;
            const float* mod = (const float*)(p.ws + WS_MOD) + ((size_t)l * 5 + cnd) * 12288 + (which == 0 ? 0 : 3 * 2048);
#pragma unroll
            for (int j = 0; j < 8; ++j) { const int c = j * 256 + lane * 4; const f32x4 g = *(const f32x4*)(nw + c), s1 = *(const f32x4*)(mod + 2048 + c); S[j] = *(const f32x4*)(mod + c);
#pragma unroll
                for (int e = 0; e < 4; ++e) A[j][e] = g[e] * (1.0f + s1[e]); } }
        const float* x = x_in(p, r); const bf16_t* xb = (const bf16_t*)(p.ws + WS_X) + (size_t)r * D;
        f32x4 v[8]; float ss = 0.f;
#pragma unroll
        for (int j = 0; j < 8; ++j) {
            if (from_in) v[j] = *(const f32x4*)(x + j * 256 + lane * 4);
            else { const u32x2 w = *(const u32x2*)(xb + j * 256 + lane * 4); v[j] = (f32x4){bf2f(w.x), bf2f(w.x >> 16), bf2f(w.y), bf2f(w.y >> 16)}; }
            ss += v[j][0] * v[j][0] + v[j][1] * v[j][1] + v[j][2] * v[j][2] + v[j][3] * v[j][3]; }
        const float rstd = rsqrtf(wave_sum(ss) * (1.0f / 2048.0f) + 1e-6f);
        bf16_t* o = (bf16_t*)(p.ws + WS_H) + (size_t)r * D;
#pragma unroll
        for (int j = 0; j < 8; ++j) { const int c = j * 256 + lane * 4; float y[4];
#pragma unroll
            for (int e = 0; e < 4; ++e) y[e] = v[j][e] * rstd * A[j][e] + S[j][e];
            u32x2 w; w.x = pk2(y[0], y[1]); w.y = pk2(y[2], y[3]); *(u32x2*)(o + c) = w; }
    }
}

namespace pg8 {
#define PG8_LAS __attribute__((address_space(3)))
typedef unsigned short bf16_t;
typedef short bf16x8 __attribute__((ext_vector_type(8)));
typedef float f32x4 __attribute__((ext_vector_type(4)));
typedef unsigned u32x4 __attribute__((ext_vector_type(4)));
constexpr int BM = 256, BK = 64, HALF = 128, HTB = HALF * BK * 2  , STAGE_BYTES = 8 * HTB, NXCD = 8, WGM = 8;

__host__ __device__ __forceinline__ int lds_byte(int r, int c) { const int st = (r >> 4) * 2 + (c >> 5), rr = r & 15, cc = c & 31, ob = rr * 64 + cc * 2; return st * 1024 + (ob ^ (((ob >> 9) & 1) << 5)); }
__host__ __device__ __forceinline__ void stage_rc(int b, int& R, int& C) { const int st = b / 1024, sb = b % 1024, swz = sb ^ (((sb >> 9) & 1) << 5); R = (st >> 1) * 16 + swz / 64; C = (st & 1) * 32 + (swz % 64) / 2; }
__host__ __device__ __forceinline__ int perm32(int rho) { const int n = rho >> 4, i = rho & 15; return 8 * (i >> 2) + 4 * n + (i & 3); }

struct Unit { int pm, pn; };
struct Gemm { const bf16_t* A; const bf16_t* Bt; int M, N, K; };

struct StaticOrder {
    int nM, nN, nwg, G, c;
    __host__ __device__ void init(int M, int N, int G_, int c_) { nM = M / BM; nN = N / BM; nwg = nM * nN; G = G_; c = c_; }
    __host__ __device__ bool next(int i, Unit& u) const {
        const long L = (long)i * G + c; if (L >= nwg) return false;
        int wgid = (int)L; { const int q = nwg / NXCD, r = nwg % NXCD, xcd = wgid % NXCD, off = wgid / NXCD; wgid = (xcd < r ? xcd * (q + 1) : r * (q + 1) + (xcd - r) * q) + off; }
        const int nig = WGM * nN, gid = wgid / nig, fm = gid * WGM, gsz = (nM - fm) < WGM ? (nM - fm) : WGM;
        u.pm = fm + ((wgid % nig) % gsz); u.pn = (wgid % nig) / gsz; return true;
    }
    __device__ __forceinline__ void a_ready(const Unit&) const {}
    __device__ __forceinline__ void done(const Unit&) const {}
};

__device__ __forceinline__ unsigned cvt_pk_bf16(float lo, float hi) { unsigned r; asm volatile("s_nop 0\n\tv_cvt_pk_bf16_f32 %0, %1, %2" : "=v"(r) : "v"(lo), "v"(hi)); return r; }

template <class Epi, class Sched, bool ALIGN_EPI = false, bool SP2 = false>
__device__ __forceinline__ void gemm_phase(PG8_LAS unsigned char* lds, const Gemm g, const Sched& S, const Epi& E, int tid_in) {
    int tid_l = tid_in; asm volatile("" : "+v"(tid_l));
    const int tid = tid_l, wid = __builtin_amdgcn_readfirstlane(tid >> 6), lane = tid & 63, wr = wid >> 2, wc = wid & 3, fr = lane & 15, fq = lane >> 4;
    const int K = g.K, nt = K / BK;
    unsigned voffA[2], voffB[2];
#pragma unroll
    for (int i = 0; i < 2; ++i) { int R, C; stage_rc(tid * 16 + i * 8192, R, C); const int Rb = Epi::PERM ? ((R & ~31) + perm32(R & 31)) : R;
        voffA[i] = (unsigned)(R * K + C) * 2u; voffB[i] = (unsigned)(Rb * K + C) * 2u; }
    const size_t kstep = (size_t)(BK * 2);
    const size_t hstep = (size_t)HALF * K * 2;
    const size_t tstep = 2 * hstep;
    const unsigned ldsw = (unsigned)wid * 1024u;
    const int aoff = lds_byte(wr * 64 + fr, fq * 8), boff = lds_byte(wc * 32 + fr, fq * 8);
#define PG8_SA(b, h) (((b) * 2 + (h)) * HTB)
#define PG8_SB(b, h) ((4 + (b) * 2 + (h)) * HTB)
#define PG8_STAGE(bufoff, gbase, voff) do { _Pragma("unroll") for (int _i = 0; _i < 2; ++_i) \
        __builtin_amdgcn_global_load_lds((const unsigned*)((const char*)(gbase) + (voff)[_i]), (PG8_LAS unsigned*)(lds + (bufoff) + ldsw + _i * 8192), 16, 0, 0); } while (0)
#define PG8_LDA(dst, b, h) do { _Pragma("unroll") for (int m = 0; m < 4; ++m) _Pragma("unroll") for (int k = 0; k < 2; ++k) dst[m][k] = *(const PG8_LAS bf16x8*)(lds + PG8_SA(b, h) + aoff + m * 2048 + k * 1024); } while (0)
#define PG8_LDB(dst, b, h) do { _Pragma("unroll") for (int n = 0; n < 2; ++n) _Pragma("unroll") for (int k = 0; k < 2; ++k) dst[n][k] = *(const PG8_LAS bf16x8*)(lds + PG8_SB(b, h) + boff + n * 2048 + k * 1024); } while (0)
#define PG8_MMA(ai, bj, At, Bt) do { __builtin_amdgcn_s_setprio(1); _Pragma("unroll") for (int m = 0; m < 4; ++m) _Pragma("unroll") for (int n = 0; n < 2; ++n) _Pragma("unroll") for (int k = 0; k < 2; ++k) \
        acc[ai][bj][m][n] = __builtin_amdgcn_mfma_f32_16x16x32_bf16(Bt[n][k], At[m][k], acc[ai][bj][m][n], 0, 0, 0); __builtin_amdgcn_s_setprio(0); } while (0)
#define PG8_WAIT_V(n) asm volatile("s_waitcnt vmcnt(" #n ")" ::: "memory")
#define PG8_WAIT_L(n) asm volatile("s_waitcnt lgkmcnt(" #n ")" ::: "memory")
#define PG8_BAR __builtin_amdgcn_s_barrier()
#define PG8_SCHED __builtin_amdgcn_sched_barrier(0)
    Unit cur, nxt; int ui = 0;
    if (!S.next(0, cur)) return;
    f32x4 acc[2][2][4][2];
    { float z0 = 0.f; asm volatile("" : "+v"(z0));
#pragma unroll
    for (int a = 0; a < 2; ++a)
#pragma unroll
        for (int b = 0; b < 2; ++b)
#pragma unroll
            for (int m = 0; m < 4; ++m)
#pragma unroll
                for (int n = 0; n < 2; ++n) acc[a][b][m][n] = (f32x4){z0, z0, z0, z0}; }
    bf16x8 At[4][2], B0[2][2], B1[2][2];
    const char* cA = (const char*)g.A + (size_t)cur.pm * tstep; const char* cB = (const char*)g.Bt + (size_t)cur.pn * tstep;
    S.a_ready(cur);
    if constexpr (SP2) {
        PG8_STAGE(PG8_SB(0, 0), cB, voffB); PG8_STAGE(PG8_SB(0, 1), cB + hstep, voffB); PG8_STAGE(PG8_SA(0, 0), cA, voffA); PG8_STAGE(PG8_SA(0, 1), cA + hstep, voffA);
        if (wr == 1) PG8_BAR;
        PG8_WAIT_V(2); PG8_BAR;
        PG8_STAGE(PG8_SB(1, 0), cB + kstep, voffB); PG8_STAGE(PG8_SA(1, 0), cA + kstep, voffA); PG8_STAGE(PG8_SB(1, 1), cB + hstep + kstep, voffB);
        PG8_WAIT_V(6); PG8_BAR;
    } else {
        PG8_STAGE(PG8_SB(0, 0), cB, voffB); PG8_STAGE(PG8_SA(0, 0), cA, voffA); PG8_STAGE(PG8_SB(0, 1), cB + hstep, voffB); PG8_STAGE(PG8_SA(0, 1), cA + hstep, voffA);
        if (wr == 1) PG8_BAR;
        PG8_WAIT_V(4); PG8_BAR;
        PG8_STAGE(PG8_SB(1, 0), cB + kstep, voffB); PG8_STAGE(PG8_SA(1, 0), cA + kstep, voffA); PG8_STAGE(PG8_SB(1, 1), cB + hstep + kstep, voffB);
        PG8_WAIT_V(6); PG8_BAR;
    }
    for (;;) {
        const bool has_next = S.next(ui + 1, nxt);
        const char* nA = has_next ? (const char*)g.A + (size_t)nxt.pm * tstep : cA; const char* nB = has_next ? (const char*)g.Bt + (size_t)nxt.pn * tstep : cB;
        for (int t = 0; t < nt; t += 2) {
            const bool last = (t == nt - 2);
            const char* a1 = cA + (size_t)(t + 1) * kstep;
            const char* a2 = last ? nA : cA + (size_t)(t + 2) * kstep; const char* b2 = last ? nB : cB + (size_t)(t + 2) * kstep;
            const char* a3 = a2 + kstep; const char* b3 = b2 + kstep;
            if (last && has_next) S.a_ready(nxt);
            if constexpr (SP2) {
            PG8_LDB(B0, 0, 0); PG8_LDB(B1, 0, 1); PG8_SCHED; PG8_LDA(At, 0, 0); PG8_STAGE(PG8_SA(1, 1), a1 + hstep, voffA);
            PG8_WAIT_V(8); PG8_WAIT_L(0); PG8_BAR; PG8_MMA(0, 0, At, B0); PG8_MMA(0, 1, At, B1); PG8_BAR; PG8_SCHED;
            PG8_LDA(At, 0, 1); PG8_STAGE(PG8_SB(0, 0), b2, voffB); PG8_STAGE(PG8_SB(0, 1), b2 + hstep, voffB); PG8_STAGE(PG8_SA(0, 0), a2, voffA);
            PG8_WAIT_V(8); PG8_WAIT_L(0); PG8_BAR; PG8_MMA(1, 0, At, B0); PG8_MMA(1, 1, At, B1); PG8_BAR; PG8_SCHED;
            PG8_LDB(B0, 1, 0); PG8_LDB(B1, 1, 1); PG8_SCHED; PG8_LDA(At, 1, 0); PG8_STAGE(PG8_SA(0, 1), a2 + hstep, voffA);
            PG8_WAIT_V(8); PG8_WAIT_L(0); PG8_BAR; PG8_MMA(0, 0, At, B0); PG8_MMA(0, 1, At, B1); PG8_BAR; PG8_SCHED;
            PG8_LDA(At, 1, 1); PG8_STAGE(PG8_SB(1, 0), b3, voffB); PG8_STAGE(PG8_SB(1, 1), b3 + hstep, voffB); PG8_STAGE(PG8_SA(1, 0), a3, voffA);
            PG8_WAIT_V(8); PG8_WAIT_L(0); PG8_BAR; PG8_MMA(1, 0, At, B0); PG8_MMA(1, 1, At, B1); PG8_BAR; PG8_SCHED;
            } else {
            PG8_LDB(B0, 0, 0); PG8_SCHED; PG8_LDA(At, 0, 0); PG8_STAGE(PG8_SA(1, 1), a1 + hstep, voffA);
            PG8_WAIT_L(8); PG8_BAR; PG8_WAIT_L(0); PG8_MMA(0, 0, At, B0); PG8_BAR; PG8_SCHED;
            PG8_LDB(B1, 0, 1); PG8_STAGE(PG8_SB(0, 0), b2, voffB);
            PG8_BAR; PG8_WAIT_L(0); PG8_MMA(0, 1, At, B1); PG8_BAR;
            PG8_LDA(At, 0, 1); PG8_STAGE(PG8_SA(0, 0), a2, voffA);
            PG8_BAR; PG8_WAIT_L(0); PG8_MMA(1, 0, At, B0); PG8_BAR; PG8_SCHED;
            PG8_STAGE(PG8_SB(0, 1), b2 + hstep, voffB);
            PG8_WAIT_V(6); PG8_BAR; PG8_MMA(1, 1, At, B1); PG8_BAR;
            PG8_LDB(B0, 1, 0); PG8_SCHED; PG8_LDA(At, 1, 0); PG8_STAGE(PG8_SA(0, 1), a2 + hstep, voffA);
            PG8_WAIT_L(8); PG8_BAR; PG8_WAIT_L(0); PG8_MMA(0, 0, At, B0); PG8_BAR; PG8_SCHED;
            PG8_LDB(B1, 1, 1); PG8_STAGE(PG8_SB(1, 0), b3, voffB);
            PG8_BAR; PG8_WAIT_L(0); PG8_MMA(0, 1, At, B1); PG8_BAR;
            PG8_LDA(At, 1, 1); PG8_STAGE(PG8_SA(1, 0), a3, voffA);
            PG8_BAR; PG8_WAIT_L(0); PG8_MMA(1, 0, At, B0); PG8_BAR; PG8_SCHED;
            PG8_STAGE(PG8_SB(1, 1), b3 + hstep, voffB);
            PG8_WAIT_V(6); PG8_BAR; PG8_MMA(1, 1, At, B1); PG8_BAR;
            }
        }
        if constexpr (ALIGN_EPI) { if (wr == 0) PG8_BAR; }
        if constexpr (!Epi::AFTER_DRAIN) { E(acc, cur, wr, wc, fr, fq); S.done(cur); }
        if (!has_next) break;
        { float z0 = 0.f; asm volatile("" : "+v"(z0));
#pragma unroll
        for (int a = 0; a < 2; ++a)
#pragma unroll
            for (int b = 0; b < 2; ++b)
#pragma unroll
                for (int m = 0; m < 4; ++m)
#pragma unroll
                    for (int n = 0; n < 2; ++n) acc[a][b][m][n] = (f32x4){z0, z0, z0, z0}; }
        cur = nxt; cA = nA; cB = nB; ++ui;
        if constexpr (ALIGN_EPI) { if (wr == 1) PG8_BAR; }
    }
    PG8_WAIT_V(0);
    if constexpr (!ALIGN_EPI) { if (wr == 0) PG8_BAR; }
    PG8_BAR;
    if constexpr (Epi::AFTER_DRAIN) { E.fused(acc, cur, wr, wc, fr, fq, lds, wid, lane); S.done(cur); }
#undef PG8_SA
#undef PG8_SB
#undef PG8_STAGE
#undef PG8_LDA
#undef PG8_LDB
#undef PG8_MMA
#undef PG8_WAIT_V
#undef PG8_WAIT_L
#undef PG8_BAR
#undef PG8_SCHED
}
}

#define PG8_ROW(ai, m) (u.pm * 256 + (ai) * 128 + wr * 64 + (m) * 16 + fr)
#define PG8_FOR(...) _Pragma("unroll") for (int ai = 0; ai < 2; ++ai) _Pragma("unroll") for (int m = 0; m < 4; ++m) { const int row = PG8_ROW(ai, m); _Pragma("unroll") for (int bj = 0; bj < 2; ++bj) { \
    const int ct = bj * 128 + wc * 32 + 8 * fq; const pg8::f32x4 v0 = acc[ai][bj][m][0], v1 = acc[ai][bj][m][1]; __VA_ARGS__ } }
__device__ __forceinline__ u32x4 pack8(const pg8::f32x4& a, const pg8::f32x4& b) { u32x4 w; w.x = pg8::cvt_pk_bf16(a[0], a[1]); w.y = pg8::cvt_pk_bf16(a[2], a[3]); w.z = pg8::cvt_pk_bf16(b[0], b[1]); w.w = pg8::cvt_pk_bf16(b[2], b[3]); return w; }
__device__ __forceinline__ void unpack8(const u32x4& w, float (&f)[8]) {
#pragma unroll
    for (int i = 0; i < 4; ++i) { f[2 * i] = bf2f(w[i]); f[2 * i + 1] = bf2f(w[i] >> 16); } }

struct Epi8In {
    static constexpr bool PERM = true, AFTER_DRAIN = false;
    unsigned char* ws;
    __device__ __forceinline__ void operator()(const pg8::f32x4 (&acc)[2][2][4][2], const pg8::Unit& u, int wr, int wc, int fr, int fq) const {
        const int pn = u.pn;
        if (pn >= 22 && pn < 25) {
            float* kva = (float*)(ws + WS_KVA);
            PG8_FOR({ float* o = kva + (size_t)row * KVAW + (pn - 22) * 256 + ct; *(pg8::f32x4*)o = v0; *(pg8::f32x4*)(o + 4) = v1; })
            return;
        }
        size_t base; int ldc, c0, mode = 0;
        if (pn < 4) { base = WS_MLQ; ldc = 1024; c0 = pn * 256; }
        else if (pn < 8) { base = WS_MLK; ldc = 1024; c0 = (pn - 4) * 256; mode = 1; }
        else if (pn < 12) { base = WS_MLV; ldc = 1024; c0 = (pn - 8) * 256; }
        else if (pn < 16) { base = WS_MLO; ldc = 1024; c0 = (pn - 12) * 256; mode = 2; }
        else if (pn < 22) { base = WS_MQ; ldc = 1536; c0 = (pn - 16) * 256; mode = 3; }
        else if (pn < 29) { base = WS_S5U; ldc = 1024; c0 = (pn - 25) * 256; }
        else if (pn < 33) { base = WS_DFQ; ldc = 1024; c0 = (pn - 29) * 256; mode = 4; }
        else if (pn < 37) { base = WS_DFK; ldc = 1024; c0 = (pn - 33) * 256; }
        else { base = WS_DFV; ldc = 1024; c0 = (pn - 37) * 256; }
        bf16_t* O = (bf16_t*)(ws + base);
        PG8_FOR({ pg8::f32x4 a = v0, b = v1;
            if (mode == 1) { a = a * 0.0625f; b = b * 0.0625f; }
            if (mode == 3) { a = a * (0.07216878364870322f * 1.4426950408889634f); b = b * (0.07216878364870322f * 1.4426950408889634f); }
            if (mode == 4) { a = a * (0.125f * 1.4426950408889634f); b = b * (0.125f * 1.4426950408889634f); }
            if (mode == 2) {
_Pragma("unroll")
                for (int e = 0; e < 4; ++e) { a[e] = sigmoidf_(a[e]); b[e] = sigmoidf_(b[e]); } }
            *(u32x4*)(O + (size_t)row * ldc + c0 + ct) = pack8(a, b); })
    }
};
struct Epi8Gate {
    static constexpr bool PERM = true, AFTER_DRAIN = false;
    bf16_t* gs;
    __device__ __forceinline__ void operator()(const pg8::f32x4 (&acc)[2][2][4][2], const pg8::Unit& u, int wr, int wc, int fr, int fq) const {
        PG8_FOR({ pg8::f32x4 a, b;
_Pragma("unroll")
            for (int e = 0; e < 4; ++e) { a[e] = sigmoidf_(v0[e]); b[e] = sigmoidf_(v1[e]); }
            *(u32x4*)(gs + (size_t)row * GATE_COLS + u.pn * 256 + ct) = pack8(a, b); })
    }
};
struct Epi8Kvb {
    static constexpr bool PERM = true, AFTER_DRAIN = false;
    bf16_t* kf; bf16_t* vf;
    __device__ __forceinline__ void operator()(const pg8::f32x4 (&acc)[2][2][4][2], const pg8::Unit& u, int wr, int wc, int fr, int fq) const {
        PG8_FOR({ bf16_t* o = bj == 0 ? kf + (size_t)row * 1536 + u.pn * 192 + wc * 32 + 8 * fq : vf + (size_t)row * 1024 + u.pn * 128 + wc * 32 + 8 * fq; (void)ct;
            *(u32x4*)o = pack8(v0, v1); })
    }
};
struct Epi8Glu {
    static constexpr bool PERM = true, AFTER_DRAIN = false;
    const bf16_t* g; bf16_t* y;
    __device__ __forceinline__ void operator()(const pg8::f32x4 (&acc)[2][2][4][2], const pg8::Unit& u, int wr, int wc, int fr, int fq) const {
        PG8_FOR({ const size_t i = (size_t)row * 1024 + u.pn * 256 + ct; float gf[8]; unpack8(*(const u32x4*)(g + i), gf); pg8::f32x4 a, b;
_Pragma("unroll")
            for (int e = 0; e < 4; ++e) { a[e] = gf[e] * sigmoidf_(v0[e]); b[e] = gf[4 + e] * sigmoidf_(v1[e]); }
            *(u32x4*)(y + i) = pack8(a, b); })
    }
};
struct Epi8Merge {
    static constexpr bool PERM = true, AFTER_DRAIN = false;
    const bf16_t* gs; bf16_t* mg; int b; int pad;
    __device__ __forceinline__ void operator()(const pg8::f32x4 (&acc)[2][2][4][2], const pg8::Unit& u, int wr, int wc, int fr, int fq) const {
        PG8_FOR({ const size_t i = (size_t)row * D + u.pn * 256 + ct; float gf[8], pf[8]; unpack8(*(const u32x4*)(gs + (size_t)row * GATE_COLS + b * D + u.pn * 256 + ct), gf);
            if (b) unpack8(*(const u32x4*)(mg + i), pf); else {
_Pragma("unroll")
                for (int e = 0; e < 8; ++e) pf[e] = 0.f; }
            pg8::f32x4 a, c;
_Pragma("unroll")
            for (int e = 0; e < 4; ++e) { a[e] = pf[e] + gf[e] * v0[e]; c[e] = pf[4 + e] + gf[4 + e] * v1[e]; }
            *(u32x4*)(mg + i) = pack8(a, c); })
    }
};
struct Epi8Res {
    static constexpr bool PERM = true, AFTER_DRAIN = false;
    P p; int l; int goff; int from_x; int pad;
    __device__ __forceinline__ void operator()(const pg8::f32x4 (&acc)[2][2][4][2], const pg8::Unit& u, int wr, int wc, int fr, int fq) const {
        bf16_t* X = (bf16_t*)(p.ws + WS_X);
        const float* gv = (const float*)(p.ws + WS_MOD) + ((size_t)l * 5 + cond_of_row(u.pm * 256)) * 12288 + goff + u.pn * 256;
        const bool from_in = (!from_x && l == 0);
        pg8::f32x4 gpre[2][2];
_Pragma("unroll")
        for (int bj = 0; bj < 2; ++bj) { const int ct = bj * 128 + wc * 32 + 8 * fq; gpre[bj][0] = *(const pg8::f32x4*)(gv + ct); gpre[bj][1] = *(const pg8::f32x4*)(gv + ct + 4); }
        PG8_FOR({ bf16_t* dst = X + (size_t)row * D + u.pn * 256 + ct;
            const pg8::f32x4 g0 = gpre[bj][0], g1 = gpre[bj][1]; pg8::f32x4 s0, s1;
            if (from_in) { const float* src = x_in(p, row) + u.pn * 256 + ct; s0 = *(const pg8::f32x4*)src; s1 = *(const pg8::f32x4*)(src + 4); }
            else { float sf[8]; unpack8(*(const u32x4*)dst, sf); s0 = (pg8::f32x4){sf[0], sf[1], sf[2], sf[3]}; s1 = (pg8::f32x4){sf[4], sf[5], sf[6], sf[7]}; }
            *(u32x4*)dst = pack8(s0 + g0 * v0, s1 + g1 * v1); })
    }
};
struct Epi8FfnIn {
    static constexpr bool PERM = true, AFTER_DRAIN = false;
    bf16_t* hh;
    __device__ __forceinline__ void operator()(const pg8::f32x4 (&acc)[2][2][4][2], const pg8::Unit& u, int wr, int wc, int fr, int fq) const {
_Pragma("unroll")
        for (int ai = 0; ai < 2; ++ai)
_Pragma("unroll")
            for (int m = 0; m < 4; ++m) { const int row = PG8_ROW(ai, m); pg8::f32x4 a, b;
_Pragma("unroll")
                for (int e = 0; e < 4; ++e) { a[e] = siluf_(acc[ai][0][m][0][e]) * acc[ai][1][m][0][e]; b[e] = siluf_(acc[ai][0][m][1][e]) * acc[ai][1][m][1][e]; }
                *(u32x4*)(hh + (size_t)row * FFN + u.pn * 128 + wc * 32 + 8 * fq) = pack8(a, b); }
    }
};

__device__ __forceinline__ int win_row(int n) {
    if (n < 4096) return n;
    if (n < 4112) return 6208 + (n - 4096);
    if (n < 5648) return 4096 + (n - 4112);
    if (n < 6224) return 5632 + (n - 5648);
    if (n < MIX_COLS) return 6400 + (n - 6224);
    return 10496 + (n - MIX_COLS);
}
template <int MAP>
__device__ __forceinline__ void cvt_item(const float* W, int K, int N, bf16_t* WT, int row_off, LAS float* scr, int item, int lane) {
    const int nblk = (N + 31) / 32, kb = item / nblk, nb = item % nblk, k0 = 64 * kb, n0 = 32 * nb;
    const int nl = (lane & 7) * 4, kr = lane >> 3;
    const bool nok = n0 + nl < N;
    const float* wp = W + (size_t)(k0 + kr) * N + n0 + nl;
    f32x4 v[8];
#pragma unroll
    for (int i = 0; i < 8; ++i) v[i] = nok ? *(const f32x4*)(wp + (size_t)(8 * i) * N) : (f32x4){0.f, 0.f, 0.f, 0.f};
#pragma unroll
    for (int i = 0; i < 8; ++i) { LAS float* d = scr + (kr + 8 * i) * 33 + nl; d[0] = v[i][0]; d[1] = v[i][1]; d[2] = v[i][2]; d[3] = v[i][3]; }
    asm volatile("s_waitcnt lgkmcnt(0)" ::: "memory");
    const int c = lane & 7;
#pragma unroll
    for (int j = 0; j < 4; ++j) { const int n = (lane >> 3) + 8 * j; const LAS float* s = scr + (8 * c) * 33 + n;
        u32x4 o; o.x = pk2(s[0 * 33], s[1 * 33]); o.y = pk2(s[2 * 33], s[3 * 33]); o.z = pk2(s[4 * 33], s[5 * 33]); o.w = pk2(s[6 * 33], s[7 * 33]);
        const int ng = n0 + n; int row;
        if (MAP == 0) row = row_off + ng; else if (MAP == 1) row = win_row(ng); else row = (ng < FFN) ? ((ng >> 7) * 256 + (ng & 127)) : (((ng - FFN) >> 7) * 256 + 128 + ((ng - FFN) & 127));
        if (ng < N) *(u32x4*)(WT + (size_t)row * K + k0 + 8 * c) = o; }
    asm volatile("s_waitcnt lgkmcnt(0)" ::: "memory");
}
constexpr size_t WB_IN = 0, WB_KVB = 73 * MiB, WB_GLU = 75 * MiB, WB_BR = 77 * MiB, WB_O = 93 * MiB, WB_FIN = 101 * MiB, WB_FOUT = 145 * MiB, WB_END = 167 * MiB;
constexpr int NIN_T = 18688;
__device__ __forceinline__ void ph_convert(const P& p, int l, int gw, int NGW, int lane, LAS float* scr, const bool early, const bool late) {
    unsigned char* wb = p.ws + WS_WBF;
    constexpr int I_IN = (D / 64) * ((IN_COLS + 31) / 32), I_KVB = (512 / 64) * (2048 / 32), I_GLU = (1024 / 64) * (1024 / 32), I_BR = (1024 / 64) * (2048 / 32), I_O = (D / 64) * (D / 32),
                  I_FIN = (D / 64) * (2 * FFN / 32), I_FOUT = (FFN / 64) * (D / 32);
    constexpr int NIT = I_IN + I_KVB + I_GLU + 4 * I_BR + I_O + I_FIN + I_FOUT;
    const int it_lo = early ? 0 : NIT - I_FOUT, it_hi = late ? NIT : NIT - I_FOUT;
    for (int it = it_lo + gw; it < it_hi; it += NGW) {
        int r = it;
        if (r < I_IN) { cvt_item<1>(p.in[17] + (size_t)l * D * IN_COLS, D, IN_COLS, (bf16_t*)(wb + WB_IN), 0, scr, r, lane); continue; } r -= I_IN;
        if (r < I_KVB) { cvt_item<0>(p.in[21] + (size_t)l * 512 * 2048, 512, 2048, (bf16_t*)(wb + WB_KVB), 0, scr, r, lane); continue; } r -= I_KVB;
        if (r < I_GLU) { cvt_item<0>(p.in[30] + (size_t)l * 1024 * 1024, 1024, 1024, (bf16_t*)(wb + WB_GLU), 0, scr, r, lane); continue; } r -= I_GLU;
        if (r < 4 * I_BR) { const int b = r / I_BR; cvt_item<0>(p.in[33] + ((size_t)l * 4 + b) * 1024 * 2048, 1024, 2048, (bf16_t*)(wb + WB_BR) + (size_t)b * 2048 * 1024, 0, scr, r % I_BR, lane); continue; } r -= 4 * I_BR;
        if (r < I_O) { cvt_item<0>(p.in[34] + (size_t)l * D * D, D, D, (bf16_t*)(wb + WB_O), 0, scr, r, lane); continue; } r -= I_O;
        if (r < I_FIN) { cvt_item<2>(p.in[35] + (size_t)l * D * 2 * FFN, D, 2 * FFN, (bf16_t*)(wb + WB_FIN), 0, scr, r, lane); continue; } r -= I_FIN;
        cvt_item<0>(p.in[36] + (size_t)l * FFN * D, FFN, D, (bf16_t*)(wb + WB_FOUT), 0, scr, r, lane);
    }
    if (early) for (int row = 6224 + gw; row < 6400; row += NGW) { u32x4* o = (u32x4*)((bf16_t*)(wb + WB_IN) + (size_t)row * D); for (int j = lane; j < D / 8; j += 64) o[j] = (u32x4){0u, 0u, 0u, 0u}; }
}


__device__ __forceinline__ int xcd_slot() { const int G_ = (int)gridDim.x, c_ = (int)blockIdx.x; return (G_ % 8 == 0) ? (c_ % 8) * (G_ / 8) + c_ / 8 : c_; }
namespace fa {
typedef short s16x4 __attribute__((ext_vector_type(4)));
__device__ __forceinline__ int crow(int r, int hi) { return (r & 3) + 8 * (r >> 2) + 4 * hi; }
__device__ __forceinline__ unsigned cvtpk(float lo, float hi) { unsigned r; asm volatile("v_cvt_pk_bf16_f32 %0, %1, %2" : "=v"(r) : "v"(lo), "v"(hi)); return r; }
#define FA_SBAR() __builtin_amdgcn_sched_barrier(0)
constexpr float THR = 8.f;
__device__ __forceinline__ void partialSM_fma(f32x16& p0, f32x16& p1, float& m_reg, float& mn, float& alpha, float SCALE) {
    const float C = SCALE * 1.4426950408889634f;
    float pmax = p0[0];
#pragma unroll
    for (int r = 1; r < 16; ++r) pmax = fmaxf(pmax, p0[r]);
#pragma unroll
    for (int r = 0; r < 16; ++r) pmax = fmaxf(pmax, p1[r]);
    { auto rr = __builtin_amdgcn_permlane32_swap(__float_as_uint(pmax), __float_as_uint(pmax), false, false);
      pmax = fmaxf(__uint_as_float(rr[0]), __uint_as_float(rr[1])); }
    if (__builtin_expect(__all(pmax - m_reg <= THR / SCALE), 1)) { mn = m_reg; alpha = 1.f; }
    else { mn = fmaxf(m_reg, pmax); alpha = __builtin_amdgcn_exp2f((m_reg - mn) * C); m_reg = mn; }
    const float mnC = -mn * C;
#pragma unroll
    for (int r = 0; r < 16; ++r) p0[r] = fmaf(p0[r], C, mnC);
#pragma unroll
    for (int r = 0; r < 16; ++r) p1[r] = fmaf(p1[r], C, mnC);
#pragma unroll
    for (int r = 0; r < 16; ++r) p0[r] = __builtin_amdgcn_exp2f(p0[r]);
}
constexpr float THR2 = THR * 1.4426950408889634f;
__device__ __forceinline__ void partialSM(f32x16& p0, f32x16& p1, float& m_reg, f32x16& nm, float& alpha, const bool first) {
    float pmax = p0[0];
#pragma unroll
    for (int r = 1; r < 16; ++r) pmax = fmaxf(pmax, p0[r]);
#pragma unroll
    for (int r = 0; r < 16; ++r) pmax = fmaxf(pmax, p1[r]);
    { auto rr = __builtin_amdgcn_permlane32_swap(__float_as_uint(pmax), __float_as_uint(pmax), false, false);
      pmax = fmaxf(__uint_as_float(rr[0]), __uint_as_float(rr[1])); }
    alpha = 1.f;
    if (first || !__all(pmax <= THR2)) {
        const float d = first ? pmax : fmaxf(pmax, 0.f);
        if (!first) alpha = __builtin_amdgcn_exp2f(-d);
        m_reg += d;
#pragma unroll
        for (int r = 0; r < 16; ++r) { p0[r] -= d; p1[r] -= d; nm[r] = -m_reg; }
    }
#pragma unroll
    for (int r = 0; r < 16; ++r) p0[r] = __builtin_amdgcn_exp2f(p0[r]);
}
__device__ __forceinline__ void finishSM(f32x16& p0, f32x16& p1, float alpha, float& l_reg, bf16x8& pa0, bf16x8& pa1, bf16x8& pa2, bf16x8& pa3) {
#pragma unroll
    for (int r = 0; r < 16; ++r) p1[r] = __builtin_amdgcn_exp2f(p1[r]);
    FA_SBAR(); asm volatile("s_nop 1");
    float ps = 0;
#pragma unroll
    for (int r = 0; r < 16; ++r) ps += p0[r];
#pragma unroll
    for (int r = 0; r < 16; ++r) ps += p1[r];
    { auto rr = __builtin_amdgcn_permlane32_swap(__float_as_uint(ps), __float_as_uint(ps), false, false);
      ps = __uint_as_float(rr[0]) + __uint_as_float(rr[1]); }
    l_reg = l_reg * alpha + ps;
#define FA_PK4(P, BASE, OUT) do { u32x4 w = {cvtpk(P[BASE + 0], P[BASE + 1]), cvtpk(P[BASE + 2], P[BASE + 3]), cvtpk(P[BASE + 4], P[BASE + 5]), cvtpk(P[BASE + 6], P[BASE + 7])}; \
    OUT = *reinterpret_cast<bf16x8*>(&w); } while (0)
    FA_PK4(p0, 0, pa0); FA_PK4(p0, 8, pa1); FA_PK4(p1, 0, pa2); FA_PK4(p1, 8, pa3);
#undef FA_PK4
}
__device__ __forceinline__ int v_rd_base(int lane) { return ((lane & 3) << 3) | (((lane >> 2) & 3) << 6) | (((lane >> 4) & 1) << 5) | (((lane >> 5) & 1) << 8); }
constexpr int v_rd_off(int d0, int ks, int half) { return d0 * 512 + ks * 4096 + half * 2048; }
__device__ __forceinline__ bf16x8 lds_rd128i(unsigned addr, const int off) { bf16x8 r; asm volatile("ds_read_b128 %0, %1 offset:%2" : "=&v"(r) : "v"(addr), "i"(off) : "memory"); return r; }
template <int OFF> __device__ __forceinline__ bf16x8 lds_rd128(unsigned addr) { bf16x8 r; asm volatile("ds_read_b128 %0, %1 offset:%2" : "=&v"(r) : "v"(addr), "i"(OFF) : "memory"); return r; }
template <int OFF> __device__ __forceinline__ s16x4 tr_read(unsigned vb) {
    s16x4 r; asm volatile("ds_read_b64_tr_b16 %0, %1 offset:%2" : "=&v"(r) : "v"(vb), "i"(OFF) : "memory"); return r;
}
template <int D0> __device__ __forceinline__ void pv_one(f32x16& od, unsigned vb, bf16x8 pa0, bf16x8 pa1, bf16x8 pa2, bf16x8 pa3) {
    const s16x4 l0 = tr_read<v_rd_off(D0, 0, 0)>(vb), h0 = tr_read<v_rd_off(D0, 0, 1)>(vb), l1 = tr_read<v_rd_off(D0, 1, 0)>(vb), h1 = tr_read<v_rd_off(D0, 1, 1)>(vb);
    const s16x4 l2 = tr_read<v_rd_off(D0, 2, 0)>(vb), h2 = tr_read<v_rd_off(D0, 2, 1)>(vb), l3 = tr_read<v_rd_off(D0, 3, 0)>(vb), h3 = tr_read<v_rd_off(D0, 3, 1)>(vb);
    asm volatile("s_waitcnt lgkmcnt(0)" ::: "memory"); FA_SBAR();
#define FA_PK(L, H) (bf16x8){L[0], L[1], L[2], L[3], H[0], H[1], H[2], H[3]}
    od = __builtin_amdgcn_mfma_f32_32x32x16_bf16(pa0, FA_PK(l0, h0), od, 0, 0, 0);
    od = __builtin_amdgcn_mfma_f32_32x32x16_bf16(pa1, FA_PK(l1, h1), od, 0, 0, 0);
    od = __builtin_amdgcn_mfma_f32_32x32x16_bf16(pa2, FA_PK(l2, h2), od, 0, 0, 0);
    od = __builtin_amdgcn_mfma_f32_32x32x16_bf16(pa3, FA_PK(l3, h3), od, 0, 0, 0);
#undef FA_PK
}
struct Args { const bf16_t* Q; const bf16_t* K; const bf16_t* V; bf16_t* O; int qpitch, kpitch, vpitch, opitch, nheads, vdiv; float scale; int pad; };

template <int DQK>
__device__ __forceinline__ void attn_phase(LAS unsigned char* lds, const Args& a, int tid) {
    constexpr int KROWB = DQK * 2, KCH = KROWB / 16, KTILE = 64 * KROWB, VTILE = 16384, STAGE = KTILE + VTILE, NKI = KTILE / 8192, NVI = 2, NDMA = NKI + NVI, ND = DQK / 16;
    constexpr int RING = (DQK == 64) ? 4 : 3;
    static_assert(RING * STAGE + 2048 <= 131072, "attention LDS");
    const int wid = __builtin_amdgcn_readfirstlane(tid >> 6), lane = tid & 63, r32 = lane & 31, hi = lane >> 5;
    const int krow = (r32 & ~0xC) | ((r32 & 4) << 1) | ((r32 & 8) >> 1);
    LAS float* wsc = (LAS float*)(lds + RING * STAGE) + wid * 64;
    unsigned koff_[NKI], voff_[NVI];
#pragma unroll
    for (int i = 0; i < NKI; ++i) { const int s = i * 512 + wid * 64 + lane, row = s / KCH, ch = s % KCH; koff_[i] = (unsigned)(row * a.kpitch + (ch ^ ((row & 3) | (((row >> 3) & 1) << 2))) * 8) * 2u; }
#pragma unroll
    for (int i = 0; i < NVI; ++i) { const int o = (i * 512 + wid * 64 + lane) * 16, sub = o >> 9, within = o & 511, kk = (sub >> 2) * 8 + (within >> 6), c = (sub & 3) * 32 + ((within & 63) >> 1);
        const int k = (kk & ~0xC) | ((kk & 4) << 1) | ((kk & 8) >> 1); voff_[i] = (unsigned)(k * a.vpitch + c) * 2u; }
    const unsigned vb0 = (unsigned)(uintptr_t)(lds + KTILE) + (unsigned)v_rd_base(lane);
    const int n_lat = a.nheads * 64, n_units = n_lat + a.nheads * 16;
    for (int u = xcd_slot(); u < n_units; u += gridDim.x) {
        int b, h, q0, nk, kbase, cbase;
        if (u < n_lat) { const int bh = u >> 4, qb = u & 15; b = bh / a.nheads; h = bh % a.nheads; q0 = NCTX + b * LL + qb * 256; nk = LL + PAST; kbase = NCTX + b * LL; cbase = MTOK + b * PAST; }
        else { const int v = u - n_lat; b = v / a.nheads; h = v % a.nheads; q0 = b * CL; nk = CL; kbase = b * CL; cbase = 0; }
        const int NT = nk >> 6, vh = h / a.vdiv;
        const bf16_t* Kh = a.K + h * DQK; const bf16_t* Vh = a.V + vh * 128;
#define FA_ISSUE(j) do { const int t0_ = (j) * 64; const int rb_ = (t0_ < LL || nk == CL) ? kbase + t0_ : cbase + (t0_ - LL); LAS unsigned char* st_ = lds + ((j) % RING) * STAGE; \
        const char* kb_ = (const char*)(Kh + (size_t)rb_ * a.kpitch); const char* vb_ = (const char*)(Vh + (size_t)rb_ * a.vpitch); \
        _Pragma("unroll") for (int i_ = 0; i_ < NKI; ++i_) __builtin_amdgcn_global_load_lds((const unsigned*)(kb_ + koff_[i_]), (LAS unsigned*)(st_ + i_ * 8192 + wid * 1024), 16, 0, 0); \
        _Pragma("unroll") for (int i_ = 0; i_ < NVI; ++i_) __builtin_amdgcn_global_load_lds((const unsigned*)(vb_ + voff_[i_]), (LAS unsigned*)(st_ + KTILE + i_ * 8192 + wid * 1024), 16, 0, 0); } while (0)
        bf16x8 qr[ND];
        { const bf16_t* Qw = a.Q + (size_t)(q0 + wid * 32 + r32) * a.qpitch + h * DQK + hi * 8;
#pragma unroll
          for (int d0 = 0; d0 < ND; ++d0) qr[d0] = *(const bf16x8*)(Qw + d0 * 16); }
        float m_reg = 0.f, l_reg = 0.f; f32x16 o[4], nm;
        float z0 = 0.f; asm volatile("" : "+v"(z0));
#pragma unroll
        for (int d = 0; d < 4; ++d)
#pragma unroll
            for (int r = 0; r < 16; ++r) o[d][r] = z0;
#pragma unroll
        for (int r = 0; r < 16; ++r) nm[r] = z0;
        FA_ISSUE(0); FA_ISSUE(1);
        if constexpr (DQK != 64) { if (NDMA == 5) asm volatile("s_waitcnt vmcnt(5)" ::: "memory"); else asm volatile("s_waitcnt vmcnt(3)" ::: "memory");
            __builtin_amdgcn_s_barrier(); asm volatile("" ::: "memory"); }
        auto tile = [&](const int j) __attribute__((always_inline)) {
            LAS unsigned char* Ks = lds + (j % RING) * STAGE;
            f32x16 p0 = nm, p1 = nm;
            constexpr int KD = (DQK == 64) ? 3 : 2;
            bf16x8 kb[KD][2];
            unsigned kae[4];
#pragma unroll
            for (int e = 0; e < 4; ++e) kae[e] = (unsigned)(uintptr_t)Ks + (unsigned)(krow * KROWB + (((2 * e + hi) ^ ((krow & 3) | (((krow >> 3) & 1) << 2))) << 4));
#define FA_LDK(d0_, s_) do { kb[s_][0] = lds_rd128i(kae[(d0_) & 3], ((d0_) >> 2) * 128); kb[s_][1] = lds_rd128i(kae[(d0_) & 3], 32 * KROWB + ((d0_) >> 2) * 128); } while (0)
#pragma unroll
            for (int d0 = 0; d0 < KD - 1; ++d0) FA_LDK(d0, d0);
#pragma unroll
            for (int d0 = 0; d0 < ND; ++d0) {
                if (d0 + KD - 1 < ND) FA_LDK(d0 + KD - 1, (d0 + KD - 1) % KD);
                const int ahead = (ND - 1 - d0) < (KD - 1) ? (ND - 1 - d0) : (KD - 1);
                if (ahead == 2) asm volatile("s_waitcnt lgkmcnt(4)" ::: "memory"); else if (ahead == 1) asm volatile("s_waitcnt lgkmcnt(2)" ::: "memory"); else asm volatile("s_waitcnt lgkmcnt(0)" ::: "memory");
                FA_SBAR();
                p0 = __builtin_amdgcn_mfma_f32_32x32x16_bf16(kb[d0 % KD][0], qr[d0], p0, 0, 0, 0);
                p1 = __builtin_amdgcn_mfma_f32_32x32x16_bf16(kb[d0 % KD][1], qr[d0], p1, 0, 0, 0);
                FA_SBAR(); }
#undef FA_LDK
            float alpha; partialSM(p0, p1, m_reg, nm, alpha, j == 0);
            if (__any(alpha < 1.f)) { if (hi == 0) wsc[32 + r32] = alpha; asm volatile("s_waitcnt lgkmcnt(0)" ::: "memory");
#pragma unroll
                for (int d = 0; d < 4; ++d)
#pragma unroll
                    for (int r = 0; r < 16; ++r) o[d][r] *= wsc[32 + crow(r, hi)]; }
            bf16x8 pa0, pa1, pa2, pa3; finishSM(p0, p1, alpha, l_reg, pa0, pa1, pa2, pa3); FA_SBAR();
            const unsigned vb = vb0 + (unsigned)((j % RING) * STAGE);
            pv_one<0>(o[0], vb, pa0, pa1, pa2, pa3); pv_one<1>(o[1], vb, pa0, pa1, pa2, pa3); pv_one<2>(o[2], vb, pa0, pa1, pa2, pa3); pv_one<3>(o[3], vb, pa0, pa1, pa2, pa3);
        };
        if constexpr (DQK == 64) {
            asm volatile("s_waitcnt vmcnt(0)" ::: "memory");
            __builtin_amdgcn_s_barrier(); asm volatile("" ::: "memory");
            for (int j = 0; j < NT; j += 2) {
                if (j + 2 < NT) { FA_ISSUE(j + 2); FA_ISSUE(j + 3); }
                tile(j); tile(j + 1);
                asm volatile("s_waitcnt vmcnt(0)" ::: "memory");
                asm volatile("s_waitcnt lgkmcnt(0)" ::: "memory");
                __builtin_amdgcn_s_barrier(); asm volatile("" ::: "memory");
            }
        } else
        for (int j = 0; j < NT; ++j) {
            if (j + 2 < NT) FA_ISSUE(j + 2);
            tile(j);
            if (j + 2 < NT) { if (NDMA == 5) asm volatile("s_waitcnt vmcnt(5)" ::: "memory"); else asm volatile("s_waitcnt vmcnt(3)" ::: "memory"); }
            else asm volatile("s_waitcnt vmcnt(0)" ::: "memory");
            asm volatile("s_waitcnt lgkmcnt(0)" ::: "memory");
            __builtin_amdgcn_s_barrier(); asm volatile("" ::: "memory");
        }
#undef FA_ISSUE
        if (hi == 0) wsc[r32] = l_reg; asm volatile("s_waitcnt lgkmcnt(0)" ::: "memory");
        bf16_t* Ow = a.O + (size_t)(q0 + wid * 32) * a.opitch + h * 128 + r32;
#pragma unroll
        for (int r = 0; r < 16; ++r) { const int orow = crow(r, hi); const float rl = __builtin_amdgcn_rcpf(wsc[orow]);
#pragma unroll
            for (int d0 = 0; d0 < 4; ++d0) Ow[(size_t)orow * a.opitch + d0 * 32] = (bf16_t)f2bf(o[d0][r] * rl); }
        asm volatile("s_waitcnt lgkmcnt(0)" ::: "memory");
    }
}
}


namespace ml {
typedef short s16x4 __attribute__((ext_vector_type(4)));
constexpr int QP = 528, VP = 80, CP = 528, PP = 144;
constexpr size_t WS_SCT = WS_CT, WS_WC = WS_CT + 4 * MiB, WS_DENI = WS_CT + 5 * MiB, WS_KW = WS_CT + 6 * MiB;
__device__ __forceinline__ s16x4 trr(unsigned addr) { s16x4 r; asm volatile("ds_read_b64_tr_b16 %0, %1" : "=&v"(r) : "v"(addr) : "memory"); return r; }
__device__ __forceinline__ unsigned cvtpk(float lo, float hi) { unsigned r; asm volatile("s_nop 0\n\tv_cvt_pk_bf16_f32 %0, %1, %2\n\ts_nop 1" : "=v"(r) : "v"(lo), "v"(hi)); return r; }
__device__ __forceinline__ int crow(int r, int hi) { return (r & 3) + 8 * (r >> 2) + 4 * hi; }
#define ML_BAR() do { asm volatile("s_waitcnt lgkmcnt(0)" ::: "memory"); __builtin_amdgcn_s_barrier(); asm volatile("" ::: "memory"); } while (0)
#define ML_TOK(c, i) (base + (dir ? (L - 1 - ((c) * 64 + (i))) : ((c) * 64 + (i))))
__device__ __forceinline__ float logsig(float g) { return fminf(g, 0.f) - __logf(1.0f + __expf(-fabsf(g))); }

__device__ __forceinline__ void scalars_wg(const P& p, const int l, const int chain, const int wave, const int lane, LAS float* sx) {
    const bool lat = chain >= 128; const int cc = lat ? chain - 128 : chain, b = cc >> 3, h = (cc >> 1) & 3, dir = cc & 1;
    const int L = lat ? LL : CL, base = lat ? NCTX + b * LL : b * CL, NC = L >> 6;
    const float* kva = (const float*)(p.ws + WS_KVA) + 576 + dir * 8 + h;
    const float bi = p.in[18][l * 16 + dir * 8 + h], bf = p.in[18][l * 16 + dir * 8 + 4 + h];
    float li_[8], lf_[8];
#pragma unroll
    for (int j = 0; j < 8; ++j) { const int c = wave + 8 * j; li_[j] = 0.f; lf_[j] = 0.f; if (c < NC) { const float* r_ = kva + (size_t)ML_TOK(c, lane) * KVAW; li_[j] = r_[0] + bi; lf_[j] = r_[4] + bf; } }
    float bb_[8], gg_[8], pm_[8];
#pragma unroll
    for (int j = 0; j < 8; ++j) { const int c = wave + 8 * j;
        float bc = logsig(lf_[j]);
#pragma unroll
        for (int o = 1; o < 64; o <<= 1) { const float t_ = __shfl_up(bc, o); if (lane >= o) bc += t_; }
        const float g = li_[j] - bc; float pm = g;
#pragma unroll
        for (int o = 1; o < 64; o <<= 1) { const float t_ = __shfl_up(pm, o); if (lane >= o) pm = fmaxf(pm, t_); }
        bb_[j] = bc; gg_[j] = g; pm_[j] = pm;
        if (lane == 63) { sx[c] = (c < NC) ? bc : 0.f; sx[64 + c] = (c < NC) ? bc + pm : -1e30f; } }
    __syncthreads();
    float al = sx[lane], be = sx[64 + lane];
#pragma unroll
    for (int o = 1; o < 64; o <<= 1) { const float ea = __shfl_up(al, o), eb = __shfl_up(be, o); if (lane >= o) { be = fmaxf(eb + al, be); al = ea + al; } }
    float m0 = 0.f; if (lat) m0 = p.in[8][(size_t)((b * 2 + l) * 2 + dir) * 4 + h];
    const float pa = __shfl_up(al, 1), pb = __shfl_up(be, 1);
    const float mst_all = lane == 0 ? m0 : fmaxf(m0 + pa, pb);
    if (!lat && wave == 0 && lane == NC - 1) p.out[O_MM + ((b * 2 + l) * 2 + dir) * 4 + h] = fmaxf(m0 + al, be);
    f32x4* sct = (f32x4*)(p.ws + WS_SCT);
#pragma unroll
    for (int j = 0; j < 8; ++j) { const int c = wave + 8 * j;
        const float m_st = __shfl(mst_all, c & 63);
        if (c < NC) { const float mxl = fmaxf(m_st, __shfl(pm_[j], 63)), mx = fmaxf(m_st, pm_[j]);
            sct[((size_t)ML_TOK(c, lane) * 2 + dir) * 4 + h] = (f32x4){__expf(pm_[j] - mx), __expf(m_st - mx), __expf(-(bb_[j] + mx)), __expf(gg_[j] - mxl)};
            if (lane == 0) ((float*)(p.ws + WS_WC))[chain * 64 + c] = __expf(m_st - mxl); } }
    __syncthreads();
}

constexpr int B_Q = 0, B_K = 33792, B_V = 67584, B_P = 101376, B_S = 110592, B_END = 112640;
__device__ __forceinline__ void intra_phase(LAS unsigned char* lds, const P& p, const int l, const int tid) {
    const int wid = __builtin_amdgcn_readfirstlane(tid >> 6), lane = tid & 63, r32 = lane & 31, hi = lane >> 5;
    const bf16_t* MQ_ = (const bf16_t*)(p.ws + WS_MLQ); const bf16_t* MK_ = (const bf16_t*)(p.ws + WS_MLK); const bf16_t* MV_ = (const bf16_t*)(p.ws + WS_MLV);
    LAS float* sg = (LAS float*)(lds + B_S); LAS float* spm = sg + 64; LAS float* sws = sg + 128; LAS float* sd0 = sg + 192; LAS float* sd1 = sg + 256;
    const unsigned ldsb = (unsigned)(uintptr_t)lds;
    const int tq = (lane & 15) >> 2, tp = lane & 3, tc0 = 16 * ((lane >> 4) & 1) + 4 * tp;
    u32x4 q4[4], k4[4], v4[4]; float gli = 0.f, glf = 0.f, gws = 0.f;
#define B_DECODE(uu) const bool lat = (uu) < 2048; const int chain = lat ? 128 + ((uu) >> 6) : ((uu) - 2048) >> 2, c = lat ? ((uu) & 63) : (((uu) - 2048) & 3); \
        const int cc = lat ? chain - 128 : chain, b = cc >> 3, h = (cc >> 1) & 3, dir = cc & 1; const int L = lat ? LL : CL, base = lat ? NCTX + b * LL : b * CL;
#define B_LOAD(uu) do { B_DECODE(uu) (void)chain; \
        _Pragma("unroll") for (int i = 0; i < 4; ++i) { const int ch = tid + 512 * i, row = ch >> 5, c16 = ch & 31; const size_t g_ = (size_t)ML_TOK(c, row) * 1024 + h * 256 + c16 * 8; \
            q4[i] = *(const u32x4*)(MQ_ + g_); k4[i] = *(const u32x4*)(MK_ + g_); v4[i] = *(const u32x4*)(MV_ + g_); } \
        if (wid == 7) { const int row = ML_TOK(c, lane); const float* r_ = (const float*)(p.ws + WS_KVA) + (size_t)row * KVAW + 576 + dir * 8 + h; \
            gli = r_[0] + p.in[18][l * 16 + dir * 8 + h]; glf = r_[4] + p.in[18][l * 16 + dir * 8 + 4 + h]; gws = ((const f32x4*)(p.ws + WS_SCT))[((size_t)row * 2 + dir) * 4 + h][3]; } } while (0)
    if ((int)blockIdx.x < 2560) B_LOAD((int)blockIdx.x);
    for (int u = blockIdx.x; u < 2560; u += gridDim.x) {
        B_DECODE(u)
        bf16_t* Hout = (bf16_t*)(p.ws + (dir ? WS_HB : WS_HF));
#pragma unroll
        for (int i = 0; i < 4; ++i) { const int ch = tid + 512 * i, row = ch >> 5, c16 = ch & 31;
            *(LAS u32x4*)(lds + B_Q + row * QP + c16 * 16) = q4[i]; *(LAS u32x4*)(lds + B_K + row * QP + c16 * 16) = k4[i]; *(LAS u32x4*)(lds + B_V + row * QP + c16 * 16) = v4[i]; }
        if (wid == 7) {
            float bc = logsig(glf);
#pragma unroll
            for (int o = 1; o < 64; o <<= 1) { const float t_ = __shfl_up(bc, o); if (lane >= o) bc += t_; }
            const float g = gli - bc; float pm = g;
#pragma unroll
            for (int o = 1; o < 64; o <<= 1) { const float t_ = __shfl_up(pm, o); if (lane >= o) pm = fmaxf(pm, t_); }
            sg[lane] = g; spm[lane] = pm; sws[lane] = gws;
        }
        if (u + (int)gridDim.x < 2560) B_LOAD(u + (int)gridDim.x);
        ML_BAR();
        if (wid < 3) {
            const int tb = wid == 0 ? 0 : 1, sb = wid == 2 ? 1 : 0, t = tb * 32 + r32;
            f32x16 p0; { float z0 = 0.f; asm volatile("" : "+v"(z0));
#pragma unroll
              for (int r = 0; r < 16; ++r) p0[r] = z0; }
#pragma unroll 4
            for (int ks = 0; ks < 16; ++ks) { const int cb = (ks * 16 + hi * 8) * 2;
                const bf16x8 qf = *(const LAS bf16x8*)(lds + B_Q + t * QP + cb), kf = *(const LAS bf16x8*)(lds + B_K + (sb * 32 + r32) * QP + cb);
                p0 = __builtin_amdgcn_mfma_f32_32x32x16_bf16(kf, qf, p0, 0, 0, 0); }
            const float mpm = -spm[t]; float dsum = 0.f;
#pragma unroll
            for (int r = 0; r < 16; ++r) { const int s = sb * 32 + crow(r, hi); const float w = (s <= t) ? __expf(sg[s] + mpm) : 0.f; p0[r] *= w; dsum += p0[r]; }
            { auto rr = __builtin_amdgcn_permlane32_swap(__float_as_uint(dsum), __float_as_uint(dsum), false, false); dsum = __uint_as_float(rr[0]) + __uint_as_float(rr[1]); }
            if (hi == 0) { if (sb == 0) sd0[t] = dsum; else sd1[r32] = dsum; }
#pragma unroll
            for (int i = 0; i < 4; ++i) { u32x2 w; w.x = cvtpk(p0[4 * i], p0[4 * i + 1]); w.y = cvtpk(p0[4 * i + 2], p0[4 * i + 3]);
                *(LAS u32x2*)(lds + B_P + t * PP + (sb * 32 + 8 * i + 4 * hi) * 2) = w; }
        } else if (wid >= 4) {
            const int k = tid - 256; float acc = 0.f;
#pragma unroll 8
            for (int s = 0; s < 64; ++s) acc += sws[s] * bf2f(*(const LAS unsigned short*)(lds + B_K + s * QP + k * 2));
            ((float*)(p.ws + WS_KW))[((size_t)chain * 64 + c) * 256 + k] = acc;
        }
        ML_BAR();
        {
            f32x16 h0, h1; { float z0 = 0.f; asm volatile("" : "+v"(z0));
#pragma unroll
              for (int r = 0; r < 16; ++r) { h0[r] = z0; h1[r] = z0; } }
#pragma unroll
            for (int ks = 0; ks < 4; ++ks) {
                const unsigned va = ldsb + B_V + (16 * ks + 8 * hi + tq) * QP + (wid * 32 + tc0) * 2;
                const s16x4 lo = trr(va), hh = trr(va + 4 * QP);
                const bf16x8 a1 = *(const LAS bf16x8*)(lds + B_P + (32 + r32) * PP + (ks * 16 + hi * 8) * 2);
                bf16x8 a0 = a1; if (ks < 2) a0 = *(const LAS bf16x8*)(lds + B_P + r32 * PP + (ks * 16 + hi * 8) * 2);
                asm volatile("s_waitcnt lgkmcnt(0)" ::: "memory"); __builtin_amdgcn_sched_barrier(0);
                const bf16x8 vf = (bf16x8){lo[0], lo[1], lo[2], lo[3], hh[0], hh[1], hh[2], hh[3]};
                if (ks < 2) h0 = __builtin_amdgcn_mfma_f32_32x32x16_bf16(a0, vf, h0, 0, 0, 0);
                h1 = __builtin_amdgcn_mfma_f32_32x32x16_bf16(a1, vf, h1, 0, 0, 0); }
#pragma unroll
            for (int r = 0; r < 16; ++r) { const int t0 = crow(r, hi);
                Hout[(size_t)ML_TOK(c, t0) * 1024 + h * 256 + wid * 32 + r32] = (bf16_t)f2bf(h0[r]); Hout[(size_t)ML_TOK(c, 32 + t0) * 1024 + h * 256 + wid * 32 + r32] = (bf16_t)f2bf(h1[r]); }
            if (tid < 64) ((float*)(p.ws + WS_DENI))[((size_t)ML_TOK(c, tid) * 2 + dir) * 4 + h] = sd0[tid] + (tid >= 32 ? sd1[tid - 32] : 0.f);
        }
        ML_BAR();
    }
}

constexpr int L_Q = 0, L_K = 33792, L_V = 67584, L_CT = 72704, L_SC = 89600, L_NQ = 95744, L_N = 96256, L_PART = 98304, L_END = 114688;
__device__ __forceinline__ void seq_phase(LAS unsigned char* lds, const P& p, const int l, const int tid) {
    const int wid = __builtin_amdgcn_readfirstlane(tid >> 6), lane = tid & 63, r32 = lane & 31, hi = lane >> 5;
    const bf16_t* MQ_ = (const bf16_t*)(p.ws + WS_MLQ); const bf16_t* MK_ = (const bf16_t*)(p.ws + WS_MLK); const bf16_t* MV_ = (const bf16_t*)(p.ws + WS_MLV);
    const unsigned ldsb = (unsigned)(uintptr_t)lds;
    const int tq = (lane & 15) >> 2, tp = lane & 3, tc0 = 16 * ((lane >> 4) & 1) + 4 * tp;
    for (int u = xcd_slot(); u < 1280; u += gridDim.x) {
        const bool lat = u < 256; const int uu = lat ? u : u - 256, cc = uu >> 3, sl = uu & 7, chain = lat ? 128 + cc : cc;
        const int b = cc >> 3, h = (cc >> 1) & 3, dir = cc & 1;
        const int L = lat ? LL : CL, base = lat ? NCTX + b * LL : b * CL, NC = L >> 6;
        const int colq = h * 256, colv = h * 256 + sl * 32;
        bf16_t* Hout = (bf16_t*)(p.ws + (dir ? WS_HB : WS_HF));
        f32x16 ct, ia;
        { float z0 = 0.f; asm volatile("" : "+v"(z0));
#pragma unroll
          for (int r = 0; r < 16; ++r) { ct[r] = z0; ia[r] = z0; } }
        LAS float* nb0 = (LAS float*)(lds + L_N); LAS float* nb1 = nb0 + 256;
        if (lat) {
            const size_t so = (size_t)((b * 2 + l) * 2 + dir) * 4 + h;
            const float* c0 = p.in[6] + so * 65536 + (size_t)(sl * 32 + r32) * 256 + wid * 32 + 4 * hi;
#pragma unroll
            for (int i = 0; i < 4; ++i) { const f32x4 v4 = *(const f32x4*)(c0 + 8 * i); ct[4 * i] = v4[0]; ct[4 * i + 1] = v4[1]; ct[4 * i + 2] = v4[2]; ct[4 * i + 3] = v4[3]; }
            if (tid < 256) nb0[tid] = p.in[7][so * 256 + tid];
        } else if (tid < 256) nb0[tid] = 0.f;
        u32x4 pq[4], pk[4], pv; pv = (u32x4){0u, 0u, 0u, 0u}; f32x4 psc = {0.f, 0.f, 0.f, 0.f}; float pdi = 0.f, pwc = 0.f, pkw = 0.f; unsigned hpre[16];
#pragma unroll
        for (int r = 0; r < 16; ++r) hpre[r] = 0u;
#define ML_HPRE(cc_) do { _Pragma("unroll") for (int rr = 0; rr < 8; ++rr) hpre[rr] = Hout[(size_t)ML_TOK(cc_, (wid & 1) * 32 + crow(8 * (wid >> 1) + rr, hi)) * 1024 + colv + r32]; } while (0)
#define ML_LOAD(c) do { _Pragma("unroll") for (int i_ = 0; i_ < 4; ++i_) { const int ch_ = tid + 512 * i_, row_ = ch_ >> 5, c16_ = ch_ & 31; const size_t g_ = (size_t)ML_TOK(c, row_) * 1024 + colq + c16_ * 8; \
            pq[i_] = *(const u32x4*)(MQ_ + g_); pk[i_] = *(const u32x4*)(MK_ + g_); } \
        if (tid < 256) { const int row_ = tid >> 2, c16_ = tid & 3; pv = *(const u32x4*)(MV_ + (size_t)ML_TOK(c, row_) * 1024 + colv + c16_ * 8); } \
        else pkw = ((const float*)(p.ws + WS_KW))[((size_t)chain * 64 + (c)) * 256 + tid - 256]; \
        if (wid == 0) { const size_t ix_ = ((size_t)ML_TOK(c, lane) * 2 + dir) * 4 + h; psc = ((const f32x4*)(p.ws + WS_SCT))[ix_]; pdi = ((const float*)(p.ws + WS_DENI))[ix_]; pwc = ((const float*)(p.ws + WS_WC))[chain * 64 + (c)]; } } while (0)
#define ML_WRITE(cc_) do { _Pragma("unroll") for (int i_ = 0; i_ < 4; ++i_) { const int ch_ = tid + 512 * i_, row_ = ch_ >> 5, c16_ = ch_ & 31; \
            *(LAS u32x4*)(lds + L_Q + row_ * QP + c16_ * 16) = pq[i_]; *(LAS u32x4*)(lds + L_K + row_ * QP + c16_ * 16) = pk[i_]; } \
        if (tid < 256) { const int row_ = tid >> 2, c16_ = tid & 3; *(LAS u32x4*)(lds + L_V + row_ * VP + c16_ * 16) = pv; } \
        if (wid == 0) { LAS float* S_ = (LAS float*)(lds + L_SC + ((cc_) % 3) * 2048); S_[lane] = psc[0]; S_[64 + lane] = psc[1]; S_[128 + lane] = psc[2]; S_[192 + lane] = psc[3]; S_[256 + lane] = pdi; if (lane == 0) S_[320] = pwc; } } while (0)
#define ML_CTB() do { _Pragma("unroll") for (int i_ = 0; i_ < 4; ++i_) { u32x2 w_; w_.x = cvtpk(ct[4 * i_], ct[4 * i_ + 1]); w_.y = cvtpk(ct[4 * i_ + 2], ct[4 * i_ + 3]); \
            *(LAS u32x2*)(lds + L_CT + r32 * CP + (wid * 32 + 8 * i_ + 4 * hi) * 2) = w_; } } while (0)
#define ML_COMB(cc_) do { const int tb_ = wid & 1, kh_ = wid >> 1; const LAS float* S_ = (const LAS float*)(lds + L_SC + ((cc_) % 3) * 2048); const LAS float* NQ_ = (const LAS float*)(lds + L_NQ + ((cc_) & 1) * 256); \
            const LAS float* PT_ = (const LAS float*)(lds + L_PART + (((cc_) & 1) * 4 + (wid ^ 2)) * 2048); \
            _Pragma("unroll") for (int rr = 0; rr < 8; ++rr) { const int r = 8 * kh_ + rr, tt = tb_ * 32 + crow(r, hi); bf16_t* hp_ = Hout + (size_t)ML_TOK(cc_, tt) * 1024 + colv + r32; \
                const float rr_ = S_[tt], wi = S_[64 + tt], den = rr_ * S_[256 + tt] + wi * NQ_[tt], it_ = (kh_ ? ia[8 + rr] : ia[rr]) + PT_[rr * 64 + lane]; \
                *hp_ = (bf16_t)f2bf((rr_ * bf2f(hpre[rr]) + wi * it_) * __builtin_amdgcn_rcpf(fmaxf(fabsf(den), S_[128 + tt]))); } } while (0)
        float kwc = 0.f;
        ML_LOAD(0); ML_WRITE(0); ML_CTB(); kwc = pkw;
        int nsel = 0;
        for (int c = 0; c < NC; ++c) {
            ML_BAR();
            LAS float* ncur = nsel ? nb1 : nb0; LAS float* nnxt = nsel ? nb0 : nb1;
            const LAS float* SC = (const LAS float*)(lds + L_SC + (c % 3) * 2048);
            if (c + 1 < NC) ML_LOAD(c + 1);
            const float w_c = SC[320];
            if (wid < 4) {
                if (c > 0) ML_COMB(c - 1);
                ML_HPRE(c);
                const int tb = wid & 1, kh = wid >> 1;
                { float z0 = 0.f; asm volatile("" : "+v"(z0));
#pragma unroll
                  for (int r = 0; r < 16; ++r) ia[r] = z0; }
#pragma unroll
                for (int k1 = 0; k1 < 8; ++k1) { const int cb0 = ((kh * 8 + k1) * 16 + hi * 8) * 2;
                    const bf16x8 qf0 = *(const LAS bf16x8*)(lds + L_Q + (tb * 32 + r32) * QP + cb0), cf0 = *(const LAS bf16x8*)(lds + L_CT + r32 * CP + cb0);
                    ia = __builtin_amdgcn_mfma_f32_32x32x16_bf16(qf0, cf0, ia, 0, 0, 0); }
                { LAS float* PW = (LAS float*)(lds + L_PART + ((c & 1) * 4 + wid) * 2048);
#pragma unroll
                  for (int rr = 0; rr < 8; ++rr) PW[rr * 64 + lane] = kh ? ia[rr] : ia[8 + rr]; }
            } else if (wid >= 4) {
                const int j = tid - 256, t = j >> 2, part = j & 3;
                float acc = 0.f;
#pragma unroll
                for (int i = 0; i < 8; ++i) { const u32x4 qv = *(const LAS u32x4*)(lds + L_Q + t * QP + (part * 64 + i * 8) * 2);
                    const f32x4 n0 = *(const LAS f32x4*)(ncur + part * 64 + i * 8), n1 = *(const LAS f32x4*)(ncur + part * 64 + i * 8 + 4);
                    acc += bf2f(qv[0]) * n0[0] + bf2f(qv[0] >> 16) * n0[1] + bf2f(qv[1]) * n0[2] + bf2f(qv[1] >> 16) * n0[3] + bf2f(qv[2]) * n1[0] + bf2f(qv[2] >> 16) * n1[1] + bf2f(qv[3]) * n1[2] + bf2f(qv[3] >> 16) * n1[3]; }
                acc += __shfl_xor(acc, 1); acc += __shfl_xor(acc, 2);
                if (part == 0) ((LAS float*)(lds + L_NQ + (c & 1) * 256))[t] = acc;
                nnxt[j] = w_c * ncur[j] + kwc;
            }
            { f32x16 cc = ct;
#pragma unroll
              for (int r = 0; r < 16; ++r) cc[r] *= w_c;
#pragma unroll
              for (int ks = 0; ks < 4; ++ks) {
                const unsigned ka = ldsb + L_K + (16 * ks + 8 * hi + tq) * QP + (wid * 32 + tc0) * 2, va = ldsb + L_V + (16 * ks + 8 * hi + tq) * VP + tc0 * 2;
                const s16x4 kl = trr(ka), kh = trr(ka + 4 * QP), vl = trr(va), vh = trr(va + 4 * VP);
                const f32x4 wa = *(const LAS f32x4*)(SC + 192 + 16 * ks + 8 * hi), wb = *(const LAS f32x4*)(SC + 192 + 16 * ks + 8 * hi + 4);
                asm volatile("s_waitcnt lgkmcnt(0)" ::: "memory"); __builtin_amdgcn_sched_barrier(0);
                u32x4 vw; vw.x = cvtpk(bf2f((unsigned short)vl[0]) * wa[0], bf2f((unsigned short)vl[1]) * wa[1]); vw.y = cvtpk(bf2f((unsigned short)vl[2]) * wa[2], bf2f((unsigned short)vl[3]) * wa[3]);
                vw.z = cvtpk(bf2f((unsigned short)vh[0]) * wb[0], bf2f((unsigned short)vh[1]) * wb[1]); vw.w = cvtpk(bf2f((unsigned short)vh[2]) * wb[2], bf2f((unsigned short)vh[3]) * wb[3]);
                const bf16x8 kf = (bf16x8){kl[0], kl[1], kl[2], kl[3], kh[0], kh[1], kh[2], kh[3]};
                cc = __builtin_amdgcn_mfma_f32_32x32x16_bf16(kf, *reinterpret_cast<bf16x8*>(&vw), cc, 0, 0, 0); }
              ct = cc; }
            ML_BAR();
            if (c + 1 < NC) { ML_WRITE(c + 1); kwc = pkw; }
            ML_CTB();
            nsel ^= 1;
        }
        if (wid < 4) ML_COMB(NC - 1);
        if (!lat) {
            const size_t so = (size_t)((b * 2 + l) * 2 + dir) * 4 + h;
            float* oc = p.out + O_MC + so * 65536 + (size_t)(sl * 32 + r32) * 256 + wid * 32 + 4 * hi;
#pragma unroll
            for (int i = 0; i < 4; ++i) *(f32x4*)(oc + 8 * i) = (f32x4){ct[4 * i], ct[4 * i + 1], ct[4 * i + 2], ct[4 * i + 3]};
            if (sl == 0) { LAS float* nfin = nsel ? nb1 : nb0; if (tid < 256) p.out[O_MN + so * 256 + tid] = nfin[tid]; }
        }
        ML_BAR();
#undef ML_LOAD
#undef ML_WRITE
#undef ML_CTB
#undef ML_COMB
#undef ML_HPRE
    }
}
#undef ML_BAR
#undef ML_TOK
#undef B_LOAD
#undef B_DECODE
}


namespace s5 {
typedef short s16x4 __attribute__((ext_vector_type(4)));
__device__ __forceinline__ s16x4 trr(unsigned addr) { s16x4 r; asm volatile("ds_read_b64_tr_b16 %0, %1" : "=&v"(r) : "v"(addr) : "memory"); return r; }
__device__ __forceinline__ unsigned cvtpk(float lo, float hi) { unsigned r; asm volatile("s_nop 0\n\tv_cvt_pk_bf16_f32 %0, %1, %2\n\ts_nop 1" : "=v"(r) : "v"(lo), "v"(hi)); return r; }
template <bool FULL>
__device__ __forceinline__ void scan_seg(const P& p, const int l, LAS unsigned char* T, const int g, const int dir, const bool lat, const int b0, const int lane, const int blk0, const int nblk,
                                         const float (&ar)[2], const float (&ai)[2], const bf16x8 (&bb)[4], float (&sr)[2], float (&si)[2]) {
    const int r32 = lane & 31, hh = lane >> 5;
    const int L = lat ? LL : CL;
    const int baseA = lat ? NCTX + b0 * LL : b0 * CL, baseB = baseA + L;
    const size_t pg = (size_t)(l * 2 + dir) * 64 + g;
    bf16x8 cm[8];
    if (FULL) {
#pragma unroll
        for (int ks = 0; ks < 8; ++ks) { u32x4 w = {0u, 0u, 0u, 0u};
            if (r32 < 16) { const int k0 = 16 * ks + 8 * hh; const float* src = (k0 < 64 ? p.in[27] : p.in[28]) + (pg * 16 + r32) * 64 + (k0 & 63); const float sg = k0 < 64 ? 1.f : -1.f;
#pragma unroll
                for (int j = 0; j < 4; ++j) w[j] = cvtpk(sg * src[2 * j], sg * src[2 * j + 1]); }
            cm[ks] = *reinterpret_cast<bf16x8*>(&w); } }
    const int urow_tok = 4 * (r32 >> 3) + (r32 & 3), urow_base = ((r32 >> 2) & 1) ? baseB : baseA;
    const bf16_t* U = (const bf16_t*)(p.ws + WS_S5U) + g * 16 + 8 * hh;
    bf16_t* Yo2 = (bf16_t*)(p.ws + (dir ? WS_YS5B : WS_YS5F)) + g * 16;
#define S5_POS(n, j) (dir ? (L - 1 - ((n) * 16 + (j))) : ((n) * 16 + (j)))
    bf16x8 ucur[4], unxt[4];
#pragma unroll
    for (int i = 0; i < 4; ++i) { ucur[i] = *(const bf16x8*)(U + (size_t)(urow_base + S5_POS(blk0 + i, urow_tok)) * 1024); unxt[i] = ucur[i]; }
    const unsigned tb = (unsigned)(uintptr_t)T;
    const int tq = (lane & 15) >> 2, tp = lane & 3, tc0 = 16 * ((lane >> 4) & 1) + 4 * tp;
    for (int n4 = blk0; n4 < blk0 + nblk; n4 += 4) {
        if (n4 + 4 < blk0 + nblk) {
#pragma unroll
            for (int i = 0; i < 4; ++i) unxt[i] = *(const bf16x8*)(U + (size_t)(urow_base + S5_POS(n4 + 4 + i, urow_tok)) * 1024); }
#pragma unroll
      for (int i4 = 0; i4 < 4; ++i4) { const int n = n4 + i4; const bf16x8 ucur1 = ucur[i4];
        f32x16 acc[4]; { float z0 = 0.f; asm volatile("" : "+v"(z0));
#pragma unroll
          for (int q = 0; q < 4; ++q)
#pragma unroll
              for (int r = 0; r < 16; ++r) acc[q][r] = z0; }
#pragma unroll
        for (int q = 0; q < 4; ++q) acc[q] = __builtin_amdgcn_mfma_f32_32x32x16_bf16(ucur1, bb[q], acc[q], 0, 0, 0);
#pragma unroll
        for (int pb = 0; pb < 2; ++pb) { float xr = sr[pb], xi = si[pb]; const float a_r = ar[pb], a_i = ai[pb];
#pragma unroll
            for (int r = 0; r < 16; ++r) { const float nr_ = a_r * xr - a_i * xi + acc[pb][r], ni_ = a_r * xi + a_i * xr + acc[2 + pb][r]; xr = nr_; xi = ni_; acc[pb][r] = nr_; acc[2 + pb][r] = ni_; }
            sr[pb] = xr; si[pb] = xi; }
        if (FULL) {
#pragma unroll
        for (int q = 0; q < 4; ++q)
#pragma unroll
            for (int a4 = 0; a4 < 4; ++a4) { u32x2 w; w.x = cvtpk(acc[q][4 * a4], acc[q][4 * a4 + 1]); w.y = cvtpk(acc[q][4 * a4 + 2], acc[q][4 * a4 + 3]);
                *(LAS u32x2*)(T + (q * 32 + r32) * 64 + 16 * a4 + 8 * hh) = w; }
        f32x16 y, y2; { float z0 = 0.f; asm volatile("" : "+v"(z0));
#pragma unroll
          for (int r = 0; r < 16; ++r) { y[r] = z0; y2[r] = z0; } }
        { s16x4 lo_[8], hi_[8];
#pragma unroll
          for (int ks = 0; ks < 8; ++ks) { const unsigned ta = tb + (16 * ks + 8 * hh + tq) * 64 + tc0 * 2; lo_[ks] = trr(ta); hi_[ks] = trr(ta + 4 * 64); }
          asm volatile("s_waitcnt lgkmcnt(0)" ::: "memory"); __builtin_amdgcn_sched_barrier(0);
#pragma unroll
          for (int ks = 0; ks < 8; ks += 2) {
            const bf16x8 af0 = (bf16x8){lo_[ks][0], lo_[ks][1], lo_[ks][2], lo_[ks][3], hi_[ks][0], hi_[ks][1], hi_[ks][2], hi_[ks][3]};
            const bf16x8 af1 = (bf16x8){lo_[ks + 1][0], lo_[ks + 1][1], lo_[ks + 1][2], lo_[ks + 1][3], hi_[ks + 1][0], hi_[ks + 1][1], hi_[ks + 1][2], hi_[ks + 1][3]};
            y = __builtin_amdgcn_mfma_f32_32x32x16_bf16(cm[ks], af0, y, 0, 0, 0);
            y2 = __builtin_amdgcn_mfma_f32_32x32x16_bf16(cm[ks + 1], af1, y2, 0, 0, 0); }
#pragma unroll
          for (int r = 0; r < 16; ++r) y[r] += y2[r]; }
        {
          bf16_t* yo = Yo2 + (size_t)(urow_base + S5_POS(n, urow_tok)) * 1024 + 4 * hh;
          u32x2 w0, w1; w0.x = cvtpk(y[0], y[1]); w0.y = cvtpk(y[2], y[3]); w1.x = cvtpk(y[4], y[5]); w1.y = cvtpk(y[6], y[7]);
          *(u32x2*)yo = w0; *(u32x2*)(yo + 8) = w1; }
        }
      }
#pragma unroll
        for (int i = 0; i < 4; ++i) ucur[i] = unxt[i];
    }
#undef S5_POS
}
__device__ __forceinline__ void params(const P& p, const int l, const int g, const int dir, const int lane, float (&ar)[2], float (&ai)[2], bf16x8 (&bb)[4]) {
    const int r32 = lane & 31, hh = lane >> 5; const size_t pg = (size_t)(l * 2 + dir) * 64 + g;
    const float dt = __expf(p.in[24][pg]);
#pragma unroll
    for (int pb = 0; pb < 2; ++pb) { const int pp = pb * 32 + r32;
        const float lr = fminf(p.in[22][pg * 64 + pp], -1e-4f), li = p.in[23][pg * 64 + pp];
        const float mag = __expf(dt * lr); float sn, cs; sincos_small(dt * li, sn, cs);
        const float a_r = mag * cs, a_i = mag * sn, den = lr * lr + li * li, nr = a_r - 1.0f, ni = a_i, qr = (nr * lr + ni * li) / den, qi = (ni * lr - nr * li) / den;
        ar[pb] = a_r; ai[pb] = a_i;
        const float* br = p.in[25] + (pg * 64 + pp) * 16 + 8 * hh; const float* bi = p.in[26] + (pg * 64 + pp) * 16 + 8 * hh;
        u32x4 wr, wi;
#pragma unroll
        for (int j = 0; j < 4; ++j) { const float r0 = qr * br[2 * j] - qi * bi[2 * j], r1 = qr * br[2 * j + 1] - qi * bi[2 * j + 1], i0 = qr * bi[2 * j] + qi * br[2 * j], i1 = qr * bi[2 * j + 1] + qi * br[2 * j + 1];
            wr[j] = cvtpk(r0, r1); wi[j] = cvtpk(i0, i1); }
        bb[pb] = *reinterpret_cast<bf16x8*>(&wr); bb[2 + pb] = *reinterpret_cast<bf16x8*>(&wi); }
}
__device__ __forceinline__ void ctx_unit(const P& p, const int l, LAS unsigned char* T, const int u, const int lane) {
    const int dir = u & 1, g = (u >> 1) & 63, b0 = 2 * (u >> 7), r32 = lane & 31, hh = lane >> 5;
    float ar[2], ai[2]; bf16x8 bb[4]; params(p, l, g, dir, lane, ar, ai, bb);
    float sr[2] = {0.f, 0.f}, si[2] = {0.f, 0.f};
    scan_seg<true>(p, l, T, g, dir, false, b0, lane, 0, CL / 16, ar, ai, bb, sr, si);
#pragma unroll
    for (int pb = 0; pb < 2; ++pb) { const size_t so = ((size_t)(((b0 + hh) * 2 + l) * 2 + dir) * 64 + g) * 64 + pb * 32 + r32; p.out[O_SR + so] = sr[pb]; p.out[O_SI + so] = si[pb]; }
}
__device__ __forceinline__ void lat_unit(const P& p, const int l, LAS unsigned char* lds, const int u, const int wave, const int lane) {
    const int dir = u & 1, g = (u >> 1) & 63, b0 = 2 * (u >> 7), r32 = lane & 31, hh = lane >> 5;
    LAS unsigned char* T = lds + wave * 8192; LAS float* X = (LAS float*)(lds + 65536);
    float ar[2], ai[2]; bf16x8 bb[4]; params(p, l, g, dir, lane, ar, ai, bb);
    float sr[2] = {0.f, 0.f}, si[2] = {0.f, 0.f};
    if (wave == 0) {
#pragma unroll
        for (int pb = 0; pb < 2; ++pb) { const size_t so = ((size_t)(((b0 + hh) * 2 + l) * 2 + dir) * 64 + g) * 64 + pb * 32 + r32; sr[pb] = p.in[9][so]; si[pb] = p.in[10][so]; } }
    const float s0r[2] = {sr[0], sr[1]}, s0i[2] = {si[0], si[1]};
    constexpr int SEGB = LL / 16 / 8;
    if (wave < 7) scan_seg<false>(p, l, T, g, dir, true, b0, lane, wave * SEGB, SEGB, ar, ai, bb, sr, si);
#pragma unroll
    for (int pb = 0; pb < 2; ++pb) { X[(wave * 4 + pb) * 64 + lane] = sr[pb]; X[(wave * 4 + 2 + pb) * 64 + lane] = si[pb]; }
    __syncthreads();
    float pr[2], pi[2];
#pragma unroll
    for (int pb = 0; pb < 2; ++pb) { float xr = ar[pb], xi = ai[pb];
#pragma unroll
        for (int k = 0; k < 9; ++k) { const float nr = xr * xr - xi * xi, ni = 2.f * xr * xi; xr = nr; xi = ni; }
        pr[pb] = xr; pi[pb] = xi; }
    float cr[2], ci[2];
    if (wave == 0) { cr[0] = s0r[0]; cr[1] = s0r[1]; ci[0] = s0i[0]; ci[1] = s0i[1]; }
    else {
#pragma unroll
        for (int pb = 0; pb < 2; ++pb) { float xr = X[(0 * 4 + pb) * 64 + lane], xi = X[(0 * 4 + 2 + pb) * 64 + lane];
            for (int j = 1; j < wave; ++j) { const float er = X[(j * 4 + pb) * 64 + lane], ei = X[(j * 4 + 2 + pb) * 64 + lane];
                const float nr = pr[pb] * xr - pi[pb] * xi + er, ni = pr[pb] * xi + pi[pb] * xr + ei; xr = nr; xi = ni; }
            cr[pb] = xr; ci[pb] = xi; } }
    scan_seg<true>(p, l, T, g, dir, true, b0, lane, wave * SEGB, SEGB, ar, ai, bb, cr, ci);
    __syncthreads();
}
__device__ __forceinline__ void combine_row(const P& p, const int l, const int r, const int lane, const f32x4 (&dpre)[4]) {
    const bf16_t* yf = (const bf16_t*)(p.ws + WS_YS5F) + (size_t)r * 1024; const bf16_t* yb = (const bf16_t*)(p.ws + WS_YS5B) + (size_t)r * 1024; const bf16_t* uu = (const bf16_t*)(p.ws + WS_S5U) + (size_t)r * 1024;
    bf16_t* o = (bf16_t*)(p.ws + WS_HB) + (size_t)r * 1024;
#pragma unroll
    for (int j = 0; j < 2; ++j) { const int c = j * 512 + lane * 8; float a[8], b[8], u[8];
        { const u32x4 w = *(const u32x4*)(yf + c);
#pragma unroll
          for (int i = 0; i < 4; ++i) { a[2 * i] = bf2f(w[i]); a[2 * i + 1] = bf2f(w[i] >> 16); } }
        { const u32x4 w = *(const u32x4*)(yb + c);
#pragma unroll
          for (int i = 0; i < 4; ++i) { b[2 * i] = bf2f(w[i]); b[2 * i + 1] = bf2f(w[i] >> 16); } }
        { const u32x4 w = *(const u32x4*)(uu + c);
#pragma unroll
          for (int i = 0; i < 4; ++i) { u[2 * i] = bf2f(w[i]); u[2 * i + 1] = bf2f(w[i] >> 16); } }
        const f32x4 d0 = dpre[2 * j], d1 = dpre[2 * j + 1];
        float gq[8];
#pragma unroll
        for (int i = 0; i < 8; ++i) gq[i] = gelu_tanh(a[i] + b[i] + (i < 4 ? d0[i] : d1[i - 4]) * u[i]);
        u32x4 w; w.x = pk2(gq[0], gq[1]); w.y = pk2(gq[2], gq[3]); w.z = pk2(gq[4], gq[5]); w.w = pk2(gq[6], gq[7]);
        *(u32x4*)(o + c) = w; }
}
}

__device__ __forceinline__ float rope_lane(float x, int lane, int prow, int pcol, const float* rt) {
    const int part = lane >> 5, jj = lane & 31, idx = jj & 15, pos = part ? pcol : prow;
    const float c = rt[pos * 16 + idx], s = rt[1024 + pos * 16 + idx];
    const float o = __shfl_xor(x, 16);
    return (jj >= 16) ? (x * c + o * s) : (x * c - o * s);
}
__device__ __forceinline__ u32x4 rope8(const u32x4 x, const int d0  , const int prow, const int pcol, const float* rt, const int pmask) {
    const int part = d0 >> 5, jj = d0 & 31, idx0 = jj & 15, pos = part ? pcol : prow; const bool second = jj >= 16;
    u32x4 o, y;
#pragma unroll
    for (int i = 0; i < 4; ++i) o[i] = __shfl_xor(x[i], pmask);
    const f32x4 c0 = *(const f32x4*)(rt + pos * 16 + idx0), c1 = *(const f32x4*)(rt + pos * 16 + idx0 + 4), s0 = *(const f32x4*)(rt + 1024 + pos * 16 + idx0), s1 = *(const f32x4*)(rt + 1024 + pos * 16 + idx0 + 4);
#pragma unroll
    for (int i = 0; i < 4; ++i) { const float ca = i < 2 ? c0[2 * i] : c1[2 * i - 4], cb = i < 2 ? c0[2 * i + 1] : c1[2 * i - 3], sa = i < 2 ? s0[2 * i] : s1[2 * i - 4], sb = i < 2 ? s0[2 * i + 1] : s1[2 * i - 3];
        const float xa = bf2f(x[i]), xb = bf2f(x[i] >> 16), oa = bf2f(o[i]), ob = bf2f(o[i] >> 16);
        y[i] = second ? pk2(xa * ca + oa * sa, xb * cb + ob * sb) : pk2(xa * ca - oa * sa, xb * cb - ob * sb); }
    return y;
}
__device__ __forceinline__ void ph_prep_row(const P& p, int l, int r, int lane) {
    unsigned char* ws = p.ws;
    bf16_t* ckvn = (bf16_t*)(ws + WS_CKVN) + (size_t)r * 512;
    bf16_t* kf = (bf16_t*)(ws + WS_KFULL) + (size_t)r * 1536;
    bf16_t* dfk = (bf16_t*)(ws + WS_DFK) + (size_t)r * 1024;
    bf16_t* dfv = (bf16_t*)(ws + WS_DFV) + (size_t)r * 1024;
    if (r >= MTOK) {
        const int i = r - MTOK, b = i >> 8, t = i & 255; const size_t cr = (size_t)(b * 2 + l) * PAST + t;
        { const float* cc = p.in[2] + cr * 512 + lane * 8; const f32x4 a = *(const f32x4*)cc, c = *(const f32x4*)(cc + 4);
          u32x4 w; w.x = pk2(a[0], a[1]); w.y = pk2(a[2], a[3]); w.z = pk2(c[0], c[1]); w.w = pk2(c[2], c[3]); *(u32x4*)(ckvn + lane * 8) = w; }
        const float kr = p.in[3][cr * 64 + lane];
#pragma unroll
        for (int h = 0; h < 8; ++h) kf[h * 192 + 128 + lane] = (bf16_t)f2bf(kr);
        const float* ck = p.in[4] + cr * 1024 + lane * 16; const float* cv = p.in[5] + cr * 1024 + lane * 16;
#pragma unroll
        for (int j = 0; j < 2; ++j) { const f32x4 a = *(const f32x4*)(ck + 8 * j), c = *(const f32x4*)(ck + 8 * j + 4), d = *(const f32x4*)(cv + 8 * j), e = *(const f32x4*)(cv + 8 * j + 4);
            u32x4 w; w.x = pk2(a[0], a[1]); w.y = pk2(a[2], a[3]); w.z = pk2(c[0], c[1]); w.w = pk2(c[2], c[3]); *(u32x4*)(dfk + lane * 16 + 8 * j) = w;
            u32x4 v; v.x = pk2(d[0], d[1]); v.y = pk2(d[2], d[3]); v.z = pk2(e[0], e[1]); v.w = pk2(e[2], e[3]); *(u32x4*)(dfv + lane * 16 + 8 * j) = v; }
        return;
    }
    const float* kva = (const float*)(ws + WS_KVA) + (size_t)r * KVAW;
    const bool ctx = r < NCTX;
    const int cb = r >> 8, ct = r & 255;
    const int t = (r - NCTX) & 4095, prow = t >> 6, pcol = t & 63;
    const float* rt = (const float*)(ws + WS_ROPE);
    const f32x4 ka = *(const f32x4*)(kva + lane * 8), kb = *(const f32x4*)(kva + lane * 8 + 4);
    float kr = kva[512 + lane];
    const float graw = lane < 16 ? kva[576 + lane] + p.in[18][l * 16 + lane] : 0.f;
    bf16_t* mq = (bf16_t*)(ws + WS_MQ) + (size_t)r * 1536 + (lane >> 3) * 192 + 128 + (lane & 7) * 8;
    bf16_t* dfq = (bf16_t*)(ws + WS_DFQ) + (size_t)r * 1024 + lane * 16;
    u32x4 xq = {0u, 0u, 0u, 0u}, xd0 = xq, xd1 = xq, xk0 = xq, xk1 = xq, xv0 = xq, xv1 = xq;
    if (!ctx) { xq = *(const u32x4*)mq; xd0 = *(const u32x4*)dfq; xd1 = *(const u32x4*)(dfq + 8); }
    xk0 = *(const u32x4*)(dfk + lane * 16); xk1 = *(const u32x4*)(dfk + lane * 16 + 8);
    if (ctx) { xv0 = *(const u32x4*)(dfv + lane * 16); xv1 = *(const u32x4*)(dfv + lane * 16 + 8); }
    { float ss = ka[0] * ka[0] + ka[1] * ka[1] + ka[2] * ka[2] + ka[3] * ka[3] + kb[0] * kb[0] + kb[1] * kb[1] + kb[2] * kb[2] + kb[3] * kb[3];
      const float rstd = rsqrtf(wave_sum(ss) * (1.0f / 512.0f) + 1e-6f);
      const float* g = p.in[20] + l * 512 + lane * 8; const f32x4 g0 = *(const f32x4*)g, g1 = *(const f32x4*)(g + 4);
      const f32x4 y0 = ka * rstd * g0, y1 = kb * rstd * g1;
      u32x4 w; w.x = pk2(y0[0], y0[1]); w.y = pk2(y0[2], y0[3]); w.z = pk2(y1[0], y1[1]); w.w = pk2(y1[2], y1[3]); *(u32x4*)(ckvn + lane * 8) = w;
      if (ctx) { float* o = p.out + O_CKV + ((size_t)(cb * 2 + l) * CL + ct) * 512 + lane * 8; *(f32x4*)o = y0; *(f32x4*)(o + 4) = y1; } }
    { if (ctx) p.out[O_KR + ((size_t)(cb * 2 + l) * CL + ct) * 64 + lane] = kr; else kr = rope_lane(kr, lane, prow, pcol, rt);
#pragma unroll
      for (int h = 0; h < 8; ++h) kf[h * 192 + 128 + lane] = (bf16_t)f2bf(kr); }
    if (lane < 16) { const float o = ((lane >> 2) & 1) ? (fminf(graw, 0.f) - __logf(1.0f + __expf(-fabsf(graw)))) : graw; ((float*)(ws + WS_GATES))[(size_t)r * 16 + lane] = o; }
    if (ctx) {
        float* ok = p.out + O_DK + ((size_t)(cb * 2 + l) * CL + ct) * 1024 + lane * 16; float* ov = p.out + O_DV + ((size_t)(cb * 2 + l) * CL + ct) * 1024 + lane * 16;
#pragma unroll
        for (int i = 0; i < 4; ++i) { *(f32x2_*)(ok + 2 * i) = (f32x2_){bf2f(xk0[i]), bf2f(xk0[i] >> 16)}; *(f32x2_*)(ok + 8 + 2 * i) = (f32x2_){bf2f(xk1[i]), bf2f(xk1[i] >> 16)};
            *(f32x2_*)(ov + 2 * i) = (f32x2_){bf2f(xv0[i]), bf2f(xv0[i] >> 16)}; *(f32x2_*)(ov + 8 + 2 * i) = (f32x2_){bf2f(xv1[i]), bf2f(xv1[i] >> 16)}; }
    } else {
        *(u32x4*)mq = rope8(xq, (lane & 7) * 8, prow, pcol, rt, 2);
        const int q = lane & 3;
        *(u32x4*)dfq = rope8(xd0, q * 16, prow, pcol, rt, 1); *(u32x4*)(dfq + 8) = rope8(xd1, q * 16 + 8, prow, pcol, rt, 1);
        *(u32x4*)(dfk + lane * 16) = rope8(xk0, q * 16, prow, pcol, rt, 1); *(u32x4*)(dfk + lane * 16 + 8) = rope8(xk1, q * 16 + 8, prow, pcol, rt, 1);
    }
}

__device__ __forceinline__ void ph_ml_combine_row(const P& p, int l, int r, int lane, const f32x4 (&gg)[4]) {
    bf16_t* hf = (bf16_t*)(p.ws + WS_HF) + (size_t)r * 1024 + lane * 4; const bf16_t* hb = (const bf16_t*)(p.ws + WS_HB) + (size_t)r * 1024 + lane * 4;
    const bf16_t* so = (const bf16_t*)(p.ws + WS_MLO) + (size_t)r * 1024 + lane * 4;
    u32x2 a[4], b[4], c[4];
#pragma unroll
    for (int h = 0; h < 4; ++h) { a[h] = *(const u32x2*)(hf + h * 256); b[h] = *(const u32x2*)(hb + h * 256); c[h] = *(const u32x2*)(so + h * 256); }
#pragma unroll
    for (int h = 0; h < 4; ++h) { float v[4];
        v[0] = bf2f(a[h].x) + bf2f(b[h].x); v[1] = bf2f(a[h].x >> 16) + bf2f(b[h].x >> 16); v[2] = bf2f(a[h].y) + bf2f(b[h].y); v[3] = bf2f(a[h].y >> 16) + bf2f(b[h].y >> 16);
        const float rstd = rsqrtf(wave_sum(v[0] * v[0] + v[1] * v[1] + v[2] * v[2] + v[3] * v[3]) * (1.0f / 256.0f) + 1e-6f);
        u32x2 w; w.x = pk2(v[0] * rstd * gg[h][0] * bf2f(c[h].x), v[1] * rstd * gg[h][1] * bf2f(c[h].x >> 16)); w.y = pk2(v[2] * rstd * gg[h][2] * bf2f(c[h].y), v[3] * rstd * gg[h][3] * bf2f(c[h].y >> 16));
        *(u32x2*)(hf + h * 256) = w; }
}

__device__ __forceinline__ void ph_df_combine_row(const P& p, int l, float lam_init, float lam, int r, int lane, const f32x4 (&gq)[4]) {
    const int h = lane >> 3, part = lane & 7;
    const bf16_t* o = (const bf16_t*)(p.ws + WS_DFO) + (size_t)r * 2048 + h * 256 + part * 16;
    const u32x4 a0 = *(const u32x4*)o, a1 = *(const u32x4*)(o + 8), b0 = *(const u32x4*)(o + 128), b1 = *(const u32x4*)(o + 136);
    float g[16];
#pragma unroll
    for (int i = 0; i < 16; ++i) g[i] = gq[i >> 2][i & 3];
    float v[16]; float ss = 0.f;
#pragma unroll
    for (int i = 0; i < 4; ++i) { v[2 * i] = bf2f(a0[i]) - lam * bf2f(b0[i]); v[2 * i + 1] = bf2f(a0[i] >> 16) - lam * bf2f(b0[i] >> 16); v[8 + 2 * i] = bf2f(a1[i]) - lam * bf2f(b1[i]); v[9 + 2 * i] = bf2f(a1[i] >> 16) - lam * bf2f(b1[i] >> 16); }
#pragma unroll
    for (int i = 0; i < 16; ++i) ss += v[i] * v[i];
    ss += __shfl_xor(ss, 1); ss += __shfl_xor(ss, 2); ss += __shfl_xor(ss, 4);
    const float sc = rsqrtf(ss * (1.0f / 128.0f) + 1e-6f) * (1.0f - lam_init);
    u32x4 w0, w1;
#pragma unroll
    for (int i = 0; i < 4; ++i) { w0[i] = pk2(v[2 * i] * sc * g[2 * i], v[2 * i + 1] * sc * g[2 * i + 1]); w1[i] = pk2(v[8 + 2 * i] * sc * g[8 + 2 * i], v[9 + 2 * i] * sc * g[9 + 2 * i]); }
    bf16_t* y = (bf16_t*)(p.ws + WS_DFQ) + (size_t)r * 1024 + h * 128 + part * 16;
    *(u32x4*)y = w0; *(u32x4*)(y + 8) = w1;
}
__device__ __forceinline__ void ph_final_row(const P& p, int r, int lane, const f32x4 (&gpre)[8]) {
    const bf16_t* xb = (const bf16_t*)(p.ws + WS_X) + (size_t)r * D;
    f32x4 v[8]; float ss = 0.f;
#pragma unroll
    for (int j = 0; j < 8; ++j) { const u32x2 w = *(const u32x2*)(xb + j * 256 + lane * 4); v[j] = (f32x4){bf2f(w.x), bf2f(w.x >> 16), bf2f(w.y), bf2f(w.y >> 16)}; ss += v[j][0] * v[j][0] + v[j][1] * v[j][1] + v[j][2] * v[j][2] + v[j][3] * v[j][3]; }
    const float rstd = rsqrtf(wave_sum(ss) * (1.0f / 2048.0f) + 1e-6f);
    float* o = p.out + (r < NCTX ? O_YP + (size_t)r * D : O_YS + (size_t)(r - NCTX) * D);
#pragma unroll
    for (int j = 0; j < 8; ++j) { const int c = j * 256 + lane * 4; *(f32x4*)(o + c) = v[j] * rstd * gpre[j]; }
}

__device__ __forceinline__ void load_args(P& p) {
#if defined(__HIP_DEVICE_COMPILE__)
    const __attribute__((address_space(4))) unsigned long long* q = (const __attribute__((address_space(4))) unsigned long long*)__builtin_amdgcn_kernarg_segment_ptr();
    asm volatile("" : "+s"(q));
#pragma unroll
    for (int i = 0; i < 38; ++i) p.in[i] = (const float*)q[i];
    p.out = (float*)q[38]; p.ws = (unsigned char*)q[39];
#endif
}
constexpr int NTHR = 512, LDS_BYTES = 147456, MISC_OFF = 131072;
#ifndef PROBE
#define PROBE 0
#endif
#ifndef PROBE_MASK_D
#define PROBE_MASK_D 0u
#endif
#ifndef PROBE_MASK_A
#define PROBE_MASK_A 0u
#endif
#define PROBE_MULT 10
#define PROBE_ADIV 100.0f
#define STAMP(idx) do { if (PROBE) { if (blockIdx.x == 0 && bar.w == 0u && lane_id_() == 0u) ((LAS unsigned long long*)((LAS unsigned char*)lds + MISC_OFF + 2048))[idx] = __builtin_amdgcn_s_memrealtime(); } } while (0)
#define GRID_BAR() do { XcdBarrier b_ = bar; asm volatile("" : "+s"(b_.x)); xcd_barrier(b_); } while (0)

#define PH_VARS P p; load_args(p); unsigned char* ws = p.ws; (void)ws; int tid_ = (int)(bar.w * 64u + lane_id_()); asm volatile("" : "+v"(tid_)); const int lane = tid_ & 63, wave = __builtin_amdgcn_readfirstlane(tid_ >> 6), half = tid_ >> 8, vt = tid_ & 255; \
    const int gw = blockIdx.x * 8 + wave, vb = blockIdx.x * 2 + half; (void)lane; (void)half; (void)vt; (void)gw; (void)vb;

template <int l>
__device__ __forceinline__ void run_layer(unsigned char* lds, const XcdBarrier& bar, const int G, const int NGW) {
        { PH_VARS ph_convert(p, l, gw, NGW, lane, (LAS float*)((LAS unsigned char*)lds + wave * 16384), l == 0, true); }
        { PH_VARS const int per_ = (MTOK + NGW - 1) / NGW, r0_ = gw * per_; ph_hnorm_rows(p, l, 0, r0_, r0_ + per_ < MTOK ? r0_ + per_ : MTOK, lane); }
        GRID_BAR(); STAMP(1 + 17 * l + 1);
        { PH_VARS pg8::Gemm g{(const bf16_t*)(ws + WS_H), (const bf16_t*)(ws + WS_WBF + WB_IN), MTOK, 10496, D}; pg8::StaticOrder S; S.init(MTOK, 10496, G, (int)blockIdx.x);
          pg8::gemm_phase<Epi8In, pg8::StaticOrder, true, true>((LAS unsigned char*)lds, g, S, Epi8In{ws}, tid_); }
        GRID_BAR(); STAMP(1 + 17 * l + 2);
        { PH_VARS for (int ch = blockIdx.x; ch < 160; ch += G) ml::scalars_wg(p, l, ch, wave, lane, (LAS float*)((LAS unsigned char*)lds)); for (int r = gw; r < MALL; r += NGW) ph_prep_row(p, l, r, lane); }
        GRID_BAR(); STAMP(1 + 17 * l + 3);
        { PH_VARS pg8::Gemm g{(const bf16_t*)(ws + WS_CKVN), (const bf16_t*)(ws + WS_WBF + WB_KVB), MALL, 2048, 512}; pg8::StaticOrder S; S.init(MALL, 2048, G, (int)blockIdx.x);
          pg8::gemm_phase<Epi8Kvb, pg8::StaticOrder, true, true>((LAS unsigned char*)lds, g, S, Epi8Kvb{(bf16_t*)(ws + WS_KFULL), (bf16_t*)(ws + WS_VFULL)}, tid_); }
        STAMP(1 + 17 * l + 4);
        { PH_VARS ml::intra_phase((LAS unsigned char*)lds, p, l, tid_); }
        GRID_BAR();
        { PH_VARS ml::seq_phase((LAS unsigned char*)lds, p, l, tid_); }
        GRID_BAR(); STAMP(1 + 17 * l + 5);
        { PH_VARS
          for (int u = xcd_slot(); u < 256; u += G) { int ln_ = lane; asm volatile("" : "+v"(ln_)); s5::lat_unit(p, l, (LAS unsigned char*)lds, u, wave, ln_); }
          if (wave < 4) { for (int u = wave * G + blockIdx.x; u < 1024; u += 4 * G) s5::ctx_unit(p, l, (LAS unsigned char*)lds + wave * 8192, u, lane); }
          else { const float* g_ = p.in[19] + l * 1024 + lane * 4; f32x4 gg_[4];
#pragma unroll
            for (int h = 0; h < 4; ++h) gg_[h] = *(const f32x4*)(g_ + h * 256);
            for (int r = blockIdx.x * 4 + (wave - 4); r < MTOK; r += G * 4) ph_ml_combine_row(p, l, r, lane, gg_); } }
        GRID_BAR(); STAMP(1 + 17 * l + 6);
        { PH_VARS const float* dv_ = p.in[29] + l * 1024; f32x4 dpre_[4];
#pragma unroll
          for (int j = 0; j < 2; ++j) { dpre_[2 * j] = *(const f32x4*)(dv_ + j * 512 + lane * 8); dpre_[2 * j + 1] = *(const f32x4*)(dv_ + j * 512 + lane * 8 + 4); }
          for (int r = gw; r < MTOK; r += NGW) s5::combine_row(p, l, r, lane, dpre_); }
        GRID_BAR(); STAMP(1 + 17 * l + 7);
        { PH_VARS pg8::Gemm g{(const bf16_t*)(ws + WS_HB), (const bf16_t*)(ws + WS_WBF + WB_GLU), MTOK, 1024, 1024}; pg8::StaticOrder S; S.init(MTOK, 1024, G, (int)blockIdx.x);
          pg8::gemm_phase<Epi8Glu, pg8::StaticOrder, true, true>((LAS unsigned char*)lds, g, S, Epi8Glu{(const bf16_t*)(ws + WS_HB), (bf16_t*)(ws + WS_S5U)}, tid_); }
        STAMP(1 + 17 * l + 8);
        { PH_VARS fa::Args aa{(const bf16_t*)(ws + WS_MQ), (const bf16_t*)(ws + WS_KFULL), (const bf16_t*)(ws + WS_VFULL), (bf16_t*)(ws + WS_MLQ), 1536, 1536, 1024, 1024, 8, 1, 0.07216878364870322f, 0};
          fa::attn_phase<192>((LAS unsigned char*)lds, aa, tid_); }
        STAMP(1 + 17 * l + 9);
        { PH_VARS fa::Args aa{(const bf16_t*)(ws + WS_DFQ), (const bf16_t*)(ws + WS_DFK), (const bf16_t*)(ws + WS_DFV), (bf16_t*)(ws + WS_DFO), 1024, 1024, 1024, 2048, 16, 2, 0.125f, 0};
          fa::attn_phase<64>((LAS unsigned char*)lds, aa, tid_); }
        GRID_BAR(); STAMP(1 + 17 * l + 10);
        { PH_VARS const float lam_init = (l == 0) ? 0.2f : 0.35550906759096927f;
          const float* lp = p.in[31] + l * 256;
          const float lam = __expf(wave_sum(lp[lane] * lp[64 + lane])) - __expf(wave_sum(lp[128 + lane] * lp[192 + lane])) + lam_init;
          const float* g_ = p.in[32] + l * 128 + (lane & 7) * 16; f32x4 gq_[4];
#pragma unroll
          for (int i = 0; i < 4; ++i) gq_[i] = *(const f32x4*)(g_ + 4 * i);
          for (int r = gw; r < MTOK; r += NGW) ph_df_combine_row(p, l, lam_init, lam, r, lane, gq_); }
        GRID_BAR(); STAMP(1 + 17 * l + 11);
        { PH_VARS pg8::Gemm g{(const bf16_t*)(ws + WS_H), (const bf16_t*)(ws + WS_WBF + WB_IN) + (size_t)10496 * D, MTOK, GATE_COLS, D}; pg8::StaticOrder S; S.init(MTOK, GATE_COLS, G, (int)blockIdx.x);
          pg8::gemm_phase<Epi8Gate, pg8::StaticOrder, true, true>((LAS unsigned char*)lds, g, S, Epi8Gate{(bf16_t*)(ws + WS_GS)}, tid_); }
        GRID_BAR(); STAMP(1 + 17 * l + 12);
        { PH_VARS pg8::Gemm g{(const bf16_t*)(ws + WS_HF), (const bf16_t*)(ws + WS_WBF + WB_BR) + (size_t)0 * 2048 * 1024, MTOK, D, 1024}; pg8::StaticOrder S; S.init(MTOK, D, G, (int)blockIdx.x);
          pg8::gemm_phase<Epi8Merge, pg8::StaticOrder, true, true>((LAS unsigned char*)lds, g, S, Epi8Merge{(const bf16_t*)(ws + WS_GS), (bf16_t*)(ws + WS_H), 0, 0}, tid_); }
        { PH_VARS pg8::Gemm g{(const bf16_t*)(ws + WS_MLQ), (const bf16_t*)(ws + WS_WBF + WB_BR) + (size_t)1 * 2048 * 1024, MTOK, D, 1024}; pg8::StaticOrder S; S.init(MTOK, D, G, (int)blockIdx.x);
          pg8::gemm_phase<Epi8Merge, pg8::StaticOrder, true, true>((LAS unsigned char*)lds, g, S, Epi8Merge{(const bf16_t*)(ws + WS_GS), (bf16_t*)(ws + WS_H), 1, 0}, tid_); }
        { PH_VARS pg8::Gemm g{(const bf16_t*)(ws + WS_S5U), (const bf16_t*)(ws + WS_WBF + WB_BR) + (size_t)2 * 2048 * 1024, MTOK, D, 1024}; pg8::StaticOrder S; S.init(MTOK, D, G, (int)blockIdx.x);
          pg8::gemm_phase<Epi8Merge, pg8::StaticOrder, true, true>((LAS unsigned char*)lds, g, S, Epi8Merge{(const bf16_t*)(ws + WS_GS), (bf16_t*)(ws + WS_H), 2, 0}, tid_); }
        { PH_VARS pg8::Gemm g{(const bf16_t*)(ws + WS_DFQ), (const bf16_t*)(ws + WS_WBF + WB_BR) + (size_t)3 * 2048 * 1024, MTOK, D, 1024}; pg8::StaticOrder S; S.init(MTOK, D, G, (int)blockIdx.x);
          pg8::gemm_phase<Epi8Merge, pg8::StaticOrder, true, true>((LAS unsigned char*)lds, g, S, Epi8Merge{(const bf16_t*)(ws + WS_GS), (bf16_t*)(ws + WS_H), 3, 0}, tid_); }
        GRID_BAR(); STAMP(1 + 17 * l + 13);
        { PH_VARS pg8::Gemm g{(const bf16_t*)(ws + WS_H), (const bf16_t*)(ws + WS_WBF + WB_O), MTOK, D, D}; pg8::StaticOrder S; S.init(MTOK, D, G, (int)blockIdx.x);
          pg8::gemm_phase<Epi8Res, pg8::StaticOrder, true, true>((LAS unsigned char*)lds, g, S, Epi8Res{p, l, 4096, 0, 0}, tid_); }
        GRID_BAR(); STAMP(1 + 17 * l + 14);
        { PH_VARS const int per_ = (MTOK + NGW - 1) / NGW, r0_ = gw * per_; ph_hnorm_rows(p, l, 1, r0_, r0_ + per_ < MTOK ? r0_ + per_ : MTOK, lane); }
        GRID_BAR(); STAMP(1 + 17 * l + 15);
        { PH_VARS pg8::Gemm g{(const bf16_t*)(ws + WS_H), (const bf16_t*)(ws + WS_WBF + WB_FIN), MTOK, 2 * FFN, D}; pg8::StaticOrder S; S.init(MTOK, 2 * FFN, G, (int)blockIdx.x);
          pg8::gemm_phase<Epi8FfnIn, pg8::StaticOrder, true, true>((LAS unsigned char*)lds, g, S, Epi8FfnIn{(bf16_t*)(ws + WS_FFNH)}, tid_); }
        GRID_BAR(); STAMP(1 + 17 * l + 16);
        { PH_VARS pg8::Gemm g{(const bf16_t*)(ws + WS_FFNH), (const bf16_t*)(ws + WS_WBF + WB_FOUT), MTOK, D, FFN}; pg8::StaticOrder S; S.init(MTOK, D, G, (int)blockIdx.x);
          pg8::gemm_phase<Epi8Res, pg8::StaticOrder, true, true>((LAS unsigned char*)lds, g, S, Epi8Res{p, l, 10240, 1, 0}, tid_); }
        if (l == 0) { PH_VARS
          const int rem = 640 % G, nidle = rem ? G - rem : G, idx = rem ? (int)blockIdx.x - rem : (int)blockIdx.x;
          if (idx >= 0) ph_convert(p, 1, idx * 8 + wave, nidle * 8, lane, (LAS float*)((LAS unsigned char*)lds + wave * 16384), true, false); }
        GRID_BAR(); STAMP(1 + 17 * l + 17);
}

__global__ void __launch_bounds__(NTHR, 2) mega(P p_arg) {
    extern __shared__ __attribute__((aligned(16))) unsigned char lds[];
    const int tid = threadIdx.x;
    const int G = gridDim.x, NGW = G * 8;
    for (int u = tid; u < (LDS_BYTES - MISC_OFF) / 4; u += NTHR) ((LAS unsigned*)((LAS unsigned char*)lds + MISC_OFF))[u] = 0u;
    __syncthreads();
    XcdBarrier bar = xcd_barrier_post((unsigned*)(p_arg.ws + WS_CTL), (volatile LAS unsigned*)((LAS unsigned char*)lds + MISC_OFF + 32));
    STAMP(0);
    { PH_VARS ph_mod_partial(p, tid_, (float*)lds); }
    GRID_BAR();
    { PH_VARS ph_mod_reduce(p, tid_); }
    GRID_BAR(); STAMP(1);
    run_layer<0>(lds, bar, G, NGW);
    run_layer<1>(lds, bar, G, NGW);
    { PH_VARS f32x4 gpre_[8];
#pragma unroll
      for (int j = 0; j < 8; ++j) gpre_[j] = *(const f32x4*)(p.in[37] + j * 256 + lane * 4);
      for (int r = gw; r < MTOK; r += NGW) ph_final_row(p, r, lane, gpre_);
#if PROBE
      STAMP(35);
      if (blockIdx.x == 0 && bar.w == 0u && lane_id_() == 0u) {
          asm volatile("s_waitcnt vmcnt(0) lgkmcnt(0)" ::: "memory");
          const LAS unsigned long long* ts = (const LAS unsigned long long*)((LAS unsigned char*)lds + MISC_OFF + 2048);
          unsigned long long sd = 0, sa = 0;
          for (int ll = 0; ll < 2; ++ll) for (int i = 0; i < 17; ++i) { const unsigned long long d = ts[1 + 17 * ll + i + 1] - ts[1 + 17 * ll + i]; if ((PROBE_MASK_D >> i) & 1u) sd += d; if ((PROBE_MASK_A >> i) & 1u) sa += d; }
          { const unsigned long long d = ts[1] - ts[0]; if ((PROBE_MASK_D >> 17) & 1u) sd += d; if ((PROBE_MASK_A >> 17) & 1u) sa += d; }
          { const unsigned long long d = ts[35] - ts[34]; if ((PROBE_MASK_D >> 18) & 1u) sd += d; if ((PROBE_MASK_A >> 18) & 1u) sa += d; }
          float v = (float)sa * 0.01f / PROBE_ADIV; v = v > 120.f ? 120.f : v;
          if (PROBE_MASK_A) p.out[O_YS] += v;
          const unsigned long long t0 = __builtin_amdgcn_s_memrealtime(), wait = sd * PROBE_MULT;
          while (__builtin_amdgcn_s_memrealtime() - t0 < wait) __builtin_amdgcn_s_sleep(32);
      }
#endif
    }
}

extern "C" void kernel_launch(void* const* d_in, const int* in_sizes, int n_in, void* d_out, int out_size, void* d_ws, size_t ws_size, hipStream_t stream) {
    static int grid = 0;
    if (grid == 0) {
        if (n_in != 38 || out_size != (int)O_END || ws_size < WS_END) { fprintf(stderr, "kernel_launch: unexpected shapes (n_in %d out %d ws %zu)\n", n_in, out_size, ws_size); grid = -1; return; }
        int dev = 0, cus = 0, per_cu = 0;
        if (hipGetDevice(&dev) != hipSuccess || hipDeviceGetAttribute(&cus, hipDeviceAttributeMultiprocessorCount, dev) != hipSuccess) { grid = -1; return; }
        if (hipFuncSetAttribute((const void*)mega, hipFuncAttributeMaxDynamicSharedMemorySize, LDS_BYTES) != hipSuccess) { fprintf(stderr, "kernel_launch: hipFuncSetAttribute failed\n"); grid = -1; return; }
        if (hipOccupancyMaxActiveBlocksPerMultiprocessor(&per_cu, (const void*)mega, NTHR, LDS_BYTES) != hipSuccess || per_cu < 1) { fprintf(stderr, "kernel_launch: occupancy query says %d workgroups per CU\n", per_cu); grid = -1; return; }
        (void)hipGetLastError();
        grid = cus;
    }
    if (grid < 0) return;
    if (hipMemsetAsync((char*)d_ws + WS_CTL, 0, CTL_BYTES, stream) != hipSuccess) return;
    P p{};
    for (int i = 0; i < 38; ++i) p.in[i] = (const float*)d_in[i];
    p.out = (float*)d_out; p.ws = (unsigned char*)d_ws;
    hipLaunchKernelGGL(mega, dim3(grid), dim3(NTHR), LDS_BYTES, stream, p);
}
```
